# Optimizing an MI355X kernel written in HIP

```python
import math
import jax, jax.numpy as jnp
from jax import lax
import numpy as np

D_MODEL = 1024
BATCH = 2
SEQ = 16384
DEPTH = 4

GRID_W = 64
CTX_LEN = 256
HEAD_DIM = 64
N_Q_HEADS = D_MODEL // HEAD_DIM
H_GLOBAL = N_Q_HEADS // 2
KV_GLOBAL = 2
G_GLOBAL = H_GLOBAL // KV_GLOBAL
H_LOCAL = N_Q_HEADS - H_GLOBAL
KV_LOCAL = 2
G_LOCAL = H_LOCAL // KV_LOCAL
MIX_WIDTH = (H_GLOBAL + H_LOCAL) * HEAD_DIM
WINDOW = 128
Q_BLOCK = 128
ROPE_THETA = 10000.0
N_EXPERTS = 16
N_GROUPS = 4
EXPERTS_PER_GROUP = N_EXPERTS // N_GROUPS
TOP_K = 2
D_EXPERT = D_MODEL // 2
NORM_EPS = 1e-6
ATTN_SCALE = 1.0 / math.sqrt(HEAD_DIM)
NEG_INF = -1e30
WIDTHS = (H_GLOBAL * HEAD_DIM, KV_GLOBAL * HEAD_DIM, KV_GLOBAL * HEAD_DIM,
          H_LOCAL * HEAD_DIM, KV_LOCAL * HEAD_DIM, KV_LOCAL * HEAD_DIM)
IN_WIDTH = sum(WIDTHS)
SPLIT_POINTS = tuple(int(v) for v in np.cumsum(WIDTHS)[:-1])

kernel_name = "hybrid_dit_gqa_window_sink_grouped_moe"


def _rms(x, g):
    xf = x.astype(jnp.float32)
    y = xf * lax.rsqrt(jnp.mean(xf * xf, axis=-1, keepdims=True) + NORM_EPS)
    return (y * g.astype(jnp.float32)).astype(x.dtype)


def _modulate(h, shift, scale):
    return h * (1.0 + scale) + shift


def _axial_rope_tables(n_tokens):
    rows = n_tokens // GRID_W
    row = jnp.repeat(jnp.arange(rows, dtype=jnp.int32), GRID_W).astype(jnp.float32)
    col = jnp.tile(jnp.arange(GRID_W, dtype=jnp.int32), rows).astype(jnp.float32)
    n_freq = HEAD_DIM // 4
    inv = ROPE_THETA ** (-jnp.arange(n_freq, dtype=jnp.float32) / n_freq)
    ang = jnp.stack([row[:, None] * inv, col[:, None] * inv], axis=1)
    return jnp.cos(ang), jnp.sin(ang)


def _apply_rope(x, cos, sin):
    n_freq = HEAD_DIM // 4
    shp = x.shape
    xr = x.astype(jnp.float32).reshape(shp[:-1] + (2, 2, n_freq))
    x1, x2 = xr[..., 0, :], xr[..., 1, :]
    bshape = (1, shp[1]) + (1,) * (x.ndim - 3) + (2, n_freq)
    cs, sn = cos.reshape(bshape), sin.reshape(bshape)
    out = jnp.stack([x1 * cs - x2 * sn, x2 * cs + x1 * sn], axis=-2)
    return out.reshape(shp).astype(x.dtype)


def _project(t, w_in):
    b, n = t.shape[0], t.shape[1]
    qg, kg, vg, ql, kl, vl = jnp.split(t @ w_in, SPLIT_POINTS, axis=-1)
    return (qg.reshape(b, n, KV_GLOBAL, G_GLOBAL, HEAD_DIM),
            kg.reshape(b, n, KV_GLOBAL, HEAD_DIM), vg.reshape(b, n, KV_GLOBAL, HEAD_DIM),
            ql.reshape(b, n, KV_LOCAL, G_LOCAL, HEAD_DIM),
            kl.reshape(b, n, KV_LOCAL, HEAD_DIM), vl.reshape(b, n, KV_LOCAL, HEAD_DIM))


def _attend(q, k, v, sink, mask):
    b, nq, kvh, g, d = q.shape
    n = k.shape[1]
    s = jnp.einsum('bqkgd,bnkd->bkgqn', q, k, preferred_element_type=jnp.float32) * ATTN_SCALE
    if mask is not None:
        s = jnp.where(mask, s, NEG_INF)
    if sink is not None:
        sk = jnp.broadcast_to(sink.astype(jnp.float32).reshape(1, kvh, g, 1, 1), s.shape[:-1] + (1,))
        s = jnp.concatenate([s, sk], axis=-1)
    p = jax.nn.softmax(s, axis=-1)[..., :n].astype(v.dtype)
    o = jnp.einsum('bkgqn,bnkd->bqkgd', p, v)
    return o.reshape(b, nq, kvh * g * d)


def _global_latent(q, k, v, kc, vc):
    b, s, kvh, g, d = q.shape
    nblk = s // Q_BLOCK
    k_all = jnp.concatenate([kc, k], axis=1)
    v_all = jnp.concatenate([vc, v], axis=1)
    qb = q.reshape(b, nblk, Q_BLOCK, kvh, g, d).transpose(1, 0, 2, 3, 4, 5)
    o = lax.map(lambda qi: _attend(qi, k_all, v_all, None, None), qb)
    return o.transpose(1, 0, 2, 3).reshape(b, s, kvh * g * d)


def _local_latent(q, k, v, kc, vc, sink):
    b, s, kvh, g, d = q.shape
    nblk = s // Q_BLOCK
    span = Q_BLOCK + 2 * WINDOW
    pad = ((0, 0), (WINDOW, WINDOW), (0, 0), (0, 0))
    kp, vp = jnp.pad(k, pad), jnp.pad(v, pad)
    qb = q.reshape(b, nblk, Q_BLOCK, kvh, g, d).transpose(1, 0, 2, 3, 4, 5)
    qi_idx = jnp.arange(Q_BLOCK, dtype=jnp.int32)[:, None]
    kj_idx = jnp.arange(span, dtype=jnp.int32)[None, :]
    band = jnp.abs(kj_idx - WINDOW - qi_idx) <= WINDOW
    ctx_ok = jnp.ones((Q_BLOCK, kc.shape[1]), dtype=bool)

    def block(args):
        qi, n = args
        start = n * Q_BLOCK
        kb = lax.dynamic_slice_in_dim(kp, start, span, axis=1)
        vb = lax.dynamic_slice_in_dim(vp, start, span, axis=1)
        key_pos = start - WINDOW + kj_idx
        valid = band & (key_pos >= 0) & (key_pos < s)
        mask = jnp.concatenate([valid, ctx_ok], axis=-1)
        return _attend(qi, jnp.concatenate([kb, kc], axis=1), jnp.concatenate([vb, vc], axis=1), sink, mask)

    o = lax.map(block, (qb, jnp.arange(nblk, dtype=jnp.int32)))
    return o.transpose(1, 0, 2, 3).reshape(b, s, kvh * g * d)


def _token_mixers(h, hc, w_in, qn_g, kn_g, qn_l, kn_l, sink, cos, sin, with_ctx_out):
    qg, kg, vg, ql, kl, vl = _project(h, w_in)
    qgc, kgc, vgc, qlc, klc, vlc = _project(hc, w_in)
    qg = _apply_rope(_rms(qg, qn_g), cos, sin)
    kg = _apply_rope(_rms(kg, kn_g), cos, sin)
    ql = _apply_rope(_rms(ql, qn_l), cos, sin)
    kl = _apply_rope(_rms(kl, kn_l), cos, sin)
    qgc, kgc = _rms(qgc, qn_g), _rms(kgc, kn_g)
    qlc, klc = _rms(qlc, qn_l), _rms(klc, kn_l)
    y = jnp.concatenate([_global_latent(qg, kg, vg, kgc, vgc),
                         _local_latent(ql, kl, vl, klc, vlc, sink)], axis=-1)
    if not with_ctx_out:
        return y, None
    yc = jnp.concatenate([_attend(qgc, kgc, vgc, None, None),
                          _attend(qlc, klc, vlc, sink, None)], axis=-1)
    return y, yc


def _grouped_moe(t, router_w, router_b, w_gate, w_up, w_down):
    n = t.shape[0]
    scores = jax.nn.sigmoid((t @ router_w).astype(jnp.float32))
    sel = scores + router_b.astype(jnp.float32)
    grp_score = lax.top_k(sel.reshape(n, N_GROUPS, EXPERTS_PER_GROUP), TOP_K)[0].sum(-1)
    g_idx = lax.top_k(grp_score, 1)[1][:, 0]
    in_group = jnp.repeat(jax.nn.one_hot(g_idx, N_GROUPS, dtype=jnp.float32), EXPERTS_PER_GROUP, axis=-1) > 0
    e_idx = lax.top_k(jnp.where(in_group, sel, -jnp.inf), TOP_K)[1]
    w = jnp.take_along_axis(scores, e_idx, axis=-1)
    w = w / jnp.sum(w, axis=-1, keepdims=True)
    gates = jnp.sum(jax.nn.one_hot(e_idx, N_EXPERTS, dtype=jnp.float32) * w[..., None], axis=1)
    y = jnp.zeros(t.shape, jnp.float32)
    for e in range(N_EXPERTS):
        he = jax.nn.silu(t @ w_gate[e]) * (t @ w_up[e])
        y = y + gates[:, e:e + 1] * (he @ w_down[e]).astype(jnp.float32)
    return y.astype(t.dtype)


def setup_inputs(seed: int = 0) -> dict:
    key = jax.random.key(seed)
    ks = jax.random.split(key, 20)
    L, D, E, F = DEPTH, D_MODEL, N_EXPERTS, D_EXPERT

    def nrm(k, shape, s):
        return jax.random.normal(k, shape, jnp.float32) * s

    return {
        "x": nrm(ks[0], (BATCH, SEQ, D), 1.0),
        "c": nrm(ks[1], (BATCH, D), 1.0),
        "ctx": nrm(ks[2], (BATCH, CTX_LEN, D), 1.0),
        "c_ctx": nrm(ks[3], (D,), 1.0),
        "ada_w": nrm(ks[4], (L, D, 6 * D), 0.5 * D ** -0.5),
        "ada_b": nrm(ks[5], (L, 6 * D), 0.02),
        "attn_norm_g": 1.0 + nrm(ks[6], (L, D), 0.02),
        "ffn_norm_g": 1.0 + nrm(ks[7], (L, D), 0.02),
        "w_in": nrm(ks[8], (L, D, IN_WIDTH), D ** -0.5),
        "qn_global": 1.0 + nrm(ks[9], (L, HEAD_DIM), 0.02),
        "kn_global": 1.0 + nrm(ks[10], (L, HEAD_DIM), 0.02),
        "qn_local": 1.0 + nrm(ks[11], (L, HEAD_DIM), 0.02),
        "kn_local": 1.0 + nrm(ks[12], (L, HEAD_DIM), 0.02),
        "sink_logit": nrm(ks[13], (L, H_LOCAL), 0.5),
        "w_out": nrm(ks[14], (L, MIX_WIDTH, D), MIX_WIDTH ** -0.5),
        "router_w": nrm(ks[15], (D, E), D ** -0.5),
        "router_b": nrm(ks[16], (E,), 0.01),
        "w_gate": nrm(ks[17], (L, E, D, F), D ** -0.5),
        "w_up": nrm(ks[18], (L, E, D, F), D ** -0.5),
        "w_down": nrm(ks[19], (L, E, F, D), F ** -0.5),
    }


def reference(x, c, ctx, c_ctx, ada_w, ada_b, attn_norm_g, ffn_norm_g, w_in, qn_global, kn_global,
              qn_local, kn_local, sink_logit, w_out, router_w, router_b, w_gate, w_up, w_down):
    b, s, d = x.shape
    n_ctx = ctx.shape[1]
    cos, sin = _axial_rope_tables(s)
    silu_c = jax.nn.silu(c)
    silu_cc = jax.nn.silu(c_ctx)
    xc = ctx
    for l in range(DEPTH):
        need_ctx = l < DEPTH - 1
        sh1, sc1, g1, sh2, sc2, g2 = [m[:, None, :] for m in jnp.split(silu_c @ ada_w[l] + ada_b[l], 6, axis=-1)]
        sh1c, sc1c, g1c, sh2c, sc2c, g2c = jnp.split(silu_cc @ ada_w[l] + ada_b[l], 6, axis=-1)
        h = _modulate(_rms(x, attn_norm_g[l]), sh1, sc1)
        hc = _modulate(_rms(xc, attn_norm_g[l]), sh1c, sc1c)
        y, yc = _token_mixers(h, hc, w_in[l], qn_global[l], kn_global[l], qn_local[l], kn_local[l],
                              sink_logit[l], cos, sin, need_ctx)
        x = x + g1 * (y @ w_out[l])
        h = _modulate(_rms(x, ffn_norm_g[l]), sh2, sc2)
        if need_ctx:
            xc = xc + g1c * (yc @ w_out[l])
            hc = _modulate(_rms(xc, ffn_norm_g[l]), sh2c, sc2c)
            tokens = jnp.concatenate([h.reshape(b * s, d), hc.reshape(b * n_ctx, d)], axis=0)
            yf = _grouped_moe(tokens, router_w, router_b, w_gate[l], w_up[l], w_down[l])
            x = x + g2 * yf[:b * s].reshape(b, s, d)
            xc = xc + g2c * yf[b * s:].reshape(b, n_ctx, d)
        else:
            yf = _grouped_moe(h.reshape(b * s, d), router_w, router_b, w_gate[l], w_up[l], w_down[l])
            x = x + g2 * yf.reshape(b, s, d)
    return x
```

```cpp
#include <hip/hip_runtime.h>
#include <hip/hip_bf16.h>
#include <cstdio>
#include <cstdint>
#include <cmath>

#define LAS __attribute__((address_space(3)))
#define GAS __attribute__((address_space(1)))
typedef unsigned short bf16_t;
typedef short bf16x8 __attribute__((ext_vector_type(8)));
typedef float f32x4 __attribute__((ext_vector_type(4)));
typedef float f32x2 __attribute__((ext_vector_type(2)));
typedef unsigned u32x4 __attribute__((ext_vector_type(4)));
typedef unsigned u32x2 __attribute__((ext_vector_type(2)));
typedef GAS unsigned gu32;

constexpr int NB = 2, SEQ = 16384, DM = 1024, NCTX = 256, NLAYER = 4, NEXP = 16, DEXP = 512;
constexpr int RB = SEQ + NCTX;
constexpr int NROW = NB * RB;
constexpr int NCLS = 24, CAP = NROW;
constexpr int MAXSLOT = 39424;
constexpr float NORM_EPS = 1e-6f;
constexpr float C2 = 0.125f * 1.4426950408889634f;
constexpr float LOG2E = 1.4426950408889634f;

constexpr size_t MiB = 1u << 20;
constexpr size_t WS_CTL = 0, CTL_ZERO_BYTES = 1 * MiB;
constexpr size_t WS_MODV = 1 * MiB;
constexpr size_t WS_ROPE = 2 * MiB;
constexpr size_t WS_GN = 3 * MiB;
constexpr size_t WS_TOK = 4 * MiB;
constexpr size_t WS_WTS = 8 * MiB;
constexpr size_t WS_WIN = 16 * MiB;
constexpr size_t WS_WOUT = 28 * MiB;
constexpr size_t WS_WGU = 36 * MiB;
constexpr size_t WS_WD = 164 * MiB;
constexpr size_t WS_XS = 228 * MiB;
constexpr size_t WS_HN = 358 * MiB;
constexpr size_t WS_QO = 423 * MiB;
constexpr size_t WS_KV = 488 * MiB;
constexpr size_t WS_ACT = 423 * MiB;
constexpr size_t WS_END = 522 * MiB;
static_assert(WS_TOK + (size_t)NCLS * CAP * 4 <= WS_WTS && WS_WTS + (size_t)NCLS * CAP * 8 <= WS_WIN, "lists");
static_assert(WS_KV + (size_t)(NROW + 256) * 512 * 2 <= WS_END && WS_ACT + (size_t)MAXSLOT * 1024 * 2 <= WS_END, "ws map");
constexpr int CW_TMO = 0, CW_CODE = 1, CW_BAR = 4096, CW_CNT = 8192;

constexpr int RING_OFF = 0, RING_BYTES = 131072;
constexpr int LDSCTL_OFF = RING_BYTES, MISC_OFF = LDSCTL_OFF + 320, MOE_OFF = LDSCTL_OFF + 1024, OFFS_OFF = LDSCTL_OFF + 2048  ;
constexpr int LDS_BYTES = 147456;
constexpr int NWAVES = 8;

#define LDS_WAIT() asm volatile("s_waitcnt lgkmcnt(0)" ::: "memory")
#define VM_WAIT() asm volatile("s_waitcnt vmcnt(0)" ::: "memory")
#define RLX_AGENT __ATOMIC_RELAXED, __HIP_MEMORY_SCOPE_AGENT

__device__ __forceinline__ unsigned f2bf(float f) { unsigned u = __builtin_bit_cast(unsigned, f); return (u + 0x7fffu + ((u >> 16) & 1u)) >> 16; }
__device__ __forceinline__ unsigned pk2(float lo, float hi) { return f2bf(lo) | (f2bf(hi) << 16); }
__device__ __forceinline__ unsigned cvt_pk_bf16(float lo, float hi) { unsigned r; asm volatile("v_cvt_pk_bf16_f32 %0, %1, %2" : "=v"(r) : "v"(lo), "v"(hi)); return r; }
__device__ __forceinline__ float wave_sum(float v) {
#pragma unroll
    for (int o = 1; o < 64; o <<= 1) v += __shfl_xor(v, o);
    return v;
}

#define XB_TMO      128
#define XB_XCNT(j)  (256  + 64 * (j))
#define XB_XSUB(j)  (1280 + 64 * (j))
#define XB_XGEN(j)  (2304 + 64 * (j))
#define XB_TOP      3328
#define XB_TOPGEN   3392
#define XCD_BAR_WORDS 3456
#define XB_SPIN_CAP (1u << 22)
__device__ __forceinline__ unsigned xb_ld(unsigned* p)              { return __hip_atomic_load(p, __ATOMIC_RELAXED, __HIP_MEMORY_SCOPE_AGENT); }
__device__ __forceinline__ unsigned xb_add(unsigned* p, unsigned v) { return __hip_atomic_fetch_add(p, v, __ATOMIC_RELAXED, __HIP_MEMORY_SCOPE_AGENT); }
__device__ __forceinline__ unsigned xb_xcc_id() { return (unsigned)__builtin_amdgcn_s_getreg((3 << 11) | 20) & 0xFu; }
#define XB_SPIN(cond, bar) do { unsigned _sp = 0; while (cond) { __builtin_amdgcn_s_sleep(1); \
    if ((++_sp & 255u) == 0u) { if (xb_ld(&(bar)[XB_TMO])) break; if (_sp > XB_SPIN_CAP) { atomicAdd(&(bar)[XB_TMO], 1u); break; } } } } while (0)
struct XcdBarrier { unsigned* bar; unsigned x; volatile LAS unsigned* st; };
__device__ __forceinline__ XcdBarrier xcd_barrier_post(unsigned* bar, volatile LAS unsigned* st) {
    XcdBarrier b; b.bar = bar; b.x = xb_xcc_id(); b.st = st;
    if (threadIdx.x == 0) (void)xb_add(&bar[XB_XCNT(b.x)], 1u);
    return b;
}
__device__ __forceinline__ void xcd_barrier_complete(unsigned* bar, unsigned x, unsigned& nloc, unsigned& nx) {
    const unsigned G = gridDim.x * gridDim.y * gridDim.z;
    unsigned sum, cnt, mine, sp = 0u;
    for (;;) {
        sum = 0u; cnt = 0u; mine = 0u;
#pragma unroll
        for (unsigned j = 0; j < 16; ++j) { const unsigned c = xb_ld(&bar[XB_XCNT(j)]); sum += c; cnt += (c > 0u) ? 1u : 0u; mine = (j == x) ? c : mine; }
        if (sum == G) break;
        __builtin_amdgcn_s_sleep(1);
        if ((++sp & 255u) == 0u) { if (xb_ld(&bar[XB_TMO])) break; if (sp > XB_SPIN_CAP) { atomicAdd(&bar[XB_TMO], 1u); break; } }
    }
    nloc = mine > 0u ? mine : 1u; nx = cnt > 0u ? cnt : 1u;
}
__device__ __forceinline__ void xcd_barrier(const XcdBarrier& b) {
    asm volatile("s_waitcnt vmcnt(0)" ::: "memory");
    __syncthreads();
    if (threadIdx.x == 0) {
        unsigned* bar = b.bar;
        __builtin_amdgcn_s_waitcnt(0);
        unsigned nloc = b.st[0], nx = b.st[1];
        if (nloc == 0u) { xcd_barrier_complete(bar, b.x, nloc, nx); b.st[0] = nloc; b.st[1] = nx; }
        const unsigned old = xb_add(&bar[XB_XSUB(b.x)], 1u);
        const unsigned gen = old / nloc;
        if (old + 1u == (gen + 1u) * nloc) {
            __builtin_amdgcn_fence(__ATOMIC_RELEASE, "agent");
            asm volatile("s_waitcnt vmcnt(0)" ::: "memory");
            const unsigned og = xb_add(&bar[XB_TOP], 1u);
            const unsigned tg = og / nx;
            if (og + 1u == (tg + 1u) * nx) xb_add(&bar[XB_TOPGEN], 1u);
            else XB_SPIN(xb_ld(&bar[XB_TOPGEN]) == tg, bar);
            __builtin_amdgcn_fence(__ATOMIC_ACQUIRE, "agent");
            xb_add(&bar[XB_XGEN(b.x)], 1u);
            asm volatile("s_waitcnt vmcnt(0)" ::: "memory");
        } else {
            XB_SPIN(xb_ld(&bar[XB_XGEN(b.x)]) == gen, bar);
            __builtin_amdgcn_fence(__ATOMIC_ACQUIRE, "agent");
            asm volatile("s_waitcnt vmcnt(0)" ::: "memory");
        }
    }
    __syncthreads();
}

namespace pg8 {
constexpr int BM = 256, BK = 64, HALF = 128, HTB = HALF * BK * 2, STAGE_BYTES = 8 * HTB, NXCD = 8, WGM = 8;
__host__ __device__ __forceinline__ int lds_byte(int r, int c) { const int st = (r >> 4) * 2 + (c >> 5), rr = r & 15, cc = c & 31, ob = rr * 64 + cc * 2; return st * 1024 + (ob ^ (((ob >> 9) & 1) << 5)); }
__host__ __device__ __forceinline__ void stage_rc(int b, int& R, int& C) { const int st = b / 1024, sb = b % 1024, swz = sb ^ (((sb >> 9) & 1) << 5); R = (st >> 1) * 16 + swz / 64; C = (st & 1) * 32 + (swz % 64) / 2; }
__host__ __device__ __forceinline__ int perm32(int rho) { const int n = rho >> 4, i = rho & 15; return 8 * (i >> 2) + 4 * n + (i & 3); }

struct Unit { int pm, pn, cls, row0, ncls, elo, ehi; };

struct StaticOrder {
    int nM, nN, nwg, G, c;
    __device__ void init(int M, int N, int G_, int c_) { nM = M / BM; nN = N / BM; nwg = nM * nN; G = G_; c = c_; }
    __device__ __forceinline__ bool next(int i, Unit& u) const {
        const long L = (long)i * G + c; if (L >= nwg) return false;
        int wgid = (int)L; { const int q = nwg / NXCD, r = nwg % NXCD, xcd = wgid % NXCD, off = wgid / NXCD; wgid = (xcd < r ? xcd * (q + 1) : r * (q + 1) + (xcd - r) * q) + off; }
        const int nig = WGM * nN, gid = wgid / nig, fm = gid * WGM, gsz = (nM - fm) < WGM ? (nM - fm) : WGM;
        u.pm = fm + ((wgid % nig) % gsz); u.pn = (wgid % nig) / gsz; u.cls = 0; u.row0 = 0; u.ncls = 0; u.elo = 0; u.ehi = 0; return true;
    }
};

struct ProbDense {
    const char* A; const char* B; int lda, ldb, nt; StaticOrder S;
    __device__ __forceinline__ bool next(int i, Unit& u) const { return S.next(i, u); }
    __device__ __forceinline__ void a_offs(const Unit& u, int tid, unsigned (&off)[2][2]) const {
#pragma unroll
        for (int i = 0; i < 2; ++i) { int R, C; stage_rc(tid * 16 + i * 8192, R, C);
#pragma unroll
            for (int h = 0; h < 2; ++h) off[h][i] = (unsigned)((u.pm * BM + h * HALF + R) * lda + C) * 2u; }
    }
    __device__ __forceinline__ const char* b_ptr(const Unit& u, int t) const { return B + (size_t)u.pn * BM * ldb * 2 + (size_t)t * (BK * 2); }
};
__device__ __forceinline__ void moe_unit(const LAS int* s_n, const LAS int* s_ts, int rt, Unit& u) {
    int cc = 0; while (s_ts[cc + 1] <= rt) ++cc;
    u.pm = rt; u.cls = cc; u.row0 = (rt - s_ts[cc]) * BM; u.ncls = s_n[cc];
    const int g = cc / 6, idx = cc % 6; const int a = idx < 3 ? 0 : (idx < 5 ? 1 : 2), b = idx < 3 ? idx + 1 : (idx < 5 ? idx - 1 : 3);
    u.elo = 4 * g + a; u.ehi = 4 * g + b;
}
struct ProbGU {
    const char* A; const char* B; const int* tok; const LAS int* s_n; const LAS int* s_ts; int total, G, c; static constexpr int ldb = 1024; int nt;
    __device__ __forceinline__ bool next(int i, Unit& u) const { const long L = (long)i * G + c; if (L >= total) return false; u.pn = (int)(L & 7); moe_unit(s_n, s_ts, (int)(L >> 3), u); return true; }
    __device__ __forceinline__ void a_offs(const Unit& u, int tid, unsigned (&off)[2][2]) const {
#pragma unroll
        for (int i = 0; i < 2; ++i) { int R, C; stage_rc(tid * 16 + i * 8192, R, C);
#pragma unroll
            for (int h = 0; h < 2; ++h) { int r = u.row0 + h * HALF + R; r = r < u.ncls ? r : u.ncls - 1; const int t = tok[(size_t)u.cls * CAP + r]; off[h][i] = (unsigned)t * 2048u + (unsigned)C * 2u; } }
    }
    __device__ __forceinline__ const char* b_ptr(const Unit& u, int t) const { const int e = u.pn >= 4 ? u.ehi : u.elo; return B + (size_t)e * (1024 * 1024 * 2) + (size_t)(u.pn & 3) * (BM * 1024 * 2) + (size_t)t * (BK * 2); }
};
struct ProbDown {
    const char* A; const char* B; const LAS int* s_n; const LAS int* s_ts; int total, G, c; static constexpr int ldb = 512; int nt;
    __device__ __forceinline__ bool next(int i, Unit& u) const { const long L = (long)i * G + c; if (L >= total) return false; u.pn = (int)(L & 3); moe_unit(s_n, s_ts, (int)(L >> 2), u); return true; }
    __device__ __forceinline__ void a_offs(const Unit& u, int tid, unsigned (&off)[2][2]) const {
#pragma unroll
        for (int i = 0; i < 2; ++i) { int R, C; stage_rc(tid * 16 + i * 8192, R, C);
#pragma unroll
            for (int h = 0; h < 2; ++h) off[h][i] = (unsigned)(u.pm * BM + h * HALF + R) * 2048u + (unsigned)C * 2u; }
    }
    __device__ __forceinline__ const char* b_ptr(const Unit& u, int t) const { const int e = t < 8 ? u.elo : u.ehi; return B + (size_t)e * (1024 * 512 * 2) + (size_t)u.pn * (BM * 512 * 2) + (size_t)(t & 7) * (BK * 2); }
};

template <class Epi, class Prob, bool ALIGN_EPI>
__device__ __forceinline__ void gemm_phase(LAS unsigned char* lds, LAS unsigned char* offs_lds, const Prob& P, const Epi& E) {
    int tid_ = threadIdx.x; asm volatile("" : "+v"(tid_));
    const int tid = tid_, wid = __builtin_amdgcn_readfirstlane(tid >> 6), lane = tid & 63, wr = wid >> 2, wc = wid & 3, fr = lane & 15, fq = lane >> 4;
    const int nt = P.nt;
    unsigned voffB[2];
#pragma unroll
    for (int i = 0; i < 2; ++i) { int R, C; stage_rc(tid * 16 + i * 8192, R, C); const int Rb = Epi::PERM ? ((R & ~31) + perm32(R & 31)) : R; voffB[i] = (unsigned)(Rb * P.ldb + C) * 2u; }
    LAS u32x4* const myoffs = (LAS u32x4*)offs_lds + tid;
    const size_t hstepB = (size_t)HALF * P.ldb * 2;
    const unsigned ldsw = (unsigned)wid * 1024u;
    const int aoff = lds_byte(wr * 64 + fr, fq * 8), boff = lds_byte(wc * 32 + fr, fq * 8);
    const char* const Ab = P.A;
#define PG8_SA(b, h) (((b) * 2 + (h)) * HTB)
#define PG8_SB(b, h) ((4 + (b) * 2 + (h)) * HTB)
#define PG8_STAGE_A(bufoff, h, offs, kt) do { _Pragma("unroll") for (int _i = 0; _i < 2; ++_i) \
        __builtin_amdgcn_global_load_lds((const unsigned*)(Ab + (size_t)(offs)[h][_i] + (size_t)(kt) * (BK * 2)), (LAS unsigned*)(lds + (bufoff) + ldsw + _i * 8192), 16, 0, 0); } while (0)
#define PG8_STAGE_B(bufoff, bp) do { _Pragma("unroll") for (int _i = 0; _i < 2; ++_i) \
        __builtin_amdgcn_global_load_lds((const unsigned*)((bp) + voffB[_i]), (LAS unsigned*)(lds + (bufoff) + ldsw + _i * 8192), 16, 0, 0); } while (0)
#define PG8_LDA(dst, b, h) do { _Pragma("unroll") for (int m = 0; m < 4; ++m) _Pragma("unroll") for (int k = 0; k < 2; ++k) dst[m][k] = *(const LAS bf16x8*)(lds + PG8_SA(b, h) + aoff + m * 2048 + k * 1024); } while (0)
#define PG8_LDB(dst, b, h) do { _Pragma("unroll") for (int n = 0; n < 2; ++n) _Pragma("unroll") for (int k = 0; k < 2; ++k) dst[n][k] = *(const LAS bf16x8*)(lds + PG8_SB(b, h) + boff + n * 2048 + k * 1024); } while (0)
#define PG8_MMA(ai, bj, At, Bt) do { __builtin_amdgcn_s_setprio(1); _Pragma("unroll") for (int m = 0; m < 4; ++m) _Pragma("unroll") for (int n = 0; n < 2; ++n) _Pragma("unroll") for (int k = 0; k < 2; ++k) \
        acc[ai][bj][m][n] = __builtin_amdgcn_mfma_f32_16x16x32_bf16(Bt[n][k], At[m][k], acc[ai][bj][m][n], 0, 0, 0); __builtin_amdgcn_s_setprio(0); } while (0)
#define PG8_WAIT_V(n) asm volatile("s_waitcnt vmcnt(" #n ")" ::: "memory")
#define PG8_WAIT_L(n) asm volatile("s_waitcnt lgkmcnt(" #n ")" ::: "memory")
#define PG8_BAR __builtin_amdgcn_s_barrier()
#define PG8_SCHED __builtin_amdgcn_sched_barrier(0)
    Unit cur, nxt; int ui = 0;
    if (!P.next(0, cur)) return;
    f32x4 acc[2][2][4][2];
#pragma unroll
    for (int a = 0; a < 2; ++a)
#pragma unroll
        for (int b = 0; b < 2; ++b)
#pragma unroll
            for (int m = 0; m < 4; ++m)
#pragma unroll
                for (int n = 0; n < 2; ++n) acc[a][b][m][n] = (f32x4){0.f, 0.f, 0.f, 0.f};
    bf16x8 At[4][2], B0[2][2], B1[2][2];
    unsigned offC[2][2];
    P.a_offs(cur, tid, offC);
    {
        const char* b0 = P.b_ptr(cur, 0); const char* b1 = P.b_ptr(cur, 1);
        PG8_STAGE_B(PG8_SB(0, 0), b0); PG8_STAGE_B(PG8_SB(0, 1), b0 + hstepB); PG8_STAGE_A(PG8_SA(0, 0), 0, offC, 0); PG8_STAGE_A(PG8_SA(0, 1), 1, offC, 0);
        if (wr == 1) PG8_BAR;
        PG8_WAIT_V(2); PG8_BAR;
        PG8_STAGE_B(PG8_SB(1, 0), b1); PG8_STAGE_A(PG8_SA(1, 0), 0, offC, 1); PG8_STAGE_B(PG8_SB(1, 1), b1 + hstepB);
        PG8_WAIT_V(6); PG8_BAR;
    }
    for (;;) {
        const bool has_next = P.next(ui + 1, nxt);
        if (!has_next) nxt = cur;
        {
            unsigned offN[2][2];
            if (has_next) P.a_offs(nxt, tid, offN);
            else {
#pragma unroll
                for (int h = 0; h < 2; ++h)
#pragma unroll
                    for (int i = 0; i < 2; ++i) offN[h][i] = offC[h][i];
            }
            *myoffs = (u32x4){offN[0][0], offN[0][1], offN[1][0], offN[1][1]};
        }
        for (int t = 0; t < nt; t += 2) {
            const bool last = (t == nt - 2);
            const int k2 = last ? 0 : t + 2;
            const char* b2 = last ? P.b_ptr(nxt, 0) : P.b_ptr(cur, t + 2);
            const char* b3 = last ? P.b_ptr(nxt, 1) : P.b_ptr(cur, t + 3);
            PG8_LDB(B0, 0, 0); PG8_LDB(B1, 0, 1); PG8_SCHED; PG8_LDA(At, 0, 0); PG8_STAGE_A(PG8_SA(1, 1), 1, offC, t + 1);
            if (last) { const u32x4 v = *myoffs; offC[0][0] = v.x; offC[0][1] = v.y; offC[1][0] = v.z; offC[1][1] = v.w; }
            PG8_WAIT_V(8); PG8_WAIT_L(0); PG8_BAR; PG8_MMA(0, 0, At, B0); PG8_MMA(0, 1, At, B1); PG8_BAR; PG8_SCHED;
            PG8_LDA(At, 0, 1); PG8_STAGE_B(PG8_SB(0, 0), b2); PG8_STAGE_B(PG8_SB(0, 1), b2 + hstepB); PG8_STAGE_A(PG8_SA(0, 0), 0, offC, k2);
            PG8_WAIT_V(8); PG8_WAIT_L(0); PG8_BAR; PG8_MMA(1, 0, At, B0); PG8_MMA(1, 1, At, B1); PG8_BAR; PG8_SCHED;
            PG8_LDB(B0, 1, 0); PG8_LDB(B1, 1, 1); PG8_SCHED; PG8_LDA(At, 1, 0); PG8_STAGE_A(PG8_SA(0, 1), 1, offC, k2);
            PG8_WAIT_V(8); PG8_WAIT_L(0); PG8_BAR; PG8_MMA(0, 0, At, B0); PG8_MMA(0, 1, At, B1); PG8_BAR; PG8_SCHED;
            PG8_LDA(At, 1, 1); PG8_STAGE_B(PG8_SB(1, 0), b3); PG8_STAGE_B(PG8_SB(1, 1), b3 + hstepB); PG8_STAGE_A(PG8_SA(1, 0), 0, offC, k2 + 1);
            PG8_WAIT_V(8); PG8_WAIT_L(0); PG8_BAR; PG8_MMA(1, 0, At, B0); PG8_MMA(1, 1, At, B1); PG8_BAR; PG8_SCHED;
        }
        if constexpr (ALIGN_EPI) { if (wr == 0) PG8_BAR; }
        E(acc, cur, wr, wc, fr, fq);
        if (!has_next) break;
#pragma unroll
        for (int a = 0; a < 2; ++a)
#pragma unroll
            for (int b = 0; b < 2; ++b)
#pragma unroll
                for (int m = 0; m < 4; ++m)
#pragma unroll
                    for (int n = 0; n < 2; ++n) acc[a][b][m][n] = (f32x4){0.f, 0.f, 0.f, 0.f};
        cur = nxt; ++ui;
        if constexpr (ALIGN_EPI) { if (wr == 1) PG8_BAR; }
    }
    PG8_WAIT_V(0);
    if constexpr (!ALIGN_EPI) { if (wr == 0) PG8_BAR; }
    PG8_BAR;
#undef PG8_SA
#undef PG8_SB
#undef PG8_STAGE_A
#undef PG8_STAGE_B
#undef PG8_LDA
#undef PG8_LDB
#undef PG8_MMA
#undef PG8_WAIT_V
#undef PG8_WAIT_L
#undef PG8_BAR
#undef PG8_SCHED
}
}

namespace pg8 {
struct EpiQKV {
    static constexpr bool PERM = true;
    unsigned char* ws; const float* gn; const float* rope;
    __device__ __forceinline__ void operator()(const f32x4 (&acc)[2][2][4][2], const Unit& u, int wr, int wc, int fr, int fq) const {
        const int pn = u.pn, tb = u.pm % 65;
        const bool is_ctx = (tb == 0);
        const bool isV = (pn >= 4) && (wc >= 2);
        const float* gain = gn + (pn < 2 ? 0 : (pn < 4 ? 64 : (pn == 4 ? 128 : 192)));
        const float osc = pn < 4 ? C2 : 1.0f;
        bf16_t* dst = (bf16_t*)(ws + (pn < 4 ? WS_QO : WS_KV));
        const int ldd = pn < 4 ? 1024 : 512, colbase = 256 * (pn < 4 ? pn : pn - 4) + 64 * wc;
        f32x4 gv[2][2];
#pragma unroll
        for (int bj = 0; bj < 2; ++bj)
#pragma unroll
            for (int n = 0; n < 2; ++n) gv[bj][n] = *(const f32x4*)(gain + 32 * bj + 16 * n + 4 * fq);
        asm volatile("" : "+v"(gv[0][0]), "+v"(gv[0][1]), "+v"(gv[1][0]), "+v"(gv[1][1]));
#pragma unroll
        for (int ai = 0; ai < 2; ++ai)
#pragma unroll
            for (int m = 0; m < 4; ++m) {
                const int row = u.pm * BM + ai * HALF + wr * 64 + m * 16 + fr;
                f32x4 v[2][2];
#pragma unroll
                for (int bj = 0; bj < 2; ++bj)
#pragma unroll
                    for (int n = 0; n < 2; ++n) v[bj][n] = acc[ai][bj][m][n];
                if (!isV) {
                    float ss = 0.f;
#pragma unroll
                    for (int bj = 0; bj < 2; ++bj)
#pragma unroll
                        for (int n = 0; n < 2; ++n) { const f32x4 x = v[bj][n]; ss += (x[0] * x[0] + x[1] * x[1]) + (x[2] * x[2] + x[3] * x[3]); }
                    ss += __shfl_xor(ss, 16); ss += __shfl_xor(ss, 32);
                    const float rs = osc / sqrtf(ss * (1.0f / 64.0f) + NORM_EPS);
#pragma unroll
                    for (int bj = 0; bj < 2; ++bj)
#pragma unroll
                        for (int n = 0; n < 2; ++n) v[bj][n] = v[bj][n] * rs * gv[bj][n];
                    if (!is_ctx) {
                        const int pr = (tb - 1) * 4 + 2 * ai + wr, pc = 16 * m + fr;
#pragma unroll
                        for (int bj = 0; bj < 2; ++bj) {
                            const int pos = bj ? pc : pr;
                            const f32x4* rp = (const f32x4*)(rope + (size_t)(pos * 16 + 4 * fq) * 2);
                            const f32x4 r0 = rp[0], r1 = rp[1];
                            const f32x4 cs = (f32x4){r0[0], r0[2], r1[0], r1[2]}, sn = (f32x4){r0[1], r0[3], r1[1], r1[3]};
                            const f32x4 x1 = v[bj][0], x2 = v[bj][1];
                            v[bj][0] = x1 * cs - x2 * sn; v[bj][1] = x2 * cs + x1 * sn;
                        }
                    }
                }
                bf16_t* rowp = dst + (size_t)row * ldd + colbase + 4 * fq;
#pragma unroll
                for (int bj = 0; bj < 2; ++bj)
#pragma unroll
                    for (int n = 0; n < 2; ++n) { u32x2 w; w.x = cvt_pk_bf16(v[bj][n][0], v[bj][n][1]); w.y = cvt_pk_bf16(v[bj][n][2], v[bj][n][3]); *(u32x2*)(rowp + 32 * bj + 16 * n) = w; }
            }
    }
};
struct EpiResid {
    static constexpr bool PERM = false;
    float* XS; const float* modv_l; int goff;
    __device__ __forceinline__ void operator()(const f32x4 (&acc)[2][2][4][2], const Unit& u, int wr, int wc, int fr, int fq) const {
        const int mv = (u.pm % 65 == 0) ? 2 : (u.pm / 65);
        const float* g = modv_l + mv * 6144 + goff;
        const int col0 = u.pn * BM + wc * 32 + 4 * fq;
        f32x4 gv[2][2];
#pragma unroll
        for (int bj = 0; bj < 2; ++bj)
#pragma unroll
            for (int n = 0; n < 2; ++n) gv[bj][n] = *(const f32x4*)(g + col0 + bj * HALF + n * 16);
#pragma unroll
        for (int ai = 0; ai < 2; ++ai)
#pragma unroll
            for (int m = 0; m < 4; ++m) {
                float* rowp = XS + (size_t)(u.pm * BM + ai * HALF + wr * 64 + m * 16 + fr) * 1024 + col0;
#pragma unroll
                for (int bj = 0; bj < 2; ++bj)
#pragma unroll
                    for (int n = 0; n < 2; ++n) { f32x4* p = (f32x4*)(rowp + bj * HALF + n * 16); f32x4 x = *p; x = x + gv[bj][n] * acc[ai][bj][m][n]; *p = x; }
            }
    }
};
struct EpiGU {
    static constexpr bool PERM = true;
    bf16_t* ACT; const f32x2* wts;
    __device__ __forceinline__ void operator()(const f32x4 (&acc)[2][2][4][2], const Unit& u, int wr, int wc, int fr, int fq) const {
        const int k = u.pn >= 4 ? 1 : 0, jt = u.pn & 3;
        const int colbase = 512 * k + 128 * jt + 32 * wc + 8 * fq;
#pragma unroll
        for (int ai = 0; ai < 2; ++ai)
#pragma unroll
            for (int m = 0; m < 4; ++m) {
                const int r = ai * HALF + wr * 64 + m * 16 + fr;
                int idx = u.row0 + r; idx = idx < u.ncls ? idx : u.ncls - 1;
                const f32x2 w2 = wts[(size_t)u.cls * CAP + idx];
                const float w = k ? w2[1] : w2[0];
                u32x4 o;
#pragma unroll
                for (int n = 0; n < 2; ++n) {
                    const f32x4 g = acc[ai][0][m][n], up = acc[ai][1][m][n]; float a[4];
#pragma unroll
                    for (int j = 0; j < 4; ++j) { const float sg = g[j] * __builtin_amdgcn_rcpf(1.0f + __builtin_amdgcn_exp2f(-g[j] * LOG2E)); a[j] = w * sg * up[j]; }
                    const unsigned lo = cvt_pk_bf16(a[0], a[1]), hi = cvt_pk_bf16(a[2], a[3]);
                    if (n == 0) { o.x = lo; o.y = hi; } else { o.z = lo; o.w = hi; }
                }
                *(u32x4*)(ACT + (size_t)(u.pm * BM + r) * 1024 + colbase) = o;
            }
    }
};
struct EpiDown {
    static constexpr bool PERM = false;
    float* XS; float* out; const int* tok; const float* modv_l;
    __device__ __forceinline__ void operator()(const f32x4 (&acc)[2][2][4][2], const Unit& u, int wr, int wc, int fr, int fq) const {
        const int col0 = u.pn * BM + wc * 32 + 4 * fq;
#pragma unroll
        for (int ai = 0; ai < 2; ++ai)
#pragma unroll
            for (int m = 0; m < 4; ++m) {
                const int idx = u.row0 + ai * HALF + wr * 64 + m * 16 + fr;
                if (idx < u.ncls) {
                    const int t = tok[(size_t)u.cls * CAP + idx];
                    const int b = t >= RB ? 1 : 0, rr = t - b * RB;
                    const int mv = rr < NCTX ? 2 : b;
                    const float* g = modv_l + mv * 6144 + 5120 + col0;
                    const float* src = XS + (size_t)t * 1024 + col0;
                    float* dstp = out ? out + (size_t)(b * SEQ + rr - NCTX) * 1024 + col0 : XS + (size_t)t * 1024 + col0;
#pragma unroll
                    for (int bj = 0; bj < 2; ++bj)
#pragma unroll
                        for (int n = 0; n < 2; ++n) { const int c = bj * HALF + n * 16; f32x4 x = *(const f32x4*)(src + c); const f32x4 gv = *(const f32x4*)(g + c); x = x + gv * acc[ai][bj][m][n]; *(f32x4*)(dstp + c) = x; }
                }
            }
    }
};
}

namespace attn_body {
using bf16 = __hip_bfloat16;
using s16x4 = __attribute__((ext_vector_type(4))) short;
using f32x16 = __attribute__((ext_vector_type(16))) float;
constexpr int D = 64, QP = 1024, KP = 512;
constexpr int NW = 8, QBLK = 32, QB = QBLK * NW, KVBLK = 64;
__device__ __forceinline__ int crow(int r, int hi) { return (r & 3) + 8 * (r >> 2) + 4 * hi; }
#define SBAR() __builtin_amdgcn_sched_barrier(0)
constexpr int NSLOT = 3, SLOTB = 8192;
constexpr int LDS_K = 0, LDS_V = NSLOT * SLOTB, LDS_WS = 2 * NSLOT * SLOTB, LDS_OST = LDS_WS + NW * 64 * 4, LDS_BYTES = LDS_OST + NW * 4096;
__device__ __forceinline__ void glds16(const void* gsrc, unsigned lds_dst) { unsigned keep;
  asm volatile("s_mov_b32 %0, m0\n\ts_mov_b32 m0, %2\n\ts_nop 0\n\tglobal_load_lds_dwordx4 %1, off\n\ts_mov_b32 m0, %0" : "=&s"(keep) : "v"(gsrc), "s"(lds_dst) : "memory"); }
__device__ __forceinline__ float max3f(float a, float b, float c) { float r; asm("v_max3_f32 %0, %1, %2, %3" : "=v"(r) : "v"(a), "v"(b), "v"(c)); return r; }
__device__ __forceinline__ float max2f(float a, float b) { float r; asm("v_max_f32_e32 %0, %1, %2" : "=v"(r) : "v"(a), "v"(b)); return r; }
__device__ __forceinline__ float fadd_s(float a, float b) { float r; asm("v_add_f32_e32 %0, %1, %2" : "=v"(r) : "v"(a), "v"(b)); return r; }
__device__ __forceinline__ float fsub_s(float a, float b) { float r; asm("v_sub_f32_e32 %0, %1, %2" : "=v"(r) : "v"(a), "v"(b)); return r; }
typedef float f32x2_t __attribute__((ext_vector_type(2))); typedef __bf16 bf16x2_t __attribute__((ext_vector_type(2)));
__device__ __forceinline__ unsigned cvtpk_s(float lo, float hi) { f32x2_t v = {lo, hi}; bf16x2_t b = __builtin_convertvector(v, bf16x2_t); return __builtin_bit_cast(unsigned, b); }
#define WAIT_BAR(N) asm volatile("s_waitcnt vmcnt(" #N ") lgkmcnt(0)\n\ts_barrier" ::: "memory")

__device__ __forceinline__ void qkt(f32x16& p0, f32x16& p1, const char* Kslot, const bf16x8* qr, const f32x16& negm, int r32, int hi) {
  const char* kb = Kslot + hi * 1024 + r32 * 16;
  #pragma unroll
  for (int d0 = 0; d0 < 4; ++d0) {
    const bf16x8 b0 = *reinterpret_cast<const bf16x8*>(kb + d0 * 2048);
    const bf16x8 b1 = *reinterpret_cast<const bf16x8*>(kb + d0 * 2048 + 512);
    if (d0 == 0) { p0 = __builtin_amdgcn_mfma_f32_32x32x16_bf16(b0, qr[0], negm, 0, 0, 0); p1 = __builtin_amdgcn_mfma_f32_32x32x16_bf16(b1, qr[0], negm, 0, 0, 0); }
    else { p0 = __builtin_amdgcn_mfma_f32_32x32x16_bf16(b0, qr[d0], p0, 0, 0, 0); p1 = __builtin_amdgcn_mfma_f32_32x32x16_bf16(b1, qr[d0], p1, 0, 0, 0); } }
}
typedef __attribute__((address_space(3))) const char* lds_cptr;
typedef short v4i16_t __attribute__((ext_vector_type(4)));
__device__ __forceinline__ void kload8(bf16x8* kf, lds_cptr kp) {
  kf[0] = *(const LAS bf16x8*)(kp);        kf[1] = *(const LAS bf16x8*)(kp + 512);
  kf[2] = *(const LAS bf16x8*)(kp + 2048); kf[3] = *(const LAS bf16x8*)(kp + 2560);
  kf[4] = *(const LAS bf16x8*)(kp + 4096); kf[5] = *(const LAS bf16x8*)(kp + 4608);
  kf[6] = *(const LAS bf16x8*)(kp + 6144); kf[7] = *(const LAS bf16x8*)(kp + 6656);
}
__device__ __forceinline__ void kload2(bf16x8* kf, lds_cptr kp, int j) { kf[2 * j] = *(const LAS bf16x8*)(kp + j * 2048); kf[2 * j + 1] = *(const LAS bf16x8*)(kp + j * 2048 + 512); }
__device__ __forceinline__ s16x4 vtr(lds_cptr p) { return __builtin_bit_cast(s16x4, __builtin_amdgcn_ds_read_tr16_b64_v4i16((LAS v4i16_t*)p)); }
__device__ __forceinline__ float rowmax(const f32x16& p0, const f32x16& p1) {
  float a = max3f(p0[0], p0[1], p1[0]), b = max3f(p0[2], p0[3], p1[1]); a = max3f(a, p1[2], p1[3]);
  #pragma unroll
  for (int r = 4; r < 16; r += 4) { a = max3f(a, p0[r], p0[r + 1]); b = max3f(b, p0[r + 2], p0[r + 3]); a = max3f(a, p1[r], p1[r + 1]); b = max3f(b, p1[r + 2], p1[r + 3]); }
  const float m = max2f(a, b);
  auto rr = __builtin_amdgcn_permlane32_swap(__float_as_uint(m), __float_as_uint(m), false, false);
  return max2f(__uint_as_float(rr[0]), __uint_as_float(rr[1]));
}
__device__ __forceinline__ void pv(f32x16* o, int vb, bf16x8 pa0, bf16x8 pa1, bf16x8 pa2, bf16x8 pa3) {
  #pragma unroll
  for (int d0 = 0; d0 < 2; ++d0) { s16x4 lo[4], hi[4];
    #pragma unroll
    for (int ks = 0; ks < 4; ++ks) {
      asm volatile("ds_read_b64_tr_b16 %0,%1 offset:%c2" : "=&v"(lo[ks]) : "v"(vb), "i"(d0 * 4096 + ks * 1024) : "memory");
      asm volatile("ds_read_b64_tr_b16 %0,%1 offset:%c2" : "=&v"(hi[ks]) : "v"(vb), "i"(d0 * 4096 + ks * 1024 + 512) : "memory"); }
    asm volatile("s_waitcnt lgkmcnt(0)" ::: "memory"); SBAR();
    #define PK(k) (bf16x8){lo[k][0], lo[k][1], lo[k][2], lo[k][3], hi[k][0], hi[k][1], hi[k][2], hi[k][3]}
    o[d0] = __builtin_amdgcn_mfma_f32_32x32x16_bf16(pa0, PK(0), o[d0], 0, 0, 0);
    o[d0] = __builtin_amdgcn_mfma_f32_32x32x16_bf16(pa1, PK(1), o[d0], 0, 0, 0);
    o[d0] = __builtin_amdgcn_mfma_f32_32x32x16_bf16(pa2, PK(2), o[d0], 0, 0, 0);
    o[d0] = __builtin_amdgcn_mfma_f32_32x32x16_bf16(pa3, PK(3), o[d0], 0, 0, 0);
    #undef PK
  }
}
__device__ __forceinline__ void bandmask(f32x16& p0, f32x16& p1, int t, int mlo, unsigned mspan, int qrel, int hi) {
  const float NEG = -INFINITY; const int kb = 64 * (t - 4) - 128 + 4 * hi - qrel - mlo;
  #pragma unroll
  for (int r = 0; r < 16; ++r) { const int d0 = kb + (r & 3) + 8 * (r >> 2); if ((unsigned)d0 > mspan) p0[r] = NEG; if ((unsigned)(d0 + 32) > mspan) p1[r] = NEG; }
}
#define ATTN_STORE16(p, v) (*(u32x4*)(p) = (v))

template <int MODE, int THRL> __device__ __forceinline__ void attn_unit(long qrow, long kvrow, int q0, int qcol, int kcol, int vcol, int NT, float sink2, const bf16* Q, const bf16* __restrict__ KVb, bf16* O, char* shm) {
  int tid_ = threadIdx.x; asm volatile("" : "+v"(tid_));
  const int tid = tid_, lane = tid & 63, r32 = lane & 31, hi = lane >> 5; const int wid = __builtin_amdgcn_readfirstlane(tid >> 6);
  const bf16* Qw = Q + (qrow + wid * QBLK) * QP + qcol;
  const bf16* Kh = KVb + kvrow * KP + kcol, *Vh = KVb + kvrow * KP + vcol;
  const unsigned lds0 = (unsigned)(uintptr_t)shm;
  float* wsf = (float*)(shm + LDS_WS) + wid * 64;
  const bf16* ksrc = Kh + (long)lane * KP + wid * 8;
  const bf16* vsrc = Vh + (long)(16 * (wid & 3) + (lane >> 2)) * KP + (wid >> 2) * 32 + (lane & 3) * 8;
  const unsigned kdst = lds0 + LDS_K + wid * 1024, vdst = lds0 + LDS_V + wid * 1024;
  #define ROWOFF(t) ((long)(MODE == 1 ? (64 * (t) + ((t) >= 4 ? (q0 - 128) : 0)) : 64 * (t)))
  #define DMA_K(t, slot) glds16(ksrc + ROWOFF(t) * KP, (unsigned)__builtin_amdgcn_readfirstlane(kdst + (slot)))
  #define DMA_V(t, slot) glds16(vsrc + ROWOFF(t) * KP, (unsigned)__builtin_amdgcn_readfirstlane(vdst + (slot)))
  const int vb0 = (int)(lds0 + LDS_V) + ((lane >> 4) & 1) * 32 + (lane & 3) * 8 + (4 * hi + ((lane & 15) >> 2)) * 64;
  const char* Kbase = shm + LDS_K; bf16x8 kf[8];
  const lds_cptr shm3 = (lds_cptr)shm; const lds_cptr kp0 = shm3 + LDS_K + hi * 1024 + r32 * 16; const lds_cptr vp0 = shm3 + LDS_V + ((lane >> 4) & 1) * 32 + (lane & 3) * 8 + (4 * hi + ((lane & 15) >> 2)) * 64;
  DMA_K(0, 0); DMA_V(0, 0); DMA_K(1, SLOTB);
  bf16x8 qr[4];
  #pragma unroll
  for (int d0 = 0; d0 < 4; ++d0) qr[d0] = *reinterpret_cast<const bf16x8*>(&Qw[(long)r32 * QP + d0 * 16 + hi * 8]);
  float mhat = 0.f, l_reg = 0.f; f32x16 o[2]; o[0] = f32x16{}; o[1] = f32x16{}; f32x16 negm = f32x16{}; asm volatile("" : "+v"(negm));
  const int qrel = wid * QBLK + r32;
  int mlo = -128, mhi = 128;
  if (MODE == 1) { const int qi = q0 + qrel; mlo = (-qi > -128) ? -qi : -128; mhi = (SEQ - 1 - qi < 128) ? (SEQ - 1 - qi) : 128; }
  const unsigned mspan = (unsigned)(mhi - mlo);
  #define CMASK(P0, P1, t) do { if (MODE == 1) { if ((t) >= 4) bandmask(P0, P1, (t), mlo, mspan, qrel, hi); } } while (0)
  bool resc = false;
  #define START(P0, P1) do { const float rm = rowmax(P0, P1); resc = false; \
    { const float dl = rm; mhat = fadd_s(mhat, dl); \
      _Pragma("unroll") for (int r = 0; r < 16; ++r) { P0[r] = fsub_s(P0[r], dl); P1[r] = fsub_s(P1[r], dl); } \
      _Pragma("unroll") for (int r = 0; r < 16; ++r) negm[r] = -mhat; asm volatile("" : "+v"(negm)); } \
    _Pragma("unroll") for (int r = 0; r < 16; ++r) P0[r] = __builtin_amdgcn_exp2f(P0[r]); } while (0)
  #define RESC() do { if (resc) { asm volatile("s_waitcnt lgkmcnt(0)" ::: "memory"); \
      _Pragma("unroll") for (int d_ = 0; d_ < 2; ++d_) _Pragma("unroll") for (int r = 0; r < 16; ++r) o[d_][r] *= wsf[crow(r, hi)]; } } while (0)
  f32x16 pA0, pA1, pB0, pB1;
  int sl_prev = 0, sl_cur = 0, sl_next = SLOTB;
  #define ROT() do { sl_prev = sl_cur; sl_cur = sl_next; sl_next = (sl_next == (NSLOT - 1) * SLOTB) ? 0 : sl_next + SLOTB; } while (0)
  DMA_K(2, 2 * SLOTB);
  WAIT_BAR(3);
  qkt(pA0, pA1, Kbase, qr, negm, r32, hi); asm volatile("s_nop 15\n\ts_nop 7" : "+v"(pA0), "+v"(pA1)); CMASK(pA0, pA1, 0);
  START(pA0, pA1);
  _Pragma("unroll") for (int r = 0; r < 16; ++r) pA1[r] = __builtin_amdgcn_exp2f(pA1[r]);
  WAIT_BAR(0);
  DMA_K(3, 0); DMA_V(1, SLOTB);
  ROT();
  kload8(kf, kp0 + sl_cur);
  WAIT_BAR(2);
  s16x4 vlo[8], vhi[8]; u32x4 pw0, pw1, pw2, pw3;
  #define PKW(P, B) cvtpk_s(P[B], P[B + 1])
  #define PAF(k) __builtin_bit_cast(bf16x8, pw##k)
  #define VFR(i) (bf16x8){vlo[i][0], vlo[i][1], vlo[i][2], vlo[i][3], vhi[i][0], vhi[i][1], vhi[i][2], vhi[i][3]}
  #define PIN(x) asm volatile("" : "+v"(x))
  #define MX3(a, b, c) __builtin_fmaxf(__builtin_fmaxf((a), (b)), (c))
  #define GAPA(MF, A0, A1, A2, A3, W0, W1, PW) do { MF; sacc += A0; sacc += A1; sacc += A2; sacc += A3; PIN(sacc); W0; W1; PIN(PW); SBAR(); } while (0)
  #define EX(v) __builtin_amdgcn_exp2f(v)
  #define GAPB(MF, X, B) do { MF; X[B] = EX(X[B]); X[B + 1] = EX(X[B + 1]); X[B + 2] = EX(X[B + 2]); X[B + 3] = EX(X[B + 3]); PIN(X); SBAR(); } while (0)
  #define VRD(i) do { vlo[i] = vtr(vp_ + (((i) >> 2) * 4096 + ((i) & 3) * 1024)); vhi[i] = vtr(vp_ + (((i) >> 2) * 4096 + ((i) & 3) * 1024 + 512)); } while (0)
  #define KRD(G, j) do { if (G) { kload2(kf, kp0 + sl_next, j); SBAR(); } } while (0)
  #define STEP(C0, C1, P0, P1, t, GK, GV, GL) do { SBAR(); \
    const lds_cptr vp_ = vp0 + sl_prev; \
    VRD(0); SBAR(); float sacc = (P0[0] + P0[1]); \
    GAPA(C0 = __builtin_amdgcn_mfma_f32_32x32x16_bf16(kf[0], qr[0], negm, 0, 0, 0), P0[2], P0[3], P0[4], P0[5],     pw0[0] = PKW(P0, 0), pw0[1] = PKW(P0, 2), pw0); \
    VRD(4); SBAR(); GAPA(C1 = __builtin_amdgcn_mfma_f32_32x32x16_bf16(kf[1], qr[0], negm, 0, 0, 0), P0[6], P0[7], P0[8], P0[9],     pw0[2] = PKW(P0, 4), pw0[3] = PKW(P0, 6), pw0); \
    VRD(1); SBAR(); GAPA(C0 = __builtin_amdgcn_mfma_f32_32x32x16_bf16(kf[2], qr[1], C0, 0, 0, 0),   P0[10], P0[11], P0[12], P0[13], pw1[0] = PKW(P0, 8), pw1[1] = PKW(P0, 10), pw1); \
    VRD(5); SBAR(); GAPA(C1 = __builtin_amdgcn_mfma_f32_32x32x16_bf16(kf[3], qr[1], C1, 0, 0, 0),   P0[14], P0[15], P1[0], P1[1],   pw1[2] = PKW(P0, 12), pw1[3] = PKW(P0, 14), pw1); \
    VRD(2); SBAR(); GAPA(C0 = __builtin_amdgcn_mfma_f32_32x32x16_bf16(kf[4], qr[2], C0, 0, 0, 0),   P1[2], P1[3], P1[4], P1[5],     pw2[0] = PKW(P1, 0), pw2[1] = PKW(P1, 2), pw2); \
    VRD(6); SBAR(); GAPA(C1 = __builtin_amdgcn_mfma_f32_32x32x16_bf16(kf[5], qr[2], C1, 0, 0, 0),   P1[6], P1[7], P1[8], P1[9],     pw2[2] = PKW(P1, 4), pw2[3] = PKW(P1, 6), pw2); \
    VRD(3); SBAR(); GAPA(C0 = __builtin_amdgcn_mfma_f32_32x32x16_bf16(kf[6], qr[3], C0, 0, 0, 0),   P1[10], P1[11], P1[12], P1[13], pw3[0] = PKW(P1, 8), pw3[1] = PKW(P1, 10), pw3); \
    VRD(7); SBAR(); GAPA(C1 = __builtin_amdgcn_mfma_f32_32x32x16_bf16(kf[7], qr[3], C1, 0, 0, 0),   P1[14], P1[15], 0.f, 0.f,       pw3[2] = PKW(P1, 12), pw3[3] = PKW(P1, 14), pw3); \
    l_reg += sacc; \
    if (GK) { DMA_K((t) + 3, sl_cur); } if (GV) { DMA_V((t) + 1, sl_next); } \
    CMASK(C0, C1, t); \
    { float a = MX3(C0[0], C0[1], C1[0]), b = MX3(C0[2], C0[3], C1[1]); a = MX3(a, C1[2], C1[3]); \
      _Pragma("unroll") for (int r = 4; r < 16; r += 4) { a = MX3(a, C0[r], C0[r + 1]); b = MX3(b, C0[r + 2], C0[r + 3]); a = MX3(a, C1[r], C1[r + 1]); b = MX3(b, C1[r + 2], C1[r + 3]); } \
      float rm = __builtin_fmaxf(a, b); { auto rr = __builtin_amdgcn_permlane32_swap(__float_as_uint(rm), __float_as_uint(rm), false, false); rm = __builtin_fmaxf(__uint_as_float(rr[0]), __uint_as_float(rr[1])); } \
      resc = false; \
      if (__builtin_expect(__any(rm > (float)THRL), 0)) { const float dl = __builtin_fmaxf(rm, 0.f); mhat += dl; \
        _Pragma("unroll") for (int r = 0; r < 16; ++r) { C0[r] -= dl; C1[r] -= dl; } \
        _Pragma("unroll") for (int r = 0; r < 16; ++r) negm[r] = -mhat; asm volatile("" : "+v"(negm)); \
        const float f = __builtin_amdgcn_exp2f(-dl); l_reg *= f; if (hi == 0) wsf[r32] = f; resc = true; } } \
    SBAR(); \
    GAPB(o[0] = __builtin_amdgcn_mfma_f32_32x32x16_bf16(PAF(0), VFR(0), o[0], 0, 0, 0), C0, 0); \
    GAPB(o[1] = __builtin_amdgcn_mfma_f32_32x32x16_bf16(PAF(0), VFR(4), o[1], 0, 0, 0), C0, 4); \
    KRD(GL, 0); GAPB(o[0] = __builtin_amdgcn_mfma_f32_32x32x16_bf16(PAF(1), VFR(1), o[0], 0, 0, 0), C0, 8); \
    KRD(GL, 1); GAPB(o[1] = __builtin_amdgcn_mfma_f32_32x32x16_bf16(PAF(1), VFR(5), o[1], 0, 0, 0), C0, 12); \
    KRD(GL, 2); GAPB(o[0] = __builtin_amdgcn_mfma_f32_32x32x16_bf16(PAF(2), VFR(2), o[0], 0, 0, 0), C1, 0); \
    KRD(GL, 3); GAPB(o[1] = __builtin_amdgcn_mfma_f32_32x32x16_bf16(PAF(2), VFR(6), o[1], 0, 0, 0), C1, 4); \
    GAPB(o[0] = __builtin_amdgcn_mfma_f32_32x32x16_bf16(PAF(3), VFR(3), o[0], 0, 0, 0), C1, 8); \
    GAPB(o[1] = __builtin_amdgcn_mfma_f32_32x32x16_bf16(PAF(3), VFR(7), o[1], 0, 0, 0), C1, 12); \
    } while (0)
  int t = 1;
  for (; t + 5 < NT; t += 2) {
    STEP(pB0, pB1, pA0, pA1, t, true, true, true);     WAIT_BAR(2); RESC(); ROT();
    STEP(pA0, pA1, pB0, pB1, t + 1, true, true, true);   WAIT_BAR(2); RESC(); ROT();
  }
  #define ENDW(tt) do { if ((tt) + 3 < NT) { WAIT_BAR(2); } else if ((tt) + 2 < NT) { WAIT_BAR(1); } else { WAIT_BAR(0); } } while (0)
  for (; t + 1 < NT; t += 2) {
    STEP(pB0, pB1, pA0, pA1, t, (t + 3 < NT), (t + 1 < NT), (t + 1 < NT));       ENDW(t);   RESC(); ROT();
    STEP(pA0, pA1, pB0, pB1, t + 1, (t + 4 < NT), (t + 2 < NT), (t + 2 < NT));     ENDW(t + 1); RESC(); ROT();
  }
  STEP(pB0, pB1, pA0, pA1, NT - 1, false, false, false); RESC();
  { float sacc = pB0[0] + pB0[1]; _Pragma("unroll") for (int r = 2; r < 16; ++r) sacc += pB0[r]; _Pragma("unroll") for (int r = 0; r < 16; ++r) sacc += pB1[r]; l_reg += sacc;
    pw0 = (u32x4){PKW(pB0, 0), PKW(pB0, 2), PKW(pB0, 4), PKW(pB0, 6)}; pw1 = (u32x4){PKW(pB0, 8), PKW(pB0, 10), PKW(pB0, 12), PKW(pB0, 14)}; pw2 = (u32x4){PKW(pB1, 0), PKW(pB1, 2), PKW(pB1, 4), PKW(pB1, 6)}; pw3 = (u32x4){PKW(pB1, 8), PKW(pB1, 10), PKW(pB1, 12), PKW(pB1, 14)};
    SBAR(); pv(o, vb0 + sl_cur, PAF(0), PAF(1), PAF(2), PAF(3)); }
  #undef PKW
  #undef PAF
  #undef VFR
  #undef PIN
  #undef MX3
  #undef GAPA
  #undef GAPB
  #undef EX
  #undef VRD
  #undef KRD
  #undef STEP
  #undef ENDW
  { auto rr = __builtin_amdgcn_permlane32_swap(__float_as_uint(l_reg), __float_as_uint(l_reg), false, false); l_reg = __uint_as_float(rr[0]) + __uint_as_float(rr[1]); }
  l_reg += __builtin_amdgcn_exp2f(sink2 - mhat);
  if (hi == 0) wsf[32 + r32] = l_reg; asm volatile("s_waitcnt lgkmcnt(0)" ::: "memory");
  float rli[16];
  #pragma unroll
  for (int r = 0; r < 16; ++r) rli[r] = __builtin_amdgcn_rcpf(wsf[32 + crow(r, hi)]);
  bf16* Ow = O + (qrow + wid * QBLK) * QP + qcol;
  { bf16* stg = (bf16*)(shm + LDS_OST) + wid * 2048;
    #pragma unroll
    for (int r = 0; r < 16; ++r) { const int orow = crow(r, hi);
      #pragma unroll
      for (int d0 = 0; d0 < 2; ++d0) stg[orow * 64 + d0 * 32 + r32] = __float2bfloat16(o[d0][r] * rli[r]); }
    asm volatile("s_waitcnt lgkmcnt(0)" ::: "memory");
    #pragma unroll
    for (int i = 0; i < 4; ++i) { const int row = i * 8 + (lane >> 3), ch = lane & 7; const u32x4 v = *(const u32x4*)(stg + row * 64 + ch * 8); ATTN_STORE16(Ow + (long)row * QP + ch * 8, v); } }
  asm volatile("s_waitcnt lgkmcnt(0)\n\ts_barrier" ::: "memory");
  #undef DMA_K
  #undef DMA_V
  #undef ROWOFF
  #undef CMASK
  #undef START
  #undef RESC
  #undef ROT
}
constexpr int ATTN_LDS_BYTES = LDS_BYTES;
#undef SBAR
#undef WAIT_BAR
}

struct Args { const float* in[20]; float* out; unsigned char* ws; int ph_lo, ph_hi; };
typedef const Args __attribute__((address_space(4)))* kargp_t;
__device__ __forceinline__ kargp_t kargs() { auto p = __builtin_amdgcn_kernarg_segment_ptr(); asm volatile("" : "+s"(p)); return (kargp_t)p; }
enum { I_X = 0, I_C, I_CTX, I_CCTX, I_ADAW, I_ADAB, I_GATTN, I_GFFN, I_WIN, I_QNG, I_KNG, I_QNL, I_KNL, I_SINK, I_WOUT, I_RW, I_RB, I_WGATE, I_WUP, I_WDOWN };
struct Frame {
    LAS unsigned char* lds; volatile LAS unsigned* MISC;
    int tid, lane, wave, vcu, G;
};
#define WSP(T, off) ((T*)(kargs()->ws + (off)))
__device__ const float ROPE_INV[16] = {1.000000000e+00f, 5.623413324e-01f, 3.162277639e-01f, 1.778279394e-01f, 1.000000015e-01f, 5.623413250e-02f, 3.162277490e-02f, 1.778279431e-02f,
                                       9.999999776e-03f, 5.623413250e-03f, 3.162277630e-03f, 1.778279431e-03f, 1.000000047e-03f, 5.623413017e-04f, 3.162277571e-04f, 1.778279402e-04f};

template <int KIND> __device__ __forceinline__ int dst_row(int n) {
    if (KIND == 0) return n;
    if (KIND == 2) return ((n >> 7) << 8) + (n & 127);
    if (KIND == 3) return ((n >> 7) << 8) + 128 + (n & 127);
    int tile, wc;
    if (n < 512) { const int h = n >> 6; tile = h >> 2; wc = h & 3; }
    else if (n < 640) { tile = 4; wc = (n - 512) >> 6; }
    else if (n < 768) { tile = 4; wc = 2 + ((n - 640) >> 6); }
    else if (n < 1280) { const int h = (n - 768) >> 6; tile = 2 + (h >> 2); wc = h & 3; }
    else if (n < 1408) { tile = 5; wc = (n - 1280) >> 6; }
    else { tile = 5; wc = 2 + ((n - 1408) >> 6); }
    const int d = n & 63, bj = d >> 5, dd = d & 31, np = dd >> 4, f = dd & 15, fq = f >> 2, j = f & 3;
    return 256 * tile + 128 * bj + 32 * wc + 8 * fq + 4 * np + j;
}
template <int KIND> __device__ __forceinline__ void p0_transpose_item(const float* W, int N, bf16_t* WT, int Kd, LAS float* scr, int kb, int nb, int lane) {
    const int k0 = 64 * kb, n0 = 32 * nb;
#pragma unroll 8
    for (int i = 0; i < 32; ++i) { const int kk = 2 * i + (lane >> 5); scr[kk * 33 + (lane & 31)] = W[(size_t)(k0 + kk) * N + n0 + (lane & 31)]; }
    LDS_WAIT(); asm volatile("" ::: "memory");
    const int c = lane & 7;
#pragma unroll
    for (int j = 0; j < 4; ++j) { const int n = (lane >> 3) + 8 * j; const LAS float* s = scr + (8 * c) * 33 + n;
        u32x4 o; o.x = pk2(s[0 * 33], s[1 * 33]); o.y = pk2(s[2 * 33], s[3 * 33]); o.z = pk2(s[4 * 33], s[5 * 33]); o.w = pk2(s[6 * 33], s[7 * 33]);
        *(GAS u32x4*)(WT + (size_t)dst_row<KIND>(n0 + n) * Kd + k0 + 8 * c) = o; }
    LDS_WAIT(); asm volatile("" ::: "memory");
}
__device__ __forceinline__ void sincos_d(float ang, float& cs, float& sn) {
    const double x = (double)ang; const double kq = __builtin_rint(x * 0.63661977236758134308);
    const double r = (x - kq * 1.5707963267948966192) - kq * 6.123233995736766036e-17, r2 = r * r;
    const double s = r * (1.0 + r2 * (-1.0 / 6 + r2 * (1.0 / 120 + r2 * (-1.0 / 5040 + r2 * (1.0 / 362880 + r2 * (-1.0 / 39916800 + r2 * (1.0 / 6227020800.0)))))));
    const double c = 1.0 + r2 * (-0.5 + r2 * (1.0 / 24 + r2 * (-1.0 / 720 + r2 * (1.0 / 40320 + r2 * (-1.0 / 3628800 + r2 * (1.0 / 479001600.0 + r2 * (-1.0 / 87178291200.0)))))));
    const int q = ((int)kq) & 3;
    const double cc = (q == 0) ? c : (q == 1) ? -s : (q == 2) ? -c : s;
    const double ss = (q == 0) ? s : (q == 1) ? c : (q == 2) ? -s : -c;
    cs = (float)cc; sn = (float)ss;
}
__device__ __forceinline__ void p0_prologue(Frame& F) {
    const int gw = F.vcu * NWAVES + F.wave, NGW = F.G * NWAVES;
    {
        const float* c = kargs()->in[I_C]; const float* cctx = kargs()->in[I_CCTX]; const float* ada_w = kargs()->in[I_ADAW]; const float* ada_b = kargs()->in[I_ADAB];
        float* modv = WSP(float, WS_MODV);
        LAS float* sv = (LAS float*)(F.lds);
        LAS float* part = (LAS float*)(F.lds + 16384);
        for (int i = F.tid; i < 3072; i += NWAVES * 64) { const int v = i >> 10, k = i & 1023; const float cv = v < 2 ? c[v * 1024 + k] : cctx[k]; sv[i] = cv / (1.0f + expf(-cv)); }
        __syncthreads();
        for (int tile = F.vcu; tile < NLAYER * 96; tile += F.G) {
            const int l = tile / 96, c0 = (tile % 96) * 64;
            const float* W = ada_w + (size_t)l * 1024 * 6144 + c0 + F.lane;
            float a0 = 0.f, a1 = 0.f, a2 = 0.f; const int kb = F.wave * 128;
#pragma unroll 8
            for (int k = 0; k < 128; ++k) { const float w = W[(size_t)(kb + k) * 6144]; a0 += sv[kb + k] * w; a1 += sv[1024 + kb + k] * w; a2 += sv[2048 + kb + k] * w; }
            part[(F.wave * 3 + 0) * 64 + F.lane] = a0; part[(F.wave * 3 + 1) * 64 + F.lane] = a1; part[(F.wave * 3 + 2) * 64 + F.lane] = a2;
            __syncthreads();
            if (F.tid < 192) { const int v = F.tid >> 6, col = F.tid & 63; float s = ada_b[l * 6144 + c0 + col];
#pragma unroll
                for (int w = 0; w < 8; ++w) s += part[(w * 3 + v) * 64 + col];
                modv[(size_t)(l * 3 + v) * 6144 + c0 + col] = s; }
            __syncthreads();
        }
    }
    { float* rope = WSP(float, WS_ROPE); const int gt = F.vcu * NWAVES * 64 + F.tid; if (gt < 4096) { const int pos = gt >> 4, f = gt & 15; const float ang = (float)pos * ROPE_INV[f]; float cs, sn; sincos_d(ang, cs, sn); rope[gt * 2] = cs; rope[gt * 2 + 1] = sn; } }
    { const int gt = F.vcu * NWAVES * 64 + F.tid; if (gt < NLAYER * 256) { const int l = gt >> 8, kq = (gt >> 6) & 3, d = gt & 63; const float* src = kargs()->in[kq == 0 ? I_QNG : (kq == 1 ? I_QNL : (kq == 2 ? I_KNG : I_KNL))]; WSP(float, WS_GN)[gt] = src[l * 64 + d]; } }
    { u32x4* p = (u32x4*)(WSP(bf16_t, WS_KV) + (size_t)NROW * 512); for (int i = F.vcu * NWAVES * 64 + F.tid; i < 256 * 512 * 2 / 16; i += F.G * NWAVES * 64) p[i] = (u32x4){0u, 0u, 0u, 0u}; }
    {
        const float* x = kargs()->in[I_X]; const float* ctx = kargs()->in[I_CTX]; float* XS = WSP(float, WS_XS);
        for (int R = gw; R < NROW; R += NGW) {
            const int b = R >= RB ? 1 : 0, rr = R - b * RB;
            const float* src = rr < NCTX ? ctx + (size_t)(b * NCTX + rr) * 1024 : x + (size_t)(b * SEQ + rr - NCTX) * 1024;
            const f32x4* s4 = (const f32x4*)src + F.lane; f32x4* d4 = (f32x4*)(XS + (size_t)R * 1024) + F.lane;
            f32x4 v[4];
#pragma unroll
            for (int j = 0; j < 4; ++j) v[j] = s4[64 * j];
#pragma unroll
            for (int j = 0; j < 4; ++j) d4[64 * j] = v[j];
        }
    }
    {
        LAS float* scr = (LAS float*)(F.lds + RING_OFF + F.wave * 16384);
        constexpr int I_IN = 4 * 768, I_OUT = 4 * 512, I_G = 64 * 256, I_U = 64 * 256, I_D = 64 * 256;
        for (int it0 = gw; it0 < I_IN + I_OUT + I_G + I_U + I_D; it0 += NGW) {
            int it = it0;
            if (it < I_IN) { const int l = it / 768, r = it % 768; p0_transpose_item<1>(kargs()->in[I_WIN] + (size_t)l * 1024 * 1536, 1536, WSP(bf16_t, WS_WIN) + (size_t)l * 1536 * 1024, 1024, scr, r / 48, r % 48, F.lane); continue; } it -= I_IN;
            if (it < I_OUT) { const int l = it / 512, r = it % 512; p0_transpose_item<0>(kargs()->in[I_WOUT] + (size_t)l * 1024 * 1024, 1024, WSP(bf16_t, WS_WOUT) + (size_t)l * 1024 * 1024, 1024, scr, r / 32, r % 32, F.lane); continue; } it -= I_OUT;
            if (it < I_G) { const int m = it / 256, r = it % 256; p0_transpose_item<2>(kargs()->in[I_WGATE] + (size_t)m * 1024 * 512, 512, WSP(bf16_t, WS_WGU) + (size_t)m * 1024 * 1024, 1024, scr, r / 16, r % 16, F.lane); continue; } it -= I_G;
            if (it < I_U) { const int m = it / 256, r = it % 256; p0_transpose_item<3>(kargs()->in[I_WUP] + (size_t)m * 1024 * 512, 512, WSP(bf16_t, WS_WGU) + (size_t)m * 1024 * 1024, 1024, scr, r / 16, r % 16, F.lane); continue; } it -= I_U;
            { const int m = it / 256, r = it % 256; p0_transpose_item<0>(kargs()->in[I_WDOWN] + (size_t)m * 512 * 1024, 1024, WSP(bf16_t, WS_WD) + (size_t)m * 1024 * 512, 512, scr, r / 32, r % 32, F.lane); }
        }
    }
}

__device__ __forceinline__ void rms_mod_row(const float* xrow, const float* g, const float* sh, const float* sc, int lane, f32x4 (&h)[4]) {
    const f32x4* xr = (const f32x4*)xrow + lane; float ss = 0.f;
#pragma unroll
    for (int j = 0; j < 4; ++j) { h[j] = xr[64 * j]; ss += (h[j][0] * h[j][0] + h[j][1] * h[j][1]) + (h[j][2] * h[j][2] + h[j][3] * h[j][3]); }
    const float rs = 1.0f / sqrtf(wave_sum(ss) * (1.0f / 1024.0f) + NORM_EPS);
#pragma unroll
    for (int j = 0; j < 4; ++j) { const f32x4 gg = ((const f32x4*)g)[lane + 64 * j], s1 = ((const f32x4*)sh)[lane + 64 * j], s2 = ((const f32x4*)sc)[lane + 64 * j];
        h[j] = (h[j] * rs * gg) * (1.0f + s2) + s1; }
}
__device__ __forceinline__ void store_row_bf16(bf16_t* orow, int lane, const f32x4 (&h)[4]) {
    u32x2* o8 = (u32x2*)orow + lane;
#pragma unroll
    for (int j = 0; j < 4; ++j) { u32x2 w; w.x = pk2(h[j][0], h[j][1]); w.y = pk2(h[j][2], h[j][3]); o8[64 * j] = w; }
}
__device__ __forceinline__ int row_mv(int R) { const int b = R >= RB ? 1 : 0; return (R - b * RB) < NCTX ? 2 : b; }

__device__ __forceinline__ void phase_norm1(Frame& F0, int l) {
    Frame F = F0; asm volatile("" : "+v"(F.tid), "+v"(F.lane), "+s"(F.wave), "+s"(F.vcu));
    const int gw = F.vcu * NWAVES + F.wave, NGW = F.G * NWAVES;
    const float* g = kargs()->in[I_GATTN] + l * 1024; const float* modv = WSP(float, WS_MODV); const float* XS = WSP(float, WS_XS); bf16_t* HN = WSP(bf16_t, WS_HN);
    for (int R = gw; R < NROW; R += NGW) {
        const float* mv = modv + (size_t)(l * 3 + row_mv(R)) * 6144;
        f32x4 h[4]; rms_mod_row(XS + (size_t)R * 1024, g, mv + 0, mv + 1024, F.lane, h);
        store_row_bf16(HN + (size_t)R * 1024, F.lane, h);
    }
}
__device__ __forceinline__ void phase_norm2_router(Frame& F0, int l, bool lastl) {
    Frame F = F0; asm volatile("" : "+v"(F.tid), "+v"(F.lane), "+s"(F.wave), "+s"(F.vcu));
    const int gw = F.vcu * NWAVES + F.wave, NGW = F.G * NWAVES;
    LAS f32x4* RW = (LAS f32x4*)(F.lds + RING_OFF);
    { const float* router_w = kargs()->in[I_RW];
      for (int idx = F.tid; idx < 4096; idx += NWAVES * 64) { const int j = idx >> 10, e = (idx >> 6) & 15, ln = idx & 63, c = 4 * ln + 256 * j;
        RW[idx] = (f32x4){router_w[(c + 0) * 16 + e], router_w[(c + 1) * 16 + e], router_w[(c + 2) * 16 + e], router_w[(c + 3) * 16 + e]}; } }
    __syncthreads();
    const float* g = kargs()->in[I_GFFN] + l * 1024; const float* router_b = kargs()->in[I_RB];
    const float* modv = WSP(float, WS_MODV); const float* XS = WSP(float, WS_XS); bf16_t* HN = WSP(bf16_t, WS_HN);
    int my_cls = -1, my_tok = 0; float my_wlo = 0.f, my_whi = 0.f;
    int k = 0;
    for (int R = gw; R < NROW; R += NGW, ++k) {
        const int mvi = row_mv(R);
        if (lastl && mvi == 2) continue;
        const float* mv = modv + (size_t)(l * 3 + mvi) * 6144;
        f32x4 h[4]; rms_mod_row(XS + (size_t)R * 1024, g, mv + 3072, mv + 4096, F.lane, h);
        store_row_bf16(HN + (size_t)R * 1024, F.lane, h);
        float sc[16], sel[16];
#pragma unroll
        for (int e = 0; e < 16; ++e) { float s = 0.f;
#pragma unroll
            for (int j = 0; j < 4; ++j) { const f32x4 w4 = RW[(j * 16 + e) * 64 + F.lane]; s += (h[j][0] * w4[0] + h[j][1] * w4[1]) + (h[j][2] * w4[2] + h[j][3] * w4[3]); }
            const float lg = wave_sum(s); sc[e] = 1.0f / (1.0f + expf(-lg)); sel[e] = sc[e] + router_b[e]; }
        float gs[4];
#pragma unroll
        for (int gq = 0; gq < 4; ++gq) { const float a = sel[4 * gq], b = sel[4 * gq + 1], c = sel[4 * gq + 2], d = sel[4 * gq + 3];
            const float h1 = fmaxf(a, b), l1 = fminf(a, b), h2 = fmaxf(c, d), l2 = fminf(c, d);
            gs[gq] = fmaxf(h1, h2) + fmaxf(fminf(h1, h2), fmaxf(l1, l2)); }
        int gi = 0; float bg = gs[0];
#pragma unroll
        for (int gq = 1; gq < 4; ++gq) if (gs[gq] > bg) { bg = gs[gq]; gi = gq; }
        float s4[4], c4[4];
#pragma unroll
        for (int q = 0; q < 4; ++q) { s4[q] = sel[q]; c4[q] = sc[q]; }
#pragma unroll
        for (int gq = 1; gq < 4; ++gq)
#pragma unroll
            for (int q = 0; q < 4; ++q) { s4[q] = (gi == gq) ? sel[4 * gq + q] : s4[q]; c4[q] = (gi == gq) ? sc[4 * gq + q] : c4[q]; }
        int i1 = 0; float b1 = s4[0], w1 = c4[0];
#pragma unroll
        for (int q = 1; q < 4; ++q) if (s4[q] > b1) { b1 = s4[q]; i1 = q; w1 = c4[q]; }
        int i2 = -1; float b2 = -INFINITY, w2 = 0.f;
#pragma unroll
        for (int q = 0; q < 4; ++q) if (q != i1 && (i2 < 0 || s4[q] > b2)) { b2 = s4[q]; i2 = q; w2 = c4[q]; }
        const float wsum = w1 + w2; w1 = w1 / wsum; w2 = w2 / wsum;
        const int ia = i1 < i2 ? i1 : i2, ib = i1 < i2 ? i2 : i1;
        const float wlo = i1 < i2 ? w1 : w2, whi = i1 < i2 ? w2 : w1;
        const int pidx = ia == 0 ? ib - 1 : (ia == 1 ? ib + 1 : 5);
        if (F.lane == k) { my_cls = gi * 6 + pidx; my_tok = R; my_wlo = wlo; my_whi = whi; }
    }
    if (my_cls >= 0) {
        const unsigned pos = __hip_atomic_fetch_add(WSP(unsigned, WS_CTL) + CW_CNT + (l * NCLS + my_cls) * 64, 1u, RLX_AGENT);
        WSP(int, WS_TOK)[(size_t)my_cls * CAP + pos] = my_tok; WSP(f32x2, WS_WTS)[(size_t)my_cls * CAP + pos] = (f32x2){my_wlo, my_whi};
    }
    __syncthreads();
}
__device__ __forceinline__ int moe_tables(Frame& F0, int l) {
    Frame F = F0; asm volatile("" : "+v"(F.tid));
    LAS int* s_n = (LAS int*)(F.lds + MOE_OFF); LAS int* s_ts = s_n + 32;
    __syncthreads();
    if (F.tid < NCLS) s_n[F.tid] = (int)__hip_atomic_load(WSP(unsigned, WS_CTL) + CW_CNT + (l * NCLS + F.tid) * 64, RLX_AGENT);
    __syncthreads();
    if (F.tid == 0) { int acc = 0; for (int c = 0; c < NCLS; ++c) { s_ts[c] = acc; acc += (s_n[c] + 255) >> 8; } s_ts[NCLS] = acc; }
    __syncthreads();
    return s_ts[NCLS];
}

constexpr int NPHASE = 1 + 7 * NLAYER;
__global__ void __launch_bounds__(NWAVES * 64, 2) fwd_kernel(Args args) {
    extern __shared__ __attribute__((aligned(16))) unsigned char lds[];
    Frame F;
    F.lds = (LAS unsigned char*)lds; F.MISC = (volatile LAS unsigned*)(F.lds + MISC_OFF);
    F.tid = threadIdx.x; F.lane = F.tid & 63; F.wave = __builtin_amdgcn_readfirstlane(F.tid >> 6);
    F.G = gridDim.x; { const int bx = blockIdx.x; F.vcu = (F.G % 8 == 0) ? (bx % 8) * (F.G / 8) + bx / 8 : bx; }
    for (int u = F.tid; u < (LDS_BYTES - LDSCTL_OFF) / 4; u += NWAVES * 64) ((LAS unsigned*)(F.lds + LDSCTL_OFF))[u] = 0u;
    __syncthreads();
    const int lo = args.ph_lo, hi = args.ph_hi;
    XcdBarrier bar; bar.bar = WSP(unsigned, WS_CTL) + CW_BAR; bar.x = 0; bar.st = nullptr;
    if (hi - lo > 1) bar = xcd_barrier_post(WSP(unsigned, WS_CTL) + CW_BAR, F.MISC + 8);
#ifndef MK_EN
#define MK_EN 0xff
#endif
#define EN(k) (((MK_EN) >> (k)) & 1)
#define RUN(p) (lo <= (p) && (p) < hi)
#define SEAM(p) do { if (RUN(p) && RUN((p) + 1)) xcd_barrier(bar); } while (0)

    if (EN(7) && RUN(0)) { p0_prologue(F); SEAM(0); }

    for (int l = 0; l < NLAYER; ++l) {
        const int pb = 1 + 7 * l; const bool lastl = (l == NLAYER - 1);
        if (EN(0) && RUN(pb + 0)) { phase_norm1(F, l); SEAM(pb + 0); }
        if (EN(1) && RUN(pb + 1)) {
            pg8::ProbDense P; P.A = WSP(const char, WS_HN); P.B = (const char*)(WSP(bf16_t, WS_WIN) + (size_t)l * 1536 * 1024); P.lda = 1024; P.ldb = 1024; P.nt = 16; P.S.init(NROW, 1536, F.G, (int)blockIdx.x);
            pg8::EpiQKV E{kargs()->ws, WSP(float, WS_GN) + l * 256, WSP(float, WS_ROPE)};
            pg8::gemm_phase<pg8::EpiQKV, pg8::ProbDense, true>(F.lds + RING_OFF, F.lds + OFFS_OFF, P, E);
            SEAM(pb + 1);
        }
        if (EN(2) && RUN(pb + 2)) {
            const attn_body::bf16* Q = WSP(const attn_body::bf16, WS_QO); const attn_body::bf16* KVb = WSP(const attn_body::bf16, WS_KV); attn_body::bf16* O = WSP(attn_body::bf16, WS_QO);
            const float* sink = kargs()->in[I_SINK] + l * 8;
            const int n0 = 1024 + (lastl ? 0 : 32);
            for (int L = F.vcu; L < n0; L += F.G) {
                long qrow, kvrow; int qcol, kcol, vcol, NT; float sink2 = -INFINITY;
                if (L < 1024) { const int bh = L >> 6, b = bh >> 3, h = bh & 7, qb = L & 63; qrow = (long)b * RB + NCTX + qb * 256; kvrow = (long)b * RB; NT = RB / 64; qcol = h * 64; kcol = (h >> 2) * 64; vcol = 128 + (h >> 2) * 64; }
                else { const int Lc = L - 1024, b = Lc >> 4, h = Lc & 15; qrow = (long)b * RB; kvrow = qrow; NT = NCTX / 64; qcol = h * 64;
                    if (h < 8) { kcol = (h >> 2) * 64; vcol = 128 + (h >> 2) * 64; } else { const int hl = h - 8; kcol = 256 + (hl >> 2) * 64; vcol = 384 + (hl >> 2) * 64; sink2 = sink[hl] * LOG2E; } }
                attn_body::attn_unit<0, 8>(qrow, kvrow, 0, qcol, kcol, vcol, NT, sink2, Q, KVb, O, (char*)lds + RING_OFF);
            }
            for (int L = F.vcu; L < 1024; L += F.G) {
                const int bh = L >> 6, b = bh >> 3, hl = bh & 7, qb = L & 63, q0 = qb * 256;
                attn_body::attn_unit<1, 8>((long)b * RB + NCTX + q0, (long)b * RB, q0, (8 + hl) * 64, 256 + (hl >> 2) * 64, 384 + (hl >> 2) * 64, 12, sink[hl] * LOG2E, Q, KVb, O, (char*)lds + RING_OFF);
            }
            SEAM(pb + 2);
        }
        if (EN(3) && RUN(pb + 3)) {
            pg8::ProbDense P; P.A = WSP(const char, WS_QO); P.B = (const char*)(WSP(bf16_t, WS_WOUT) + (size_t)l * 1024 * 1024); P.lda = 1024; P.ldb = 1024; P.nt = 16; P.S.init(NROW, 1024, F.G, (int)blockIdx.x);
            pg8::EpiResid E{WSP(float, WS_XS), WSP(float, WS_MODV) + (size_t)l * 3 * 6144, 2048};
            pg8::gemm_phase<pg8::EpiResid, pg8::ProbDense, true>(F.lds + RING_OFF, F.lds + OFFS_OFF, P, E);
            SEAM(pb + 3);
        }
        if (EN(4) && RUN(pb + 4)) { phase_norm2_router(F, l, lastl); SEAM(pb + 4); }
        if (EN(5) && RUN(pb + 5)) {
            const int ntile = moe_tables(F, l);
            pg8::ProbGU P; P.A = WSP(const char, WS_HN); P.B = (const char*)(WSP(bf16_t, WS_WGU) + (size_t)l * 16 * 1024 * 1024); P.tok = WSP(int, WS_TOK); P.s_n = (const LAS int*)(F.lds + MOE_OFF); P.s_ts = P.s_n + 32;
            P.total = ntile * 8; P.G = F.G; P.c = (int)blockIdx.x; P.nt = 16;
            pg8::EpiGU E{WSP(bf16_t, WS_ACT), WSP(f32x2, WS_WTS)};
            pg8::gemm_phase<pg8::EpiGU, pg8::ProbGU, true>(F.lds + RING_OFF, F.lds + OFFS_OFF, P, E);
            SEAM(pb + 5);
        }
        if (EN(6) && RUN(pb + 6)) {
            const int ntile = moe_tables(F, l);
            pg8::ProbDown P; P.A = WSP(const char, WS_ACT); P.B = (const char*)(WSP(bf16_t, WS_WD) + (size_t)l * 16 * 1024 * 512); P.s_n = (const LAS int*)(F.lds + MOE_OFF); P.s_ts = P.s_n + 32;
            P.total = ntile * 4; P.G = F.G; P.c = (int)blockIdx.x; P.nt = 16;
            pg8::EpiDown E{WSP(float, WS_XS), lastl ? kargs()->out : nullptr, WSP(int, WS_TOK), WSP(float, WS_MODV) + (size_t)l * 3 * 6144};
            pg8::gemm_phase<pg8::EpiDown, pg8::ProbDown, true>(F.lds + RING_OFF, F.lds + OFFS_OFF, P, E);
            SEAM(pb + 6);
        }
    }
#undef RUN
#undef SEAM
}

#ifndef MK_SPLIT
#define MK_SPLIT 0
#endif
extern "C" void kernel_launch(void* const* d_in, const int* in_sizes, int n_in, void* d_out, int out_size, void* d_ws, size_t ws_size, hipStream_t stream) {
    static int grid = 0;
    if (grid == 0) {
        if (n_in != 20 || in_sizes[0] != NB * SEQ * DM || out_size != NB * SEQ * DM || ws_size < WS_END) {
            fprintf(stderr, "kernel_launch: unexpected shapes (n_in %d, in0 %d, out %d, ws %zu); nothing launched\n", n_in, n_in > 0 ? in_sizes[0] : -1, out_size, ws_size); grid = -1; return; }
        int dev = 0, cus = 0, per_cu = 0;
        if (hipGetDevice(&dev) != hipSuccess || hipDeviceGetAttribute(&cus, hipDeviceAttributeMultiprocessorCount, dev) != hipSuccess) { grid = -1; return; }
        if (hipFuncSetAttribute((const void*)fwd_kernel, hipFuncAttributeMaxDynamicSharedMemorySize, LDS_BYTES) != hipSuccess) { fprintf(stderr, "kernel_launch: hipFuncSetAttribute failed\n"); grid = -1; return; }
        if (hipOccupancyMaxActiveBlocksPerMultiprocessor(&per_cu, (const void*)fwd_kernel, NWAVES * 64, LDS_BYTES) != hipSuccess || per_cu < 1)
            fprintf(stderr, "kernel_launch: note: occupancy query reports %d workgroups per CU\n", per_cu);
        (void)hipGetLastError();
        grid = cus;
    }
    if (grid < 0) return;
    if (hipMemsetAsync((char*)d_ws + WS_CTL, 0, CTL_ZERO_BYTES, stream) != hipSuccess) return;
    Args a{};
    for (int i = 0; i < 20; ++i) a.in[i] = (const float*)d_in[i];
    a.out = (float*)d_out; a.ws = (unsigned char*)d_ws;
#if MK_SPLIT
    for (int p = 0; p < NPHASE; ++p) { a.ph_lo = p; a.ph_hi = p + 1; hipLaunchKernelGGL(fwd_kernel, dim3(grid), dim3(NWAVES * 64), LDS_BYTES, stream, a); }
#else
    a.ph_lo = 0; a.ph_hi = NPHASE;
    hipLaunchKernelGGL(fwd_kernel, dim3(grid), dim3(NWAVES * 64), LDS_BYTES, stream, a);
#endif
    const hipError_t le = hipPeekAtLastError();
    if (le != hipSuccess) fprintf(stderr, "kernel_launch: launch failed: %s\n", hipGetErrorName(le));
}
```

```cpp
#include <hip/hip_runtime.h>
#include <hip/hip_bf16.h>
#include <cstdio>
#include <cstdint>
#include <cmath>

#define LAS __attribute__((address_space(3)))
#define GAS __attribute__((address_space(1)))
typedef unsigned short bf16_t;
typedef short bf16x8 __attribute__((ext_vector_type(8)));
typedef float f32x4 __attribute__((ext_vector_type(4)));
typedef float f32x2 __attribute__((ext_vector_type(2)));
typedef unsigned u32x4 __attribute__((ext_vector_type(4)));
typedef unsigned u32x2 __attribute__((ext_vector_type(2)));
typedef GAS unsigned gu32;

constexpr int NB = 2, SEQ = 16384, DM = 1024, NCTX = 256, NLAYER = 4, NEXP = 16, DEXP = 512;
constexpr int RB = SEQ + NCTX;
constexpr int NROW = NB * RB;
constexpr int NCLS = 24, CAP = NROW;
constexpr int MAXSLOT = 39424;
constexpr float NORM_EPS = 1e-6f;
constexpr float C2 = 0.125f * 1.4426950408889634f;
constexpr float LOG2E = 1.4426950408889634f;

constexpr size_t MiB = 1u << 20;
constexpr size_t WS_CTL = 0, CTL_ZERO_BYTES = 1 * MiB;
constexpr size_t WS_MODV = 1 * MiB;
constexpr size_t WS_ROPE = 2 * MiB;
constexpr size_t WS_GN = 3 * MiB;
constexpr size_t WS_BND = 3 * MiB + 8192;
constexpr size_t WS_TOK = 4 * MiB;
constexpr size_t WS_WTS = 8 * MiB;
constexpr size_t WS_WIN = 16 * MiB;
constexpr size_t WS_WOUT = 28 * MiB;
constexpr size_t WS_WGU = 36 * MiB;
constexpr size_t WS_WD = 164 * MiB;
constexpr size_t WS_XS = 228 * MiB;
constexpr size_t WS_HN = 358 * MiB;
constexpr size_t WS_QO = 423 * MiB;
constexpr size_t WS_KV = 488 * MiB;
constexpr size_t WS_ACT = 423 * MiB;
constexpr size_t WS_END = 522 * MiB;
static_assert(WS_TOK + (size_t)NCLS * CAP * 4 <= WS_WTS && WS_WTS + (size_t)NCLS * CAP * 8 <= WS_WIN, "lists");
static_assert(WS_KV + (size_t)(NROW + 256) * 512 * 2 <= WS_END && WS_ACT + (size_t)MAXSLOT * 1024 * 2 <= WS_END, "ws map");
constexpr int CW_TMO = 0, CW_CODE = 1, CW_BAR = 4096, CW_CNT = 8192;

constexpr int RING_OFF = 0, RING_BYTES = 131072;
constexpr int LDSCTL_OFF = RING_BYTES, MISC_OFF = LDSCTL_OFF + 320, MOE_OFF = LDSCTL_OFF + 1024, OFFS_OFF = LDSCTL_OFF + 2048  ;
constexpr int LDS_BYTES = 147456;
constexpr int NWAVES = 8;

#define LDS_WAIT() asm volatile("s_waitcnt lgkmcnt(0)" ::: "memory")
#define VM_WAIT() asm volatile("s_waitcnt vmcnt(0)" ::: "memory")
#define RLX_AGENT __ATOMIC_RELAXED, __HIP_MEMORY_SCOPE_AGENT

__device__ __forceinline__ unsigned f2bf(float f) { unsigned u = __builtin_bit_cast(unsigned, f); return (u + 0x7fffu + ((u >> 16) & 1u)) >> 16; }
__device__ __forceinline__ unsigned pk2(float lo, float hi) { return f2bf(lo) | (f2bf(hi) << 16); }
__device__ __forceinline__ unsigned cvt_pk_bf16(float lo, float hi) { unsigned r; asm volatile("v_cvt_pk_bf16_f32 %0, %1, %2" : "=v"(r) : "v"(lo), "v"(hi)); return r; }
__device__ __forceinline__ float wave_sum(float v) {
#pragma unroll
    for (int o = 1; o < 64; o <<= 1) v += __shfl_xor(v, o);
    return v;
}

#define XB_TMO      128
#define XB_XCNT(j)  (256  + 64 * (j))
#define XB_XSUB(j)  (1280 + 64 * (j))
#define XB_XGEN(j)  (2304 + 64 * (j))
#define XB_TOP      3328
#define XB_TOPGEN   3392
#define XCD_BAR_WORDS 3456
#define XB_SPIN_CAP (1u << 22)
__device__ __forceinline__ unsigned xb_ld(unsigned* p)              { return __hip_atomic_load(p, __ATOMIC_RELAXED, __HIP_MEMORY_SCOPE_AGENT); }
__device__ __forceinline__ unsigned xb_add(unsigned* p, unsigned v) { return __hip_atomic_fetch_add(p, v, __ATOMIC_RELAXED, __HIP_MEMORY_SCOPE_AGENT); }
__device__ __forceinline__ unsigned xb_xcc_id() { return (unsigned)__builtin_amdgcn_s_getreg((3 << 11) | 20) & 0xFu; }
#define XB_SPIN(cond, bar) do { unsigned _sp = 0; while (cond) { __builtin_amdgcn_s_sleep(1); \
    if ((++_sp & 255u) == 0u) { if (xb_ld(&(bar)[XB_TMO])) break; if (_sp > XB_SPIN_CAP) { atomicAdd(&(bar)[XB_TMO], 1u); break; } } } } while (0)
struct XcdBarrier { unsigned* bar; unsigned x; volatile LAS unsigned* st; };
__device__ __forceinline__ XcdBarrier xcd_barrier_post(unsigned* bar, volatile LAS unsigned* st) {
    XcdBarrier b; b.bar = bar; b.x = xb_xcc_id(); b.st = st;
    if (threadIdx.x == 0) (void)xb_add(&bar[XB_XCNT(b.x)], 1u);
    return b;
}
__device__ __forceinline__ void xcd_barrier_complete(unsigned* bar, unsigned x, unsigned& nloc, unsigned& nx) {
    const unsigned G = gridDim.x * gridDim.y * gridDim.z;
    unsigned sum, cnt, mine, sp = 0u;
    for (;;) {
        sum = 0u; cnt = 0u; mine = 0u;
#pragma unroll
        for (unsigned j = 0; j < 16; ++j) { const unsigned c = xb_ld(&bar[XB_XCNT(j)]); sum += c; cnt += (c > 0u) ? 1u : 0u; mine = (j == x) ? c : mine; }
        if (sum == G) break;
        __builtin_amdgcn_s_sleep(1);
        if ((++sp & 255u) == 0u) { if (xb_ld(&bar[XB_TMO])) break; if (sp > XB_SPIN_CAP) { atomicAdd(&bar[XB_TMO], 1u); break; } }
    }
    nloc = mine > 0u ? mine : 1u; nx = cnt > 0u ? cnt : 1u;
}
__device__ __forceinline__ void xcd_barrier(const XcdBarrier& b) {
    asm volatile("s_waitcnt vmcnt(0)" ::: "memory");
    __syncthreads();
    if (threadIdx.x == 0) {
        unsigned* bar = b.bar;
        __builtin_amdgcn_s_waitcnt(0);
        unsigned nloc = b.st[0], nx = b.st[1];
        if (nloc == 0u) { xcd_barrier_complete(bar, b.x, nloc, nx); b.st[0] = nloc; b.st[1] = nx; }
        const unsigned old = xb_add(&bar[XB_XSUB(b.x)], 1u);
        const unsigned gen = old / nloc;
        if (old + 1u == (gen + 1u) * nloc) {
            __builtin_amdgcn_fence(__ATOMIC_RELEASE, "agent");
            asm volatile("s_waitcnt vmcnt(0)" ::: "memory");
            const unsigned og = xb_add(&bar[XB_TOP], 1u);
            const unsigned tg = og / nx;
            if (og + 1u == (tg + 1u) * nx) xb_add(&bar[XB_TOPGEN], 1u);
            else XB_SPIN(xb_ld(&bar[XB_TOPGEN]) == tg, bar);
            __builtin_amdgcn_fence(__ATOMIC_ACQUIRE, "agent");
            xb_add(&bar[XB_XGEN(b.x)], 1u);
            asm volatile("s_waitcnt vmcnt(0)" ::: "memory");
        } else {
            XB_SPIN(xb_ld(&bar[XB_XGEN(b.x)]) == gen, bar);
            __builtin_amdgcn_fence(__ATOMIC_ACQUIRE, "agent");
            asm volatile("s_waitcnt vmcnt(0)" ::: "memory");
        }
    }
    __syncthreads();
}

namespace pg8 {
constexpr int BM = 256, BK = 64, HALF = 128, HTB = HALF * BK * 2, STAGE_BYTES = 8 * HTB, NXCD = 8, WGM = 8;
__host__ __device__ __forceinline__ int lds_byte(int r, int c) { const int st = (r >> 4) * 2 + (c >> 5), rr = r & 15, cc = c & 31, ob = rr * 64 + cc * 2; return st * 1024 + (ob ^ (((ob >> 9) & 1) << 5)); }
__host__ __device__ __forceinline__ void stage_rc(int b, int& R, int& C) { const int st = b / 1024, sb = b % 1024, swz = sb ^ (((sb >> 9) & 1) << 5); R = (st >> 1) * 16 + swz / 64; C = (st & 1) * 32 + (swz % 64) / 2; }
__host__ __device__ __forceinline__ int perm32(int rho) { const int n = rho >> 4, i = rho & 15; return 8 * (i >> 2) + 4 * n + (i & 3); }

struct Unit { int pm, pn, cls, row0, ncls, elo, ehi; };

struct StaticOrder {
    int nM, nN, nwg, G, c;
    __device__ void init(int M, int N, int G_, int c_) { nM = M / BM; nN = N / BM; nwg = nM * nN; G = G_; c = c_; }
    __device__ __forceinline__ bool next(int i, Unit& u) const {
        const long L = (long)i * G + c; if (L >= nwg) return false;
        int wgid = (int)L; { const int q = nwg / NXCD, r = nwg % NXCD, xcd = wgid % NXCD, off = wgid / NXCD; wgid = (xcd < r ? xcd * (q + 1) : r * (q + 1) + (xcd - r) * q) + off; }
        const int nig = WGM * nN, gid = wgid / nig, fm = gid * WGM, gsz = (nM - fm) < WGM ? (nM - fm) : WGM;
        u.pm = fm + ((wgid % nig) % gsz); u.pn = (wgid % nig) / gsz; u.cls = 0; u.row0 = 0; u.ncls = 0; u.elo = 0; u.ehi = 0; return true;
    }
};

struct ProbDense {
    const char* A; const char* B; int lda, ldb, nt; StaticOrder S;
    __device__ __forceinline__ bool next(int i, Unit& u) const { return S.next(i, u); }
    __device__ __forceinline__ void a_offs(const Unit& u, int tid, unsigned (&off)[2][2]) const {
#pragma unroll
        for (int i = 0; i < 2; ++i) { int R, C; stage_rc(tid * 16 + i * 8192, R, C);
#pragma unroll
            for (int h = 0; h < 2; ++h) off[h][i] = (unsigned)((u.pm * BM + h * HALF + R) * lda + C) * 2u; }
    }
    __device__ __forceinline__ const char* b_ptr(const Unit& u, int t) const { return B + (size_t)u.pn * BM * ldb * 2 + (size_t)t * (BK * 2); }
};
__device__ __forceinline__ void moe_unit(const LAS int* s_n, const LAS int* s_ts, int rt, Unit& u) {
    int cc = 0; while (s_ts[cc + 1] <= rt) ++cc;
    u.pm = rt; u.cls = cc; u.row0 = (rt - s_ts[cc]) * BM; u.ncls = s_n[cc];
    const int g = cc / 6, idx = cc % 6; const int a = idx < 3 ? 0 : (idx < 5 ? 1 : 2), b = idx < 3 ? idx + 1 : (idx < 5 ? idx - 1 : 3);
    u.elo = 4 * g + a; u.ehi = 4 * g + b;
}
struct ProbGU {
    const char* A; const char* B; const int* tok; const LAS int* s_n; const LAS int* s_ts; int total, G, c; static constexpr int ldb = 1024; int nt;
    __device__ __forceinline__ bool next(int i, Unit& u) const { const long L = (long)i * G + c; if (L >= total) return false; u.pn = (int)(L & 7); moe_unit(s_n, s_ts, (int)(L >> 3), u); return true; }
    __device__ __forceinline__ void a_offs(const Unit& u, int tid, unsigned (&off)[2][2]) const {
#pragma unroll
        for (int i = 0; i < 2; ++i) { int R, C; stage_rc(tid * 16 + i * 8192, R, C);
#pragma unroll
            for (int h = 0; h < 2; ++h) { int r = u.row0 + h * HALF + R; r = r < u.ncls ? r : u.ncls - 1; const int t = tok[(size_t)u.cls * CAP + r]; off[h][i] = (unsigned)t * 2048u + (unsigned)C * 2u; } }
    }
    __device__ __forceinline__ const char* b_ptr(const Unit& u, int t) const { const int e = u.pn >= 4 ? u.ehi : u.elo; return B + (size_t)e * (1024 * 1024 * 2) + (size_t)(u.pn & 3) * (BM * 1024 * 2) + (size_t)t * (BK * 2); }
};
struct ProbDown {
    const char* A; const char* B; const LAS int* s_n; const LAS int* s_ts; int total, G, c; static constexpr int ldb = 512; int nt;
    __device__ __forceinline__ bool next(int i, Unit& u) const { const long L = (long)i * G + c; if (L >= total) return false; u.pn = (int)(L & 3); moe_unit(s_n, s_ts, (int)(L >> 2), u); return true; }
    __device__ __forceinline__ void a_offs(const Unit& u, int tid, unsigned (&off)[2][2]) const {
#pragma unroll
        for (int i = 0; i < 2; ++i) { int R, C; stage_rc(tid * 16 + i * 8192, R, C);
#pragma unroll
            for (int h = 0; h < 2; ++h) off[h][i] = (unsigned)(u.pm * BM + h * HALF + R) * 2048u + (unsigned)C * 2u; }
    }
    __device__ __forceinline__ const char* b_ptr(const Unit& u, int t) const { const int e = t < 8 ? u.elo : u.ehi; return B + (size_t)e * (1024 * 512 * 2) + (size_t)u.pn * (BM * 512 * 2) + (size_t)(t & 7) * (BK * 2); }
};

template <class Epi, class Prob, bool ALIGN_EPI>
__device__ __forceinline__ void gemm_phase(LAS unsigned char* lds, LAS unsigned char* offs_lds, const Prob& P, const Epi& E) {
    int tid_ = threadIdx.x; asm volatile("" : "+v"(tid_));
    const int tid = tid_, wid = __builtin_amdgcn_readfirstlane(tid >> 6), lane = tid & 63, wr = wid >> 2, wc = wid & 3, fr = lane & 15, fq = lane >> 4;
    const int nt = P.nt;
    unsigned voffB[2];
#pragma unroll
    for (int i = 0; i < 2; ++i) { int R, C; stage_rc(tid * 16 + i * 8192, R, C); const int Rb = Epi::PERM ? ((R & ~31) + perm32(R & 31)) : R; voffB[i] = (unsigned)(Rb * P.ldb + C) * 2u; }
    LAS u32x4* const myoffs = (LAS u32x4*)offs_lds + tid;
    const size_t hstepB = (size_t)HALF * P.ldb * 2;
    const unsigned ldsw = (unsigned)wid * 1024u;
    const int aoff = lds_byte(wr * 64 + fr, fq * 8), boff = lds_byte(wc * 32 + fr, fq * 8);
    const char* const Ab = P.A;
#define PG8_SA(b, h) (((b) * 2 + (h)) * HTB)
#define PG8_SB(b, h) ((4 + (b) * 2 + (h)) * HTB)
#define PG8_STAGE_A(bufoff, h, offs, kt) do { _Pragma("unroll") for (int _i = 0; _i < 2; ++_i) \
        __builtin_amdgcn_global_load_lds((const unsigned*)(Ab + (size_t)(offs)[h][_i] + (size_t)(kt) * (BK * 2)), (LAS unsigned*)(lds + (bufoff) + ldsw + _i * 8192), 16, 0, 0); } while (0)
#define PG8_STAGE_B(bufoff, bp) do { _Pragma("unroll") for (int _i = 0; _i < 2; ++_i) \
        __builtin_amdgcn_global_load_lds((const unsigned*)((bp) + voffB[_i]), (LAS unsigned*)(lds + (bufoff) + ldsw + _i * 8192), 16, 0, 0); } while (0)
#define PG8_LDA(dst, b, h) do { _Pragma("unroll") for (int m = 0; m < 4; ++m) _Pragma("unroll") for (int k = 0; k < 2; ++k) dst[m][k] = *(const LAS bf16x8*)(lds + PG8_SA(b, h) + aoff + m * 2048 + k * 1024); } while (0)
#define PG8_LDB(dst, b, h) do { _Pragma("unroll") for (int n = 0; n < 2; ++n) _Pragma("unroll") for (int k = 0; k < 2; ++k) dst[n][k] = *(const LAS bf16x8*)(lds + PG8_SB(b, h) + boff + n * 2048 + k * 1024); } while (0)
#define PG8_MMA(ai, bj, At, Bt) do { __builtin_amdgcn_s_setprio(1); _Pragma("unroll") for (int m = 0; m < 4; ++m) _Pragma("unroll") for (int n = 0; n < 2; ++n) _Pragma("unroll") for (int k = 0; k < 2; ++k) \
        acc[ai][bj][m][n] = __builtin_amdgcn_mfma_f32_16x16x32_bf16(Bt[n][k], At[m][k], acc[ai][bj][m][n], 0, 0, 0); __builtin_amdgcn_s_setprio(0); } while (0)
#define PG8_WAIT_V(n) asm volatile("s_waitcnt vmcnt(" #n ")" ::: "memory")
#define PG8_WAIT_L(n) asm volatile("s_waitcnt lgkmcnt(" #n ")" ::: "memory")
#define PG8_BAR __builtin_amdgcn_s_barrier()
#define PG8_SCHED __builtin_amdgcn_sched_barrier(0)
    Unit cur, nxt; int ui = 0;
    if (!P.next(0, cur)) return;
    f32x4 acc[2][2][4][2];
#pragma unroll
    for (int a = 0; a < 2; ++a)
#pragma unroll
        for (int b = 0; b < 2; ++b)
#pragma unroll
            for (int m = 0; m < 4; ++m)
#pragma unroll
                for (int n = 0; n < 2; ++n) acc[a][b][m][n] = (f32x4){0.f, 0.f, 0.f, 0.f};
    bf16x8 At[4][2], B0[2][2], B1[2][2];
    unsigned offC[2][2];
    P.a_offs(cur, tid, offC);
    {
        const char* b0 = P.b_ptr(cur, 0); const char* b1 = P.b_ptr(cur, 1);
        PG8_STAGE_B(PG8_SB(0, 0), b0); PG8_STAGE_B(PG8_SB(0, 1), b0 + hstepB); PG8_STAGE_A(PG8_SA(0, 0), 0, offC, 0); PG8_STAGE_A(PG8_SA(0, 1), 1, offC, 0);
        if (wr == 1) PG8_BAR;
        PG8_WAIT_V(2); PG8_BAR;
        PG8_STAGE_B(PG8_SB(1, 0), b1); PG8_STAGE_A(PG8_SA(1, 0), 0, offC, 1); PG8_STAGE_B(PG8_SB(1, 1), b1 + hstepB);
        PG8_WAIT_V(6); PG8_BAR;
    }
    for (;;) {
        const bool has_next = P.next(ui + 1, nxt);
        if (!has_next) nxt = cur;
        {
            unsigned offN[2][2];
            if (has_next) P.a_offs(nxt, tid, offN);
            else {
#pragma unroll
                for (int h = 0; h < 2; ++h)
#pragma unroll
                    for (int i = 0; i < 2; ++i) offN[h][i] = offC[h][i];
            }
            *myoffs = (u32x4){offN[0][0], offN[0][1], offN[1][0], offN[1][1]};
        }
        for (int t = 0; t < nt; t += 2) {
            const bool last = (t == nt - 2);
            const int k2 = last ? 0 : t + 2;
            const char* b2 = last ? P.b_ptr(nxt, 0) : P.b_ptr(cur, t + 2);
            const char* b3 = last ? P.b_ptr(nxt, 1) : P.b_ptr(cur, t + 3);
            PG8_LDB(B0, 0, 0); PG8_LDB(B1, 0, 1); PG8_SCHED; PG8_LDA(At, 0, 0); PG8_STAGE_A(PG8_SA(1, 1), 1, offC, t + 1);
            if (last) { const u32x4 v = *myoffs; offC[0][0] = v.x; offC[0][1] = v.y; offC[1][0] = v.z; offC[1][1] = v.w; }
            PG8_WAIT_V(8); PG8_WAIT_L(0); PG8_BAR; PG8_MMA(0, 0, At, B0); PG8_MMA(0, 1, At, B1); PG8_BAR; PG8_SCHED;
            PG8_LDA(At, 0, 1); PG8_STAGE_B(PG8_SB(0, 0), b2); PG8_STAGE_B(PG8_SB(0, 1), b2 + hstepB); PG8_STAGE_A(PG8_SA(0, 0), 0, offC, k2);
            PG8_WAIT_V(8); PG8_WAIT_L(0); PG8_BAR; PG8_MMA(1, 0, At, B0); PG8_MMA(1, 1, At, B1); PG8_BAR; PG8_SCHED;
            PG8_LDB(B0, 1, 0); PG8_LDB(B1, 1, 1); PG8_SCHED; PG8_LDA(At, 1, 0); PG8_STAGE_A(PG8_SA(0, 1), 1, offC, k2);
            PG8_WAIT_V(8); PG8_WAIT_L(0); PG8_BAR; PG8_MMA(0, 0, At, B0); PG8_MMA(0, 1, At, B1); PG8_BAR; PG8_SCHED;
            PG8_LDA(At, 1, 1); PG8_STAGE_B(PG8_SB(1, 0), b3); PG8_STAGE_B(PG8_SB(1, 1), b3 + hstepB); PG8_STAGE_A(PG8_SA(1, 0), 0, offC, k2 + 1);
            PG8_WAIT_V(8); PG8_WAIT_L(0); PG8_BAR; PG8_MMA(1, 0, At, B0); PG8_MMA(1, 1, At, B1); PG8_BAR; PG8_SCHED;
        }
        if constexpr (ALIGN_EPI) { if (wr == 0) PG8_BAR; }
        E(acc, cur, wr, wc, fr, fq);
        if (!has_next) break;
#pragma unroll
        for (int a = 0; a < 2; ++a)
#pragma unroll
            for (int b = 0; b < 2; ++b)
#pragma unroll
                for (int m = 0; m < 4; ++m)
#pragma unroll
                    for (int n = 0; n < 2; ++n) acc[a][b][m][n] = (f32x4){0.f, 0.f, 0.f, 0.f};
        cur = nxt; ++ui;
        if constexpr (ALIGN_EPI) { if (wr == 1) PG8_BAR; }
    }
    PG8_WAIT_V(0);
    if constexpr (!ALIGN_EPI) { if (wr == 0) PG8_BAR; }
    PG8_BAR;
#undef PG8_SA
#undef PG8_SB
#undef PG8_STAGE_A
#undef PG8_STAGE_B
#undef PG8_LDA
#undef PG8_LDB
#undef PG8_MMA
#undef PG8_WAIT_V
#undef PG8_WAIT_L
#undef PG8_BAR
#undef PG8_SCHED
}
}

namespace pg8 {
struct EpiQKV {
    static constexpr bool PERM = true;
    unsigned char* ws; const float* gn; const float* rope;
    __device__ __forceinline__ void operator()(const f32x4 (&acc)[2][2][4][2], const Unit& u, int wr, int wc, int fr, int fq) const {
        const int pn = u.pn, tb = u.pm % 65;
        const bool is_ctx = (tb == 0);
        const bool isV = (pn >= 4) && (wc >= 2);
        const float* gain = gn + (pn < 2 ? 0 : (pn < 4 ? 64 : (pn == 4 ? 128 : 192)));
        const float osc = pn < 4 ? C2 : 1.0f;
        bf16_t* dst = (bf16_t*)(ws + (pn < 4 ? WS_QO : WS_KV));
        const int ldd = pn < 4 ? 1024 : 512, colbase = 256 * (pn < 4 ? pn : pn - 4) + 64 * wc;
        f32x4 gv[2][2];
#pragma unroll
        for (int bj = 0; bj < 2; ++bj)
#pragma unroll
            for (int n = 0; n < 2; ++n) gv[bj][n] = *(const f32x4*)(gain + 32 * bj + 16 * n + 4 * fq);
        asm volatile("" : "+v"(gv[0][0]), "+v"(gv[0][1]), "+v"(gv[1][0]), "+v"(gv[1][1]));
#pragma unroll
        for (int ai = 0; ai < 2; ++ai)
#pragma unroll
            for (int m = 0; m < 4; ++m) {
                const int row = u.pm * BM + ai * HALF + wr * 64 + m * 16 + fr;
                f32x4 v[2][2];
#pragma unroll
                for (int bj = 0; bj < 2; ++bj)
#pragma unroll
                    for (int n = 0; n < 2; ++n) v[bj][n] = acc[ai][bj][m][n];
                if (!isV) {
                    float ss = 0.f;
#pragma unroll
                    for (int bj = 0; bj < 2; ++bj)
#pragma unroll
                        for (int n = 0; n < 2; ++n) { const f32x4 x = v[bj][n]; ss += (x[0] * x[0] + x[1] * x[1]) + (x[2] * x[2] + x[3] * x[3]); }
                    ss += __shfl_xor(ss, 16); ss += __shfl_xor(ss, 32);
                    const float rs = osc / sqrtf(ss * (1.0f / 64.0f) + NORM_EPS);
#pragma unroll
                    for (int bj = 0; bj < 2; ++bj)
#pragma unroll
                        for (int n = 0; n < 2; ++n) v[bj][n] = v[bj][n] * rs * gv[bj][n];
                    if (!is_ctx) {
                        const int pr = (tb - 1) * 4 + 2 * ai + wr, pc = 16 * m + fr;
#pragma unroll
                        for (int bj = 0; bj < 2; ++bj) {
                            const int pos = bj ? pc : pr;
                            const f32x4* rp = (const f32x4*)(rope + (size_t)(pos * 16 + 4 * fq) * 2);
                            const f32x4 r0 = rp[0], r1 = rp[1];
                            const f32x4 cs = (f32x4){r0[0], r0[2], r1[0], r1[2]}, sn = (f32x4){r0[1], r0[3], r1[1], r1[3]};
                            const f32x4 x1 = v[bj][0], x2 = v[bj][1];
                            v[bj][0] = x1 * cs - x2 * sn; v[bj][1] = x2 * cs + x1 * sn;
                        }
                    }
                }
                bf16_t* rowp = dst + (size_t)row * ldd + colbase + 4 * fq;
#pragma unroll
                for (int bj = 0; bj < 2; ++bj)
#pragma unroll
                    for (int n = 0; n < 2; ++n) { u32x2 w; w.x = cvt_pk_bf16(v[bj][n][0], v[bj][n][1]); w.y = cvt_pk_bf16(v[bj][n][2], v[bj][n][3]); *(u32x2*)(rowp + 32 * bj + 16 * n) = w; }
            }
    }
};
struct EpiResid {
    static constexpr bool PERM = false;
    float* XS; const float* modv_l; int goff; float sgn;
    __device__ __forceinline__ void operator()(const f32x4 (&acc)[2][2][4][2], const Unit& u, int wr, int wc, int fr, int fq) const {
        const int mv = (u.pm % 65 == 0) ? 2 : (u.pm / 65);
        const float* g = modv_l + mv * 6144 + goff;
        const int col0 = u.pn * BM + wc * 32 + 4 * fq;
        f32x4 gv[2][2];
#pragma unroll
        for (int bj = 0; bj < 2; ++bj)
#pragma unroll
            for (int n = 0; n < 2; ++n) gv[bj][n] = *(const f32x4*)(g + col0 + bj * HALF + n * 16);
#pragma unroll
        for (int ai = 0; ai < 2; ++ai)
#pragma unroll
            for (int m = 0; m < 4; ++m) {
                float* rowp = XS + (size_t)(u.pm * BM + ai * HALF + wr * 64 + m * 16 + fr) * 1024 + col0;
#pragma unroll
                for (int bj = 0; bj < 2; ++bj)
#pragma unroll
                    for (int n = 0; n < 2; ++n) { f32x4* p = (f32x4*)(rowp + bj * HALF + n * 16); f32x4 x = *p; x = x + (gv[bj][n] * sgn) * acc[ai][bj][m][n]; *p = x; }
            }
    }
};
struct EpiGU {
    static constexpr bool PERM = true;
    bf16_t* ACT; const f32x2* wts;
    __device__ __forceinline__ void operator()(const f32x4 (&acc)[2][2][4][2], const Unit& u, int wr, int wc, int fr, int fq) const {
        const int k = u.pn >= 4 ? 1 : 0, jt = u.pn & 3;
        const int colbase = 512 * k + 128 * jt + 32 * wc + 8 * fq;
#pragma unroll
        for (int ai = 0; ai < 2; ++ai)
#pragma unroll
            for (int m = 0; m < 4; ++m) {
                const int r = ai * HALF + wr * 64 + m * 16 + fr;
                int idx = u.row0 + r; idx = idx < u.ncls ? idx : u.ncls - 1;
                const f32x2 w2 = wts[(size_t)u.cls * CAP + idx];
                const float w = k ? w2[1] : w2[0];
                u32x4 o;
#pragma unroll
                for (int n = 0; n < 2; ++n) {
                    const f32x4 g = acc[ai][0][m][n], up = acc[ai][1][m][n]; float a[4];
#pragma unroll
                    for (int j = 0; j < 4; ++j) { const float sg = g[j] * __builtin_amdgcn_rcpf(1.0f + __builtin_amdgcn_exp2f(-g[j] * LOG2E)); a[j] = w * sg * up[j]; }
                    const unsigned lo = cvt_pk_bf16(a[0], a[1]), hi = cvt_pk_bf16(a[2], a[3]);
                    if (n == 0) { o.x = lo; o.y = hi; } else { o.z = lo; o.w = hi; }
                }
                *(u32x4*)(ACT + (size_t)(u.pm * BM + r) * 1024 + colbase) = o;
            }
    }
};
struct EpiDown {
    static constexpr bool PERM = false;
    float* XS; float* out; const int* tok; const float* modv_l; float sgn;
    __device__ __forceinline__ void operator()(const f32x4 (&acc)[2][2][4][2], const Unit& u, int wr, int wc, int fr, int fq) const {
        const int col0 = u.pn * BM + wc * 32 + 4 * fq;
#pragma unroll
        for (int ai = 0; ai < 2; ++ai)
#pragma unroll
            for (int m = 0; m < 4; ++m) {
                const int idx = u.row0 + ai * HALF + wr * 64 + m * 16 + fr;
                if (idx < u.ncls) {
                    const int t = tok[(size_t)u.cls * CAP + idx];
                    const int b = t >= RB ? 1 : 0, rr = t - b * RB;
                    const int mv = rr < NCTX ? 2 : b;
                    const float* g = modv_l + mv * 6144 + 5120 + col0;
                    const float* src = XS + (size_t)t * 1024 + col0;
                    float* dstp = out ? out + (size_t)(b * SEQ + rr - NCTX) * 1024 + col0 : XS + (size_t)t * 1024 + col0;
#pragma unroll
                    for (int bj = 0; bj < 2; ++bj)
#pragma unroll
                        for (int n = 0; n < 2; ++n) { const int c = bj * HALF + n * 16; f32x4 x = *(const f32x4*)(src + c); const f32x4 gv = *(const f32x4*)(g + c); x = x + (gv * sgn) * acc[ai][bj][m][n]; *(f32x4*)(dstp + c) = x; }
                }
            }
    }
};
}

namespace attn_body {
using bf16 = __hip_bfloat16;
using s16x4 = __attribute__((ext_vector_type(4))) short;
using f32x16 = __attribute__((ext_vector_type(16))) float;
constexpr int D = 64, QP = 1024, KP = 512;
constexpr int NW = 8, QBLK = 32, QB = QBLK * NW, KVBLK = 64;
__device__ __forceinline__ int crow(int r, int hi) { return (r & 3) + 8 * (r >> 2) + 4 * hi; }
#define SBAR() __builtin_amdgcn_sched_barrier(0)
constexpr int NSLOT = 3, SLOTB = 8192;
constexpr int LDS_K = 0, LDS_V = NSLOT * SLOTB, LDS_WS = 2 * NSLOT * SLOTB, LDS_OST = LDS_WS + NW * 64 * 4, LDS_BYTES = LDS_OST + NW * 4096;
__device__ __forceinline__ void glds16(const void* gsrc, unsigned lds_dst) { unsigned keep;
  asm volatile("s_mov_b32 %0, m0\n\ts_mov_b32 m0, %2\n\ts_nop 0\n\tglobal_load_lds_dwordx4 %1, off\n\ts_mov_b32 m0, %0" : "=&s"(keep) : "v"(gsrc), "s"(lds_dst) : "memory"); }
__device__ __forceinline__ float max3f(float a, float b, float c) { float r; asm("v_max3_f32 %0, %1, %2, %3" : "=v"(r) : "v"(a), "v"(b), "v"(c)); return r; }
__device__ __forceinline__ float max2f(float a, float b) { float r; asm("v_max_f32_e32 %0, %1, %2" : "=v"(r) : "v"(a), "v"(b)); return r; }
__device__ __forceinline__ float fadd_s(float a, float b) { float r; asm("v_add_f32_e32 %0, %1, %2" : "=v"(r) : "v"(a), "v"(b)); return r; }
__device__ __forceinline__ float fsub_s(float a, float b) { float r; asm("v_sub_f32_e32 %0, %1, %2" : "=v"(r) : "v"(a), "v"(b)); return r; }
typedef float f32x2_t __attribute__((ext_vector_type(2))); typedef __bf16 bf16x2_t __attribute__((ext_vector_type(2)));
__device__ __forceinline__ unsigned cvtpk_s(float lo, float hi) { f32x2_t v = {lo, hi}; bf16x2_t b = __builtin_convertvector(v, bf16x2_t); return __builtin_bit_cast(unsigned, b); }
#define WAIT_BAR(N) asm volatile("s_waitcnt vmcnt(" #N ") lgkmcnt(0)\n\ts_barrier" ::: "memory")

__device__ __forceinline__ void qkt(f32x16& p0, f32x16& p1, const char* Kslot, const bf16x8* qr, const f32x16& negm, int r32, int hi) {
  const char* kb = Kslot + hi * 1024 + r32 * 16;
  #pragma unroll
  for (int d0 = 0; d0 < 4; ++d0) {
    const bf16x8 b0 = *reinterpret_cast<const bf16x8*>(kb + d0 * 2048);
    const bf16x8 b1 = *reinterpret_cast<const bf16x8*>(kb + d0 * 2048 + 512);
    if (d0 == 0) { p0 = __builtin_amdgcn_mfma_f32_32x32x16_bf16(b0, qr[0], negm, 0, 0, 0); p1 = __builtin_amdgcn_mfma_f32_32x32x16_bf16(b1, qr[0], negm, 0, 0, 0); }
    else { p0 = __builtin_amdgcn_mfma_f32_32x32x16_bf16(b0, qr[d0], p0, 0, 0, 0); p1 = __builtin_amdgcn_mfma_f32_32x32x16_bf16(b1, qr[d0], p1, 0, 0, 0); } }
}
typedef __attribute__((address_space(3))) const char* lds_cptr;
typedef short v4i16_t __attribute__((ext_vector_type(4)));
__device__ __forceinline__ void kload8(bf16x8* kf, lds_cptr kp) {
  kf[0] = *(const LAS bf16x8*)(kp);        kf[1] = *(const LAS bf16x8*)(kp + 512);
  kf[2] = *(const LAS bf16x8*)(kp + 2048); kf[3] = *(const LAS bf16x8*)(kp + 2560);
  kf[4] = *(const LAS bf16x8*)(kp + 4096); kf[5] = *(const LAS bf16x8*)(kp + 4608);
  kf[6] = *(const LAS bf16x8*)(kp + 6144); kf[7] = *(const LAS bf16x8*)(kp + 6656);
}
__device__ __forceinline__ void kload2(bf16x8* kf, lds_cptr kp, int j) { kf[2 * j] = *(const LAS bf16x8*)(kp + j * 2048); kf[2 * j + 1] = *(const LAS bf16x8*)(kp + j * 2048 + 512); }
__device__ __forceinline__ s16x4 vtr(lds_cptr p) { return __builtin_bit_cast(s16x4, __builtin_amdgcn_ds_read_tr16_b64_v4i16((LAS v4i16_t*)p)); }
__device__ __forceinline__ float rowmax(const f32x16& p0, const f32x16& p1) {
  float a = max3f(p0[0], p0[1], p1[0]), b = max3f(p0[2], p0[3], p1[1]); a = max3f(a, p1[2], p1[3]);
  #pragma unroll
  for (int r = 4; r < 16; r += 4) { a = max3f(a, p0[r], p0[r + 1]); b = max3f(b, p0[r + 2], p0[r + 3]); a = max3f(a, p1[r], p1[r + 1]); b = max3f(b, p1[r + 2], p1[r + 3]); }
  const float m = max2f(a, b);
  auto rr = __builtin_amdgcn_permlane32_swap(__float_as_uint(m), __float_as_uint(m), false, false);
  return max2f(__uint_as_float(rr[0]), __uint_as_float(rr[1]));
}
__device__ __forceinline__ void pv(f32x16* o, int vb, bf16x8 pa0, bf16x8 pa1, bf16x8 pa2, bf16x8 pa3) {
  #pragma unroll
  for (int d0 = 0; d0 < 2; ++d0) { s16x4 lo[4], hi[4];
    #pragma unroll
    for (int ks = 0; ks < 4; ++ks) {
      asm volatile("ds_read_b64_tr_b16 %0,%1 offset:%c2" : "=&v"(lo[ks]) : "v"(vb), "i"(d0 * 4096 + ks * 1024) : "memory");
      asm volatile("ds_read_b64_tr_b16 %0,%1 offset:%c2" : "=&v"(hi[ks]) : "v"(vb), "i"(d0 * 4096 + ks * 1024 + 512) : "memory"); }
    asm volatile("s_waitcnt lgkmcnt(0)" ::: "memory"); SBAR();
    #define PK(k) (bf16x8){lo[k][0], lo[k][1], lo[k][2], lo[k][3], hi[k][0], hi[k][1], hi[k][2], hi[k][3]}
    o[d0] = __builtin_amdgcn_mfma_f32_32x32x16_bf16(pa0, PK(0), o[d0], 0, 0, 0);
    o[d0] = __builtin_amdgcn_mfma_f32_32x32x16_bf16(pa1, PK(1), o[d0], 0, 0, 0);
    o[d0] = __builtin_amdgcn_mfma_f32_32x32x16_bf16(pa2, PK(2), o[d0], 0, 0, 0);
    o[d0] = __builtin_amdgcn_mfma_f32_32x32x16_bf16(pa3, PK(3), o[d0], 0, 0, 0);
    #undef PK
  }
}
__device__ __forceinline__ void bandmask(f32x16& p0, f32x16& p1, int t, int mlo, unsigned mspan, int qrel, int hi) {
  const float NEG = -INFINITY; const int kb = 64 * (t - 4) - 128 + 4 * hi - qrel - mlo;
  #pragma unroll
  for (int r = 0; r < 16; ++r) { const int d0 = kb + (r & 3) + 8 * (r >> 2); if ((unsigned)d0 > mspan) p0[r] = NEG; if ((unsigned)(d0 + 32) > mspan) p1[r] = NEG; }
}
#define ATTN_STORE16(p, v) (*(u32x4*)(p) = (v))

template <int MODE, int THRL> __device__ __forceinline__ void attn_unit(long qrow, long kvrow, int q0, int qcol, int kcol, int vcol, int NT, float sink2, const bf16* Q, const bf16* __restrict__ KVb, bf16* O, char* shm) {
  int tid_ = threadIdx.x; asm volatile("" : "+v"(tid_));
  const int tid = tid_, lane = tid & 63, r32 = lane & 31, hi = lane >> 5; const int wid = __builtin_amdgcn_readfirstlane(tid >> 6);
  const bf16* Qw = Q + (qrow + wid * QBLK) * QP + qcol;
  const bf16* Kh = KVb + kvrow * KP + kcol, *Vh = KVb + kvrow * KP + vcol;
  const unsigned lds0 = (unsigned)(uintptr_t)shm;
  float* wsf = (float*)(shm + LDS_WS) + wid * 64;
  const bf16* ksrc = Kh + (long)lane * KP + wid * 8;
  const bf16* vsrc = Vh + (long)(16 * (wid & 3) + (lane >> 2)) * KP + (wid >> 2) * 32 + (lane & 3) * 8;
  const unsigned kdst = lds0 + LDS_K + wid * 1024, vdst = lds0 + LDS_V + wid * 1024;
  #define ROWOFF(t) ((long)(MODE == 1 ? (64 * (t) + ((t) >= 4 ? (q0 - 128) : 0)) : 64 * (t)))
  #define DMA_K(t, slot) glds16(ksrc + ROWOFF(t) * KP, (unsigned)__builtin_amdgcn_readfirstlane(kdst + (slot)))
  #define DMA_V(t, slot) glds16(vsrc + ROWOFF(t) * KP, (unsigned)__builtin_amdgcn_readfirstlane(vdst + (slot)))
  const int vb0 = (int)(lds0 + LDS_V) + ((lane >> 4) & 1) * 32 + (lane & 3) * 8 + (4 * hi + ((lane & 15) >> 2)) * 64;
  const char* Kbase = shm + LDS_K; bf16x8 kf[8];
  const lds_cptr shm3 = (lds_cptr)shm; const lds_cptr kp0 = shm3 + LDS_K + hi * 1024 + r32 * 16; const lds_cptr vp0 = shm3 + LDS_V + ((lane >> 4) & 1) * 32 + (lane & 3) * 8 + (4 * hi + ((lane & 15) >> 2)) * 64;
  DMA_K(0, 0); DMA_V(0, 0); DMA_K(1, SLOTB);
  bf16x8 qr[4];
  #pragma unroll
  for (int d0 = 0; d0 < 4; ++d0) qr[d0] = *reinterpret_cast<const bf16x8*>(&Qw[(long)r32 * QP + d0 * 16 + hi * 8]);
  float mhat = 0.f, l_reg = 0.f; f32x16 o[2]; o[0] = f32x16{}; o[1] = f32x16{}; f32x16 negm = f32x16{}; asm volatile("" : "+v"(negm));
  const int qrel = wid * QBLK + r32;
  int mlo = -128, mhi = 128;
  if (MODE == 1) { const int qi = q0 + qrel; mlo = (-qi > -128) ? -qi : -128; mhi = (SEQ - 1 - qi < 128) ? (SEQ - 1 - qi) : 128; }
  const unsigned mspan = (unsigned)(mhi - mlo);
  #define CMASK(P0, P1, t) do { if (MODE == 1) { if ((t) >= 4) bandmask(P0, P1, (t), mlo, mspan, qrel, hi); } } while (0)
  bool resc = false;
  #define START(P0, P1) do { const float rm = rowmax(P0, P1); resc = false; \
    { const float dl = rm; mhat = fadd_s(mhat, dl); \
      _Pragma("unroll") for (int r = 0; r < 16; ++r) { P0[r] = fsub_s(P0[r], dl); P1[r] = fsub_s(P1[r], dl); } \
      _Pragma("unroll") for (int r = 0; r < 16; ++r) negm[r] = -mhat; asm volatile("" : "+v"(negm)); } \
    _Pragma("unroll") for (int r = 0; r < 16; ++r) P0[r] = __builtin_amdgcn_exp2f(P0[r]); } while (0)
  #define RESC() do { if (resc) { asm volatile("s_waitcnt lgkmcnt(0)" ::: "memory"); \
      _Pragma("unroll") for (int d_ = 0; d_ < 2; ++d_) _Pragma("unroll") for (int r = 0; r < 16; ++r) o[d_][r] *= wsf[crow(r, hi)]; } } while (0)
  f32x16 pA0, pA1, pB0, pB1;
  int sl_prev = 0, sl_cur = 0, sl_next = SLOTB;
  #define ROT() do { sl_prev = sl_cur; sl_cur = sl_next; sl_next = (sl_next == (NSLOT - 1) * SLOTB) ? 0 : sl_next + SLOTB; } while (0)
  DMA_K(2, 2 * SLOTB);
  WAIT_BAR(3);
  qkt(pA0, pA1, Kbase, qr, negm, r32, hi); asm volatile("s_nop 15\n\ts_nop 7" : "+v"(pA0), "+v"(pA1)); CMASK(pA0, pA1, 0);
  START(pA0, pA1);
  _Pragma("unroll") for (int r = 0; r < 16; ++r) pA1[r] = __builtin_amdgcn_exp2f(pA1[r]);
  WAIT_BAR(0);
  DMA_K(3, 0); DMA_V(1, SLOTB);
  ROT();
  kload8(kf, kp0 + sl_cur);
  WAIT_BAR(2);
  s16x4 vlo[8], vhi[8]; u32x4 pw0, pw1, pw2, pw3;
  #define PKW(P, B) cvtpk_s(P[B], P[B + 1])
  #define PAF(k) __builtin_bit_cast(bf16x8, pw##k)
  #define VFR(i) (bf16x8){vlo[i][0], vlo[i][1], vlo[i][2], vlo[i][3], vhi[i][0], vhi[i][1], vhi[i][2], vhi[i][3]}
  #define PIN(x) asm volatile("" : "+v"(x))
  #define MX3(a, b, c) __builtin_fmaxf(__builtin_fmaxf((a), (b)), (c))
  #define GAPA(MF, A0, A1, A2, A3, W0, W1, PW) do { MF; sacc += A0; sacc += A1; sacc += A2; sacc += A3; PIN(sacc); W0; W1; PIN(PW); SBAR(); } while (0)
  #define EX(v) __builtin_amdgcn_exp2f(v)
  #define GAPB(MF, X, B) do { MF; X[B] = EX(X[B]); X[B + 1] = EX(X[B + 1]); X[B + 2] = EX(X[B + 2]); X[B + 3] = EX(X[B + 3]); PIN(X); SBAR(); } while (0)
  #define VRD(i) do { vlo[i] = vtr(vp_ + (((i) >> 2) * 4096 + ((i) & 3) * 1024)); vhi[i] = vtr(vp_ + (((i) >> 2) * 4096 + ((i) & 3) * 1024 + 512)); } while (0)
  #define KRD(G, j) do { if (G) { kload2(kf, kp0 + sl_next, j); SBAR(); } } while (0)
  #define STEP(C0, C1, P0, P1, t, GK, GV, GL) do { SBAR(); \
    const lds_cptr vp_ = vp0 + sl_prev; \
    VRD(0); SBAR(); float sacc = (P0[0] + P0[1]); \
    GAPA(C0 = __builtin_amdgcn_mfma_f32_32x32x16_bf16(kf[0], qr[0], negm, 0, 0, 0), P0[2], P0[3], P0[4], P0[5],     pw0[0] = PKW(P0, 0), pw0[1] = PKW(P0, 2), pw0); \
    VRD(4); SBAR(); GAPA(C1 = __builtin_amdgcn_mfma_f32_32x32x16_bf16(kf[1], qr[0], negm, 0, 0, 0), P0[6], P0[7], P0[8], P0[9],     pw0[2] = PKW(P0, 4), pw0[3] = PKW(P0, 6), pw0); \
    VRD(1); SBAR(); GAPA(C0 = __builtin_amdgcn_mfma_f32_32x32x16_bf16(kf[2], qr[1], C0, 0, 0, 0),   P0[10], P0[11], P0[12], P0[13], pw1[0] = PKW(P0, 8), pw1[1] = PKW(P0, 10), pw1); \
    VRD(5); SBAR(); GAPA(C1 = __builtin_amdgcn_mfma_f32_32x32x16_bf16(kf[3], qr[1], C1, 0, 0, 0),   P0[14], P0[15], P1[0], P1[1],   pw1[2] = PKW(P0, 12), pw1[3] = PKW(P0, 14), pw1); \
    VRD(2); SBAR(); GAPA(C0 = __builtin_amdgcn_mfma_f32_32x32x16_bf16(kf[4], qr[2], C0, 0, 0, 0),   P1[2], P1[3], P1[4], P1[5],     pw2[0] = PKW(P1, 0), pw2[1] = PKW(P1, 2), pw2); \
    VRD(6); SBAR(); GAPA(C1 = __builtin_amdgcn_mfma_f32_32x32x16_bf16(kf[5], qr[2], C1, 0, 0, 0),   P1[6], P1[7], P1[8], P1[9],     pw2[2] = PKW(P1, 4), pw2[3] = PKW(P1, 6), pw2); \
    VRD(3); SBAR(); GAPA(C0 = __builtin_amdgcn_mfma_f32_32x32x16_bf16(kf[6], qr[3], C0, 0, 0, 0),   P1[10], P1[11], P1[12], P1[13], pw3[0] = PKW(P1, 8), pw3[1] = PKW(P1, 10), pw3); \
    VRD(7); SBAR(); GAPA(C1 = __builtin_amdgcn_mfma_f32_32x32x16_bf16(kf[7], qr[3], C1, 0, 0, 0),   P1[14], P1[15], 0.f, 0.f,       pw3[2] = PKW(P1, 12), pw3[3] = PKW(P1, 14), pw3); \
    l_reg += sacc; \
    if (GK) { DMA_K((t) + 3, sl_cur); } if (GV) { DMA_V((t) + 1, sl_next); } \
    CMASK(C0, C1, t); \
    { float a = MX3(C0[0], C0[1], C1[0]), b = MX3(C0[2], C0[3], C1[1]); a = MX3(a, C1[2], C1[3]); \
      _Pragma("unroll") for (int r = 4; r < 16; r += 4) { a = MX3(a, C0[r], C0[r + 1]); b = MX3(b, C0[r + 2], C0[r + 3]); a = MX3(a, C1[r], C1[r + 1]); b = MX3(b, C1[r + 2], C1[r + 3]); } \
      float rm = __builtin_fmaxf(a, b); { auto rr = __builtin_amdgcn_permlane32_swap(__float_as_uint(rm), __float_as_uint(rm), false, false); rm = __builtin_fmaxf(__uint_as_float(rr[0]), __uint_as_float(rr[1])); } \
      resc = false; \
      if (__builtin_expect(__any(rm > (float)THRL), 0)) { const float dl = __builtin_fmaxf(rm, 0.f); mhat += dl; \
        _Pragma("unroll") for (int r = 0; r < 16; ++r) { C0[r] -= dl; C1[r] -= dl; } \
        _Pragma("unroll") for (int r = 0; r < 16; ++r) negm[r] = -mhat; asm volatile("" : "+v"(negm)); \
        const float f = __builtin_amdgcn_exp2f(-dl); l_reg *= f; if (hi == 0) wsf[r32] = f; resc = true; } } \
    SBAR(); \
    GAPB(o[0] = __builtin_amdgcn_mfma_f32_32x32x16_bf16(PAF(0), VFR(0), o[0], 0, 0, 0), C0, 0); \
    GAPB(o[1] = __builtin_amdgcn_mfma_f32_32x32x16_bf16(PAF(0), VFR(4), o[1], 0, 0, 0), C0, 4); \
    KRD(GL, 0); GAPB(o[0] = __builtin_amdgcn_mfma_f32_32x32x16_bf16(PAF(1), VFR(1), o[0], 0, 0, 0), C0, 8); \
    KRD(GL, 1); GAPB(o[1] = __builtin_amdgcn_mfma_f32_32x32x16_bf16(PAF(1), VFR(5), o[1], 0, 0, 0), C0, 12); \
    KRD(GL, 2); GAPB(o[0] = __builtin_amdgcn_mfma_f32_32x32x16_bf16(PAF(2), VFR(2), o[0], 0, 0, 0), C1, 0); \
    KRD(GL, 3); GAPB(o[1] = __builtin_amdgcn_mfma_f32_32x32x16_bf16(PAF(2), VFR(6), o[1], 0, 0, 0), C1, 4); \
    GAPB(o[0] = __builtin_amdgcn_mfma_f32_32x32x16_bf16(PAF(3), VFR(3), o[0], 0, 0, 0), C1, 8); \
    GAPB(o[1] = __builtin_amdgcn_mfma_f32_32x32x16_bf16(PAF(3), VFR(7), o[1], 0, 0, 0), C1, 12); \
    } while (0)
  int t = 1;
  for (; t + 5 < NT; t += 2) {
    STEP(pB0, pB1, pA0, pA1, t, true, true, true);     WAIT_BAR(2); RESC(); ROT();
    STEP(pA0, pA1, pB0, pB1, t + 1, true, true, true);   WAIT_BAR(2); RESC(); ROT();
  }
  #define ENDW(tt) do { if ((tt) + 3 < NT) { WAIT_BAR(2); } else if ((tt) + 2 < NT) { WAIT_BAR(1); } else { WAIT_BAR(0); } } while (0)
  for (; t + 1 < NT; t += 2) {
    STEP(pB0, pB1, pA0, pA1, t, (t + 3 < NT), (t + 1 < NT), (t + 1 < NT));       ENDW(t);   RESC(); ROT();
    STEP(pA0, pA1, pB0, pB1, t + 1, (t + 4 < NT), (t + 2 < NT), (t + 2 < NT));     ENDW(t + 1); RESC(); ROT();
  }
  STEP(pB0, pB1, pA0, pA1, NT - 1, false, false, false); RESC();
  { float sacc = pB0[0] + pB0[1]; _Pragma("unroll") for (int r = 2; r < 16; ++r) sacc += pB0[r]; _Pragma("unroll") for (int r = 0; r < 16; ++r) sacc += pB1[r]; l_reg += sacc;
    pw0 = (u32x4){PKW(pB0, 0), PKW(pB0, 2), PKW(pB0, 4), PKW(pB0, 6)}; pw1 = (u32x4){PKW(pB0, 8), PKW(pB0, 10), PKW(pB0, 12), PKW(pB0, 14)}; pw2 = (u32x4){PKW(pB1, 0), PKW(pB1, 2), PKW(pB1, 4), PKW(pB1, 6)}; pw3 = (u32x4){PKW(pB1, 8), PKW(pB1, 10), PKW(pB1, 12), PKW(pB1, 14)};
    SBAR(); pv(o, vb0 + sl_cur, PAF(0), PAF(1), PAF(2), PAF(3)); }
  #undef PKW
  #undef PAF
  #undef VFR
  #undef PIN
  #undef MX3
  #undef GAPA
  #undef GAPB
  #undef EX
  #undef VRD
  #undef KRD
  #undef STEP
  #undef ENDW
  { auto rr = __builtin_amdgcn_permlane32_swap(__float_as_uint(l_reg), __float_as_uint(l_reg), false, false); l_reg = __uint_as_float(rr[0]) + __uint_as_float(rr[1]); }
  l_reg += __builtin_amdgcn_exp2f(sink2 - mhat);
  if (hi == 0) wsf[32 + r32] = l_reg; asm volatile("s_waitcnt lgkmcnt(0)" ::: "memory");
  float rli[16];
  #pragma unroll
  for (int r = 0; r < 16; ++r) rli[r] = __builtin_amdgcn_rcpf(wsf[32 + crow(r, hi)]);
  bf16* Ow = O + (qrow + wid * QBLK) * QP + qcol;
  { bf16* stg = (bf16*)(shm + LDS_OST) + wid * 2048;
    #pragma unroll
    for (int r = 0; r < 16; ++r) { const int orow = crow(r, hi);
      #pragma unroll
      for (int d0 = 0; d0 < 2; ++d0) stg[orow * 64 + d0 * 32 + r32] = __float2bfloat16(o[d0][r] * rli[r]); }
    asm volatile("s_waitcnt lgkmcnt(0)" ::: "memory");
    #pragma unroll
    for (int i = 0; i < 4; ++i) { const int row = i * 8 + (lane >> 3), ch = lane & 7; const u32x4 v = *(const u32x4*)(stg + row * 64 + ch * 8); ATTN_STORE16(Ow + (long)row * QP + ch * 8, v); } }
  asm volatile("s_waitcnt lgkmcnt(0)\n\ts_barrier" ::: "memory");
  #undef DMA_K
  #undef DMA_V
  #undef ROWOFF
  #undef CMASK
  #undef START
  #undef RESC
  #undef ROT
}
template <int MODE> __device__ __forceinline__ void attn_unit_sb(long qrow, long kvrow, int q0, int qcol, int kcol, int vcol, int NT, float sink2, float bound, const bf16* Q, const bf16* __restrict__ KVb, bf16* O, char* shm) {
  int tid_ = threadIdx.x; asm volatile("" : "+v"(tid_));
  const int tid = tid_, lane = tid & 63, r32 = lane & 31, hi = lane >> 5; const int wid = __builtin_amdgcn_readfirstlane(tid >> 6);
  const bf16* Qw = Q + (qrow + wid * QBLK) * QP + qcol;
  const bf16* Kh = KVb + kvrow * KP + kcol, *Vh = KVb + kvrow * KP + vcol;
  const unsigned lds0 = (unsigned)(uintptr_t)shm;
  const bf16* ksrc = Kh + (long)lane * KP + wid * 8;
  const bf16* vsrc = Vh + (long)(16 * (wid & 3) + (lane >> 2)) * KP + (wid >> 2) * 32 + (lane & 3) * 8;
  const unsigned kdst = lds0 + LDS_K + wid * 1024, vdst = lds0 + LDS_V + wid * 1024;
  #define ROWOFF(t) ((long)(MODE == 1 ? (64 * (t) + ((t) >= 4 ? (q0 - 128) : 0)) : 64 * (t)))
  #define DMA_K(t, slot) glds16(ksrc + ROWOFF(t) * KP, (unsigned)__builtin_amdgcn_readfirstlane(kdst + (slot)))
  #define DMA_V(t, slot) glds16(vsrc + ROWOFF(t) * KP, (unsigned)__builtin_amdgcn_readfirstlane(vdst + (slot)))
  const int vb0 = (int)(lds0 + LDS_V) + ((lane >> 4) & 1) * 32 + (lane & 3) * 8 + (4 * hi + ((lane & 15) >> 2)) * 64;
  const char* Kbase = shm + LDS_K; bf16x8 kf[8];
  const lds_cptr shm3 = (lds_cptr)shm; const lds_cptr kp0 = shm3 + LDS_K + hi * 1024 + r32 * 16; const lds_cptr vp0 = shm3 + LDS_V + ((lane >> 4) & 1) * 32 + (lane & 3) * 8 + (4 * hi + ((lane & 15) >> 2)) * 64;
  DMA_K(0, 0); DMA_V(0, 0); DMA_K(1, SLOTB);
  bf16x8 qr[4];
  #pragma unroll
  for (int d0 = 0; d0 < 4; ++d0) qr[d0] = *reinterpret_cast<const bf16x8*>(&Qw[(long)r32 * QP + d0 * 16 + hi * 8]);
  f32x16 o[2]; o[0] = f32x16{}; o[1] = f32x16{}; f32x16 osum = f32x16{};
  const f32x16 negm = f32x16{};
  bf16x8 ones;
  #pragma unroll
  for (int i = 0; i < 8; ++i) ones[i] = (short)0x3F80;
  asm volatile("" : "+v"(ones));
  const int qrel = wid * QBLK + r32;
  int mlo = -128, mhi = 128;
  if (MODE == 1) { const int qi = q0 + qrel; mlo = (-qi > -128) ? -qi : -128; mhi = (SEQ - 1 - qi < 128) ? (SEQ - 1 - qi) : 128; }
  const unsigned mspan = (unsigned)(mhi - mlo);
  #define CMASK(P0, P1, t) do { if (MODE == 1) { if ((t) >= 4) bandmask(P0, P1, (t), mlo, mspan, qrel, hi); } } while (0)
  f32x16 pA0, pA1, pB0, pB1;
  int sl_prev = 0, sl_cur = 0, sl_next = SLOTB;
  #define ROT() do { sl_prev = sl_cur; sl_cur = sl_next; sl_next = (sl_next == (NSLOT - 1) * SLOTB) ? 0 : sl_next + SLOTB; } while (0)
  DMA_K(2, 2 * SLOTB);
  WAIT_BAR(3);
  qkt(pA0, pA1, Kbase, qr, negm, r32, hi); asm volatile("s_nop 15\n\ts_nop 7" : "+v"(pA0), "+v"(pA1)); CMASK(pA0, pA1, 0);
  _Pragma("unroll") for (int r = 0; r < 16; ++r) { pA0[r] = __builtin_amdgcn_exp2f(pA0[r]); pA1[r] = __builtin_amdgcn_exp2f(pA1[r]); }
  WAIT_BAR(0);
  DMA_K(3, 0); DMA_V(1, SLOTB);
  ROT();
  kload8(kf, kp0 + sl_cur);
  WAIT_BAR(2);
  s16x4 vlo[8], vhi[8]; u32x4 pw0, pw1, pw2, pw3;
  #define PKW(P, B) cvtpk_s(P[B], P[B + 1])
  #define PAF(k) __builtin_bit_cast(bf16x8, pw##k)
  #define VFR(i) (bf16x8){vlo[i][0], vlo[i][1], vlo[i][2], vlo[i][3], vhi[i][0], vhi[i][1], vhi[i][2], vhi[i][3]}
  #define PIN(x) asm volatile("" : "+v"(x))
  #define GAPA(MF, W0, W1, PW) do { MF; W0; W1; PIN(PW); SBAR(); } while (0)
  #define OSUM(k) do { osum = __builtin_amdgcn_mfma_f32_32x32x16_bf16(PAF(k), ones, osum, 0, 0, 0); SBAR(); } while (0)
  #define EX(v) __builtin_amdgcn_exp2f(v)
  #define GAPB(MF, X, B) do { MF; X[B] = EX(X[B]); X[B + 1] = EX(X[B + 1]); X[B + 2] = EX(X[B + 2]); X[B + 3] = EX(X[B + 3]); PIN(X); SBAR(); } while (0)
  #define VRD(i) do { vlo[i] = vtr(vp_ + (((i) >> 2) * 4096 + ((i) & 3) * 1024)); vhi[i] = vtr(vp_ + (((i) >> 2) * 4096 + ((i) & 3) * 1024 + 512)); } while (0)
  #define KRD(G, j) do { if (G) { kload2(kf, kp0 + sl_next, j); SBAR(); } } while (0)
  #define STEP(C0, C1, P0, P1, t, GK, GV, GL) do { SBAR(); \
    const lds_cptr vp_ = vp0 + sl_prev; \
    VRD(0); SBAR(); GAPA(C0 = __builtin_amdgcn_mfma_f32_32x32x16_bf16(kf[0], qr[0], negm, 0, 0, 0), pw0[0] = PKW(P0, 0), pw0[1] = PKW(P0, 2), pw0); \
    VRD(4); SBAR(); GAPA(C1 = __builtin_amdgcn_mfma_f32_32x32x16_bf16(kf[1], qr[0], negm, 0, 0, 0), pw0[2] = PKW(P0, 4), pw0[3] = PKW(P0, 6), pw0); \
    VRD(1); SBAR(); GAPA(C0 = __builtin_amdgcn_mfma_f32_32x32x16_bf16(kf[2], qr[1], C0, 0, 0, 0),   pw1[0] = PKW(P0, 8), pw1[1] = PKW(P0, 10), pw1); \
    OSUM(0); \
    VRD(5); SBAR(); GAPA(C1 = __builtin_amdgcn_mfma_f32_32x32x16_bf16(kf[3], qr[1], C1, 0, 0, 0),   pw1[2] = PKW(P0, 12), pw1[3] = PKW(P0, 14), pw1); \
    VRD(2); SBAR(); GAPA(C0 = __builtin_amdgcn_mfma_f32_32x32x16_bf16(kf[4], qr[2], C0, 0, 0, 0),   pw2[0] = PKW(P1, 0), pw2[1] = PKW(P1, 2), pw2); \
    OSUM(1); \
    VRD(6); SBAR(); GAPA(C1 = __builtin_amdgcn_mfma_f32_32x32x16_bf16(kf[5], qr[2], C1, 0, 0, 0),   pw2[2] = PKW(P1, 4), pw2[3] = PKW(P1, 6), pw2); \
    VRD(3); SBAR(); GAPA(C0 = __builtin_amdgcn_mfma_f32_32x32x16_bf16(kf[6], qr[3], C0, 0, 0, 0),   pw3[0] = PKW(P1, 8), pw3[1] = PKW(P1, 10), pw3); \
    OSUM(2); \
    VRD(7); SBAR(); GAPA(C1 = __builtin_amdgcn_mfma_f32_32x32x16_bf16(kf[7], qr[3], C1, 0, 0, 0),   pw3[2] = PKW(P1, 12), pw3[3] = PKW(P1, 14), pw3); \
    if (GK) { DMA_K((t) + 3, sl_cur); } if (GV) { DMA_V((t) + 1, sl_next); } \
    OSUM(3); \
    CMASK(C0, C1, t); \
    SBAR(); \
    GAPB(o[0] = __builtin_amdgcn_mfma_f32_32x32x16_bf16(PAF(0), VFR(0), o[0], 0, 0, 0), C0, 0); \
    GAPB(o[1] = __builtin_amdgcn_mfma_f32_32x32x16_bf16(PAF(0), VFR(4), o[1], 0, 0, 0), C0, 4); \
    KRD(GL, 0); GAPB(o[0] = __builtin_amdgcn_mfma_f32_32x32x16_bf16(PAF(1), VFR(1), o[0], 0, 0, 0), C0, 8); \
    KRD(GL, 1); GAPB(o[1] = __builtin_amdgcn_mfma_f32_32x32x16_bf16(PAF(1), VFR(5), o[1], 0, 0, 0), C0, 12); \
    KRD(GL, 2); GAPB(o[0] = __builtin_amdgcn_mfma_f32_32x32x16_bf16(PAF(2), VFR(2), o[0], 0, 0, 0), C1, 0); \
    KRD(GL, 3); GAPB(o[1] = __builtin_amdgcn_mfma_f32_32x32x16_bf16(PAF(2), VFR(6), o[1], 0, 0, 0), C1, 4); \
    GAPB(o[0] = __builtin_amdgcn_mfma_f32_32x32x16_bf16(PAF(3), VFR(3), o[0], 0, 0, 0), C1, 8); \
    GAPB(o[1] = __builtin_amdgcn_mfma_f32_32x32x16_bf16(PAF(3), VFR(7), o[1], 0, 0, 0), C1, 12); \
    } while (0)
  int t = 1;
  for (; t + 5 < NT; t += 2) {
    STEP(pB0, pB1, pA0, pA1, t, true, true, true);     WAIT_BAR(2); ROT();
    STEP(pA0, pA1, pB0, pB1, t + 1, true, true, true);   WAIT_BAR(2); ROT();
  }
  #define ENDW(tt) do { if ((tt) + 3 < NT) { WAIT_BAR(2); } else if ((tt) + 2 < NT) { WAIT_BAR(1); } else { WAIT_BAR(0); } } while (0)
  for (; t + 1 < NT; t += 2) {
    STEP(pB0, pB1, pA0, pA1, t, (t + 3 < NT), (t + 1 < NT), (t + 1 < NT));       ENDW(t);   ROT();
    STEP(pA0, pA1, pB0, pB1, t + 1, (t + 4 < NT), (t + 2 < NT), (t + 2 < NT));     ENDW(t + 1); ROT();
  }
  STEP(pB0, pB1, pA0, pA1, NT - 1, false, false, false);
  { pw0 = (u32x4){PKW(pB0, 0), PKW(pB0, 2), PKW(pB0, 4), PKW(pB0, 6)}; pw1 = (u32x4){PKW(pB0, 8), PKW(pB0, 10), PKW(pB0, 12), PKW(pB0, 14)}; pw2 = (u32x4){PKW(pB1, 0), PKW(pB1, 2), PKW(pB1, 4), PKW(pB1, 6)}; pw3 = (u32x4){PKW(pB1, 8), PKW(pB1, 10), PKW(pB1, 12), PKW(pB1, 14)};
    SBAR(); OSUM(0); OSUM(1); OSUM(2); OSUM(3); pv(o, vb0 + sl_cur, PAF(0), PAF(1), PAF(2), PAF(3)); }
  #undef PKW
  #undef PAF
  #undef VFR
  #undef PIN
  #undef GAPA
  #undef OSUM
  #undef GAPB
  #undef EX
  #undef VRD
  #undef KRD
  #undef STEP
  #undef ENDW
  const float sterm = __builtin_amdgcn_exp2f(sink2);
  float rli[16];
  #pragma unroll
  for (int r = 0; r < 16; ++r) rli[r] = __builtin_amdgcn_rcpf(osum[r] + sterm);
  bf16* Ow = O + (qrow + wid * QBLK) * QP + qcol;
  { bf16* stg = (bf16*)(shm + LDS_OST) + wid * 2048;
    #pragma unroll
    for (int r = 0; r < 16; ++r) { const int orow = crow(r, hi);
      #pragma unroll
      for (int d0 = 0; d0 < 2; ++d0) stg[orow * 64 + d0 * 32 + r32] = __float2bfloat16(o[d0][r] * rli[r]); }
    asm volatile("s_waitcnt lgkmcnt(0)" ::: "memory");
    #pragma unroll
    for (int i = 0; i < 4; ++i) { const int row = i * 8 + (lane >> 3), ch = lane & 7; const u32x4 v = *(const u32x4*)(stg + row * 64 + ch * 8); ATTN_STORE16(Ow + (long)row * QP + ch * 8, v); } }
  asm volatile("s_waitcnt lgkmcnt(0)\n\ts_barrier" ::: "memory");
  #undef DMA_K
  #undef DMA_V
  #undef ROWOFF
  #undef CMASK
  #undef ROT
}
constexpr int ATTN_LDS_BYTES = LDS_BYTES;
#undef SBAR
#undef WAIT_BAR
}

struct Args { const float* in[20]; float* out; unsigned char* ws; int ph_lo, ph_hi; };
typedef const Args __attribute__((address_space(4)))* kargp_t;
__device__ __forceinline__ kargp_t kargs() { auto p = __builtin_amdgcn_kernarg_segment_ptr(); asm volatile("" : "+s"(p)); return (kargp_t)p; }
enum { I_X = 0, I_C, I_CTX, I_CCTX, I_ADAW, I_ADAB, I_GATTN, I_GFFN, I_WIN, I_QNG, I_KNG, I_QNL, I_KNL, I_SINK, I_WOUT, I_RW, I_RB, I_WGATE, I_WUP, I_WDOWN };
struct Frame {
    LAS unsigned char* lds; volatile LAS unsigned* MISC;
    int tid, lane, wave, vcu, G;
};
#define WSP(T, off) ((T*)(kargs()->ws + (off)))
__device__ const float ROPE_INV[16] = {1.000000000e+00f, 5.623413324e-01f, 3.162277639e-01f, 1.778279394e-01f, 1.000000015e-01f, 5.623413250e-02f, 3.162277490e-02f, 1.778279431e-02f,
                                       9.999999776e-03f, 5.623413250e-03f, 3.162277630e-03f, 1.778279431e-03f, 1.000000047e-03f, 5.623413017e-04f, 3.162277571e-04f, 1.778279402e-04f};

template <int KIND> __device__ __forceinline__ int dst_row(int n) {
    if (KIND == 0) return n;
    if (KIND == 2) return ((n >> 7) << 8) + (n & 127);
    if (KIND == 3) return ((n >> 7) << 8) + 128 + (n & 127);
    int tile, wc;
    if (n < 512) { const int h = n >> 6; tile = h >> 2; wc = h & 3; }
    else if (n < 640) { tile = 4; wc = (n - 512) >> 6; }
    else if (n < 768) { tile = 4; wc = 2 + ((n - 640) >> 6); }
    else if (n < 1280) { const int h = (n - 768) >> 6; tile = 2 + (h >> 2); wc = h & 3; }
    else if (n < 1408) { tile = 5; wc = (n - 1280) >> 6; }
    else { tile = 5; wc = 2 + ((n - 1408) >> 6); }
    const int d = n & 63, bj = d >> 5, dd = d & 31, np = dd >> 4, f = dd & 15, fq = f >> 2, j = f & 3;
    return 256 * tile + 128 * bj + 32 * wc + 8 * fq + 4 * np + j;
}
template <int KIND> __device__ __forceinline__ void p0_transpose_item(const float* W, int N, bf16_t* WT, int Kd, LAS float* scr, int kb, int nb, int lane) {
    const int k0 = 64 * kb, n0 = 32 * nb;
#pragma unroll 8
    for (int i = 0; i < 32; ++i) { const int kk = 2 * i + (lane >> 5); scr[kk * 33 + (lane & 31)] = W[(size_t)(k0 + kk) * N + n0 + (lane & 31)]; }
    LDS_WAIT(); asm volatile("" ::: "memory");
    const int c = lane & 7;
#pragma unroll
    for (int j = 0; j < 4; ++j) { const int n = (lane >> 3) + 8 * j; const LAS float* s = scr + (8 * c) * 33 + n;
        u32x4 o; o.x = pk2(s[0 * 33], s[1 * 33]); o.y = pk2(s[2 * 33], s[3 * 33]); o.z = pk2(s[4 * 33], s[5 * 33]); o.w = pk2(s[6 * 33], s[7 * 33]);
        *(GAS u32x4*)(WT + (size_t)dst_row<KIND>(n0 + n) * Kd + k0 + 8 * c) = o; }
    LDS_WAIT(); asm volatile("" ::: "memory");
}
__device__ __forceinline__ void sincos_d(float ang, float& cs, float& sn) {
    const double x = (double)ang; const double kq = __builtin_rint(x * 0.63661977236758134308);
    const double r = (x - kq * 1.5707963267948966192) - kq * 6.123233995736766036e-17, r2 = r * r;
    const double s = r * (1.0 + r2 * (-1.0 / 6 + r2 * (1.0 / 120 + r2 * (-1.0 / 5040 + r2 * (1.0 / 362880 + r2 * (-1.0 / 39916800 + r2 * (1.0 / 6227020800.0)))))));
    const double c = 1.0 + r2 * (-0.5 + r2 * (1.0 / 24 + r2 * (-1.0 / 720 + r2 * (1.0 / 40320 + r2 * (-1.0 / 3628800 + r2 * (1.0 / 479001600.0 + r2 * (-1.0 / 87178291200.0)))))));
    const int q = ((int)kq) & 3;
    const double cc = (q == 0) ? c : (q == 1) ? -s : (q == 2) ? -c : s;
    const double ss = (q == 0) ? s : (q == 1) ? c : (q == 2) ? -s : -c;
    cs = (float)cc; sn = (float)ss;
}
__device__ __forceinline__ void p0_prologue(Frame& F) {
    const int gw = F.vcu * NWAVES + F.wave, NGW = F.G * NWAVES;
    {
        const float* c = kargs()->in[I_C]; const float* cctx = kargs()->in[I_CCTX]; const float* ada_w = kargs()->in[I_ADAW]; const float* ada_b = kargs()->in[I_ADAB];
        float* modv = WSP(float, WS_MODV);
        LAS float* sv = (LAS float*)(F.lds);
        LAS float* part = (LAS float*)(F.lds + 16384);
        for (int i = F.tid; i < 3072; i += NWAVES * 64) { const int v = i >> 10, k = i & 1023; const float cv = v < 2 ? c[v * 1024 + k] : cctx[k]; sv[i] = cv / (1.0f + expf(-cv)); }
        __syncthreads();
        for (int tile = F.vcu; tile < NLAYER * 96; tile += F.G) {
            const int l = tile / 96, c0 = (tile % 96) * 64;
            const float* W = ada_w + (size_t)l * 1024 * 6144 + c0 + F.lane;
            float a0 = 0.f, a1 = 0.f, a2 = 0.f; const int kb = F.wave * 128;
#pragma unroll 8
            for (int k = 0; k < 128; ++k) { const float w = W[(size_t)(kb + k) * 6144]; a0 += sv[kb + k] * w; a1 += sv[1024 + kb + k] * w; a2 += sv[2048 + kb + k] * w; }
            part[(F.wave * 3 + 0) * 64 + F.lane] = a0; part[(F.wave * 3 + 1) * 64 + F.lane] = a1; part[(F.wave * 3 + 2) * 64 + F.lane] = a2;
            __syncthreads();
            if (F.tid < 192) { const int v = F.tid >> 6, col = F.tid & 63; float s = ada_b[l * 6144 + c0 + col];
#pragma unroll
                for (int w = 0; w < 8; ++w) s += part[(w * 3 + v) * 64 + col];
                modv[(size_t)(l * 3 + v) * 6144 + c0 + col] = s; }
            __syncthreads();
        }
    }
    { float* rope = WSP(float, WS_ROPE); const int gt = F.vcu * NWAVES * 64 + F.tid; if (gt < 4096) { const int pos = gt >> 4, f = gt & 15; const float ang = (float)pos * ROPE_INV[f]; float cs, sn; sincos_d(ang, cs, sn); rope[gt * 2] = cs; rope[gt * 2 + 1] = sn; } }
    { const int gt = F.vcu * NWAVES * 64 + F.tid; if (gt < NLAYER * 256) { const int l = gt >> 8, kq = (gt >> 6) & 3, d = gt & 63; const float* src = kargs()->in[kq == 0 ? I_QNG : (kq == 1 ? I_QNL : (kq == 2 ? I_KNG : I_KNL))]; WSP(float, WS_GN)[gt] = src[l * 64 + d]; } }
    if (gw < NLAYER * 2) { const int l = gw >> 1, loc = gw & 1; float mq = fabsf(kargs()->in[loc ? I_QNL : I_QNG][l * 64 + F.lane]), mk = fabsf(kargs()->in[loc ? I_KNL : I_KNG][l * 64 + F.lane]);
#pragma unroll
        for (int o = 1; o < 64; o <<= 1) { mq = fmaxf(mq, __shfl_xor(mq, o)); mk = fmaxf(mk, __shfl_xor(mk, o)); }
        if (F.lane == 0) WSP(float, WS_BND)[gw] = 64.0f * C2 * mq * mk * 1.02f + 0.05f; }
    { u32x4* p = (u32x4*)(WSP(bf16_t, WS_KV) + (size_t)NROW * 512); for (int i = F.vcu * NWAVES * 64 + F.tid; i < 256 * 512 * 2 / 16; i += F.G * NWAVES * 64) p[i] = (u32x4){0u, 0u, 0u, 0u}; }
    {
        const float* x = kargs()->in[I_X]; const float* ctx = kargs()->in[I_CTX]; float* XS = WSP(float, WS_XS);
        for (int R = gw; R < NROW; R += NGW) {
            const int b = R >= RB ? 1 : 0, rr = R - b * RB;
            const float* src = rr < NCTX ? ctx + (size_t)(b * NCTX + rr) * 1024 : x + (size_t)(b * SEQ + rr - NCTX) * 1024;
            const f32x4* s4 = (const f32x4*)src + F.lane; f32x4* d4 = (f32x4*)(XS + (size_t)R * 1024) + F.lane;
            f32x4 v[4];
#pragma unroll
            for (int j = 0; j < 4; ++j) v[j] = s4[64 * j];
#pragma unroll
            for (int j = 0; j < 4; ++j) d4[64 * j] = v[j];
        }
    }
    {
        LAS float* scr = (LAS float*)(F.lds + RING_OFF + F.wave * 16384);
        constexpr int I_IN = 4 * 768, I_OUT = 4 * 512, I_G = 64 * 256, I_U = 64 * 256, I_D = 64 * 256;
        for (int it0 = gw; it0 < I_IN + I_OUT + I_G + I_U + I_D; it0 += NGW) {
            int it = it0;
            if (it < I_IN) { const int l = it / 768, r = it % 768; p0_transpose_item<1>(kargs()->in[I_WIN] + (size_t)l * 1024 * 1536, 1536, WSP(bf16_t, WS_WIN) + (size_t)l * 1536 * 1024, 1024, scr, r / 48, r % 48, F.lane); continue; } it -= I_IN;
            if (it < I_OUT) { const int l = it / 512, r = it % 512; p0_transpose_item<0>(kargs()->in[I_WOUT] + (size_t)l * 1024 * 1024, 1024, WSP(bf16_t, WS_WOUT) + (size_t)l * 1024 * 1024, 1024, scr, r / 32, r % 32, F.lane); continue; } it -= I_OUT;
            if (it < I_G) { const int m = it / 256, r = it % 256; p0_transpose_item<2>(kargs()->in[I_WGATE] + (size_t)m * 1024 * 512, 512, WSP(bf16_t, WS_WGU) + (size_t)m * 1024 * 1024, 1024, scr, r / 16, r % 16, F.lane); continue; } it -= I_G;
            if (it < I_U) { const int m = it / 256, r = it % 256; p0_transpose_item<3>(kargs()->in[I_WUP] + (size_t)m * 1024 * 512, 512, WSP(bf16_t, WS_WGU) + (size_t)m * 1024 * 1024, 1024, scr, r / 16, r % 16, F.lane); continue; } it -= I_U;
            { const int m = it / 256, r = it % 256; p0_transpose_item<0>(kargs()->in[I_WDOWN] + (size_t)m * 512 * 1024, 1024, WSP(bf16_t, WS_WD) + (size_t)m * 1024 * 512, 512, scr, r / 32, r % 32, F.lane); }
        }
    }
}

__device__ __forceinline__ void rms_mod_row(const float* xrow, const float* g, const float* sh, const float* sc, int lane, f32x4 (&h)[4]) {
    const f32x4* xr = (const f32x4*)xrow + lane; float ss = 0.f;
#pragma unroll
    for (int j = 0; j < 4; ++j) { h[j] = xr[64 * j]; ss += (h[j][0] * h[j][0] + h[j][1] * h[j][1]) + (h[j][2] * h[j][2] + h[j][3] * h[j][3]); }
    const float rs = 1.0f / sqrtf(wave_sum(ss) * (1.0f / 1024.0f) + NORM_EPS);
#pragma unroll
    for (int j = 0; j < 4; ++j) { const f32x4 gg = ((const f32x4*)g)[lane + 64 * j], s1 = ((const f32x4*)sh)[lane + 64 * j], s2 = ((const f32x4*)sc)[lane + 64 * j];
        h[j] = (h[j] * rs * gg) * (1.0f + s2) + s1; }
}
__device__ __forceinline__ void store_row_bf16(bf16_t* orow, int lane, const f32x4 (&h)[4]) {
    u32x2* o8 = (u32x2*)orow + lane;
#pragma unroll
    for (int j = 0; j < 4; ++j) { u32x2 w; w.x = pk2(h[j][0], h[j][1]); w.y = pk2(h[j][2], h[j][3]); o8[64 * j] = w; }
}
__device__ __forceinline__ int row_mv(int R) { const int b = R >= RB ? 1 : 0; return (R - b * RB) < NCTX ? 2 : b; }

__device__ __forceinline__ void phase_norm1(Frame& F0, int l) {
    Frame F = F0; asm volatile("" : "+v"(F.tid), "+v"(F.lane), "+s"(F.wave), "+s"(F.vcu));
    const int gw = F.vcu * NWAVES + F.wave, NGW = F.G * NWAVES;
    const float* g = kargs()->in[I_GATTN] + l * 1024; const float* modv = WSP(float, WS_MODV); const float* XS = WSP(float, WS_XS); bf16_t* HN = WSP(bf16_t, WS_HN);
    for (int R = gw; R < NROW; R += NGW) {
        const float* mv = modv + (size_t)(l * 3 + row_mv(R)) * 6144;
        f32x4 h[4]; rms_mod_row(XS + (size_t)R * 1024, g, mv + 0, mv + 1024, F.lane, h);
        store_row_bf16(HN + (size_t)R * 1024, F.lane, h);
    }
}
__device__ __forceinline__ void phase_norm2_router(Frame& F0, int l, bool lastl, bool dry = false) {
    Frame F = F0; asm volatile("" : "+v"(F.tid), "+v"(F.lane), "+s"(F.wave), "+s"(F.vcu));
    const int gw = F.vcu * NWAVES + F.wave, NGW = F.G * NWAVES;
    LAS f32x4* RW = (LAS f32x4*)(F.lds + RING_OFF);
    { const float* router_w = kargs()->in[I_RW];
      for (int idx = F.tid; idx < 4096; idx += NWAVES * 64) { const int j = idx >> 10, e = (idx >> 6) & 15, ln = idx & 63, c = 4 * ln + 256 * j;
        RW[idx] = (f32x4){router_w[(c + 0) * 16 + e], router_w[(c + 1) * 16 + e], router_w[(c + 2) * 16 + e], router_w[(c + 3) * 16 + e]}; } }
    __syncthreads();
    const float* g = kargs()->in[I_GFFN] + l * 1024; const float* router_b = kargs()->in[I_RB];
    LAS float* PS = (LAS float*)(F.lds + RING_OFF + 65536) + F.wave * (16 * 65);
    const float* modv = WSP(float, WS_MODV); const float* XS = WSP(float, WS_XS); bf16_t* HN = WSP(bf16_t, WS_HN);
    int my_cls = -1, my_tok = 0; float my_wlo = 0.f, my_whi = 0.f;
    int k = 0;
    for (int R = gw; R < NROW; R += NGW, ++k) {
        const int mvi = row_mv(R);
        if (lastl && mvi == 2) continue;
        const float* mv = modv + (size_t)(l * 3 + mvi) * 6144;
        f32x4 h[4]; rms_mod_row(XS + (size_t)R * 1024, g, mv + 3072, mv + 4096, F.lane, h);
        store_row_bf16(HN + (size_t)R * 1024, F.lane, h);
        {
#pragma unroll
            for (int e = 0; e < 16; ++e) { float s = 0.f;
#pragma unroll
                for (int j = 0; j < 4; ++j) { const f32x4 w4 = RW[(j * 16 + e) * 64 + F.lane]; s += (h[j][0] * w4[0] + h[j][1] * w4[1]) + (h[j][2] * w4[2] + h[j][3] * w4[3]); }
                PS[e * 65 + F.lane] = s; }
        }
        float tl = 0.f;
        { const LAS float* pr = PS + (F.lane & 15) * 65 + (F.lane >> 4) * 16;
#pragma unroll
          for (int i = 0; i < 16; ++i) tl += pr[i]; }
        tl += __shfl_xor(tl, 16); tl += __shfl_xor(tl, 32);
        const float my_sc = 1.0f / (1.0f + expf(-tl)), my_sel = my_sc + router_b[F.lane & 15];
        float sc[16], sel[16];
#pragma unroll
        for (int e = 0; e < 16; ++e) { sc[e] = __builtin_bit_cast(float, __builtin_amdgcn_readlane(__builtin_bit_cast(int, my_sc), e)); sel[e] = __builtin_bit_cast(float, __builtin_amdgcn_readlane(__builtin_bit_cast(int, my_sel), e)); }
        float gs[4];
#pragma unroll
        for (int gq = 0; gq < 4; ++gq) { const float a = sel[4 * gq], b = sel[4 * gq + 1], c = sel[4 * gq + 2], d = sel[4 * gq + 3];
            const float h1 = fmaxf(a, b), l1 = fminf(a, b), h2 = fmaxf(c, d), l2 = fminf(c, d);
            gs[gq] = fmaxf(h1, h2) + fmaxf(fminf(h1, h2), fmaxf(l1, l2)); }
        int gi = 0; float bg = gs[0];
#pragma unroll
        for (int gq = 1; gq < 4; ++gq) if (gs[gq] > bg) { bg = gs[gq]; gi = gq; }
        float s4[4], c4[4];
#pragma unroll
        for (int q = 0; q < 4; ++q) { s4[q] = sel[q]; c4[q] = sc[q]; }
#pragma unroll
        for (int gq = 1; gq < 4; ++gq)
#pragma unroll
            for (int q = 0; q < 4; ++q) { s4[q] = (gi == gq) ? sel[4 * gq + q] : s4[q]; c4[q] = (gi == gq) ? sc[4 * gq + q] : c4[q]; }
        int i1 = 0; float b1 = s4[0], w1 = c4[0];
#pragma unroll
        for (int q = 1; q < 4; ++q) if (s4[q] > b1) { b1 = s4[q]; i1 = q; w1 = c4[q]; }
        int i2 = -1; float b2 = -INFINITY, w2 = 0.f;
#pragma unroll
        for (int q = 0; q < 4; ++q) if (q != i1 && (i2 < 0 || s4[q] > b2)) { b2 = s4[q]; i2 = q; w2 = c4[q]; }
        const float wsum = w1 + w2; w1 = w1 / wsum; w2 = w2 / wsum;
        const int ia = i1 < i2 ? i1 : i2, ib = i1 < i2 ? i2 : i1;
        const float wlo = i1 < i2 ? w1 : w2, whi = i1 < i2 ? w2 : w1;
        const int pidx = ia == 0 ? ib - 1 : (ia == 1 ? ib + 1 : 5);
        if (F.lane == k) { my_cls = gi * 6 + pidx; my_tok = R; my_wlo = wlo; my_whi = whi; }
    }
    if (my_cls >= 0 && !dry) {
        const unsigned pos = __hip_atomic_fetch_add(WSP(unsigned, WS_CTL) + CW_CNT + (l * NCLS + my_cls) * 64, 1u, RLX_AGENT);
        WSP(int, WS_TOK)[(size_t)my_cls * CAP + pos] = my_tok; WSP(f32x2, WS_WTS)[(size_t)my_cls * CAP + pos] = (f32x2){my_wlo, my_whi};
    }
    __syncthreads();
}
__device__ __forceinline__ int moe_tables(Frame& F0, int l) {
    Frame F = F0; asm volatile("" : "+v"(F.tid));
    LAS int* s_n = (LAS int*)(F.lds + MOE_OFF); LAS int* s_ts = s_n + 32;
    __syncthreads();
    if (F.tid < NCLS) s_n[F.tid] = (int)__hip_atomic_load(WSP(unsigned, WS_CTL) + CW_CNT + (l * NCLS + F.tid) * 64, RLX_AGENT);
    __syncthreads();
    if (F.tid == 0) { int acc = 0; for (int c = 0; c < NCLS; ++c) { s_ts[c] = acc; acc += (s_n[c] + 255) >> 8; } s_ts[NCLS] = acc; }
    __syncthreads();
    return s_ts[NCLS];
}

constexpr int NPHASE = 1 + 7 * NLAYER;
__global__ void __launch_bounds__(NWAVES * 64, 2) fwd_kernel(Args args) {
    extern __shared__ __attribute__((aligned(16))) unsigned char lds[];
    Frame F;
    F.lds = (LAS unsigned char*)lds; F.MISC = (volatile LAS unsigned*)(F.lds + MISC_OFF);
    F.tid = threadIdx.x; F.lane = F.tid & 63; F.wave = __builtin_amdgcn_readfirstlane(F.tid >> 6);
    F.G = gridDim.x; { const int bx = blockIdx.x; F.vcu = (F.G % 8 == 0) ? (bx % 8) * (F.G / 8) + bx / 8 : bx; }
    for (int u = F.tid; u < (LDS_BYTES - LDSCTL_OFF) / 4; u += NWAVES * 64) ((LAS unsigned*)(F.lds + LDSCTL_OFF))[u] = 0u;
    __syncthreads();
    const int lo = args.ph_lo, hi = args.ph_hi;
    XcdBarrier bar; bar.bar = WSP(unsigned, WS_CTL) + CW_BAR; bar.x = 0; bar.st = nullptr;
    if (hi - lo > 1) bar = xcd_barrier_post(WSP(unsigned, WS_CTL) + CW_BAR, F.MISC + 8);
#ifndef MK_EN
#define MK_EN 0xff
#endif
#define EN(k) (((MK_EN) >> (k)) & 1)
#ifndef REP_P0
#define REP_P0 1
#endif
#ifndef REP_A
#define REP_A 1
#endif
#ifndef REP_B
#define REP_B 1
#endif
#ifndef REP_C
#define REP_C 1
#endif
#ifndef REP_F
#define REP_F 1
#endif
#ifndef REP_D
#define REP_D 1
#endif
#ifndef REP_E
#define REP_E 1
#endif
#ifndef REP_G
#define REP_G 1
#endif
#define RUN(p) (lo <= (p) && (p) < hi)
#define SEAM(p) do { if (RUN(p) && RUN((p) + 1)) xcd_barrier(bar); } while (0)

    if (EN(7) && RUN(0)) { for (int rep = 0; rep < REP_P0; ++rep) { p0_prologue(F); if (rep + 1 < REP_P0) xcd_barrier(bar); } SEAM(0); }

    for (int l = 0; l < NLAYER; ++l) {
        const int pb = 1 + 7 * l; const bool lastl = (l == NLAYER - 1);
        if (EN(0) && RUN(pb + 0)) { for (int rep = 0; rep < REP_A; ++rep) { phase_norm1(F, l); if (rep + 1 < REP_A) xcd_barrier(bar); } SEAM(pb + 0); }
        if (EN(1) && RUN(pb + 1)) {
            pg8::ProbDense P; P.A = WSP(const char, WS_HN); P.B = (const char*)(WSP(bf16_t, WS_WIN) + (size_t)l * 1536 * 1024); P.lda = 1024; P.ldb = 1024; P.nt = 16; P.S.init(NROW, 1536, F.G, (int)blockIdx.x);
            pg8::EpiQKV E{kargs()->ws, WSP(float, WS_GN) + l * 256, WSP(float, WS_ROPE)};
            for (int rep = 0; rep < REP_B; ++rep) { pg8::gemm_phase<pg8::EpiQKV, pg8::ProbDense, true>(F.lds + RING_OFF, F.lds + OFFS_OFF, P, E); if (rep + 1 < REP_B) xcd_barrier(bar); }
            SEAM(pb + 1);
        }
        if (EN(2) && RUN(pb + 2)) {
            const attn_body::bf16* Q = WSP(const attn_body::bf16, WS_QO); const attn_body::bf16* KVb = WSP(const attn_body::bf16, WS_KV); attn_body::bf16* O = WSP(attn_body::bf16, WS_HN);
            const float* sink = kargs()->in[I_SINK] + l * 8;
            const int n0 = 1024 + (lastl ? 0 : 32);
            const float bnd_g = WSP(const float, WS_BND)[l * 2], bnd_l = WSP(const float, WS_BND)[l * 2 + 1];
            #ifndef FORCE_FAST
#define FORCE_FAST 0
#endif
            const bool fast = FORCE_FAST || ((bnd_g <= 48.0f) && (bnd_l <= 48.0f));
            for (int rep = 0; rep < REP_C; ++rep) {
            for (int L = F.vcu; L < n0; L += F.G) {
                long qrow, kvrow; int qcol, kcol, vcol, NT; float sink2 = -INFINITY, bnd = bnd_g;
                if (L < 1024) { const int bh = L >> 6, b = bh >> 3, h = bh & 7, qb = L & 63; qrow = (long)b * RB + NCTX + qb * 256; kvrow = (long)b * RB; NT = RB / 64; qcol = h * 64; kcol = (h >> 2) * 64; vcol = 128 + (h >> 2) * 64; }
                else { const int Lc = L - 1024, b = Lc >> 4, h = Lc & 15; qrow = (long)b * RB; kvrow = qrow; NT = NCTX / 64; qcol = h * 64;
                    if (h < 8) { kcol = (h >> 2) * 64; vcol = 128 + (h >> 2) * 64; } else { const int hl = h - 8; kcol = 256 + (hl >> 2) * 64; vcol = 384 + (hl >> 2) * 64; sink2 = sink[hl] * LOG2E; bnd = bnd_l; } }
                if (fast) attn_body::attn_unit_sb<0>(qrow, kvrow, 0, qcol, kcol, vcol, NT, sink2, bnd, Q, KVb, O, (char*)lds + RING_OFF);
                else attn_body::attn_unit<0, 8>(qrow, kvrow, 0, qcol, kcol, vcol, NT, sink2, Q, KVb, O, (char*)lds + RING_OFF);
            }
            for (int L = F.vcu; L < 1024; L += F.G) {
                const int bh = L >> 6, b = bh >> 3, hl = bh & 7, qb = L & 63, q0 = qb * 256;
                if (fast) attn_body::attn_unit_sb<1>((long)b * RB + NCTX + q0, (long)b * RB, q0, (8 + hl) * 64, 256 + (hl >> 2) * 64, 384 + (hl >> 2) * 64, 12, sink[hl] * LOG2E, bnd_l, Q, KVb, O, (char*)lds + RING_OFF);
                else attn_body::attn_unit<1, 8>((long)b * RB + NCTX + q0, (long)b * RB, q0, (8 + hl) * 64, 256 + (hl >> 2) * 64, 384 + (hl >> 2) * 64, 12, sink[hl] * LOG2E, Q, KVb, O, (char*)lds + RING_OFF);
            }
            if (rep + 1 < REP_C) xcd_barrier(bar); }
            SEAM(pb + 2);
        }
        if (EN(3) && RUN(pb + 3)) {
            pg8::ProbDense P; P.A = WSP(const char, WS_HN); P.B = (const char*)(WSP(bf16_t, WS_WOUT) + (size_t)l * 1024 * 1024); P.lda = 1024; P.ldb = 1024; P.nt = 16; P.S.init(NROW, 1024, F.G, (int)blockIdx.x);
            for (int rep = 0; rep < REP_D; ++rep) {
            pg8::EpiResid E{WSP(float, WS_XS), WSP(float, WS_MODV) + (size_t)l * 3 * 6144, 2048, (rep & 1) ? -1.0f : 1.0f};
            pg8::gemm_phase<pg8::EpiResid, pg8::ProbDense, true>(F.lds + RING_OFF, F.lds + OFFS_OFF, P, E); if (rep + 1 < REP_D) xcd_barrier(bar); }
            SEAM(pb + 3);
        }
        if (EN(4) && RUN(pb + 4)) { for (int rep = 0; rep < REP_E; ++rep) { phase_norm2_router(F, l, lastl, rep + 1 < REP_E); if (rep + 1 < REP_E) xcd_barrier(bar); } SEAM(pb + 4); }
        if (EN(5) && RUN(pb + 5)) {
            const int ntile = moe_tables(F, l);
            pg8::ProbGU P; P.A = WSP(const char, WS_HN); P.B = (const char*)(WSP(bf16_t, WS_WGU) + (size_t)l * 16 * 1024 * 1024); P.tok = WSP(int, WS_TOK); P.s_n = (const LAS int*)(F.lds + MOE_OFF); P.s_ts = P.s_n + 32;
            P.total = ntile * 8; P.G = F.G; P.c = (int)blockIdx.x; P.nt = 16;
            pg8::EpiGU E{WSP(bf16_t, WS_ACT), WSP(f32x2, WS_WTS)};
            for (int rep = 0; rep < REP_F; ++rep) { pg8::gemm_phase<pg8::EpiGU, pg8::ProbGU, true>(F.lds + RING_OFF, F.lds + OFFS_OFF, P, E); if (rep + 1 < REP_F) xcd_barrier(bar); }
            SEAM(pb + 5);
        }
        if (EN(6) && RUN(pb + 6)) {
            const int ntile = moe_tables(F, l);
            pg8::ProbDown P; P.A = WSP(const char, WS_ACT); P.B = (const char*)(WSP(bf16_t, WS_WD) + (size_t)l * 16 * 1024 * 512); P.s_n = (const LAS int*)(F.lds + MOE_OFF); P.s_ts = P.s_n + 32;
            P.total = ntile * 4; P.G = F.G; P.c = (int)blockIdx.x; P.nt = 16;
            for (int rep = 0; rep < REP_G; ++rep) {
            pg8::EpiDown E{WSP(float, WS_XS), lastl ? kargs()->out : nullptr, WSP(int, WS_TOK), WSP(float, WS_MODV) + (size_t)l * 3 * 6144, (rep & 1) ? -1.0f : 1.0f};
            pg8::gemm_phase<pg8::EpiDown, pg8::ProbDown, true>(F.lds + RING_OFF, F.lds + OFFS_OFF, P, E); if (rep + 1 < REP_G) xcd_barrier(bar); }
            SEAM(pb + 6);
        }
    }
#undef RUN
#undef SEAM
}

#ifndef MK_SPLIT
#define MK_SPLIT 0
#endif
extern "C" void kernel_launch(void* const* d_in, const int* in_sizes, int n_in, void* d_out, int out_size, void* d_ws, size_t ws_size, hipStream_t stream) {
    static int grid = 0;
    if (grid == 0) {
        if (n_in != 20 || in_sizes[0] != NB * SEQ * DM || out_size != NB * SEQ * DM || ws_size < WS_END) {
            fprintf(stderr, "kernel_launch: unexpected shapes (n_in %d, in0 %d, out %d, ws %zu); nothing launched\n", n_in, n_in > 0 ? in_sizes[0] : -1, out_size, ws_size); grid = -1; return; }
        int dev = 0, cus = 0, per_cu = 0;
        if (hipGetDevice(&dev) != hipSuccess || hipDeviceGetAttribute(&cus, hipDeviceAttributeMultiprocessorCount, dev) != hipSuccess) { grid = -1; return; }
        if (hipFuncSetAttribute((const void*)fwd_kernel, hipFuncAttributeMaxDynamicSharedMemorySize, LDS_BYTES) != hipSuccess) { fprintf(stderr, "kernel_launch: hipFuncSetAttribute failed\n"); grid = -1; return; }
        if (hipOccupancyMaxActiveBlocksPerMultiprocessor(&per_cu, (const void*)fwd_kernel, NWAVES * 64, LDS_BYTES) != hipSuccess || per_cu < 1)
            fprintf(stderr, "kernel_launch: note: occupancy query reports %d workgroups per CU\n", per_cu);
        (void)hipGetLastError();
        grid = cus;
    }
    if (grid < 0) return;
    if (hipMemsetAsync((char*)d_ws + WS_CTL, 0, CTL_ZERO_BYTES, stream) != hipSuccess) return;
    Args a{};
    for (int i = 0; i < 20; ++i) a.in[i] = (const float*)d_in[i];
    a.out = (float*)d_out; a.ws = (unsigned char*)d_ws;
#if MK_SPLIT
    for (int p = 0; p < NPHASE; ++p) { a.ph_lo = p; a.ph_hi = p + 1; hipLaunchKernelGGL(fwd_kernel, dim3(grid), dim3(NWAVES * 64), LDS_BYTES, stream, a); }
#else
    a.ph_lo = 0; a.ph_hi = NPHASE;
    hipLaunchKernelGGL(fwd_kernel, dim3(grid), dim3(NWAVES * 64), LDS_BYTES, stream, a);
#endif
    const hipError_t le = hipPeekAtLastError();
    if (le != hipSuccess) fprintf(stderr, "kernel_launch: launch failed: %s\n", hipGetErrorName(le));
}
```

```cpp
#define ATTN_FAST attn_unit_sb
#include <hip/hip_runtime.h>
#include <hip/hip_bf16.h>
#include <cstdio>
#include <cstdint>
#include <cmath>

#define LAS __attribute__((address_space(3)))
#define GAS __attribute__((address_space(1)))
typedef unsigned short bf16_t;
typedef short bf16x8 __attribute__((ext_vector_type(8)));
typedef float f32x4 __attribute__((ext_vector_type(4)));
typedef float f32x2 __attribute__((ext_vector_type(2)));
typedef unsigned u32x4 __attribute__((ext_vector_type(4)));
typedef unsigned u32x2 __attribute__((ext_vector_type(2)));
typedef GAS unsigned gu32;

constexpr int NB = 2, SEQ = 16384, DM = 1024, NCTX = 256, NLAYER = 4, NEXP = 16, DEXP = 512;
constexpr int RB = SEQ + NCTX;
constexpr int NROW = NB * RB;
constexpr int NCLS = 24, CAP = NROW;
constexpr int MAXSLOT = 39424;
constexpr float NORM_EPS = 1e-6f;
constexpr float C2 = 0.125f * 1.4426950408889634f;
constexpr float LOG2E = 1.4426950408889634f;

constexpr size_t MiB = 1u << 20;
constexpr size_t WS_CTL = 0, CTL_ZERO_BYTES = 1 * MiB;
constexpr size_t WS_MODV = 1 * MiB;
constexpr size_t WS_ROPE = 2 * MiB;
constexpr size_t WS_GN = 3 * MiB;
constexpr size_t WS_BND = 3 * MiB + 8192;
constexpr size_t WS_TOK = 4 * MiB;
constexpr size_t WS_WTS = 8 * MiB;
constexpr size_t WS_WIN = 16 * MiB;
constexpr size_t WS_WOUT = 28 * MiB;
constexpr size_t WS_WGU = 36 * MiB;
constexpr size_t WS_WD = 164 * MiB;
constexpr size_t WS_XS = 228 * MiB;
constexpr size_t WS_HN = 358 * MiB;
constexpr size_t WS_QO = 423 * MiB;
constexpr size_t WS_KV = 488 * MiB;
constexpr size_t WS_ACT = 423 * MiB;
constexpr size_t WS_END = 522 * MiB;
static_assert(WS_TOK + (size_t)NCLS * CAP * 4 <= WS_WTS && WS_WTS + (size_t)NCLS * CAP * 8 <= WS_WIN, "lists");
static_assert(WS_KV + (size_t)(NROW + 256) * 512 * 2 <= WS_END && WS_ACT + (size_t)MAXSLOT * 1024 * 2 <= WS_END, "ws map");
constexpr int CW_TMO = 0, CW_CODE = 1, CW_BAR = 4096, CW_CNT = 8192;

constexpr int RING_OFF = 0, RING_BYTES = 131072;
constexpr int LDSCTL_OFF = RING_BYTES, MISC_OFF = LDSCTL_OFF + 320, MOE_OFF = LDSCTL_OFF + 1024, OFFS_OFF = LDSCTL_OFF + 2048  ;
constexpr int LDS_BYTES = 147456;
constexpr int NWAVES = 8;

#define LDS_WAIT() asm volatile("s_waitcnt lgkmcnt(0)" ::: "memory")
#define VM_WAIT() asm volatile("s_waitcnt vmcnt(0)" ::: "memory")
#define RLX_AGENT __ATOMIC_RELAXED, __HIP_MEMORY_SCOPE_AGENT

__device__ __forceinline__ unsigned f2bf(float f) { unsigned u = __builtin_bit_cast(unsigned, f); return (u + 0x7fffu + ((u >> 16) & 1u)) >> 16; }
__device__ __forceinline__ unsigned pk2(float lo, float hi) { return f2bf(lo) | (f2bf(hi) << 16); }
__device__ __forceinline__ unsigned cvt_pk_bf16(float lo, float hi) { unsigned r; asm volatile("v_cvt_pk_bf16_f32 %0, %1, %2" : "=v"(r) : "v"(lo), "v"(hi)); return r; }
__device__ __forceinline__ float wave_sum(float v) {
#pragma unroll
    for (int o = 1; o < 64; o <<= 1) v += __shfl_xor(v, o);
    return v;
}

#define XB_TMO      128
#define XB_XCNT(j)  (256  + 64 * (j))
#define XB_XSUB(j)  (1280 + 64 * (j))
#define XB_XGEN(j)  (2304 + 64 * (j))
#define XB_TOP      3328
#define XB_TOPGEN   3392
#define XCD_BAR_WORDS 3456
#define XB_SPIN_CAP (1u << 22)
__device__ __forceinline__ unsigned xb_ld(unsigned* p)              { return __hip_atomic_load(p, __ATOMIC_RELAXED, __HIP_MEMORY_SCOPE_AGENT); }
__device__ __forceinline__ unsigned xb_add(unsigned* p, unsigned v) { return __hip_atomic_fetch_add(p, v, __ATOMIC_RELAXED, __HIP_MEMORY_SCOPE_AGENT); }
__device__ __forceinline__ unsigned xb_xcc_id() { return (unsigned)__builtin_amdgcn_s_getreg((3 << 11) | 20) & 0xFu; }
#define XB_SPIN(cond, bar) do { unsigned _sp = 0; while (cond) { __builtin_amdgcn_s_sleep(1); \
    if ((++_sp & 255u) == 0u) { if (xb_ld(&(bar)[XB_TMO])) break; if (_sp > XB_SPIN_CAP) { atomicAdd(&(bar)[XB_TMO], 1u); break; } } } } while (0)
struct XcdBarrier { unsigned* bar; unsigned x; volatile LAS unsigned* st; };
__device__ __forceinline__ XcdBarrier xcd_barrier_post(unsigned* bar, volatile LAS unsigned* st) {
    XcdBarrier b; b.bar = bar; b.x = xb_xcc_id(); b.st = st;
    if (threadIdx.x == 0) (void)xb_add(&bar[XB_XCNT(b.x)], 1u);
    return b;
}
__device__ __forceinline__ void xcd_barrier_complete(unsigned* bar, unsigned x, unsigned& nloc, unsigned& nx) {
    const unsigned G = gridDim.x * gridDim.y * gridDim.z;
    unsigned sum, cnt, mine, sp = 0u;
    for (;;) {
        sum = 0u; cnt = 0u; mine = 0u;
#pragma unroll
        for (unsigned j = 0; j < 16; ++j) { const unsigned c = xb_ld(&bar[XB_XCNT(j)]); sum += c; cnt += (c > 0u) ? 1u : 0u; mine = (j == x) ? c : mine; }
        if (sum == G) break;
        __builtin_amdgcn_s_sleep(1);
        if ((++sp & 255u) == 0u) { if (xb_ld(&bar[XB_TMO])) break; if (sp > XB_SPIN_CAP) { atomicAdd(&bar[XB_TMO], 1u); break; } }
    }
    nloc = mine > 0u ? mine : 1u; nx = cnt > 0u ? cnt : 1u;
}
__device__ __forceinline__ void xcd_barrier(const XcdBarrier& b) {
    asm volatile("s_waitcnt vmcnt(0)" ::: "memory");
    __syncthreads();
    if (threadIdx.x == 0) {
        unsigned* bar = b.bar;
        __builtin_amdgcn_s_waitcnt(0);
        unsigned nloc = b.st[0], nx = b.st[1];
        if (nloc == 0u) { xcd_barrier_complete(bar, b.x, nloc, nx); b.st[0] = nloc; b.st[1] = nx; }
        const unsigned old = xb_add(&bar[XB_XSUB(b.x)], 1u);
        const unsigned gen = old / nloc;
        if (old + 1u == (gen + 1u) * nloc) {
            __builtin_amdgcn_fence(__ATOMIC_RELEASE, "agent");
            asm volatile("s_waitcnt vmcnt(0)" ::: "memory");
            const unsigned og = xb_add(&bar[XB_TOP], 1u);
            const unsigned tg = og / nx;
            if (og + 1u == (tg + 1u) * nx) xb_add(&bar[XB_TOPGEN], 1u);
            else XB_SPIN(xb_ld(&bar[XB_TOPGEN]) == tg, bar);
            __builtin_amdgcn_fence(__ATOMIC_ACQUIRE, "agent");
            xb_add(&bar[XB_XGEN(b.x)], 1u);
            asm volatile("s_waitcnt vmcnt(0)" ::: "memory");
        } else {
            XB_SPIN(xb_ld(&bar[XB_XGEN(b.x)]) == gen, bar);
            __builtin_amdgcn_fence(__ATOMIC_ACQUIRE, "agent");
            asm volatile("s_waitcnt vmcnt(0)" ::: "memory");
        }
    }
    __syncthreads();
}

namespace pg8 {
constexpr int BM = 256, BK = 64, HALF = 128, HTB = HALF * BK * 2, STAGE_BYTES = 8 * HTB, NXCD = 8, WGM = 8;
__host__ __device__ __forceinline__ int lds_byte(int r, int c) { const int st = (r >> 4) * 2 + (c >> 5), rr = r & 15, cc = c & 31, ob = rr * 64 + cc * 2; return st * 1024 + (ob ^ (((ob >> 9) & 1) << 5)); }
__host__ __device__ __forceinline__ void stage_rc(int b, int& R, int& C) { const int st = b / 1024, sb = b % 1024, swz = sb ^ (((sb >> 9) & 1) << 5); R = (st >> 1) * 16 + swz / 64; C = (st & 1) * 32 + (swz % 64) / 2; }
__host__ __device__ __forceinline__ int perm32(int rho) { const int n = rho >> 4, i = rho & 15; return 8 * (i >> 2) + 4 * n + (i & 3); }

struct Unit { int pm, pn, cls, row0, ncls, elo, ehi; };

struct StaticOrder {
    int nM, nN, nwg, G, c;
    __device__ void init(int M, int N, int G_, int c_) { nM = M / BM; nN = N / BM; nwg = nM * nN; G = G_; c = c_; }
    __device__ __forceinline__ bool next(int i, Unit& u) const {
        const long L = (long)i * G + c; if (L >= nwg) return false;
        int wgid = (int)L; { const int q = nwg / NXCD, r = nwg % NXCD, xcd = wgid % NXCD, off = wgid / NXCD; wgid = (xcd < r ? xcd * (q + 1) : r * (q + 1) + (xcd - r) * q) + off; }
        const int nig = WGM * nN, gid = wgid / nig, fm = gid * WGM, gsz = (nM - fm) < WGM ? (nM - fm) : WGM;
        u.pm = fm + ((wgid % nig) % gsz); u.pn = (wgid % nig) / gsz; u.cls = 0; u.row0 = 0; u.ncls = 0; u.elo = 0; u.ehi = 0; return true;
    }
};

struct ProbDense {
    const char* A; const char* B; int lda, ldb, nt; StaticOrder S;
    __device__ __forceinline__ bool next(int i, Unit& u) const { return S.next(i, u); }
    __device__ __forceinline__ void a_offs(const Unit& u, int tid, unsigned (&off)[2][2]) const {
#pragma unroll
        for (int i = 0; i < 2; ++i) { int R, C; stage_rc(tid * 16 + i * 8192, R, C);
#pragma unroll
            for (int h = 0; h < 2; ++h) off[h][i] = (unsigned)((u.pm * BM + h * HALF + R) * lda + C) * 2u; }
    }
    __device__ __forceinline__ const char* b_ptr(const Unit& u, int t) const { return B + (size_t)u.pn * BM * ldb * 2 + (size_t)t * (BK * 2); }
};
__device__ __forceinline__ void moe_unit(const LAS int* s_n, const LAS int* s_ts, int rt, Unit& u) {
    int cc = 0; while (s_ts[cc + 1] <= rt) ++cc;
    u.pm = rt; u.cls = cc; u.row0 = (rt - s_ts[cc]) * BM; u.ncls = s_n[cc];
    const int g = cc / 6, idx = cc % 6; const int a = idx < 3 ? 0 : (idx < 5 ? 1 : 2), b = idx < 3 ? idx + 1 : (idx < 5 ? idx - 1 : 3);
    u.elo = 4 * g + a; u.ehi = 4 * g + b;
}
struct ProbGU {
    const char* A; const char* B; const int* tok; const LAS int* s_n; const LAS int* s_ts; int total, G, c; static constexpr int ldb = 1024; int nt;
    __device__ __forceinline__ bool next(int i, Unit& u) const { const long L = (long)i * G + c; if (L >= total) return false; u.pn = (int)(L & 7); moe_unit(s_n, s_ts, (int)(L >> 3), u); return true; }
    __device__ __forceinline__ void a_offs(const Unit& u, int tid, unsigned (&off)[2][2]) const {
#pragma unroll
        for (int i = 0; i < 2; ++i) { int R, C; stage_rc(tid * 16 + i * 8192, R, C);
#pragma unroll
            for (int h = 0; h < 2; ++h) { int r = u.row0 + h * HALF + R; r = r < u.ncls ? r : u.ncls - 1; const int t = tok[(size_t)u.cls * CAP + r]; off[h][i] = (unsigned)t * 2048u + (unsigned)C * 2u; } }
    }
    __device__ __forceinline__ const char* b_ptr(const Unit& u, int t) const { const int e = u.pn >= 4 ? u.ehi : u.elo; return B + (size_t)e * (1024 * 1024 * 2) + (size_t)(u.pn & 3) * (BM * 1024 * 2) + (size_t)t * (BK * 2); }
};
struct ProbDown {
    const char* A; const char* B; const LAS int* s_n; const LAS int* s_ts; int total, G, c; static constexpr int ldb = 512; int nt;
    __device__ __forceinline__ bool next(int i, Unit& u) const { const long L = (long)i * G + c; if (L >= total) return false; u.pn = (int)(L & 3); moe_unit(s_n, s_ts, (int)(L >> 2), u); return true; }
    __device__ __forceinline__ void a_offs(const Unit& u, int tid, unsigned (&off)[2][2]) const {
#pragma unroll
        for (int i = 0; i < 2; ++i) { int R, C; stage_rc(tid * 16 + i * 8192, R, C);
#pragma unroll
            for (int h = 0; h < 2; ++h) off[h][i] = (unsigned)(u.pm * BM + h * HALF + R) * 2048u + (unsigned)C * 2u; }
    }
    __device__ __forceinline__ const char* b_ptr(const Unit& u, int t) const { const int e = t < 8 ? u.elo : u.ehi; return B + (size_t)e * (1024 * 512 * 2) + (size_t)u.pn * (BM * 512 * 2) + (size_t)(t & 7) * (BK * 2); }
};

template <class Epi, class Prob, bool ALIGN_EPI>
__device__ __forceinline__ void gemm_phase(LAS unsigned char* lds, LAS unsigned char* offs_lds, const Prob& P, const Epi& E) {
    int tid_ = threadIdx.x; asm volatile("" : "+v"(tid_));
    const int tid = tid_, wid = __builtin_amdgcn_readfirstlane(tid >> 6), lane = tid & 63, wr = wid >> 2, wc = wid & 3, fr = lane & 15, fq = lane >> 4;
    const int nt = P.nt;
    unsigned voffB[2];
#pragma unroll
    for (int i = 0; i < 2; ++i) { int R, C; stage_rc(tid * 16 + i * 8192, R, C); const int Rb = Epi::PERM ? ((R & ~31) + perm32(R & 31)) : R; voffB[i] = (unsigned)(Rb * P.ldb + C) * 2u; }
    LAS u32x4* const myoffs = (LAS u32x4*)offs_lds + tid;
    const size_t hstepB = (size_t)HALF * P.ldb * 2;
    const unsigned ldsw = (unsigned)wid * 1024u;
    const int aoff = lds_byte(wr * 64 + fr, fq * 8), boff = lds_byte(wc * 32 + fr, fq * 8);
    const char* const Ab = P.A;
#define PG8_SA(b, h) (((b) * 2 + (h)) * HTB)
#define PG8_SB(b, h) ((4 + (b) * 2 + (h)) * HTB)
#define PG8_STAGE_A(bufoff, h, offs, kt) do { _Pragma("unroll") for (int _i = 0; _i < 2; ++_i) \
        __builtin_amdgcn_global_load_lds((const unsigned*)(Ab + (size_t)(offs)[h][_i] + (size_t)(kt) * (BK * 2)), (LAS unsigned*)(lds + (bufoff) + ldsw + _i * 8192), 16, 0, 0); } while (0)
#define PG8_STAGE_B(bufoff, bp) do { _Pragma("unroll") for (int _i = 0; _i < 2; ++_i) \
        __builtin_amdgcn_global_load_lds((const unsigned*)((bp) + voffB[_i]), (LAS unsigned*)(lds + (bufoff) + ldsw + _i * 8192), 16, 0, 0); } while (0)
#define PG8_LDA(dst, b, h) do { _Pragma("unroll") for (int m = 0; m < 4; ++m) _Pragma("unroll") for (int k = 0; k < 2; ++k) dst[m][k] = *(const LAS bf16x8*)(lds + PG8_SA(b, h) + aoff + m * 2048 + k * 1024); } while (0)
#define PG8_LDB(dst, b, h) do { _Pragma("unroll") for (int n = 0; n < 2; ++n) _Pragma("unroll") for (int k = 0; k < 2; ++k) dst[n][k] = *(const LAS bf16x8*)(lds + PG8_SB(b, h) + boff + n * 2048 + k * 1024); } while (0)
#define PG8_MMA(ai, bj, At, Bt) do { __builtin_amdgcn_s_setprio(1); _Pragma("unroll") for (int m = 0; m < 4; ++m) _Pragma("unroll") for (int n = 0; n < 2; ++n) _Pragma("unroll") for (int k = 0; k < 2; ++k) \
        acc[ai][bj][m][n] = __builtin_amdgcn_mfma_f32_16x16x32_bf16(Bt[n][k], At[m][k], acc[ai][bj][m][n], 0, 0, 0); __builtin_amdgcn_s_setprio(0); } while (0)
#define PG8_WAIT_V(n) asm volatile("s_waitcnt vmcnt(" #n ")" ::: "memory")
#define PG8_WAIT_L(n) asm volatile("s_waitcnt lgkmcnt(" #n ")" ::: "memory")
#define PG8_BAR __builtin_amdgcn_s_barrier()
#define PG8_SCHED __builtin_amdgcn_sched_barrier(0)
    Unit cur, nxt; int ui = 0;
    if (!P.next(0, cur)) return;
    f32x4 acc[2][2][4][2];
#pragma unroll
    for (int a = 0; a < 2; ++a)
#pragma unroll
        for (int b = 0; b < 2; ++b)
#pragma unroll
            for (int m = 0; m < 4; ++m)
#pragma unroll
                for (int n = 0; n < 2; ++n) acc[a][b][m][n] = (f32x4){0.f, 0.f, 0.f, 0.f};
    bf16x8 At[4][2], B0[2][2], B1[2][2];
    unsigned offC[2][2];
    P.a_offs(cur, tid, offC);
    {
        const char* b0 = P.b_ptr(cur, 0); const char* b1 = P.b_ptr(cur, 1);
        PG8_STAGE_B(PG8_SB(0, 0), b0); PG8_STAGE_B(PG8_SB(0, 1), b0 + hstepB); PG8_STAGE_A(PG8_SA(0, 0), 0, offC, 0); PG8_STAGE_A(PG8_SA(0, 1), 1, offC, 0);
        if (wr == 1) PG8_BAR;
        PG8_WAIT_V(2); PG8_BAR;
        PG8_STAGE_B(PG8_SB(1, 0), b1); PG8_STAGE_A(PG8_SA(1, 0), 0, offC, 1); PG8_STAGE_B(PG8_SB(1, 1), b1 + hstepB);
        PG8_WAIT_V(6); PG8_BAR;
    }
    for (;;) {
        const bool has_next = P.next(ui + 1, nxt);
        if (!has_next) nxt = cur;
        {
            unsigned offN[2][2];
            if (has_next) P.a_offs(nxt, tid, offN);
            else {
#pragma unroll
                for (int h = 0; h < 2; ++h)
#pragma unroll
                    for (int i = 0; i < 2; ++i) offN[h][i] = offC[h][i];
            }
            *myoffs = (u32x4){offN[0][0], offN[0][1], offN[1][0], offN[1][1]};
        }
        for (int t = 0; t < nt; t += 2) {
            const bool last = (t == nt - 2);
            const int k2 = last ? 0 : t + 2;
            const char* b2 = last ? P.b_ptr(nxt, 0) : P.b_ptr(cur, t + 2);
            const char* b3 = last ? P.b_ptr(nxt, 1) : P.b_ptr(cur, t + 3);
            PG8_LDB(B0, 0, 0); PG8_LDB(B1, 0, 1); PG8_SCHED; PG8_LDA(At, 0, 0); PG8_STAGE_A(PG8_SA(1, 1), 1, offC, t + 1);
            if (last) { const u32x4 v = *myoffs; offC[0][0] = v.x; offC[0][1] = v.y; offC[1][0] = v.z; offC[1][1] = v.w; }
            PG8_WAIT_V(8); PG8_WAIT_L(0); PG8_BAR; PG8_MMA(0, 0, At, B0); PG8_MMA(0, 1, At, B1); PG8_BAR; PG8_SCHED;
            PG8_LDA(At, 0, 1); PG8_STAGE_B(PG8_SB(0, 0), b2); PG8_STAGE_B(PG8_SB(0, 1), b2 + hstepB); PG8_STAGE_A(PG8_SA(0, 0), 0, offC, k2);
            PG8_WAIT_V(8); PG8_WAIT_L(0); PG8_BAR; PG8_MMA(1, 0, At, B0); PG8_MMA(1, 1, At, B1); PG8_BAR; PG8_SCHED;
            PG8_LDB(B0, 1, 0); PG8_LDB(B1, 1, 1); PG8_SCHED; PG8_LDA(At, 1, 0); PG8_STAGE_A(PG8_SA(0, 1), 1, offC, k2);
            PG8_WAIT_V(8); PG8_WAIT_L(0); PG8_BAR; PG8_MMA(0, 0, At, B0); PG8_MMA(0, 1, At, B1); PG8_BAR; PG8_SCHED;
            PG8_LDA(At, 1, 1); PG8_STAGE_B(PG8_SB(1, 0), b3); PG8_STAGE_B(PG8_SB(1, 1), b3 + hstepB); PG8_STAGE_A(PG8_SA(1, 0), 0, offC, k2 + 1);
            PG8_WAIT_V(8); PG8_WAIT_L(0); PG8_BAR; PG8_MMA(1, 0, At, B0); PG8_MMA(1, 1, At, B1); PG8_BAR; PG8_SCHED;
        }
        if constexpr (ALIGN_EPI) { if (wr == 0) PG8_BAR; }
        E(acc, cur, wr, wc, fr, fq);
        if (!has_next) break;
#pragma unroll
        for (int a = 0; a < 2; ++a)
#pragma unroll
            for (int b = 0; b < 2; ++b)
#pragma unroll
                for (int m = 0; m < 4; ++m)
#pragma unroll
                    for (int n = 0; n < 2; ++n) acc[a][b][m][n] = (f32x4){0.f, 0.f, 0.f, 0.f};
        cur = nxt; ++ui;
        if constexpr (ALIGN_EPI) { if (wr == 1) PG8_BAR; }
    }
    PG8_WAIT_V(0);
    if constexpr (!ALIGN_EPI) { if (wr == 0) PG8_BAR; }
    PG8_BAR;
#undef PG8_SA
#undef PG8_SB
#undef PG8_STAGE_A
#undef PG8_STAGE_B
#undef PG8_LDA
#undef PG8_LDB
#undef PG8_MMA
#undef PG8_WAIT_V
#undef PG8_WAIT_L
#undef PG8_BAR
#undef PG8_SCHED
}
}

namespace pg8 {
struct EpiQKV {
    static constexpr bool PERM = true;
    unsigned char* ws; const float* gn; const float* rope;
    __device__ __forceinline__ void operator()(const f32x4 (&acc)[2][2][4][2], const Unit& u, int wr, int wc, int fr, int fq) const {
        const int pn = u.pn, tb = u.pm % 65;
        const bool is_ctx = (tb == 0);
        const bool isV = (pn >= 4) && (wc >= 2);
        const float* gain = gn + (pn < 2 ? 0 : (pn < 4 ? 64 : (pn == 4 ? 128 : 192)));
        const float osc = pn < 4 ? C2 : 1.0f;
        bf16_t* dst = (bf16_t*)(ws + (pn < 4 ? WS_QO : WS_KV));
        const int ldd = pn < 4 ? 1024 : 512, colbase = 256 * (pn < 4 ? pn : pn - 4) + 64 * wc;
        f32x4 gv[2][2];
#pragma unroll
        for (int bj = 0; bj < 2; ++bj)
#pragma unroll
            for (int n = 0; n < 2; ++n) gv[bj][n] = *(const f32x4*)(gain + 32 * bj + 16 * n + 4 * fq);
        asm volatile("" : "+v"(gv[0][0]), "+v"(gv[0][1]), "+v"(gv[1][0]), "+v"(gv[1][1]));
#pragma unroll
        for (int ai = 0; ai < 2; ++ai)
#pragma unroll
            for (int m = 0; m < 4; ++m) {
                const int row = u.pm * BM + ai * HALF + wr * 64 + m * 16 + fr;
                f32x4 v[2][2];
#pragma unroll
                for (int bj = 0; bj < 2; ++bj)
#pragma unroll
                    for (int n = 0; n < 2; ++n) v[bj][n] = acc[ai][bj][m][n];
                if (!isV) {
                    float ss = 0.f;
#pragma unroll
                    for (int bj = 0; bj < 2; ++bj)
#pragma unroll
                        for (int n = 0; n < 2; ++n) { const f32x4 x = v[bj][n]; ss += (x[0] * x[0] + x[1] * x[1]) + (x[2] * x[2] + x[3] * x[3]); }
                    ss += __shfl_xor(ss, 16); ss += __shfl_xor(ss, 32);
                    const float rs = osc / sqrtf(ss * (1.0f / 64.0f) + NORM_EPS);
#pragma unroll
                    for (int bj = 0; bj < 2; ++bj)
#pragma unroll
                        for (int n = 0; n < 2; ++n) v[bj][n] = v[bj][n] * rs * gv[bj][n];
                    if (!is_ctx) {
                        const int pr = (tb - 1) * 4 + 2 * ai + wr, pc = 16 * m + fr;
#pragma unroll
                        for (int bj = 0; bj < 2; ++bj) {
                            const int pos = bj ? pc : pr;
                            const f32x4* rp = (const f32x4*)(rope + (size_t)(pos * 16 + 4 * fq) * 2);
                            const f32x4 r0 = rp[0], r1 = rp[1];
                            const f32x4 cs = (f32x4){r0[0], r0[2], r1[0], r1[2]}, sn = (f32x4){r0[1], r0[3], r1[1], r1[3]};
                            const f32x4 x1 = v[bj][0], x2 = v[bj][1];
                            v[bj][0] = x1 * cs - x2 * sn; v[bj][1] = x2 * cs + x1 * sn;
                        }
                    }
                }
                if (pn < 4) {
                    bf16_t* rowp = dst + (size_t)row * ldd + colbase + 4 * fq;
#pragma unroll
                    for (int bj = 0; bj < 2; ++bj)
#pragma unroll
                        for (int n = 0; n < 2; ++n) { u32x2 w; w.x = cvt_pk_bf16(v[bj][n][0], v[bj][n][1]); w.y = cvt_pk_bf16(v[bj][n][2], v[bj][n][3]); *(u32x2*)(rowp + 32 * bj + 16 * n) = w; }
                } else {
                    unsigned char* tb = (unsigned char*)dst + ((size_t)(u.pm * 4 + ai * 2 + wr) * 8 + (isV ? 4 : 0) + 2 * (pn - 4) + (wc & 1)) * 8192;
                    if (!isV) {
                        const unsigned kof = (unsigned)((fq >> 1) * 1024 + (16 * m + fr) * 16 + 8 * (fq & 1));
#pragma unroll
                        for (int bj = 0; bj < 2; ++bj)
#pragma unroll
                            for (int n = 0; n < 2; ++n) { u32x2 w; w.x = cvt_pk_bf16(v[bj][n][0], v[bj][n][1]); w.y = cvt_pk_bf16(v[bj][n][2], v[bj][n][3]);
                                *(u32x2*)(tb + (kof + (unsigned)((4 * bj + 2 * n) * 1024))) = w; }
                    } else {
                        const int sub = fr >> 2, hb = sub & 1;
                        const unsigned vbase = (unsigned)(4 * fq * 128 + (4 * (sub >> 1) + (fr & 3)) * 2);
#pragma unroll
                        for (int j = 0; j < 4; ++j) { const int swz = (2 * fq + (j >> 1)) & 7;
                            const unsigned vof = vbase + (unsigned)(j * 128) + (unsigned)((((2 * m) ^ (swz & 6)) | ((hb ^ swz) & 1)) * 16);
#pragma unroll
                            for (int bj = 0; bj < 2; ++bj)
#pragma unroll
                                for (int n = 0; n < 2; ++n) *(bf16_t*)(tb + (vof + (unsigned)((32 * bj + 16 * n) * 128))) = (bf16_t)f2bf(v[bj][n][j]); }
                    }
                }
            }
    }
};
struct EpiResid {
    static constexpr bool PERM = false;
    float* XS; const float* modv_l; int goff; float sgn;
    __device__ __forceinline__ void operator()(const f32x4 (&acc)[2][2][4][2], const Unit& u, int wr, int wc, int fr, int fq) const {
        const int mv = (u.pm % 65 == 0) ? 2 : (u.pm / 65);
        const float* g = modv_l + mv * 6144 + goff;
        const int col0 = u.pn * BM + wc * 32 + 4 * fq;
        f32x4 gv[2][2];
#pragma unroll
        for (int bj = 0; bj < 2; ++bj)
#pragma unroll
            for (int n = 0; n < 2; ++n) gv[bj][n] = *(const f32x4*)(g + col0 + bj * HALF + n * 16);
#pragma unroll
        for (int ai = 0; ai < 2; ++ai)
#pragma unroll
            for (int m = 0; m < 4; ++m) {
                float* rowp = XS + (size_t)(u.pm * BM + ai * HALF + wr * 64 + m * 16 + fr) * 1024 + col0;
#pragma unroll
                for (int bj = 0; bj < 2; ++bj)
#pragma unroll
                    for (int n = 0; n < 2; ++n) { f32x4* p = (f32x4*)(rowp + bj * HALF + n * 16); f32x4 x = *p; x = x + (gv[bj][n] * sgn) * acc[ai][bj][m][n]; *p = x; }
            }
    }
};
struct EpiGU {
    static constexpr bool PERM = true;
    bf16_t* ACT; const f32x2* wts;
    __device__ __forceinline__ void operator()(const f32x4 (&acc)[2][2][4][2], const Unit& u, int wr, int wc, int fr, int fq) const {
        const int k = u.pn >= 4 ? 1 : 0, jt = u.pn & 3;
        const int colbase = 512 * k + 128 * jt + 32 * wc + 8 * fq;
#pragma unroll
        for (int ai = 0; ai < 2; ++ai)
#pragma unroll
            for (int m = 0; m < 4; ++m) {
                const int r = ai * HALF + wr * 64 + m * 16 + fr;
                int idx = u.row0 + r; idx = idx < u.ncls ? idx : u.ncls - 1;
                const f32x2 w2 = wts[(size_t)u.cls * CAP + idx];
                const float w = k ? w2[1] : w2[0];
                u32x4 o;
#pragma unroll
                for (int n = 0; n < 2; ++n) {
                    const f32x4 g = acc[ai][0][m][n], up = acc[ai][1][m][n]; float a[4];
#pragma unroll
                    for (int j = 0; j < 4; ++j) { const float sg = g[j] * __builtin_amdgcn_rcpf(1.0f + __builtin_amdgcn_exp2f(-g[j] * LOG2E)); a[j] = w * sg * up[j]; }
                    const unsigned lo = cvt_pk_bf16(a[0], a[1]), hi = cvt_pk_bf16(a[2], a[3]);
                    if (n == 0) { o.x = lo; o.y = hi; } else { o.z = lo; o.w = hi; }
                }
                *(u32x4*)(ACT + (size_t)(u.pm * BM + r) * 1024 + colbase) = o;
            }
    }
};
struct EpiDown {
    static constexpr bool PERM = false;
    float* XS; float* out; const int* tok; const float* modv_l; float sgn;
    __device__ __forceinline__ void operator()(const f32x4 (&acc)[2][2][4][2], const Unit& u, int wr, int wc, int fr, int fq) const {
        const int col0 = u.pn * BM + wc * 32 + 4 * fq;
#pragma unroll
        for (int ai = 0; ai < 2; ++ai)
#pragma unroll
            for (int m = 0; m < 4; ++m) {
                const int idx = u.row0 + ai * HALF + wr * 64 + m * 16 + fr;
                if (idx < u.ncls) {
                    const int t = tok[(size_t)u.cls * CAP + idx];
                    const int b = t >= RB ? 1 : 0, rr = t - b * RB;
                    const int mv = rr < NCTX ? 2 : b;
                    const float* g = modv_l + mv * 6144 + 5120 + col0;
                    const float* src = XS + (size_t)t * 1024 + col0;
                    float* dstp = out ? out + (size_t)(b * SEQ + rr - NCTX) * 1024 + col0 : XS + (size_t)t * 1024 + col0;
#pragma unroll
                    for (int bj = 0; bj < 2; ++bj)
#pragma unroll
                        for (int n = 0; n < 2; ++n) { const int c = bj * HALF + n * 16; f32x4 x = *(const f32x4*)(src + c); const f32x4 gv = *(const f32x4*)(g + c); x = x + (gv * sgn) * acc[ai][bj][m][n]; *(f32x4*)(dstp + c) = x; }
                }
            }
    }
};
}

namespace attn_body {
using bf16 = __hip_bfloat16;
using s16x4 = __attribute__((ext_vector_type(4))) short;
using f32x16 = __attribute__((ext_vector_type(16))) float;
constexpr int D = 64, QP = 1024, KP = 512;
constexpr int NW = 8, QBLK = 32, QB = QBLK * NW, KVBLK = 64;
__device__ __forceinline__ int crow(int r, int hi) { return (r & 3) + 8 * (r >> 2) + 4 * hi; }
#define SBAR() __builtin_amdgcn_sched_barrier(0)
constexpr int NSLOT = 3, SLOTB = 8192;
constexpr int LDS_K = 0, LDS_V = NSLOT * SLOTB, LDS_WS = 2 * NSLOT * SLOTB, LDS_OST = LDS_WS + NW * 64 * 4, LDS_BYTES = LDS_OST + NW * 4096;
__device__ __forceinline__ void glds16(const void* gsrc, unsigned lds_dst) { unsigned keep;
  asm volatile("s_mov_b32 %0, m0\n\ts_mov_b32 m0, %2\n\ts_nop 0\n\tglobal_load_lds_dwordx4 %1, off\n\ts_mov_b32 m0, %0" : "=&s"(keep) : "v"(gsrc), "s"(lds_dst) : "memory"); }
__device__ __forceinline__ float max3f(float a, float b, float c) { float r; asm("v_max3_f32 %0, %1, %2, %3" : "=v"(r) : "v"(a), "v"(b), "v"(c)); return r; }
__device__ __forceinline__ float max2f(float a, float b) { float r; asm("v_max_f32_e32 %0, %1, %2" : "=v"(r) : "v"(a), "v"(b)); return r; }
__device__ __forceinline__ float fadd_s(float a, float b) { float r; asm("v_add_f32_e32 %0, %1, %2" : "=v"(r) : "v"(a), "v"(b)); return r; }
__device__ __forceinline__ float fsub_s(float a, float b) { float r; asm("v_sub_f32_e32 %0, %1, %2" : "=v"(r) : "v"(a), "v"(b)); return r; }
typedef float f32x2_t __attribute__((ext_vector_type(2))); typedef __bf16 bf16x2_t __attribute__((ext_vector_type(2)));
__device__ __forceinline__ unsigned cvtpk_s(float lo, float hi) { f32x2_t v = {lo, hi}; bf16x2_t b = __builtin_convertvector(v, bf16x2_t); return __builtin_bit_cast(unsigned, b); }
#define WAIT_BAR(N) asm volatile("s_waitcnt vmcnt(" #N ") lgkmcnt(0)\n\ts_barrier" ::: "memory")

__device__ __forceinline__ void qkt(f32x16& p0, f32x16& p1, const char* Kslot, const bf16x8* qr, const f32x16& negm, int r32, int hi) {
  const char* kb = Kslot + hi * 1024 + r32 * 16;
  #pragma unroll
  for (int d0 = 0; d0 < 4; ++d0) {
    const bf16x8 b0 = *reinterpret_cast<const bf16x8*>(kb + d0 * 2048);
    const bf16x8 b1 = *reinterpret_cast<const bf16x8*>(kb + d0 * 2048 + 512);
    if (d0 == 0) { p0 = __builtin_amdgcn_mfma_f32_32x32x16_bf16(b0, qr[0], negm, 0, 0, 0); p1 = __builtin_amdgcn_mfma_f32_32x32x16_bf16(b1, qr[0], negm, 0, 0, 0); }
    else { p0 = __builtin_amdgcn_mfma_f32_32x32x16_bf16(b0, qr[d0], p0, 0, 0, 0); p1 = __builtin_amdgcn_mfma_f32_32x32x16_bf16(b1, qr[d0], p1, 0, 0, 0); } }
}
typedef __attribute__((address_space(3))) const char* lds_cptr;
typedef short v4i16_t __attribute__((ext_vector_type(4)));
__device__ __forceinline__ void kload8(bf16x8* kf, lds_cptr kp) {
  kf[0] = *(const LAS bf16x8*)(kp);        kf[1] = *(const LAS bf16x8*)(kp + 512);
  kf[2] = *(const LAS bf16x8*)(kp + 2048); kf[3] = *(const LAS bf16x8*)(kp + 2560);
  kf[4] = *(const LAS bf16x8*)(kp + 4096); kf[5] = *(const LAS bf16x8*)(kp + 4608);
  kf[6] = *(const LAS bf16x8*)(kp + 6144); kf[7] = *(const LAS bf16x8*)(kp + 6656);
}
__device__ __forceinline__ void kload2(bf16x8* kf, lds_cptr kp, int j) { kf[2 * j] = *(const LAS bf16x8*)(kp + j * 2048); kf[2 * j + 1] = *(const LAS bf16x8*)(kp + j * 2048 + 512); }
__device__ __forceinline__ s16x4 vtr(lds_cptr p) { return __builtin_bit_cast(s16x4, __builtin_amdgcn_ds_read_tr16_b64_v4i16((LAS v4i16_t*)p)); }
__device__ __forceinline__ float rowmax(const f32x16& p0, const f32x16& p1) {
  float a = max3f(p0[0], p0[1], p1[0]), b = max3f(p0[2], p0[3], p1[1]); a = max3f(a, p1[2], p1[3]);
  #pragma unroll
  for (int r = 4; r < 16; r += 4) { a = max3f(a, p0[r], p0[r + 1]); b = max3f(b, p0[r + 2], p0[r + 3]); a = max3f(a, p1[r], p1[r + 1]); b = max3f(b, p1[r + 2], p1[r + 3]); }
  const float m = max2f(a, b);
  auto rr = __builtin_amdgcn_permlane32_swap(__float_as_uint(m), __float_as_uint(m), false, false);
  return max2f(__uint_as_float(rr[0]), __uint_as_float(rr[1]));
}
__device__ __forceinline__ void pv(f32x16* o, int vb, bf16x8 pa0, bf16x8 pa1, bf16x8 pa2, bf16x8 pa3) {
  #pragma unroll
  for (int d0 = 0; d0 < 2; ++d0) { s16x4 lo[4], hi[4];
    #pragma unroll
    for (int ks = 0; ks < 4; ++ks) {
      asm volatile("ds_read_b64_tr_b16 %0,%1 offset:%c2" : "=&v"(lo[ks]) : "v"(vb), "i"(d0 * 4096 + ks * 1024) : "memory");
      asm volatile("ds_read_b64_tr_b16 %0,%1 offset:%c2" : "=&v"(hi[ks]) : "v"(vb), "i"(d0 * 4096 + ks * 1024 + 512) : "memory"); }
    asm volatile("s_waitcnt lgkmcnt(0)" ::: "memory"); SBAR();
    #define PK(k) (bf16x8){lo[k][0], lo[k][1], lo[k][2], lo[k][3], hi[k][0], hi[k][1], hi[k][2], hi[k][3]}
    o[d0] = __builtin_amdgcn_mfma_f32_32x32x16_bf16(pa0, PK(0), o[d0], 0, 0, 0);
    o[d0] = __builtin_amdgcn_mfma_f32_32x32x16_bf16(pa1, PK(1), o[d0], 0, 0, 0);
    o[d0] = __builtin_amdgcn_mfma_f32_32x32x16_bf16(pa2, PK(2), o[d0], 0, 0, 0);
    o[d0] = __builtin_amdgcn_mfma_f32_32x32x16_bf16(pa3, PK(3), o[d0], 0, 0, 0);
    #undef PK
  }
}
__device__ __forceinline__ void pv2(f32x16* o, const lds_cptr* vq, int slot, bf16x8 pa0, bf16x8 pa1, bf16x8 pa2, bf16x8 pa3) {
  #pragma unroll
  for (int d0 = 0; d0 < 2; ++d0) {
    const bf16x8 v0 = *(const LAS bf16x8*)(vq[0] + slot + d0 * 4096), v1 = *(const LAS bf16x8*)(vq[1] + slot + d0 * 4096), v2 = *(const LAS bf16x8*)(vq[2] + slot + d0 * 4096), v3 = *(const LAS bf16x8*)(vq[3] + slot + d0 * 4096);
    o[d0] = __builtin_amdgcn_mfma_f32_32x32x16_bf16(pa0, v0, o[d0], 0, 0, 0);
    o[d0] = __builtin_amdgcn_mfma_f32_32x32x16_bf16(pa1, v1, o[d0], 0, 0, 0);
    o[d0] = __builtin_amdgcn_mfma_f32_32x32x16_bf16(pa2, v2, o[d0], 0, 0, 0);
    o[d0] = __builtin_amdgcn_mfma_f32_32x32x16_bf16(pa3, v3, o[d0], 0, 0, 0);
  }
}
__device__ __forceinline__ void bandmask(f32x16& p0, f32x16& p1, int t, int mlo, unsigned mspan, int qrel, int hi) {
  const float NEG = -INFINITY; const int kb = 64 * (t - 4) - 128 + 4 * hi - qrel - mlo;
  #pragma unroll
  for (int r = 0; r < 16; ++r) { const int d0 = kb + (r & 3) + 8 * (r >> 2); if ((unsigned)d0 > mspan) p0[r] = NEG; if ((unsigned)(d0 + 32) > mspan) p1[r] = NEG; }
}
#ifndef FASTEXP
#define FASTEXP 0
#endif
__device__ __forceinline__ float exp2_fast(float x) { const float t = __builtin_fmaf(x, 8388608.0f, 1064986823.0f); unsigned u; asm("v_cvt_u32_f32 %0, %1" : "=v"(u) : "v"(t)); return __builtin_bit_cast(float, u); }
#define ATTN_STORE16(p, v) (*(u32x4*)(p) = (v))

template <int MODE, int THRL> __device__ __forceinline__ void attn_unit(long qrow, long kvrow, int q0, int qcol, int kcol, int vcol, int NT, float sink2, const bf16* Q, const bf16* __restrict__ KVb, bf16* O, char* shm) {
  int tid_ = threadIdx.x; asm volatile("" : "+v"(tid_));
  const int tid = tid_, lane = tid & 63, r32 = lane & 31, hi = lane >> 5; const int wid = __builtin_amdgcn_readfirstlane(tid >> 6);
  const bf16* Qw = Q + (qrow + wid * QBLK) * QP + qcol;
  const char* kvt = (const char*)KVb + (size_t)(kvrow >> 6) * 65536 + wid * 1024 + lane * 16;
  const unsigned lds0 = (unsigned)(uintptr_t)shm;
  float* wsf = (float*)(shm + LDS_WS) + wid * 64;
  const char* ksrc = kvt + kcol * 8192; const char* vsrc = kvt + vcol * 8192;
  const unsigned kdst = lds0 + LDS_K + wid * 1024, vdst = lds0 + LDS_V + wid * 1024;
  #define ROWOFF(t) ((long)(MODE == 1 ? ((t) + ((t) >= 4 ? ((q0 - 128) >> 6) : 0)) : (t)) * 65536)
  #define DMA_K(t, slot) glds16(ksrc + ROWOFF(t), (unsigned)__builtin_amdgcn_readfirstlane(kdst + (slot)))
  #define DMA_V(t, slot) glds16(vsrc + ROWOFF(t), (unsigned)__builtin_amdgcn_readfirstlane(vdst + (slot)))
  const char* Kbase = shm + LDS_K; bf16x8 kf[8];
  const lds_cptr shm3 = (lds_cptr)shm; const lds_cptr kp0 = shm3 + LDS_K + hi * 1024 + r32 * 16; lds_cptr vq[4];
  { const int swz = (r32 >> 1) & 7; _Pragma("unroll") for (int ks_ = 0; ks_ < 4; ++ks_) vq[ks_] = shm3 + LDS_V + r32 * 128 + (((2 * ks_ + hi) ^ swz) * 16); }
  DMA_K(0, 0); DMA_V(0, 0); DMA_K(1, SLOTB);
  bf16x8 qr[4];
  #pragma unroll
  for (int d0 = 0; d0 < 4; ++d0) qr[d0] = *reinterpret_cast<const bf16x8*>(&Qw[(long)r32 * QP + d0 * 16 + hi * 8]);
  float mhat = 0.f, l_reg = 0.f; f32x16 o[2]; o[0] = f32x16{}; o[1] = f32x16{}; f32x16 negm = f32x16{}; asm volatile("" : "+v"(negm));
  const int qrel = wid * QBLK + r32;
  int mlo = -128, mhi = 128;
  if (MODE == 1) { const int qi = q0 + qrel; mlo = (-qi > -128) ? -qi : -128; mhi = (SEQ - 1 - qi < 128) ? (SEQ - 1 - qi) : 128; }
  const unsigned mspan = (unsigned)(mhi - mlo);
  #define CMASK(P0, P1, t) do { if (MODE == 1) { if ((t) >= 4) bandmask(P0, P1, (t), mlo, mspan, qrel, hi); } } while (0)
  bool resc = false;
  #define START(P0, P1) do { const float rm = rowmax(P0, P1); resc = false; \
    { const float dl = rm; mhat = fadd_s(mhat, dl); \
      _Pragma("unroll") for (int r = 0; r < 16; ++r) { P0[r] = fsub_s(P0[r], dl); P1[r] = fsub_s(P1[r], dl); } \
      _Pragma("unroll") for (int r = 0; r < 16; ++r) negm[r] = -mhat; asm volatile("" : "+v"(negm)); } \
    _Pragma("unroll") for (int r = 0; r < 16; ++r) P0[r] = __builtin_amdgcn_exp2f(P0[r]); } while (0)
  #define RESC() do { if (resc) { asm volatile("s_waitcnt lgkmcnt(0)" ::: "memory"); \
      _Pragma("unroll") for (int d_ = 0; d_ < 2; ++d_) _Pragma("unroll") for (int r = 0; r < 16; ++r) o[d_][r] *= wsf[crow(r, hi)]; } } while (0)
  f32x16 pA0, pA1, pB0, pB1;
  int sl_prev = 0, sl_cur = 0, sl_next = SLOTB;
  #define ROT() do { sl_prev = sl_cur; sl_cur = sl_next; sl_next = (sl_next == (NSLOT - 1) * SLOTB) ? 0 : sl_next + SLOTB; } while (0)
  DMA_K(2, 2 * SLOTB);
  WAIT_BAR(3);
  qkt(pA0, pA1, Kbase, qr, negm, r32, hi); asm volatile("s_nop 15\n\ts_nop 7" : "+v"(pA0), "+v"(pA1)); CMASK(pA0, pA1, 0);
  START(pA0, pA1);
  _Pragma("unroll") for (int r = 0; r < 16; ++r) pA1[r] = __builtin_amdgcn_exp2f(pA1[r]);
  WAIT_BAR(0);
  DMA_K(3, 0); DMA_V(1, SLOTB);
  ROT();
  kload8(kf, kp0 + sl_cur);
  WAIT_BAR(2);
  bf16x8 vfr[8]; u32x4 pw0, pw1, pw2, pw3;
  #define PKW(P, B) cvtpk_s(P[B], P[B + 1])
  #define PAF(k) __builtin_bit_cast(bf16x8, pw##k)
  #define VFR(i) vfr[i]
  #define PIN(x) asm volatile("" : "+v"(x))
  #define MX3(a, b, c) __builtin_fmaxf(__builtin_fmaxf((a), (b)), (c))
  #define GAPA(MF, A0, A1, A2, A3, W0, W1, PW) do { MF; sacc += A0; sacc += A1; sacc += A2; sacc += A3; PIN(sacc); W0; W1; PIN(PW); SBAR(); } while (0)
  #define EX(v) __builtin_amdgcn_exp2f(v)
  #define GAPB(MF, X, B) do { MF; X[B] = EX(X[B]); X[B + 1] = EX(X[B + 1]); X[B + 2] = EX(X[B + 2]); X[B + 3] = EX(X[B + 3]); PIN(X); SBAR(); } while (0)
  #define VRD(i) do { vfr[i] = *(const LAS bf16x8*)(vq[(i) & 3] + vsl_ + ((i) >> 2) * 4096); } while (0)
  #define KRD(G, j) do { if (G) { kload2(kf, kp0 + sl_next, j); SBAR(); } } while (0)
  #define STEP(C0, C1, P0, P1, t, GK, GV, GL) do { SBAR(); \
    const int vsl_ = sl_prev; \
    VRD(0); SBAR(); float sacc = (P0[0] + P0[1]); \
    GAPA(C0 = __builtin_amdgcn_mfma_f32_32x32x16_bf16(kf[0], qr[0], negm, 0, 0, 0), P0[2], P0[3], P0[4], P0[5],     pw0[0] = PKW(P0, 0), pw0[1] = PKW(P0, 2), pw0); \
    VRD(4); SBAR(); GAPA(C1 = __builtin_amdgcn_mfma_f32_32x32x16_bf16(kf[1], qr[0], negm, 0, 0, 0), P0[6], P0[7], P0[8], P0[9],     pw0[2] = PKW(P0, 4), pw0[3] = PKW(P0, 6), pw0); \
    VRD(1); SBAR(); GAPA(C0 = __builtin_amdgcn_mfma_f32_32x32x16_bf16(kf[2], qr[1], C0, 0, 0, 0),   P0[10], P0[11], P0[12], P0[13], pw1[0] = PKW(P0, 8), pw1[1] = PKW(P0, 10), pw1); \
    VRD(5); SBAR(); GAPA(C1 = __builtin_amdgcn_mfma_f32_32x32x16_bf16(kf[3], qr[1], C1, 0, 0, 0),   P0[14], P0[15], P1[0], P1[1],   pw1[2] = PKW(P0, 12), pw1[3] = PKW(P0, 14), pw1); \
    VRD(2); SBAR(); GAPA(C0 = __builtin_amdgcn_mfma_f32_32x32x16_bf16(kf[4], qr[2], C0, 0, 0, 0),   P1[2], P1[3], P1[4], P1[5],     pw2[0] = PKW(P1, 0), pw2[1] = PKW(P1, 2), pw2); \
    VRD(6); SBAR(); GAPA(C1 = __builtin_amdgcn_mfma_f32_32x32x16_bf16(kf[5], qr[2], C1, 0, 0, 0),   P1[6], P1[7], P1[8], P1[9],     pw2[2] = PKW(P1, 4), pw2[3] = PKW(P1, 6), pw2); \
    VRD(3); SBAR(); GAPA(C0 = __builtin_amdgcn_mfma_f32_32x32x16_bf16(kf[6], qr[3], C0, 0, 0, 0),   P1[10], P1[11], P1[12], P1[13], pw3[0] = PKW(P1, 8), pw3[1] = PKW(P1, 10), pw3); \
    VRD(7); SBAR(); GAPA(C1 = __builtin_amdgcn_mfma_f32_32x32x16_bf16(kf[7], qr[3], C1, 0, 0, 0),   P1[14], P1[15], 0.f, 0.f,       pw3[2] = PKW(P1, 12), pw3[3] = PKW(P1, 14), pw3); \
    l_reg += sacc; \
    if (GK) { DMA_K((t) + 3, sl_cur); } if (GV) { DMA_V((t) + 1, sl_next); } \
    CMASK(C0, C1, t); \
    { float a = MX3(C0[0], C0[1], C1[0]), b = MX3(C0[2], C0[3], C1[1]); a = MX3(a, C1[2], C1[3]); \
      _Pragma("unroll") for (int r = 4; r < 16; r += 4) { a = MX3(a, C0[r], C0[r + 1]); b = MX3(b, C0[r + 2], C0[r + 3]); a = MX3(a, C1[r], C1[r + 1]); b = MX3(b, C1[r + 2], C1[r + 3]); } \
      float rm = __builtin_fmaxf(a, b); { auto rr = __builtin_amdgcn_permlane32_swap(__float_as_uint(rm), __float_as_uint(rm), false, false); rm = __builtin_fmaxf(__uint_as_float(rr[0]), __uint_as_float(rr[1])); } \
      resc = false; \
      if (__builtin_expect(__any(rm > (float)THRL), 0)) { const float dl = __builtin_fmaxf(rm, 0.f); mhat += dl; \
        _Pragma("unroll") for (int r = 0; r < 16; ++r) { C0[r] -= dl; C1[r] -= dl; } \
        _Pragma("unroll") for (int r = 0; r < 16; ++r) negm[r] = -mhat; asm volatile("" : "+v"(negm)); \
        const float f = __builtin_amdgcn_exp2f(-dl); l_reg *= f; if (hi == 0) wsf[r32] = f; resc = true; } } \
    SBAR(); \
    GAPB(o[0] = __builtin_amdgcn_mfma_f32_32x32x16_bf16(PAF(0), VFR(0), o[0], 0, 0, 0), C0, 0); \
    GAPB(o[1] = __builtin_amdgcn_mfma_f32_32x32x16_bf16(PAF(0), VFR(4), o[1], 0, 0, 0), C0, 4); \
    KRD(GL, 0); GAPB(o[0] = __builtin_amdgcn_mfma_f32_32x32x16_bf16(PAF(1), VFR(1), o[0], 0, 0, 0), C0, 8); \
    KRD(GL, 1); GAPB(o[1] = __builtin_amdgcn_mfma_f32_32x32x16_bf16(PAF(1), VFR(5), o[1], 0, 0, 0), C0, 12); \
    KRD(GL, 2); GAPB(o[0] = __builtin_amdgcn_mfma_f32_32x32x16_bf16(PAF(2), VFR(2), o[0], 0, 0, 0), C1, 0); \
    KRD(GL, 3); GAPB(o[1] = __builtin_amdgcn_mfma_f32_32x32x16_bf16(PAF(2), VFR(6), o[1], 0, 0, 0), C1, 4); \
    GAPB(o[0] = __builtin_amdgcn_mfma_f32_32x32x16_bf16(PAF(3), VFR(3), o[0], 0, 0, 0), C1, 8); \
    GAPB(o[1] = __builtin_amdgcn_mfma_f32_32x32x16_bf16(PAF(3), VFR(7), o[1], 0, 0, 0), C1, 12); \
    } while (0)
  int t = 1;
  for (; t + 5 < NT; t += 2) {
    STEP(pB0, pB1, pA0, pA1, t, true, true, true);     WAIT_BAR(2); RESC(); ROT();
    STEP(pA0, pA1, pB0, pB1, t + 1, true, true, true);   WAIT_BAR(2); RESC(); ROT();
  }
  #define ENDW(tt) do { if ((tt) + 3 < NT) { WAIT_BAR(2); } else if ((tt) + 2 < NT) { WAIT_BAR(1); } else { WAIT_BAR(0); } } while (0)
  for (; t + 1 < NT; t += 2) {
    STEP(pB0, pB1, pA0, pA1, t, (t + 3 < NT), (t + 1 < NT), (t + 1 < NT));       ENDW(t);   RESC(); ROT();
    STEP(pA0, pA1, pB0, pB1, t + 1, (t + 4 < NT), (t + 2 < NT), (t + 2 < NT));     ENDW(t + 1); RESC(); ROT();
  }
  STEP(pB0, pB1, pA0, pA1, NT - 1, false, false, false); RESC();
  { float sacc = pB0[0] + pB0[1]; _Pragma("unroll") for (int r = 2; r < 16; ++r) sacc += pB0[r]; _Pragma("unroll") for (int r = 0; r < 16; ++r) sacc += pB1[r]; l_reg += sacc;
    pw0 = (u32x4){PKW(pB0, 0), PKW(pB0, 2), PKW(pB0, 4), PKW(pB0, 6)}; pw1 = (u32x4){PKW(pB0, 8), PKW(pB0, 10), PKW(pB0, 12), PKW(pB0, 14)}; pw2 = (u32x4){PKW(pB1, 0), PKW(pB1, 2), PKW(pB1, 4), PKW(pB1, 6)}; pw3 = (u32x4){PKW(pB1, 8), PKW(pB1, 10), PKW(pB1, 12), PKW(pB1, 14)};
    SBAR(); pv2(o, vq, sl_cur, PAF(0), PAF(1), PAF(2), PAF(3)); }
  #undef PKW
  #undef PAF
  #undef VFR
  #undef PIN
  #undef MX3
  #undef GAPA
  #undef GAPB
  #undef EX
  #undef VRD
  #undef KRD
  #undef STEP
  #undef ENDW
  { auto rr = __builtin_amdgcn_permlane32_swap(__float_as_uint(l_reg), __float_as_uint(l_reg), false, false); l_reg = __uint_as_float(rr[0]) + __uint_as_float(rr[1]); }
  l_reg += __builtin_amdgcn_exp2f(sink2 - mhat);
  if (hi == 0) wsf[32 + r32] = l_reg; asm volatile("s_waitcnt lgkmcnt(0)" ::: "memory");
  float rli[16];
  #pragma unroll
  for (int r = 0; r < 16; ++r) rli[r] = __builtin_amdgcn_rcpf(wsf[32 + crow(r, hi)]);
  bf16* Ow = O + (qrow + wid * QBLK) * QP + qcol;
  { bf16* stg = (bf16*)(shm + LDS_OST) + wid * 2048;
    #pragma unroll
    for (int r = 0; r < 16; ++r) { const int orow = crow(r, hi);
      #pragma unroll
      for (int d0 = 0; d0 < 2; ++d0) stg[orow * 64 + d0 * 32 + r32] = __float2bfloat16(o[d0][r] * rli[r]); }
    asm volatile("s_waitcnt lgkmcnt(0)" ::: "memory");
    #pragma unroll
    for (int i = 0; i < 4; ++i) { const int row = i * 8 + (lane >> 3), ch = lane & 7; const u32x4 v = *(const u32x4*)(stg + row * 64 + ch * 8); ATTN_STORE16(Ow + (long)row * QP + ch * 8, v); } }
  asm volatile("s_waitcnt lgkmcnt(0)\n\ts_barrier" ::: "memory");
  #undef DMA_K
  #undef DMA_V
  #undef ROWOFF
  #undef CMASK
  #undef START
  #undef RESC
  #undef ROT
}
template <int MODE, int XV = 0> __device__ __forceinline__ void attn_unit_sb(long qrow, long kvrow, int q0, int qcol, int kcol, int vcol, int NT, float sink2, float bound, const bf16* Q, const bf16* __restrict__ KVb, bf16* O, char* shm) {
  int tid_ = threadIdx.x; asm volatile("" : "+v"(tid_));
  const int tid = tid_, lane = tid & 63, r32 = lane & 31, hi = lane >> 5; const int wid = __builtin_amdgcn_readfirstlane(tid >> 6);
  const bf16* Qw = Q + (qrow + wid * QBLK) * QP + qcol;
  const char* kvt = (const char*)KVb + (size_t)(kvrow >> 6) * 65536 + wid * 1024 + lane * 16;
  const unsigned lds0 = (unsigned)(uintptr_t)shm;
  const char* ksrc = kvt + kcol * 8192; const char* vsrc = kvt + vcol * 8192;
  const unsigned kdst = lds0 + LDS_K + wid * 1024, vdst = lds0 + LDS_V + wid * 1024;
  #define ROWOFF(t) ((long)(MODE == 1 ? ((t) + ((t) >= 4 ? ((q0 - 128) >> 6) : 0)) : (t)) * 65536)
  #define DMA_K(t, slot) glds16(ksrc + ROWOFF(t), (unsigned)__builtin_amdgcn_readfirstlane(kdst + (slot)))
  #define DMA_V(t, slot) glds16(vsrc + ROWOFF(t), (unsigned)__builtin_amdgcn_readfirstlane(vdst + (slot)))
  const char* Kbase = shm + LDS_K; bf16x8 kf[8];
  const lds_cptr shm3 = (lds_cptr)shm; const lds_cptr kp0 = shm3 + LDS_K + hi * 1024 + r32 * 16; lds_cptr vq[4];
  { const int swz = (r32 >> 1) & 7; _Pragma("unroll") for (int ks_ = 0; ks_ < 4; ++ks_) vq[ks_] = shm3 + LDS_V + r32 * 128 + (((2 * ks_ + hi) ^ swz) * 16); }
  DMA_K(0, 0); DMA_V(0, 0); DMA_K(1, SLOTB);
  bf16x8 qr[4];
  #pragma unroll
  for (int d0 = 0; d0 < 4; ++d0) qr[d0] = *reinterpret_cast<const bf16x8*>(&Qw[(long)r32 * QP + d0 * 16 + hi * 8]);
  f32x16 o[2]; o[0] = f32x16{}; o[1] = f32x16{}; f32x16 osum = f32x16{};
  const f32x16 negm = f32x16{};
  bf16x8 ones;
  #pragma unroll
  for (int i = 0; i < 8; ++i) ones[i] = (short)0x3F80;
  asm volatile("" : "+v"(ones));
  const int qrel = wid * QBLK + r32;
  int mlo = -128, mhi = 128;
  if (MODE == 1) { const int qi = q0 + qrel; mlo = (-qi > -128) ? -qi : -128; mhi = (SEQ - 1 - qi < 128) ? (SEQ - 1 - qi) : 128; }
  const unsigned mspan = (unsigned)(mhi - mlo);
  #define CMASK(P0, P1, t) do { if (MODE == 1) { if ((t) >= 4) bandmask(P0, P1, (t), mlo, mspan, qrel, hi); } } while (0)
  f32x16 pA0, pA1, pB0, pB1;
  int sl_prev = 0, sl_cur = 0, sl_next = SLOTB;
  #define ROT() do { sl_prev = sl_cur; sl_cur = sl_next; sl_next = (sl_next == (NSLOT - 1) * SLOTB) ? 0 : sl_next + SLOTB; } while (0)
  DMA_K(2, 2 * SLOTB);
  WAIT_BAR(3);
  qkt(pA0, pA1, Kbase, qr, negm, r32, hi); asm volatile("s_nop 15\n\ts_nop 7" : "+v"(pA0), "+v"(pA1)); CMASK(pA0, pA1, 0);
  _Pragma("unroll") for (int r = 0; r < 16; ++r) { pA0[r] = __builtin_amdgcn_exp2f(pA0[r]); pA1[r] = __builtin_amdgcn_exp2f(pA1[r]); }
  WAIT_BAR(0);
  DMA_K(3, 0); DMA_V(1, SLOTB);
  ROT();
  kload8(kf, kp0 + sl_cur);
  WAIT_BAR(2);
  bf16x8 vfr[8]; u32x4 pw0, pw1, pw2, pw3;
  #define PKW(P, B) cvtpk_s(P[B], P[B + 1])
  #define PAF(k) __builtin_bit_cast(bf16x8, pw##k)
  #define VFR(i) vfr[i]
  #define PIN(x) asm volatile("" : "+v"(x))
  #define GAPA(MF, W0, W1, PW) do { MF; W0; W1; PIN(PW); SBAR(); } while (0)
  #define OSUM(k) do { if (XV != 5) osum = __builtin_amdgcn_mfma_f32_32x32x16_bf16(PAF(k), ones, osum, 0, 0, 0); SBAR(); } while (0)
  #define EX(v) (XV == 2 ? (v) : (FASTEXP ? exp2_fast(v) : __builtin_amdgcn_exp2f(v)))
  #define GAPB(MF, X, B) do { MF; X[B] = EX(X[B]); X[B + 1] = EX(X[B + 1]); X[B + 2] = EX(X[B + 2]); X[B + 3] = EX(X[B + 3]); PIN(X); SBAR(); } while (0)
  #define VRD(i) do { if (XV == 3) break; vfr[i] = *(const LAS bf16x8*)(vq[(i) & 3] + vsl_ + ((i) >> 2) * 4096); } while (0)
  #define KRD(G, j) do { if ((G) && XV != 3) { kload2(kf, kp0 + sl_next, j); SBAR(); } } while (0)
  #define STEP(C0, C1, P0, P1, t, GK, GV, GL) do { SBAR(); \
    const int vsl_ = sl_prev; \
    VRD(0); SBAR(); GAPA(C0 = __builtin_amdgcn_mfma_f32_32x32x16_bf16(kf[0], qr[0], negm, 0, 0, 0), pw0[0] = PKW(P0, 0), pw0[1] = PKW(P0, 2), pw0); \
    VRD(4); SBAR(); GAPA(C1 = __builtin_amdgcn_mfma_f32_32x32x16_bf16(kf[1], qr[0], negm, 0, 0, 0), pw0[2] = PKW(P0, 4), pw0[3] = PKW(P0, 6), pw0); \
    VRD(1); SBAR(); GAPA(C0 = __builtin_amdgcn_mfma_f32_32x32x16_bf16(kf[2], qr[1], C0, 0, 0, 0),   pw1[0] = PKW(P0, 8), pw1[1] = PKW(P0, 10), pw1); \
    OSUM(0); \
    VRD(5); SBAR(); GAPA(C1 = __builtin_amdgcn_mfma_f32_32x32x16_bf16(kf[3], qr[1], C1, 0, 0, 0),   pw1[2] = PKW(P0, 12), pw1[3] = PKW(P0, 14), pw1); \
    VRD(2); SBAR(); GAPA(C0 = __builtin_amdgcn_mfma_f32_32x32x16_bf16(kf[4], qr[2], C0, 0, 0, 0),   pw2[0] = PKW(P1, 0), pw2[1] = PKW(P1, 2), pw2); \
    OSUM(1); \
    VRD(6); SBAR(); GAPA(C1 = __builtin_amdgcn_mfma_f32_32x32x16_bf16(kf[5], qr[2], C1, 0, 0, 0),   pw2[2] = PKW(P1, 4), pw2[3] = PKW(P1, 6), pw2); \
    VRD(3); SBAR(); GAPA(C0 = __builtin_amdgcn_mfma_f32_32x32x16_bf16(kf[6], qr[3], C0, 0, 0, 0),   pw3[0] = PKW(P1, 8), pw3[1] = PKW(P1, 10), pw3); \
    OSUM(2); \
    VRD(7); SBAR(); GAPA(C1 = __builtin_amdgcn_mfma_f32_32x32x16_bf16(kf[7], qr[3], C1, 0, 0, 0),   pw3[2] = PKW(P1, 12), pw3[3] = PKW(P1, 14), pw3); \
    if (XV != 1) { if (GK) { DMA_K((t) + 3, sl_cur); } if (GV) { DMA_V((t) + 1, sl_next); } } \
    OSUM(3); \
    CMASK(C0, C1, t); \
    SBAR(); \
    GAPB(o[0] = __builtin_amdgcn_mfma_f32_32x32x16_bf16(PAF(0), VFR(0), o[0], 0, 0, 0), C0, 0); \
    GAPB(o[1] = __builtin_amdgcn_mfma_f32_32x32x16_bf16(PAF(0), VFR(4), o[1], 0, 0, 0), C0, 4); \
    KRD(GL, 0); GAPB(o[0] = __builtin_amdgcn_mfma_f32_32x32x16_bf16(PAF(1), VFR(1), o[0], 0, 0, 0), C0, 8); \
    KRD(GL, 1); GAPB(o[1] = __builtin_amdgcn_mfma_f32_32x32x16_bf16(PAF(1), VFR(5), o[1], 0, 0, 0), C0, 12); \
    KRD(GL, 2); GAPB(o[0] = __builtin_amdgcn_mfma_f32_32x32x16_bf16(PAF(2), VFR(2), o[0], 0, 0, 0), C1, 0); \
    KRD(GL, 3); GAPB(o[1] = __builtin_amdgcn_mfma_f32_32x32x16_bf16(PAF(2), VFR(6), o[1], 0, 0, 0), C1, 4); \
    GAPB(o[0] = __builtin_amdgcn_mfma_f32_32x32x16_bf16(PAF(3), VFR(3), o[0], 0, 0, 0), C1, 8); \
    GAPB(o[1] = __builtin_amdgcn_mfma_f32_32x32x16_bf16(PAF(3), VFR(7), o[1], 0, 0, 0), C1, 12); \
    } while (0)
  int t = 1;
  for (; t + 5 < NT; t += 2) {
    STEP(pB0, pB1, pA0, pA1, t, true, true, true);     WAIT_BAR(2); ROT();
    STEP(pA0, pA1, pB0, pB1, t + 1, true, true, true);   WAIT_BAR(2); ROT();
  }
  #define ENDW(tt) do { if ((tt) + 3 < NT) { WAIT_BAR(2); } else if ((tt) + 2 < NT) { WAIT_BAR(1); } else { WAIT_BAR(0); } } while (0)
  for (; t + 1 < NT; t += 2) {
    STEP(pB0, pB1, pA0, pA1, t, (t + 3 < NT), (t + 1 < NT), (t + 1 < NT));       ENDW(t);   ROT();
    STEP(pA0, pA1, pB0, pB1, t + 1, (t + 4 < NT), (t + 2 < NT), (t + 2 < NT));     ENDW(t + 1); ROT();
  }
  STEP(pB0, pB1, pA0, pA1, NT - 1, false, false, false);
  { pw0 = (u32x4){PKW(pB0, 0), PKW(pB0, 2), PKW(pB0, 4), PKW(pB0, 6)}; pw1 = (u32x4){PKW(pB0, 8), PKW(pB0, 10), PKW(pB0, 12), PKW(pB0, 14)}; pw2 = (u32x4){PKW(pB1, 0), PKW(pB1, 2), PKW(pB1, 4), PKW(pB1, 6)}; pw3 = (u32x4){PKW(pB1, 8), PKW(pB1, 10), PKW(pB1, 12), PKW(pB1, 14)};
    SBAR(); OSUM(0); OSUM(1); OSUM(2); OSUM(3); pv2(o, vq, sl_cur, PAF(0), PAF(1), PAF(2), PAF(3)); }
  #undef PKW
  #undef PAF
  #undef VFR
  #undef PIN
  #undef GAPA
  #undef OSUM
  #undef GAPB
  #undef EX
  #undef VRD
  #undef KRD
  #undef STEP
  #undef ENDW
  const float sterm = __builtin_amdgcn_exp2f(sink2);
  float rli[16];
  #pragma unroll
  for (int r = 0; r < 16; ++r) rli[r] = __builtin_amdgcn_rcpf(osum[r] + sterm);
  bf16* Ow = O + (qrow + wid * QBLK) * QP + qcol;
  { bf16* stg = (bf16*)(shm + LDS_OST) + wid * 2048;
    #pragma unroll
    for (int r = 0; r < 16; ++r) { const int orow = crow(r, hi);
      #pragma unroll
      for (int d0 = 0; d0 < 2; ++d0) stg[orow * 64 + d0 * 32 + r32] = __float2bfloat16(o[d0][r] * rli[r]); }
    asm volatile("s_waitcnt lgkmcnt(0)" ::: "memory");
    #pragma unroll
    for (int i = 0; i < 4; ++i) { const int row = i * 8 + (lane >> 3), ch = lane & 7; const u32x4 v = *(const u32x4*)(stg + row * 64 + ch * 8); ATTN_STORE16(Ow + (long)row * QP + ch * 8, v); } }
  asm volatile("s_waitcnt lgkmcnt(0)\n\ts_barrier" ::: "memory");
  #undef DMA_K
  #undef DMA_V
  #undef ROWOFF
  #undef CMASK
  #undef ROT
}
template <int MODE> __device__ __forceinline__ void attn_unit_sk(long qrow, long kvrow, int q0, int qcol, int kcol, int vcol, int NT, float sink2, float bound, const bf16* Q, const bf16* __restrict__ KVb, bf16* O, char* shm) {
  int tid_ = threadIdx.x; asm volatile("" : "+v"(tid_));
  const int tid = tid_, lane = tid & 63, r32 = lane & 31, hi = lane >> 5; const int wid = __builtin_amdgcn_readfirstlane(tid >> 6);
  const bf16* Qw = Q + (qrow + wid * QBLK) * QP + qcol;
  const char* kvt = (const char*)KVb + (size_t)(kvrow >> 6) * 65536 + wid * 1024 + lane * 16;
  constexpr int NSL = 4, LK = 0, LV = NSL * SLOTB, LOST = 2 * NSL * SLOTB + NW * 64 * 4;
  const unsigned lds0 = (unsigned)(uintptr_t)shm;
  const char* ksrc = kvt + kcol * 8192; const char* vsrc = kvt + vcol * 8192;
  const unsigned kdst = lds0 + LK + wid * 1024, vdst = lds0 + LV + wid * 1024;
  #define ROWOFF(t) ((long)(MODE == 1 ? ((t) + ((t) >= 4 ? ((q0 - 128) >> 6) : 0)) : (t)) * 65536)
  #define DMA_K(t, slot) glds16(ksrc + ROWOFF(t), (unsigned)__builtin_amdgcn_readfirstlane(kdst + (slot)))
  #define DMA_V(t, slot) glds16(vsrc + ROWOFF(t), (unsigned)__builtin_amdgcn_readfirstlane(vdst + (slot)))
  const char* Kbase = shm + LK; bf16x8 kf[8];
  const lds_cptr shm3 = (lds_cptr)shm; const lds_cptr kp0 = shm3 + LK + hi * 1024 + r32 * 16; lds_cptr vq[4];
  { const int swz = (r32 >> 1) & 7; _Pragma("unroll") for (int ks_ = 0; ks_ < 4; ++ks_) vq[ks_] = shm3 + LV + r32 * 128 + (((2 * ks_ + hi) ^ swz) * 16); }
  DMA_K(0, 0); DMA_V(0, 0); DMA_K(1, SLOTB);
  bf16x8 qr[4];
  #pragma unroll
  for (int d0 = 0; d0 < 4; ++d0) qr[d0] = *reinterpret_cast<const bf16x8*>(&Qw[(long)r32 * QP + d0 * 16 + hi * 8]);
  f32x16 o[2]; o[0] = f32x16{}; o[1] = f32x16{}; f32x16 osum = f32x16{};
  const f32x16 negm = f32x16{};
  bf16x8 ones;
  #pragma unroll
  for (int i = 0; i < 8; ++i) ones[i] = (short)0x3F80;
  asm volatile("" : "+v"(ones));
  const int qrel = wid * QBLK + r32;
  int mlo = -128, mhi = 128;
  if (MODE == 1) { const int qi = q0 + qrel; mlo = (-qi > -128) ? -qi : -128; mhi = (SEQ - 1 - qi < 128) ? (SEQ - 1 - qi) : 128; }
  const unsigned mspan = (unsigned)(mhi - mlo);
  #define CMASK(P0, P1, t) do { if (MODE == 1) { if ((t) >= 4) bandmask(P0, P1, (t), mlo, mspan, qrel, hi); } } while (0)
  f32x16 pA0, pA1, pB0, pB1;
  int sl_prev = 0, sl_cur = 0, sl_next = SLOTB;
  #define ROT() do { sl_prev = sl_cur; sl_cur = sl_next; sl_next = (sl_next == (NSL - 1) * SLOTB) ? 0 : sl_next + SLOTB; } while (0)
  DMA_K(2, 2 * SLOTB);
  WAIT_BAR(3);
  qkt(pA0, pA1, Kbase, qr, negm, r32, hi); asm volatile("s_nop 15\n\ts_nop 7" : "+v"(pA0), "+v"(pA1)); CMASK(pA0, pA1, 0);
  _Pragma("unroll") for (int r = 0; r < 16; ++r) { pA0[r] = __builtin_amdgcn_exp2f(pA0[r]); pA1[r] = __builtin_amdgcn_exp2f(pA1[r]); }
  WAIT_BAR(0);
  DMA_V(1, SLOTB); DMA_K(3, 3 * SLOTB); DMA_V(2, 2 * SLOTB); if (4 < NT) { DMA_K(4, 0); }
  ROT();
  kload8(kf, kp0 + sl_cur);
  WAIT_BAR(4);
  if (wid >= 4) asm volatile("s_barrier" ::: "memory");
  bf16x8 vfr[8]; u32x4 pw0, pw1, pw2, pw3;
  #define PKW(P, B) cvtpk_s(P[B], P[B + 1])
  #define PAF(k) __builtin_bit_cast(bf16x8, pw##k)
  #define VFR(i) vfr[i]
  #define PIN(x) asm volatile("" : "+v"(x))
  #define GAPA(MF, W0, W1, PW) do { MF; W0; W1; PIN(PW); SBAR(); } while (0)
  #define OSUM(k) do { osum = __builtin_amdgcn_mfma_f32_32x32x16_bf16(PAF(k), ones, osum, 0, 0, 0); SBAR(); } while (0)
  #define EX(v) (FASTEXP ? exp2_fast(v) : __builtin_amdgcn_exp2f(v))
  #define GAPB(MF, X, B) do { MF; X[B] = EX(X[B]); X[B + 1] = EX(X[B + 1]); X[B + 2] = EX(X[B + 2]); X[B + 3] = EX(X[B + 3]); PIN(X); SBAR(); } while (0)
  #define VRD(i) do { vfr[i] = *(const LAS bf16x8*)(vq[(i) & 3] + vsl_ + ((i) >> 2) * 4096); } while (0)
  #define KRD(G, j) do { if (G) { kload2(kf, kp0 + sl_next, j); SBAR(); } } while (0)
  #define STEP(C0, C1, P0, P1, t, GK, GV, GL, WMID) do { SBAR(); \
    const int vsl_ = sl_prev; \
    VRD(0); SBAR(); GAPA(C0 = __builtin_amdgcn_mfma_f32_32x32x16_bf16(kf[0], qr[0], negm, 0, 0, 0), pw0[0] = PKW(P0, 0), pw0[1] = PKW(P0, 2), pw0); \
    VRD(4); SBAR(); GAPA(C1 = __builtin_amdgcn_mfma_f32_32x32x16_bf16(kf[1], qr[0], negm, 0, 0, 0), pw0[2] = PKW(P0, 4), pw0[3] = PKW(P0, 6), pw0); \
    VRD(1); SBAR(); GAPA(C0 = __builtin_amdgcn_mfma_f32_32x32x16_bf16(kf[2], qr[1], C0, 0, 0, 0),   pw1[0] = PKW(P0, 8), pw1[1] = PKW(P0, 10), pw1); \
    OSUM(0); \
    VRD(5); SBAR(); GAPA(C1 = __builtin_amdgcn_mfma_f32_32x32x16_bf16(kf[3], qr[1], C1, 0, 0, 0),   pw1[2] = PKW(P0, 12), pw1[3] = PKW(P0, 14), pw1); \
    VRD(2); SBAR(); GAPA(C0 = __builtin_amdgcn_mfma_f32_32x32x16_bf16(kf[4], qr[2], C0, 0, 0, 0),   pw2[0] = PKW(P1, 0), pw2[1] = PKW(P1, 2), pw2); \
    OSUM(1); \
    VRD(6); SBAR(); GAPA(C1 = __builtin_amdgcn_mfma_f32_32x32x16_bf16(kf[5], qr[2], C1, 0, 0, 0),   pw2[2] = PKW(P1, 4), pw2[3] = PKW(P1, 6), pw2); \
    VRD(3); SBAR(); GAPA(C0 = __builtin_amdgcn_mfma_f32_32x32x16_bf16(kf[6], qr[3], C0, 0, 0, 0),   pw3[0] = PKW(P1, 8), pw3[1] = PKW(P1, 10), pw3); \
    OSUM(2); \
    VRD(7); SBAR(); GAPA(C1 = __builtin_amdgcn_mfma_f32_32x32x16_bf16(kf[7], qr[3], C1, 0, 0, 0),   pw3[2] = PKW(P1, 12), pw3[3] = PKW(P1, 14), pw3); \
    OSUM(3); \
    CMASK(C0, C1, t); \
    SBAR(); \
    WMID; \
    if (GV) { DMA_V((t) + 2, (sl_next == (NSL - 1) * SLOTB) ? 0 : sl_next + SLOTB); } if (GK) { DMA_K((t) + 4, sl_cur); } \
    SBAR(); \
    GAPB(o[0] = __builtin_amdgcn_mfma_f32_32x32x16_bf16(PAF(0), VFR(0), o[0], 0, 0, 0), C0, 0); \
    GAPB(o[1] = __builtin_amdgcn_mfma_f32_32x32x16_bf16(PAF(0), VFR(4), o[1], 0, 0, 0), C0, 4); \
    KRD(GL, 0); GAPB(o[0] = __builtin_amdgcn_mfma_f32_32x32x16_bf16(PAF(1), VFR(1), o[0], 0, 0, 0), C0, 8); \
    KRD(GL, 1); GAPB(o[1] = __builtin_amdgcn_mfma_f32_32x32x16_bf16(PAF(1), VFR(5), o[1], 0, 0, 0), C0, 12); \
    KRD(GL, 2); GAPB(o[0] = __builtin_amdgcn_mfma_f32_32x32x16_bf16(PAF(2), VFR(2), o[0], 0, 0, 0), C1, 0); \
    KRD(GL, 3); GAPB(o[1] = __builtin_amdgcn_mfma_f32_32x32x16_bf16(PAF(2), VFR(6), o[1], 0, 0, 0), C1, 4); \
    GAPB(o[0] = __builtin_amdgcn_mfma_f32_32x32x16_bf16(PAF(3), VFR(3), o[0], 0, 0, 0), C1, 8); \
    GAPB(o[1] = __builtin_amdgcn_mfma_f32_32x32x16_bf16(PAF(3), VFR(7), o[1], 0, 0, 0), C1, 12); \
    } while (0)
  int t = 1;
  for (; t + 5 < NT; t += 2) {
    STEP(pB0, pB1, pA0, pA1, t, true, true, true, WAIT_BAR(3));     WAIT_BAR(4); ROT();
    STEP(pA0, pA1, pB0, pB1, t + 1, true, true, true, WAIT_BAR(3));   WAIT_BAR(4); ROT();
  }
  for (; t + 1 < NT; t += 2) {
    STEP(pB0, pB1, pA0, pA1, t, (t + 4 < NT), (t + 2 < NT), (t + 1 < NT), WAIT_BAR(0));       WAIT_BAR(0); ROT();
    STEP(pA0, pA1, pB0, pB1, t + 1, (t + 5 < NT), (t + 3 < NT), (t + 2 < NT), WAIT_BAR(0));     WAIT_BAR(0); ROT();
  }
  STEP(pB0, pB1, pA0, pA1, NT - 1, false, false, false, WAIT_BAR(0));
  if (wid < 4) { WAIT_BAR(0); }
  { pw0 = (u32x4){PKW(pB0, 0), PKW(pB0, 2), PKW(pB0, 4), PKW(pB0, 6)}; pw1 = (u32x4){PKW(pB0, 8), PKW(pB0, 10), PKW(pB0, 12), PKW(pB0, 14)}; pw2 = (u32x4){PKW(pB1, 0), PKW(pB1, 2), PKW(pB1, 4), PKW(pB1, 6)}; pw3 = (u32x4){PKW(pB1, 8), PKW(pB1, 10), PKW(pB1, 12), PKW(pB1, 14)};
    SBAR(); OSUM(0); OSUM(1); OSUM(2); OSUM(3); pv2(o, vq, sl_cur, PAF(0), PAF(1), PAF(2), PAF(3)); }
  #undef PKW
  #undef PAF
  #undef VFR
  #undef PIN
  #undef GAPA
  #undef OSUM
  #undef GAPB
  #undef EX
  #undef VRD
  #undef KRD
  #undef STEP
  const float sterm = __builtin_amdgcn_exp2f(sink2);
  float rli[16];
  #pragma unroll
  for (int r = 0; r < 16; ++r) rli[r] = __builtin_amdgcn_rcpf(osum[r] + sterm);
  bf16* Ow = O + (qrow + wid * QBLK) * QP + qcol;
  { bf16* stg = (bf16*)(shm + LOST) + wid * 2048;
    #pragma unroll
    for (int r = 0; r < 16; ++r) { const int orow = crow(r, hi);
      #pragma unroll
      for (int d0 = 0; d0 < 2; ++d0) stg[orow * 64 + d0 * 32 + r32] = __float2bfloat16(o[d0][r] * rli[r]); }
    asm volatile("s_waitcnt lgkmcnt(0)" ::: "memory");
    #pragma unroll
    for (int i = 0; i < 4; ++i) { const int row = i * 8 + (lane >> 3), ch = lane & 7; const u32x4 v = *(const u32x4*)(stg + row * 64 + ch * 8); ATTN_STORE16(Ow + (long)row * QP + ch * 8, v); } }
  asm volatile("s_waitcnt lgkmcnt(0)\n\ts_barrier" ::: "memory");
  #undef DMA_K
  #undef DMA_V
  #undef ROWOFF
  #undef CMASK
  #undef ROT
}
constexpr int ATTN_LDS_BYTES = LDS_BYTES;
#undef SBAR
#undef WAIT_BAR
}

struct Args { const float* in[20]; float* out; unsigned char* ws; int ph_lo, ph_hi; };
typedef const Args __attribute__((address_space(4)))* kargp_t;
__device__ __forceinline__ kargp_t kargs() { auto p = __builtin_amdgcn_kernarg_segment_ptr(); asm volatile("" : "+s"(p)); return (kargp_t)p; }
enum { I_X = 0, I_C, I_CTX, I_CCTX, I_ADAW, I_ADAB, I_GATTN, I_GFFN, I_WIN, I_QNG, I_KNG, I_QNL, I_KNL, I_SINK, I_WOUT, I_RW, I_RB, I_WGATE, I_WUP, I_WDOWN };
struct Frame {
    LAS unsigned char* lds; volatile LAS unsigned* MISC;
    int tid, lane, wave, vcu, G;
};
#define WSP(T, off) ((T*)(kargs()->ws + (off)))
__device__ const float ROPE_INV[16] = {1.000000000e+00f, 5.623413324e-01f, 3.162277639e-01f, 1.778279394e-01f, 1.000000015e-01f, 5.623413250e-02f, 3.162277490e-02f, 1.778279431e-02f,
                                       9.999999776e-03f, 5.623413250e-03f, 3.162277630e-03f, 1.778279431e-03f, 1.000000047e-03f, 5.623413017e-04f, 3.162277571e-04f, 1.778279402e-04f};

template <int KIND> __device__ __forceinline__ int dst_row(int n) {
    if (KIND == 0) return n;
    if (KIND == 2) return ((n >> 7) << 8) + (n & 127);
    if (KIND == 3) return ((n >> 7) << 8) + 128 + (n & 127);
    int tile, wc;
    if (n < 512) { const int h = n >> 6; tile = h >> 2; wc = h & 3; }
    else if (n < 640) { tile = 4; wc = (n - 512) >> 6; }
    else if (n < 768) { tile = 4; wc = 2 + ((n - 640) >> 6); }
    else if (n < 1280) { const int h = (n - 768) >> 6; tile = 2 + (h >> 2); wc = h & 3; }
    else if (n < 1408) { tile = 5; wc = (n - 1280) >> 6; }
    else { tile = 5; wc = 2 + ((n - 1408) >> 6); }
    const int d = n & 63, bj = d >> 5, dd = d & 31, np = dd >> 4, f = dd & 15, fq = f >> 2, j = f & 3;
    return 256 * tile + 128 * bj + 32 * wc + 8 * fq + 4 * np + j;
}
template <int KIND> __device__ __forceinline__ void p0_transpose_item(const float* W, int N, bf16_t* WT, int Kd, LAS float* scr, int kb, int nb, int lane) {
    const int k0 = 64 * kb, n0 = 32 * nb;
#pragma unroll 8
    for (int i = 0; i < 32; ++i) { const int kk = 2 * i + (lane >> 5); scr[kk * 33 + (lane & 31)] = W[(size_t)(k0 + kk) * N + n0 + (lane & 31)]; }
    LDS_WAIT(); asm volatile("" ::: "memory");
    const int c = lane & 7;
#pragma unroll
    for (int j = 0; j < 4; ++j) { const int n = (lane >> 3) + 8 * j; const LAS float* s = scr + (8 * c) * 33 + n;
        u32x4 o; o.x = pk2(s[0 * 33], s[1 * 33]); o.y = pk2(s[2 * 33], s[3 * 33]); o.z = pk2(s[4 * 33], s[5 * 33]); o.w = pk2(s[6 * 33], s[7 * 33]);
        *(GAS u32x4*)(WT + (size_t)dst_row<KIND>(n0 + n) * Kd + k0 + 8 * c) = o; }
    LDS_WAIT(); asm volatile("" ::: "memory");
}
__device__ __forceinline__ void sincos_d(float ang, float& cs, float& sn) {
    const double x = (double)ang; const double kq = __builtin_rint(x * 0.63661977236758134308);
    const double r = (x - kq * 1.5707963267948966192) - kq * 6.123233995736766036e-17, r2 = r * r;
    const double s = r * (1.0 + r2 * (-1.0 / 6 + r2 * (1.0 / 120 + r2 * (-1.0 / 5040 + r2 * (1.0 / 362880 + r2 * (-1.0 / 39916800 + r2 * (1.0 / 6227020800.0)))))));
    const double c = 1.0 + r2 * (-0.5 + r2 * (1.0 / 24 + r2 * (-1.0 / 720 + r2 * (1.0 / 40320 + r2 * (-1.0 / 3628800 + r2 * (1.0 / 479001600.0 + r2 * (-1.0 / 87178291200.0)))))));
    const int q = ((int)kq) & 3;
    const double cc = (q == 0) ? c : (q == 1) ? -s : (q == 2) ? -c : s;
    const double ss = (q == 0) ? s : (q == 1) ? c : (q == 2) ? -s : -c;
    cs = (float)cc; sn = (float)ss;
}
__device__ __forceinline__ void p0_prologue(Frame& F) {
    const int gw = F.vcu * NWAVES + F.wave, NGW = F.G * NWAVES;
    {
        const float* c = kargs()->in[I_C]; const float* cctx = kargs()->in[I_CCTX]; const float* ada_w = kargs()->in[I_ADAW]; const float* ada_b = kargs()->in[I_ADAB];
        float* modv = WSP(float, WS_MODV);
        LAS float* sv = (LAS float*)(F.lds);
        LAS float* part = (LAS float*)(F.lds + 16384);
        for (int i = F.tid; i < 3072; i += NWAVES * 64) { const int v = i >> 10, k = i & 1023; const float cv = v < 2 ? c[v * 1024 + k] : cctx[k]; sv[i] = cv / (1.0f + expf(-cv)); }
        __syncthreads();
        for (int tile = F.vcu; tile < NLAYER * 96; tile += F.G) {
            const int l = tile / 96, c0 = (tile % 96) * 64;
            const float* W = ada_w + (size_t)l * 1024 * 6144 + c0 + F.lane;
            float a0 = 0.f, a1 = 0.f, a2 = 0.f; const int kb = F.wave * 128;
#pragma unroll 8
            for (int k = 0; k < 128; ++k) { const float w = W[(size_t)(kb + k) * 6144]; a0 += sv[kb + k] * w; a1 += sv[1024 + kb + k] * w; a2 += sv[2048 + kb + k] * w; }
            part[(F.wave * 3 + 0) * 64 + F.lane] = a0; part[(F.wave * 3 + 1) * 64 + F.lane] = a1; part[(F.wave * 3 + 2) * 64 + F.lane] = a2;
            __syncthreads();
            if (F.tid < 192) { const int v = F.tid >> 6, col = F.tid & 63; float s = ada_b[l * 6144 + c0 + col];
#pragma unroll
                for (int w = 0; w < 8; ++w) s += part[(w * 3 + v) * 64 + col];
                modv[(size_t)(l * 3 + v) * 6144 + c0 + col] = s; }
            __syncthreads();
        }
    }
    { float* rope = WSP(float, WS_ROPE); const int gt = F.vcu * NWAVES * 64 + F.tid; if (gt < 4096) { const int pos = gt >> 4, f = gt & 15; const float ang = (float)pos * ROPE_INV[f]; float cs, sn; sincos_d(ang, cs, sn); rope[gt * 2] = cs; rope[gt * 2 + 1] = sn; } }
    { const int gt = F.vcu * NWAVES * 64 + F.tid; if (gt < NLAYER * 256) { const int l = gt >> 8, kq = (gt >> 6) & 3, d = gt & 63; const float* src = kargs()->in[kq == 0 ? I_QNG : (kq == 1 ? I_QNL : (kq == 2 ? I_KNG : I_KNL))]; WSP(float, WS_GN)[gt] = src[l * 64 + d]; } }
    if (gw < NLAYER * 2) { const int l = gw >> 1, loc = gw & 1; float mq = fabsf(kargs()->in[loc ? I_QNL : I_QNG][l * 64 + F.lane]), mk = fabsf(kargs()->in[loc ? I_KNL : I_KNG][l * 64 + F.lane]);
#pragma unroll
        for (int o = 1; o < 64; o <<= 1) { mq = fmaxf(mq, __shfl_xor(mq, o)); mk = fmaxf(mk, __shfl_xor(mk, o)); }
        if (F.lane == 0) WSP(float, WS_BND)[gw] = 64.0f * C2 * mq * mk * 1.02f + 0.05f; }
    { u32x4* p = (u32x4*)(WSP(bf16_t, WS_KV) + (size_t)NROW * 512); for (int i = F.vcu * NWAVES * 64 + F.tid; i < 256 * 512 * 2 / 16; i += F.G * NWAVES * 64) p[i] = (u32x4){0u, 0u, 0u, 0u}; }
    {
        const float* x = kargs()->in[I_X]; const float* ctx = kargs()->in[I_CTX]; float* XS = WSP(float, WS_XS);
        for (int R = gw; R < NROW; R += NGW) {
            const int b = R >= RB ? 1 : 0, rr = R - b * RB;
            const float* src = rr < NCTX ? ctx + (size_t)(b * NCTX + rr) * 1024 : x + (size_t)(b * SEQ + rr - NCTX) * 1024;
            const f32x4* s4 = (const f32x4*)src + F.lane; f32x4* d4 = (f32x4*)(XS + (size_t)R * 1024) + F.lane;
            f32x4 v[4];
#pragma unroll
            for (int j = 0; j < 4; ++j) v[j] = s4[64 * j];
#pragma unroll
            for (int j = 0; j < 4; ++j) d4[64 * j] = v[j];
        }
    }
    {
        LAS float* scr = (LAS float*)(F.lds + RING_OFF + F.wave * 16384);
        constexpr int I_IN = 4 * 768, I_OUT = 4 * 512, I_G = 64 * 256, I_U = 64 * 256, I_D = 64 * 256;
        for (int it0 = gw; it0 < I_IN + I_OUT + I_G + I_U + I_D; it0 += NGW) {
            int it = it0;
            if (it < I_IN) { const int l = it / 768, r = it % 768; p0_transpose_item<1>(kargs()->in[I_WIN] + (size_t)l * 1024 * 1536, 1536, WSP(bf16_t, WS_WIN) + (size_t)l * 1536 * 1024, 1024, scr, r / 48, r % 48, F.lane); continue; } it -= I_IN;
            if (it < I_OUT) { const int l = it / 512, r = it % 512; p0_transpose_item<0>(kargs()->in[I_WOUT] + (size_t)l * 1024 * 1024, 1024, WSP(bf16_t, WS_WOUT) + (size_t)l * 1024 * 1024, 1024, scr, r / 32, r % 32, F.lane); continue; } it -= I_OUT;
            if (it < I_G) { const int m = it / 256, r = it % 256; p0_transpose_item<2>(kargs()->in[I_WGATE] + (size_t)m * 1024 * 512, 512, WSP(bf16_t, WS_WGU) + (size_t)m * 1024 * 1024, 1024, scr, r / 16, r % 16, F.lane); continue; } it -= I_G;
            if (it < I_U) { const int m = it / 256, r = it % 256; p0_transpose_item<3>(kargs()->in[I_WUP] + (size_t)m * 1024 * 512, 512, WSP(bf16_t, WS_WGU) + (size_t)m * 1024 * 1024, 1024, scr, r / 16, r % 16, F.lane); continue; } it -= I_U;
            { const int m = it / 256, r = it % 256; p0_transpose_item<0>(kargs()->in[I_WDOWN] + (size_t)m * 512 * 1024, 1024, WSP(bf16_t, WS_WD) + (size_t)m * 1024 * 512, 512, scr, r / 32, r % 32, F.lane); }
        }
    }
}

__device__ __forceinline__ void load_row(const float* xrow, int lane, f32x4 (&h)[4]) {
    const f32x4* xr = (const f32x4*)xrow + lane;
#pragma unroll
    for (int j = 0; j < 4; ++j) h[j] = xr[64 * j];
}
__device__ __forceinline__ void rms_mod(const float* g, const float* sh, const float* sc, int lane, f32x4 (&h)[4]) {
    float ss = 0.f;
#pragma unroll
    for (int j = 0; j < 4; ++j) ss += (h[j][0] * h[j][0] + h[j][1] * h[j][1]) + (h[j][2] * h[j][2] + h[j][3] * h[j][3]);
    const float rs = 1.0f / sqrtf(wave_sum(ss) * (1.0f / 1024.0f) + NORM_EPS);
#pragma unroll
    for (int j = 0; j < 4; ++j) { const f32x4 gg = ((const f32x4*)g)[lane + 64 * j], s1 = ((const f32x4*)sh)[lane + 64 * j], s2 = ((const f32x4*)sc)[lane + 64 * j];
        h[j] = (h[j] * rs * gg) * (1.0f + s2) + s1; }
}
__device__ __forceinline__ void store_row_bf16(bf16_t* orow, int lane, const f32x4 (&h)[4]) {
    u32x2* o8 = (u32x2*)orow + lane;
#pragma unroll
    for (int j = 0; j < 4; ++j) { u32x2 w; w.x = pk2(h[j][0], h[j][1]); w.y = pk2(h[j][2], h[j][3]); o8[64 * j] = w; }
}
__device__ __forceinline__ int row_mv(int R) { const int b = R >= RB ? 1 : 0; return (R - b * RB) < NCTX ? 2 : b; }

__device__ __forceinline__ void phase_norm1(Frame& F0, int l) {
    Frame F = F0; asm volatile("" : "+v"(F.tid), "+v"(F.lane), "+s"(F.wave), "+s"(F.vcu));
    const int gw = F.vcu * NWAVES + F.wave, NGW = F.G * NWAVES;
    const float* g = kargs()->in[I_GATTN] + l * 1024; const float* modv = WSP(float, WS_MODV); const float* XS = WSP(float, WS_XS); bf16_t* HN = WSP(bf16_t, WS_HN);
    f32x4 xn[4]; if (gw < NROW) load_row(XS + (size_t)gw * 1024, F.lane, xn);
    for (int R = gw; R < NROW; R += NGW) {
        const float* mv = modv + (size_t)(l * 3 + row_mv(R)) * 6144;
        f32x4 h[4];
#pragma unroll
        for (int j = 0; j < 4; ++j) h[j] = xn[j];
        if (R + NGW < NROW) load_row(XS + (size_t)(R + NGW) * 1024, F.lane, xn);
        rms_mod(g, mv + 0, mv + 1024, F.lane, h);
        store_row_bf16(HN + (size_t)R * 1024, F.lane, h);
    }
}
__device__ __forceinline__ void phase_norm2_router(Frame& F0, int l, bool lastl, bool dry = false) {
    Frame F = F0; asm volatile("" : "+v"(F.tid), "+v"(F.lane), "+s"(F.wave), "+s"(F.vcu));
    const int gw = F.vcu * NWAVES + F.wave, NGW = F.G * NWAVES;
    LAS f32x4* RW = (LAS f32x4*)(F.lds + RING_OFF);
    { const float* router_w = kargs()->in[I_RW];
      for (int idx = F.tid; idx < 4096; idx += NWAVES * 64) { const int j = idx >> 10, e = (idx >> 6) & 15, ln = idx & 63, c = 4 * ln + 256 * j;
        RW[idx] = (f32x4){router_w[(c + 0) * 16 + e], router_w[(c + 1) * 16 + e], router_w[(c + 2) * 16 + e], router_w[(c + 3) * 16 + e]}; } }
    __syncthreads();
    const float* g = kargs()->in[I_GFFN] + l * 1024; const float* router_b = kargs()->in[I_RB];
    LAS float* PS = (LAS float*)(F.lds + RING_OFF + 65536) + F.wave * (16 * 65);
    const float* modv = WSP(float, WS_MODV); const float* XS = WSP(float, WS_XS); bf16_t* HN = WSP(bf16_t, WS_HN);
    int my_cls = -1, my_tok = 0; float my_wlo = 0.f, my_whi = 0.f;
    int k = 0;
    f32x4 xn[4]; if (gw < NROW) load_row(XS + (size_t)gw * 1024, F.lane, xn);
    for (int R = gw; R < NROW; R += NGW, ++k) {
        const int mvi = row_mv(R);
        f32x4 h[4];
#pragma unroll
        for (int j = 0; j < 4; ++j) h[j] = xn[j];
        if (R + NGW < NROW) load_row(XS + (size_t)(R + NGW) * 1024, F.lane, xn);
        if (lastl && mvi == 2) continue;
        const float* mv = modv + (size_t)(l * 3 + mvi) * 6144;
        rms_mod(g, mv + 3072, mv + 4096, F.lane, h);
        store_row_bf16(HN + (size_t)R * 1024, F.lane, h);
        {
#pragma unroll
            for (int e = 0; e < 16; ++e) { float s = 0.f;
#pragma unroll
                for (int j = 0; j < 4; ++j) { const f32x4 w4 = RW[(j * 16 + e) * 64 + F.lane]; s += (h[j][0] * w4[0] + h[j][1] * w4[1]) + (h[j][2] * w4[2] + h[j][3] * w4[3]); }
                PS[e * 65 + F.lane] = s; }
        }
        float tl = 0.f;
        { const LAS float* pr = PS + (F.lane & 15) * 65 + (F.lane >> 4) * 16;
#pragma unroll
          for (int i = 0; i < 16; ++i) tl += pr[i]; }
        tl += __shfl_xor(tl, 16); tl += __shfl_xor(tl, 32);
        const float my_sc = 1.0f / (1.0f + expf(-tl)), my_sel = my_sc + router_b[F.lane & 15];
        float sc[16], sel[16];
#pragma unroll
        for (int e = 0; e < 16; ++e) { sc[e] = __builtin_bit_cast(float, __builtin_amdgcn_readlane(__builtin_bit_cast(int, my_sc), e)); sel[e] = __builtin_bit_cast(float, __builtin_amdgcn_readlane(__builtin_bit_cast(int, my_sel), e)); }
        float gs[4];
#pragma unroll
        for (int gq = 0; gq < 4; ++gq) { const float a = sel[4 * gq], b = sel[4 * gq + 1], c = sel[4 * gq + 2], d = sel[4 * gq + 3];
            const float h1 = fmaxf(a, b), l1 = fminf(a, b), h2 = fmaxf(c, d), l2 = fminf(c, d);
            gs[gq] = fmaxf(h1, h2) + fmaxf(fminf(h1, h2), fmaxf(l1, l2)); }
        int gi = 0; float bg = gs[0];
#pragma unroll
        for (int gq = 1; gq < 4; ++gq) if (gs[gq] > bg) { bg = gs[gq]; gi = gq; }
        float s4[4], c4[4];
#pragma unroll
        for (int q = 0; q < 4; ++q) { s4[q] = sel[q]; c4[q] = sc[q]; }
#pragma unroll
        for (int gq = 1; gq < 4; ++gq)
#pragma unroll
            for (int q = 0; q < 4; ++q) { s4[q] = (gi == gq) ? sel[4 * gq + q] : s4[q]; c4[q] = (gi == gq) ? sc[4 * gq + q] : c4[q]; }
        int i1 = 0; float b1 = s4[0], w1 = c4[0];
#pragma unroll
        for (int q = 1; q < 4; ++q) if (s4[q] > b1) { b1 = s4[q]; i1 = q; w1 = c4[q]; }
        int i2 = -1; float b2 = -INFINITY, w2 = 0.f;
#pragma unroll
        for (int q = 0; q < 4; ++q) if (q != i1 && (i2 < 0 || s4[q] > b2)) { b2 = s4[q]; i2 = q; w2 = c4[q]; }
        const float wsum = w1 + w2; w1 = w1 / wsum; w2 = w2 / wsum;
        const int ia = i1 < i2 ? i1 : i2, ib = i1 < i2 ? i2 : i1;
        const float wlo = i1 < i2 ? w1 : w2, whi = i1 < i2 ? w2 : w1;
        const int pidx = ia == 0 ? ib - 1 : (ia == 1 ? ib + 1 : 5);
        if (F.lane == k) { my_cls = gi * 6 + pidx; my_tok = R; my_wlo = wlo; my_whi = whi; }
    }
    if (my_cls >= 0 && !dry) {
        const unsigned pos = __hip_atomic_fetch_add(WSP(unsigned, WS_CTL) + CW_CNT + (l * NCLS + my_cls) * 64, 1u, RLX_AGENT);
        WSP(int, WS_TOK)[(size_t)my_cls * CAP + pos] = my_tok; WSP(f32x2, WS_WTS)[(size_t)my_cls * CAP + pos] = (f32x2){my_wlo, my_whi};
    }
    __syncthreads();
}
__device__ __forceinline__ int moe_tables(Frame& F0, int l) {
    Frame F = F0; asm volatile("" : "+v"(F.tid));
    LAS int* s_n = (LAS int*)(F.lds + MOE_OFF); LAS int* s_ts = s_n + 32;
    __syncthreads();
    if (F.tid < NCLS) s_n[F.tid] = (int)__hip_atomic_load(WSP(unsigned, WS_CTL) + CW_CNT + (l * NCLS + F.tid) * 64, RLX_AGENT);
    __syncthreads();
    if (F.tid == 0) { int acc = 0; for (int c = 0; c < NCLS; ++c) { s_ts[c] = acc; acc += (s_n[c] + 255) >> 8; } s_ts[NCLS] = acc; }
    __syncthreads();
    return s_ts[NCLS];
}

constexpr int NPHASE = 1 + 7 * NLAYER;
__global__ void __launch_bounds__(NWAVES * 64, 2) fwd_kernel(Args args) {
    extern __shared__ __attribute__((aligned(16))) unsigned char lds[];
    Frame F;
    F.lds = (LAS unsigned char*)lds; F.MISC = (volatile LAS unsigned*)(F.lds + MISC_OFF);
    F.tid = threadIdx.x; F.lane = F.tid & 63; F.wave = __builtin_amdgcn_readfirstlane(F.tid >> 6);
    F.G = gridDim.x; { const int bx = blockIdx.x; F.vcu = (F.G % 8 == 0) ? (bx % 8) * (F.G / 8) + bx / 8 : bx; }
    for (int u = F.tid; u < (LDS_BYTES - LDSCTL_OFF) / 4; u += NWAVES * 64) ((LAS unsigned*)(F.lds + LDSCTL_OFF))[u] = 0u;
    __syncthreads();
    const int lo = args.ph_lo, hi = args.ph_hi;
    XcdBarrier bar; bar.bar = WSP(unsigned, WS_CTL) + CW_BAR; bar.x = 0; bar.st = nullptr;
    if (hi - lo > 1) bar = xcd_barrier_post(WSP(unsigned, WS_CTL) + CW_BAR, F.MISC + 8);
#ifndef MK_EN
#define MK_EN 0xff
#endif
#define EN(k) (((MK_EN) >> (k)) & 1)
#ifndef REP_P0
#define REP_P0 1
#endif
#ifndef REP_A
#define REP_A 1
#endif
#ifndef REP_B
#define REP_B 1
#endif
#ifndef REP_C
#define REP_C 1
#endif
#ifndef REP_F
#define REP_F 1
#endif
#ifndef REP_D
#define REP_D 1
#endif
#ifndef REP_E
#define REP_E 1
#endif
#ifndef REP_G
#define REP_G 1
#endif
#define RUN(p) (lo <= (p) && (p) < hi)
#define SEAM(p) do { if (RUN(p) && RUN((p) + 1)) xcd_barrier(bar); } while (0)

    if (EN(7) && RUN(0)) { for (int rep = 0; rep < REP_P0; ++rep) { p0_prologue(F); if (rep + 1 < REP_P0) xcd_barrier(bar); } SEAM(0); }

    for (int l = 0; l < NLAYER; ++l) {
        const int pb = 1 + 7 * l; const bool lastl = (l == NLAYER - 1);
        if (EN(0) && RUN(pb + 0)) { for (int rep = 0; rep < REP_A; ++rep) { phase_norm1(F, l); if (rep + 1 < REP_A) xcd_barrier(bar); } SEAM(pb + 0); }
        if (EN(1) && RUN(pb + 1)) {
            pg8::ProbDense P; P.A = WSP(const char, WS_HN); P.B = (const char*)(WSP(bf16_t, WS_WIN) + (size_t)l * 1536 * 1024); P.lda = 1024; P.ldb = 1024; P.nt = 16; P.S.init(NROW, 1536, F.G, (int)blockIdx.x);
            pg8::EpiQKV E{kargs()->ws, WSP(float, WS_GN) + l * 256, WSP(float, WS_ROPE)};
            for (int rep = 0; rep < REP_B; ++rep) { pg8::gemm_phase<pg8::EpiQKV, pg8::ProbDense, true>(F.lds + RING_OFF, F.lds + OFFS_OFF, P, E); if (rep + 1 < REP_B) xcd_barrier(bar); }
            SEAM(pb + 1);
        }
        if (EN(2) && RUN(pb + 2)) {
            const attn_body::bf16* Q = WSP(const attn_body::bf16, WS_QO); const attn_body::bf16* KVb = WSP(const attn_body::bf16, WS_KV); attn_body::bf16* O = WSP(attn_body::bf16, WS_HN);
            const float* sink = kargs()->in[I_SINK] + l * 8;
            const int n0 = 1024 + (lastl ? 0 : 32);
            const float bnd_g = WSP(const float, WS_BND)[l * 2], bnd_l = WSP(const float, WS_BND)[l * 2 + 1];
            #ifndef ATTN_FAST
#define ATTN_FAST attn_unit_sk
#endif
#ifndef FORCE_FAST
#define FORCE_FAST 0
#endif
            const bool fast = FORCE_FAST || ((bnd_g <= 48.0f) && (bnd_l <= 48.0f));
#ifndef PROBE_XV
#define PROBE_XV 0
#endif
            for (int rep = 0; rep < REP_C; ++rep) {
            if (PROBE_XV != 0 && rep + 1 < REP_C) {
                attn_body::bf16* OD = (attn_body::bf16*)(kargs()->ws + (size_t)524 * MiB);
                for (int L = F.vcu; L < 1024; L += F.G) { const int bh = L >> 6, b = bh >> 3, h = bh & 7, qb = L & 63;
                    attn_body::attn_unit_sb<0, PROBE_XV>((long)b * RB + NCTX + qb * 256, (long)b * RB, 0, h * 64, (h >> 2), 4 + (h >> 2), RB / 64, -INFINITY, bnd_g, Q, KVb, OD, (char*)lds + RING_OFF); }
                xcd_barrier(bar); continue; }
            for (int L = F.vcu; L < n0; L += F.G) {
                long qrow, kvrow; int qcol, kcol, vcol, NT; float sink2 = -INFINITY, bnd = bnd_g;
                if (L < 1024) { const int bh = L >> 6, b = bh >> 3, h = bh & 7, qb = L & 63; qrow = (long)b * RB + NCTX + qb * 256; kvrow = (long)b * RB; NT = RB / 64; qcol = h * 64; kcol = (h >> 2); vcol = 4 + (h >> 2); }
                else { const int Lc = L - 1024, b = Lc >> 4, h = Lc & 15; qrow = (long)b * RB; kvrow = qrow; NT = NCTX / 64; qcol = h * 64;
                    if (h < 8) { kcol = (h >> 2); vcol = 4 + (h >> 2); } else { const int hl = h - 8; kcol = 2 + (hl >> 2); vcol = 6 + (hl >> 2); sink2 = sink[hl] * LOG2E; bnd = bnd_l; } }
                if (fast) attn_body::ATTN_FAST<0>(qrow, kvrow, 0, qcol, kcol, vcol, NT, sink2, bnd, Q, KVb, O, (char*)lds + RING_OFF);
                else attn_body::attn_unit<0, 8>(qrow, kvrow, 0, qcol, kcol, vcol, NT, sink2, Q, KVb, O, (char*)lds + RING_OFF);
            }
            for (int L = F.vcu; L < 1024; L += F.G) {
                const int bh = L >> 6, b = bh >> 3, hl = bh & 7, qb = L & 63, q0 = qb * 256;
                if (fast) attn_body::ATTN_FAST<1>((long)b * RB + NCTX + q0, (long)b * RB, q0, (8 + hl) * 64, 2 + (hl >> 2), 6 + (hl >> 2), 12, sink[hl] * LOG2E, bnd_l, Q, KVb, O, (char*)lds + RING_OFF);
                else attn_body::attn_unit<1, 8>((long)b * RB + NCTX + q0, (long)b * RB, q0, (8 + hl) * 64, 2 + (hl >> 2), 6 + (hl >> 2), 12, sink[hl] * LOG2E, Q, KVb, O, (char*)lds + RING_OFF);
            }
            if (rep + 1 < REP_C) xcd_barrier(bar); }
            SEAM(pb + 2);
        }
        if (EN(3) && RUN(pb + 3)) {
            pg8::ProbDense P; P.A = WSP(const char, WS_HN); P.B = (const char*)(WSP(bf16_t, WS_WOUT) + (size_t)l * 1024 * 1024); P.lda = 1024; P.ldb = 1024; P.nt = 16; P.S.init(NROW, 1024, F.G, (int)blockIdx.x);
            for (int rep = 0; rep < REP_D; ++rep) {
            pg8::EpiResid E{WSP(float, WS_XS), WSP(float, WS_MODV) + (size_t)l * 3 * 6144, 2048, (rep & 1) ? -1.0f : 1.0f};
            pg8::gemm_phase<pg8::EpiResid, pg8::ProbDense, true>(F.lds + RING_OFF, F.lds + OFFS_OFF, P, E); if (rep + 1 < REP_D) xcd_barrier(bar); }
            SEAM(pb + 3);
        }
        if (EN(4) && RUN(pb + 4)) { for (int rep = 0; rep < REP_E; ++rep) { phase_norm2_router(F, l, lastl, rep + 1 < REP_E); if (rep + 1 < REP_E) xcd_barrier(bar); } SEAM(pb + 4); }
        if (EN(5) && RUN(pb + 5)) {
            const int ntile = moe_tables(F, l);
            pg8::ProbGU P; P.A = WSP(const char, WS_HN); P.B = (const char*)(WSP(bf16_t, WS_WGU) + (size_t)l * 16 * 1024 * 1024); P.tok = WSP(int, WS_TOK); P.s_n = (const LAS int*)(F.lds + MOE_OFF); P.s_ts = P.s_n + 32;
            P.total = ntile * 8; P.G = F.G; P.c = (int)blockIdx.x; P.nt = 16;
            pg8::EpiGU E{WSP(bf16_t, WS_ACT), WSP(f32x2, WS_WTS)};
            for (int rep = 0; rep < REP_F; ++rep) { pg8::gemm_phase<pg8::EpiGU, pg8::ProbGU, true>(F.lds + RING_OFF, F.lds + OFFS_OFF, P, E); if (rep + 1 < REP_F) xcd_barrier(bar); }
            SEAM(pb + 5);
        }
        if (EN(6) && RUN(pb + 6)) {
            const int ntile = moe_tables(F, l);
            pg8::ProbDown P; P.A = WSP(const char, WS_ACT); P.B = (const char*)(WSP(bf16_t, WS_WD) + (size_t)l * 16 * 1024 * 512); P.s_n = (const LAS int*)(F.lds + MOE_OFF); P.s_ts = P.s_n + 32;
            P.total = ntile * 4; P.G = F.G; P.c = (int)blockIdx.x; P.nt = 16;
            for (int rep = 0; rep < REP_G; ++rep) {
            pg8::EpiDown E{WSP(float, WS_XS), lastl ? kargs()->out : nullptr, WSP(int, WS_TOK), WSP(float, WS_MODV) + (size_t)l * 3 * 6144, (rep & 1) ? -1.0f : 1.0f};
            pg8::gemm_phase<pg8::EpiDown, pg8::ProbDown, true>(F.lds + RING_OFF, F.lds + OFFS_OFF, P, E); if (rep + 1 < REP_G) xcd_barrier(bar); }
            SEAM(pb + 6);
        }
    }
#undef RUN
#undef SEAM
}

#ifndef MK_SPLIT
#define MK_SPLIT 0
#endif
extern "C" void kernel_launch(void* const* d_in, const int* in_sizes, int n_in, void* d_out, int out_size, void* d_ws, size_t ws_size, hipStream_t stream) {
    static int grid = 0;
    if (grid == 0) {
        if (n_in != 20 || in_sizes[0] != NB * SEQ * DM || out_size != NB * SEQ * DM || ws_size < WS_END) {
            fprintf(stderr, "kernel_launch: unexpected shapes (n_in %d, in0 %d, out %d, ws %zu); nothing launched\n", n_in, n_in > 0 ? in_sizes[0] : -1, out_size, ws_size); grid = -1; return; }
        int dev = 0, cus = 0, per_cu = 0;
        if (hipGetDevice(&dev) != hipSuccess || hipDeviceGetAttribute(&cus, hipDeviceAttributeMultiprocessorCount, dev) != hipSuccess) { grid = -1; return; }
        if (hipFuncSetAttribute((const void*)fwd_kernel, hipFuncAttributeMaxDynamicSharedMemorySize, LDS_BYTES) != hipSuccess) { fprintf(stderr, "kernel_launch: hipFuncSetAttribute failed\n"); grid = -1; return; }
        if (hipOccupancyMaxActiveBlocksPerMultiprocessor(&per_cu, (const void*)fwd_kernel, NWAVES * 64, LDS_BYTES) != hipSuccess || per_cu < 1)
            fprintf(stderr, "kernel_launch: note: occupancy query reports %d workgroups per CU\n", per_cu);
        (void)hipGetLastError();
        grid = cus;
    }
    if (grid < 0) return;
    if (hipMemsetAsync((char*)d_ws + WS_CTL, 0, CTL_ZERO_BYTES, stream) != hipSuccess) return;
    Args a{};
    for (int i = 0; i < 20; ++i) a.in[i] = (const float*)d_in[i];
    a.out = (float*)d_out; a.ws = (unsigned char*)d_ws;
#if MK_SPLIT
    for (int p = 0; p < NPHASE; ++p) { a.ph_lo = p; a.ph_hi = p + 1; hipLaunchKernelGGL(fwd_kernel, dim3(grid), dim3(NWAVES * 64), LDS_BYTES, stream, a); }
#else
    a.ph_lo = 0; a.ph_hi = NPHASE;
    hipLaunchKernelGGL(fwd_kernel, dim3(grid), dim3(NWAVES * 64), LDS_BYTES, stream, a);
#endif
    const hipError_t le = hipPeekAtLastError();
    if (le != hipSuccess) fprintf(stderr, "kernel_launch: launch failed: %s\n", hipGetErrorName(le));
}
```

```cpp
#define ATTN_FAST attn_unit_sb
#include <hip/hip_runtime.h>
#include <hip/hip_bf16.h>
#include <cstdio>
#include <cstdint>
#include <cmath>

#define LAS __attribute__((address_space(3)))
#define GAS __attribute__((address_space(1)))
typedef unsigned short bf16_t;
typedef short bf16x8 __attribute__((ext_vector_type(8)));
typedef float f32x4 __attribute__((ext_vector_type(4)));
typedef float f32x2 __attribute__((ext_vector_type(2)));
typedef unsigned u32x4 __attribute__((ext_vector_type(4)));
typedef unsigned u32x2 __attribute__((ext_vector_type(2)));
typedef GAS unsigned gu32;

constexpr int NB = 2, SEQ = 16384, DM = 1024, NCTX = 256, NLAYER = 4, NEXP = 16, DEXP = 512;
constexpr int RB = SEQ + NCTX;
constexpr int NROW = NB * RB;
constexpr int NCLS = 24, CAP = NROW;
constexpr int MAXSLOT = 39424;
constexpr float NORM_EPS = 1e-6f;
constexpr float C2 = 0.125f * 1.4426950408889634f;
constexpr float LOG2E = 1.4426950408889634f;

constexpr size_t MiB = 1u << 20;
constexpr size_t WS_CTL = 0, CTL_ZERO_BYTES = 1 * MiB;
constexpr size_t WS_MODV = 1 * MiB;
constexpr size_t WS_ROPE = 2 * MiB;
constexpr size_t WS_GN = 3 * MiB;
constexpr size_t WS_BND = 3 * MiB + 8192;
constexpr size_t WS_TOK = 4 * MiB;
constexpr size_t WS_WTS = 8 * MiB;
constexpr size_t WS_WIN = 16 * MiB;
constexpr size_t WS_WOUT = 28 * MiB;
constexpr size_t WS_WGU = 36 * MiB;
constexpr size_t WS_WD = 164 * MiB;
constexpr size_t WS_XS = 228 * MiB;
constexpr size_t WS_HN = 358 * MiB;
constexpr size_t WS_QO = 423 * MiB;
constexpr size_t WS_KV = 488 * MiB;
constexpr size_t WS_ACT = 423 * MiB;
constexpr size_t WS_END = 522 * MiB;
static_assert(WS_TOK + (size_t)NCLS * CAP * 4 <= WS_WTS && WS_WTS + (size_t)NCLS * CAP * 8 <= WS_WIN, "lists");
static_assert(WS_KV + (size_t)(NROW + 256) * 512 * 2 <= WS_END && WS_ACT + (size_t)MAXSLOT * 1024 * 2 <= WS_END, "ws map");
constexpr int CW_TMO = 0, CW_CODE = 1, CW_BAR = 4096, CW_CNT = 8192;

constexpr int RING_OFF = 0, RING_BYTES = 131072;
constexpr int LDSCTL_OFF = RING_BYTES, MISC_OFF = LDSCTL_OFF + 320, MOE_OFF = LDSCTL_OFF + 1024, OFFS_OFF = LDSCTL_OFF + 2048  ;
constexpr int LDS_BYTES = 147456;
constexpr int NWAVES = 8;

#define LDS_WAIT() asm volatile("s_waitcnt lgkmcnt(0)" ::: "memory")
#define VM_WAIT() asm volatile("s_waitcnt vmcnt(0)" ::: "memory")
#define RLX_AGENT __ATOMIC_RELAXED, __HIP_MEMORY_SCOPE_AGENT

__device__ __forceinline__ unsigned f2bf(float f) { unsigned u = __builtin_bit_cast(unsigned, f); return (u + 0x7fffu + ((u >> 16) & 1u)) >> 16; }
__device__ __forceinline__ unsigned pk2(float lo, float hi) { return f2bf(lo) | (f2bf(hi) << 16); }
__device__ __forceinline__ unsigned cvt_pk_bf16(float lo, float hi) { unsigned r; asm volatile("v_cvt_pk_bf16_f32 %0, %1, %2" : "=v"(r) : "v"(lo), "v"(hi)); return r; }
__device__ __forceinline__ float wave_sum(float v) {
#pragma unroll
    for (int o = 1; o < 64; o <<= 1) v += __shfl_xor(v, o);
    return v;
}

#define XB_TMO      128
#define XB_XCNT(j)  (256  + 64 * (j))
#define XB_XSUB(j)  (1280 + 64 * (j))
#define XB_XGEN(j)  (2304 + 64 * (j))
#define XB_TOP      3328
#define XB_TOPGEN   3392
#define XCD_BAR_WORDS 3456
#define XB_SPIN_CAP (1u << 22)
__device__ __forceinline__ unsigned xb_ld(unsigned* p)              { return __hip_atomic_load(p, __ATOMIC_RELAXED, __HIP_MEMORY_SCOPE_AGENT); }
__device__ __forceinline__ unsigned xb_add(unsigned* p, unsigned v) { return __hip_atomic_fetch_add(p, v, __ATOMIC_RELAXED, __HIP_MEMORY_SCOPE_AGENT); }
__device__ __forceinline__ unsigned xb_xcc_id() { return (unsigned)__builtin_amdgcn_s_getreg((3 << 11) | 20) & 0xFu; }
#define XB_SPIN(cond, bar) do { unsigned _sp = 0; while (cond) { __builtin_amdgcn_s_sleep(1); \
    if ((++_sp & 255u) == 0u) { if (xb_ld(&(bar)[XB_TMO])) break; if (_sp > XB_SPIN_CAP) { atomicAdd(&(bar)[XB_TMO], 1u); break; } } } } while (0)
struct XcdBarrier { unsigned* bar; unsigned x; volatile LAS unsigned* st; };
__device__ __forceinline__ XcdBarrier xcd_barrier_post(unsigned* bar, volatile LAS unsigned* st) {
    XcdBarrier b; b.bar = bar; b.x = xb_xcc_id(); b.st = st;
    if (threadIdx.x == 0) (void)xb_add(&bar[XB_XCNT(b.x)], 1u);
    return b;
}
__device__ __forceinline__ void xcd_barrier_complete(unsigned* bar, unsigned x, unsigned& nloc, unsigned& nx) {
    const unsigned G = gridDim.x * gridDim.y * gridDim.z;
    unsigned sum, cnt, mine, sp = 0u;
    for (;;) {
        sum = 0u; cnt = 0u; mine = 0u;
#pragma unroll
        for (unsigned j = 0; j < 16; ++j) { const unsigned c = xb_ld(&bar[XB_XCNT(j)]); sum += c; cnt += (c > 0u) ? 1u : 0u; mine = (j == x) ? c : mine; }
        if (sum == G) break;
        __builtin_amdgcn_s_sleep(1);
        if ((++sp & 255u) == 0u) { if (xb_ld(&bar[XB_TMO])) break; if (sp > XB_SPIN_CAP) { atomicAdd(&bar[XB_TMO], 1u); break; } }
    }
    nloc = mine > 0u ? mine : 1u; nx = cnt > 0u ? cnt : 1u;
}
__device__ __forceinline__ void xcd_barrier(const XcdBarrier& b) {
    asm volatile("s_waitcnt vmcnt(0)" ::: "memory");
    __syncthreads();
    if (threadIdx.x == 0) {
        unsigned* bar = b.bar;
        __builtin_amdgcn_s_waitcnt(0);
        unsigned nloc = b.st[0], nx = b.st[1];
        if (nloc == 0u) { xcd_barrier_complete(bar, b.x, nloc, nx); b.st[0] = nloc; b.st[1] = nx; }
        const unsigned old = xb_add(&bar[XB_XSUB(b.x)], 1u);
        const unsigned gen = old / nloc;
        if (old + 1u == (gen + 1u) * nloc) {
            __builtin_amdgcn_fence(__ATOMIC_RELEASE, "agent");
            asm volatile("s_waitcnt vmcnt(0)" ::: "memory");
            const unsigned og = xb_add(&bar[XB_TOP], 1u);
            const unsigned tg = og / nx;
            if (og + 1u == (tg + 1u) * nx) xb_add(&bar[XB_TOPGEN], 1u);
            else XB_SPIN(xb_ld(&bar[XB_TOPGEN]) == tg, bar);
            __builtin_amdgcn_fence(__ATOMIC_ACQUIRE, "agent");
            xb_add(&bar[XB_XGEN(b.x)], 1u);
            asm volatile("s_waitcnt vmcnt(0)" ::: "memory");
        } else {
            XB_SPIN(xb_ld(&bar[XB_XGEN(b.x)]) == gen, bar);
            __builtin_amdgcn_fence(__ATOMIC_ACQUIRE, "agent");
            asm volatile("s_waitcnt vmcnt(0)" ::: "memory");
        }
    }
    __syncthreads();
}

namespace pg8 {
constexpr int BM = 256, BK = 64, HALF = 128, HTB = HALF * BK * 2, STAGE_BYTES = 8 * HTB, NXCD = 8, WGM = 8;
__host__ __device__ __forceinline__ int lds_byte(int r, int c) { const int st = (r >> 4) * 2 + (c >> 5), rr = r & 15, cc = c & 31, ob = rr * 64 + cc * 2; return st * 1024 + (ob ^ (((ob >> 9) & 1) << 5)); }
__host__ __device__ __forceinline__ void stage_rc(int b, int& R, int& C) { const int st = b / 1024, sb = b % 1024, swz = sb ^ (((sb >> 9) & 1) << 5); R = (st >> 1) * 16 + swz / 64; C = (st & 1) * 32 + (swz % 64) / 2; }
__host__ __device__ __forceinline__ int perm32(int rho) { const int n = rho >> 4, i = rho & 15; return 8 * (i >> 2) + 4 * n + (i & 3); }

struct Unit { int pm, pn, cls, row0, ncls, elo, ehi; };

struct StaticOrder {
    int nM, nN, nwg, G, c;
    __device__ void init(int M, int N, int G_, int c_) { nM = M / BM; nN = N / BM; nwg = nM * nN; G = G_; c = c_; }
    __device__ __forceinline__ bool next(int i, Unit& u) const {
        const long L = (long)i * G + c; if (L >= nwg) return false;
        int wgid = (int)L; { const int q = nwg / NXCD, r = nwg % NXCD, xcd = wgid % NXCD, off = wgid / NXCD; wgid = (xcd < r ? xcd * (q + 1) : r * (q + 1) + (xcd - r) * q) + off; }
        const int nig = WGM * nN, gid = wgid / nig, fm = gid * WGM, gsz = (nM - fm) < WGM ? (nM - fm) : WGM;
        u.pm = fm + ((wgid % nig) % gsz); u.pn = (wgid % nig) / gsz; u.cls = 0; u.row0 = 0; u.ncls = 0; u.elo = 0; u.ehi = 0; return true;
    }
};

struct ProbDense {
    const char* A; const char* B; int lda, ldb, nt; StaticOrder S; bool skip_ctx;
    __device__ __forceinline__ bool next(int i, Unit& u) const { if (!S.next(i, u)) return false; if (skip_ctx) u.pm += 1 + (u.pm >= 64 ? 1 : 0); return true; }
    __device__ __forceinline__ void a_offs(const Unit& u, int tid, unsigned (&off)[2][2]) const {
#pragma unroll
        for (int i = 0; i < 2; ++i) { int R, C; stage_rc(tid * 16 + i * 8192, R, C);
#pragma unroll
            for (int h = 0; h < 2; ++h) off[h][i] = (unsigned)((u.pm * BM + h * HALF + R) * lda + C) * 2u; }
    }
    __device__ __forceinline__ const char* b_ptr(const Unit& u, int t) const { return B + (size_t)u.pn * BM * ldb * 2 + (size_t)t * (BK * 2); }
};
__device__ __forceinline__ void moe_unit(const LAS int* s_n, const LAS int* s_ts, int rt, Unit& u) {
    int cc = 0; while (s_ts[cc + 1] <= rt) ++cc;
    u.pm = rt; u.cls = cc; u.row0 = (rt - s_ts[cc]) * BM; u.ncls = s_n[cc];
    const int g = cc / 6, idx = cc % 6; const int a = idx < 3 ? 0 : (idx < 5 ? 1 : 2), b = idx < 3 ? idx + 1 : (idx < 5 ? idx - 1 : 3);
    u.elo = 4 * g + a; u.ehi = 4 * g + b;
}
struct ProbGU {
    const char* A; const char* B; const int* tok; const LAS int* s_n; const LAS int* s_ts; int total, G, c; static constexpr int ldb = 1024; int nt;
    __device__ __forceinline__ bool next(int i, Unit& u) const { const long L = (long)i * G + c; if (L >= total) return false; u.pn = (int)(L & 7); moe_unit(s_n, s_ts, (int)(L >> 3), u); return true; }
    __device__ __forceinline__ void a_offs(const Unit& u, int tid, unsigned (&off)[2][2]) const {
#pragma unroll
        for (int i = 0; i < 2; ++i) { int R, C; stage_rc(tid * 16 + i * 8192, R, C);
#pragma unroll
            for (int h = 0; h < 2; ++h) { int r = u.row0 + h * HALF + R; r = r < u.ncls ? r : u.ncls - 1; const int t = tok[(size_t)u.cls * CAP + r]; off[h][i] = (unsigned)t * 2048u + (unsigned)C * 2u; } }
    }
    __device__ __forceinline__ const char* b_ptr(const Unit& u, int t) const { const int e = u.pn >= 4 ? u.ehi : u.elo; return B + (size_t)e * (1024 * 1024 * 2) + (size_t)(u.pn & 3) * (BM * 1024 * 2) + (size_t)t * (BK * 2); }
};
struct ProbDown {
    const char* A; const char* B; const LAS int* s_n; const LAS int* s_ts; int total, G, c; static constexpr int ldb = 512; int nt;
    __device__ __forceinline__ bool next(int i, Unit& u) const { const long L = (long)i * G + c; if (L >= total) return false; u.pn = (int)(L & 3); moe_unit(s_n, s_ts, (int)(L >> 2), u); return true; }
    __device__ __forceinline__ void a_offs(const Unit& u, int tid, unsigned (&off)[2][2]) const {
#pragma unroll
        for (int i = 0; i < 2; ++i) { int R, C; stage_rc(tid * 16 + i * 8192, R, C);
#pragma unroll
            for (int h = 0; h < 2; ++h) off[h][i] = (unsigned)(u.pm * BM + h * HALF + R) * 2048u + (unsigned)C * 2u; }
    }
    __device__ __forceinline__ const char* b_ptr(const Unit& u, int t) const { const int e = t < 8 ? u.elo : u.ehi; return B + (size_t)e * (1024 * 512 * 2) + (size_t)u.pn * (BM * 512 * 2) + (size_t)(t & 7) * (BK * 2); }
};

template <class Epi, class Prob, bool ALIGN_EPI>
__device__ __forceinline__ void gemm_phase(LAS unsigned char* lds, LAS unsigned char* offs_lds, const Prob& P, const Epi& E) {
    int tid_ = threadIdx.x; asm volatile("" : "+v"(tid_));
    const int tid = tid_, wid = __builtin_amdgcn_readfirstlane(tid >> 6), lane = tid & 63, wr = wid >> 2, wc = wid & 3, fr = lane & 15, fq = lane >> 4;
    const int nt = P.nt;
    unsigned voffB[2];
#pragma unroll
    for (int i = 0; i < 2; ++i) { int R, C; stage_rc(tid * 16 + i * 8192, R, C); const int Rb = Epi::PERM ? ((R & ~31) + perm32(R & 31)) : R; voffB[i] = (unsigned)(Rb * P.ldb + C) * 2u; }
    LAS u32x4* const myoffs = (LAS u32x4*)offs_lds + tid;
    const size_t hstepB = (size_t)HALF * P.ldb * 2;
    const unsigned ldsw = (unsigned)wid * 1024u;
    const int aoff = lds_byte(wr * 64 + fr, fq * 8), boff = lds_byte(wc * 32 + fr, fq * 8);
    const char* const Ab = P.A;
#define PG8_SA(b, h) (((b) * 2 + (h)) * HTB)
#define PG8_SB(b, h) ((4 + (b) * 2 + (h)) * HTB)
#define PG8_STAGE_A(bufoff, h, offs, kt) do { _Pragma("unroll") for (int _i = 0; _i < 2; ++_i) \
        __builtin_amdgcn_global_load_lds((const unsigned*)(Ab + (size_t)(offs)[h][_i] + (size_t)(kt) * (BK * 2)), (LAS unsigned*)(lds + (bufoff) + ldsw + _i * 8192), 16, 0, 0); } while (0)
#define PG8_STAGE_B(bufoff, bp) do { _Pragma("unroll") for (int _i = 0; _i < 2; ++_i) \
        __builtin_amdgcn_global_load_lds((const unsigned*)((bp) + voffB[_i]), (LAS unsigned*)(lds + (bufoff) + ldsw + _i * 8192), 16, 0, 0); } while (0)
#define PG8_LDA(dst, b, h) do { _Pragma("unroll") for (int m = 0; m < 4; ++m) _Pragma("unroll") for (int k = 0; k < 2; ++k) dst[m][k] = *(const LAS bf16x8*)(lds + PG8_SA(b, h) + aoff + m * 2048 + k * 1024); } while (0)
#define PG8_LDB(dst, b, h) do { _Pragma("unroll") for (int n = 0; n < 2; ++n) _Pragma("unroll") for (int k = 0; k < 2; ++k) dst[n][k] = *(const LAS bf16x8*)(lds + PG8_SB(b, h) + boff + n * 2048 + k * 1024); } while (0)
#define PG8_MMA(ai, bj, At, Bt) do { __builtin_amdgcn_s_setprio(1); _Pragma("unroll") for (int m = 0; m < 4; ++m) _Pragma("unroll") for (int n = 0; n < 2; ++n) _Pragma("unroll") for (int k = 0; k < 2; ++k) \
        acc[ai][bj][m][n] = __builtin_amdgcn_mfma_f32_16x16x32_bf16(Bt[n][k], At[m][k], acc[ai][bj][m][n], 0, 0, 0); __builtin_amdgcn_s_setprio(0); } while (0)
#define PG8_WAIT_V(n) asm volatile("s_waitcnt vmcnt(" #n ")" ::: "memory")
#define PG8_WAIT_L(n) asm volatile("s_waitcnt lgkmcnt(" #n ")" ::: "memory")
#define PG8_BAR __builtin_amdgcn_s_barrier()
#define PG8_SCHED __builtin_amdgcn_sched_barrier(0)
    Unit cur, nxt; int ui = 0;
    if (!P.next(0, cur)) return;
    f32x4 acc[2][2][4][2];
#pragma unroll
    for (int a = 0; a < 2; ++a)
#pragma unroll
        for (int b = 0; b < 2; ++b)
#pragma unroll
            for (int m = 0; m < 4; ++m)
#pragma unroll
                for (int n = 0; n < 2; ++n) acc[a][b][m][n] = (f32x4){0.f, 0.f, 0.f, 0.f};
    bf16x8 At[4][2], B0[2][2], B1[2][2];
    unsigned offC[2][2];
    P.a_offs(cur, tid, offC);
    {
        const char* b0 = P.b_ptr(cur, 0); const char* b1 = P.b_ptr(cur, 1);
        PG8_STAGE_B(PG8_SB(0, 0), b0); PG8_STAGE_B(PG8_SB(0, 1), b0 + hstepB); PG8_STAGE_A(PG8_SA(0, 0), 0, offC, 0); PG8_STAGE_A(PG8_SA(0, 1), 1, offC, 0);
        if (wr == 1) PG8_BAR;
        PG8_WAIT_V(2); PG8_BAR;
        PG8_STAGE_B(PG8_SB(1, 0), b1); PG8_STAGE_A(PG8_SA(1, 0), 0, offC, 1); PG8_STAGE_B(PG8_SB(1, 1), b1 + hstepB);
        PG8_WAIT_V(6); PG8_BAR;
    }
    for (;;) {
        const bool has_next = P.next(ui + 1, nxt);
        if (!has_next) nxt = cur;
        {
            unsigned offN[2][2];
            if (has_next) P.a_offs(nxt, tid, offN);
            else {
#pragma unroll
                for (int h = 0; h < 2; ++h)
#pragma unroll
                    for (int i = 0; i < 2; ++i) offN[h][i] = offC[h][i];
            }
            *myoffs = (u32x4){offN[0][0], offN[0][1], offN[1][0], offN[1][1]};
        }
        for (int t = 0; t < nt; t += 2) {
            const bool last = (t == nt - 2);
            const int k2 = last ? 0 : t + 2;
            const char* b2 = last ? P.b_ptr(nxt, 0) : P.b_ptr(cur, t + 2);
            const char* b3 = last ? P.b_ptr(nxt, 1) : P.b_ptr(cur, t + 3);
            PG8_LDB(B0, 0, 0); PG8_LDB(B1, 0, 1); PG8_SCHED; PG8_LDA(At, 0, 0); PG8_STAGE_A(PG8_SA(1, 1), 1, offC, t + 1);
            if (last) { const u32x4 v = *myoffs; offC[0][0] = v.x; offC[0][1] = v.y; offC[1][0] = v.z; offC[1][1] = v.w; }
            PG8_WAIT_V(8); PG8_WAIT_L(0); PG8_BAR; PG8_MMA(0, 0, At, B0); PG8_MMA(0, 1, At, B1); PG8_BAR; PG8_SCHED;
            PG8_LDA(At, 0, 1); PG8_STAGE_B(PG8_SB(0, 0), b2); PG8_STAGE_B(PG8_SB(0, 1), b2 + hstepB); PG8_STAGE_A(PG8_SA(0, 0), 0, offC, k2);
            PG8_WAIT_V(8); PG8_WAIT_L(0); PG8_BAR; PG8_MMA(1, 0, At, B0); PG8_MMA(1, 1, At, B1); PG8_BAR; PG8_SCHED;
            PG8_LDB(B0, 1, 0); PG8_LDB(B1, 1, 1); PG8_SCHED; PG8_LDA(At, 1, 0); PG8_STAGE_A(PG8_SA(0, 1), 1, offC, k2);
            PG8_WAIT_V(8); PG8_WAIT_L(0); PG8_BAR; PG8_MMA(0, 0, At, B0); PG8_MMA(0, 1, At, B1); PG8_BAR; PG8_SCHED;
            PG8_LDA(At, 1, 1); PG8_STAGE_B(PG8_SB(1, 0), b3); PG8_STAGE_B(PG8_SB(1, 1), b3 + hstepB); PG8_STAGE_A(PG8_SA(1, 0), 0, offC, k2 + 1);
            PG8_WAIT_V(8); PG8_WAIT_L(0); PG8_BAR; PG8_MMA(1, 0, At, B0); PG8_MMA(1, 1, At, B1); PG8_BAR; PG8_SCHED;
        }
        if constexpr (ALIGN_EPI) { if (wr == 0) PG8_BAR; }
        E(acc, cur, wr, wc, fr, fq);
        if (!has_next) break;
#pragma unroll
        for (int a = 0; a < 2; ++a)
#pragma unroll
            for (int b = 0; b < 2; ++b)
#pragma unroll
                for (int m = 0; m < 4; ++m)
#pragma unroll
                    for (int n = 0; n < 2; ++n) acc[a][b][m][n] = (f32x4){0.f, 0.f, 0.f, 0.f};
        cur = nxt; ++ui;
        if constexpr (ALIGN_EPI) { if (wr == 1) PG8_BAR; }
    }
    PG8_WAIT_V(0);
    if constexpr (!ALIGN_EPI) { if (wr == 0) PG8_BAR; }
    PG8_BAR;
#undef PG8_SA
#undef PG8_SB
#undef PG8_STAGE_A
#undef PG8_STAGE_B
#undef PG8_LDA
#undef PG8_LDB
#undef PG8_MMA
#undef PG8_WAIT_V
#undef PG8_WAIT_L
#undef PG8_BAR
#undef PG8_SCHED
}
}

namespace pg8 {
struct EpiQKV {
    static constexpr bool PERM = true;
    unsigned char* ws; const float* gn; const float* rope;
    __device__ __forceinline__ void operator()(const f32x4 (&acc)[2][2][4][2], const Unit& u, int wr, int wc, int fr, int fq) const {
        const int pn = u.pn, tb = u.pm % 65;
        const bool is_ctx = (tb == 0);
        const bool isV = (pn >= 4) && (wc >= 2);
        const float* gain = gn + (pn < 2 ? 0 : (pn < 4 ? 64 : (pn == 4 ? 128 : 192)));
        const float osc = pn < 4 ? C2 : 1.0f;
        bf16_t* dst = (bf16_t*)(ws + (pn < 4 ? WS_QO : WS_KV));
        const int ldd = pn < 4 ? 1024 : 512, colbase = 256 * (pn < 4 ? pn : pn - 4) + 64 * wc;
#pragma unroll
        for (int ai = 0; ai < 2; ++ai)
#pragma unroll
            for (int m = 0; m < 4; ++m) {
                const int row = u.pm * BM + ai * HALF + wr * 64 + m * 16 + fr;
                f32x4 v[2][2];
#pragma unroll
                for (int bj = 0; bj < 2; ++bj)
#pragma unroll
                    for (int n = 0; n < 2; ++n) v[bj][n] = acc[ai][bj][m][n];
                if (!isV) {
                    float ss = 0.f;
#pragma unroll
                    for (int bj = 0; bj < 2; ++bj)
#pragma unroll
                        for (int n = 0; n < 2; ++n) { const f32x4 x = v[bj][n]; ss += (x[0] * x[0] + x[1] * x[1]) + (x[2] * x[2] + x[3] * x[3]); }
                    ss += __shfl_xor(ss, 16); ss += __shfl_xor(ss, 32);
                    const float rs = osc / sqrtf(ss * (1.0f / 64.0f) + NORM_EPS);
#pragma unroll
                    for (int bj = 0; bj < 2; ++bj)
#pragma unroll
                        for (int n = 0; n < 2; ++n) v[bj][n] = v[bj][n] * rs * *(const f32x4*)(gain + 32 * bj + 16 * n + 4 * fq);
                    if (!is_ctx) {
                        const int pr = (tb - 1) * 4 + 2 * ai + wr, pc = 16 * m + fr;
#pragma unroll
                        for (int bj = 0; bj < 2; ++bj) {
                            const int pos = bj ? pc : pr;
                            const f32x4* rp = (const f32x4*)(rope + (size_t)(pos * 16 + 4 * fq) * 2);
                            const f32x4 r0 = rp[0], r1 = rp[1];
                            const f32x4 cs = (f32x4){r0[0], r0[2], r1[0], r1[2]}, sn = (f32x4){r0[1], r0[3], r1[1], r1[3]};
                            const f32x4 x1 = v[bj][0], x2 = v[bj][1];
                            v[bj][0] = x1 * cs - x2 * sn; v[bj][1] = x2 * cs + x1 * sn;
                        }
                    }
                }
                if (pn < 4) {
                    bf16_t* rowp = dst + (size_t)row * ldd + colbase + 4 * fq;
#pragma unroll
                    for (int bj = 0; bj < 2; ++bj)
#pragma unroll
                        for (int n = 0; n < 2; ++n) { u32x2 w; w.x = cvt_pk_bf16(v[bj][n][0], v[bj][n][1]); w.y = cvt_pk_bf16(v[bj][n][2], v[bj][n][3]); *(u32x2*)(rowp + 32 * bj + 16 * n) = w; }
                } else {
                    unsigned char* tb = (unsigned char*)dst + ((size_t)(u.pm * 4 + ai * 2 + wr) * 8 + (isV ? 4 : 0) + 2 * (pn - 4) + (wc & 1)) * 8192;
                    if (!isV) {
                        const unsigned kof = (unsigned)((fq >> 1) * 1024 + (16 * m + fr) * 16 + 8 * (fq & 1));
#pragma unroll
                        for (int bj = 0; bj < 2; ++bj)
#pragma unroll
                            for (int n = 0; n < 2; ++n) { u32x2 w; w.x = cvt_pk_bf16(v[bj][n][0], v[bj][n][1]); w.y = cvt_pk_bf16(v[bj][n][2], v[bj][n][3]);
                                *(u32x2*)(tb + (kof + (unsigned)((4 * bj + 2 * n) * 1024))) = w; }
                    } else {
                        const int sub = fr >> 2, hb = sub & 1;
                        const unsigned vbase = (unsigned)(4 * fq * 128 + (4 * (sub >> 1) + (fr & 3)) * 2);
#pragma unroll
                        for (int j = 0; j < 4; ++j) { const int swz = (2 * fq + (j >> 1)) & 7;
                            const unsigned vof = vbase + (unsigned)(j * 128) + (unsigned)((((2 * m) ^ (swz & 6)) | ((hb ^ swz) & 1)) * 16);
#pragma unroll
                            for (int bj = 0; bj < 2; ++bj)
#pragma unroll
                                for (int n = 0; n < 2; ++n) *(bf16_t*)(tb + (vof + (unsigned)((32 * bj + 16 * n) * 128))) = (bf16_t)f2bf(v[bj][n][j]); }
                    }
                }
            }
    }
};
__device__ __forceinline__ float bf_lo(unsigned w) { return __builtin_bit_cast(float, w << 16); }
__device__ __forceinline__ float bf_hi(unsigned w) { return __builtin_bit_cast(float, w & 0xffff0000u); }
struct EpiResid {
    static constexpr bool PERM = true;
    bf16_t* XS; const float* modv_l; int goff; float sgn;
    __device__ __forceinline__ void operator()(const f32x4 (&acc)[2][2][4][2], const Unit& u, int wr, int wc, int fr, int fq) const {
        const int mv = (u.pm % 65 == 0) ? 2 : (u.pm / 65);
        const float* g = modv_l + mv * 6144 + goff;
        const int col0 = u.pn * BM + wc * 32 + 8 * fq;
        f32x4 gv[2][2];
#pragma unroll
        for (int bj = 0; bj < 2; ++bj)
#pragma unroll
            for (int n = 0; n < 2; ++n) gv[bj][n] = *(const f32x4*)(g + col0 + bj * HALF + n * 4) * sgn;
#pragma unroll
        for (int ai = 0; ai < 2; ++ai)
#pragma unroll
            for (int m = 0; m < 4; ++m) {
                bf16_t* rowp = XS + (size_t)(u.pm * BM + ai * HALF + wr * 64 + m * 16 + fr) * 1024 + col0;
#pragma unroll
                for (int bj = 0; bj < 2; ++bj) { u32x4* p = (u32x4*)(rowp + bj * HALF); const u32x4 w = *p; u32x4 o;
                    const f32x4 a0 = gv[bj][0] * acc[ai][bj][m][0], a1 = gv[bj][1] * acc[ai][bj][m][1];
                    o.x = cvt_pk_bf16(bf_lo(w.x) + a0[0], bf_hi(w.x) + a0[1]); o.y = cvt_pk_bf16(bf_lo(w.y) + a0[2], bf_hi(w.y) + a0[3]);
                    o.z = cvt_pk_bf16(bf_lo(w.z) + a1[0], bf_hi(w.z) + a1[1]); o.w = cvt_pk_bf16(bf_lo(w.w) + a1[2], bf_hi(w.w) + a1[3]);
                    *p = o; }
            }
    }
};
struct EpiGU {
    static constexpr bool PERM = true;
    bf16_t* ACT; const f32x2* wts;
    __device__ __forceinline__ void operator()(const f32x4 (&acc)[2][2][4][2], const Unit& u, int wr, int wc, int fr, int fq) const {
        const int k = u.pn >= 4 ? 1 : 0, jt = u.pn & 3;
        const int colbase = 512 * k + 128 * jt + 32 * wc + 8 * fq;
#pragma unroll
        for (int ai = 0; ai < 2; ++ai)
#pragma unroll
            for (int m = 0; m < 4; ++m) {
                const int r = ai * HALF + wr * 64 + m * 16 + fr;
                int idx = u.row0 + r; idx = idx < u.ncls ? idx : u.ncls - 1;
                const f32x2 w2 = wts[(size_t)u.cls * CAP + idx];
                const float w = k ? w2[1] : w2[0];
                u32x4 o;
#pragma unroll
                for (int n = 0; n < 2; ++n) {
                    const f32x4 g = acc[ai][0][m][n], up = acc[ai][1][m][n]; float a[4];
#pragma unroll
                    for (int j = 0; j < 4; ++j) { const float sg = g[j] * __builtin_amdgcn_rcpf(1.0f + __builtin_amdgcn_exp2f(-g[j] * LOG2E)); a[j] = w * sg * up[j]; }
                    const unsigned lo = cvt_pk_bf16(a[0], a[1]), hi = cvt_pk_bf16(a[2], a[3]);
                    if (n == 0) { o.x = lo; o.y = hi; } else { o.z = lo; o.w = hi; }
                }
                *(u32x4*)(ACT + (size_t)(u.pm * BM + r) * 1024 + colbase) = o;
            }
    }
};
struct EpiDown {
    static constexpr bool PERM = true;
    bf16_t* XS; float* out; const int* tok; const float* modv_l; float sgn;
    __device__ __forceinline__ void operator()(const f32x4 (&acc)[2][2][4][2], const Unit& u, int wr, int wc, int fr, int fq) const {
        const int col0 = u.pn * BM + wc * 32 + 8 * fq;
#pragma unroll
        for (int ai = 0; ai < 2; ++ai)
#pragma unroll
            for (int m = 0; m < 4; ++m) {
                const int idx = u.row0 + ai * HALF + wr * 64 + m * 16 + fr;
                if (idx < u.ncls) {
                    const int t = tok[(size_t)u.cls * CAP + idx];
                    const int b = t >= RB ? 1 : 0, rr = t - b * RB;
                    const int mv = rr < NCTX ? 2 : b;
                    const float* g = modv_l + mv * 6144 + 5120 + col0;
                    bf16_t* xp = XS + (size_t)t * 1024 + col0;
                    float* op = out + (size_t)(b * SEQ + rr - NCTX) * 1024 + col0;
#pragma unroll
                    for (int bj = 0; bj < 2; ++bj) { const u32x4 w = *(const u32x4*)(xp + bj * HALF);
                        const f32x4 a0 = (*(const f32x4*)(g + bj * HALF) * sgn) * acc[ai][bj][m][0], a1 = (*(const f32x4*)(g + bj * HALF + 4) * sgn) * acc[ai][bj][m][1];
                        const f32x4 x0 = (f32x4){bf_lo(w.x) + a0[0], bf_hi(w.x) + a0[1], bf_lo(w.y) + a0[2], bf_hi(w.y) + a0[3]}, x1 = (f32x4){bf_lo(w.z) + a1[0], bf_hi(w.z) + a1[1], bf_lo(w.w) + a1[2], bf_hi(w.w) + a1[3]};
                        if (out) { *(f32x4*)(op + bj * HALF) = x0; *(f32x4*)(op + bj * HALF + 4) = x1; }
                        else { u32x4 o; o.x = cvt_pk_bf16(x0[0], x0[1]); o.y = cvt_pk_bf16(x0[2], x0[3]); o.z = cvt_pk_bf16(x1[0], x1[1]); o.w = cvt_pk_bf16(x1[2], x1[3]); *(u32x4*)(xp + bj * HALF) = o; }
                    }
                }
            }
    }
};
}

namespace attn_body {
using bf16 = __hip_bfloat16;
using s16x4 = __attribute__((ext_vector_type(4))) short;
using f32x16 = __attribute__((ext_vector_type(16))) float;
constexpr int D = 64, QP = 1024, KP = 512;
constexpr int NW = 8, QBLK = 32, QB = QBLK * NW, KVBLK = 64;
__device__ __forceinline__ int crow(int r, int hi) { return (r & 3) + 8 * (r >> 2) + 4 * hi; }
#define SBAR() __builtin_amdgcn_sched_barrier(0)
constexpr int NSLOT = 3, SLOTB = 8192;
constexpr int LDS_K = 0, LDS_V = NSLOT * SLOTB, LDS_WS = 2 * NSLOT * SLOTB, LDS_OST = LDS_WS + NW * 64 * 4, LDS_BYTES = LDS_OST + NW * 4096;
__device__ __forceinline__ void glds16(const void* gsrc, unsigned lds_dst) { unsigned keep;
  asm volatile("s_mov_b32 %0, m0\n\ts_mov_b32 m0, %2\n\ts_nop 0\n\tglobal_load_lds_dwordx4 %1, off\n\ts_mov_b32 m0, %0" : "=&s"(keep) : "v"(gsrc), "s"(lds_dst) : "memory"); }
__device__ __forceinline__ float max3f(float a, float b, float c) { float r; asm("v_max3_f32 %0, %1, %2, %3" : "=v"(r) : "v"(a), "v"(b), "v"(c)); return r; }
__device__ __forceinline__ float max2f(float a, float b) { float r; asm("v_max_f32_e32 %0, %1, %2" : "=v"(r) : "v"(a), "v"(b)); return r; }
__device__ __forceinline__ float fadd_s(float a, float b) { float r; asm("v_add_f32_e32 %0, %1, %2" : "=v"(r) : "v"(a), "v"(b)); return r; }
__device__ __forceinline__ float fsub_s(float a, float b) { float r; asm("v_sub_f32_e32 %0, %1, %2" : "=v"(r) : "v"(a), "v"(b)); return r; }
typedef float f32x2_t __attribute__((ext_vector_type(2))); typedef __bf16 bf16x2_t __attribute__((ext_vector_type(2)));
__device__ __forceinline__ unsigned cvtpk_s(float lo, float hi) { f32x2_t v = {lo, hi}; bf16x2_t b = __builtin_convertvector(v, bf16x2_t); return __builtin_bit_cast(unsigned, b); }
#define WAIT_BAR(N) asm volatile("s_waitcnt vmcnt(" #N ") lgkmcnt(0)\n\ts_barrier" ::: "memory")

__device__ __forceinline__ void qkt(f32x16& p0, f32x16& p1, const char* Kslot, const bf16x8* qr, const f32x16& negm, int r32, int hi) {
  const char* kb = Kslot + hi * 1024 + r32 * 16;
  #pragma unroll
  for (int d0 = 0; d0 < 4; ++d0) {
    const bf16x8 b0 = *reinterpret_cast<const bf16x8*>(kb + d0 * 2048);
    const bf16x8 b1 = *reinterpret_cast<const bf16x8*>(kb + d0 * 2048 + 512);
    if (d0 == 0) { p0 = __builtin_amdgcn_mfma_f32_32x32x16_bf16(b0, qr[0], negm, 0, 0, 0); p1 = __builtin_amdgcn_mfma_f32_32x32x16_bf16(b1, qr[0], negm, 0, 0, 0); }
    else { p0 = __builtin_amdgcn_mfma_f32_32x32x16_bf16(b0, qr[d0], p0, 0, 0, 0); p1 = __builtin_amdgcn_mfma_f32_32x32x16_bf16(b1, qr[d0], p1, 0, 0, 0); } }
}
typedef __attribute__((address_space(3))) const char* lds_cptr;
typedef short v4i16_t __attribute__((ext_vector_type(4)));
__device__ __forceinline__ void kload8(bf16x8* kf, lds_cptr kp) {
  kf[0] = *(const LAS bf16x8*)(kp);        kf[1] = *(const LAS bf16x8*)(kp + 512);
  kf[2] = *(const LAS bf16x8*)(kp + 2048); kf[3] = *(const LAS bf16x8*)(kp + 2560);
  kf[4] = *(const LAS bf16x8*)(kp + 4096); kf[5] = *(const LAS bf16x8*)(kp + 4608);
  kf[6] = *(const LAS bf16x8*)(kp + 6144); kf[7] = *(const LAS bf16x8*)(kp + 6656);
}
__device__ __forceinline__ void kload2(bf16x8* kf, lds_cptr kp, int j) { kf[2 * j] = *(const LAS bf16x8*)(kp + j * 2048); kf[2 * j + 1] = *(const LAS bf16x8*)(kp + j * 2048 + 512); }
__device__ __forceinline__ s16x4 vtr(lds_cptr p) { return __builtin_bit_cast(s16x4, __builtin_amdgcn_ds_read_tr16_b64_v4i16((LAS v4i16_t*)p)); }
__device__ __forceinline__ float rowmax(const f32x16& p0, const f32x16& p1) {
  float a = max3f(p0[0], p0[1], p1[0]), b = max3f(p0[2], p0[3], p1[1]); a = max3f(a, p1[2], p1[3]);
  #pragma unroll
  for (int r = 4; r < 16; r += 4) { a = max3f(a, p0[r], p0[r + 1]); b = max3f(b, p0[r + 2], p0[r + 3]); a = max3f(a, p1[r], p1[r + 1]); b = max3f(b, p1[r + 2], p1[r + 3]); }
  const float m = max2f(a, b);
  auto rr = __builtin_amdgcn_permlane32_swap(__float_as_uint(m), __float_as_uint(m), false, false);
  return max2f(__uint_as_float(rr[0]), __uint_as_float(rr[1]));
}
__device__ __forceinline__ void pv(f32x16* o, int vb, bf16x8 pa0, bf16x8 pa1, bf16x8 pa2, bf16x8 pa3) {
  #pragma unroll
  for (int d0 = 0; d0 < 2; ++d0) { s16x4 lo[4], hi[4];
    #pragma unroll
    for (int ks = 0; ks < 4; ++ks) {
      asm volatile("ds_read_b64_tr_b16 %0,%1 offset:%c2" : "=&v"(lo[ks]) : "v"(vb), "i"(d0 * 4096 + ks * 1024) : "memory");
      asm volatile("ds_read_b64_tr_b16 %0,%1 offset:%c2" : "=&v"(hi[ks]) : "v"(vb), "i"(d0 * 4096 + ks * 1024 + 512) : "memory"); }
    asm volatile("s_waitcnt lgkmcnt(0)" ::: "memory"); SBAR();
    #define PK(k) (bf16x8){lo[k][0], lo[k][1], lo[k][2], lo[k][3], hi[k][0], hi[k][1], hi[k][2], hi[k][3]}
    o[d0] = __builtin_amdgcn_mfma_f32_32x32x16_bf16(pa0, PK(0), o[d0], 0, 0, 0);
    o[d0] = __builtin_amdgcn_mfma_f32_32x32x16_bf16(pa1, PK(1), o[d0], 0, 0, 0);
    o[d0] = __builtin_amdgcn_mfma_f32_32x32x16_bf16(pa2, PK(2), o[d0], 0, 0, 0);
    o[d0] = __builtin_amdgcn_mfma_f32_32x32x16_bf16(pa3, PK(3), o[d0], 0, 0, 0);
    #undef PK
  }
}
__device__ __forceinline__ void pv2(f32x16* o, const lds_cptr* vq, int slot, bf16x8 pa0, bf16x8 pa1, bf16x8 pa2, bf16x8 pa3) {
  #pragma unroll
  for (int d0 = 0; d0 < 2; ++d0) {
    const bf16x8 v0 = *(const LAS bf16x8*)(vq[0] + slot + d0 * 4096), v1 = *(const LAS bf16x8*)(vq[1] + slot + d0 * 4096), v2 = *(const LAS bf16x8*)(vq[2] + slot + d0 * 4096), v3 = *(const LAS bf16x8*)(vq[3] + slot + d0 * 4096);
    o[d0] = __builtin_amdgcn_mfma_f32_32x32x16_bf16(pa0, v0, o[d0], 0, 0, 0);
    o[d0] = __builtin_amdgcn_mfma_f32_32x32x16_bf16(pa1, v1, o[d0], 0, 0, 0);
    o[d0] = __builtin_amdgcn_mfma_f32_32x32x16_bf16(pa2, v2, o[d0], 0, 0, 0);
    o[d0] = __builtin_amdgcn_mfma_f32_32x32x16_bf16(pa3, v3, o[d0], 0, 0, 0);
  }
}
__device__ __forceinline__ void bandmask(f32x16& p0, f32x16& p1, int t, int mlo, unsigned mspan, int qrel, int hi) {
  const float NEG = -INFINITY; const int kb = 64 * (t - 4) - 128 + 4 * hi - qrel - mlo;
  #pragma unroll
  for (int r = 0; r < 16; ++r) { const int d0 = kb + (r & 3) + 8 * (r >> 2); if ((unsigned)d0 > mspan) p0[r] = NEG; if ((unsigned)(d0 + 32) > mspan) p1[r] = NEG; }
}
#ifndef FASTEXP
#define FASTEXP 0
#endif
__device__ __forceinline__ float exp2_fast(float x) { const float t = __builtin_fmaf(x, 8388608.0f, 1064986823.0f); unsigned u; asm("v_cvt_u32_f32 %0, %1" : "=v"(u) : "v"(t)); return __builtin_bit_cast(float, u); }
#define ATTN_STORE16(p, v) (*(u32x4*)(p) = (v))

template <int MODE, int THRL> __device__ __forceinline__ void attn_unit(long qrow, long kvrow, int q0, int qcol, int kcol, int vcol, int NT, float sink2, const bf16* Q, const bf16* __restrict__ KVb, bf16* O, char* shm) {
  int tid_ = threadIdx.x; asm volatile("" : "+v"(tid_));
  const int tid = tid_, lane = tid & 63, r32 = lane & 31, hi = lane >> 5; const int wid = __builtin_amdgcn_readfirstlane(tid >> 6);
  const bf16* Qw = Q + (qrow + wid * QBLK) * QP + qcol;
  const char* kvt = (const char*)KVb + (size_t)(kvrow >> 6) * 65536 + wid * 1024 + lane * 16;
  const unsigned lds0 = (unsigned)(uintptr_t)shm;
  float* wsf = (float*)(shm + LDS_WS) + wid * 64;
  const char* ksrc = kvt + kcol * 8192; const char* vsrc = kvt + vcol * 8192;
  const unsigned kdst = lds0 + LDS_K + wid * 1024, vdst = lds0 + LDS_V + wid * 1024;
  #define ROWOFF(t) ((long)(MODE == 1 ? ((t) + ((t) >= 4 ? ((q0 - 128) >> 6) : 0)) : (t)) * 65536)
  #define DMA_K(t, slot) glds16(ksrc + ROWOFF(t), (unsigned)__builtin_amdgcn_readfirstlane(kdst + (slot)))
  #define DMA_V(t, slot) glds16(vsrc + ROWOFF(t), (unsigned)__builtin_amdgcn_readfirstlane(vdst + (slot)))
  const char* Kbase = shm + LDS_K; bf16x8 kf[8];
  const lds_cptr shm3 = (lds_cptr)shm; const lds_cptr kp0 = shm3 + LDS_K + hi * 1024 + r32 * 16; lds_cptr vq[4];
  { const int swz = (r32 >> 1) & 7; _Pragma("unroll") for (int ks_ = 0; ks_ < 4; ++ks_) vq[ks_] = shm3 + LDS_V + r32 * 128 + (((2 * ks_ + hi) ^ swz) * 16); }
  DMA_K(0, 0); DMA_V(0, 0); DMA_K(1, SLOTB);
  bf16x8 qr[4];
  #pragma unroll
  for (int d0 = 0; d0 < 4; ++d0) qr[d0] = *reinterpret_cast<const bf16x8*>(&Qw[(long)r32 * QP + d0 * 16 + hi * 8]);
  float mhat = 0.f, l_reg = 0.f; f32x16 o[2]; o[0] = f32x16{}; o[1] = f32x16{}; f32x16 negm = f32x16{}; asm volatile("" : "+v"(negm));
  const int qrel = wid * QBLK + r32;
  int mlo = -128, mhi = 128;
  if (MODE == 1) { const int qi = q0 + qrel; mlo = (-qi > -128) ? -qi : -128; mhi = (SEQ - 1 - qi < 128) ? (SEQ - 1 - qi) : 128; }
  const unsigned mspan = (unsigned)(mhi - mlo);
  #define CMASK(P0, P1, t) do { if (MODE == 1) { if ((t) >= 4) bandmask(P0, P1, (t), mlo, mspan, qrel, hi); } } while (0)
  bool resc = false;
  #define START(P0, P1) do { const float rm = rowmax(P0, P1); resc = false; \
    { const float dl = rm; mhat = fadd_s(mhat, dl); \
      _Pragma("unroll") for (int r = 0; r < 16; ++r) { P0[r] = fsub_s(P0[r], dl); P1[r] = fsub_s(P1[r], dl); } \
      _Pragma("unroll") for (int r = 0; r < 16; ++r) negm[r] = -mhat; asm volatile("" : "+v"(negm)); } \
    _Pragma("unroll") for (int r = 0; r < 16; ++r) P0[r] = __builtin_amdgcn_exp2f(P0[r]); } while (0)
  #define RESC() do { if (resc) { asm volatile("s_waitcnt lgkmcnt(0)" ::: "memory"); \
      _Pragma("unroll") for (int d_ = 0; d_ < 2; ++d_) _Pragma("unroll") for (int r = 0; r < 16; ++r) o[d_][r] *= wsf[crow(r, hi)]; } } while (0)
  f32x16 pA0, pA1, pB0, pB1;
  int sl_prev = 0, sl_cur = 0, sl_next = SLOTB;
  #define ROT() do { sl_prev = sl_cur; sl_cur = sl_next; sl_next = (sl_next == (NSLOT - 1) * SLOTB) ? 0 : sl_next + SLOTB; } while (0)
  DMA_K(2, 2 * SLOTB);
  WAIT_BAR(3);
  qkt(pA0, pA1, Kbase, qr, negm, r32, hi); asm volatile("s_nop 15\n\ts_nop 7" : "+v"(pA0), "+v"(pA1)); CMASK(pA0, pA1, 0);
  START(pA0, pA1);
  _Pragma("unroll") for (int r = 0; r < 16; ++r) pA1[r] = __builtin_amdgcn_exp2f(pA1[r]);
  WAIT_BAR(0);
  DMA_K(3, 0); DMA_V(1, SLOTB);
  ROT();
  kload8(kf, kp0 + sl_cur);
  WAIT_BAR(2);
  bf16x8 vfr[8]; u32x4 pw0, pw1, pw2, pw3;
  #define PKW(P, B) cvtpk_s(P[B], P[B + 1])
  #define PAF(k) __builtin_bit_cast(bf16x8, pw##k)
  #define VFR(i) vfr[i]
  #define PIN(x) asm volatile("" : "+v"(x))
  #define MX3(a, b, c) __builtin_fmaxf(__builtin_fmaxf((a), (b)), (c))
  #define GAPA(MF, A0, A1, A2, A3, W0, W1, PW) do { MF; sacc += A0; sacc += A1; sacc += A2; sacc += A3; PIN(sacc); W0; W1; PIN(PW); SBAR(); } while (0)
  #define EX(v) __builtin_amdgcn_exp2f(v)
  #define GAPB(MF, X, B) do { MF; X[B] = EX(X[B]); X[B + 1] = EX(X[B + 1]); X[B + 2] = EX(X[B + 2]); X[B + 3] = EX(X[B + 3]); PIN(X); SBAR(); } while (0)
  #define VRD(i) do { vfr[i] = *(const LAS bf16x8*)(vq[(i) & 3] + vsl_ + ((i) >> 2) * 4096); } while (0)
  #define KRD(G, j) do { if (G) { kload2(kf, kp0 + sl_next, j); SBAR(); } } while (0)
  #define STEP(C0, C1, P0, P1, t, GK, GV, GL) do { SBAR(); \
    const int vsl_ = sl_prev; \
    VRD(0); SBAR(); float sacc = (P0[0] + P0[1]); \
    GAPA(C0 = __builtin_amdgcn_mfma_f32_32x32x16_bf16(kf[0], qr[0], negm, 0, 0, 0), P0[2], P0[3], P0[4], P0[5],     pw0[0] = PKW(P0, 0), pw0[1] = PKW(P0, 2), pw0); \
    VRD(4); SBAR(); GAPA(C1 = __builtin_amdgcn_mfma_f32_32x32x16_bf16(kf[1], qr[0], negm, 0, 0, 0), P0[6], P0[7], P0[8], P0[9],     pw0[2] = PKW(P0, 4), pw0[3] = PKW(P0, 6), pw0); \
    VRD(1); SBAR(); GAPA(C0 = __builtin_amdgcn_mfma_f32_32x32x16_bf16(kf[2], qr[1], C0, 0, 0, 0),   P0[10], P0[11], P0[12], P0[13], pw1[0] = PKW(P0, 8), pw1[1] = PKW(P0, 10), pw1); \
    VRD(5); SBAR(); GAPA(C1 = __builtin_amdgcn_mfma_f32_32x32x16_bf16(kf[3], qr[1], C1, 0, 0, 0),   P0[14], P0[15], P1[0], P1[1],   pw1[2] = PKW(P0, 12), pw1[3] = PKW(P0, 14), pw1); \
    VRD(2); SBAR(); GAPA(C0 = __builtin_amdgcn_mfma_f32_32x32x16_bf16(kf[4], qr[2], C0, 0, 0, 0),   P1[2], P1[3], P1[4], P1[5],     pw2[0] = PKW(P1, 0), pw2[1] = PKW(P1, 2), pw2); \
    VRD(6); SBAR(); GAPA(C1 = __builtin_amdgcn_mfma_f32_32x32x16_bf16(kf[5], qr[2], C1, 0, 0, 0),   P1[6], P1[7], P1[8], P1[9],     pw2[2] = PKW(P1, 4), pw2[3] = PKW(P1, 6), pw2); \
    VRD(3); SBAR(); GAPA(C0 = __builtin_amdgcn_mfma_f32_32x32x16_bf16(kf[6], qr[3], C0, 0, 0, 0),   P1[10], P1[11], P1[12], P1[13], pw3[0] = PKW(P1, 8), pw3[1] = PKW(P1, 10), pw3); \
    VRD(7); SBAR(); GAPA(C1 = __builtin_amdgcn_mfma_f32_32x32x16_bf16(kf[7], qr[3], C1, 0, 0, 0),   P1[14], P1[15], 0.f, 0.f,       pw3[2] = PKW(P1, 12), pw3[3] = PKW(P1, 14), pw3); \
    l_reg += sacc; \
    if (GK) { DMA_K((t) + 3, sl_cur); } if (GV) { DMA_V((t) + 1, sl_next); } \
    CMASK(C0, C1, t); \
    { float a = MX3(C0[0], C0[1], C1[0]), b = MX3(C0[2], C0[3], C1[1]); a = MX3(a, C1[2], C1[3]); \
      _Pragma("unroll") for (int r = 4; r < 16; r += 4) { a = MX3(a, C0[r], C0[r + 1]); b = MX3(b, C0[r + 2], C0[r + 3]); a = MX3(a, C1[r], C1[r + 1]); b = MX3(b, C1[r + 2], C1[r + 3]); } \
      float rm = __builtin_fmaxf(a, b); { auto rr = __builtin_amdgcn_permlane32_swap(__float_as_uint(rm), __float_as_uint(rm), false, false); rm = __builtin_fmaxf(__uint_as_float(rr[0]), __uint_as_float(rr[1])); } \
      resc = false; \
      if (__builtin_expect(__any(rm > (float)THRL), 0)) { const float dl = __builtin_fmaxf(rm, 0.f); mhat += dl; \
        _Pragma("unroll") for (int r = 0; r < 16; ++r) { C0[r] -= dl; C1[r] -= dl; } \
        _Pragma("unroll") for (int r = 0; r < 16; ++r) negm[r] = -mhat; asm volatile("" : "+v"(negm)); \
        const float f = __builtin_amdgcn_exp2f(-dl); l_reg *= f; if (hi == 0) wsf[r32] = f; resc = true; } } \
    SBAR(); \
    GAPB(o[0] = __builtin_amdgcn_mfma_f32_32x32x16_bf16(PAF(0), VFR(0), o[0], 0, 0, 0), C0, 0); \
    GAPB(o[1] = __builtin_amdgcn_mfma_f32_32x32x16_bf16(PAF(0), VFR(4), o[1], 0, 0, 0), C0, 4); \
    KRD(GL, 0); GAPB(o[0] = __builtin_amdgcn_mfma_f32_32x32x16_bf16(PAF(1), VFR(1), o[0], 0, 0, 0), C0, 8); \
    KRD(GL, 1); GAPB(o[1] = __builtin_amdgcn_mfma_f32_32x32x16_bf16(PAF(1), VFR(5), o[1], 0, 0, 0), C0, 12); \
    KRD(GL, 2); GAPB(o[0] = __builtin_amdgcn_mfma_f32_32x32x16_bf16(PAF(2), VFR(2), o[0], 0, 0, 0), C1, 0); \
    KRD(GL, 3); GAPB(o[1] = __builtin_amdgcn_mfma_f32_32x32x16_bf16(PAF(2), VFR(6), o[1], 0, 0, 0), C1, 4); \
    GAPB(o[0] = __builtin_amdgcn_mfma_f32_32x32x16_bf16(PAF(3), VFR(3), o[0], 0, 0, 0), C1, 8); \
    GAPB(o[1] = __builtin_amdgcn_mfma_f32_32x32x16_bf16(PAF(3), VFR(7), o[1], 0, 0, 0), C1, 12); \
    } while (0)
  int t = 1;
  for (; t + 5 < NT; t += 2) {
    STEP(pB0, pB1, pA0, pA1, t, true, true, true);     WAIT_BAR(2); RESC(); ROT();
    STEP(pA0, pA1, pB0, pB1, t + 1, true, true, true);   WAIT_BAR(2); RESC(); ROT();
  }
  #define ENDW(tt) do { if ((tt) + 3 < NT) { WAIT_BAR(2); } else if ((tt) + 2 < NT) { WAIT_BAR(1); } else { WAIT_BAR(0); } } while (0)
  for (; t + 1 < NT; t += 2) {
    STEP(pB0, pB1, pA0, pA1, t, (t + 3 < NT), (t + 1 < NT), (t + 1 < NT));       ENDW(t);   RESC(); ROT();
    STEP(pA0, pA1, pB0, pB1, t + 1, (t + 4 < NT), (t + 2 < NT), (t + 2 < NT));     ENDW(t + 1); RESC(); ROT();
  }
  STEP(pB0, pB1, pA0, pA1, NT - 1, false, false, false); RESC();
  { float sacc = pB0[0] + pB0[1]; _Pragma("unroll") for (int r = 2; r < 16; ++r) sacc += pB0[r]; _Pragma("unroll") for (int r = 0; r < 16; ++r) sacc += pB1[r]; l_reg += sacc;
    pw0 = (u32x4){PKW(pB0, 0), PKW(pB0, 2), PKW(pB0, 4), PKW(pB0, 6)}; pw1 = (u32x4){PKW(pB0, 8), PKW(pB0, 10), PKW(pB0, 12), PKW(pB0, 14)}; pw2 = (u32x4){PKW(pB1, 0), PKW(pB1, 2), PKW(pB1, 4), PKW(pB1, 6)}; pw3 = (u32x4){PKW(pB1, 8), PKW(pB1, 10), PKW(pB1, 12), PKW(pB1, 14)};
    SBAR(); pv2(o, vq, sl_cur, PAF(0), PAF(1), PAF(2), PAF(3)); }
  #undef PKW
  #undef PAF
  #undef VFR
  #undef PIN
  #undef MX3
  #undef GAPA
  #undef GAPB
  #undef EX
  #undef VRD
  #undef KRD
  #undef STEP
  #undef ENDW
  { auto rr = __builtin_amdgcn_permlane32_swap(__float_as_uint(l_reg), __float_as_uint(l_reg), false, false); l_reg = __uint_as_float(rr[0]) + __uint_as_float(rr[1]); }
  l_reg += __builtin_amdgcn_exp2f(sink2 - mhat);
  if (hi == 0) wsf[32 + r32] = l_reg; asm volatile("s_waitcnt lgkmcnt(0)" ::: "memory");
  float rli[16];
  #pragma unroll
  for (int r = 0; r < 16; ++r) rli[r] = __builtin_amdgcn_rcpf(wsf[32 + crow(r, hi)]);
  bf16* Ow = O + (qrow + wid * QBLK) * QP + qcol;
  { bf16* stg = (bf16*)(shm + LDS_OST) + wid * 2048;
    #pragma unroll
    for (int r = 0; r < 16; ++r) { const int orow = crow(r, hi);
      #pragma unroll
      for (int d0 = 0; d0 < 2; ++d0) stg[orow * 64 + d0 * 32 + r32] = __float2bfloat16(o[d0][r] * rli[r]); }
    asm volatile("s_waitcnt lgkmcnt(0)" ::: "memory");
    #pragma unroll
    for (int i = 0; i < 4; ++i) { const int row = i * 8 + (lane >> 3), ch = lane & 7; const u32x4 v = *(const u32x4*)(stg + row * 64 + ch * 8); ATTN_STORE16(Ow + (long)row * QP + ch * 8, v); } }
  asm volatile("s_waitcnt lgkmcnt(0)\n\ts_barrier" ::: "memory");
  #undef DMA_K
  #undef DMA_V
  #undef ROWOFF
  #undef CMASK
  #undef START
  #undef RESC
  #undef ROT
}
template <int MODE, int XV = 0> __device__ __forceinline__ void attn_unit_sb(long qrow, long kvrow, int q0, int qcol, int kcol, int vcol, int NT, float sink2, float bound, const bf16* Q, const bf16* __restrict__ KVb, bf16* O, char* shm) {
  int tid_ = threadIdx.x; asm volatile("" : "+v"(tid_));
  const int tid = tid_, lane = tid & 63, r32 = lane & 31, hi = lane >> 5; const int wid = __builtin_amdgcn_readfirstlane(tid >> 6);
  const bf16* Qw = Q + (qrow + wid * QBLK) * QP + qcol;
  const char* kvt = (const char*)KVb + (size_t)(kvrow >> 6) * 65536 + wid * 1024 + lane * 16;
  const unsigned lds0 = (unsigned)(uintptr_t)shm;
  const char* ksrc = kvt + kcol * 8192; const char* vsrc = kvt + vcol * 8192;
  const unsigned kdst = lds0 + LDS_K + wid * 1024, vdst = lds0 + LDS_V + wid * 1024;
  #define ROWOFF(t) ((long)(MODE == 1 ? ((t) + ((t) >= 4 ? ((q0 - 128) >> 6) : 0)) : (t)) * 65536)
  #define DMA_K(t, slot) glds16(ksrc + ROWOFF(t), (unsigned)__builtin_amdgcn_readfirstlane(kdst + (slot)))
  #define DMA_V(t, slot) glds16(vsrc + ROWOFF(t), (unsigned)__builtin_amdgcn_readfirstlane(vdst + (slot)))
  const char* Kbase = shm + LDS_K; bf16x8 kf[8];
  const lds_cptr shm3 = (lds_cptr)shm; const lds_cptr kp0 = shm3 + LDS_K + hi * 1024 + r32 * 16; lds_cptr vq[4];
  { const int swz = (r32 >> 1) & 7; _Pragma("unroll") for (int ks_ = 0; ks_ < 4; ++ks_) vq[ks_] = shm3 + LDS_V + r32 * 128 + (((2 * ks_ + hi) ^ swz) * 16); }
  DMA_K(0, 0); DMA_V(0, 0); DMA_K(1, SLOTB);
  bf16x8 qr[4];
  #pragma unroll
  for (int d0 = 0; d0 < 4; ++d0) qr[d0] = *reinterpret_cast<const bf16x8*>(&Qw[(long)r32 * QP + d0 * 16 + hi * 8]);
  f32x16 o[2]; o[0] = f32x16{}; o[1] = f32x16{}; f32x16 osum = f32x16{};
  const f32x16 negm = f32x16{};
  bf16x8 ones;
  #pragma unroll
  for (int i = 0; i < 8; ++i) ones[i] = (short)0x3F80;
  asm volatile("" : "+v"(ones));
  const int qrel = wid * QBLK + r32;
  int mlo = -128, mhi = 128;
  if (MODE == 1) { const int qi = q0 + qrel; mlo = (-qi > -128) ? -qi : -128; mhi = (SEQ - 1 - qi < 128) ? (SEQ - 1 - qi) : 128; }
  const unsigned mspan = (unsigned)(mhi - mlo);
  #define CMASK(P0, P1, t) do { if (MODE == 1) { if ((t) >= 4) bandmask(P0, P1, (t), mlo, mspan, qrel, hi); } } while (0)
  f32x16 pA0, pA1, pB0, pB1;
  int sl_prev = 0, sl_cur = 0, sl_next = SLOTB;
  #define ROT() do { sl_prev = sl_cur; sl_cur = sl_next; sl_next = (sl_next == (NSLOT - 1) * SLOTB) ? 0 : sl_next + SLOTB; } while (0)
  DMA_K(2, 2 * SLOTB);
  WAIT_BAR(3);
  qkt(pA0, pA1, Kbase, qr, negm, r32, hi); asm volatile("s_nop 15\n\ts_nop 7" : "+v"(pA0), "+v"(pA1)); CMASK(pA0, pA1, 0);
  _Pragma("unroll") for (int r = 0; r < 16; ++r) { pA0[r] = __builtin_amdgcn_exp2f(pA0[r]); pA1[r] = __builtin_amdgcn_exp2f(pA1[r]); }
  WAIT_BAR(0);
  DMA_K(3, 0); DMA_V(1, SLOTB);
  ROT();
  kload8(kf, kp0 + sl_cur);
  WAIT_BAR(2);
  bf16x8 vfr[8]; u32x4 pw0, pw1, pw2, pw3;
  #define PKW(P, B) cvtpk_s(P[B], P[B + 1])
  #define PAF(k) __builtin_bit_cast(bf16x8, pw##k)
  #define VFR(i) vfr[i]
  #define PIN(x) asm volatile("" : "+v"(x))
  #define GAPA(MF, W0, W1, PW) do { MF; W0; W1; PIN(PW); SBAR(); } while (0)
  #define OSUM(k) do { if (XV != 5) osum = __builtin_amdgcn_mfma_f32_32x32x16_bf16(PAF(k), ones, osum, 0, 0, 0); SBAR(); } while (0)
  #define EX(v) (XV == 2 ? (v) : (FASTEXP ? exp2_fast(v) : __builtin_amdgcn_exp2f(v)))
  #define GAPB(MF, X, B) do { MF; X[B] = EX(X[B]); X[B + 1] = EX(X[B + 1]); X[B + 2] = EX(X[B + 2]); X[B + 3] = EX(X[B + 3]); PIN(X); SBAR(); } while (0)
  #define VRD(i) do { if (XV == 3) break; vfr[i] = *(const LAS bf16x8*)(vq[(i) & 3] + vsl_ + ((i) >> 2) * 4096); } while (0)
  #define KRD(G, j) do { if ((G) && XV != 3) { kload2(kf, kp0 + sl_next, j); SBAR(); } } while (0)
  #define STEP(C0, C1, P0, P1, t, GK, GV, GL) do { SBAR(); \
    const int vsl_ = sl_prev; \
    VRD(0); SBAR(); GAPA(C0 = __builtin_amdgcn_mfma_f32_32x32x16_bf16(kf[0], qr[0], negm, 0, 0, 0), pw0[0] = PKW(P0, 0), pw0[1] = PKW(P0, 2), pw0); \
    VRD(4); SBAR(); GAPA(C1 = __builtin_amdgcn_mfma_f32_32x32x16_bf16(kf[1], qr[0], negm, 0, 0, 0), pw0[2] = PKW(P0, 4), pw0[3] = PKW(P0, 6), pw0); \
    VRD(1); SBAR(); GAPA(C0 = __builtin_amdgcn_mfma_f32_32x32x16_bf16(kf[2], qr[1], C0, 0, 0, 0),   pw1[0] = PKW(P0, 8), pw1[1] = PKW(P0, 10), pw1); \
    OSUM(0); \
    VRD(5); SBAR(); GAPA(C1 = __builtin_amdgcn_mfma_f32_32x32x16_bf16(kf[3], qr[1], C1, 0, 0, 0),   pw1[2] = PKW(P0, 12), pw1[3] = PKW(P0, 14), pw1); \
    VRD(2); SBAR(); GAPA(C0 = __builtin_amdgcn_mfma_f32_32x32x16_bf16(kf[4], qr[2], C0, 0, 0, 0),   pw2[0] = PKW(P1, 0), pw2[1] = PKW(P1, 2), pw2); \
    OSUM(1); \
    VRD(6); SBAR(); GAPA(C1 = __builtin_amdgcn_mfma_f32_32x32x16_bf16(kf[5], qr[2], C1, 0, 0, 0),   pw2[2] = PKW(P1, 4), pw2[3] = PKW(P1, 6), pw2); \
    VRD(3); SBAR(); GAPA(C0 = __builtin_amdgcn_mfma_f32_32x32x16_bf16(kf[6], qr[3], C0, 0, 0, 0),   pw3[0] = PKW(P1, 8), pw3[1] = PKW(P1, 10), pw3); \
    OSUM(2); \
    VRD(7); SBAR(); GAPA(C1 = __builtin_amdgcn_mfma_f32_32x32x16_bf16(kf[7], qr[3], C1, 0, 0, 0),   pw3[2] = PKW(P1, 12), pw3[3] = PKW(P1, 14), pw3); \
    if (XV != 1) { if (GK) { DMA_K((t) + 3, sl_cur); } if (GV) { DMA_V((t) + 1, sl_next); } } \
    OSUM(3); \
    CMASK(C0, C1, t); \
    SBAR(); \
    GAPB(o[0] = __builtin_amdgcn_mfma_f32_32x32x16_bf16(PAF(0), VFR(0), o[0], 0, 0, 0), C0, 0); \
    GAPB(o[1] = __builtin_amdgcn_mfma_f32_32x32x16_bf16(PAF(0), VFR(4), o[1], 0, 0, 0), C0, 4); \
    KRD(GL, 0); GAPB(o[0] = __builtin_amdgcn_mfma_f32_32x32x16_bf16(PAF(1), VFR(1), o[0], 0, 0, 0), C0, 8); \
    KRD(GL, 1); GAPB(o[1] = __builtin_amdgcn_mfma_f32_32x32x16_bf16(PAF(1), VFR(5), o[1], 0, 0, 0), C0, 12); \
    KRD(GL, 2); GAPB(o[0] = __builtin_amdgcn_mfma_f32_32x32x16_bf16(PAF(2), VFR(2), o[0], 0, 0, 0), C1, 0); \
    KRD(GL, 3); GAPB(o[1] = __builtin_amdgcn_mfma_f32_32x32x16_bf16(PAF(2), VFR(6), o[1], 0, 0, 0), C1, 4); \
    GAPB(o[0] = __builtin_amdgcn_mfma_f32_32x32x16_bf16(PAF(3), VFR(3), o[0], 0, 0, 0), C1, 8); \
    GAPB(o[1] = __builtin_amdgcn_mfma_f32_32x32x16_bf16(PAF(3), VFR(7), o[1], 0, 0, 0), C1, 12); \
    } while (0)
  int t = 1;
  for (; t + 5 < NT; t += 2) {
    STEP(pB0, pB1, pA0, pA1, t, true, true, true);     WAIT_BAR(2); ROT();
    STEP(pA0, pA1, pB0, pB1, t + 1, true, true, true);   WAIT_BAR(2); ROT();
  }
  #define ENDW(tt) do { if ((tt) + 3 < NT) { WAIT_BAR(2); } else if ((tt) + 2 < NT) { WAIT_BAR(1); } else { WAIT_BAR(0); } } while (0)
  for (; t + 1 < NT; t += 2) {
    STEP(pB0, pB1, pA0, pA1, t, (t + 3 < NT), (t + 1 < NT), (t + 1 < NT));       ENDW(t);   ROT();
    STEP(pA0, pA1, pB0, pB1, t + 1, (t + 4 < NT), (t + 2 < NT), (t + 2 < NT));     ENDW(t + 1); ROT();
  }
  STEP(pB0, pB1, pA0, pA1, NT - 1, false, false, false);
  { pw0 = (u32x4){PKW(pB0, 0), PKW(pB0, 2), PKW(pB0, 4), PKW(pB0, 6)}; pw1 = (u32x4){PKW(pB0, 8), PKW(pB0, 10), PKW(pB0, 12), PKW(pB0, 14)}; pw2 = (u32x4){PKW(pB1, 0), PKW(pB1, 2), PKW(pB1, 4), PKW(pB1, 6)}; pw3 = (u32x4){PKW(pB1, 8), PKW(pB1, 10), PKW(pB1, 12), PKW(pB1, 14)};
    SBAR(); OSUM(0); OSUM(1); OSUM(2); OSUM(3); pv2(o, vq, sl_cur, PAF(0), PAF(1), PAF(2), PAF(3)); }
  #undef PKW
  #undef PAF
  #undef VFR
  #undef PIN
  #undef GAPA
  #undef OSUM
  #undef GAPB
  #undef EX
  #undef VRD
  #undef KRD
  #undef STEP
  #undef ENDW
  const float sterm = __builtin_amdgcn_exp2f(sink2);
  float rli[16];
  #pragma unroll
  for (int r = 0; r < 16; ++r) rli[r] = __builtin_amdgcn_rcpf(osum[r] + sterm);
  bf16* Ow = O + (qrow + wid * QBLK) * QP + qcol;
  { bf16* stg = (bf16*)(shm + LDS_OST) + wid * 2048;
    #pragma unroll
    for (int r = 0; r < 16; ++r) { const int orow = crow(r, hi);
      #pragma unroll
      for (int d0 = 0; d0 < 2; ++d0) stg[orow * 64 + d0 * 32 + r32] = __float2bfloat16(o[d0][r] * rli[r]); }
    asm volatile("s_waitcnt lgkmcnt(0)" ::: "memory");
    #pragma unroll
    for (int i = 0; i < 4; ++i) { const int row = i * 8 + (lane >> 3), ch = lane & 7; const u32x4 v = *(const u32x4*)(stg + row * 64 + ch * 8); ATTN_STORE16(Ow + (long)row * QP + ch * 8, v); } }
  asm volatile("s_waitcnt lgkmcnt(0)\n\ts_barrier" ::: "memory");
  #undef DMA_K
  #undef DMA_V
  #undef ROWOFF
  #undef CMASK
  #undef ROT
}
template <int MODE> __device__ __forceinline__ void attn_unit_sk(long qrow, long kvrow, int q0, int qcol, int kcol, int vcol, int NT, float sink2, float bound, const bf16* Q, const bf16* __restrict__ KVb, bf16* O, char* shm) {
  int tid_ = threadIdx.x; asm volatile("" : "+v"(tid_));
  const int tid = tid_, lane = tid & 63, r32 = lane & 31, hi = lane >> 5; const int wid = __builtin_amdgcn_readfirstlane(tid >> 6);
  const bf16* Qw = Q + (qrow + wid * QBLK) * QP + qcol;
  const char* kvt = (const char*)KVb + (size_t)(kvrow >> 6) * 65536 + wid * 1024 + lane * 16;
  constexpr int NSL = 4, LK = 0, LV = NSL * SLOTB, LOST = 2 * NSL * SLOTB + NW * 64 * 4;
  const unsigned lds0 = (unsigned)(uintptr_t)shm;
  const char* ksrc = kvt + kcol * 8192; const char* vsrc = kvt + vcol * 8192;
  const unsigned kdst = lds0 + LK + wid * 1024, vdst = lds0 + LV + wid * 1024;
  #define ROWOFF(t) ((long)(MODE == 1 ? ((t) + ((t) >= 4 ? ((q0 - 128) >> 6) : 0)) : (t)) * 65536)
  #define DMA_K(t, slot) glds16(ksrc + ROWOFF(t), (unsigned)__builtin_amdgcn_readfirstlane(kdst + (slot)))
  #define DMA_V(t, slot) glds16(vsrc + ROWOFF(t), (unsigned)__builtin_amdgcn_readfirstlane(vdst + (slot)))
  const char* Kbase = shm + LK; bf16x8 kf[8];
  const lds_cptr shm3 = (lds_cptr)shm; const lds_cptr kp0 = shm3 + LK + hi * 1024 + r32 * 16; lds_cptr vq[4];
  { const int swz = (r32 >> 1) & 7; _Pragma("unroll") for (int ks_ = 0; ks_ < 4; ++ks_) vq[ks_] = shm3 + LV + r32 * 128 + (((2 * ks_ + hi) ^ swz) * 16); }
  DMA_K(0, 0); DMA_V(0, 0); DMA_K(1, SLOTB);
  bf16x8 qr[4];
  #pragma unroll
  for (int d0 = 0; d0 < 4; ++d0) qr[d0] = *reinterpret_cast<const bf16x8*>(&Qw[(long)r32 * QP + d0 * 16 + hi * 8]);
  f32x16 o[2]; o[0] = f32x16{}; o[1] = f32x16{}; f32x16 osum = f32x16{};
  const f32x16 negm = f32x16{};
  bf16x8 ones;
  #pragma unroll
  for (int i = 0; i < 8; ++i) ones[i] = (short)0x3F80;
  asm volatile("" : "+v"(ones));
  const int qrel = wid * QBLK + r32;
  int mlo = -128, mhi = 128;
  if (MODE == 1) { const int qi = q0 + qrel; mlo = (-qi > -128) ? -qi : -128; mhi = (SEQ - 1 - qi < 128) ? (SEQ - 1 - qi) : 128; }
  const unsigned mspan = (unsigned)(mhi - mlo);
  #define CMASK(P0, P1, t) do { if (MODE == 1) { if ((t) >= 4) bandmask(P0, P1, (t), mlo, mspan, qrel, hi); } } while (0)
  f32x16 pA0, pA1, pB0, pB1;
  int sl_prev = 0, sl_cur = 0, sl_next = SLOTB;
  #define ROT() do { sl_prev = sl_cur; sl_cur = sl_next; sl_next = (sl_next == (NSL - 1) * SLOTB) ? 0 : sl_next + SLOTB; } while (0)
  DMA_K(2, 2 * SLOTB);
  WAIT_BAR(3);
  qkt(pA0, pA1, Kbase, qr, negm, r32, hi); asm volatile("s_nop 15\n\ts_nop 7" : "+v"(pA0), "+v"(pA1)); CMASK(pA0, pA1, 0);
  _Pragma("unroll") for (int r = 0; r < 16; ++r) { pA0[r] = __builtin_amdgcn_exp2f(pA0[r]); pA1[r] = __builtin_amdgcn_exp2f(pA1[r]); }
  WAIT_BAR(0);
  DMA_V(1, SLOTB); DMA_K(3, 3 * SLOTB); DMA_V(2, 2 * SLOTB); if (4 < NT) { DMA_K(4, 0); }
  ROT();
  kload8(kf, kp0 + sl_cur);
  WAIT_BAR(4);
  if (wid >= 4) asm volatile("s_barrier" ::: "memory");
  bf16x8 vfr[8]; u32x4 pw0, pw1, pw2, pw3;
  #define PKW(P, B) cvtpk_s(P[B], P[B + 1])
  #define PAF(k) __builtin_bit_cast(bf16x8, pw##k)
  #define VFR(i) vfr[i]
  #define PIN(x) asm volatile("" : "+v"(x))
  #define GAPA(MF, W0, W1, PW) do { MF; W0; W1; PIN(PW); SBAR(); } while (0)
  #define OSUM(k) do { osum = __builtin_amdgcn_mfma_f32_32x32x16_bf16(PAF(k), ones, osum, 0, 0, 0); SBAR(); } while (0)
  #define EX(v) (FASTEXP ? exp2_fast(v) : __builtin_amdgcn_exp2f(v))
  #define GAPB(MF, X, B) do { MF; X[B] = EX(X[B]); X[B + 1] = EX(X[B + 1]); X[B + 2] = EX(X[B + 2]); X[B + 3] = EX(X[B + 3]); PIN(X); SBAR(); } while (0)
  #define VRD(i) do { vfr[i] = *(const LAS bf16x8*)(vq[(i) & 3] + vsl_ + ((i) >> 2) * 4096); } while (0)
  #define KRD(G, j) do { if (G) { kload2(kf, kp0 + sl_next, j); SBAR(); } } while (0)
  #define STEP(C0, C1, P0, P1, t, GK, GV, GL, WMID) do { SBAR(); \
    const int vsl_ = sl_prev; \
    VRD(0); SBAR(); GAPA(C0 = __builtin_amdgcn_mfma_f32_32x32x16_bf16(kf[0], qr[0], negm, 0, 0, 0), pw0[0] = PKW(P0, 0), pw0[1] = PKW(P0, 2), pw0); \
    VRD(4); SBAR(); GAPA(C1 = __builtin_amdgcn_mfma_f32_32x32x16_bf16(kf[1], qr[0], negm, 0, 0, 0), pw0[2] = PKW(P0, 4), pw0[3] = PKW(P0, 6), pw0); \
    VRD(1); SBAR(); GAPA(C0 = __builtin_amdgcn_mfma_f32_32x32x16_bf16(kf[2], qr[1], C0, 0, 0, 0),   pw1[0] = PKW(P0, 8), pw1[1] = PKW(P0, 10), pw1); \
    OSUM(0); \
    VRD(5); SBAR(); GAPA(C1 = __builtin_amdgcn_mfma_f32_32x32x16_bf16(kf[3], qr[1], C1, 0, 0, 0),   pw1[2] = PKW(P0, 12), pw1[3] = PKW(P0, 14), pw1); \
    VRD(2); SBAR(); GAPA(C0 = __builtin_amdgcn_mfma_f32_32x32x16_bf16(kf[4], qr[2], C0, 0, 0, 0),   pw2[0] = PKW(P1, 0), pw2[1] = PKW(P1, 2), pw2); \
    OSUM(1); \
    VRD(6); SBAR(); GAPA(C1 = __builtin_amdgcn_mfma_f32_32x32x16_bf16(kf[5], qr[2], C1, 0, 0, 0),   pw2[2] = PKW(P1, 4), pw2[3] = PKW(P1, 6), pw2); \
    VRD(3); SBAR(); GAPA(C0 = __builtin_amdgcn_mfma_f32_32x32x16_bf16(kf[6], qr[3], C0, 0, 0, 0),   pw3[0] = PKW(P1, 8), pw3[1] = PKW(P1, 10), pw3); \
    OSUM(2); \
    VRD(7); SBAR(); GAPA(C1 = __builtin_amdgcn_mfma_f32_32x32x16_bf16(kf[7], qr[3], C1, 0, 0, 0),   pw3[2] = PKW(P1, 12), pw3[3] = PKW(P1, 14), pw3); \
    OSUM(3); \
    CMASK(C0, C1, t); \
    SBAR(); \
    WMID; \
    if (GV) { DMA_V((t) + 2, (sl_next == (NSL - 1) * SLOTB) ? 0 : sl_next + SLOTB); } if (GK) { DMA_K((t) + 4, sl_cur); } \
    SBAR(); \
    GAPB(o[0] = __builtin_amdgcn_mfma_f32_32x32x16_bf16(PAF(0), VFR(0), o[0], 0, 0, 0), C0, 0); \
    GAPB(o[1] = __builtin_amdgcn_mfma_f32_32x32x16_bf16(PAF(0), VFR(4), o[1], 0, 0, 0), C0, 4); \
    KRD(GL, 0); GAPB(o[0] = __builtin_amdgcn_mfma_f32_32x32x16_bf16(PAF(1), VFR(1), o[0], 0, 0, 0), C0, 8); \
    KRD(GL, 1); GAPB(o[1] = __builtin_amdgcn_mfma_f32_32x32x16_bf16(PAF(1), VFR(5), o[1], 0, 0, 0), C0, 12); \
    KRD(GL, 2); GAPB(o[0] = __builtin_amdgcn_mfma_f32_32x32x16_bf16(PAF(2), VFR(2), o[0], 0, 0, 0), C1, 0); \
    KRD(GL, 3); GAPB(o[1] = __builtin_amdgcn_mfma_f32_32x32x16_bf16(PAF(2), VFR(6), o[1], 0, 0, 0), C1, 4); \
    GAPB(o[0] = __builtin_amdgcn_mfma_f32_32x32x16_bf16(PAF(3), VFR(3), o[0], 0, 0, 0), C1, 8); \
    GAPB(o[1] = __builtin_amdgcn_mfma_f32_32x32x16_bf16(PAF(3), VFR(7), o[1], 0, 0, 0), C1, 12); \
    } while (0)
  int t = 1;
  for (; t + 5 < NT; t += 2) {
    STEP(pB0, pB1, pA0, pA1, t, true, true, true, WAIT_BAR(3));     WAIT_BAR(4); ROT();
    STEP(pA0, pA1, pB0, pB1, t + 1, true, true, true, WAIT_BAR(3));   WAIT_BAR(4); ROT();
  }
  for (; t + 1 < NT; t += 2) {
    STEP(pB0, pB1, pA0, pA1, t, (t + 4 < NT), (t + 2 < NT), (t + 1 < NT), WAIT_BAR(0));       WAIT_BAR(0); ROT();
    STEP(pA0, pA1, pB0, pB1, t + 1, (t + 5 < NT), (t + 3 < NT), (t + 2 < NT), WAIT_BAR(0));     WAIT_BAR(0); ROT();
  }
  STEP(pB0, pB1, pA0, pA1, NT - 1, false, false, false, WAIT_BAR(0));
  if (wid < 4) { WAIT_BAR(0); }
  { pw0 = (u32x4){PKW(pB0, 0), PKW(pB0, 2), PKW(pB0, 4), PKW(pB0, 6)}; pw1 = (u32x4){PKW(pB0, 8), PKW(pB0, 10), PKW(pB0, 12), PKW(pB0, 14)}; pw2 = (u32x4){PKW(pB1, 0), PKW(pB1, 2), PKW(pB1, 4), PKW(pB1, 6)}; pw3 = (u32x4){PKW(pB1, 8), PKW(pB1, 10), PKW(pB1, 12), PKW(pB1, 14)};
    SBAR(); OSUM(0); OSUM(1); OSUM(2); OSUM(3); pv2(o, vq, sl_cur, PAF(0), PAF(1), PAF(2), PAF(3)); }
  #undef PKW
  #undef PAF
  #undef VFR
  #undef PIN
  #undef GAPA
  #undef OSUM
  #undef GAPB
  #undef EX
  #undef VRD
  #undef KRD
  #undef STEP
  const float sterm = __builtin_amdgcn_exp2f(sink2);
  float rli[16];
  #pragma unroll
  for (int r = 0; r < 16; ++r) rli[r] = __builtin_amdgcn_rcpf(osum[r] + sterm);
  bf16* Ow = O + (qrow + wid * QBLK) * QP + qcol;
  { bf16* stg = (bf16*)(shm + LOST) + wid * 2048;
    #pragma unroll
    for (int r = 0; r < 16; ++r) { const int orow = crow(r, hi);
      #pragma unroll
      for (int d0 = 0; d0 < 2; ++d0) stg[orow * 64 + d0 * 32 + r32] = __float2bfloat16(o[d0][r] * rli[r]); }
    asm volatile("s_waitcnt lgkmcnt(0)" ::: "memory");
    #pragma unroll
    for (int i = 0; i < 4; ++i) { const int row = i * 8 + (lane >> 3), ch = lane & 7; const u32x4 v = *(const u32x4*)(stg + row * 64 + ch * 8); ATTN_STORE16(Ow + (long)row * QP + ch * 8, v); } }
  asm volatile("s_waitcnt lgkmcnt(0)\n\ts_barrier" ::: "memory");
  #undef DMA_K
  #undef DMA_V
  #undef ROWOFF
  #undef CMASK
  #undef ROT
}
constexpr int ATTN_LDS_BYTES = LDS_BYTES;
#undef SBAR
#undef WAIT_BAR
}

struct Args { const float* in[20]; float* out; unsigned char* ws; int ph_lo, ph_hi; };
typedef const Args __attribute__((address_space(4)))* kargp_t;
__device__ __forceinline__ kargp_t kargs() { auto p = __builtin_amdgcn_kernarg_segment_ptr(); asm volatile("" : "+s"(p)); return (kargp_t)p; }
enum { I_X = 0, I_C, I_CTX, I_CCTX, I_ADAW, I_ADAB, I_GATTN, I_GFFN, I_WIN, I_QNG, I_KNG, I_QNL, I_KNL, I_SINK, I_WOUT, I_RW, I_RB, I_WGATE, I_WUP, I_WDOWN };
struct Frame {
    LAS unsigned char* lds; volatile LAS unsigned* MISC;
    int tid, lane, wave, vcu, G;
};
#define WSP(T, off) ((T*)(kargs()->ws + (off)))
__device__ const float ROPE_INV[16] = {1.000000000e+00f, 5.623413324e-01f, 3.162277639e-01f, 1.778279394e-01f, 1.000000015e-01f, 5.623413250e-02f, 3.162277490e-02f, 1.778279431e-02f,
                                       9.999999776e-03f, 5.623413250e-03f, 3.162277630e-03f, 1.778279431e-03f, 1.000000047e-03f, 5.623413017e-04f, 3.162277571e-04f, 1.778279402e-04f};

template <int KIND> __device__ __forceinline__ int dst_row(int n) {
    if (KIND == 0) return n;
    if (KIND == 2) return ((n >> 7) << 8) + (n & 127);
    if (KIND == 3) return ((n >> 7) << 8) + 128 + (n & 127);
    int tile, wc;
    if (n < 512) { const int h = n >> 6; tile = h >> 2; wc = h & 3; }
    else if (n < 640) { tile = 4; wc = (n - 512) >> 6; }
    else if (n < 768) { tile = 4; wc = 2 + ((n - 640) >> 6); }
    else if (n < 1280) { const int h = (n - 768) >> 6; tile = 2 + (h >> 2); wc = h & 3; }
    else if (n < 1408) { tile = 5; wc = (n - 1280) >> 6; }
    else { tile = 5; wc = 2 + ((n - 1408) >> 6); }
    const int d = n & 63, bj = d >> 5, dd = d & 31, np = dd >> 4, f = dd & 15, fq = f >> 2, j = f & 3;
    return 256 * tile + 128 * bj + 32 * wc + 8 * fq + 4 * np + j;
}
template <int KIND> __device__ __forceinline__ void p0_transpose_item(const float* W, int N, bf16_t* WT, int Kd, LAS float* scr, int kb, int nb, int lane) {
    const int k0 = 64 * kb, n0 = 32 * nb;
#pragma unroll 8
    for (int i = 0; i < 32; ++i) { const int kk = 2 * i + (lane >> 5); scr[kk * 33 + (lane & 31)] = W[(size_t)(k0 + kk) * N + n0 + (lane & 31)]; }
    LDS_WAIT(); asm volatile("" ::: "memory");
    const int c = lane & 7;
#pragma unroll
    for (int j = 0; j < 4; ++j) { const int n = (lane >> 3) + 8 * j; const LAS float* s = scr + (8 * c) * 33 + n;
        u32x4 o; o.x = pk2(s[0 * 33], s[1 * 33]); o.y = pk2(s[2 * 33], s[3 * 33]); o.z = pk2(s[4 * 33], s[5 * 33]); o.w = pk2(s[6 * 33], s[7 * 33]);
        *(GAS u32x4*)(WT + (size_t)dst_row<KIND>(n0 + n) * Kd + k0 + 8 * c) = o; }
    LDS_WAIT(); asm volatile("" ::: "memory");
}
__device__ __forceinline__ void sincos_d(float ang, float& cs, float& sn) {
    const double x = (double)ang; const double kq = __builtin_rint(x * 0.63661977236758134308);
    const double r = (x - kq * 1.5707963267948966192) - kq * 6.123233995736766036e-17, r2 = r * r;
    const double s = r * (1.0 + r2 * (-1.0 / 6 + r2 * (1.0 / 120 + r2 * (-1.0 / 5040 + r2 * (1.0 / 362880 + r2 * (-1.0 / 39916800 + r2 * (1.0 / 6227020800.0)))))));
    const double c = 1.0 + r2 * (-0.5 + r2 * (1.0 / 24 + r2 * (-1.0 / 720 + r2 * (1.0 / 40320 + r2 * (-1.0 / 3628800 + r2 * (1.0 / 479001600.0 + r2 * (-1.0 / 87178291200.0)))))));
    const int q = ((int)kq) & 3;
    const double cc = (q == 0) ? c : (q == 1) ? -s : (q == 2) ? -c : s;
    const double ss = (q == 0) ? s : (q == 1) ? c : (q == 2) ? -s : -c;
    cs = (float)cc; sn = (float)ss;
}
__device__ __forceinline__ void p0_prologue(Frame& F) {
    const int gw = F.vcu * NWAVES + F.wave, NGW = F.G * NWAVES;
    {
        const float* c = kargs()->in[I_C]; const float* cctx = kargs()->in[I_CCTX]; const float* ada_w = kargs()->in[I_ADAW]; const float* ada_b = kargs()->in[I_ADAB];
        float* modv = WSP(float, WS_MODV);
        LAS float* sv = (LAS float*)(F.lds);
        LAS float* part = (LAS float*)(F.lds + 16384);
        for (int i = F.tid; i < 3072; i += NWAVES * 64) { const int v = i >> 10, k = i & 1023; const float cv = v < 2 ? c[v * 1024 + k] : cctx[k]; sv[i] = cv / (1.0f + expf(-cv)); }
        __syncthreads();
        for (int tile = F.vcu; tile < NLAYER * 96; tile += F.G) {
            const int l = tile / 96, c0 = (tile % 96) * 64;
            const float* W = ada_w + (size_t)l * 1024 * 6144 + c0 + F.lane;
            float a0 = 0.f, a1 = 0.f, a2 = 0.f; const int kb = F.wave * 128;
#pragma unroll 8
            for (int k = 0; k < 128; ++k) { const float w = W[(size_t)(kb + k) * 6144]; a0 += sv[kb + k] * w; a1 += sv[1024 + kb + k] * w; a2 += sv[2048 + kb + k] * w; }
            part[(F.wave * 3 + 0) * 64 + F.lane] = a0; part[(F.wave * 3 + 1) * 64 + F.lane] = a1; part[(F.wave * 3 + 2) * 64 + F.lane] = a2;
            __syncthreads();
            if (F.tid < 192) { const int v = F.tid >> 6, col = F.tid & 63; float s = ada_b[l * 6144 + c0 + col];
#pragma unroll
                for (int w = 0; w < 8; ++w) s += part[(w * 3 + v) * 64 + col];
                modv[(size_t)(l * 3 + v) * 6144 + c0 + col] = s; }
            __syncthreads();
        }
    }
    { float* rope = WSP(float, WS_ROPE); const int gt = F.vcu * NWAVES * 64 + F.tid; if (gt < 4096) { const int pos = gt >> 4, f = gt & 15; const float ang = (float)pos * ROPE_INV[f]; float cs, sn; sincos_d(ang, cs, sn); rope[gt * 2] = cs; rope[gt * 2 + 1] = sn; } }
    { const int gt = F.vcu * NWAVES * 64 + F.tid; if (gt < NLAYER * 256) { const int l = gt >> 8, kq = (gt >> 6) & 3, d = gt & 63; const float* src = kargs()->in[kq == 0 ? I_QNG : (kq == 1 ? I_QNL : (kq == 2 ? I_KNG : I_KNL))]; WSP(float, WS_GN)[gt] = src[l * 64 + d]; } }
    if (gw < NLAYER * 2) { const int l = gw >> 1, loc = gw & 1; float mq = fabsf(kargs()->in[loc ? I_QNL : I_QNG][l * 64 + F.lane]), mk = fabsf(kargs()->in[loc ? I_KNL : I_KNG][l * 64 + F.lane]);
#pragma unroll
        for (int o = 1; o < 64; o <<= 1) { mq = fmaxf(mq, __shfl_xor(mq, o)); mk = fmaxf(mk, __shfl_xor(mk, o)); }
        if (F.lane == 0) WSP(float, WS_BND)[gw] = 64.0f * C2 * mq * mk * 1.02f + 0.05f; }
    { u32x4* p = (u32x4*)(WSP(bf16_t, WS_KV) + (size_t)NROW * 512); for (int i = F.vcu * NWAVES * 64 + F.tid; i < 256 * 512 * 2 / 16; i += F.G * NWAVES * 64) p[i] = (u32x4){0u, 0u, 0u, 0u}; }
    {
        const float* x = kargs()->in[I_X]; const float* ctx = kargs()->in[I_CTX]; bf16_t* XS = WSP(bf16_t, WS_XS);
        for (int R = gw; R < NROW; R += NGW) {
            const int b = R >= RB ? 1 : 0, rr = R - b * RB;
            const float* src = rr < NCTX ? ctx + (size_t)(b * NCTX + rr) * 1024 : x + (size_t)(b * SEQ + rr - NCTX) * 1024;
            const f32x4* s4 = (const f32x4*)src + F.lane; u32x2* d2 = (u32x2*)(XS + (size_t)R * 1024) + F.lane;
            f32x4 v[4];
#pragma unroll
            for (int j = 0; j < 4; ++j) v[j] = s4[64 * j];
#pragma unroll
            for (int j = 0; j < 4; ++j) { u32x2 w; w.x = pk2(v[j][0], v[j][1]); w.y = pk2(v[j][2], v[j][3]); d2[64 * j] = w; }
        }
    }
    {
        LAS float* scr = (LAS float*)(F.lds + RING_OFF + F.wave * 16384);
        constexpr int I_IN = 4 * 768, I_OUT = 4 * 512, I_G = 64 * 256, I_U = 64 * 256, I_D = 64 * 256;
        for (int it0 = gw; it0 < I_IN + I_OUT + I_G + I_U + I_D; it0 += NGW) {
            int it = it0;
            if (it < I_IN) { const int l = it / 768, r = it % 768; p0_transpose_item<1>(kargs()->in[I_WIN] + (size_t)l * 1024 * 1536, 1536, WSP(bf16_t, WS_WIN) + (size_t)l * 1536 * 1024, 1024, scr, r / 48, r % 48, F.lane); continue; } it -= I_IN;
            if (it < I_OUT) { const int l = it / 512, r = it % 512; p0_transpose_item<0>(kargs()->in[I_WOUT] + (size_t)l * 1024 * 1024, 1024, WSP(bf16_t, WS_WOUT) + (size_t)l * 1024 * 1024, 1024, scr, r / 32, r % 32, F.lane); continue; } it -= I_OUT;
            if (it < I_G) { const int m = it / 256, r = it % 256; p0_transpose_item<2>(kargs()->in[I_WGATE] + (size_t)m * 1024 * 512, 512, WSP(bf16_t, WS_WGU) + (size_t)m * 1024 * 1024, 1024, scr, r / 16, r % 16, F.lane); continue; } it -= I_G;
            if (it < I_U) { const int m = it / 256, r = it % 256; p0_transpose_item<3>(kargs()->in[I_WUP] + (size_t)m * 1024 * 512, 512, WSP(bf16_t, WS_WGU) + (size_t)m * 1024 * 1024, 1024, scr, r / 16, r % 16, F.lane); continue; } it -= I_U;
            { const int m = it / 256, r = it % 256; p0_transpose_item<0>(kargs()->in[I_WDOWN] + (size_t)m * 512 * 1024, 1024, WSP(bf16_t, WS_WD) + (size_t)m * 1024 * 512, 512, scr, r / 32, r % 32, F.lane); }
        }
    }
}

__device__ __forceinline__ void load_row(const bf16_t* xrow, int lane, f32x4 (&h)[4]) {
    const u32x2* xr = (const u32x2*)xrow + lane;
#pragma unroll
    for (int j = 0; j < 4; ++j) { const u32x2 w = xr[64 * j]; h[j] = (f32x4){__builtin_bit_cast(float, w.x << 16), __builtin_bit_cast(float, w.x & 0xffff0000u), __builtin_bit_cast(float, w.y << 16), __builtin_bit_cast(float, w.y & 0xffff0000u)}; }
}
__device__ __forceinline__ void rms_mod(const float* g, const float* sh, const float* sc, int lane, f32x4 (&h)[4]) {
    float ss = 0.f;
#pragma unroll
    for (int j = 0; j < 4; ++j) ss += (h[j][0] * h[j][0] + h[j][1] * h[j][1]) + (h[j][2] * h[j][2] + h[j][3] * h[j][3]);
    const float rs = 1.0f / sqrtf(wave_sum(ss) * (1.0f / 1024.0f) + NORM_EPS);
#pragma unroll
    for (int j = 0; j < 4; ++j) { const f32x4 gg = ((const f32x4*)g)[lane + 64 * j], s1 = ((const f32x4*)sh)[lane + 64 * j], s2 = ((const f32x4*)sc)[lane + 64 * j];
        h[j] = (h[j] * rs * gg) * (1.0f + s2) + s1; }
}
__device__ __forceinline__ void store_row_bf16(bf16_t* orow, int lane, const f32x4 (&h)[4]) {
    u32x2* o8 = (u32x2*)orow + lane;
#pragma unroll
    for (int j = 0; j < 4; ++j) { u32x2 w; w.x = pk2(h[j][0], h[j][1]); w.y = pk2(h[j][2], h[j][3]); o8[64 * j] = w; }
}
__device__ __forceinline__ int row_mv(int R) { const int b = R >= RB ? 1 : 0; return (R - b * RB) < NCTX ? 2 : b; }

__device__ __forceinline__ void phase_norm1(Frame& F0, int l) {
    Frame F = F0; asm volatile("" : "+v"(F.tid), "+v"(F.lane), "+s"(F.wave), "+s"(F.vcu));
    const int gw = F.vcu * NWAVES + F.wave, NGW = F.G * NWAVES;
    const float* g = kargs()->in[I_GATTN] + l * 1024; const float* modv = WSP(float, WS_MODV); const bf16_t* XS = WSP(bf16_t, WS_XS); bf16_t* HN = WSP(bf16_t, WS_HN);
    f32x4 xn[4]; if (gw < NROW) load_row(XS + (size_t)gw * 1024, F.lane, xn);
    for (int R = gw; R < NROW; R += NGW) {
        const float* mv = modv + (size_t)(l * 3 + row_mv(R)) * 6144;
        f32x4 h[4];
#pragma unroll
        for (int j = 0; j < 4; ++j) h[j] = xn[j];
        if (R + NGW < NROW) load_row(XS + (size_t)(R + NGW) * 1024, F.lane, xn);
        rms_mod(g, mv + 0, mv + 1024, F.lane, h);
        store_row_bf16(HN + (size_t)R * 1024, F.lane, h);
    }
}
__device__ __forceinline__ void phase_norm2_router(Frame& F0, int l, bool lastl, bool dry = false) {
    Frame F = F0; asm volatile("" : "+v"(F.tid), "+v"(F.lane), "+s"(F.wave), "+s"(F.vcu));
    const int gw = F.vcu * NWAVES + F.wave, NGW = F.G * NWAVES;
    LAS f32x4* RW = (LAS f32x4*)(F.lds + RING_OFF);
    { const float* router_w = kargs()->in[I_RW];
      for (int idx = F.tid; idx < 4096; idx += NWAVES * 64) { const int j = idx >> 10, e = (idx >> 6) & 15, ln = idx & 63, c = 4 * ln + 256 * j;
        RW[idx] = (f32x4){router_w[(c + 0) * 16 + e], router_w[(c + 1) * 16 + e], router_w[(c + 2) * 16 + e], router_w[(c + 3) * 16 + e]}; } }
    __syncthreads();
    const float* g = kargs()->in[I_GFFN] + l * 1024; const float* router_b = kargs()->in[I_RB];
    LAS float* PS = (LAS float*)(F.lds + RING_OFF + 65536) + F.wave * (16 * 65);
    const float* modv = WSP(float, WS_MODV); const bf16_t* XS = WSP(bf16_t, WS_XS); bf16_t* HN = WSP(bf16_t, WS_HN);
    int my_cls = -1, my_tok = 0; float my_wlo = 0.f, my_whi = 0.f;
    int k = 0;
    f32x4 xn[4]; if (gw < NROW) load_row(XS + (size_t)gw * 1024, F.lane, xn);
    for (int R = gw; R < NROW; R += NGW, ++k) {
        const int mvi = row_mv(R);
        f32x4 h[4];
#pragma unroll
        for (int j = 0; j < 4; ++j) h[j] = xn[j];
        if (R + NGW < NROW) load_row(XS + (size_t)(R + NGW) * 1024, F.lane, xn);
        if (lastl && mvi == 2) continue;
        const float* mv = modv + (size_t)(l * 3 + mvi) * 6144;
        rms_mod(g, mv + 3072, mv + 4096, F.lane, h);
        store_row_bf16(HN + (size_t)R * 1024, F.lane, h);
        {
            float s[16];
#pragma unroll
            for (int e = 0; e < 16; ++e) s[e] = 0.f;
#pragma unroll
            for (int j = 0; j < 4; ++j)
#pragma unroll
                for (int e = 0; e < 16; ++e) { const f32x4 w4 = RW[(j * 16 + e) * 64 + F.lane]; s[e] += (h[j][0] * w4[0] + h[j][1] * w4[1]) + (h[j][2] * w4[2] + h[j][3] * w4[3]); }
#pragma unroll
            for (int e = 0; e < 16; ++e) PS[e * 65 + F.lane] = s[e];
        }
        float tl = 0.f;
        { const LAS float* pr = PS + (F.lane & 15) * 65 + (F.lane >> 4) * 16;
#pragma unroll
          for (int i = 0; i < 16; ++i) tl += pr[i]; }
        tl += __shfl_xor(tl, 16); tl += __shfl_xor(tl, 32);
        const float my_sc = 1.0f / (1.0f + expf(-tl)), my_sel = my_sc + router_b[F.lane & 15];
        float sc[16], sel[16];
#pragma unroll
        for (int e = 0; e < 16; ++e) { sc[e] = __builtin_bit_cast(float, __builtin_amdgcn_readlane(__builtin_bit_cast(int, my_sc), e)); sel[e] = __builtin_bit_cast(float, __builtin_amdgcn_readlane(__builtin_bit_cast(int, my_sel), e)); }
        float gs[4];
#pragma unroll
        for (int gq = 0; gq < 4; ++gq) { const float a = sel[4 * gq], b = sel[4 * gq + 1], c = sel[4 * gq + 2], d = sel[4 * gq + 3];
            const float h1 = fmaxf(a, b), l1 = fminf(a, b), h2 = fmaxf(c, d), l2 = fminf(c, d);
            gs[gq] = fmaxf(h1, h2) + fmaxf(fminf(h1, h2), fmaxf(l1, l2)); }
        int gi = 0; float bg = gs[0];
#pragma unroll
        for (int gq = 1; gq < 4; ++gq) if (gs[gq] > bg) { bg = gs[gq]; gi = gq; }
        float s4[4], c4[4];
#pragma unroll
        for (int q = 0; q < 4; ++q) { s4[q] = sel[q]; c4[q] = sc[q]; }
#pragma unroll
        for (int gq = 1; gq < 4; ++gq)
#pragma unroll
            for (int q = 0; q < 4; ++q) { s4[q] = (gi == gq) ? sel[4 * gq + q] : s4[q]; c4[q] = (gi == gq) ? sc[4 * gq + q] : c4[q]; }
        int i1 = 0; float b1 = s4[0], w1 = c4[0];
#pragma unroll
        for (int q = 1; q < 4; ++q) if (s4[q] > b1) { b1 = s4[q]; i1 = q; w1 = c4[q]; }
        int i2 = -1; float b2 = -INFINITY, w2 = 0.f;
#pragma unroll
        for (int q = 0; q < 4; ++q) if (q != i1 && (i2 < 0 || s4[q] > b2)) { b2 = s4[q]; i2 = q; w2 = c4[q]; }
        const float wsum = w1 + w2; w1 = w1 / wsum; w2 = w2 / wsum;
        const int ia = i1 < i2 ? i1 : i2, ib = i1 < i2 ? i2 : i1;
        const float wlo = i1 < i2 ? w1 : w2, whi = i1 < i2 ? w2 : w1;
        const int pidx = ia == 0 ? ib - 1 : (ia == 1 ? ib + 1 : 5);
        if (F.lane == k) { my_cls = gi * 6 + pidx; my_tok = R; my_wlo = wlo; my_whi = whi; }
    }
    if (my_cls >= 0 && !dry) {
        const unsigned pos = __hip_atomic_fetch_add(WSP(unsigned, WS_CTL) + CW_CNT + (l * NCLS + my_cls) * 64, 1u, RLX_AGENT);
        WSP(int, WS_TOK)[(size_t)my_cls * CAP + pos] = my_tok; WSP(f32x2, WS_WTS)[(size_t)my_cls * CAP + pos] = (f32x2){my_wlo, my_whi};
    }
    __syncthreads();
}
__device__ __forceinline__ int moe_tables(Frame& F0, int l) {
    Frame F = F0; asm volatile("" : "+v"(F.tid));
    LAS int* s_n = (LAS int*)(F.lds + MOE_OFF); LAS int* s_ts = s_n + 32;
    __syncthreads();
    if (F.tid < NCLS) s_n[F.tid] = (int)__hip_atomic_load(WSP(unsigned, WS_CTL) + CW_CNT + (l * NCLS + F.tid) * 64, RLX_AGENT);
    __syncthreads();
    if (F.tid == 0) { int acc = 0; for (int c = 0; c < NCLS; ++c) { s_ts[c] = acc; acc += (s_n[c] + 255) >> 8; } s_ts[NCLS] = acc; }
    __syncthreads();
    return s_ts[NCLS];
}

constexpr int NPHASE = 1 + 7 * NLAYER;
__global__ void __launch_bounds__(NWAVES * 64, 2) fwd_kernel(Args args) {
    extern __shared__ __attribute__((aligned(16))) unsigned char lds[];
    Frame F;
    F.lds = (LAS unsigned char*)lds; F.MISC = (volatile LAS unsigned*)(F.lds + MISC_OFF);
    F.tid = threadIdx.x; F.lane = F.tid & 63; F.wave = __builtin_amdgcn_readfirstlane(F.tid >> 6);
    F.G = gridDim.x; { const int bx = blockIdx.x; F.vcu = (F.G % 8 == 0) ? (bx % 8) * (F.G / 8) + bx / 8 : bx; }
    for (int u = F.tid; u < (LDS_BYTES - LDSCTL_OFF) / 4; u += NWAVES * 64) ((LAS unsigned*)(F.lds + LDSCTL_OFF))[u] = 0u;
    __syncthreads();
    const int lo = args.ph_lo, hi = args.ph_hi;
    XcdBarrier bar; bar.bar = WSP(unsigned, WS_CTL) + CW_BAR; bar.x = 0; bar.st = nullptr;
    if (hi - lo > 1) bar = xcd_barrier_post(WSP(unsigned, WS_CTL) + CW_BAR, F.MISC + 8);
#ifndef MK_EN
#define MK_EN 0xff
#endif
#define EN(k) (((MK_EN) >> (k)) & 1)
#ifndef REP_P0
#define REP_P0 1
#endif
#ifndef REP_A
#define REP_A 1
#endif
#ifndef REP_B
#define REP_B 1
#endif
#ifndef REP_C
#define REP_C 1
#endif
#ifndef REP_F
#define REP_F 1
#endif
#ifndef REP_D
#define REP_D 1
#endif
#ifndef REP_E
#define REP_E 1
#endif
#ifndef REP_G
#define REP_G 1
#endif
#define RUN(p) (lo <= (p) && (p) < hi)
#ifndef REP_BAR
#define REP_BAR 1
#endif
#define SEAM(p) do { if (RUN(p) && RUN((p) + 1)) { xcd_barrier(bar); if (REP_BAR > 1) xcd_barrier(bar); if (REP_BAR > 2) xcd_barrier(bar); } } while (0)

    if (EN(7) && RUN(0)) { for (int rep = 0; rep < REP_P0; ++rep) { p0_prologue(F); if (rep + 1 < REP_P0) xcd_barrier(bar); } SEAM(0); }

    for (int l = 0; l < NLAYER; ++l) {
        const int pb = 1 + 7 * l; const bool lastl = (l == NLAYER - 1);
        if (EN(0) && RUN(pb + 0)) { for (int rep = 0; rep < REP_A; ++rep) { phase_norm1(F, l); if (rep + 1 < REP_A) xcd_barrier(bar); } SEAM(pb + 0); }
        if (EN(1) && RUN(pb + 1)) {
            pg8::ProbDense P; P.A = WSP(const char, WS_HN); P.B = (const char*)(WSP(bf16_t, WS_WIN) + (size_t)l * 1536 * 1024); P.lda = 1024; P.ldb = 1024; P.nt = 16; P.skip_ctx = false; P.S.init(NROW, 1536, F.G, (int)blockIdx.x);
            pg8::EpiQKV E{kargs()->ws, WSP(float, WS_GN) + l * 256, WSP(float, WS_ROPE)};
            for (int rep = 0; rep < REP_B; ++rep) { pg8::gemm_phase<pg8::EpiQKV, pg8::ProbDense, true>(F.lds + RING_OFF, F.lds + OFFS_OFF, P, E); if (rep + 1 < REP_B) xcd_barrier(bar); }
            SEAM(pb + 1);
        }
        if (EN(2) && RUN(pb + 2)) {
            const attn_body::bf16* Q = WSP(const attn_body::bf16, WS_QO); const attn_body::bf16* KVb = WSP(const attn_body::bf16, WS_KV); attn_body::bf16* O = WSP(attn_body::bf16, WS_HN);
            const float* sink = kargs()->in[I_SINK] + l * 8;
            const int n0 = 1024 + (lastl ? 0 : 32);
            const float bnd_g = WSP(const float, WS_BND)[l * 2], bnd_l = WSP(const float, WS_BND)[l * 2 + 1];
            #ifndef ATTN_FAST
#define ATTN_FAST attn_unit_sk
#endif
#ifndef FORCE_FAST
#define FORCE_FAST 0
#endif
            const bool fast = FORCE_FAST || ((bnd_g <= 48.0f) && (bnd_l <= 48.0f));
#ifndef PROBE_XV
#define PROBE_XV 0
#endif
            for (int rep = 0; rep < REP_C; ++rep) {
            if (PROBE_XV != 0 && rep + 1 < REP_C) {
                attn_body::bf16* OD = (attn_body::bf16*)(kargs()->ws + (size_t)524 * MiB);
                for (int L = F.vcu; L < 1024; L += F.G) { const int bh = L >> 6, b = bh >> 3, h = bh & 7, qb = L & 63;
                    attn_body::attn_unit_sb<0, PROBE_XV>((long)b * RB + NCTX + qb * 256, (long)b * RB, 0, h * 64, (h >> 2), 4 + (h >> 2), RB / 64, -INFINITY, bnd_g, Q, KVb, OD, (char*)lds + RING_OFF); }
                xcd_barrier(bar); continue; }
            for (int L = F.vcu; L < n0; L += F.G) {
                long qrow, kvrow; int qcol, kcol, vcol, NT; float sink2 = -INFINITY, bnd = bnd_g;
                if (L < 1024) { const int bh = L >> 6, b = bh >> 3, h = bh & 7, qb = L & 63; qrow = (long)b * RB + NCTX + qb * 256; kvrow = (long)b * RB; NT = RB / 64; qcol = h * 64; kcol = (h >> 2); vcol = 4 + (h >> 2); }
                else { const int Lc = L - 1024, b = Lc >> 4, h = Lc & 15; qrow = (long)b * RB; kvrow = qrow; NT = NCTX / 64; qcol = h * 64;
                    if (h < 8) { kcol = (h >> 2); vcol = 4 + (h >> 2); } else { const int hl = h - 8; kcol = 2 + (hl >> 2); vcol = 6 + (hl >> 2); sink2 = sink[hl] * LOG2E; bnd = bnd_l; } }
                if (fast) attn_body::ATTN_FAST<0>(qrow, kvrow, 0, qcol, kcol, vcol, NT, sink2, bnd, Q, KVb, O, (char*)lds + RING_OFF);
                else attn_body::attn_unit<0, 8>(qrow, kvrow, 0, qcol, kcol, vcol, NT, sink2, Q, KVb, O, (char*)lds + RING_OFF);
            }
            for (int L = F.vcu; L < 1024; L += F.G) {
                const int bh = L >> 6, b = bh >> 3, hl = bh & 7, qb = L & 63, q0 = qb * 256;
                if (fast) attn_body::ATTN_FAST<1>((long)b * RB + NCTX + q0, (long)b * RB, q0, (8 + hl) * 64, 2 + (hl >> 2), 6 + (hl >> 2), 12, sink[hl] * LOG2E, bnd_l, Q, KVb, O, (char*)lds + RING_OFF);
                else attn_body::attn_unit<1, 8>((long)b * RB + NCTX + q0, (long)b * RB, q0, (8 + hl) * 64, 2 + (hl >> 2), 6 + (hl >> 2), 12, sink[hl] * LOG2E, Q, KVb, O, (char*)lds + RING_OFF);
            }
            if (rep + 1 < REP_C) xcd_barrier(bar); }
            SEAM(pb + 2);
        }
        if (EN(3) && RUN(pb + 3)) {
            pg8::ProbDense P; P.A = WSP(const char, WS_HN); P.B = (const char*)(WSP(bf16_t, WS_WOUT) + (size_t)l * 1024 * 1024); P.lda = 1024; P.ldb = 1024; P.nt = 16; P.skip_ctx = lastl; P.S.init(lastl ? NB * SEQ : NROW, 1024, F.G, (int)blockIdx.x);
            for (int rep = 0; rep < REP_D; ++rep) {
            pg8::EpiResid E{WSP(bf16_t, WS_XS), WSP(float, WS_MODV) + (size_t)l * 3 * 6144, 2048, (rep & 1) ? -1.0f : 1.0f};
            pg8::gemm_phase<pg8::EpiResid, pg8::ProbDense, true>(F.lds + RING_OFF, F.lds + OFFS_OFF, P, E); if (rep + 1 < REP_D) xcd_barrier(bar); }
            SEAM(pb + 3);
        }
        if (EN(4) && RUN(pb + 4)) {
#if REP_E == 2
            phase_norm2_router(F, l, lastl, true); xcd_barrier(bar);
#endif
            phase_norm2_router(F, l, lastl, false); SEAM(pb + 4); }
        if (EN(5) && RUN(pb + 5)) {
            const int ntile = moe_tables(F, l);
            pg8::ProbGU P; P.A = WSP(const char, WS_HN); P.B = (const char*)(WSP(bf16_t, WS_WGU) + (size_t)l * 16 * 1024 * 1024); P.tok = WSP(int, WS_TOK); P.s_n = (const LAS int*)(F.lds + MOE_OFF); P.s_ts = P.s_n + 32;
            P.total = ntile * 8; P.G = F.G; P.c = F.vcu; P.nt = 16;
            pg8::EpiGU E{WSP(bf16_t, WS_ACT), WSP(f32x2, WS_WTS)};
            for (int rep = 0; rep < REP_F; ++rep) { pg8::gemm_phase<pg8::EpiGU, pg8::ProbGU, true>(F.lds + RING_OFF, F.lds + OFFS_OFF, P, E); if (rep + 1 < REP_F) xcd_barrier(bar); }
            SEAM(pb + 5);
        }
        if (EN(6) && RUN(pb + 6)) {
            const int ntile = moe_tables(F, l);
            pg8::ProbDown P; P.A = WSP(const char, WS_ACT); P.B = (const char*)(WSP(bf16_t, WS_WD) + (size_t)l * 16 * 1024 * 512); P.s_n = (const LAS int*)(F.lds + MOE_OFF); P.s_ts = P.s_n + 32;
            P.total = ntile * 4; P.G = F.G; P.c = F.vcu; P.nt = 16;
            for (int rep = 0; rep < REP_G; ++rep) {
            pg8::EpiDown E{WSP(bf16_t, WS_XS), lastl ? kargs()->out : nullptr, WSP(int, WS_TOK), WSP(float, WS_MODV) + (size_t)l * 3 * 6144, (rep & 1) ? -1.0f : 1.0f};
            pg8::gemm_phase<pg8::EpiDown, pg8::ProbDown, true>(F.lds + RING_OFF, F.lds + OFFS_OFF, P, E); if (rep + 1 < REP_G) xcd_barrier(bar); }
            SEAM(pb + 6);
        }
    }
#undef RUN
#undef SEAM
}

#ifndef MK_SPLIT
#define MK_SPLIT 0
#endif
extern "C" void kernel_launch(void* const* d_in, const int* in_sizes, int n_in, void* d_out, int out_size, void* d_ws, size_t ws_size, hipStream_t stream) {
    static int grid = 0;
    if (grid == 0) {
        if (n_in != 20 || in_sizes[0] != NB * SEQ * DM || out_size != NB * SEQ * DM || ws_size < WS_END) {
            fprintf(stderr, "kernel_launch: unexpected shapes (n_in %d, in0 %d, out %d, ws %zu); nothing launched\n", n_in, n_in > 0 ? in_sizes[0] : -1, out_size, ws_size); grid = -1; return; }
        int dev = 0, cus = 0, per_cu = 0;
        if (hipGetDevice(&dev) != hipSuccess || hipDeviceGetAttribute(&cus, hipDeviceAttributeMultiprocessorCount, dev) != hipSuccess) { grid = -1; return; }
        if (hipFuncSetAttribute((const void*)fwd_kernel, hipFuncAttributeMaxDynamicSharedMemorySize, LDS_BYTES) != hipSuccess) { fprintf(stderr, "kernel_launch: hipFuncSetAttribute failed\n"); grid = -1; return; }
        if (hipOccupancyMaxActiveBlocksPerMultiprocessor(&per_cu, (const void*)fwd_kernel, NWAVES * 64, LDS_BYTES) != hipSuccess || per_cu < 1)
            fprintf(stderr, "kernel_launch: note: occupancy query reports %d workgroups per CU\n", per_cu);
        (void)hipGetLastError();
        grid = cus;
    }
    if (grid < 0) return;
    if (hipMemsetAsync((char*)d_ws + WS_CTL, 0, CTL_ZERO_BYTES, stream) != hipSuccess) return;
    Args a{};
    for (int i = 0; i < 20; ++i) a.in[i] = (const float*)d_in[i];
    a.out = (float*)d_out; a.ws = (unsigned char*)d_ws;
#if MK_SPLIT
    for (int p = 0; p < NPHASE; ++p) { a.ph_lo = p; a.ph_hi = p + 1; hipLaunchKernelGGL(fwd_kernel, dim3(grid), dim3(NWAVES * 64), LDS_BYTES, stream, a); }
#else
    a.ph_lo = 0; a.ph_hi = NPHASE;
    hipLaunchKernelGGL(fwd_kernel, dim3(grid), dim3(NWAVES * 64), LDS_BYTES, stream, a);
#endif
    const hipError_t le = hipPeekAtLastError();
    if (le != hipSuccess) fprintf(stderr, "kernel_launch: launch failed: %s\n", hipGetErrorName(le));
}
```

```cpp
#include <hip/hip_runtime.h>
#include <hip/hip_bf16.h>
#include <cstdio>
#include <cstdint>
#include <cmath>

#define LAS __attribute__((address_space(3)))
#define GAS __attribute__((address_space(1)))
typedef unsigned short bf16_t;
typedef short bf16x8 __attribute__((ext_vector_type(8)));
typedef float f32x4 __attribute__((ext_vector_type(4)));
typedef float f32x2 __attribute__((ext_vector_type(2)));
typedef unsigned u32x4 __attribute__((ext_vector_type(4)));
typedef unsigned u32x2 __attribute__((ext_vector_type(2)));
typedef GAS unsigned gu32;

constexpr int NB = 2, SEQ = 16384, DM = 1024, NCTX = 256, NLAYER = 4, NEXP = 16, DEXP = 512;
constexpr int RB = SEQ + NCTX;
constexpr int NROW = NB * RB;
constexpr int NCLS = 24, CAP = NROW;
constexpr int MAXSLOT = 39424;
constexpr float NORM_EPS = 1e-6f;
constexpr float C2 = 0.125f * 1.4426950408889634f;
constexpr float LOG2E = 1.4426950408889634f;
constexpr float SQC2 = 0.42466090014400953f;

constexpr size_t MiB = 1u << 20;
constexpr size_t WS_CTL = 0, CTL_ZERO_BYTES = 1 * MiB;
constexpr size_t WS_MODV = 1 * MiB;
constexpr size_t WS_ROPE = 2 * MiB;
constexpr size_t WS_GN = 3 * MiB;
constexpr size_t WS_BND = 3 * MiB + 8192;
constexpr size_t WS_TOK = 4 * MiB;
constexpr size_t WS_WTS = 8 * MiB;
constexpr size_t WS_WIN = 16 * MiB;
constexpr size_t WS_WOUT = 28 * MiB;
constexpr size_t WS_WGU = 36 * MiB;
constexpr size_t WS_WD = 164 * MiB;
constexpr size_t WS_XS = 228 * MiB;
constexpr size_t WS_HN = 358 * MiB;
constexpr size_t WS_QO = 423 * MiB;
constexpr size_t WS_KV = 488 * MiB;
constexpr size_t WS_ACT = 423 * MiB;
constexpr size_t WS_END = 522 * MiB;
static_assert(WS_TOK + (size_t)NCLS * CAP * 4 <= WS_WTS && WS_WTS + (size_t)NCLS * CAP * 8 <= WS_WIN, "lists");
static_assert(WS_KV + (size_t)(NROW + 256) * 512 * 2 <= WS_END && WS_ACT + (size_t)MAXSLOT * 1024 * 2 <= WS_END, "ws map");
constexpr int CW_TMO = 0, CW_CODE = 1, CW_BAR = 4096, CW_CNT = 8192;

constexpr int RING_OFF = 0, RING_BYTES = 131072;
constexpr int LDSCTL_OFF = RING_BYTES, MISC_OFF = LDSCTL_OFF + 320, MOE_OFF = LDSCTL_OFF + 1024, OFFS_OFF = LDSCTL_OFF + 2048  ;
constexpr int LDS_BYTES = 147456;
constexpr int NWAVES = 8;

#define LDS_WAIT() asm volatile("s_waitcnt lgkmcnt(0)" ::: "memory")
#define VM_WAIT() asm volatile("s_waitcnt vmcnt(0)" ::: "memory")
#define RLX_AGENT __ATOMIC_RELAXED, __HIP_MEMORY_SCOPE_AGENT

__device__ __forceinline__ unsigned f2bf(float f) { unsigned u = __builtin_bit_cast(unsigned, f); return (u + 0x7fffu + ((u >> 16) & 1u)) >> 16; }
__device__ __forceinline__ unsigned pk2(float lo, float hi) { return f2bf(lo) | (f2bf(hi) << 16); }
__device__ __forceinline__ unsigned cvt_pk_bf16(float lo, float hi) { unsigned r; asm volatile("v_cvt_pk_bf16_f32 %0, %1, %2" : "=v"(r) : "v"(lo), "v"(hi)); return r; }
__device__ __forceinline__ float wave_sum(float v) {
#pragma unroll
    for (int o = 1; o < 64; o <<= 1) v += __shfl_xor(v, o);
    return v;
}

#define XB_TMO      128
#define XB_XCNT(j)  (256  + 64 * (j))
#define XB_XSUB(j)  (1280 + 64 * (j))
#define XB_XGEN(j)  (2304 + 64 * (j))
#define XB_TOP      3328
#define XB_TOPGEN   3392
#define XCD_BAR_WORDS 3456
#define XB_SPIN_CAP (1u << 22)
__device__ __forceinline__ unsigned xb_ld(unsigned* p)              { return __hip_atomic_load(p, __ATOMIC_RELAXED, __HIP_MEMORY_SCOPE_AGENT); }
__device__ __forceinline__ unsigned xb_add(unsigned* p, unsigned v) { return __hip_atomic_fetch_add(p, v, __ATOMIC_RELAXED, __HIP_MEMORY_SCOPE_AGENT); }
__device__ __forceinline__ unsigned xb_xcc_id() { return (unsigned)__builtin_amdgcn_s_getreg((3 << 11) | 20) & 0xFu; }
#define XB_SPIN(cond, bar) do { unsigned _sp = 0; while (cond) { __builtin_amdgcn_s_sleep(1); \
    if ((++_sp & 255u) == 0u) { if (xb_ld(&(bar)[XB_TMO])) break; if (_sp > XB_SPIN_CAP) { atomicAdd(&(bar)[XB_TMO], 1u); break; } } } } while (0)
struct XcdBarrier { unsigned* bar; unsigned x; volatile LAS unsigned* st; };
__device__ __forceinline__ XcdBarrier xcd_barrier_post(unsigned* bar, volatile LAS unsigned* st) {
    XcdBarrier b; b.bar = bar; b.x = xb_xcc_id(); b.st = st;
    if (threadIdx.x == 0) (void)xb_add(&bar[XB_XCNT(b.x)], 1u);
    return b;
}
__device__ __forceinline__ void xcd_barrier_complete(unsigned* bar, unsigned x, unsigned& nloc, unsigned& nx) {
    const unsigned G = gridDim.x * gridDim.y * gridDim.z;
    unsigned sum, cnt, mine, sp = 0u;
    for (;;) {
        sum = 0u; cnt = 0u; mine = 0u;
#pragma unroll
        for (unsigned j = 0; j < 16; ++j) { const unsigned c = xb_ld(&bar[XB_XCNT(j)]); sum += c; cnt += (c > 0u) ? 1u : 0u; mine = (j == x) ? c : mine; }
        if (sum == G) break;
        __builtin_amdgcn_s_sleep(1);
        if ((++sp & 255u) == 0u) { if (xb_ld(&bar[XB_TMO])) break; if (sp > XB_SPIN_CAP) { atomicAdd(&bar[XB_TMO], 1u); break; } }
    }
    nloc = mine > 0u ? mine : 1u; nx = cnt > 0u ? cnt : 1u;
}
__device__ __forceinline__ void xcd_barrier(const XcdBarrier& b) {
    asm volatile("s_waitcnt vmcnt(0)" ::: "memory");
    __syncthreads();
    if (threadIdx.x == 0) {
        unsigned* bar = b.bar;
        __builtin_amdgcn_s_waitcnt(0);
        unsigned nloc = b.st[0], nx = b.st[1];
        if (nloc == 0u) { xcd_barrier_complete(bar, b.x, nloc, nx); b.st[0] = nloc; b.st[1] = nx; }
        const unsigned old = xb_add(&bar[XB_XSUB(b.x)], 1u);
        const unsigned gen = old / nloc;
        if (old + 1u == (gen + 1u) * nloc) {
            __builtin_amdgcn_fence(__ATOMIC_RELEASE, "agent");
            asm volatile("s_waitcnt vmcnt(0)" ::: "memory");
            const unsigned og = xb_add(&bar[XB_TOP], 1u);
            const unsigned tg = og / nx;
            if (og + 1u == (tg + 1u) * nx) xb_add(&bar[XB_TOPGEN], 1u);
            else XB_SPIN(xb_ld(&bar[XB_TOPGEN]) == tg, bar);
            __builtin_amdgcn_fence(__ATOMIC_ACQUIRE, "agent");
            xb_add(&bar[XB_XGEN(b.x)], 1u);
            asm volatile("s_waitcnt vmcnt(0)" ::: "memory");
        } else {
            XB_SPIN(xb_ld(&bar[XB_XGEN(b.x)]) == gen, bar);
            __builtin_amdgcn_fence(__ATOMIC_ACQUIRE, "agent");
            asm volatile("s_waitcnt vmcnt(0)" ::: "memory");
        }
    }
    __syncthreads();
}

namespace pg8 {
constexpr int BM = 256, BK = 64, HALF = 128, HTB = HALF * BK * 2, STAGE_BYTES = 8 * HTB, NXCD = 8, WGM = 8;
__host__ __device__ __forceinline__ int lds_byte(int r, int c) { const int st = (r >> 4) * 2 + (c >> 5), rr = r & 15, cc = c & 31, ob = rr * 64 + cc * 2; return st * 1024 + (ob ^ (((ob >> 9) & 1) << 5)); }
__host__ __device__ __forceinline__ void stage_rc(int b, int& R, int& C) { const int st = b / 1024, sb = b % 1024, swz = sb ^ (((sb >> 9) & 1) << 5); R = (st >> 1) * 16 + swz / 64; C = (st & 1) * 32 + (swz % 64) / 2; }
__host__ __device__ __forceinline__ int perm32(int rho) { const int n = rho >> 4, i = rho & 15; return 8 * (i >> 2) + 4 * n + (i & 3); }

struct Unit { int pm, pn, cls, row0, ncls, elo, ehi; };

struct StaticOrder {
    int nM, nN, nwg, G, c;
    __device__ void init(int M, int N, int G_, int c_) { nM = M / BM; nN = N / BM; nwg = nM * nN; G = G_; c = c_; }
    __device__ __forceinline__ bool next(int i, Unit& u) const {
        const long L = (long)i * G + c; if (L >= nwg) return false;
        int wgid = (int)L; { const int q = nwg / NXCD, r = nwg % NXCD, xcd = wgid % NXCD, off = wgid / NXCD; wgid = (xcd < r ? xcd * (q + 1) : r * (q + 1) + (xcd - r) * q) + off; }
        const int nig = WGM * nN, gid = wgid / nig, fm = gid * WGM, gsz = (nM - fm) < WGM ? (nM - fm) : WGM;
        u.pm = fm + ((wgid % nig) % gsz); u.pn = (wgid % nig) / gsz; u.cls = 0; u.row0 = 0; u.ncls = 0; u.elo = 0; u.ehi = 0; return true;
    }
};

struct ProbDense {
    const char* A; const char* B; int lda, ldb, nt; StaticOrder S; bool skip_ctx;
    __device__ __forceinline__ bool next(int i, Unit& u) const { if (!S.next(i, u)) return false; if (skip_ctx) u.pm += 1 + (u.pm >= 64 ? 1 : 0); return true; }
    __device__ __forceinline__ void a_offs(const Unit& u, int tid, unsigned (&off)[2][2]) const {
#pragma unroll
        for (int i = 0; i < 2; ++i) { int R, C; stage_rc(tid * 16 + i * 8192, R, C);
#pragma unroll
            for (int h = 0; h < 2; ++h) off[h][i] = (unsigned)((u.pm * BM + h * HALF + R) * lda + C) * 2u; }
    }
    __device__ __forceinline__ const char* b_ptr(const Unit& u, int t) const { return B + (size_t)u.pn * BM * ldb * 2 + (size_t)t * (BK * 2); }
};
__device__ __forceinline__ void moe_unit(const LAS int* s_n, const LAS int* s_ts, int rt, Unit& u) {
    int cc = 0; while (s_ts[cc + 1] <= rt) ++cc;
    u.pm = rt; u.cls = cc; u.row0 = (rt - s_ts[cc]) * BM; u.ncls = s_n[cc];
    const int g = cc / 6, idx = cc % 6; const int a = idx < 3 ? 0 : (idx < 5 ? 1 : 2), b = idx < 3 ? idx + 1 : (idx < 5 ? idx - 1 : 3);
    u.elo = 4 * g + a; u.ehi = 4 * g + b;
}
struct ProbGU {
    const char* A; const char* B; const int* tok; const LAS int* s_n; const LAS int* s_ts; int total, G, c; static constexpr int ldb = 1024; int nt;
    __device__ __forceinline__ bool next(int i, Unit& u) const { const long L = (long)i * G + c; if (L >= total) return false; u.pn = (int)(L & 7); moe_unit(s_n, s_ts, (int)(L >> 3), u); return true; }
    __device__ __forceinline__ void a_offs(const Unit& u, int tid, unsigned (&off)[2][2]) const {
#pragma unroll
        for (int i = 0; i < 2; ++i) { int R, C; stage_rc(tid * 16 + i * 8192, R, C);
#pragma unroll
            for (int h = 0; h < 2; ++h) { int r = u.row0 + h * HALF + R; r = r < u.ncls ? r : u.ncls - 1; const int t = tok[(size_t)u.cls * CAP + r]; off[h][i] = (unsigned)t * 2048u + (unsigned)C * 2u; } }
    }
    __device__ __forceinline__ const char* b_ptr(const Unit& u, int t) const { const int e = u.pn >= 4 ? u.ehi : u.elo; return B + (size_t)e * (1024 * 1024 * 2) + (size_t)(u.pn & 3) * (BM * 1024 * 2) + (size_t)t * (BK * 2); }
};
struct ProbDown {
    const char* A; const char* B; const LAS int* s_n; const LAS int* s_ts; int total, G, c; static constexpr int ldb = 512; int nt;
    __device__ __forceinline__ bool next(int i, Unit& u) const { const long L = (long)i * G + c; if (L >= total) return false; u.pn = (int)(L & 3); moe_unit(s_n, s_ts, (int)(L >> 2), u); return true; }
    __device__ __forceinline__ void a_offs(const Unit& u, int tid, unsigned (&off)[2][2]) const {
#pragma unroll
        for (int i = 0; i < 2; ++i) { int R, C; stage_rc(tid * 16 + i * 8192, R, C);
#pragma unroll
            for (int h = 0; h < 2; ++h) off[h][i] = (unsigned)(u.pm * BM + h * HALF + R) * 2048u + (unsigned)C * 2u; }
    }
    __device__ __forceinline__ const char* b_ptr(const Unit& u, int t) const { const int e = t < 8 ? u.elo : u.ehi; return B + (size_t)e * (1024 * 512 * 2) + (size_t)u.pn * (BM * 512 * 2) + (size_t)(t & 7) * (BK * 2); }
};

template <class Epi, class Prob, bool ALIGN_EPI>
__device__ __forceinline__ void gemm_phase(LAS unsigned char* lds, LAS unsigned char* offs_lds, const Prob& P, const Epi& E) {
    int tid_ = threadIdx.x; asm volatile("" : "+v"(tid_));
    const int tid = tid_, wid = __builtin_amdgcn_readfirstlane(tid >> 6), lane = tid & 63, wr = wid >> 2, wc = wid & 3, fr = lane & 15, fq = lane >> 4;
    const int nt = P.nt;
    unsigned voffB[2];
#pragma unroll
    for (int i = 0; i < 2; ++i) { int R, C; stage_rc(tid * 16 + i * 8192, R, C); const int Rb = Epi::PERM ? ((R & ~31) + perm32(R & 31)) : R; voffB[i] = (unsigned)(Rb * P.ldb + C) * 2u; }
    LAS u32x4* const myoffs = (LAS u32x4*)offs_lds + tid;
    const size_t hstepB = (size_t)HALF * P.ldb * 2;
    const unsigned ldsw = (unsigned)wid * 1024u;
    const int aoff = lds_byte(wr * 64 + fr, fq * 8), boff = lds_byte(wc * 32 + fr, fq * 8);
    const char* const Ab = P.A;
#define PG8_SA(b, h) (((b) * 2 + (h)) * HTB)
#define PG8_SB(b, h) ((4 + (b) * 2 + (h)) * HTB)
#define PG8_STAGE_A(bufoff, h, offs, kt) do { _Pragma("unroll") for (int _i = 0; _i < 2; ++_i) \
        __builtin_amdgcn_global_load_lds((const unsigned*)(Ab + (size_t)(offs)[h][_i] + (size_t)(kt) * (BK * 2)), (LAS unsigned*)(lds + (bufoff) + ldsw + _i * 8192), 16, 0, 0); } while (0)
#define PG8_STAGE_B(bufoff, bp) do { _Pragma("unroll") for (int _i = 0; _i < 2; ++_i) \
        __builtin_amdgcn_global_load_lds((const unsigned*)((bp) + voffB[_i]), (LAS unsigned*)(lds + (bufoff) + ldsw + _i * 8192), 16, 0, 0); } while (0)
#define PG8_LDA(dst, b, h) do { _Pragma("unroll") for (int m = 0; m < 4; ++m) _Pragma("unroll") for (int k = 0; k < 2; ++k) dst[m][k] = *(const LAS bf16x8*)(lds + PG8_SA(b, h) + aoff + m * 2048 + k * 1024); } while (0)
#define PG8_LDB(dst, b, h) do { _Pragma("unroll") for (int n = 0; n < 2; ++n) _Pragma("unroll") for (int k = 0; k < 2; ++k) dst[n][k] = *(const LAS bf16x8*)(lds + PG8_SB(b, h) + boff + n * 2048 + k * 1024); } while (0)
#define PG8_MMA(ai, bj, At, Bt) do { __builtin_amdgcn_s_setprio(1); _Pragma("unroll") for (int m = 0; m < 4; ++m) _Pragma("unroll") for (int n = 0; n < 2; ++n) _Pragma("unroll") for (int k = 0; k < 2; ++k) \
        acc[ai][bj][m][n] = __builtin_amdgcn_mfma_f32_16x16x32_bf16(Bt[n][k], At[m][k], acc[ai][bj][m][n], 0, 0, 0); __builtin_amdgcn_s_setprio(0); } while (0)
#define PG8_WAIT_V(n) asm volatile("s_waitcnt vmcnt(" #n ")" ::: "memory")
#define PG8_WAIT_L(n) asm volatile("s_waitcnt lgkmcnt(" #n ")" ::: "memory")
#define PG8_BAR __builtin_amdgcn_s_barrier()
#define PG8_SCHED __builtin_amdgcn_sched_barrier(0)
    Unit cur, nxt; int ui = 0;
    if (!P.next(0, cur)) return;
    f32x4 acc[2][2][4][2];
#pragma unroll
    for (int a = 0; a < 2; ++a)
#pragma unroll
        for (int b = 0; b < 2; ++b)
#pragma unroll
            for (int m = 0; m < 4; ++m)
#pragma unroll
                for (int n = 0; n < 2; ++n) acc[a][b][m][n] = (f32x4){0.f, 0.f, 0.f, 0.f};
    bf16x8 At[4][2], B0[2][2], B1[2][2];
    unsigned offC[2][2];
    P.a_offs(cur, tid, offC);
    {
        const char* b0 = P.b_ptr(cur, 0); const char* b1 = P.b_ptr(cur, 1);
        PG8_STAGE_B(PG8_SB(0, 0), b0); PG8_STAGE_B(PG8_SB(0, 1), b0 + hstepB); PG8_STAGE_A(PG8_SA(0, 0), 0, offC, 0); PG8_STAGE_A(PG8_SA(0, 1), 1, offC, 0);
        if (wr == 1) PG8_BAR;
        PG8_WAIT_V(2); PG8_BAR;
        PG8_STAGE_B(PG8_SB(1, 0), b1); PG8_STAGE_A(PG8_SA(1, 0), 0, offC, 1); PG8_STAGE_B(PG8_SB(1, 1), b1 + hstepB);
        PG8_WAIT_V(6); PG8_BAR;
    }
    for (;;) {
        const bool has_next = P.next(ui + 1, nxt);
        if (!has_next) nxt = cur;
        {
            unsigned offN[2][2];
            if (has_next) P.a_offs(nxt, tid, offN);
            else {
#pragma unroll
                for (int h = 0; h < 2; ++h)
#pragma unroll
                    for (int i = 0; i < 2; ++i) offN[h][i] = offC[h][i];
            }
            *myoffs = (u32x4){offN[0][0], offN[0][1], offN[1][0], offN[1][1]};
        }
        for (int t = 0; t < nt; t += 2) {
            const bool last = (t == nt - 2);
            const int k2 = last ? 0 : t + 2;
            const char* b2 = last ? P.b_ptr(nxt, 0) : P.b_ptr(cur, t + 2);
            const char* b3 = last ? P.b_ptr(nxt, 1) : P.b_ptr(cur, t + 3);
            PG8_LDB(B0, 0, 0); PG8_LDB(B1, 0, 1); PG8_SCHED; PG8_LDA(At, 0, 0); PG8_STAGE_A(PG8_SA(1, 1), 1, offC, t + 1);
            if (last) { const u32x4 v = *myoffs; offC[0][0] = v.x; offC[0][1] = v.y; offC[1][0] = v.z; offC[1][1] = v.w; }
            PG8_WAIT_V(8); PG8_WAIT_L(0); PG8_BAR; PG8_MMA(0, 0, At, B0); PG8_MMA(0, 1, At, B1); PG8_BAR; PG8_SCHED;
            PG8_LDA(At, 0, 1); PG8_STAGE_B(PG8_SB(0, 0), b2); PG8_STAGE_B(PG8_SB(0, 1), b2 + hstepB); PG8_STAGE_A(PG8_SA(0, 0), 0, offC, k2);
            PG8_WAIT_V(8); PG8_WAIT_L(0); PG8_BAR; PG8_MMA(1, 0, At, B0); PG8_MMA(1, 1, At, B1); PG8_BAR; PG8_SCHED;
            PG8_LDB(B0, 1, 0); PG8_LDB(B1, 1, 1); PG8_SCHED; PG8_LDA(At, 1, 0); PG8_STAGE_A(PG8_SA(0, 1), 1, offC, k2);
            PG8_WAIT_V(8); PG8_WAIT_L(0); PG8_BAR; PG8_MMA(0, 0, At, B0); PG8_MMA(0, 1, At, B1); PG8_BAR; PG8_SCHED;
            PG8_LDA(At, 1, 1); PG8_STAGE_B(PG8_SB(1, 0), b3); PG8_STAGE_B(PG8_SB(1, 1), b3 + hstepB); PG8_STAGE_A(PG8_SA(1, 0), 0, offC, k2 + 1);
            PG8_WAIT_V(8); PG8_WAIT_L(0); PG8_BAR; PG8_MMA(1, 0, At, B0); PG8_MMA(1, 1, At, B1); PG8_BAR; PG8_SCHED;
        }
        if constexpr (ALIGN_EPI) { if (wr == 0) PG8_BAR; }
        E(acc, cur, wr, wc, fr, fq);
        if (!has_next) break;
#pragma unroll
        for (int a = 0; a < 2; ++a)
#pragma unroll
            for (int b = 0; b < 2; ++b)
#pragma unroll
                for (int m = 0; m < 4; ++m)
#pragma unroll
                    for (int n = 0; n < 2; ++n) acc[a][b][m][n] = (f32x4){0.f, 0.f, 0.f, 0.f};
        cur = nxt; ++ui;
        if constexpr (ALIGN_EPI) { if (wr == 1) PG8_BAR; }
    }
    PG8_WAIT_V(0);
    if constexpr (!ALIGN_EPI) { if (wr == 0) PG8_BAR; }
    PG8_BAR;
#undef PG8_SA
#undef PG8_SB
#undef PG8_STAGE_A
#undef PG8_STAGE_B
#undef PG8_LDA
#undef PG8_LDB
#undef PG8_MMA
#undef PG8_WAIT_V
#undef PG8_WAIT_L
#undef PG8_BAR
#undef PG8_SCHED
}
}

namespace pg8 {
struct EpiQKV {
    static constexpr bool PERM = true;
    unsigned char* ws; const float* gn; const float* rope;
    __device__ __forceinline__ void operator()(const f32x4 (&acc)[2][2][4][2], const Unit& u, int wr, int wc, int fr, int fq) const {
        const int pn = u.pn, tb_ = u.pm % 65;
        const bool is_ctx = (tb_ == 0);
        const bool isV = (pn >= 4) && (wc >= 2);
        const float* gain = gn + (pn < 2 ? 0 : (pn < 4 ? 64 : (pn == 4 ? 128 : 192)));
        const int strm = 2 * (pn - 4) + (wc & 1);
#pragma unroll
        for (int ai = 0; ai < 2; ++ai)
#pragma unroll
            for (int m = 0; m < 4; ++m) {
                int mfr = m * 16 + fr; asm volatile("" : "+v"(mfr));
                const int row = u.pm * BM + ai * HALF + wr * 64 + mfr;
                f32x4 v[2][2];
#pragma unroll
                for (int bj = 0; bj < 2; ++bj)
#pragma unroll
                    for (int n = 0; n < 2; ++n) v[bj][n] = acc[ai][bj][m][n];
                if (!isV) {
                    float ss = 0.f;
#pragma unroll
                    for (int bj = 0; bj < 2; ++bj)
#pragma unroll
                        for (int n = 0; n < 2; ++n) { const f32x4 x = v[bj][n]; ss += (x[0] * x[0] + x[1] * x[1]) + (x[2] * x[2] + x[3] * x[3]); }
                    ss += __shfl_xor(ss, 16); ss += __shfl_xor(ss, 32);
                    const float rs = SQC2 / sqrtf(ss * (1.0f / 64.0f) + NORM_EPS);
#pragma unroll
                    for (int bj = 0; bj < 2; ++bj)
#pragma unroll
                        for (int n = 0; n < 2; ++n) v[bj][n] = v[bj][n] * rs * *(const f32x4*)(gain + 32 * bj + 16 * n + 4 * fq);
                    if (!is_ctx) {
                        const int pr = (tb_ - 1) * 4 + 2 * ai + wr, pc = mfr;
#pragma unroll
                        for (int bj = 0; bj < 2; ++bj) {
                            const int pos = bj ? pc : pr;
                            const f32x4* rp = (const f32x4*)(rope + (size_t)(pos * 16 + 4 * fq) * 2);
                            const f32x4 r0 = rp[0], r1 = rp[1];
                            const f32x4 cs = (f32x4){r0[0], r0[2], r1[0], r1[2]}, sn = (f32x4){r0[1], r0[3], r1[1], r1[3]};
                            const f32x4 x1 = v[bj][0], x2 = v[bj][1];
                            v[bj][0] = x1 * cs - x2 * sn; v[bj][1] = x2 * cs + x1 * sn;
                        }
                    }
                }
                if (pn < 4) {
                    unsigned char* rowp = ws + WS_QO + (size_t)row * 1024 + 256 * pn + 64 * wc + 4 * fq;
#pragma unroll
                    for (int bj = 0; bj < 2; ++bj)
#pragma unroll
                        for (int n = 0; n < 2; ++n) { int w = __builtin_amdgcn_cvt_pk_fp8_f32(v[bj][n][0], v[bj][n][1], 0, false); w = __builtin_amdgcn_cvt_pk_fp8_f32(v[bj][n][2], v[bj][n][3], w, true);
                            *(int*)(rowp + 32 * bj + 16 * n) = w; }
                } else {
                    unsigned char* tb = ws + WS_KV + (size_t)(u.pm * 4 + ai * 2 + wr) * 49152 + (isV ? 16384 + strm * 8192 : strm * 4096);
                    if (!isV) {
                        const int kk = mfr; const unsigned kof = (unsigned)(kk * 64 + 4 * fq), ksw = (unsigned)((kk >> 2) & 3);
#pragma unroll
                        for (int bj = 0; bj < 2; ++bj)
#pragma unroll
                            for (int n = 0; n < 2; ++n) { int w = __builtin_amdgcn_cvt_pk_fp8_f32(v[bj][n][0], v[bj][n][1], 0, false); w = __builtin_amdgcn_cvt_pk_fp8_f32(v[bj][n][2], v[bj][n][3], w, true);
                                *(int*)(tb + (kof + (((unsigned)(2 * bj + n) ^ ksw) * 16u))) = w; }
                    } else {
                        const int sub = fr >> 2, hb = sub & 1;
                        const unsigned vbase = (unsigned)(4 * fq * 128 + (4 * (sub >> 1) + (fr & 3)) * 2);
#pragma unroll
                        for (int j = 0; j < 4; ++j) { const int swz = (2 * fq + (j >> 1)) & 7;
                            const unsigned vof = vbase + (unsigned)(j * 128) + (unsigned)((((2 * m) ^ (swz & 6)) | ((hb ^ swz) & 1)) * 16);
#pragma unroll
                            for (int bj = 0; bj < 2; ++bj)
#pragma unroll
                                for (int n = 0; n < 2; ++n) *(bf16_t*)(tb + (vof + (unsigned)((32 * bj + 16 * n) * 128))) = (bf16_t)f2bf(v[bj][n][j]); }
                    }
                }
            }
    }
};
__device__ __forceinline__ float bf_lo(unsigned w) { return __builtin_bit_cast(float, w << 16); }
__device__ __forceinline__ float bf_hi(unsigned w) { return __builtin_bit_cast(float, w & 0xffff0000u); }
struct EpiResid {
    static constexpr bool PERM = true;
    bf16_t* XS; const float* modv_l; int goff; float sgn;
    __device__ __forceinline__ void operator()(const f32x4 (&acc)[2][2][4][2], const Unit& u, int wr, int wc, int fr, int fq) const {
        const int mv = (u.pm % 65 == 0) ? 2 : (u.pm / 65);
        const float* g = modv_l + mv * 6144 + goff;
        const int col0 = u.pn * BM + wc * 32 + 8 * fq;
        f32x4 gv[2][2];
#pragma unroll
        for (int bj = 0; bj < 2; ++bj)
#pragma unroll
            for (int n = 0; n < 2; ++n) gv[bj][n] = *(const f32x4*)(g + col0 + bj * HALF + n * 4) * sgn;
#pragma unroll
        for (int ai = 0; ai < 2; ++ai)
#pragma unroll
            for (int m = 0; m < 4; ++m) {
                bf16_t* rowp = XS + (size_t)(u.pm * BM + ai * HALF + wr * 64 + m * 16 + fr) * 1024 + col0;
#pragma unroll
                for (int bj = 0; bj < 2; ++bj) { u32x4* p = (u32x4*)(rowp + bj * HALF); const u32x4 w = *p; u32x4 o;
                    const f32x4 a0 = gv[bj][0] * acc[ai][bj][m][0], a1 = gv[bj][1] * acc[ai][bj][m][1];
                    o.x = cvt_pk_bf16(bf_lo(w.x) + a0[0], bf_hi(w.x) + a0[1]); o.y = cvt_pk_bf16(bf_lo(w.y) + a0[2], bf_hi(w.y) + a0[3]);
                    o.z = cvt_pk_bf16(bf_lo(w.z) + a1[0], bf_hi(w.z) + a1[1]); o.w = cvt_pk_bf16(bf_lo(w.w) + a1[2], bf_hi(w.w) + a1[3]);
                    *p = o; }
            }
    }
};
struct EpiGU {
    static constexpr bool PERM = true;
    bf16_t* ACT; const f32x2* wts;
    __device__ __forceinline__ void operator()(const f32x4 (&acc)[2][2][4][2], const Unit& u, int wr, int wc, int fr, int fq) const {
        const int k = u.pn >= 4 ? 1 : 0, jt = u.pn & 3;
        const int colbase = 512 * k + 128 * jt + 32 * wc + 8 * fq;
#pragma unroll
        for (int ai = 0; ai < 2; ++ai)
#pragma unroll
            for (int m = 0; m < 4; ++m) {
                const int r = ai * HALF + wr * 64 + m * 16 + fr;
                int idx = u.row0 + r; idx = idx < u.ncls ? idx : u.ncls - 1;
                const f32x2 w2 = wts[(size_t)u.cls * CAP + idx];
                const float w = k ? w2[1] : w2[0];
                u32x4 o;
#pragma unroll
                for (int n = 0; n < 2; ++n) {
                    const f32x4 g = acc[ai][0][m][n], up = acc[ai][1][m][n]; float a[4];
#pragma unroll
                    for (int j = 0; j < 4; ++j) { const float sg = g[j] * __builtin_amdgcn_rcpf(1.0f + __builtin_amdgcn_exp2f(-g[j] * LOG2E)); a[j] = w * sg * up[j]; }
                    const unsigned lo = cvt_pk_bf16(a[0], a[1]), hi = cvt_pk_bf16(a[2], a[3]);
                    if (n == 0) { o.x = lo; o.y = hi; } else { o.z = lo; o.w = hi; }
                }
                *(u32x4*)(ACT + (size_t)(u.pm * BM + r) * 1024 + colbase) = o;
            }
    }
};
struct EpiDown {
    static constexpr bool PERM = true;
    bf16_t* XS; float* out; const int* tok; const float* modv_l; float sgn;
    __device__ __forceinline__ void operator()(const f32x4 (&acc)[2][2][4][2], const Unit& u, int wr, int wc, int fr, int fq) const {
        const int col0 = u.pn * BM + wc * 32 + 8 * fq;
#pragma unroll
        for (int ai = 0; ai < 2; ++ai)
#pragma unroll
            for (int m = 0; m < 4; ++m) {
                const int idx = u.row0 + ai * HALF + wr * 64 + m * 16 + fr;
                if (idx < u.ncls) {
                    const int t = tok[(size_t)u.cls * CAP + idx];
                    const int b = t >= RB ? 1 : 0, rr = t - b * RB;
                    const int mv = rr < NCTX ? 2 : b;
                    const float* g = modv_l + mv * 6144 + 5120 + col0;
                    bf16_t* xp = XS + (size_t)t * 1024 + col0;
                    float* op = out + (size_t)(b * SEQ + rr - NCTX) * 1024 + col0;
#pragma unroll
                    for (int bj = 0; bj < 2; ++bj) { const u32x4 w = *(const u32x4*)(xp + bj * HALF);
                        const f32x4 a0 = (*(const f32x4*)(g + bj * HALF) * sgn) * acc[ai][bj][m][0], a1 = (*(const f32x4*)(g + bj * HALF + 4) * sgn) * acc[ai][bj][m][1];
                        const f32x4 x0 = (f32x4){bf_lo(w.x) + a0[0], bf_hi(w.x) + a0[1], bf_lo(w.y) + a0[2], bf_hi(w.y) + a0[3]}, x1 = (f32x4){bf_lo(w.z) + a1[0], bf_hi(w.z) + a1[1], bf_lo(w.w) + a1[2], bf_hi(w.w) + a1[3]};
                        if (out) { *(f32x4*)(op + bj * HALF) = x0; *(f32x4*)(op + bj * HALF + 4) = x1; }
                        else { u32x4 o; o.x = cvt_pk_bf16(x0[0], x0[1]); o.y = cvt_pk_bf16(x0[2], x0[3]); o.z = cvt_pk_bf16(x1[0], x1[1]); o.w = cvt_pk_bf16(x1[2], x1[3]); *(u32x4*)(xp + bj * HALF) = o; }
                    }
                }
            }
    }
};
}

namespace attn_body {
using bf16 = __hip_bfloat16;
using s16x4 = __attribute__((ext_vector_type(4))) short;
using f32x16 = __attribute__((ext_vector_type(16))) float;
constexpr int D = 64, QP = 1024, KP = 512;
constexpr int NW = 8, QBLK = 32, QB = QBLK * NW, KVBLK = 64;
__device__ __forceinline__ int crow(int r, int hi) { return (r & 3) + 8 * (r >> 2) + 4 * hi; }
#define SBAR() __builtin_amdgcn_sched_barrier(0)
constexpr int NSLOT = 3, SLOTB = 8192;
constexpr int LDS_K = 0, LDS_V = NSLOT * SLOTB, LDS_WS = 2 * NSLOT * SLOTB, LDS_OST = LDS_WS + NW * 64 * 4, LDS_BYTES = LDS_OST + NW * 4096;
__device__ __forceinline__ void glds16(const void* gsrc, unsigned lds_dst) { unsigned keep;
  asm volatile("s_mov_b32 %0, m0\n\ts_mov_b32 m0, %2\n\ts_nop 0\n\tglobal_load_lds_dwordx4 %1, off\n\ts_mov_b32 m0, %0" : "=&s"(keep) : "v"(gsrc), "s"(lds_dst) : "memory"); }
__device__ __forceinline__ float max3f(float a, float b, float c) { float r; asm("v_max3_f32 %0, %1, %2, %3" : "=v"(r) : "v"(a), "v"(b), "v"(c)); return r; }
__device__ __forceinline__ float max2f(float a, float b) { float r; asm("v_max_f32_e32 %0, %1, %2" : "=v"(r) : "v"(a), "v"(b)); return r; }
__device__ __forceinline__ float fadd_s(float a, float b) { float r; asm("v_add_f32_e32 %0, %1, %2" : "=v"(r) : "v"(a), "v"(b)); return r; }
__device__ __forceinline__ float fsub_s(float a, float b) { float r; asm("v_sub_f32_e32 %0, %1, %2" : "=v"(r) : "v"(a), "v"(b)); return r; }
typedef float f32x2_t __attribute__((ext_vector_type(2))); typedef __bf16 bf16x2_t __attribute__((ext_vector_type(2)));
__device__ __forceinline__ unsigned cvtpk_s(float lo, float hi) { f32x2_t v = {lo, hi}; bf16x2_t b = __builtin_convertvector(v, bf16x2_t); return __builtin_bit_cast(unsigned, b); }
#define WAIT_BAR(N) asm volatile("s_waitcnt vmcnt(" #N ") lgkmcnt(0)\n\ts_barrier" ::: "memory")

__device__ __forceinline__ void qkt(f32x16& p0, f32x16& p1, const char* Kslot, const bf16x8* qr, const f32x16& negm, int r32, int hi) {
  const char* kb = Kslot + hi * 1024 + r32 * 16;
  #pragma unroll
  for (int d0 = 0; d0 < 4; ++d0) {
    const bf16x8 b0 = *reinterpret_cast<const bf16x8*>(kb + d0 * 2048);
    const bf16x8 b1 = *reinterpret_cast<const bf16x8*>(kb + d0 * 2048 + 512);
    if (d0 == 0) { p0 = __builtin_amdgcn_mfma_f32_32x32x16_bf16(b0, qr[0], negm, 0, 0, 0); p1 = __builtin_amdgcn_mfma_f32_32x32x16_bf16(b1, qr[0], negm, 0, 0, 0); }
    else { p0 = __builtin_amdgcn_mfma_f32_32x32x16_bf16(b0, qr[d0], p0, 0, 0, 0); p1 = __builtin_amdgcn_mfma_f32_32x32x16_bf16(b1, qr[d0], p1, 0, 0, 0); } }
}
typedef __attribute__((address_space(3))) const char* lds_cptr;
typedef short v4i16_t __attribute__((ext_vector_type(4)));
__device__ __forceinline__ void kload8(bf16x8* kf, lds_cptr kp) {
  kf[0] = *(const LAS bf16x8*)(kp);        kf[1] = *(const LAS bf16x8*)(kp + 512);
  kf[2] = *(const LAS bf16x8*)(kp + 2048); kf[3] = *(const LAS bf16x8*)(kp + 2560);
  kf[4] = *(const LAS bf16x8*)(kp + 4096); kf[5] = *(const LAS bf16x8*)(kp + 4608);
  kf[6] = *(const LAS bf16x8*)(kp + 6144); kf[7] = *(const LAS bf16x8*)(kp + 6656);
}
__device__ __forceinline__ void kload2(bf16x8* kf, lds_cptr kp, int j) { kf[2 * j] = *(const LAS bf16x8*)(kp + j * 2048); kf[2 * j + 1] = *(const LAS bf16x8*)(kp + j * 2048 + 512); }
__device__ __forceinline__ s16x4 vtr(lds_cptr p) { return __builtin_bit_cast(s16x4, __builtin_amdgcn_ds_read_tr16_b64_v4i16((LAS v4i16_t*)p)); }
__device__ __forceinline__ float rowmax(const f32x16& p0, const f32x16& p1) {
  float a = max3f(p0[0], p0[1], p1[0]), b = max3f(p0[2], p0[3], p1[1]); a = max3f(a, p1[2], p1[3]);
  #pragma unroll
  for (int r = 4; r < 16; r += 4) { a = max3f(a, p0[r], p0[r + 1]); b = max3f(b, p0[r + 2], p0[r + 3]); a = max3f(a, p1[r], p1[r + 1]); b = max3f(b, p1[r + 2], p1[r + 3]); }
  const float m = max2f(a, b);
  auto rr = __builtin_amdgcn_permlane32_swap(__float_as_uint(m), __float_as_uint(m), false, false);
  return max2f(__uint_as_float(rr[0]), __uint_as_float(rr[1]));
}
__device__ __forceinline__ void pv(f32x16* o, int vb, bf16x8 pa0, bf16x8 pa1, bf16x8 pa2, bf16x8 pa3) {
  #pragma unroll
  for (int d0 = 0; d0 < 2; ++d0) { s16x4 lo[4], hi[4];
    #pragma unroll
    for (int ks = 0; ks < 4; ++ks) {
      asm volatile("ds_read_b64_tr_b16 %0,%1 offset:%c2" : "=&v"(lo[ks]) : "v"(vb), "i"(d0 * 4096 + ks * 1024) : "memory");
      asm volatile("ds_read_b64_tr_b16 %0,%1 offset:%c2" : "=&v"(hi[ks]) : "v"(vb), "i"(d0 * 4096 + ks * 1024 + 512) : "memory"); }
    asm volatile("s_waitcnt lgkmcnt(0)" ::: "memory"); SBAR();
    #define PK(k) (bf16x8){lo[k][0], lo[k][1], lo[k][2], lo[k][3], hi[k][0], hi[k][1], hi[k][2], hi[k][3]}
    o[d0] = __builtin_amdgcn_mfma_f32_32x32x16_bf16(pa0, PK(0), o[d0], 0, 0, 0);
    o[d0] = __builtin_amdgcn_mfma_f32_32x32x16_bf16(pa1, PK(1), o[d0], 0, 0, 0);
    o[d0] = __builtin_amdgcn_mfma_f32_32x32x16_bf16(pa2, PK(2), o[d0], 0, 0, 0);
    o[d0] = __builtin_amdgcn_mfma_f32_32x32x16_bf16(pa3, PK(3), o[d0], 0, 0, 0);
    #undef PK
  }
}
__device__ __forceinline__ void pv2(f32x16* o, const lds_cptr* vq, int slot, bf16x8 pa0, bf16x8 pa1, bf16x8 pa2, bf16x8 pa3) {
  #pragma unroll
  for (int d0 = 0; d0 < 2; ++d0) {
    const bf16x8 v0 = *(const LAS bf16x8*)(vq[0] + slot + d0 * 4096), v1 = *(const LAS bf16x8*)(vq[1] + slot + d0 * 4096), v2 = *(const LAS bf16x8*)(vq[2] + slot + d0 * 4096), v3 = *(const LAS bf16x8*)(vq[3] + slot + d0 * 4096);
    o[d0] = __builtin_amdgcn_mfma_f32_32x32x16_bf16(pa0, v0, o[d0], 0, 0, 0);
    o[d0] = __builtin_amdgcn_mfma_f32_32x32x16_bf16(pa1, v1, o[d0], 0, 0, 0);
    o[d0] = __builtin_amdgcn_mfma_f32_32x32x16_bf16(pa2, v2, o[d0], 0, 0, 0);
    o[d0] = __builtin_amdgcn_mfma_f32_32x32x16_bf16(pa3, v3, o[d0], 0, 0, 0);
  }
}
__device__ __forceinline__ void bandmask(f32x16& p0, f32x16& p1, int t, int mlo, unsigned mspan, int qrel, int hi) {
  const float NEG = -INFINITY; const int kb = 64 * (t - 4) - 128 + 4 * hi - qrel - mlo;
  #pragma unroll
  for (int r = 0; r < 16; ++r) { const int d0 = kb + (r & 3) + 8 * (r >> 2); if ((unsigned)d0 > mspan) p0[r] = NEG; if ((unsigned)(d0 + 32) > mspan) p1[r] = NEG; }
}
#ifndef FASTEXP
#define FASTEXP 0
#endif
__device__ __forceinline__ float exp2_fast(float x) { const float t = __builtin_fmaf(x, 8388608.0f, 1064986823.0f); unsigned u; asm("v_cvt_u32_f32 %0, %1" : "=v"(u) : "v"(t)); return __builtin_bit_cast(float, u); }
#define ATTN_STORE16(p, v) (*(u32x4*)(p) = (v))

template <int MODE, int THRL> __device__ __forceinline__ void attn_unit(long qrow, long kvrow, int q0, int qcol, int kcol, int vcol, int NT, float sink2, const bf16* Q, const bf16* __restrict__ KVb, bf16* O, char* shm) {
  int tid_ = threadIdx.x; asm volatile("" : "+v"(tid_));
  const int tid = tid_, lane = tid & 63, r32 = lane & 31, hi = lane >> 5; const int wid = __builtin_amdgcn_readfirstlane(tid >> 6);
  const bf16* Qw = Q + (qrow + wid * QBLK) * QP + qcol;
  const char* kvt = (const char*)KVb + (size_t)(kvrow >> 6) * 65536 + wid * 1024 + lane * 16;
  const unsigned lds0 = (unsigned)(uintptr_t)shm;
  float* wsf = (float*)(shm + LDS_WS) + wid * 64;
  const char* ksrc = kvt + kcol * 8192; const char* vsrc = kvt + vcol * 8192;
  const unsigned kdst = lds0 + LDS_K + wid * 1024, vdst = lds0 + LDS_V + wid * 1024;
  #define ROWOFF(t) ((long)(MODE == 1 ? ((t) + ((t) >= 4 ? ((q0 - 128) >> 6) : 0)) : (t)) * 65536)
  #define DMA_K(t, slot) glds16(ksrc + ROWOFF(t), (unsigned)__builtin_amdgcn_readfirstlane(kdst + (slot)))
  #define DMA_V(t, slot) glds16(vsrc + ROWOFF(t), (unsigned)__builtin_amdgcn_readfirstlane(vdst + (slot)))
  const char* Kbase = shm + LDS_K; bf16x8 kf[8];
  const lds_cptr shm3 = (lds_cptr)shm; const lds_cptr kp0 = shm3 + LDS_K + hi * 1024 + r32 * 16; lds_cptr vq[4];
  { const int swz = (r32 >> 1) & 7; _Pragma("unroll") for (int ks_ = 0; ks_ < 4; ++ks_) vq[ks_] = shm3 + LDS_V + r32 * 128 + (((2 * ks_ + hi) ^ swz) * 16); }
  DMA_K(0, 0); DMA_V(0, 0); DMA_K(1, SLOTB);
  bf16x8 qr[4];
  #pragma unroll
  for (int d0 = 0; d0 < 4; ++d0) qr[d0] = *reinterpret_cast<const bf16x8*>(&Qw[(long)r32 * QP + d0 * 16 + hi * 8]);
  float mhat = 0.f, l_reg = 0.f; f32x16 o[2]; o[0] = f32x16{}; o[1] = f32x16{}; f32x16 negm = f32x16{}; asm volatile("" : "+v"(negm));
  const int qrel = wid * QBLK + r32;
  int mlo = -128, mhi = 128;
  if (MODE == 1) { const int qi = q0 + qrel; mlo = (-qi > -128) ? -qi : -128; mhi = (SEQ - 1 - qi < 128) ? (SEQ - 1 - qi) : 128; }
  const unsigned mspan = (unsigned)(mhi - mlo);
  #define CMASK(P0, P1, t) do { if (MODE == 1) { if ((t) >= 4) bandmask(P0, P1, (t), mlo, mspan, qrel, hi); } } while (0)
  bool resc = false;
  #define START(P0, P1) do { const float rm = rowmax(P0, P1); resc = false; \
    { const float dl = rm; mhat = fadd_s(mhat, dl); \
      _Pragma("unroll") for (int r = 0; r < 16; ++r) { P0[r] = fsub_s(P0[r], dl); P1[r] = fsub_s(P1[r], dl); } \
      _Pragma("unroll") for (int r = 0; r < 16; ++r) negm[r] = -mhat; asm volatile("" : "+v"(negm)); } \
    _Pragma("unroll") for (int r = 0; r < 16; ++r) P0[r] = __builtin_amdgcn_exp2f(P0[r]); } while (0)
  #define RESC() do { if (resc) { asm volatile("s_waitcnt lgkmcnt(0)" ::: "memory"); \
      _Pragma("unroll") for (int d_ = 0; d_ < 2; ++d_) _Pragma("unroll") for (int r = 0; r < 16; ++r) o[d_][r] *= wsf[crow(r, hi)]; } } while (0)
  f32x16 pA0, pA1, pB0, pB1;
  int sl_prev = 0, sl_cur = 0, sl_next = SLOTB;
  #define ROT() do { sl_prev = sl_cur; sl_cur = sl_next; sl_next = (sl_next == (NSLOT - 1) * SLOTB) ? 0 : sl_next + SLOTB; } while (0)
  DMA_K(2, 2 * SLOTB);
  WAIT_BAR(3);
  qkt(pA0, pA1, Kbase, qr, negm, r32, hi); asm volatile("s_nop 15\n\ts_nop 7" : "+v"(pA0), "+v"(pA1)); CMASK(pA0, pA1, 0);
  START(pA0, pA1);
  _Pragma("unroll") for (int r = 0; r < 16; ++r) pA1[r] = __builtin_amdgcn_exp2f(pA1[r]);
  WAIT_BAR(0);
  DMA_K(3, 0); DMA_V(1, SLOTB);
  ROT();
  kload8(kf, kp0 + sl_cur);
  WAIT_BAR(2);
  bf16x8 vfr[8]; u32x4 pw0, pw1, pw2, pw3;
  #define PKW(P, B) cvtpk_s(P[B], P[B + 1])
  #define PAF(k) __builtin_bit_cast(bf16x8, pw##k)
  #define VFR(i) vfr[i]
  #define PIN(x) asm volatile("" : "+v"(x))
  #define MX3(a, b, c) __builtin_fmaxf(__builtin_fmaxf((a), (b)), (c))
  #define GAPA(MF, A0, A1, A2, A3, W0, W1, PW) do { MF; sacc += A0; sacc += A1; sacc += A2; sacc += A3; PIN(sacc); W0; W1; PIN(PW); SBAR(); } while (0)
  #define EX(v) __builtin_amdgcn_exp2f(v)
  #define GAPB(MF, X, B) do { MF; X[B] = EX(X[B]); X[B + 1] = EX(X[B + 1]); X[B + 2] = EX(X[B + 2]); X[B + 3] = EX(X[B + 3]); PIN(X); SBAR(); } while (0)
  #define VRD(i) do { vfr[i] = *(const LAS bf16x8*)(vq[(i) & 3] + vsl_ + ((i) >> 2) * 4096); } while (0)
  #define KRD(G, j) do { if (G) { kload2(kf, kp0 + sl_next, j); SBAR(); } } while (0)
  #define STEP(C0, C1, P0, P1, t, GK, GV, GL) do { SBAR(); \
    const int vsl_ = sl_prev; \
    VRD(0); SBAR(); float sacc = (P0[0] + P0[1]); \
    GAPA(C0 = __builtin_amdgcn_mfma_f32_32x32x16_bf16(kf[0], qr[0], negm, 0, 0, 0), P0[2], P0[3], P0[4], P0[5],     pw0[0] = PKW(P0, 0), pw0[1] = PKW(P0, 2), pw0); \
    VRD(4); SBAR(); GAPA(C1 = __builtin_amdgcn_mfma_f32_32x32x16_bf16(kf[1], qr[0], negm, 0, 0, 0), P0[6], P0[7], P0[8], P0[9],     pw0[2] = PKW(P0, 4), pw0[3] = PKW(P0, 6), pw0); \
    VRD(1); SBAR(); GAPA(C0 = __builtin_amdgcn_mfma_f32_32x32x16_bf16(kf[2], qr[1], C0, 0, 0, 0),   P0[10], P0[11], P0[12], P0[13], pw1[0] = PKW(P0, 8), pw1[1] = PKW(P0, 10), pw1); \
    VRD(5); SBAR(); GAPA(C1 = __builtin_amdgcn_mfma_f32_32x32x16_bf16(kf[3], qr[1], C1, 0, 0, 0),   P0[14], P0[15], P1[0], P1[1],   pw1[2] = PKW(P0, 12), pw1[3] = PKW(P0, 14), pw1); \
    VRD(2); SBAR(); GAPA(C0 = __builtin_amdgcn_mfma_f32_32x32x16_bf16(kf[4], qr[2], C0, 0, 0, 0),   P1[2], P1[3], P1[4], P1[5],     pw2[0] = PKW(P1, 0), pw2[1] = PKW(P1, 2), pw2); \
    VRD(6); SBAR(); GAPA(C1 = __builtin_amdgcn_mfma_f32_32x32x16_bf16(kf[5], qr[2], C1, 0, 0, 0),   P1[6], P1[7], P1[8], P1[9],     pw2[2] = PKW(P1, 4), pw2[3] = PKW(P1, 6), pw2); \
    VRD(3); SBAR(); GAPA(C0 = __builtin_amdgcn_mfma_f32_32x32x16_bf16(kf[6], qr[3], C0, 0, 0, 0),   P1[10], P1[11], P1[12], P1[13], pw3[0] = PKW(P1, 8), pw3[1] = PKW(P1, 10), pw3); \
    VRD(7); SBAR(); GAPA(C1 = __builtin_amdgcn_mfma_f32_32x32x16_bf16(kf[7], qr[3], C1, 0, 0, 0),   P1[14], P1[15], 0.f, 0.f,       pw3[2] = PKW(P1, 12), pw3[3] = PKW(P1, 14), pw3); \
    l_reg += sacc; \
    if (GK) { DMA_K((t) + 3, sl_cur); } if (GV) { DMA_V((t) + 1, sl_next); } \
    CMASK(C0, C1, t); \
    { float a = MX3(C0[0], C0[1], C1[0]), b = MX3(C0[2], C0[3], C1[1]); a = MX3(a, C1[2], C1[3]); \
      _Pragma("unroll") for (int r = 4; r < 16; r += 4) { a = MX3(a, C0[r], C0[r + 1]); b = MX3(b, C0[r + 2], C0[r + 3]); a = MX3(a, C1[r], C1[r + 1]); b = MX3(b, C1[r + 2], C1[r + 3]); } \
      float rm = __builtin_fmaxf(a, b); { auto rr = __builtin_amdgcn_permlane32_swap(__float_as_uint(rm), __float_as_uint(rm), false, false); rm = __builtin_fmaxf(__uint_as_float(rr[0]), __uint_as_float(rr[1])); } \
      resc = false; \
      if (__builtin_expect(__any(rm > (float)THRL), 0)) { const float dl = __builtin_fmaxf(rm, 0.f); mhat += dl; \
        _Pragma("unroll") for (int r = 0; r < 16; ++r) { C0[r] -= dl; C1[r] -= dl; } \
        _Pragma("unroll") for (int r = 0; r < 16; ++r) negm[r] = -mhat; asm volatile("" : "+v"(negm)); \
        const float f = __builtin_amdgcn_exp2f(-dl); l_reg *= f; if (hi == 0) wsf[r32] = f; resc = true; } } \
    SBAR(); \
    GAPB(o[0] = __builtin_amdgcn_mfma_f32_32x32x16_bf16(PAF(0), VFR(0), o[0], 0, 0, 0), C0, 0); \
    GAPB(o[1] = __builtin_amdgcn_mfma_f32_32x32x16_bf16(PAF(0), VFR(4), o[1], 0, 0, 0), C0, 4); \
    KRD(GL, 0); GAPB(o[0] = __builtin_amdgcn_mfma_f32_32x32x16_bf16(PAF(1), VFR(1), o[0], 0, 0, 0), C0, 8); \
    KRD(GL, 1); GAPB(o[1] = __builtin_amdgcn_mfma_f32_32x32x16_bf16(PAF(1), VFR(5), o[1], 0, 0, 0), C0, 12); \
    KRD(GL, 2); GAPB(o[0] = __builtin_amdgcn_mfma_f32_32x32x16_bf16(PAF(2), VFR(2), o[0], 0, 0, 0), C1, 0); \
    KRD(GL, 3); GAPB(o[1] = __builtin_amdgcn_mfma_f32_32x32x16_bf16(PAF(2), VFR(6), o[1], 0, 0, 0), C1, 4); \
    GAPB(o[0] = __builtin_amdgcn_mfma_f32_32x32x16_bf16(PAF(3), VFR(3), o[0], 0, 0, 0), C1, 8); \
    GAPB(o[1] = __builtin_amdgcn_mfma_f32_32x32x16_bf16(PAF(3), VFR(7), o[1], 0, 0, 0), C1, 12); \
    } while (0)
  int t = 1;
  for (; t + 5 < NT; t += 2) {
    STEP(pB0, pB1, pA0, pA1, t, true, true, true);     WAIT_BAR(2); RESC(); ROT();
    STEP(pA0, pA1, pB0, pB1, t + 1, true, true, true);   WAIT_BAR(2); RESC(); ROT();
  }
  #define ENDW(tt) do { if ((tt) + 3 < NT) { WAIT_BAR(2); } else if ((tt) + 2 < NT) { WAIT_BAR(1); } else { WAIT_BAR(0); } } while (0)
  for (; t + 1 < NT; t += 2) {
    STEP(pB0, pB1, pA0, pA1, t, (t + 3 < NT), (t + 1 < NT), (t + 1 < NT));       ENDW(t);   RESC(); ROT();
    STEP(pA0, pA1, pB0, pB1, t + 1, (t + 4 < NT), (t + 2 < NT), (t + 2 < NT));     ENDW(t + 1); RESC(); ROT();
  }
  STEP(pB0, pB1, pA0, pA1, NT - 1, false, false, false); RESC();
  { float sacc = pB0[0] + pB0[1]; _Pragma("unroll") for (int r = 2; r < 16; ++r) sacc += pB0[r]; _Pragma("unroll") for (int r = 0; r < 16; ++r) sacc += pB1[r]; l_reg += sacc;
    pw0 = (u32x4){PKW(pB0, 0), PKW(pB0, 2), PKW(pB0, 4), PKW(pB0, 6)}; pw1 = (u32x4){PKW(pB0, 8), PKW(pB0, 10), PKW(pB0, 12), PKW(pB0, 14)}; pw2 = (u32x4){PKW(pB1, 0), PKW(pB1, 2), PKW(pB1, 4), PKW(pB1, 6)}; pw3 = (u32x4){PKW(pB1, 8), PKW(pB1, 10), PKW(pB1, 12), PKW(pB1, 14)};
    SBAR(); pv2(o, vq, sl_cur, PAF(0), PAF(1), PAF(2), PAF(3)); }
  #undef PKW
  #undef PAF
  #undef VFR
  #undef PIN
  #undef MX3
  #undef GAPA
  #undef GAPB
  #undef EX
  #undef VRD
  #undef KRD
  #undef STEP
  #undef ENDW
  { auto rr = __builtin_amdgcn_permlane32_swap(__float_as_uint(l_reg), __float_as_uint(l_reg), false, false); l_reg = __uint_as_float(rr[0]) + __uint_as_float(rr[1]); }
  l_reg += __builtin_amdgcn_exp2f(sink2 - mhat);
  if (hi == 0) wsf[32 + r32] = l_reg; asm volatile("s_waitcnt lgkmcnt(0)" ::: "memory");
  float rli[16];
  #pragma unroll
  for (int r = 0; r < 16; ++r) rli[r] = __builtin_amdgcn_rcpf(wsf[32 + crow(r, hi)]);
  bf16* Ow = O + (qrow + wid * QBLK) * QP + qcol;
  { bf16* stg = (bf16*)(shm + LDS_OST) + wid * 2048;
    #pragma unroll
    for (int r = 0; r < 16; ++r) { const int orow = crow(r, hi);
      #pragma unroll
      for (int d0 = 0; d0 < 2; ++d0) stg[orow * 64 + d0 * 32 + r32] = __float2bfloat16(o[d0][r] * rli[r]); }
    asm volatile("s_waitcnt lgkmcnt(0)" ::: "memory");
    #pragma unroll
    for (int i = 0; i < 4; ++i) { const int row = i * 8 + (lane >> 3), ch = lane & 7; const u32x4 v = *(const u32x4*)(stg + row * 64 + ch * 8); ATTN_STORE16(Ow + (long)row * QP + ch * 8, v); } }
  asm volatile("s_waitcnt lgkmcnt(0)\n\ts_barrier" ::: "memory");
  #undef DMA_K
  #undef DMA_V
  #undef ROWOFF
  #undef CMASK
  #undef START
  #undef RESC
  #undef ROT
}
template <int MODE, int XV = 0> __device__ __forceinline__ void attn_unit_sb(long qrow, long kvrow, int q0, int qcol, int kcol, int vcol, int NT, float sink2, float bound, const bf16* Q, const bf16* __restrict__ KVb, bf16* O, char* shm) {
  int tid_ = threadIdx.x; asm volatile("" : "+v"(tid_));
  const int tid = tid_, lane = tid & 63, r32 = lane & 31, hi = lane >> 5; const int wid = __builtin_amdgcn_readfirstlane(tid >> 6);
  const bf16* Qw = Q + (qrow + wid * QBLK) * QP + qcol;
  const char* kvt = (const char*)KVb + (size_t)(kvrow >> 6) * 65536 + wid * 1024 + lane * 16;
  const unsigned lds0 = (unsigned)(uintptr_t)shm;
  const char* ksrc = kvt + kcol * 8192; const char* vsrc = kvt + vcol * 8192;
  const unsigned kdst = lds0 + LDS_K + wid * 1024, vdst = lds0 + LDS_V + wid * 1024;
  #define ROWOFF(t) ((long)(MODE == 1 ? ((t) + ((t) >= 4 ? ((q0 - 128) >> 6) : 0)) : (t)) * 65536)
  #define DMA_K(t, slot) glds16(ksrc + ROWOFF(t), (unsigned)__builtin_amdgcn_readfirstlane(kdst + (slot)))
  #define DMA_V(t, slot) glds16(vsrc + ROWOFF(t), (unsigned)__builtin_amdgcn_readfirstlane(vdst + (slot)))
  const char* Kbase = shm + LDS_K; bf16x8 kf[8];
  const lds_cptr shm3 = (lds_cptr)shm; const lds_cptr kp0 = shm3 + LDS_K + hi * 1024 + r32 * 16; lds_cptr vq[4];
  { const int swz = (r32 >> 1) & 7; _Pragma("unroll") for (int ks_ = 0; ks_ < 4; ++ks_) vq[ks_] = shm3 + LDS_V + r32 * 128 + (((2 * ks_ + hi) ^ swz) * 16); }
  DMA_K(0, 0); DMA_V(0, 0); DMA_K(1, SLOTB);
  bf16x8 qr[4];
  #pragma unroll
  for (int d0 = 0; d0 < 4; ++d0) qr[d0] = *reinterpret_cast<const bf16x8*>(&Qw[(long)r32 * QP + d0 * 16 + hi * 8]);
  f32x16 o[2]; o[0] = f32x16{}; o[1] = f32x16{}; f32x16 osum = f32x16{};
  const f32x16 negm = f32x16{};
  bf16x8 ones;
  #pragma unroll
  for (int i = 0; i < 8; ++i) ones[i] = (short)0x3F80;
  asm volatile("" : "+v"(ones));
  const int qrel = wid * QBLK + r32;
  int mlo = -128, mhi = 128;
  if (MODE == 1) { const int qi = q0 + qrel; mlo = (-qi > -128) ? -qi : -128; mhi = (SEQ - 1 - qi < 128) ? (SEQ - 1 - qi) : 128; }
  const unsigned mspan = (unsigned)(mhi - mlo);
  #define CMASK(P0, P1, t) do { if (MODE == 1) { if ((t) >= 4) bandmask(P0, P1, (t), mlo, mspan, qrel, hi); } } while (0)
  f32x16 pA0, pA1, pB0, pB1;
  int sl_prev = 0, sl_cur = 0, sl_next = SLOTB;
  #define ROT() do { sl_prev = sl_cur; sl_cur = sl_next; sl_next = (sl_next == (NSLOT - 1) * SLOTB) ? 0 : sl_next + SLOTB; } while (0)
  DMA_K(2, 2 * SLOTB);
  WAIT_BAR(3);
  qkt(pA0, pA1, Kbase, qr, negm, r32, hi); asm volatile("s_nop 15\n\ts_nop 7" : "+v"(pA0), "+v"(pA1)); CMASK(pA0, pA1, 0);
  _Pragma("unroll") for (int r = 0; r < 16; ++r) { pA0[r] = __builtin_amdgcn_exp2f(pA0[r]); pA1[r] = __builtin_amdgcn_exp2f(pA1[r]); }
  WAIT_BAR(0);
  DMA_K(3, 0); DMA_V(1, SLOTB);
  ROT();
  kload8(kf, kp0 + sl_cur);
  WAIT_BAR(2);
  bf16x8 vfr[8]; u32x4 pw0, pw1, pw2, pw3;
  #define PKW(P, B) cvtpk_s(P[B], P[B + 1])
  #define PAF(k) __builtin_bit_cast(bf16x8, pw##k)
  #define VFR(i) vfr[i]
  #define PIN(x) asm volatile("" : "+v"(x))
  #define GAPA(MF, W0, W1, PW) do { MF; W0; W1; PIN(PW); SBAR(); } while (0)
  #define OSUM(k) do { if (XV != 5) osum = __builtin_amdgcn_mfma_f32_32x32x16_bf16(PAF(k), ones, osum, 0, 0, 0); SBAR(); } while (0)
  #define EX(v) (XV == 2 ? (v) : (FASTEXP ? exp2_fast(v) : __builtin_amdgcn_exp2f(v)))
  #define GAPB(MF, X, B) do { MF; X[B] = EX(X[B]); X[B + 1] = EX(X[B + 1]); X[B + 2] = EX(X[B + 2]); X[B + 3] = EX(X[B + 3]); PIN(X); SBAR(); } while (0)
  #define VRD(i) do { if (XV == 3) break; vfr[i] = *(const LAS bf16x8*)(vq[(i) & 3] + vsl_ + ((i) >> 2) * 4096); } while (0)
  #define KRD(G, j) do { if ((G) && XV != 3) { kload2(kf, kp0 + sl_next, j); SBAR(); } } while (0)
  #define STEP(C0, C1, P0, P1, t, GK, GV, GL) do { SBAR(); \
    const int vsl_ = sl_prev; \
    VRD(0); SBAR(); GAPA(C0 = __builtin_amdgcn_mfma_f32_32x32x16_bf16(kf[0], qr[0], negm, 0, 0, 0), pw0[0] = PKW(P0, 0), pw0[1] = PKW(P0, 2), pw0); \
    VRD(4); SBAR(); GAPA(C1 = __builtin_amdgcn_mfma_f32_32x32x16_bf16(kf[1], qr[0], negm, 0, 0, 0), pw0[2] = PKW(P0, 4), pw0[3] = PKW(P0, 6), pw0); \
    VRD(1); SBAR(); GAPA(C0 = __builtin_amdgcn_mfma_f32_32x32x16_bf16(kf[2], qr[1], C0, 0, 0, 0),   pw1[0] = PKW(P0, 8), pw1[1] = PKW(P0, 10), pw1); \
    OSUM(0); \
    VRD(5); SBAR(); GAPA(C1 = __builtin_amdgcn_mfma_f32_32x32x16_bf16(kf[3], qr[1], C1, 0, 0, 0),   pw1[2] = PKW(P0, 12), pw1[3] = PKW(P0, 14), pw1); \
    VRD(2); SBAR(); GAPA(C0 = __builtin_amdgcn_mfma_f32_32x32x16_bf16(kf[4], qr[2], C0, 0, 0, 0),   pw2[0] = PKW(P1, 0), pw2[1] = PKW(P1, 2), pw2); \
    OSUM(1); \
    VRD(6); SBAR(); GAPA(C1 = __builtin_amdgcn_mfma_f32_32x32x16_bf16(kf[5], qr[2], C1, 0, 0, 0),   pw2[2] = PKW(P1, 4), pw2[3] = PKW(P1, 6), pw2); \
    VRD(3); SBAR(); GAPA(C0 = __builtin_amdgcn_mfma_f32_32x32x16_bf16(kf[6], qr[3], C0, 0, 0, 0),   pw3[0] = PKW(P1, 8), pw3[1] = PKW(P1, 10), pw3); \
    OSUM(2); \
    VRD(7); SBAR(); GAPA(C1 = __builtin_amdgcn_mfma_f32_32x32x16_bf16(kf[7], qr[3], C1, 0, 0, 0),   pw3[2] = PKW(P1, 12), pw3[3] = PKW(P1, 14), pw3); \
    if (XV != 1) { if (GK) { DMA_K((t) + 3, sl_cur); } if (GV) { DMA_V((t) + 1, sl_next); } } \
    OSUM(3); \
    CMASK(C0, C1, t); \
    SBAR(); \
    GAPB(o[0] = __builtin_amdgcn_mfma_f32_32x32x16_bf16(PAF(0), VFR(0), o[0], 0, 0, 0), C0, 0); \
    GAPB(o[1] = __builtin_amdgcn_mfma_f32_32x32x16_bf16(PAF(0), VFR(4), o[1], 0, 0, 0), C0, 4); \
    KRD(GL, 0); GAPB(o[0] = __builtin_amdgcn_mfma_f32_32x32x16_bf16(PAF(1), VFR(1), o[0], 0, 0, 0), C0, 8); \
    KRD(GL, 1); GAPB(o[1] = __builtin_amdgcn_mfma_f32_32x32x16_bf16(PAF(1), VFR(5), o[1], 0, 0, 0), C0, 12); \
    KRD(GL, 2); GAPB(o[0] = __builtin_amdgcn_mfma_f32_32x32x16_bf16(PAF(2), VFR(2), o[0], 0, 0, 0), C1, 0); \
    KRD(GL, 3); GAPB(o[1] = __builtin_amdgcn_mfma_f32_32x32x16_bf16(PAF(2), VFR(6), o[1], 0, 0, 0), C1, 4); \
    GAPB(o[0] = __builtin_amdgcn_mfma_f32_32x32x16_bf16(PAF(3), VFR(3), o[0], 0, 0, 0), C1, 8); \
    GAPB(o[1] = __builtin_amdgcn_mfma_f32_32x32x16_bf16(PAF(3), VFR(7), o[1], 0, 0, 0), C1, 12); \
    } while (0)
  int t = 1;
  for (; t + 5 < NT; t += 2) {
    STEP(pB0, pB1, pA0, pA1, t, true, true, true);     WAIT_BAR(2); ROT();
    STEP(pA0, pA1, pB0, pB1, t + 1, true, true, true);   WAIT_BAR(2); ROT();
  }
  #define ENDW(tt) do { if ((tt) + 3 < NT) { WAIT_BAR(2); } else if ((tt) + 2 < NT) { WAIT_BAR(1); } else { WAIT_BAR(0); } } while (0)
  for (; t + 1 < NT; t += 2) {
    STEP(pB0, pB1, pA0, pA1, t, (t + 3 < NT), (t + 1 < NT), (t + 1 < NT));       ENDW(t);   ROT();
    STEP(pA0, pA1, pB0, pB1, t + 1, (t + 4 < NT), (t + 2 < NT), (t + 2 < NT));     ENDW(t + 1); ROT();
  }
  STEP(pB0, pB1, pA0, pA1, NT - 1, false, false, false);
  { pw0 = (u32x4){PKW(pB0, 0), PKW(pB0, 2), PKW(pB0, 4), PKW(pB0, 6)}; pw1 = (u32x4){PKW(pB0, 8), PKW(pB0, 10), PKW(pB0, 12), PKW(pB0, 14)}; pw2 = (u32x4){PKW(pB1, 0), PKW(pB1, 2), PKW(pB1, 4), PKW(pB1, 6)}; pw3 = (u32x4){PKW(pB1, 8), PKW(pB1, 10), PKW(pB1, 12), PKW(pB1, 14)};
    SBAR(); OSUM(0); OSUM(1); OSUM(2); OSUM(3); pv2(o, vq, sl_cur, PAF(0), PAF(1), PAF(2), PAF(3)); }
  #undef PKW
  #undef PAF
  #undef VFR
  #undef PIN
  #undef GAPA
  #undef OSUM
  #undef GAPB
  #undef EX
  #undef VRD
  #undef KRD
  #undef STEP
  #undef ENDW
  const float sterm = __builtin_amdgcn_exp2f(sink2);
  float rli[16];
  #pragma unroll
  for (int r = 0; r < 16; ++r) rli[r] = __builtin_amdgcn_rcpf(osum[r] + sterm);
  bf16* Ow = O + (qrow + wid * QBLK) * QP + qcol;
  { bf16* stg = (bf16*)(shm + LDS_OST) + wid * 2048;
    #pragma unroll
    for (int r = 0; r < 16; ++r) { const int orow = crow(r, hi);
      #pragma unroll
      for (int d0 = 0; d0 < 2; ++d0) stg[orow * 64 + d0 * 32 + r32] = __float2bfloat16(o[d0][r] * rli[r]); }
    asm volatile("s_waitcnt lgkmcnt(0)" ::: "memory");
    #pragma unroll
    for (int i = 0; i < 4; ++i) { const int row = i * 8 + (lane >> 3), ch = lane & 7; const u32x4 v = *(const u32x4*)(stg + row * 64 + ch * 8); ATTN_STORE16(Ow + (long)row * QP + ch * 8, v); } }
  asm volatile("s_waitcnt lgkmcnt(0)\n\ts_barrier" ::: "memory");
  #undef DMA_K
  #undef DMA_V
  #undef ROWOFF
  #undef CMASK
  #undef ROT
}
template <int MODE> __device__ __forceinline__ void attn_unit_sk(long qrow, long kvrow, int q0, int qcol, int kcol, int vcol, int NT, float sink2, float bound, const bf16* Q, const bf16* __restrict__ KVb, bf16* O, char* shm) {
  int tid_ = threadIdx.x; asm volatile("" : "+v"(tid_));
  const int tid = tid_, lane = tid & 63, r32 = lane & 31, hi = lane >> 5; const int wid = __builtin_amdgcn_readfirstlane(tid >> 6);
  const bf16* Qw = Q + (qrow + wid * QBLK) * QP + qcol;
  const char* kvt = (const char*)KVb + (size_t)(kvrow >> 6) * 65536 + wid * 1024 + lane * 16;
  constexpr int NSL = 4, LK = 0, LV = NSL * SLOTB, LOST = 2 * NSL * SLOTB + NW * 64 * 4;
  const unsigned lds0 = (unsigned)(uintptr_t)shm;
  const char* ksrc = kvt + kcol * 8192; const char* vsrc = kvt + vcol * 8192;
  const unsigned kdst = lds0 + LK + wid * 1024, vdst = lds0 + LV + wid * 1024;
  #define ROWOFF(t) ((long)(MODE == 1 ? ((t) + ((t) >= 4 ? ((q0 - 128) >> 6) : 0)) : (t)) * 65536)
  #define DMA_K(t, slot) glds16(ksrc + ROWOFF(t), (unsigned)__builtin_amdgcn_readfirstlane(kdst + (slot)))
  #define DMA_V(t, slot) glds16(vsrc + ROWOFF(t), (unsigned)__builtin_amdgcn_readfirstlane(vdst + (slot)))
  const char* Kbase = shm + LK; bf16x8 kf[8];
  const lds_cptr shm3 = (lds_cptr)shm; const lds_cptr kp0 = shm3 + LK + hi * 1024 + r32 * 16; lds_cptr vq[4];
  { const int swz = (r32 >> 1) & 7; _Pragma("unroll") for (int ks_ = 0; ks_ < 4; ++ks_) vq[ks_] = shm3 + LV + r32 * 128 + (((2 * ks_ + hi) ^ swz) * 16); }
  DMA_K(0, 0); DMA_V(0, 0); DMA_K(1, SLOTB);
  bf16x8 qr[4];
  #pragma unroll
  for (int d0 = 0; d0 < 4; ++d0) qr[d0] = *reinterpret_cast<const bf16x8*>(&Qw[(long)r32 * QP + d0 * 16 + hi * 8]);
  f32x16 o[2]; o[0] = f32x16{}; o[1] = f32x16{}; f32x16 osum = f32x16{};
  const f32x16 negm = f32x16{};
  bf16x8 ones;
  #pragma unroll
  for (int i = 0; i < 8; ++i) ones[i] = (short)0x3F80;
  asm volatile("" : "+v"(ones));
  const int qrel = wid * QBLK + r32;
  int mlo = -128, mhi = 128;
  if (MODE == 1) { const int qi = q0 + qrel; mlo = (-qi > -128) ? -qi : -128; mhi = (SEQ - 1 - qi < 128) ? (SEQ - 1 - qi) : 128; }
  const unsigned mspan = (unsigned)(mhi - mlo);
  #define CMASK(P0, P1, t) do { if (MODE == 1) { if ((t) >= 4) bandmask(P0, P1, (t), mlo, mspan, qrel, hi); } } while (0)
  f32x16 pA0, pA1, pB0, pB1;
  int sl_prev = 0, sl_cur = 0, sl_next = SLOTB;
  #define ROT() do { sl_prev = sl_cur; sl_cur = sl_next; sl_next = (sl_next == (NSL - 1) * SLOTB) ? 0 : sl_next + SLOTB; } while (0)
  DMA_K(2, 2 * SLOTB);
  WAIT_BAR(3);
  qkt(pA0, pA1, Kbase, qr, negm, r32, hi); asm volatile("s_nop 15\n\ts_nop 7" : "+v"(pA0), "+v"(pA1)); CMASK(pA0, pA1, 0);
  _Pragma("unroll") for (int r = 0; r < 16; ++r) { pA0[r] = __builtin_amdgcn_exp2f(pA0[r]); pA1[r] = __builtin_amdgcn_exp2f(pA1[r]); }
  WAIT_BAR(0);
  DMA_V(1, SLOTB); DMA_K(3, 3 * SLOTB); DMA_V(2, 2 * SLOTB); if (4 < NT) { DMA_K(4, 0); }
  ROT();
  kload8(kf, kp0 + sl_cur);
  WAIT_BAR(4);
  if (wid >= 4) asm volatile("s_barrier" ::: "memory");
  bf16x8 vfr[8]; u32x4 pw0, pw1, pw2, pw3;
  #define PKW(P, B) cvtpk_s(P[B], P[B + 1])
  #define PAF(k) __builtin_bit_cast(bf16x8, pw##k)
  #define VFR(i) vfr[i]
  #define PIN(x) asm volatile("" : "+v"(x))
  #define GAPA(MF, W0, W1, PW) do { MF; W0; W1; PIN(PW); SBAR(); } while (0)
  #define OSUM(k) do { osum = __builtin_amdgcn_mfma_f32_32x32x16_bf16(PAF(k), ones, osum, 0, 0, 0); SBAR(); } while (0)
  #define EX(v) (FASTEXP ? exp2_fast(v) : __builtin_amdgcn_exp2f(v))
  #define GAPB(MF, X, B) do { MF; X[B] = EX(X[B]); X[B + 1] = EX(X[B + 1]); X[B + 2] = EX(X[B + 2]); X[B + 3] = EX(X[B + 3]); PIN(X); SBAR(); } while (0)
  #define VRD(i) do { vfr[i] = *(const LAS bf16x8*)(vq[(i) & 3] + vsl_ + ((i) >> 2) * 4096); } while (0)
  #define KRD(G, j) do { if (G) { kload2(kf, kp0 + sl_next, j); SBAR(); } } while (0)
  #define STEP(C0, C1, P0, P1, t, GK, GV, GL, WMID) do { SBAR(); \
    const int vsl_ = sl_prev; \
    VRD(0); SBAR(); GAPA(C0 = __builtin_amdgcn_mfma_f32_32x32x16_bf16(kf[0], qr[0], negm, 0, 0, 0), pw0[0] = PKW(P0, 0), pw0[1] = PKW(P0, 2), pw0); \
    VRD(4); SBAR(); GAPA(C1 = __builtin_amdgcn_mfma_f32_32x32x16_bf16(kf[1], qr[0], negm, 0, 0, 0), pw0[2] = PKW(P0, 4), pw0[3] = PKW(P0, 6), pw0); \
    VRD(1); SBAR(); GAPA(C0 = __builtin_amdgcn_mfma_f32_32x32x16_bf16(kf[2], qr[1], C0, 0, 0, 0),   pw1[0] = PKW(P0, 8), pw1[1] = PKW(P0, 10), pw1); \
    OSUM(0); \
    VRD(5); SBAR(); GAPA(C1 = __builtin_amdgcn_mfma_f32_32x32x16_bf16(kf[3], qr[1], C1, 0, 0, 0),   pw1[2] = PKW(P0, 12), pw1[3] = PKW(P0, 14), pw1); \
    VRD(2); SBAR(); GAPA(C0 = __builtin_amdgcn_mfma_f32_32x32x16_bf16(kf[4], qr[2], C0, 0, 0, 0),   pw2[0] = PKW(P1, 0), pw2[1] = PKW(P1, 2), pw2); \
    OSUM(1); \
    VRD(6); SBAR(); GAPA(C1 = __builtin_amdgcn_mfma_f32_32x32x16_bf16(kf[5], qr[2], C1, 0, 0, 0),   pw2[2] = PKW(P1, 4), pw2[3] = PKW(P1, 6), pw2); \
    VRD(3); SBAR(); GAPA(C0 = __builtin_amdgcn_mfma_f32_32x32x16_bf16(kf[6], qr[3], C0, 0, 0, 0),   pw3[0] = PKW(P1, 8), pw3[1] = PKW(P1, 10), pw3); \
    OSUM(2); \
    VRD(7); SBAR(); GAPA(C1 = __builtin_amdgcn_mfma_f32_32x32x16_bf16(kf[7], qr[3], C1, 0, 0, 0),   pw3[2] = PKW(P1, 12), pw3[3] = PKW(P1, 14), pw3); \
    OSUM(3); \
    CMASK(C0, C1, t); \
    SBAR(); \
    WMID; \
    if (GV) { DMA_V((t) + 2, (sl_next == (NSL - 1) * SLOTB) ? 0 : sl_next + SLOTB); } if (GK) { DMA_K((t) + 4, sl_cur); } \
    SBAR(); \
    GAPB(o[0] = __builtin_amdgcn_mfma_f32_32x32x16_bf16(PAF(0), VFR(0), o[0], 0, 0, 0), C0, 0); \
    GAPB(o[1] = __builtin_amdgcn_mfma_f32_32x32x16_bf16(PAF(0), VFR(4), o[1], 0, 0, 0), C0, 4); \
    KRD(GL, 0); GAPB(o[0] = __builtin_amdgcn_mfma_f32_32x32x16_bf16(PAF(1), VFR(1), o[0], 0, 0, 0), C0, 8); \
    KRD(GL, 1); GAPB(o[1] = __builtin_amdgcn_mfma_f32_32x32x16_bf16(PAF(1), VFR(5), o[1], 0, 0, 0), C0, 12); \
    KRD(GL, 2); GAPB(o[0] = __builtin_amdgcn_mfma_f32_32x32x16_bf16(PAF(2), VFR(2), o[0], 0, 0, 0), C1, 0); \
    KRD(GL, 3); GAPB(o[1] = __builtin_amdgcn_mfma_f32_32x32x16_bf16(PAF(2), VFR(6), o[1], 0, 0, 0), C1, 4); \
    GAPB(o[0] = __builtin_amdgcn_mfma_f32_32x32x16_bf16(PAF(3), VFR(3), o[0], 0, 0, 0), C1, 8); \
    GAPB(o[1] = __builtin_amdgcn_mfma_f32_32x32x16_bf16(PAF(3), VFR(7), o[1], 0, 0, 0), C1, 12); \
    } while (0)
  int t = 1;
  for (; t + 5 < NT; t += 2) {
    STEP(pB0, pB1, pA0, pA1, t, true, true, true, WAIT_BAR(3));     WAIT_BAR(4); ROT();
    STEP(pA0, pA1, pB0, pB1, t + 1, true, true, true, WAIT_BAR(3));   WAIT_BAR(4); ROT();
  }
  for (; t + 1 < NT; t += 2) {
    STEP(pB0, pB1, pA0, pA1, t, (t + 4 < NT), (t + 2 < NT), (t + 1 < NT), WAIT_BAR(0));       WAIT_BAR(0); ROT();
    STEP(pA0, pA1, pB0, pB1, t + 1, (t + 5 < NT), (t + 3 < NT), (t + 2 < NT), WAIT_BAR(0));     WAIT_BAR(0); ROT();
  }
  STEP(pB0, pB1, pA0, pA1, NT - 1, false, false, false, WAIT_BAR(0));
  if (wid < 4) { WAIT_BAR(0); }
  { pw0 = (u32x4){PKW(pB0, 0), PKW(pB0, 2), PKW(pB0, 4), PKW(pB0, 6)}; pw1 = (u32x4){PKW(pB0, 8), PKW(pB0, 10), PKW(pB0, 12), PKW(pB0, 14)}; pw2 = (u32x4){PKW(pB1, 0), PKW(pB1, 2), PKW(pB1, 4), PKW(pB1, 6)}; pw3 = (u32x4){PKW(pB1, 8), PKW(pB1, 10), PKW(pB1, 12), PKW(pB1, 14)};
    SBAR(); OSUM(0); OSUM(1); OSUM(2); OSUM(3); pv2(o, vq, sl_cur, PAF(0), PAF(1), PAF(2), PAF(3)); }
  #undef PKW
  #undef PAF
  #undef VFR
  #undef PIN
  #undef GAPA
  #undef OSUM
  #undef GAPB
  #undef EX
  #undef VRD
  #undef KRD
  #undef STEP
  const float sterm = __builtin_amdgcn_exp2f(sink2);
  float rli[16];
  #pragma unroll
  for (int r = 0; r < 16; ++r) rli[r] = __builtin_amdgcn_rcpf(osum[r] + sterm);
  bf16* Ow = O + (qrow + wid * QBLK) * QP + qcol;
  { bf16* stg = (bf16*)(shm + LOST) + wid * 2048;
    #pragma unroll
    for (int r = 0; r < 16; ++r) { const int orow = crow(r, hi);
      #pragma unroll
      for (int d0 = 0; d0 < 2; ++d0) stg[orow * 64 + d0 * 32 + r32] = __float2bfloat16(o[d0][r] * rli[r]); }
    asm volatile("s_waitcnt lgkmcnt(0)" ::: "memory");
    #pragma unroll
    for (int i = 0; i < 4; ++i) { const int row = i * 8 + (lane >> 3), ch = lane & 7; const u32x4 v = *(const u32x4*)(stg + row * 64 + ch * 8); ATTN_STORE16(Ow + (long)row * QP + ch * 8, v); } }
  asm volatile("s_waitcnt lgkmcnt(0)\n\ts_barrier" ::: "memory");
  #undef DMA_K
  #undef DMA_V
  #undef ROWOFF
  #undef CMASK
  #undef ROT
}
typedef int v8i_t __attribute__((ext_vector_type(8)));
typedef int v4i_t __attribute__((ext_vector_type(4)));
template <int MODE, int XV = 0> __device__ __forceinline__ void attn_unit_f8(long qrow, long kvrow, int q0, int qcol, int kst, int vst, int NT, float sink2, float ref, const unsigned char* Qf8, const unsigned char* KVT, bf16* O, char* shm) {
  int tid_ = threadIdx.x; asm volatile("" : "+v"(tid_));
  const int tid = tid_, lane = tid & 63, r32 = lane & 31, hi = lane >> 5; const int wid = __builtin_amdgcn_readfirstlane(tid >> 6);
  constexpr int KSL = 4096, VSL = 8192, LK = 0, LV = 3 * KSL, LOST = LV + 3 * VSL, TILEB = 49152;
  const unsigned lds0 = (unsigned)(uintptr_t)shm;
  const unsigned char* tile0 = KVT + (size_t)(kvrow >> 6) * TILEB;
  const unsigned char* ksrc = tile0 + kst * KSL + wid * 512 + (lane & 31) * 16;
  const unsigned char* vsrc = tile0 + 4 * KSL + vst * VSL + wid * 1024 + lane * 16;
  const unsigned kdst = lds0 + LK + wid * 512, vdst = lds0 + LV + wid * 1024;
  #define ROWOFF(t) ((long)(MODE == 1 ? ((t) + ((t) >= 4 ? ((q0 - 128) >> 6) : 0)) : (t)) * TILEB)
  #define DMA_K(t, kslot) do { if (lane < 32) glds16(ksrc + ROWOFF(t), (unsigned)__builtin_amdgcn_readfirstlane(kdst + (kslot))); } while (0)
  #define DMA_V(t, vslot) glds16(vsrc + ROWOFF(t), (unsigned)__builtin_amdgcn_readfirstlane(vdst + (vslot)))
  const lds_cptr shm3 = (lds_cptr)shm;
  const int ksw = (r32 >> 2) & 3;
  const lds_cptr kq0 = shm3 + LK + r32 * 64 + (((2 * hi) ^ ksw) * 16), kq1 = shm3 + LK + r32 * 64 + (((2 * hi + 1) ^ ksw) * 16);
  lds_cptr vq[4];
  { const int swz = (r32 >> 1) & 7; _Pragma("unroll") for (int ks_ = 0; ks_ < 4; ++ks_) vq[ks_] = shm3 + LV + r32 * 128 + (((2 * ks_ + hi) ^ swz) * 16); }
  DMA_K(0, 0); DMA_V(0, 0); DMA_K(1, KSL);
  v8i_t qf;
  { const v4i_t* qp = (const v4i_t*)(Qf8 + (size_t)(qrow + wid * QBLK + r32) * 1024 + qcol + hi * 32); const v4i_t a = qp[0], b = qp[1]; qf = (v8i_t){a[0], a[1], a[2], a[3], b[0], b[1], b[2], b[3]}; }
  f32x16 o[2]; o[0] = f32x16{}; o[1] = f32x16{}; f32x16 osum = f32x16{};
  f32x16 negm;
  #pragma unroll
  for (int r = 0; r < 16; ++r) negm[r] = -ref;
  asm volatile("" : "+v"(negm));
  bf16x8 ones;
  #pragma unroll
  for (int i = 0; i < 8; ++i) ones[i] = (short)0x3F80;
  asm volatile("" : "+v"(ones));
  const int qrel = wid * QBLK + r32;
  int mlo = -128, mhi = 128;
  if (MODE == 1) { const int qi = q0 + qrel; mlo = (-qi > -128) ? -qi : -128; mhi = (SEQ - 1 - qi < 128) ? (SEQ - 1 - qi) : 128; }
  const unsigned mspan = (unsigned)(mhi - mlo);
  #define CMASK(P0, P1, t) do { if (MODE == 1) { if ((t) >= 4) bandmask(P0, P1, (t), mlo, mspan, qrel, hi); } } while (0)
  #define MF8(kfr, cin) __builtin_amdgcn_mfma_scale_f32_32x32x64_f8f6f4(kfr, qf, cin, 0, 0, 0, 0x7F7F7F7F, 0, 0x7F7F7F7F)
  #define KLOAD(dst, b, kslot) do { const v4i_t a_ = *(const LAS v4i_t*)(kq0 + (kslot) + (b) * 2048), b_ = *(const LAS v4i_t*)(kq1 + (kslot) + (b) * 2048); dst = (v8i_t){a_[0], a_[1], a_[2], a_[3], b_[0], b_[1], b_[2], b_[3]}; } while (0)
  f32x16 pA0, pA1, pB0, pB1;
  int sl_prev = 0, sl_cur = 0, sl_next = VSL;
  #define ROT() do { sl_prev = sl_cur; sl_cur = sl_next; sl_next = (sl_next == 2 * VSL) ? 0 : sl_next + VSL; } while (0)
  DMA_K(2, 2 * KSL);
  WAIT_BAR(3);
  v8i_t kf0, kf1;
  KLOAD(kf0, 0, 0); KLOAD(kf1, 1, 0);
  pA0 = MF8(kf0, negm); pA1 = MF8(kf1, negm);
  asm volatile("s_nop 15\n\ts_nop 7" : "+v"(pA0), "+v"(pA1)); CMASK(pA0, pA1, 0);
  _Pragma("unroll") for (int r = 0; r < 16; ++r) { pA0[r] = __builtin_amdgcn_exp2f(pA0[r]); pA1[r] = __builtin_amdgcn_exp2f(pA1[r]); }
  WAIT_BAR(0);
  DMA_K(3, 0); DMA_V(1, VSL);
  ROT();
  KLOAD(kf0, 0, sl_cur >> 1); KLOAD(kf1, 1, sl_cur >> 1);
  WAIT_BAR(2);
  bf16x8 vfr[8]; u32x4 pw0, pw1, pw2, pw3;
  #define PKW(P, B) cvtpk_s(P[B], P[B + 1])
  #define PAF(k) __builtin_bit_cast(bf16x8, pw##k)
  #define VFR(i) vfr[i]
  #define PIN(x) asm volatile("" : "+v"(x))
  #define OSUM(k) do { if (XV != 5) osum = __builtin_amdgcn_mfma_f32_32x32x16_bf16(PAF(k), ones, osum, 0, 0, 0); SBAR(); } while (0)
  #define EX(v) __builtin_amdgcn_exp2f(v)
  #define GAPB(MF, X, B) do { MF; X[B] = EX(X[B]); X[B + 1] = EX(X[B + 1]); X[B + 2] = EX(X[B + 2]); X[B + 3] = EX(X[B + 3]); PIN(X); SBAR(); } while (0)
  #define VRD(i) do { vfr[i] = *(const LAS bf16x8*)(vq[(i) & 3] + vsl_ + ((i) >> 2) * 4096); } while (0)
  #define STEP(C0, C1, P0, P1, t, GK, GV, GL) do { SBAR(); \
    const int vsl_ = sl_prev; \
    VRD(0); VRD(4); SBAR(); \
    C0 = MF8(kf0, negm); pw0[0] = PKW(P0, 0); pw0[1] = PKW(P0, 2); pw0[2] = PKW(P0, 4); pw0[3] = PKW(P0, 6); PIN(pw0); SBAR(); \
    VRD(1); VRD(5); SBAR(); \
    C1 = MF8(kf1, negm); pw1[0] = PKW(P0, 8); pw1[1] = PKW(P0, 10); pw1[2] = PKW(P0, 12); pw1[3] = PKW(P0, 14); PIN(pw1); SBAR(); \
    VRD(2); VRD(6); SBAR(); \
    OSUM(0); pw2[0] = PKW(P1, 0); pw2[1] = PKW(P1, 2); pw2[2] = PKW(P1, 4); pw2[3] = PKW(P1, 6); PIN(pw2); SBAR(); \
    VRD(3); VRD(7); SBAR(); \
    OSUM(1); pw3[0] = PKW(P1, 8); pw3[1] = PKW(P1, 10); pw3[2] = PKW(P1, 12); pw3[3] = PKW(P1, 14); PIN(pw3); SBAR(); \
    OSUM(2); \
    if (GK) { DMA_K((t) + 3, sl_cur >> 1); } if (GV) { DMA_V((t) + 1, sl_next); } \
    OSUM(3); \
    CMASK(C0, C1, t); \
    SBAR(); \
    GAPB(o[0] = __builtin_amdgcn_mfma_f32_32x32x16_bf16(PAF(0), VFR(0), o[0], 0, 0, 0), C0, 0); \
    GAPB(o[1] = __builtin_amdgcn_mfma_f32_32x32x16_bf16(PAF(0), VFR(4), o[1], 0, 0, 0), C0, 4); \
    if (GL) { KLOAD(kf0, 0, sl_next >> 1); SBAR(); } \
    GAPB(o[0] = __builtin_amdgcn_mfma_f32_32x32x16_bf16(PAF(1), VFR(1), o[0], 0, 0, 0), C0, 8); \
    GAPB(o[1] = __builtin_amdgcn_mfma_f32_32x32x16_bf16(PAF(1), VFR(5), o[1], 0, 0, 0), C0, 12); \
    if (GL) { KLOAD(kf1, 1, sl_next >> 1); SBAR(); } \
    GAPB(o[0] = __builtin_amdgcn_mfma_f32_32x32x16_bf16(PAF(2), VFR(2), o[0], 0, 0, 0), C1, 0); \
    GAPB(o[1] = __builtin_amdgcn_mfma_f32_32x32x16_bf16(PAF(2), VFR(6), o[1], 0, 0, 0), C1, 4); \
    GAPB(o[0] = __builtin_amdgcn_mfma_f32_32x32x16_bf16(PAF(3), VFR(3), o[0], 0, 0, 0), C1, 8); \
    GAPB(o[1] = __builtin_amdgcn_mfma_f32_32x32x16_bf16(PAF(3), VFR(7), o[1], 0, 0, 0), C1, 12); \
    } while (0)
  int t = 1;
  for (; t + 5 < NT; t += 2) {
    STEP(pB0, pB1, pA0, pA1, t, true, true, true);     WAIT_BAR(2); ROT();
    STEP(pA0, pA1, pB0, pB1, t + 1, true, true, true);   WAIT_BAR(2); ROT();
  }
  #define ENDW(tt) do { if ((tt) + 3 < NT) { WAIT_BAR(2); } else if ((tt) + 2 < NT) { WAIT_BAR(1); } else { WAIT_BAR(0); } } while (0)
  for (; t + 1 < NT; t += 2) {
    STEP(pB0, pB1, pA0, pA1, t, (t + 3 < NT), (t + 1 < NT), (t + 1 < NT));       ENDW(t);   ROT();
    STEP(pA0, pA1, pB0, pB1, t + 1, (t + 4 < NT), (t + 2 < NT), (t + 2 < NT));     ENDW(t + 1); ROT();
  }
  STEP(pB0, pB1, pA0, pA1, NT - 1, false, false, false);
  { pw0 = (u32x4){PKW(pB0, 0), PKW(pB0, 2), PKW(pB0, 4), PKW(pB0, 6)}; pw1 = (u32x4){PKW(pB0, 8), PKW(pB0, 10), PKW(pB0, 12), PKW(pB0, 14)}; pw2 = (u32x4){PKW(pB1, 0), PKW(pB1, 2), PKW(pB1, 4), PKW(pB1, 6)}; pw3 = (u32x4){PKW(pB1, 8), PKW(pB1, 10), PKW(pB1, 12), PKW(pB1, 14)};
    SBAR(); OSUM(0); OSUM(1); OSUM(2); OSUM(3); pv2(o, vq, sl_cur, PAF(0), PAF(1), PAF(2), PAF(3)); }
  #undef PKW
  #undef PAF
  #undef VFR
  #undef PIN
  #undef OSUM
  #undef GAPB
  #undef EX
  #undef VRD
  #undef STEP
  #undef ENDW
  #undef MF8
  #undef KLOAD
  const float sterm = __builtin_amdgcn_exp2f(sink2 - ref);
  float rli[16];
  #pragma unroll
  for (int r = 0; r < 16; ++r) rli[r] = __builtin_amdgcn_rcpf(osum[r] + sterm);
  bf16* Ow = O + (qrow + wid * QBLK) * QP + qcol;
  { bf16* stg = (bf16*)(shm + LOST) + wid * 2048;
    #pragma unroll
    for (int r = 0; r < 16; ++r) { const int orow = crow(r, hi);
      #pragma unroll
      for (int d0 = 0; d0 < 2; ++d0) stg[orow * 64 + d0 * 32 + r32] = __float2bfloat16(o[d0][r] * rli[r]); }
    asm volatile("s_waitcnt lgkmcnt(0)" ::: "memory");
    #pragma unroll
    for (int i = 0; i < 4; ++i) { const int row = i * 8 + (lane >> 3), ch = lane & 7; const u32x4 v = *(const u32x4*)(stg + row * 64 + ch * 8); ATTN_STORE16(Ow + (long)row * QP + ch * 8, v); } }
  asm volatile("s_waitcnt lgkmcnt(0)\n\ts_barrier" ::: "memory");
  #undef DMA_K
  #undef DMA_V
  #undef ROWOFF
  #undef CMASK
  #undef ROT
}
constexpr int ATTN_LDS_BYTES = LDS_BYTES;
#undef SBAR
#undef WAIT_BAR
}

struct Args { const float* in[20]; float* out; unsigned char* ws; int ph_lo, ph_hi; };
typedef const Args __attribute__((address_space(4)))* kargp_t;
__device__ __forceinline__ kargp_t kargs() { auto p = __builtin_amdgcn_kernarg_segment_ptr(); asm volatile("" : "+s"(p)); return (kargp_t)p; }
enum { I_X = 0, I_C, I_CTX, I_CCTX, I_ADAW, I_ADAB, I_GATTN, I_GFFN, I_WIN, I_QNG, I_KNG, I_QNL, I_KNL, I_SINK, I_WOUT, I_RW, I_RB, I_WGATE, I_WUP, I_WDOWN };
struct Frame {
    LAS unsigned char* lds; volatile LAS unsigned* MISC;
    int tid, lane, wave, vcu, G;
};
#define WSP(T, off) ((T*)(kargs()->ws + (off)))
__device__ const float ROPE_INV[16] = {1.000000000e+00f, 5.623413324e-01f, 3.162277639e-01f, 1.778279394e-01f, 1.000000015e-01f, 5.623413250e-02f, 3.162277490e-02f, 1.778279431e-02f,
                                       9.999999776e-03f, 5.623413250e-03f, 3.162277630e-03f, 1.778279431e-03f, 1.000000047e-03f, 5.623413017e-04f, 3.162277571e-04f, 1.778279402e-04f};

template <int KIND> __device__ __forceinline__ int dst_row(int n) {
    if (KIND == 0) return n;
    if (KIND == 2) return ((n >> 7) << 8) + (n & 127);
    if (KIND == 3) return ((n >> 7) << 8) + 128 + (n & 127);
    int tile, wc;
    if (n < 512) { const int h = n >> 6; tile = h >> 2; wc = h & 3; }
    else if (n < 640) { tile = 4; wc = (n - 512) >> 6; }
    else if (n < 768) { tile = 4; wc = 2 + ((n - 640) >> 6); }
    else if (n < 1280) { const int h = (n - 768) >> 6; tile = 2 + (h >> 2); wc = h & 3; }
    else if (n < 1408) { tile = 5; wc = (n - 1280) >> 6; }
    else { tile = 5; wc = 2 + ((n - 1408) >> 6); }
    const int d = n & 63, bj = d >> 5, dd = d & 31, np = dd >> 4, f = dd & 15, fq = f >> 2, j = f & 3;
    return 256 * tile + 128 * bj + 32 * wc + 8 * fq + 4 * np + j;
}
template <int KIND> __device__ __forceinline__ void p0_transpose_item(const float* W, int N, bf16_t* WT, int Kd, LAS float* scr, int kb, int nb, int lane) {
    const int k0 = 64 * kb, n0 = 32 * nb;
#pragma unroll 8
    for (int i = 0; i < 32; ++i) { const int kk = 2 * i + (lane >> 5); scr[kk * 33 + (lane & 31)] = W[(size_t)(k0 + kk) * N + n0 + (lane & 31)]; }
    LDS_WAIT(); asm volatile("" ::: "memory");
    const int c = lane & 7;
#pragma unroll
    for (int j = 0; j < 4; ++j) { const int n = (lane >> 3) + 8 * j; const LAS float* s = scr + (8 * c) * 33 + n;
        u32x4 o; o.x = pk2(s[0 * 33], s[1 * 33]); o.y = pk2(s[2 * 33], s[3 * 33]); o.z = pk2(s[4 * 33], s[5 * 33]); o.w = pk2(s[6 * 33], s[7 * 33]);
        *(GAS u32x4*)(WT + (size_t)dst_row<KIND>(n0 + n) * Kd + k0 + 8 * c) = o; }
    LDS_WAIT(); asm volatile("" ::: "memory");
}
__device__ __forceinline__ void sincos_d(float ang, float& cs, float& sn) {
    const double x = (double)ang; const double kq = __builtin_rint(x * 0.63661977236758134308);
    const double r = (x - kq * 1.5707963267948966192) - kq * 6.123233995736766036e-17, r2 = r * r;
    const double s = r * (1.0 + r2 * (-1.0 / 6 + r2 * (1.0 / 120 + r2 * (-1.0 / 5040 + r2 * (1.0 / 362880 + r2 * (-1.0 / 39916800 + r2 * (1.0 / 6227020800.0)))))));
    const double c = 1.0 + r2 * (-0.5 + r2 * (1.0 / 24 + r2 * (-1.0 / 720 + r2 * (1.0 / 40320 + r2 * (-1.0 / 3628800 + r2 * (1.0 / 479001600.0 + r2 * (-1.0 / 87178291200.0)))))));
    const int q = ((int)kq) & 3;
    const double cc = (q == 0) ? c : (q == 1) ? -s : (q == 2) ? -c : s;
    const double ss = (q == 0) ? s : (q == 1) ? c : (q == 2) ? -s : -c;
    cs = (float)cc; sn = (float)ss;
}
__device__ __forceinline__ void p0_prologue(Frame& F) {
    const int gw = F.vcu * NWAVES + F.wave, NGW = F.G * NWAVES;
    {
        const float* c = kargs()->in[I_C]; const float* cctx = kargs()->in[I_CCTX]; const float* ada_w = kargs()->in[I_ADAW]; const float* ada_b = kargs()->in[I_ADAB];
        float* modv = WSP(float, WS_MODV);
        LAS float* sv = (LAS float*)(F.lds);
        LAS float* part = (LAS float*)(F.lds + 16384);
        for (int i = F.tid; i < 3072; i += NWAVES * 64) { const int v = i >> 10, k = i & 1023; const float cv = v < 2 ? c[v * 1024 + k] : cctx[k]; sv[i] = cv / (1.0f + expf(-cv)); }
        __syncthreads();
        for (int tile = F.vcu; tile < NLAYER * 96; tile += F.G) {
            const int l = tile / 96, c0 = (tile % 96) * 64;
            const float* W = ada_w + (size_t)l * 1024 * 6144 + c0 + F.lane;
            float a0 = 0.f, a1 = 0.f, a2 = 0.f; const int kb = F.wave * 128;
#pragma unroll 8
            for (int k = 0; k < 128; ++k) { const float w = W[(size_t)(kb + k) * 6144]; a0 += sv[kb + k] * w; a1 += sv[1024 + kb + k] * w; a2 += sv[2048 + kb + k] * w; }
            part[(F.wave * 3 + 0) * 64 + F.lane] = a0; part[(F.wave * 3 + 1) * 64 + F.lane] = a1; part[(F.wave * 3 + 2) * 64 + F.lane] = a2;
            __syncthreads();
            if (F.tid < 192) { const int v = F.tid >> 6, col = F.tid & 63; float s = ada_b[l * 6144 + c0 + col];
#pragma unroll
                for (int w = 0; w < 8; ++w) s += part[(w * 3 + v) * 64 + col];
                modv[(size_t)(l * 3 + v) * 6144 + c0 + col] = s; }
            __syncthreads();
        }
    }
    { float* rope = WSP(float, WS_ROPE); const int gt = F.vcu * NWAVES * 64 + F.tid; if (gt < 4096) { const int pos = gt >> 4, f = gt & 15; const float ang = (float)pos * ROPE_INV[f]; float cs, sn; sincos_d(ang, cs, sn); rope[gt * 2] = cs; rope[gt * 2 + 1] = sn; } }
    { const int gt = F.vcu * NWAVES * 64 + F.tid; if (gt < NLAYER * 256) { const int l = gt >> 8, kq = (gt >> 6) & 3, d = gt & 63; const float* src = kargs()->in[kq == 0 ? I_QNG : (kq == 1 ? I_QNL : (kq == 2 ? I_KNG : I_KNL))]; WSP(float, WS_GN)[gt] = src[l * 64 + d]; } }
    if (gw < NLAYER * 2) { const int l = gw >> 1, loc = gw & 1; float mq = fabsf(kargs()->in[loc ? I_QNL : I_QNG][l * 64 + F.lane]), mk = fabsf(kargs()->in[loc ? I_KNL : I_KNG][l * 64 + F.lane]);
#pragma unroll
        for (int o = 1; o < 64; o <<= 1) { mq = fmaxf(mq, __shfl_xor(mq, o)); mk = fmaxf(mk, __shfl_xor(mk, o)); }
        if (F.lane == 0) WSP(float, WS_BND)[gw] = 64.0f * C2 * mq * mk * 1.02f + 0.05f; }
    { u32x4* p = (u32x4*)(WSP(unsigned char, WS_KV) + (size_t)(NROW / 64) * 49152); for (int i = F.vcu * NWAVES * 64 + F.tid; i < 4 * 49152 / 16; i += F.G * NWAVES * 64) p[i] = (u32x4){0u, 0u, 0u, 0u}; }
    {
        const float* x = kargs()->in[I_X]; const float* ctx = kargs()->in[I_CTX]; bf16_t* XS = WSP(bf16_t, WS_XS);
        for (int R = gw; R < NROW; R += NGW) {
            const int b = R >= RB ? 1 : 0, rr = R - b * RB;
            const float* src = rr < NCTX ? ctx + (size_t)(b * NCTX + rr) * 1024 : x + (size_t)(b * SEQ + rr - NCTX) * 1024;
            const f32x4* s4 = (const f32x4*)src + F.lane; u32x2* d2 = (u32x2*)(XS + (size_t)R * 1024) + F.lane;
            f32x4 v[4];
#pragma unroll
            for (int j = 0; j < 4; ++j) v[j] = s4[64 * j];
#pragma unroll
            for (int j = 0; j < 4; ++j) { u32x2 w; w.x = pk2(v[j][0], v[j][1]); w.y = pk2(v[j][2], v[j][3]); d2[64 * j] = w; }
        }
    }
    {
        LAS float* scr = (LAS float*)(F.lds + RING_OFF + F.wave * 16384);
        constexpr int I_IN = 4 * 768, I_OUT = 4 * 512, I_G = 64 * 256, I_U = 64 * 256, I_D = 64 * 256;
        for (int it0 = gw; it0 < I_IN + I_OUT + I_G + I_U + I_D; it0 += NGW) {
            int it = it0;
            if (it < I_IN) { const int l = it / 768, r = it % 768; p0_transpose_item<1>(kargs()->in[I_WIN] + (size_t)l * 1024 * 1536, 1536, WSP(bf16_t, WS_WIN) + (size_t)l * 1536 * 1024, 1024, scr, r / 48, r % 48, F.lane); continue; } it -= I_IN;
            if (it < I_OUT) { const int l = it / 512, r = it % 512; p0_transpose_item<0>(kargs()->in[I_WOUT] + (size_t)l * 1024 * 1024, 1024, WSP(bf16_t, WS_WOUT) + (size_t)l * 1024 * 1024, 1024, scr, r / 32, r % 32, F.lane); continue; } it -= I_OUT;
            if (it < I_G) { const int m = it / 256, r = it % 256; p0_transpose_item<2>(kargs()->in[I_WGATE] + (size_t)m * 1024 * 512, 512, WSP(bf16_t, WS_WGU) + (size_t)m * 1024 * 1024, 1024, scr, r / 16, r % 16, F.lane); continue; } it -= I_G;
            if (it < I_U) { const int m = it / 256, r = it % 256; p0_transpose_item<3>(kargs()->in[I_WUP] + (size_t)m * 1024 * 512, 512, WSP(bf16_t, WS_WGU) + (size_t)m * 1024 * 1024, 1024, scr, r / 16, r % 16, F.lane); continue; } it -= I_U;
            { const int m = it / 256, r = it % 256; p0_transpose_item<0>(kargs()->in[I_WDOWN] + (size_t)m * 512 * 1024, 1024, WSP(bf16_t, WS_WD) + (size_t)m * 1024 * 512, 512, scr, r / 32, r % 32, F.lane); }
        }
    }
}

__device__ __forceinline__ void load_row(const bf16_t* xrow, int lane, f32x4 (&h)[4]) {
    const u32x2* xr = (const u32x2*)xrow + lane;
#pragma unroll
    for (int j = 0; j < 4; ++j) { const u32x2 w = xr[64 * j]; h[j] = (f32x4){__builtin_bit_cast(float, w.x << 16), __builtin_bit_cast(float, w.x & 0xffff0000u), __builtin_bit_cast(float, w.y << 16), __builtin_bit_cast(float, w.y & 0xffff0000u)}; }
}
__device__ __forceinline__ void rms_mod(const float* g, const float* sh, const float* sc, int lane, f32x4 (&h)[4]) {
    float ss = 0.f;
#pragma unroll
    for (int j = 0; j < 4; ++j) ss += (h[j][0] * h[j][0] + h[j][1] * h[j][1]) + (h[j][2] * h[j][2] + h[j][3] * h[j][3]);
    const float rs = 1.0f / sqrtf(wave_sum(ss) * (1.0f / 1024.0f) + NORM_EPS);
#pragma unroll
    for (int j = 0; j < 4; ++j) { const f32x4 gg = ((const f32x4*)g)[lane + 64 * j], s1 = ((const f32x4*)sh)[lane + 64 * j], s2 = ((const f32x4*)sc)[lane + 64 * j];
        h[j] = (h[j] * rs * gg) * (1.0f + s2) + s1; }
}
__device__ __forceinline__ void store_row_bf16(bf16_t* orow, int lane, const f32x4 (&h)[4]) {
    u32x2* o8 = (u32x2*)orow + lane;
#pragma unroll
    for (int j = 0; j < 4; ++j) { u32x2 w; w.x = pk2(h[j][0], h[j][1]); w.y = pk2(h[j][2], h[j][3]); o8[64 * j] = w; }
}
__device__ __forceinline__ int row_mv(int R) { const int b = R >= RB ? 1 : 0; return (R - b * RB) < NCTX ? 2 : b; }

__device__ __forceinline__ void phase_norm1(Frame& F0, int l) {
    Frame F = F0; asm volatile("" : "+v"(F.tid), "+v"(F.lane), "+s"(F.wave), "+s"(F.vcu));
    const int gw = F.vcu * NWAVES + F.wave, NGW = F.G * NWAVES;
    const float* g = kargs()->in[I_GATTN] + l * 1024; const float* modv = WSP(float, WS_MODV); const bf16_t* XS = WSP(bf16_t, WS_XS); bf16_t* HN = WSP(bf16_t, WS_HN);
    f32x4 xn[4]; if (gw < NROW) load_row(XS + (size_t)gw * 1024, F.lane, xn);
    for (int R = gw; R < NROW; R += NGW) {
        const float* mv = modv + (size_t)(l * 3 + row_mv(R)) * 6144;
        f32x4 h[4];
#pragma unroll
        for (int j = 0; j < 4; ++j) h[j] = xn[j];
        if (R + NGW < NROW) load_row(XS + (size_t)(R + NGW) * 1024, F.lane, xn);
        rms_mod(g, mv + 0, mv + 1024, F.lane, h);
        store_row_bf16(HN + (size_t)R * 1024, F.lane, h);
    }
}
__device__ __forceinline__ void phase_norm2_router(Frame& F0, int l, bool lastl, bool dry = false) {
    Frame F = F0; asm volatile("" : "+v"(F.tid), "+v"(F.lane), "+s"(F.wave), "+s"(F.vcu));
    const int gw = F.vcu * NWAVES + F.wave, NGW = F.G * NWAVES;
    LAS f32x4* RW = (LAS f32x4*)(F.lds + RING_OFF);
    { const float* router_w = kargs()->in[I_RW];
      for (int idx = F.tid; idx < 4096; idx += NWAVES * 64) { const int j = idx >> 10, e = (idx >> 6) & 15, ln = idx & 63, c = 4 * ln + 256 * j;
        RW[idx] = (f32x4){router_w[(c + 0) * 16 + e], router_w[(c + 1) * 16 + e], router_w[(c + 2) * 16 + e], router_w[(c + 3) * 16 + e]}; } }
    __syncthreads();
    const float* g = kargs()->in[I_GFFN] + l * 1024; const float* router_b = kargs()->in[I_RB];
    LAS float* PS = (LAS float*)(F.lds + RING_OFF + 65536) + F.wave * (16 * 65);
    const float* modv = WSP(float, WS_MODV); const bf16_t* XS = WSP(bf16_t, WS_XS); bf16_t* HN = WSP(bf16_t, WS_HN);
    int my_cls = -1, my_tok = 0; float my_wlo = 0.f, my_whi = 0.f;
    int k = 0;
    f32x4 xn[4]; if (gw < NROW) load_row(XS + (size_t)gw * 1024, F.lane, xn);
    for (int R = gw; R < NROW; R += NGW, ++k) {
        const int mvi = row_mv(R);
        f32x4 h[4];
#pragma unroll
        for (int j = 0; j < 4; ++j) h[j] = xn[j];
        if (R + NGW < NROW) load_row(XS + (size_t)(R + NGW) * 1024, F.lane, xn);
        if (lastl && mvi == 2) continue;
        const float* mv = modv + (size_t)(l * 3 + mvi) * 6144;
        rms_mod(g, mv + 3072, mv + 4096, F.lane, h);
        store_row_bf16(HN + (size_t)R * 1024, F.lane, h);
        {
            float s[16];
#pragma unroll
            for (int e = 0; e < 16; ++e) s[e] = 0.f;
#pragma unroll
            for (int j = 0; j < 4; ++j)
#pragma unroll
                for (int e = 0; e < 16; ++e) { const f32x4 w4 = RW[(j * 16 + e) * 64 + F.lane]; s[e] += (h[j][0] * w4[0] + h[j][1] * w4[1]) + (h[j][2] * w4[2] + h[j][3] * w4[3]); }
#pragma unroll
            for (int e = 0; e < 16; ++e) PS[e * 65 + F.lane] = s[e];
        }
        float tl = 0.f;
        { const LAS float* pr = PS + (F.lane & 15) * 65 + (F.lane >> 4) * 16;
#pragma unroll
          for (int i = 0; i < 16; ++i) tl += pr[i]; }
        tl += __shfl_xor(tl, 16); tl += __shfl_xor(tl, 32);
        const float my_sc = 1.0f / (1.0f + expf(-tl)), my_sel = my_sc + router_b[F.lane & 15];
        float sc[16], sel[16];
#pragma unroll
        for (int e = 0; e < 16; ++e) { sc[e] = __builtin_bit_cast(float, __builtin_amdgcn_readlane(__builtin_bit_cast(int, my_sc), e)); sel[e] = __builtin_bit_cast(float, __builtin_amdgcn_readlane(__builtin_bit_cast(int, my_sel), e)); }
        float gs[4];
#pragma unroll
        for (int gq = 0; gq < 4; ++gq) { const float a = sel[4 * gq], b = sel[4 * gq + 1], c = sel[4 * gq + 2], d = sel[4 * gq + 3];
            const float h1 = fmaxf(a, b), l1 = fminf(a, b), h2 = fmaxf(c, d), l2 = fminf(c, d);
            gs[gq] = fmaxf(h1, h2) + fmaxf(fminf(h1, h2), fmaxf(l1, l2)); }
        int gi = 0; float bg = gs[0];
#pragma unroll
        for (int gq = 1; gq < 4; ++gq) if (gs[gq] > bg) { bg = gs[gq]; gi = gq; }
        float s4[4], c4[4];
#pragma unroll
        for (int q = 0; q < 4; ++q) { s4[q] = sel[q]; c4[q] = sc[q]; }
#pragma unroll
        for (int gq = 1; gq < 4; ++gq)
#pragma unroll
            for (int q = 0; q < 4; ++q) { s4[q] = (gi == gq) ? sel[4 * gq + q] : s4[q]; c4[q] = (gi == gq) ? sc[4 * gq + q] : c4[q]; }
        int i1 = 0; float b1 = s4[0], w1 = c4[0];
#pragma unroll
        for (int q = 1; q < 4; ++q) if (s4[q] > b1) { b1 = s4[q]; i1 = q; w1 = c4[q]; }
        int i2 = -1; float b2 = -INFINITY, w2 = 0.f;
#pragma unroll
        for (int q = 0; q < 4; ++q) if (q != i1 && (i2 < 0 || s4[q] > b2)) { b2 = s4[q]; i2 = q; w2 = c4[q]; }
        const float wsum = w1 + w2; w1 = w1 / wsum; w2 = w2 / wsum;
        const int ia = i1 < i2 ? i1 : i2, ib = i1 < i2 ? i2 : i1;
        const float wlo = i1 < i2 ? w1 : w2, whi = i1 < i2 ? w2 : w1;
        const int pidx = ia == 0 ? ib - 1 : (ia == 1 ? ib + 1 : 5);
        if (F.lane == k) { my_cls = gi * 6 + pidx; my_tok = R; my_wlo = wlo; my_whi = whi; }
    }
    if (my_cls >= 0 && !dry) {
        const unsigned pos = __hip_atomic_fetch_add(WSP(unsigned, WS_CTL) + CW_CNT + (l * NCLS + my_cls) * 64, 1u, RLX_AGENT);
        WSP(int, WS_TOK)[(size_t)my_cls * CAP + pos] = my_tok; WSP(f32x2, WS_WTS)[(size_t)my_cls * CAP + pos] = (f32x2){my_wlo, my_whi};
    }
    __syncthreads();
}
__device__ __forceinline__ int moe_tables(Frame& F0, int l) {
    Frame F = F0; asm volatile("" : "+v"(F.tid));
    LAS int* s_n = (LAS int*)(F.lds + MOE_OFF); LAS int* s_ts = s_n + 32;
    __syncthreads();
    if (F.tid < NCLS) s_n[F.tid] = (int)__hip_atomic_load(WSP(unsigned, WS_CTL) + CW_CNT + (l * NCLS + F.tid) * 64, RLX_AGENT);
    __syncthreads();
    if (F.tid == 0) { int acc = 0; for (int c = 0; c < NCLS; ++c) { s_ts[c] = acc; acc += (s_n[c] + 255) >> 8; } s_ts[NCLS] = acc; }
    __syncthreads();
    return s_ts[NCLS];
}

constexpr int NPHASE = 1 + 7 * NLAYER;
__global__ void __launch_bounds__(NWAVES * 64, 2) fwd_kernel(Args args) {
    extern __shared__ __attribute__((aligned(16))) unsigned char lds[];
    Frame F;
    F.lds = (LAS unsigned char*)lds; F.MISC = (volatile LAS unsigned*)(F.lds + MISC_OFF);
    F.tid = threadIdx.x; F.lane = F.tid & 63; F.wave = __builtin_amdgcn_readfirstlane(F.tid >> 6);
    F.G = gridDim.x; { const int bx = blockIdx.x; F.vcu = (F.G % 8 == 0) ? (bx % 8) * (F.G / 8) + bx / 8 : bx; }
    for (int u = F.tid; u < (LDS_BYTES - LDSCTL_OFF) / 4; u += NWAVES * 64) ((LAS unsigned*)(F.lds + LDSCTL_OFF))[u] = 0u;
    __syncthreads();
    const int lo = args.ph_lo, hi = args.ph_hi;
    XcdBarrier bar; bar.bar = WSP(unsigned, WS_CTL) + CW_BAR; bar.x = 0; bar.st = nullptr;
    if (hi - lo > 1) bar = xcd_barrier_post(WSP(unsigned, WS_CTL) + CW_BAR, F.MISC + 8);
#ifndef MK_EN
#define MK_EN 0xff
#endif
#define EN(k) (((MK_EN) >> (k)) & 1)
#ifndef REP_P0
#define REP_P0 1
#endif
#ifndef REP_A
#define REP_A 1
#endif
#ifndef REP_B
#define REP_B 1
#endif
#ifndef REP_C
#define REP_C 1
#endif
#ifndef REP_F
#define REP_F 1
#endif
#ifndef REP_D
#define REP_D 1
#endif
#ifndef REP_E
#define REP_E 1
#endif
#ifndef REP_G
#define REP_G 1
#endif
#define RUN(p) (lo <= (p) && (p) < hi)
#ifndef REP_BAR
#define REP_BAR 1
#endif
#define SEAM(p) do { if (RUN(p) && RUN((p) + 1)) { xcd_barrier(bar); if (REP_BAR > 1) xcd_barrier(bar); if (REP_BAR > 2) xcd_barrier(bar); } } while (0)

    if (EN(7) && RUN(0)) { for (int rep = 0; rep < REP_P0; ++rep) { p0_prologue(F); if (rep + 1 < REP_P0) xcd_barrier(bar); } SEAM(0); }

    for (int l = 0; l < NLAYER; ++l) {
        const int pb = 1 + 7 * l; const bool lastl = (l == NLAYER - 1);
        if (EN(0) && RUN(pb + 0)) { for (int rep = 0; rep < REP_A; ++rep) { phase_norm1(F, l); if (rep + 1 < REP_A) xcd_barrier(bar); } SEAM(pb + 0); }
        if (EN(1) && RUN(pb + 1)) {
            pg8::ProbDense P; P.A = WSP(const char, WS_HN); P.B = (const char*)(WSP(bf16_t, WS_WIN) + (size_t)l * 1536 * 1024); P.lda = 1024; P.ldb = 1024; P.nt = 16; P.skip_ctx = false; P.S.init(NROW, 1536, F.G, (int)blockIdx.x);
            pg8::EpiQKV E{kargs()->ws, WSP(float, WS_GN) + l * 256, WSP(float, WS_ROPE)};
            for (int rep = 0; rep < REP_B; ++rep) { pg8::gemm_phase<pg8::EpiQKV, pg8::ProbDense, true>(F.lds + RING_OFF, F.lds + OFFS_OFF, P, E); if (rep + 1 < REP_B) xcd_barrier(bar); }
            SEAM(pb + 1);
        }
        if (EN(2) && RUN(pb + 2)) {
            const unsigned char* Qf8 = WSP(const unsigned char, WS_QO); const unsigned char* KVT = WSP(const unsigned char, WS_KV); attn_body::bf16* O = WSP(attn_body::bf16, WS_HN);
            const float* sink = kargs()->in[I_SINK] + l * 8;
            const int n0 = 1024 + (lastl ? 0 : 32);
            const float bnd_g = WSP(const float, WS_BND)[l * 2], bnd_l = WSP(const float, WS_BND)[l * 2 + 1];
            const float ref_g = fmaxf(bnd_g - 96.0f, 0.0f), ref_l = fmaxf(bnd_l - 96.0f, 0.0f);
            for (int rep = 0; rep < REP_C; ++rep) {
            for (int L = F.vcu; L < n0; L += F.G) {
                long qrow, kvrow; int qcol, st, NT; float sink2 = -INFINITY, ref = ref_g;
                if (L < 1024) { const int bh = L >> 6, b = bh >> 3, h = bh & 7, qb = L & 63; qrow = (long)b * RB + NCTX + qb * 256; kvrow = (long)b * RB; NT = RB / 64; qcol = h * 64; st = h >> 2; }
                else { const int Lc = L - 1024, b = Lc >> 4, h = Lc & 15; qrow = (long)b * RB; kvrow = qrow; NT = NCTX / 64; qcol = h * 64;
                    if (h < 8) { st = h >> 2; } else { const int hl = h - 8; st = 2 + (hl >> 2); sink2 = sink[hl] * LOG2E; ref = ref_l; } }
                attn_body::attn_unit_f8<0>(qrow, kvrow, 0, qcol, st, st, NT, sink2, ref, Qf8, KVT, O, (char*)lds + RING_OFF);
            }
            for (int L = F.vcu; L < 1024; L += F.G) {
                const int bh = L >> 6, b = bh >> 3, hl = bh & 7, qb = L & 63, q0 = qb * 256;
                attn_body::attn_unit_f8<1>((long)b * RB + NCTX + q0, (long)b * RB, q0, (8 + hl) * 64, 2 + (hl >> 2), 2 + (hl >> 2), 12, sink[hl] * LOG2E, ref_l, Qf8, KVT, O, (char*)lds + RING_OFF);
            }
            if (rep + 1 < REP_C) xcd_barrier(bar); }
            SEAM(pb + 2);
        }
        if (EN(3) && RUN(pb + 3)) {
            pg8::ProbDense P; P.A = WSP(const char, WS_HN); P.B = (const char*)(WSP(bf16_t, WS_WOUT) + (size_t)l * 1024 * 1024); P.lda = 1024; P.ldb = 1024; P.nt = 16; P.skip_ctx = lastl; P.S.init(lastl ? NB * SEQ : NROW, 1024, F.G, (int)blockIdx.x);
            for (int rep = 0; rep < REP_D; ++rep) {
            pg8::EpiResid E{WSP(bf16_t, WS_XS), WSP(float, WS_MODV) + (size_t)l * 3 * 6144, 2048, (rep & 1) ? -1.0f : 1.0f};
            pg8::gemm_phase<pg8::EpiResid, pg8::ProbDense, true>(F.lds + RING_OFF, F.lds + OFFS_OFF, P, E); if (rep + 1 < REP_D) xcd_barrier(bar); }
            SEAM(pb + 3);
        }
        if (EN(4) && RUN(pb + 4)) {
#if REP_E == 2
            phase_norm2_router(F, l, lastl, true); xcd_barrier(bar);
#endif
            phase_norm2_router(F, l, lastl, false); SEAM(pb + 4); }
        if (EN(5) && RUN(pb + 5)) {
            const int ntile = moe_tables(F, l);
            pg8::ProbGU P; P.A = WSP(const char, WS_HN); P.B = (const char*)(WSP(bf16_t, WS_WGU) + (size_t)l * 16 * 1024 * 1024); P.tok = WSP(int, WS_TOK); P.s_n = (const LAS int*)(F.lds + MOE_OFF); P.s_ts = P.s_n + 32;
            P.total = ntile * 8; P.G = F.G; P.c = F.vcu; P.nt = 16;
            pg8::EpiGU E{WSP(bf16_t, WS_ACT), WSP(f32x2, WS_WTS)};
            for (int rep = 0; rep < REP_F; ++rep) { pg8::gemm_phase<pg8::EpiGU, pg8::ProbGU, true>(F.lds + RING_OFF, F.lds + OFFS_OFF, P, E); if (rep + 1 < REP_F) xcd_barrier(bar); }
            SEAM(pb + 5);
        }
        if (EN(6) && RUN(pb + 6)) {
            const int ntile = moe_tables(F, l);
            pg8::ProbDown P; P.A = WSP(const char, WS_ACT); P.B = (const char*)(WSP(bf16_t, WS_WD) + (size_t)l * 16 * 1024 * 512); P.s_n = (const LAS int*)(F.lds + MOE_OFF); P.s_ts = P.s_n + 32;
            P.total = ntile * 4; P.G = F.G; P.c = F.vcu; P.nt = 16;
            for (int rep = 0; rep < REP_G; ++rep) {
            pg8::EpiDown E{WSP(bf16_t, WS_XS), lastl ? kargs()->out : nullptr, WSP(int, WS_TOK), WSP(float, WS_MODV) + (size_t)l * 3 * 6144, (rep & 1) ? -1.0f : 1.0f};
            pg8::gemm_phase<pg8::EpiDown, pg8::ProbDown, true>(F.lds + RING_OFF, F.lds + OFFS_OFF, P, E); if (rep + 1 < REP_G) xcd_barrier(bar); }
            SEAM(pb + 6);
        }
    }
#undef RUN
#undef SEAM
}

#ifndef MK_SPLIT
#define MK_SPLIT 0
#endif
extern "C" void kernel_launch(void* const* d_in, const int* in_sizes, int n_in, void* d_out, int out_size, void* d_ws, size_t ws_size, hipStream_t stream) {
    static int grid = 0;
    if (grid == 0) {
        if (n_in != 20 || in_sizes[0] != NB * SEQ * DM || out_size != NB * SEQ * DM || ws_size < WS_END) {
            fprintf(stderr, "kernel_launch: unexpected shapes (n_in %d, in0 %d, out %d, ws %zu); nothing launched\n", n_in, n_in > 0 ? in_sizes[0] : -1, out_size, ws_size); grid = -1; return; }
        int dev = 0, cus = 0, per_cu = 0;
        if (hipGetDevice(&dev) != hipSuccess || hipDeviceGetAttribute(&cus, hipDeviceAttributeMultiprocessorCount, dev) != hipSuccess) { grid = -1; return; }
        if (hipFuncSetAttribute((const void*)fwd_kernel, hipFuncAttributeMaxDynamicSharedMemorySize, LDS_BYTES) != hipSuccess) { fprintf(stderr, "kernel_launch: hipFuncSetAttribute failed\n"); grid = -1; return; }
        if (hipOccupancyMaxActiveBlocksPerMultiprocessor(&per_cu, (const void*)fwd_kernel, NWAVES * 64, LDS_BYTES) != hipSuccess || per_cu < 1)
            fprintf(stderr, "kernel_launch: note: occupancy query reports %d workgroups per CU\n", per_cu);
        (void)hipGetLastError();
        grid = cus;
    }
    if (grid < 0) return;
    if (hipMemsetAsync((char*)d_ws + WS_CTL, 0, CTL_ZERO_BYTES, stream) != hipSuccess) return;
    Args a{};
    for (int i = 0; i < 20; ++i) a.in[i] = (const float*)d_in[i];
    a.out = (float*)d_out; a.ws = (unsigned char*)d_ws;
#if MK_SPLIT
    for (int p = 0; p < NPHASE; ++p) { a.ph_lo = p; a.ph_hi = p + 1; hipLaunchKernelGGL(fwd_kernel, dim3(grid), dim3(NWAVES * 64), LDS_BYTES, stream, a); }
#else
    a.ph_lo = 0; a.ph_hi = NPHASE;
    hipLaunchKernelGGL(fwd_kernel, dim3(grid), dim3(NWAVES * 64), LDS_BYTES, stream, a);
#endif
    const hipError_t le = hipPeekAtLastError();
    if (le != hipSuccess) fprintf(stderr, "kernel_launch: launch failed: %s\n", hipGetErrorName(le));
}
```

```cpp
#include <hip/hip_runtime.h>
#include <hip/hip_bf16.h>
#include <cstdio>
#include <cstdint>
#include <cmath>

#define LAS __attribute__((address_space(3)))
#define GAS __attribute__((address_space(1)))
typedef unsigned short bf16_t;
typedef short bf16x8 __attribute__((ext_vector_type(8)));
typedef float f32x4 __attribute__((ext_vector_type(4)));
typedef float f32x2 __attribute__((ext_vector_type(2)));
typedef unsigned u32x4 __attribute__((ext_vector_type(4)));
typedef unsigned u32x2 __attribute__((ext_vector_type(2)));
typedef GAS unsigned gu32;

constexpr int NB = 2, SEQ = 16384, DM = 1024, NCTX = 256, NLAYER = 4, NEXP = 16, DEXP = 512;
constexpr int RB = SEQ + NCTX;
constexpr int NROW = NB * RB;
constexpr int NCLS = 24, CAP = NROW;
constexpr int MAXSLOT = 39424;
constexpr float NORM_EPS = 1e-6f;
constexpr float C2 = 0.125f * 1.4426950408889634f;
constexpr float LOG2E = 1.4426950408889634f;
#ifndef VFP8
#define VFP8 1
#endif
constexpr int KV_VSL = VFP8 ? 4096 : 8192, KV_TILEB = 16384 + 4 * KV_VSL;
constexpr float SQC2 = 0.42466090014400953f;

constexpr size_t MiB = 1u << 20;
constexpr size_t WS_CTL = 0, CTL_ZERO_BYTES = 1 * MiB;
constexpr size_t WS_MODV = 1 * MiB;
constexpr size_t WS_ROPE = 2 * MiB;
constexpr size_t WS_GN = 3 * MiB;
constexpr size_t WS_BND = 3 * MiB + 8192;
constexpr size_t WS_TOK = 4 * MiB;
constexpr size_t WS_WTS = 8 * MiB;
constexpr size_t WS_WIN = 16 * MiB;
constexpr size_t WS_WOUT = 28 * MiB;
constexpr size_t WS_WGU = 36 * MiB;
constexpr size_t WS_WD = 164 * MiB;
constexpr size_t WS_XS = 228 * MiB;
constexpr size_t WS_HN = 358 * MiB;
constexpr size_t WS_QO = 423 * MiB;
constexpr size_t WS_KV = 488 * MiB;
constexpr size_t WS_ACT = 423 * MiB;
constexpr size_t WS_END = 522 * MiB;
static_assert(WS_TOK + (size_t)NCLS * CAP * 4 <= WS_WTS && WS_WTS + (size_t)NCLS * CAP * 8 <= WS_WIN, "lists");
static_assert(WS_KV + (size_t)(NROW + 256) * 512 * 2 <= WS_END && WS_ACT + (size_t)MAXSLOT * 1024 * 2 <= WS_END, "ws map");
constexpr int CW_TMO = 0, CW_CODE = 1, CW_BAR = 4096, CW_CNT = 8192;

constexpr int RING_OFF = 0, RING_BYTES = 131072;
constexpr int LDSCTL_OFF = RING_BYTES, MISC_OFF = LDSCTL_OFF + 320, MOE_OFF = LDSCTL_OFF + 1024, OFFS_OFF = LDSCTL_OFF + 2048  ;
constexpr int LDS_BYTES = 147456;
constexpr int NWAVES = 8;

#define LDS_WAIT() asm volatile("s_waitcnt lgkmcnt(0)" ::: "memory")
#define VM_WAIT() asm volatile("s_waitcnt vmcnt(0)" ::: "memory")
#define RLX_AGENT __ATOMIC_RELAXED, __HIP_MEMORY_SCOPE_AGENT

__device__ __forceinline__ unsigned f2bf(float f) { unsigned u = __builtin_bit_cast(unsigned, f); return (u + 0x7fffu + ((u >> 16) & 1u)) >> 16; }
__device__ __forceinline__ unsigned pk2(float lo, float hi) { return f2bf(lo) | (f2bf(hi) << 16); }
__device__ __forceinline__ unsigned cvt_pk_bf16(float lo, float hi) { unsigned r; asm volatile("v_cvt_pk_bf16_f32 %0, %1, %2" : "=v"(r) : "v"(lo), "v"(hi)); return r; }
__device__ __forceinline__ float wave_sum(float v) {
#pragma unroll
    for (int o = 1; o < 64; o <<= 1) v += __shfl_xor(v, o);
    return v;
}

#define XB_TMO      128
#define XB_XCNT(j)  (256  + 64 * (j))
#define XB_XSUB(j)  (1280 + 64 * (j))
#define XB_XGEN(j)  (2304 + 64 * (j))
#define XB_TOP      3328
#define XB_TOPGEN   3392
#define XCD_BAR_WORDS 3456
#define XB_SPIN_CAP (1u << 22)
__device__ __forceinline__ unsigned xb_ld(unsigned* p)              { return __hip_atomic_load(p, __ATOMIC_RELAXED, __HIP_MEMORY_SCOPE_AGENT); }
__device__ __forceinline__ unsigned xb_add(unsigned* p, unsigned v) { return __hip_atomic_fetch_add(p, v, __ATOMIC_RELAXED, __HIP_MEMORY_SCOPE_AGENT); }
__device__ __forceinline__ unsigned xb_xcc_id() { return (unsigned)__builtin_amdgcn_s_getreg((3 << 11) | 20) & 0xFu; }
#define XB_SPIN(cond, bar) do { unsigned _sp = 0; while (cond) { __builtin_amdgcn_s_sleep(1); \
    if ((++_sp & 255u) == 0u) { if (xb_ld(&(bar)[XB_TMO])) break; if (_sp > XB_SPIN_CAP) { atomicAdd(&(bar)[XB_TMO], 1u); break; } } } } while (0)
struct XcdBarrier { unsigned* bar; unsigned x; volatile LAS unsigned* st; };
__device__ __forceinline__ XcdBarrier xcd_barrier_post(unsigned* bar, volatile LAS unsigned* st) {
    XcdBarrier b; b.bar = bar; b.x = xb_xcc_id(); b.st = st;
    if (threadIdx.x == 0) (void)xb_add(&bar[XB_XCNT(b.x)], 1u);
    return b;
}
__device__ __forceinline__ void xcd_barrier_complete(unsigned* bar, unsigned x, unsigned& nloc, unsigned& nx) {
    const unsigned G = gridDim.x * gridDim.y * gridDim.z;
    unsigned sum, cnt, mine, sp = 0u;
    for (;;) {
        sum = 0u; cnt = 0u; mine = 0u;
#pragma unroll
        for (unsigned j = 0; j < 16; ++j) { const unsigned c = xb_ld(&bar[XB_XCNT(j)]); sum += c; cnt += (c > 0u) ? 1u : 0u; mine = (j == x) ? c : mine; }
        if (sum == G) break;
        __builtin_amdgcn_s_sleep(1);
        if ((++sp & 255u) == 0u) { if (xb_ld(&bar[XB_TMO])) break; if (sp > XB_SPIN_CAP) { atomicAdd(&bar[XB_TMO], 1u); break; } }
    }
    nloc = mine > 0u ? mine : 1u; nx = cnt > 0u ? cnt : 1u;
}
__device__ __forceinline__ void xcd_barrier(const XcdBarrier& b) {
    asm volatile("s_waitcnt vmcnt(0)" ::: "memory");
    __syncthreads();
    if (threadIdx.x == 0) {
        unsigned* bar = b.bar;
        __builtin_amdgcn_s_waitcnt(0);
        unsigned nloc = b.st[0], nx = b.st[1];
        if (nloc == 0u) { xcd_barrier_complete(bar, b.x, nloc, nx); b.st[0] = nloc; b.st[1] = nx; }
        const unsigned old = xb_add(&bar[XB_XSUB(b.x)], 1u);
        const unsigned gen = old / nloc;
        if (old + 1u == (gen + 1u) * nloc) {
            __builtin_amdgcn_fence(__ATOMIC_RELEASE, "agent");
            asm volatile("s_waitcnt vmcnt(0)" ::: "memory");
            const unsigned og = xb_add(&bar[XB_TOP], 1u);
            const unsigned tg = og / nx;
            if (og + 1u == (tg + 1u) * nx) xb_add(&bar[XB_TOPGEN], 1u);
            else XB_SPIN(xb_ld(&bar[XB_TOPGEN]) == tg, bar);
            __builtin_amdgcn_fence(__ATOMIC_ACQUIRE, "agent");
            xb_add(&bar[XB_XGEN(b.x)], 1u);
            asm volatile("s_waitcnt vmcnt(0)" ::: "memory");
        } else {
            XB_SPIN(xb_ld(&bar[XB_XGEN(b.x)]) == gen, bar);
            __builtin_amdgcn_fence(__ATOMIC_ACQUIRE, "agent");
            asm volatile("s_waitcnt vmcnt(0)" ::: "memory");
        }
    }
    __syncthreads();
}

namespace pg8 {
constexpr int BM = 256, BK = 64, HALF = 128, HTB = HALF * BK * 2, STAGE_BYTES = 8 * HTB, NXCD = 8, WGM = 8;
__host__ __device__ __forceinline__ int lds_byte(int r, int c) { const int st = (r >> 4) * 2 + (c >> 5), rr = r & 15, cc = c & 31, ob = rr * 64 + cc * 2; return st * 1024 + (ob ^ (((ob >> 9) & 1) << 5)); }
__host__ __device__ __forceinline__ void stage_rc(int b, int& R, int& C) { const int st = b / 1024, sb = b % 1024, swz = sb ^ (((sb >> 9) & 1) << 5); R = (st >> 1) * 16 + swz / 64; C = (st & 1) * 32 + (swz % 64) / 2; }
__host__ __device__ __forceinline__ int perm32(int rho) { const int n = rho >> 4, i = rho & 15; return 8 * (i >> 2) + 4 * n + (i & 3); }

struct Unit { int pm, pn, cls, row0, ncls, elo, ehi; };

struct StaticOrder {
    int nM, nN, nwg, G, c;
    __device__ void init(int M, int N, int G_, int c_) { nM = M / BM; nN = N / BM; nwg = nM * nN; G = G_; c = c_; }
    __device__ __forceinline__ bool next(int i, Unit& u) const {
        const long L = (long)i * G + c; if (L >= nwg) return false;
        int wgid = (int)L; { const int q = nwg / NXCD, r = nwg % NXCD, xcd = wgid % NXCD, off = wgid / NXCD; wgid = (xcd < r ? xcd * (q + 1) : r * (q + 1) + (xcd - r) * q) + off; }
        const int nig = WGM * nN, gid = wgid / nig, fm = gid * WGM, gsz = (nM - fm) < WGM ? (nM - fm) : WGM;
        u.pm = fm + ((wgid % nig) % gsz); u.pn = (wgid % nig) / gsz; u.cls = 0; u.row0 = 0; u.ncls = 0; u.elo = 0; u.ehi = 0; return true;
    }
};

struct ProbDense {
    const char* A; const char* B; int lda, ldb, nt; StaticOrder S; bool skip_ctx;
    __device__ __forceinline__ bool next(int i, Unit& u) const { if (!S.next(i, u)) return false; if (skip_ctx) u.pm += 1 + (u.pm >= 64 ? 1 : 0); return true; }
    __device__ __forceinline__ void a_offs(const Unit& u, int tid, unsigned (&off)[2][2]) const {
#pragma unroll
        for (int i = 0; i < 2; ++i) { int R, C; stage_rc(tid * 16 + i * 8192, R, C);
#pragma unroll
            for (int h = 0; h < 2; ++h) off[h][i] = (unsigned)((u.pm * BM + h * HALF + R) * lda + C) * 2u; }
    }
    __device__ __forceinline__ const char* b_ptr(const Unit& u, int t) const { return B + (size_t)u.pn * BM * ldb * 2 + (size_t)t * (BK * 2); }
};
__device__ __forceinline__ void moe_unit(const LAS int* s_n, const LAS int* s_ts, int rt, Unit& u) {
    int cc = 0; while (s_ts[cc + 1] <= rt) ++cc;
    u.pm = rt; u.cls = cc; u.row0 = (rt - s_ts[cc]) * BM; u.ncls = s_n[cc];
    const int g = cc / 6, idx = cc % 6; const int a = idx < 3 ? 0 : (idx < 5 ? 1 : 2), b = idx < 3 ? idx + 1 : (idx < 5 ? idx - 1 : 3);
    u.elo = 4 * g + a; u.ehi = 4 * g + b;
}
struct ProbGU {
    const char* A; const char* B; const int* tok; const LAS int* s_n; const LAS int* s_ts; int total, G, c; static constexpr int ldb = 1024; int nt;
    __device__ __forceinline__ bool next(int i, Unit& u) const { const long L = (long)i * G + c; if (L >= total) return false; u.pn = (int)(L & 7); moe_unit(s_n, s_ts, (int)(L >> 3), u); return true; }
    __device__ __forceinline__ void a_offs(const Unit& u, int tid, unsigned (&off)[2][2]) const {
#pragma unroll
        for (int i = 0; i < 2; ++i) { int R, C; stage_rc(tid * 16 + i * 8192, R, C);
#pragma unroll
            for (int h = 0; h < 2; ++h) { int r = u.row0 + h * HALF + R; r = r < u.ncls ? r : u.ncls - 1; const int t = tok[(size_t)u.cls * CAP + r]; off[h][i] = (unsigned)t * 2048u + (unsigned)C * 2u; } }
    }
    __device__ __forceinline__ const char* b_ptr(const Unit& u, int t) const { const int e = u.pn >= 4 ? u.ehi : u.elo; return B + (size_t)e * (1024 * 1024 * 2) + (size_t)(u.pn & 3) * (BM * 1024 * 2) + (size_t)t * (BK * 2); }
};
struct ProbDown {
    const char* A; const char* B; const LAS int* s_n; const LAS int* s_ts; int total, G, c; static constexpr int ldb = 512; int nt;
    __device__ __forceinline__ bool next(int i, Unit& u) const { const long L = (long)i * G + c; if (L >= total) return false; u.pn = (int)(L & 3); moe_unit(s_n, s_ts, (int)(L >> 2), u); return true; }
    __device__ __forceinline__ void a_offs(const Unit& u, int tid, unsigned (&off)[2][2]) const {
#pragma unroll
        for (int i = 0; i < 2; ++i) { int R, C; stage_rc(tid * 16 + i * 8192, R, C);
#pragma unroll
            for (int h = 0; h < 2; ++h) off[h][i] = (unsigned)(u.pm * BM + h * HALF + R) * 2048u + (unsigned)C * 2u; }
    }
    __device__ __forceinline__ const char* b_ptr(const Unit& u, int t) const { const int e = t < 8 ? u.elo : u.ehi; return B + (size_t)e * (1024 * 512 * 2) + (size_t)u.pn * (BM * 512 * 2) + (size_t)(t & 7) * (BK * 2); }
};

template <class Epi, class Prob, bool ALIGN_EPI>
__device__ __forceinline__ void gemm_phase(LAS unsigned char* lds, LAS unsigned char* offs_lds, const Prob& P, const Epi& E) {
    int tid_ = threadIdx.x; asm volatile("" : "+v"(tid_));
    const int tid = tid_, wid = __builtin_amdgcn_readfirstlane(tid >> 6), lane = tid & 63, wr = wid >> 2, wc = wid & 3, fr = lane & 15, fq = lane >> 4;
    const int nt = P.nt;
    unsigned voffB[2];
#pragma unroll
    for (int i = 0; i < 2; ++i) { int R, C; stage_rc(tid * 16 + i * 8192, R, C); const int Rb = Epi::PERM ? ((R & ~31) + perm32(R & 31)) : R; voffB[i] = (unsigned)(Rb * P.ldb + C) * 2u; }
    LAS u32x4* const myoffs = (LAS u32x4*)offs_lds + tid;
    const size_t hstepB = (size_t)HALF * P.ldb * 2;
    const unsigned ldsw = (unsigned)wid * 1024u;
    const int aoff = lds_byte(wr * 64 + fr, fq * 8), boff = lds_byte(wc * 32 + fr, fq * 8);
    const char* const Ab = P.A;
#define PG8_SA(b, h) (((b) * 2 + (h)) * HTB)
#define PG8_SB(b, h) ((4 + (b) * 2 + (h)) * HTB)
#define PG8_STAGE_A(bufoff, h, offs, kt) do { _Pragma("unroll") for (int _i = 0; _i < 2; ++_i) \
        __builtin_amdgcn_global_load_lds((const unsigned*)(Ab + (size_t)(offs)[h][_i] + (size_t)(kt) * (BK * 2)), (LAS unsigned*)(lds + (bufoff) + ldsw + _i * 8192), 16, 0, 0); } while (0)
#define PG8_STAGE_B(bufoff, bp) do { _Pragma("unroll") for (int _i = 0; _i < 2; ++_i) \
        __builtin_amdgcn_global_load_lds((const unsigned*)((bp) + voffB[_i]), (LAS unsigned*)(lds + (bufoff) + ldsw + _i * 8192), 16, 0, 0); } while (0)
#define PG8_LDA(dst, b, h) do { _Pragma("unroll") for (int m = 0; m < 4; ++m) _Pragma("unroll") for (int k = 0; k < 2; ++k) dst[m][k] = *(const LAS bf16x8*)(lds + PG8_SA(b, h) + aoff + m * 2048 + k * 1024); } while (0)
#define PG8_LDB(dst, b, h) do { _Pragma("unroll") for (int n = 0; n < 2; ++n) _Pragma("unroll") for (int k = 0; k < 2; ++k) dst[n][k] = *(const LAS bf16x8*)(lds + PG8_SB(b, h) + boff + n * 2048 + k * 1024); } while (0)
#define PG8_MMA(ai, bj, At, Bt) do { __builtin_amdgcn_s_setprio(1); _Pragma("unroll") for (int m = 0; m < 4; ++m) _Pragma("unroll") for (int n = 0; n < 2; ++n) _Pragma("unroll") for (int k = 0; k < 2; ++k) \
        acc[ai][bj][m][n] = __builtin_amdgcn_mfma_f32_16x16x32_bf16(Bt[n][k], At[m][k], acc[ai][bj][m][n], 0, 0, 0); __builtin_amdgcn_s_setprio(0); } while (0)
#define PG8_WAIT_V(n) asm volatile("s_waitcnt vmcnt(" #n ")" ::: "memory")
#define PG8_WAIT_L(n) asm volatile("s_waitcnt lgkmcnt(" #n ")" ::: "memory")
#define PG8_BAR __builtin_amdgcn_s_barrier()
#define PG8_SCHED __builtin_amdgcn_sched_barrier(0)
    Unit cur, nxt; int ui = 0;
    if (!P.next(0, cur)) return;
    f32x4 acc[2][2][4][2];
#pragma unroll
    for (int a = 0; a < 2; ++a)
#pragma unroll
        for (int b = 0; b < 2; ++b)
#pragma unroll
            for (int m = 0; m < 4; ++m)
#pragma unroll
                for (int n = 0; n < 2; ++n) acc[a][b][m][n] = (f32x4){0.f, 0.f, 0.f, 0.f};
    bf16x8 At[4][2], B0[2][2], B1[2][2];
    unsigned offC[2][2];
    P.a_offs(cur, tid, offC);
    {
        const char* b0 = P.b_ptr(cur, 0); const char* b1 = P.b_ptr(cur, 1);
        PG8_STAGE_B(PG8_SB(0, 0), b0); PG8_STAGE_B(PG8_SB(0, 1), b0 + hstepB); PG8_STAGE_A(PG8_SA(0, 0), 0, offC, 0); PG8_STAGE_A(PG8_SA(0, 1), 1, offC, 0);
        if (wr == 1) PG8_BAR;
        PG8_WAIT_V(2); PG8_BAR;
        PG8_STAGE_B(PG8_SB(1, 0), b1); PG8_STAGE_A(PG8_SA(1, 0), 0, offC, 1); PG8_STAGE_B(PG8_SB(1, 1), b1 + hstepB);
        PG8_WAIT_V(6); PG8_BAR;
    }
    for (;;) {
        const bool has_next = P.next(ui + 1, nxt);
        if (!has_next) nxt = cur;
        {
            unsigned offN[2][2];
            if (has_next) P.a_offs(nxt, tid, offN);
            else {
#pragma unroll
                for (int h = 0; h < 2; ++h)
#pragma unroll
                    for (int i = 0; i < 2; ++i) offN[h][i] = offC[h][i];
            }
            *myoffs = (u32x4){offN[0][0], offN[0][1], offN[1][0], offN[1][1]};
        }
        for (int t = 0; t < nt; t += 2) {
            const bool last = (t == nt - 2);
            const int k2 = last ? 0 : t + 2;
            const char* b2 = last ? P.b_ptr(nxt, 0) : P.b_ptr(cur, t + 2);
            const char* b3 = last ? P.b_ptr(nxt, 1) : P.b_ptr(cur, t + 3);
            PG8_LDB(B0, 0, 0); PG8_LDB(B1, 0, 1); PG8_SCHED; PG8_LDA(At, 0, 0); PG8_STAGE_A(PG8_SA(1, 1), 1, offC, t + 1);
            if (last) { const u32x4 v = *myoffs; offC[0][0] = v.x; offC[0][1] = v.y; offC[1][0] = v.z; offC[1][1] = v.w; }
            PG8_WAIT_V(8); PG8_WAIT_L(0); PG8_BAR; PG8_MMA(0, 0, At, B0); PG8_MMA(0, 1, At, B1); PG8_BAR; PG8_SCHED;
            PG8_LDA(At, 0, 1); PG8_STAGE_B(PG8_SB(0, 0), b2); PG8_STAGE_B(PG8_SB(0, 1), b2 + hstepB); PG8_STAGE_A(PG8_SA(0, 0), 0, offC, k2);
            PG8_WAIT_V(8); PG8_WAIT_L(0); PG8_BAR; PG8_MMA(1, 0, At, B0); PG8_MMA(1, 1, At, B1); PG8_BAR; PG8_SCHED;
            PG8_LDB(B0, 1, 0); PG8_LDB(B1, 1, 1); PG8_SCHED; PG8_LDA(At, 1, 0); PG8_STAGE_A(PG8_SA(0, 1), 1, offC, k2);
            PG8_WAIT_V(8); PG8_WAIT_L(0); PG8_BAR; PG8_MMA(0, 0, At, B0); PG8_MMA(0, 1, At, B1); PG8_BAR; PG8_SCHED;
            PG8_LDA(At, 1, 1); PG8_STAGE_B(PG8_SB(1, 0), b3); PG8_STAGE_B(PG8_SB(1, 1), b3 + hstepB); PG8_STAGE_A(PG8_SA(1, 0), 0, offC, k2 + 1);
            PG8_WAIT_V(8); PG8_WAIT_L(0); PG8_BAR; PG8_MMA(1, 0, At, B0); PG8_MMA(1, 1, At, B1); PG8_BAR; PG8_SCHED;
        }
        if constexpr (ALIGN_EPI) { if (wr == 0) PG8_BAR; }
        E(acc, cur, wr, wc, fr, fq);
        if (!has_next) break;
#pragma unroll
        for (int a = 0; a < 2; ++a)
#pragma unroll
            for (int b = 0; b < 2; ++b)
#pragma unroll
                for (int m = 0; m < 4; ++m)
#pragma unroll
                    for (int n = 0; n < 2; ++n) acc[a][b][m][n] = (f32x4){0.f, 0.f, 0.f, 0.f};
        cur = nxt; ++ui;
        if constexpr (ALIGN_EPI) { if (wr == 1) PG8_BAR; }
    }
    PG8_WAIT_V(0);
    if constexpr (!ALIGN_EPI) { if (wr == 0) PG8_BAR; }
    PG8_BAR;
#undef PG8_SA
#undef PG8_SB
#undef PG8_STAGE_A
#undef PG8_STAGE_B
#undef PG8_LDA
#undef PG8_LDB
#undef PG8_MMA
#undef PG8_WAIT_V
#undef PG8_WAIT_L
#undef PG8_BAR
#undef PG8_SCHED
}
}

namespace pg8 {
struct EpiQKV {
    static constexpr bool PERM = true;
    unsigned char* ws; const float* gn; const float* rope;
    __device__ __forceinline__ void operator()(const f32x4 (&acc)[2][2][4][2], const Unit& u, int wr, int wc, int fr, int fq) const {
        const int pn = u.pn, tb_ = u.pm % 65;
        const bool is_ctx = (tb_ == 0);
        const bool isV = (pn >= 4) && (wc >= 2);
        const float* gain = gn + (pn < 2 ? 0 : (pn < 4 ? 64 : (pn == 4 ? 128 : 192)));
        const int strm = 2 * (pn - 4) + (wc & 1);
#pragma unroll
        for (int ai = 0; ai < 2; ++ai)
#pragma unroll
            for (int m = 0; m < 4; ++m) {
                int mfr = m * 16 + fr; asm volatile("" : "+v"(mfr));
                const int row = u.pm * BM + ai * HALF + wr * 64 + mfr;
                f32x4 v[2][2];
#pragma unroll
                for (int bj = 0; bj < 2; ++bj)
#pragma unroll
                    for (int n = 0; n < 2; ++n) v[bj][n] = acc[ai][bj][m][n];
                if (!isV) {
                    float ss = 0.f;
#pragma unroll
                    for (int bj = 0; bj < 2; ++bj)
#pragma unroll
                        for (int n = 0; n < 2; ++n) { const f32x4 x = v[bj][n]; ss += (x[0] * x[0] + x[1] * x[1]) + (x[2] * x[2] + x[3] * x[3]); }
                    ss += __shfl_xor(ss, 16); ss += __shfl_xor(ss, 32);
                    const float rs = SQC2 / sqrtf(ss * (1.0f / 64.0f) + NORM_EPS);
#pragma unroll
                    for (int bj = 0; bj < 2; ++bj)
#pragma unroll
                        for (int n = 0; n < 2; ++n) v[bj][n] = v[bj][n] * rs * *(const f32x4*)(gain + 32 * bj + 16 * n + 4 * fq);
                    if (!is_ctx) {
                        const int pr = (tb_ - 1) * 4 + 2 * ai + wr, pc = mfr;
#pragma unroll
                        for (int bj = 0; bj < 2; ++bj) {
                            const int pos = bj ? pc : pr;
                            const f32x4* rp = (const f32x4*)(rope + (size_t)(pos * 16 + 4 * fq) * 2);
                            const f32x4 r0 = rp[0], r1 = rp[1];
                            const f32x4 cs = (f32x4){r0[0], r0[2], r1[0], r1[2]}, sn = (f32x4){r0[1], r0[3], r1[1], r1[3]};
                            const f32x4 x1 = v[bj][0], x2 = v[bj][1];
                            v[bj][0] = x1 * cs - x2 * sn; v[bj][1] = x2 * cs + x1 * sn;
                        }
                    }
                }
                if (pn < 4) {
                    unsigned char* rowp = ws + WS_QO + (size_t)row * 1024 + 256 * pn + 64 * wc + 4 * fq;
#pragma unroll
                    for (int bj = 0; bj < 2; ++bj)
#pragma unroll
                        for (int n = 0; n < 2; ++n) { int w = __builtin_amdgcn_cvt_pk_fp8_f32(v[bj][n][0], v[bj][n][1], 0, false); w = __builtin_amdgcn_cvt_pk_fp8_f32(v[bj][n][2], v[bj][n][3], w, true);
                            *(int*)(rowp + 32 * bj + 16 * n) = w; }
                } else {
                    unsigned char* tb = ws + WS_KV + (size_t)(u.pm * 4 + ai * 2 + wr) * KV_TILEB + (isV ? 16384 + strm * KV_VSL : strm * 4096);
                    if (!isV) {
                        const int kk = mfr; const unsigned kof = (unsigned)(kk * 64 + 4 * fq), ksw = (unsigned)((kk >> 2) & 3);
#pragma unroll
                        for (int bj = 0; bj < 2; ++bj)
#pragma unroll
                            for (int n = 0; n < 2; ++n) { int w = __builtin_amdgcn_cvt_pk_fp8_f32(v[bj][n][0], v[bj][n][1], 0, false); w = __builtin_amdgcn_cvt_pk_fp8_f32(v[bj][n][2], v[bj][n][3], w, true);
                                *(int*)(tb + (kof + (((unsigned)(2 * bj + n) ^ ksw) * 16u))) = w; }
                    } else {
#if VFP8
                        const int kk = mfr, uu = kk >> 5, w5 = kk & 31, hh = (w5 >> 2) & 1, jb = (w5 & 3) + 4 * (w5 >> 3);
                        const unsigned vof = (unsigned)(4 * fq * 64 + (((2 * hh + uu) ^ fq) * 16) + jb);
#pragma unroll
                        for (int bj = 0; bj < 2; ++bj)
#pragma unroll
                            for (int n = 0; n < 2; ++n)
#pragma unroll
                                for (int jp = 0; jp < 2; ++jp) { const int w = __builtin_amdgcn_cvt_pk_fp8_f32(v[bj][n][2 * jp], v[bj][n][2 * jp + 1], 0, false);
                                    *(unsigned char*)(tb + (vof + (unsigned)((32 * bj + 16 * n + 2 * jp) * 64))) = (unsigned char)w; *(unsigned char*)(tb + (vof + (unsigned)((32 * bj + 16 * n + 2 * jp + 1) * 64))) = (unsigned char)(w >> 8); }
#else
                        const int fr_ = mfr & 15, m_ = mfr >> 4, sub = fr_ >> 2, hb = sub & 1;
                        const unsigned vbase = (unsigned)(4 * fq * 128 + (4 * (sub >> 1) + (fr_ & 3)) * 2);
#pragma unroll
                        for (int j = 0; j < 4; ++j) { const int swz = (2 * fq + (j >> 1)) & 7;
                            const unsigned vof = vbase + (unsigned)(j * 128) + (unsigned)((((2 * m_) ^ (swz & 6)) | ((hb ^ swz) & 1)) * 16);
#pragma unroll
                            for (int bj = 0; bj < 2; ++bj)
#pragma unroll
                                for (int n = 0; n < 2; ++n) *(bf16_t*)(tb + (vof + (unsigned)((32 * bj + 16 * n) * 128))) = (bf16_t)f2bf(v[bj][n][j]); }
#endif
                    }
                }
            }
    }
};
__device__ __forceinline__ float bf_lo(unsigned w) { return __builtin_bit_cast(float, w << 16); }
__device__ __forceinline__ float bf_hi(unsigned w) { return __builtin_bit_cast(float, w & 0xffff0000u); }
struct EpiResid {
    static constexpr bool PERM = true;
    bf16_t* XS; const float* modv_l; int goff; float sgn;
    __device__ __forceinline__ void operator()(const f32x4 (&acc)[2][2][4][2], const Unit& u, int wr, int wc, int fr, int fq) const {
        const int mv = (u.pm % 65 == 0) ? 2 : (u.pm / 65);
        const float* g = modv_l + mv * 6144 + goff;
        const int col0 = u.pn * BM + wc * 32 + 8 * fq;
        f32x4 gv[2][2];
#pragma unroll
        for (int bj = 0; bj < 2; ++bj)
#pragma unroll
            for (int n = 0; n < 2; ++n) gv[bj][n] = *(const f32x4*)(g + col0 + bj * HALF + n * 4) * sgn;
#pragma unroll
        for (int ai = 0; ai < 2; ++ai)
#pragma unroll
            for (int m = 0; m < 4; ++m) {
                bf16_t* rowp = XS + (size_t)(u.pm * BM + ai * HALF + wr * 64 + m * 16 + fr) * 1024 + col0;
#pragma unroll
                for (int bj = 0; bj < 2; ++bj) { u32x4* p = (u32x4*)(rowp + bj * HALF); const u32x4 w = *p; u32x4 o;
                    const f32x4 a0 = gv[bj][0] * acc[ai][bj][m][0], a1 = gv[bj][1] * acc[ai][bj][m][1];
                    o.x = cvt_pk_bf16(bf_lo(w.x) + a0[0], bf_hi(w.x) + a0[1]); o.y = cvt_pk_bf16(bf_lo(w.y) + a0[2], bf_hi(w.y) + a0[3]);
                    o.z = cvt_pk_bf16(bf_lo(w.z) + a1[0], bf_hi(w.z) + a1[1]); o.w = cvt_pk_bf16(bf_lo(w.w) + a1[2], bf_hi(w.w) + a1[3]);
                    *p = o; }
            }
    }
};
struct EpiGU {
    static constexpr bool PERM = true;
    bf16_t* ACT; const f32x2* wts;
    __device__ __forceinline__ void operator()(const f32x4 (&acc)[2][2][4][2], const Unit& u, int wr, int wc, int fr, int fq) const {
        const int k = u.pn >= 4 ? 1 : 0, jt = u.pn & 3;
        const int colbase = 512 * k + 128 * jt + 32 * wc + 8 * fq;
#pragma unroll
        for (int ai = 0; ai < 2; ++ai)
#pragma unroll
            for (int m = 0; m < 4; ++m) {
                const int r = ai * HALF + wr * 64 + m * 16 + fr;
                int idx = u.row0 + r; idx = idx < u.ncls ? idx : u.ncls - 1;
                const f32x2 w2 = wts[(size_t)u.cls * CAP + idx];
                const float w = k ? w2[1] : w2[0];
                u32x4 o;
#pragma unroll
                for (int n = 0; n < 2; ++n) {
                    const f32x4 g = acc[ai][0][m][n], up = acc[ai][1][m][n]; float a[4];
#pragma unroll
                    for (int j = 0; j < 4; ++j) { const float sg = g[j] * __builtin_amdgcn_rcpf(1.0f + __builtin_amdgcn_exp2f(-g[j] * LOG2E)); a[j] = w * sg * up[j]; }
                    const unsigned lo = cvt_pk_bf16(a[0], a[1]), hi = cvt_pk_bf16(a[2], a[3]);
                    if (n == 0) { o.x = lo; o.y = hi; } else { o.z = lo; o.w = hi; }
                }
                *(u32x4*)(ACT + (size_t)(u.pm * BM + r) * 1024 + colbase) = o;
            }
    }
};
struct EpiDown {
    static constexpr bool PERM = true;
    bf16_t* XS; float* out; const int* tok; const float* modv_l; float sgn;
    __device__ __forceinline__ void operator()(const f32x4 (&acc)[2][2][4][2], const Unit& u, int wr, int wc, int fr, int fq) const {
        const int col0 = u.pn * BM + wc * 32 + 8 * fq;
#pragma unroll
        for (int ai = 0; ai < 2; ++ai)
#pragma unroll
            for (int m = 0; m < 4; ++m) {
                const int idx = u.row0 + ai * HALF + wr * 64 + m * 16 + fr;
                if (idx < u.ncls) {
                    const int t = tok[(size_t)u.cls * CAP + idx];
                    const int b = t >= RB ? 1 : 0, rr = t - b * RB;
                    const int mv = rr < NCTX ? 2 : b;
                    const float* g = modv_l + mv * 6144 + 5120 + col0;
                    bf16_t* xp = XS + (size_t)t * 1024 + col0;
                    float* op = out + (size_t)(b * SEQ + rr - NCTX) * 1024 + col0;
#pragma unroll
                    for (int bj = 0; bj < 2; ++bj) { const u32x4 w = *(const u32x4*)(xp + bj * HALF);
                        const f32x4 a0 = (*(const f32x4*)(g + bj * HALF) * sgn) * acc[ai][bj][m][0], a1 = (*(const f32x4*)(g + bj * HALF + 4) * sgn) * acc[ai][bj][m][1];
                        const f32x4 x0 = (f32x4){bf_lo(w.x) + a0[0], bf_hi(w.x) + a0[1], bf_lo(w.y) + a0[2], bf_hi(w.y) + a0[3]}, x1 = (f32x4){bf_lo(w.z) + a1[0], bf_hi(w.z) + a1[1], bf_lo(w.w) + a1[2], bf_hi(w.w) + a1[3]};
                        if (out) { *(f32x4*)(op + bj * HALF) = x0; *(f32x4*)(op + bj * HALF + 4) = x1; }
                        else { u32x4 o; o.x = cvt_pk_bf16(x0[0], x0[1]); o.y = cvt_pk_bf16(x0[2], x0[3]); o.z = cvt_pk_bf16(x1[0], x1[1]); o.w = cvt_pk_bf16(x1[2], x1[3]); *(u32x4*)(xp + bj * HALF) = o; }
                    }
                }
            }
    }
};
}

namespace attn_body {
using bf16 = __hip_bfloat16;
using s16x4 = __attribute__((ext_vector_type(4))) short;
using f32x16 = __attribute__((ext_vector_type(16))) float;
constexpr int D = 64, QP = 1024, KP = 512;
constexpr int NW = 8, QBLK = 32, QB = QBLK * NW, KVBLK = 64;
__device__ __forceinline__ int crow(int r, int hi) { return (r & 3) + 8 * (r >> 2) + 4 * hi; }
#define SBAR() __builtin_amdgcn_sched_barrier(0)
constexpr int NSLOT = 3, SLOTB = 8192;
constexpr int LDS_K = 0, LDS_V = NSLOT * SLOTB, LDS_WS = 2 * NSLOT * SLOTB, LDS_OST = LDS_WS + NW * 64 * 4, LDS_BYTES = LDS_OST + NW * 4096;
__device__ __forceinline__ void glds16(const void* gsrc, unsigned lds_dst) { unsigned keep;
  asm volatile("s_mov_b32 %0, m0\n\ts_mov_b32 m0, %2\n\ts_nop 0\n\tglobal_load_lds_dwordx4 %1, off\n\ts_mov_b32 m0, %0" : "=&s"(keep) : "v"(gsrc), "s"(lds_dst) : "memory"); }
__device__ __forceinline__ float max3f(float a, float b, float c) { float r; asm("v_max3_f32 %0, %1, %2, %3" : "=v"(r) : "v"(a), "v"(b), "v"(c)); return r; }
__device__ __forceinline__ float max2f(float a, float b) { float r; asm("v_max_f32_e32 %0, %1, %2" : "=v"(r) : "v"(a), "v"(b)); return r; }
__device__ __forceinline__ float fadd_s(float a, float b) { float r; asm("v_add_f32_e32 %0, %1, %2" : "=v"(r) : "v"(a), "v"(b)); return r; }
__device__ __forceinline__ float fsub_s(float a, float b) { float r; asm("v_sub_f32_e32 %0, %1, %2" : "=v"(r) : "v"(a), "v"(b)); return r; }
typedef float f32x2_t __attribute__((ext_vector_type(2))); typedef __bf16 bf16x2_t __attribute__((ext_vector_type(2)));
__device__ __forceinline__ unsigned cvtpk_s(float lo, float hi) { f32x2_t v = {lo, hi}; bf16x2_t b = __builtin_convertvector(v, bf16x2_t); return __builtin_bit_cast(unsigned, b); }
#define WAIT_BAR(N) asm volatile("s_waitcnt vmcnt(" #N ") lgkmcnt(0)\n\ts_barrier" ::: "memory")

__device__ __forceinline__ void qkt(f32x16& p0, f32x16& p1, const char* Kslot, const bf16x8* qr, const f32x16& negm, int r32, int hi) {
  const char* kb = Kslot + hi * 1024 + r32 * 16;
  #pragma unroll
  for (int d0 = 0; d0 < 4; ++d0) {
    const bf16x8 b0 = *reinterpret_cast<const bf16x8*>(kb + d0 * 2048);
    const bf16x8 b1 = *reinterpret_cast<const bf16x8*>(kb + d0 * 2048 + 512);
    if (d0 == 0) { p0 = __builtin_amdgcn_mfma_f32_32x32x16_bf16(b0, qr[0], negm, 0, 0, 0); p1 = __builtin_amdgcn_mfma_f32_32x32x16_bf16(b1, qr[0], negm, 0, 0, 0); }
    else { p0 = __builtin_amdgcn_mfma_f32_32x32x16_bf16(b0, qr[d0], p0, 0, 0, 0); p1 = __builtin_amdgcn_mfma_f32_32x32x16_bf16(b1, qr[d0], p1, 0, 0, 0); } }
}
typedef __attribute__((address_space(3))) const char* lds_cptr;
typedef short v4i16_t __attribute__((ext_vector_type(4)));
__device__ __forceinline__ void kload8(bf16x8* kf, lds_cptr kp) {
  kf[0] = *(const LAS bf16x8*)(kp);        kf[1] = *(const LAS bf16x8*)(kp + 512);
  kf[2] = *(const LAS bf16x8*)(kp + 2048); kf[3] = *(const LAS bf16x8*)(kp + 2560);
  kf[4] = *(const LAS bf16x8*)(kp + 4096); kf[5] = *(const LAS bf16x8*)(kp + 4608);
  kf[6] = *(const LAS bf16x8*)(kp + 6144); kf[7] = *(const LAS bf16x8*)(kp + 6656);
}
__device__ __forceinline__ void kload2(bf16x8* kf, lds_cptr kp, int j) { kf[2 * j] = *(const LAS bf16x8*)(kp + j * 2048); kf[2 * j + 1] = *(const LAS bf16x8*)(kp + j * 2048 + 512); }
__device__ __forceinline__ s16x4 vtr(lds_cptr p) { return __builtin_bit_cast(s16x4, __builtin_amdgcn_ds_read_tr16_b64_v4i16((LAS v4i16_t*)p)); }
__device__ __forceinline__ float rowmax(const f32x16& p0, const f32x16& p1) {
  float a = max3f(p0[0], p0[1], p1[0]), b = max3f(p0[2], p0[3], p1[1]); a = max3f(a, p1[2], p1[3]);
  #pragma unroll
  for (int r = 4; r < 16; r += 4) { a = max3f(a, p0[r], p0[r + 1]); b = max3f(b, p0[r + 2], p0[r + 3]); a = max3f(a, p1[r], p1[r + 1]); b = max3f(b, p1[r + 2], p1[r + 3]); }
  const float m = max2f(a, b);
  auto rr = __builtin_amdgcn_permlane32_swap(__float_as_uint(m), __float_as_uint(m), false, false);
  return max2f(__uint_as_float(rr[0]), __uint_as_float(rr[1]));
}
__device__ __forceinline__ void pv(f32x16* o, int vb, bf16x8 pa0, bf16x8 pa1, bf16x8 pa2, bf16x8 pa3) {
  #pragma unroll
  for (int d0 = 0; d0 < 2; ++d0) { s16x4 lo[4], hi[4];
    #pragma unroll
    for (int ks = 0; ks < 4; ++ks) {
      asm volatile("ds_read_b64_tr_b16 %0,%1 offset:%c2" : "=&v"(lo[ks]) : "v"(vb), "i"(d0 * 4096 + ks * 1024) : "memory");
      asm volatile("ds_read_b64_tr_b16 %0,%1 offset:%c2" : "=&v"(hi[ks]) : "v"(vb), "i"(d0 * 4096 + ks * 1024 + 512) : "memory"); }
    asm volatile("s_waitcnt lgkmcnt(0)" ::: "memory"); SBAR();
    #define PK(k) (bf16x8){lo[k][0], lo[k][1], lo[k][2], lo[k][3], hi[k][0], hi[k][1], hi[k][2], hi[k][3]}
    o[d0] = __builtin_amdgcn_mfma_f32_32x32x16_bf16(pa0, PK(0), o[d0], 0, 0, 0);
    o[d0] = __builtin_amdgcn_mfma_f32_32x32x16_bf16(pa1, PK(1), o[d0], 0, 0, 0);
    o[d0] = __builtin_amdgcn_mfma_f32_32x32x16_bf16(pa2, PK(2), o[d0], 0, 0, 0);
    o[d0] = __builtin_amdgcn_mfma_f32_32x32x16_bf16(pa3, PK(3), o[d0], 0, 0, 0);
    #undef PK
  }
}
__device__ __forceinline__ void pv2(f32x16* o, const lds_cptr* vq, int slot, bf16x8 pa0, bf16x8 pa1, bf16x8 pa2, bf16x8 pa3) {
  #pragma unroll
  for (int d0 = 0; d0 < 2; ++d0) {
    const bf16x8 v0 = *(const LAS bf16x8*)(vq[0] + slot + d0 * 4096), v1 = *(const LAS bf16x8*)(vq[1] + slot + d0 * 4096), v2 = *(const LAS bf16x8*)(vq[2] + slot + d0 * 4096), v3 = *(const LAS bf16x8*)(vq[3] + slot + d0 * 4096);
    o[d0] = __builtin_amdgcn_mfma_f32_32x32x16_bf16(pa0, v0, o[d0], 0, 0, 0);
    o[d0] = __builtin_amdgcn_mfma_f32_32x32x16_bf16(pa1, v1, o[d0], 0, 0, 0);
    o[d0] = __builtin_amdgcn_mfma_f32_32x32x16_bf16(pa2, v2, o[d0], 0, 0, 0);
    o[d0] = __builtin_amdgcn_mfma_f32_32x32x16_bf16(pa3, v3, o[d0], 0, 0, 0);
  }
}
__device__ __forceinline__ void bandmask(f32x16& p0, f32x16& p1, int t, int mlo, unsigned mspan, int qrel, int hi) {
  const float NEG = -INFINITY; const int kb = 64 * (t - 4) - 128 + 4 * hi - qrel - mlo;
  #pragma unroll
  for (int r = 0; r < 16; ++r) { const int d0 = kb + (r & 3) + 8 * (r >> 2); if ((unsigned)d0 > mspan) p0[r] = NEG; if ((unsigned)(d0 + 32) > mspan) p1[r] = NEG; }
}
#ifndef FASTEXP
#define FASTEXP 0
#endif
__device__ __forceinline__ float exp2_fast(float x) { const float t = __builtin_fmaf(x, 8388608.0f, 1064986823.0f); unsigned u; asm("v_cvt_u32_f32 %0, %1" : "=v"(u) : "v"(t)); return __builtin_bit_cast(float, u); }
#define ATTN_STORE16(p, v) (*(u32x4*)(p) = (v))

template <int MODE, int THRL> __device__ __forceinline__ void attn_unit(long qrow, long kvrow, int q0, int qcol, int kcol, int vcol, int NT, float sink2, const bf16* Q, const bf16* __restrict__ KVb, bf16* O, char* shm) {
  int tid_ = threadIdx.x; asm volatile("" : "+v"(tid_));
  const int tid = tid_, lane = tid & 63, r32 = lane & 31, hi = lane >> 5; const int wid = __builtin_amdgcn_readfirstlane(tid >> 6);
  const bf16* Qw = Q + (qrow + wid * QBLK) * QP + qcol;
  const char* kvt = (const char*)KVb + (size_t)(kvrow >> 6) * 65536 + wid * 1024 + lane * 16;
  const unsigned lds0 = (unsigned)(uintptr_t)shm;
  float* wsf = (float*)(shm + LDS_WS) + wid * 64;
  const char* ksrc = kvt + kcol * 8192; const char* vsrc = kvt + vcol * 8192;
  const unsigned kdst = lds0 + LDS_K + wid * 1024, vdst = lds0 + LDS_V + wid * 1024;
  #define ROWOFF(t) ((long)(MODE == 1 ? ((t) + ((t) >= 4 ? ((q0 - 128) >> 6) : 0)) : (t)) * 65536)
  #define DMA_K(t, slot) glds16(ksrc + ROWOFF(t), (unsigned)__builtin_amdgcn_readfirstlane(kdst + (slot)))
  #define DMA_V(t, slot) glds16(vsrc + ROWOFF(t), (unsigned)__builtin_amdgcn_readfirstlane(vdst + (slot)))
  const char* Kbase = shm + LDS_K; bf16x8 kf[8];
  const lds_cptr shm3 = (lds_cptr)shm; const lds_cptr kp0 = shm3 + LDS_K + hi * 1024 + r32 * 16; lds_cptr vq[4];
  { const int swz = (r32 >> 1) & 7; _Pragma("unroll") for (int ks_ = 0; ks_ < 4; ++ks_) vq[ks_] = shm3 + LDS_V + r32 * 128 + (((2 * ks_ + hi) ^ swz) * 16); }
  DMA_K(0, 0); DMA_V(0, 0); DMA_K(1, SLOTB);
  bf16x8 qr[4];
  #pragma unroll
  for (int d0 = 0; d0 < 4; ++d0) qr[d0] = *reinterpret_cast<const bf16x8*>(&Qw[(long)r32 * QP + d0 * 16 + hi * 8]);
  float mhat = 0.f, l_reg = 0.f; f32x16 o[2]; o[0] = f32x16{}; o[1] = f32x16{}; f32x16 negm = f32x16{}; asm volatile("" : "+v"(negm));
  const int qrel = wid * QBLK + r32;
  int mlo = -128, mhi = 128;
  if (MODE == 1) { const int qi = q0 + qrel; mlo = (-qi > -128) ? -qi : -128; mhi = (SEQ - 1 - qi < 128) ? (SEQ - 1 - qi) : 128; }
  const unsigned mspan = (unsigned)(mhi - mlo);
  #define CMASK(P0, P1, t) do { if (MODE == 1) { if ((t) >= 4) bandmask(P0, P1, (t), mlo, mspan, qrel, hi); } } while (0)
  bool resc = false;
  #define START(P0, P1) do { const float rm = rowmax(P0, P1); resc = false; \
    { const float dl = rm; mhat = fadd_s(mhat, dl); \
      _Pragma("unroll") for (int r = 0; r < 16; ++r) { P0[r] = fsub_s(P0[r], dl); P1[r] = fsub_s(P1[r], dl); } \
      _Pragma("unroll") for (int r = 0; r < 16; ++r) negm[r] = -mhat; asm volatile("" : "+v"(negm)); } \
    _Pragma("unroll") for (int r = 0; r < 16; ++r) P0[r] = __builtin_amdgcn_exp2f(P0[r]); } while (0)
  #define RESC() do { if (resc) { asm volatile("s_waitcnt lgkmcnt(0)" ::: "memory"); \
      _Pragma("unroll") for (int d_ = 0; d_ < 2; ++d_) _Pragma("unroll") for (int r = 0; r < 16; ++r) o[d_][r] *= wsf[crow(r, hi)]; } } while (0)
  f32x16 pA0, pA1, pB0, pB1;
  int sl_prev = 0, sl_cur = 0, sl_next = SLOTB;
  #define ROT() do { sl_prev = sl_cur; sl_cur = sl_next; sl_next = (sl_next == (NSLOT - 1) * SLOTB) ? 0 : sl_next + SLOTB; } while (0)
  DMA_K(2, 2 * SLOTB);
  WAIT_BAR(3);
  qkt(pA0, pA1, Kbase, qr, negm, r32, hi); asm volatile("s_nop 15\n\ts_nop 7" : "+v"(pA0), "+v"(pA1)); CMASK(pA0, pA1, 0);
  START(pA0, pA1);
  _Pragma("unroll") for (int r = 0; r < 16; ++r) pA1[r] = __builtin_amdgcn_exp2f(pA1[r]);
  WAIT_BAR(0);
  DMA_K(3, 0); DMA_V(1, SLOTB);
  ROT();
  kload8(kf, kp0 + sl_cur);
  WAIT_BAR(2);
  bf16x8 vfr[8]; u32x4 pw0, pw1, pw2, pw3;
  #define PKW(P, B) cvtpk_s(P[B], P[B + 1])
  #define PAF(k) __builtin_bit_cast(bf16x8, pw##k)
  #define VFR(i) vfr[i]
  #define PIN(x) asm volatile("" : "+v"(x))
  #define MX3(a, b, c) __builtin_fmaxf(__builtin_fmaxf((a), (b)), (c))
  #define GAPA(MF, A0, A1, A2, A3, W0, W1, PW) do { MF; sacc += A0; sacc += A1; sacc += A2; sacc += A3; PIN(sacc); W0; W1; PIN(PW); SBAR(); } while (0)
  #define EX(v) __builtin_amdgcn_exp2f(v)
  #define GAPB(MF, X, B) do { MF; X[B] = EX(X[B]); X[B + 1] = EX(X[B + 1]); X[B + 2] = EX(X[B + 2]); X[B + 3] = EX(X[B + 3]); PIN(X); SBAR(); } while (0)
  #define VRD(i) do { vfr[i] = *(const LAS bf16x8*)(vq[(i) & 3] + vsl_ + ((i) >> 2) * 4096); } while (0)
  #define KRD(G, j) do { if (G) { kload2(kf, kp0 + sl_next, j); SBAR(); } } while (0)
  #define STEP(C0, C1, P0, P1, t, GK, GV, GL) do { SBAR(); \
    const int vsl_ = sl_prev; \
    VRD(0); SBAR(); float sacc = (P0[0] + P0[1]); \
    GAPA(C0 = __builtin_amdgcn_mfma_f32_32x32x16_bf16(kf[0], qr[0], negm, 0, 0, 0), P0[2], P0[3], P0[4], P0[5],     pw0[0] = PKW(P0, 0), pw0[1] = PKW(P0, 2), pw0); \
    VRD(4); SBAR(); GAPA(C1 = __builtin_amdgcn_mfma_f32_32x32x16_bf16(kf[1], qr[0], negm, 0, 0, 0), P0[6], P0[7], P0[8], P0[9],     pw0[2] = PKW(P0, 4), pw0[3] = PKW(P0, 6), pw0); \
    VRD(1); SBAR(); GAPA(C0 = __builtin_amdgcn_mfma_f32_32x32x16_bf16(kf[2], qr[1], C0, 0, 0, 0),   P0[10], P0[11], P0[12], P0[13], pw1[0] = PKW(P0, 8), pw1[1] = PKW(P0, 10), pw1); \
    VRD(5); SBAR(); GAPA(C1 = __builtin_amdgcn_mfma_f32_32x32x16_bf16(kf[3], qr[1], C1, 0, 0, 0),   P0[14], P0[15], P1[0], P1[1],   pw1[2] = PKW(P0, 12), pw1[3] = PKW(P0, 14), pw1); \
    VRD(2); SBAR(); GAPA(C0 = __builtin_amdgcn_mfma_f32_32x32x16_bf16(kf[4], qr[2], C0, 0, 0, 0),   P1[2], P1[3], P1[4], P1[5],     pw2[0] = PKW(P1, 0), pw2[1] = PKW(P1, 2), pw2); \
    VRD(6); SBAR(); GAPA(C1 = __builtin_amdgcn_mfma_f32_32x32x16_bf16(kf[5], qr[2], C1, 0, 0, 0),   P1[6], P1[7], P1[8], P1[9],     pw2[2] = PKW(P1, 4), pw2[3] = PKW(P1, 6), pw2); \
    VRD(3); SBAR(); GAPA(C0 = __builtin_amdgcn_mfma_f32_32x32x16_bf16(kf[6], qr[3], C0, 0, 0, 0),   P1[10], P1[11], P1[12], P1[13], pw3[0] = PKW(P1, 8), pw3[1] = PKW(P1, 10), pw3); \
    VRD(7); SBAR(); GAPA(C1 = __builtin_amdgcn_mfma_f32_32x32x16_bf16(kf[7], qr[3], C1, 0, 0, 0),   P1[14], P1[15], 0.f, 0.f,       pw3[2] = PKW(P1, 12), pw3[3] = PKW(P1, 14), pw3); \
    l_reg += sacc; \
    if (GK) { DMA_K((t) + 3, sl_cur); } if (GV) { DMA_V((t) + 1, sl_next); } \
    CMASK(C0, C1, t); \
    { float a = MX3(C0[0], C0[1], C1[0]), b = MX3(C0[2], C0[3], C1[1]); a = MX3(a, C1[2], C1[3]); \
      _Pragma("unroll") for (int r = 4; r < 16; r += 4) { a = MX3(a, C0[r], C0[r + 1]); b = MX3(b, C0[r + 2], C0[r + 3]); a = MX3(a, C1[r], C1[r + 1]); b = MX3(b, C1[r + 2], C1[r + 3]); } \
      float rm = __builtin_fmaxf(a, b); { auto rr = __builtin_amdgcn_permlane32_swap(__float_as_uint(rm), __float_as_uint(rm), false, false); rm = __builtin_fmaxf(__uint_as_float(rr[0]), __uint_as_float(rr[1])); } \
      resc = false; \
      if (__builtin_expect(__any(rm > (float)THRL), 0)) { const float dl = __builtin_fmaxf(rm, 0.f); mhat += dl; \
        _Pragma("unroll") for (int r = 0; r < 16; ++r) { C0[r] -= dl; C1[r] -= dl; } \
        _Pragma("unroll") for (int r = 0; r < 16; ++r) negm[r] = -mhat; asm volatile("" : "+v"(negm)); \
        const float f = __builtin_amdgcn_exp2f(-dl); l_reg *= f; if (hi == 0) wsf[r32] = f; resc = true; } } \
    SBAR(); \
    GAPB(o[0] = __builtin_amdgcn_mfma_f32_32x32x16_bf16(PAF(0), VFR(0), o[0], 0, 0, 0), C0, 0); \
    GAPB(o[1] = __builtin_amdgcn_mfma_f32_32x32x16_bf16(PAF(0), VFR(4), o[1], 0, 0, 0), C0, 4); \
    KRD(GL, 0); GAPB(o[0] = __builtin_amdgcn_mfma_f32_32x32x16_bf16(PAF(1), VFR(1), o[0], 0, 0, 0), C0, 8); \
    KRD(GL, 1); GAPB(o[1] = __builtin_amdgcn_mfma_f32_32x32x16_bf16(PAF(1), VFR(5), o[1], 0, 0, 0), C0, 12); \
    KRD(GL, 2); GAPB(o[0] = __builtin_amdgcn_mfma_f32_32x32x16_bf16(PAF(2), VFR(2), o[0], 0, 0, 0), C1, 0); \
    KRD(GL, 3); GAPB(o[1] = __builtin_amdgcn_mfma_f32_32x32x16_bf16(PAF(2), VFR(6), o[1], 0, 0, 0), C1, 4); \
    GAPB(o[0] = __builtin_amdgcn_mfma_f32_32x32x16_bf16(PAF(3), VFR(3), o[0], 0, 0, 0), C1, 8); \
    GAPB(o[1] = __builtin_amdgcn_mfma_f32_32x32x16_bf16(PAF(3), VFR(7), o[1], 0, 0, 0), C1, 12); \
    } while (0)
  int t = 1;
  for (; t + 5 < NT; t += 2) {
    STEP(pB0, pB1, pA0, pA1, t, true, true, true);     WAIT_BAR(2); RESC(); ROT();
    STEP(pA0, pA1, pB0, pB1, t + 1, true, true, true);   WAIT_BAR(2); RESC(); ROT();
  }
  #define ENDW(tt) do { if ((tt) + 3 < NT) { WAIT_BAR(2); } else if ((tt) + 2 < NT) { WAIT_BAR(1); } else { WAIT_BAR(0); } } while (0)
  for (; t + 1 < NT; t += 2) {
    STEP(pB0, pB1, pA0, pA1, t, (t + 3 < NT), (t + 1 < NT), (t + 1 < NT));       ENDW(t);   RESC(); ROT();
    STEP(pA0, pA1, pB0, pB1, t + 1, (t + 4 < NT), (t + 2 < NT), (t + 2 < NT));     ENDW(t + 1); RESC(); ROT();
  }
  STEP(pB0, pB1, pA0, pA1, NT - 1, false, false, false); RESC();
  { float sacc = pB0[0] + pB0[1]; _Pragma("unroll") for (int r = 2; r < 16; ++r) sacc += pB0[r]; _Pragma("unroll") for (int r = 0; r < 16; ++r) sacc += pB1[r]; l_reg += sacc;
    pw0 = (u32x4){PKW(pB0, 0), PKW(pB0, 2), PKW(pB0, 4), PKW(pB0, 6)}; pw1 = (u32x4){PKW(pB0, 8), PKW(pB0, 10), PKW(pB0, 12), PKW(pB0, 14)}; pw2 = (u32x4){PKW(pB1, 0), PKW(pB1, 2), PKW(pB1, 4), PKW(pB1, 6)}; pw3 = (u32x4){PKW(pB1, 8), PKW(pB1, 10), PKW(pB1, 12), PKW(pB1, 14)};
    SBAR(); pv2(o, vq, sl_cur, PAF(0), PAF(1), PAF(2), PAF(3)); }
  #undef PKW
  #undef PAF
  #undef VFR
  #undef PIN
  #undef MX3
  #undef GAPA
  #undef GAPB
  #undef EX
  #undef VRD
  #undef KRD
  #undef STEP
  #undef ENDW
  { auto rr = __builtin_amdgcn_permlane32_swap(__float_as_uint(l_reg), __float_as_uint(l_reg), false, false); l_reg = __uint_as_float(rr[0]) + __uint_as_float(rr[1]); }
  l_reg += __builtin_amdgcn_exp2f(sink2 - mhat);
  if (hi == 0) wsf[32 + r32] = l_reg; asm volatile("s_waitcnt lgkmcnt(0)" ::: "memory");
  float rli[16];
  #pragma unroll
  for (int r = 0; r < 16; ++r) rli[r] = __builtin_amdgcn_rcpf(wsf[32 + crow(r, hi)]);
  bf16* Ow = O + (qrow + wid * QBLK) * QP + qcol;
  { bf16* stg = (bf16*)(shm + LDS_OST) + wid * 2048;
    #pragma unroll
    for (int r = 0; r < 16; ++r) { const int orow = crow(r, hi);
      #pragma unroll
      for (int d0 = 0; d0 < 2; ++d0) stg[orow * 64 + d0 * 32 + r32] = __float2bfloat16(o[d0][r] * rli[r]); }
    asm volatile("s_waitcnt lgkmcnt(0)" ::: "memory");
    #pragma unroll
    for (int i = 0; i < 4; ++i) { const int row = i * 8 + (lane >> 3), ch = lane & 7; const u32x4 v = *(const u32x4*)(stg + row * 64 + ch * 8); ATTN_STORE16(Ow + (long)row * QP + ch * 8, v); } }
  asm volatile("s_waitcnt lgkmcnt(0)\n\ts_barrier" ::: "memory");
  #undef DMA_K
  #undef DMA_V
  #undef ROWOFF
  #undef CMASK
  #undef START
  #undef RESC
  #undef ROT
}
template <int MODE, int XV = 0> __device__ __forceinline__ void attn_unit_sb(long qrow, long kvrow, int q0, int qcol, int kcol, int vcol, int NT, float sink2, float bound, const bf16* Q, const bf16* __restrict__ KVb, bf16* O, char* shm) {
  int tid_ = threadIdx.x; asm volatile("" : "+v"(tid_));
  const int tid = tid_, lane = tid & 63, r32 = lane & 31, hi = lane >> 5; const int wid = __builtin_amdgcn_readfirstlane(tid >> 6);
  const bf16* Qw = Q + (qrow + wid * QBLK) * QP + qcol;
  const char* kvt = (const char*)KVb + (size_t)(kvrow >> 6) * 65536 + wid * 1024 + lane * 16;
  const unsigned lds0 = (unsigned)(uintptr_t)shm;
  const char* ksrc = kvt + kcol * 8192; const char* vsrc = kvt + vcol * 8192;
  const unsigned kdst = lds0 + LDS_K + wid * 1024, vdst = lds0 + LDS_V + wid * 1024;
  #define ROWOFF(t) ((long)(MODE == 1 ? ((t) + ((t) >= 4 ? ((q0 - 128) >> 6) : 0)) : (t)) * 65536)
  #define DMA_K(t, slot) glds16(ksrc + ROWOFF(t), (unsigned)__builtin_amdgcn_readfirstlane(kdst + (slot)))
  #define DMA_V(t, slot) glds16(vsrc + ROWOFF(t), (unsigned)__builtin_amdgcn_readfirstlane(vdst + (slot)))
  const char* Kbase = shm + LDS_K; bf16x8 kf[8];
  const lds_cptr shm3 = (lds_cptr)shm; const lds_cptr kp0 = shm3 + LDS_K + hi * 1024 + r32 * 16; lds_cptr vq[4];
  { const int swz = (r32 >> 1) & 7; _Pragma("unroll") for (int ks_ = 0; ks_ < 4; ++ks_) vq[ks_] = shm3 + LDS_V + r32 * 128 + (((2 * ks_ + hi) ^ swz) * 16); }
  DMA_K(0, 0); DMA_V(0, 0); DMA_K(1, SLOTB);
  bf16x8 qr[4];
  #pragma unroll
  for (int d0 = 0; d0 < 4; ++d0) qr[d0] = *reinterpret_cast<const bf16x8*>(&Qw[(long)r32 * QP + d0 * 16 + hi * 8]);
  f32x16 o[2]; o[0] = f32x16{}; o[1] = f32x16{}; f32x16 osum = f32x16{};
  const f32x16 negm = f32x16{};
  bf16x8 ones;
  #pragma unroll
  for (int i = 0; i < 8; ++i) ones[i] = (short)0x3F80;
  asm volatile("" : "+v"(ones));
  const int qrel = wid * QBLK + r32;
  int mlo = -128, mhi = 128;
  if (MODE == 1) { const int qi = q0 + qrel; mlo = (-qi > -128) ? -qi : -128; mhi = (SEQ - 1 - qi < 128) ? (SEQ - 1 - qi) : 128; }
  const unsigned mspan = (unsigned)(mhi - mlo);
  #define CMASK(P0, P1, t) do { if (MODE == 1) { if ((t) >= 4) bandmask(P0, P1, (t), mlo, mspan, qrel, hi); } } while (0)
  f32x16 pA0, pA1, pB0, pB1;
  int sl_prev = 0, sl_cur = 0, sl_next = SLOTB;
  #define ROT() do { sl_prev = sl_cur; sl_cur = sl_next; sl_next = (sl_next == (NSLOT - 1) * SLOTB) ? 0 : sl_next + SLOTB; } while (0)
  DMA_K(2, 2 * SLOTB);
  WAIT_BAR(3);
  qkt(pA0, pA1, Kbase, qr, negm, r32, hi); asm volatile("s_nop 15\n\ts_nop 7" : "+v"(pA0), "+v"(pA1)); CMASK(pA0, pA1, 0);
  _Pragma("unroll") for (int r = 0; r < 16; ++r) { pA0[r] = __builtin_amdgcn_exp2f(pA0[r]); pA1[r] = __builtin_amdgcn_exp2f(pA1[r]); }
  WAIT_BAR(0);
  DMA_K(3, 0); DMA_V(1, SLOTB);
  ROT();
  kload8(kf, kp0 + sl_cur);
  WAIT_BAR(2);
  bf16x8 vfr[8]; u32x4 pw0, pw1, pw2, pw3;
  #define PKW(P, B) cvtpk_s(P[B], P[B + 1])
  #define PAF(k) __builtin_bit_cast(bf16x8, pw##k)
  #define VFR(i) vfr[i]
  #define PIN(x) asm volatile("" : "+v"(x))
  #define GAPA(MF, W0, W1, PW) do { MF; W0; W1; PIN(PW); SBAR(); } while (0)
  #define OSUM(k) do { if (XV != 5) osum = __builtin_amdgcn_mfma_f32_32x32x16_bf16(PAF(k), ones, osum, 0, 0, 0); SBAR(); } while (0)
  #define EX(v) (XV == 2 ? (v) : (FASTEXP ? exp2_fast(v) : __builtin_amdgcn_exp2f(v)))
  #define GAPB(MF, X, B) do { MF; X[B] = EX(X[B]); X[B + 1] = EX(X[B + 1]); X[B + 2] = EX(X[B + 2]); X[B + 3] = EX(X[B + 3]); PIN(X); SBAR(); } while (0)
  #define VRD(i) do { if (XV == 3) break; vfr[i] = *(const LAS bf16x8*)(vq[(i) & 3] + vsl_ + ((i) >> 2) * 4096); } while (0)
  #define KRD(G, j) do { if ((G) && XV != 3) { kload2(kf, kp0 + sl_next, j); SBAR(); } } while (0)
  #define STEP(C0, C1, P0, P1, t, GK, GV, GL) do { SBAR(); \
    const int vsl_ = sl_prev; \
    VRD(0); SBAR(); GAPA(C0 = __builtin_amdgcn_mfma_f32_32x32x16_bf16(kf[0], qr[0], negm, 0, 0, 0), pw0[0] = PKW(P0, 0), pw0[1] = PKW(P0, 2), pw0); \
    VRD(4); SBAR(); GAPA(C1 = __builtin_amdgcn_mfma_f32_32x32x16_bf16(kf[1], qr[0], negm, 0, 0, 0), pw0[2] = PKW(P0, 4), pw0[3] = PKW(P0, 6), pw0); \
    VRD(1); SBAR(); GAPA(C0 = __builtin_amdgcn_mfma_f32_32x32x16_bf16(kf[2], qr[1], C0, 0, 0, 0),   pw1[0] = PKW(P0, 8), pw1[1] = PKW(P0, 10), pw1); \
    OSUM(0); \
    VRD(5); SBAR(); GAPA(C1 = __builtin_amdgcn_mfma_f32_32x32x16_bf16(kf[3], qr[1], C1, 0, 0, 0),   pw1[2] = PKW(P0, 12), pw1[3] = PKW(P0, 14), pw1); \
    VRD(2); SBAR(); GAPA(C0 = __builtin_amdgcn_mfma_f32_32x32x16_bf16(kf[4], qr[2], C0, 0, 0, 0),   pw2[0] = PKW(P1, 0), pw2[1] = PKW(P1, 2), pw2); \
    OSUM(1); \
    VRD(6); SBAR(); GAPA(C1 = __builtin_amdgcn_mfma_f32_32x32x16_bf16(kf[5], qr[2], C1, 0, 0, 0),   pw2[2] = PKW(P1, 4), pw2[3] = PKW(P1, 6), pw2); \
    VRD(3); SBAR(); GAPA(C0 = __builtin_amdgcn_mfma_f32_32x32x16_bf16(kf[6], qr[3], C0, 0, 0, 0),   pw3[0] = PKW(P1, 8), pw3[1] = PKW(P1, 10), pw3); \
    OSUM(2); \
    VRD(7); SBAR(); GAPA(C1 = __builtin_amdgcn_mfma_f32_32x32x16_bf16(kf[7], qr[3], C1, 0, 0, 0),   pw3[2] = PKW(P1, 12), pw3[3] = PKW(P1, 14), pw3); \
    if (XV != 1) { if (GK) { DMA_K((t) + 3, sl_cur); } if (GV) { DMA_V((t) + 1, sl_next); } } \
    OSUM(3); \
    CMASK(C0, C1, t); \
    SBAR(); \
    GAPB(o[0] = __builtin_amdgcn_mfma_f32_32x32x16_bf16(PAF(0), VFR(0), o[0], 0, 0, 0), C0, 0); \
    GAPB(o[1] = __builtin_amdgcn_mfma_f32_32x32x16_bf16(PAF(0), VFR(4), o[1], 0, 0, 0), C0, 4); \
    KRD(GL, 0); GAPB(o[0] = __builtin_amdgcn_mfma_f32_32x32x16_bf16(PAF(1), VFR(1), o[0], 0, 0, 0), C0, 8); \
    KRD(GL, 1); GAPB(o[1] = __builtin_amdgcn_mfma_f32_32x32x16_bf16(PAF(1), VFR(5), o[1], 0, 0, 0), C0, 12); \
    KRD(GL, 2); GAPB(o[0] = __builtin_amdgcn_mfma_f32_32x32x16_bf16(PAF(2), VFR(2), o[0], 0, 0, 0), C1, 0); \
    KRD(GL, 3); GAPB(o[1] = __builtin_amdgcn_mfma_f32_32x32x16_bf16(PAF(2), VFR(6), o[1], 0, 0, 0), C1, 4); \
    GAPB(o[0] = __builtin_amdgcn_mfma_f32_32x32x16_bf16(PAF(3), VFR(3), o[0], 0, 0, 0), C1, 8); \
    GAPB(o[1] = __builtin_amdgcn_mfma_f32_32x32x16_bf16(PAF(3), VFR(7), o[1], 0, 0, 0), C1, 12); \
    } while (0)
  int t = 1;
  for (; t + 5 < NT; t += 2) {
    STEP(pB0, pB1, pA0, pA1, t, true, true, true);     WAIT_BAR(2); ROT();
    STEP(pA0, pA1, pB0, pB1, t + 1, true, true, true);   WAIT_BAR(2); ROT();
  }
  #define ENDW(tt) do { if ((tt) + 3 < NT) { WAIT_BAR(2); } else if ((tt) + 2 < NT) { WAIT_BAR(1); } else { WAIT_BAR(0); } } while (0)
  for (; t + 1 < NT; t += 2) {
    STEP(pB0, pB1, pA0, pA1, t, (t + 3 < NT), (t + 1 < NT), (t + 1 < NT));       ENDW(t);   ROT();
    STEP(pA0, pA1, pB0, pB1, t + 1, (t + 4 < NT), (t + 2 < NT), (t + 2 < NT));     ENDW(t + 1); ROT();
  }
  STEP(pB0, pB1, pA0, pA1, NT - 1, false, false, false);
  { pw0 = (u32x4){PKW(pB0, 0), PKW(pB0, 2), PKW(pB0, 4), PKW(pB0, 6)}; pw1 = (u32x4){PKW(pB0, 8), PKW(pB0, 10), PKW(pB0, 12), PKW(pB0, 14)}; pw2 = (u32x4){PKW(pB1, 0), PKW(pB1, 2), PKW(pB1, 4), PKW(pB1, 6)}; pw3 = (u32x4){PKW(pB1, 8), PKW(pB1, 10), PKW(pB1, 12), PKW(pB1, 14)};
    SBAR(); OSUM(0); OSUM(1); OSUM(2); OSUM(3); pv2(o, vq, sl_cur, PAF(0), PAF(1), PAF(2), PAF(3)); }
  #undef PKW
  #undef PAF
  #undef VFR
  #undef PIN
  #undef GAPA
  #undef OSUM
  #undef GAPB
  #undef EX
  #undef VRD
  #undef KRD
  #undef STEP
  #undef ENDW
  const float sterm = __builtin_amdgcn_exp2f(sink2);
  float rli[16];
  #pragma unroll
  for (int r = 0; r < 16; ++r) rli[r] = __builtin_amdgcn_rcpf(osum[r] + sterm);
  bf16* Ow = O + (qrow + wid * QBLK) * QP + qcol;
  { bf16* stg = (bf16*)(shm + LDS_OST) + wid * 2048;
    #pragma unroll
    for (int r = 0; r < 16; ++r) { const int orow = crow(r, hi);
      #pragma unroll
      for (int d0 = 0; d0 < 2; ++d0) stg[orow * 64 + d0 * 32 + r32] = __float2bfloat16(o[d0][r] * rli[r]); }
    asm volatile("s_waitcnt lgkmcnt(0)" ::: "memory");
    #pragma unroll
    for (int i = 0; i < 4; ++i) { const int row = i * 8 + (lane >> 3), ch = lane & 7; const u32x4 v = *(const u32x4*)(stg + row * 64 + ch * 8); ATTN_STORE16(Ow + (long)row * QP + ch * 8, v); } }
  asm volatile("s_waitcnt lgkmcnt(0)\n\ts_barrier" ::: "memory");
  #undef DMA_K
  #undef DMA_V
  #undef ROWOFF
  #undef CMASK
  #undef ROT
}
template <int MODE> __device__ __forceinline__ void attn_unit_sk(long qrow, long kvrow, int q0, int qcol, int kcol, int vcol, int NT, float sink2, float bound, const bf16* Q, const bf16* __restrict__ KVb, bf16* O, char* shm) {
  int tid_ = threadIdx.x; asm volatile("" : "+v"(tid_));
  const int tid = tid_, lane = tid & 63, r32 = lane & 31, hi = lane >> 5; const int wid = __builtin_amdgcn_readfirstlane(tid >> 6);
  const bf16* Qw = Q + (qrow + wid * QBLK) * QP + qcol;
  const char* kvt = (const char*)KVb + (size_t)(kvrow >> 6) * 65536 + wid * 1024 + lane * 16;
  constexpr int NSL = 4, LK = 0, LV = NSL * SLOTB, LOST = 2 * NSL * SLOTB + NW * 64 * 4;
  const unsigned lds0 = (unsigned)(uintptr_t)shm;
  const char* ksrc = kvt + kcol * 8192; const char* vsrc = kvt + vcol * 8192;
  const unsigned kdst = lds0 + LK + wid * 1024, vdst = lds0 + LV + wid * 1024;
  #define ROWOFF(t) ((long)(MODE == 1 ? ((t) + ((t) >= 4 ? ((q0 - 128) >> 6) : 0)) : (t)) * 65536)
  #define DMA_K(t, slot) glds16(ksrc + ROWOFF(t), (unsigned)__builtin_amdgcn_readfirstlane(kdst + (slot)))
  #define DMA_V(t, slot) glds16(vsrc + ROWOFF(t), (unsigned)__builtin_amdgcn_readfirstlane(vdst + (slot)))
  const char* Kbase = shm + LK; bf16x8 kf[8];
  const lds_cptr shm3 = (lds_cptr)shm; const lds_cptr kp0 = shm3 + LK + hi * 1024 + r32 * 16; lds_cptr vq[4];
  { const int swz = (r32 >> 1) & 7; _Pragma("unroll") for (int ks_ = 0; ks_ < 4; ++ks_) vq[ks_] = shm3 + LV + r32 * 128 + (((2 * ks_ + hi) ^ swz) * 16); }
  DMA_K(0, 0); DMA_V(0, 0); DMA_K(1, SLOTB);
  bf16x8 qr[4];
  #pragma unroll
  for (int d0 = 0; d0 < 4; ++d0) qr[d0] = *reinterpret_cast<const bf16x8*>(&Qw[(long)r32 * QP + d0 * 16 + hi * 8]);
  f32x16 o[2]; o[0] = f32x16{}; o[1] = f32x16{}; f32x16 osum = f32x16{};
  const f32x16 negm = f32x16{};
  bf16x8 ones;
  #pragma unroll
  for (int i = 0; i < 8; ++i) ones[i] = (short)0x3F80;
  asm volatile("" : "+v"(ones));
  const int qrel = wid * QBLK + r32;
  int mlo = -128, mhi = 128;
  if (MODE == 1) { const int qi = q0 + qrel; mlo = (-qi > -128) ? -qi : -128; mhi = (SEQ - 1 - qi < 128) ? (SEQ - 1 - qi) : 128; }
  const unsigned mspan = (unsigned)(mhi - mlo);
  #define CMASK(P0, P1, t) do { if (MODE == 1) { if ((t) >= 4) bandmask(P0, P1, (t), mlo, mspan, qrel, hi); } } while (0)
  f32x16 pA0, pA1, pB0, pB1;
  int sl_prev = 0, sl_cur = 0, sl_next = SLOTB;
  #define ROT() do { sl_prev = sl_cur; sl_cur = sl_next; sl_next = (sl_next == (NSL - 1) * SLOTB) ? 0 : sl_next + SLOTB; } while (0)
  DMA_K(2, 2 * SLOTB);
  WAIT_BAR(3);
  qkt(pA0, pA1, Kbase, qr, negm, r32, hi); asm volatile("s_nop 15\n\ts_nop 7" : "+v"(pA0), "+v"(pA1)); CMASK(pA0, pA1, 0);
  _Pragma("unroll") for (int r = 0; r < 16; ++r) { pA0[r] = __builtin_amdgcn_exp2f(pA0[r]); pA1[r] = __builtin_amdgcn_exp2f(pA1[r]); }
  WAIT_BAR(0);
  DMA_V(1, SLOTB); DMA_K(3, 3 * SLOTB); DMA_V(2, 2 * SLOTB); if (4 < NT) { DMA_K(4, 0); }
  ROT();
  kload8(kf, kp0 + sl_cur);
  WAIT_BAR(4);
  if (wid >= 4) asm volatile("s_barrier" ::: "memory");
  bf16x8 vfr[8]; u32x4 pw0, pw1, pw2, pw3;
  #define PKW(P, B) cvtpk_s(P[B], P[B + 1])
  #define PAF(k) __builtin_bit_cast(bf16x8, pw##k)
  #define VFR(i) vfr[i]
  #define PIN(x) asm volatile("" : "+v"(x))
  #define GAPA(MF, W0, W1, PW) do { MF; W0; W1; PIN(PW); SBAR(); } while (0)
  #define OSUM(k) do { osum = __builtin_amdgcn_mfma_f32_32x32x16_bf16(PAF(k), ones, osum, 0, 0, 0); SBAR(); } while (0)
  #define EX(v) (FASTEXP ? exp2_fast(v) : __builtin_amdgcn_exp2f(v))
  #define GAPB(MF, X, B) do { MF; X[B] = EX(X[B]); X[B + 1] = EX(X[B + 1]); X[B + 2] = EX(X[B + 2]); X[B + 3] = EX(X[B + 3]); PIN(X); SBAR(); } while (0)
  #define VRD(i) do { vfr[i] = *(const LAS bf16x8*)(vq[(i) & 3] + vsl_ + ((i) >> 2) * 4096); } while (0)
  #define KRD(G, j) do { if (G) { kload2(kf, kp0 + sl_next, j); SBAR(); } } while (0)
  #define STEP(C0, C1, P0, P1, t, GK, GV, GL, WMID) do { SBAR(); \
    const int vsl_ = sl_prev; \
    VRD(0); SBAR(); GAPA(C0 = __builtin_amdgcn_mfma_f32_32x32x16_bf16(kf[0], qr[0], negm, 0, 0, 0), pw0[0] = PKW(P0, 0), pw0[1] = PKW(P0, 2), pw0); \
    VRD(4); SBAR(); GAPA(C1 = __builtin_amdgcn_mfma_f32_32x32x16_bf16(kf[1], qr[0], negm, 0, 0, 0), pw0[2] = PKW(P0, 4), pw0[3] = PKW(P0, 6), pw0); \
    VRD(1); SBAR(); GAPA(C0 = __builtin_amdgcn_mfma_f32_32x32x16_bf16(kf[2], qr[1], C0, 0, 0, 0),   pw1[0] = PKW(P0, 8), pw1[1] = PKW(P0, 10), pw1); \
    OSUM(0); \
    VRD(5); SBAR(); GAPA(C1 = __builtin_amdgcn_mfma_f32_32x32x16_bf16(kf[3], qr[1], C1, 0, 0, 0),   pw1[2] = PKW(P0, 12), pw1[3] = PKW(P0, 14), pw1); \
    VRD(2); SBAR(); GAPA(C0 = __builtin_amdgcn_mfma_f32_32x32x16_bf16(kf[4], qr[2], C0, 0, 0, 0),   pw2[0] = PKW(P1, 0), pw2[1] = PKW(P1, 2), pw2); \
    OSUM(1); \
    VRD(6); SBAR(); GAPA(C1 = __builtin_amdgcn_mfma_f32_32x32x16_bf16(kf[5], qr[2], C1, 0, 0, 0),   pw2[2] = PKW(P1, 4), pw2[3] = PKW(P1, 6), pw2); \
    VRD(3); SBAR(); GAPA(C0 = __builtin_amdgcn_mfma_f32_32x32x16_bf16(kf[6], qr[3], C0, 0, 0, 0),   pw3[0] = PKW(P1, 8), pw3[1] = PKW(P1, 10), pw3); \
    OSUM(2); \
    VRD(7); SBAR(); GAPA(C1 = __builtin_amdgcn_mfma_f32_32x32x16_bf16(kf[7], qr[3], C1, 0, 0, 0),   pw3[2] = PKW(P1, 12), pw3[3] = PKW(P1, 14), pw3); \
    OSUM(3); \
    CMASK(C0, C1, t); \
    SBAR(); \
    WMID; \
    if (GV) { DMA_V((t) + 2, (sl_next == (NSL - 1) * SLOTB) ? 0 : sl_next + SLOTB); } if (GK) { DMA_K((t) + 4, sl_cur); } \
    SBAR(); \
    GAPB(o[0] = __builtin_amdgcn_mfma_f32_32x32x16_bf16(PAF(0), VFR(0), o[0], 0, 0, 0), C0, 0); \
    GAPB(o[1] = __builtin_amdgcn_mfma_f32_32x32x16_bf16(PAF(0), VFR(4), o[1], 0, 0, 0), C0, 4); \
    KRD(GL, 0); GAPB(o[0] = __builtin_amdgcn_mfma_f32_32x32x16_bf16(PAF(1), VFR(1), o[0], 0, 0, 0), C0, 8); \
    KRD(GL, 1); GAPB(o[1] = __builtin_amdgcn_mfma_f32_32x32x16_bf16(PAF(1), VFR(5), o[1], 0, 0, 0), C0, 12); \
    KRD(GL, 2); GAPB(o[0] = __builtin_amdgcn_mfma_f32_32x32x16_bf16(PAF(2), VFR(2), o[0], 0, 0, 0), C1, 0); \
    KRD(GL, 3); GAPB(o[1] = __builtin_amdgcn_mfma_f32_32x32x16_bf16(PAF(2), VFR(6), o[1], 0, 0, 0), C1, 4); \
    GAPB(o[0] = __builtin_amdgcn_mfma_f32_32x32x16_bf16(PAF(3), VFR(3), o[0], 0, 0, 0), C1, 8); \
    GAPB(o[1] = __builtin_amdgcn_mfma_f32_32x32x16_bf16(PAF(3), VFR(7), o[1], 0, 0, 0), C1, 12); \
    } while (0)
  int t = 1;
  for (; t + 5 < NT; t += 2) {
    STEP(pB0, pB1, pA0, pA1, t, true, true, true, WAIT_BAR(3));     WAIT_BAR(4); ROT();
    STEP(pA0, pA1, pB0, pB1, t + 1, true, true, true, WAIT_BAR(3));   WAIT_BAR(4); ROT();
  }
  for (; t + 1 < NT; t += 2) {
    STEP(pB0, pB1, pA0, pA1, t, (t + 4 < NT), (t + 2 < NT), (t + 1 < NT), WAIT_BAR(0));       WAIT_BAR(0); ROT();
    STEP(pA0, pA1, pB0, pB1, t + 1, (t + 5 < NT), (t + 3 < NT), (t + 2 < NT), WAIT_BAR(0));     WAIT_BAR(0); ROT();
  }
  STEP(pB0, pB1, pA0, pA1, NT - 1, false, false, false, WAIT_BAR(0));
  if (wid < 4) { WAIT_BAR(0); }
  { pw0 = (u32x4){PKW(pB0, 0), PKW(pB0, 2), PKW(pB0, 4), PKW(pB0, 6)}; pw1 = (u32x4){PKW(pB0, 8), PKW(pB0, 10), PKW(pB0, 12), PKW(pB0, 14)}; pw2 = (u32x4){PKW(pB1, 0), PKW(pB1, 2), PKW(pB1, 4), PKW(pB1, 6)}; pw3 = (u32x4){PKW(pB1, 8), PKW(pB1, 10), PKW(pB1, 12), PKW(pB1, 14)};
    SBAR(); OSUM(0); OSUM(1); OSUM(2); OSUM(3); pv2(o, vq, sl_cur, PAF(0), PAF(1), PAF(2), PAF(3)); }
  #undef PKW
  #undef PAF
  #undef VFR
  #undef PIN
  #undef GAPA
  #undef OSUM
  #undef GAPB
  #undef EX
  #undef VRD
  #undef KRD
  #undef STEP
  const float sterm = __builtin_amdgcn_exp2f(sink2);
  float rli[16];
  #pragma unroll
  for (int r = 0; r < 16; ++r) rli[r] = __builtin_amdgcn_rcpf(osum[r] + sterm);
  bf16* Ow = O + (qrow + wid * QBLK) * QP + qcol;
  { bf16* stg = (bf16*)(shm + LOST) + wid * 2048;
    #pragma unroll
    for (int r = 0; r < 16; ++r) { const int orow = crow(r, hi);
      #pragma unroll
      for (int d0 = 0; d0 < 2; ++d0) stg[orow * 64 + d0 * 32 + r32] = __float2bfloat16(o[d0][r] * rli[r]); }
    asm volatile("s_waitcnt lgkmcnt(0)" ::: "memory");
    #pragma unroll
    for (int i = 0; i < 4; ++i) { const int row = i * 8 + (lane >> 3), ch = lane & 7; const u32x4 v = *(const u32x4*)(stg + row * 64 + ch * 8); ATTN_STORE16(Ow + (long)row * QP + ch * 8, v); } }
  asm volatile("s_waitcnt lgkmcnt(0)\n\ts_barrier" ::: "memory");
  #undef DMA_K
  #undef DMA_V
  #undef ROWOFF
  #undef CMASK
  #undef ROT
}
typedef int v8i_t __attribute__((ext_vector_type(8)));
typedef int v4i_t __attribute__((ext_vector_type(4)));
template <int MODE, int XV = 0> __device__ __forceinline__ void attn_unit_f8(long qrow, long kvrow, int q0, int qcol, int kst, int vst, int NT, float sink2, float ref, const unsigned char* Qf8, const unsigned char* KVT, bf16* O, char* shm) {
  int tid_ = threadIdx.x; asm volatile("" : "+v"(tid_));
  const int tid = tid_, lane = tid & 63, r32 = lane & 31, hi = lane >> 5; const int wid = __builtin_amdgcn_readfirstlane(tid >> 6);
  constexpr int KSL = 4096, VSL = 8192, LK = 0, LV = 3 * KSL, LOST = LV + 3 * VSL, TILEB = 49152;
  const unsigned lds0 = (unsigned)(uintptr_t)shm;
  const unsigned char* tile0 = KVT + (size_t)(kvrow >> 6) * TILEB;
  const unsigned char* ksrc = tile0 + kst * KSL + wid * 512 + (lane & 31) * 16;
  const unsigned char* vsrc = tile0 + 4 * KSL + vst * VSL + wid * 1024 + lane * 16;
  const unsigned kdst = lds0 + LK + wid * 512, vdst = lds0 + LV + wid * 1024;
  #define ROWOFF(t) ((long)(MODE == 1 ? ((t) + ((t) >= 4 ? ((q0 - 128) >> 6) : 0)) : (t)) * TILEB)
  #define DMA_K(t, kslot) do { if (lane < 32) glds16(ksrc + ROWOFF(t), (unsigned)__builtin_amdgcn_readfirstlane(kdst + (kslot))); } while (0)
  #define DMA_V(t, vslot) glds16(vsrc + ROWOFF(t), (unsigned)__builtin_amdgcn_readfirstlane(vdst + (vslot)))
  const lds_cptr shm3 = (lds_cptr)shm;
  const int ksw = (r32 >> 2) & 3;
  const lds_cptr kq0 = shm3 + LK + r32 * 64 + (((2 * hi) ^ ksw) * 16), kq1 = shm3 + LK + r32 * 64 + (((2 * hi + 1) ^ ksw) * 16);
  lds_cptr vq[4];
  { const int swz = (r32 >> 1) & 7; _Pragma("unroll") for (int ks_ = 0; ks_ < 4; ++ks_) vq[ks_] = shm3 + LV + r32 * 128 + (((2 * ks_ + hi) ^ swz) * 16); }
  DMA_K(0, 0); DMA_V(0, 0); DMA_K(1, KSL);
  v8i_t qf;
  { const v4i_t* qp = (const v4i_t*)(Qf8 + (size_t)(qrow + wid * QBLK + r32) * 1024 + qcol + hi * 32); const v4i_t a = qp[0], b = qp[1]; qf = (v8i_t){a[0], a[1], a[2], a[3], b[0], b[1], b[2], b[3]}; }
  f32x16 o[2]; o[0] = f32x16{}; o[1] = f32x16{}; f32x16 osum = f32x16{};
  f32x16 negm;
  #pragma unroll
  for (int r = 0; r < 16; ++r) negm[r] = -ref;
  asm volatile("" : "+v"(negm));
  bf16x8 ones;
  #pragma unroll
  for (int i = 0; i < 8; ++i) ones[i] = (short)0x3F80;
  asm volatile("" : "+v"(ones));
  const int qrel = wid * QBLK + r32;
  int mlo = -128, mhi = 128;
  if (MODE == 1) { const int qi = q0 + qrel; mlo = (-qi > -128) ? -qi : -128; mhi = (SEQ - 1 - qi < 128) ? (SEQ - 1 - qi) : 128; }
  const unsigned mspan = (unsigned)(mhi - mlo);
  #define CMASK(P0, P1, t) do { if (MODE == 1) { if ((t) >= 4) bandmask(P0, P1, (t), mlo, mspan, qrel, hi); } } while (0)
  #define MF8(kfr, cin) __builtin_amdgcn_mfma_scale_f32_32x32x64_f8f6f4(kfr, qf, cin, 0, 0, 0, 0x7F7F7F7F, 0, 0x7F7F7F7F)
  #define KLOAD(dst, b, kslot) do { const v4i_t a_ = *(const LAS v4i_t*)(kq0 + (kslot) + (b) * 2048), b_ = *(const LAS v4i_t*)(kq1 + (kslot) + (b) * 2048); dst = (v8i_t){a_[0], a_[1], a_[2], a_[3], b_[0], b_[1], b_[2], b_[3]}; } while (0)
  f32x16 pA0, pA1, pB0, pB1;
  int sl_prev = 0, sl_cur = 0, sl_next = VSL;
  #define ROT() do { sl_prev = sl_cur; sl_cur = sl_next; sl_next = (sl_next == 2 * VSL) ? 0 : sl_next + VSL; } while (0)
  DMA_K(2, 2 * KSL);
  WAIT_BAR(3);
  v8i_t kf0, kf1;
  KLOAD(kf0, 0, 0); KLOAD(kf1, 1, 0);
  pA0 = MF8(kf0, negm); pA1 = MF8(kf1, negm);
  asm volatile("s_nop 15\n\ts_nop 7" : "+v"(pA0), "+v"(pA1)); CMASK(pA0, pA1, 0);
  _Pragma("unroll") for (int r = 0; r < 16; ++r) { pA0[r] = __builtin_amdgcn_exp2f(pA0[r]); pA1[r] = __builtin_amdgcn_exp2f(pA1[r]); }
  WAIT_BAR(0);
  DMA_K(3, 0); DMA_V(1, VSL);
  ROT();
  KLOAD(kf0, 0, sl_cur >> 1); KLOAD(kf1, 1, sl_cur >> 1);
  WAIT_BAR(2);
  bf16x8 vfr[8]; u32x4 pw0, pw1, pw2, pw3;
  #define PKW(P, B) cvtpk_s(P[B], P[B + 1])
  #define PAF(k) __builtin_bit_cast(bf16x8, pw##k)
  #define VFR(i) vfr[i]
  #define PIN(x) asm volatile("" : "+v"(x))
  #define OSUM(k) do { if (XV != 5) osum = __builtin_amdgcn_mfma_f32_32x32x16_bf16(PAF(k), ones, osum, 0, 0, 0); SBAR(); } while (0)
  #define EX(v) __builtin_amdgcn_exp2f(v)
  #define GAPB(MF, X, B) do { MF; X[B] = EX(X[B]); X[B + 1] = EX(X[B + 1]); X[B + 2] = EX(X[B + 2]); X[B + 3] = EX(X[B + 3]); PIN(X); SBAR(); } while (0)
  #define VRD(i) do { vfr[i] = *(const LAS bf16x8*)(vq[(i) & 3] + vsl_ + ((i) >> 2) * 4096); } while (0)
  #define STEP(C0, C1, P0, P1, t, GK, GV, GL) do { SBAR(); \
    const int vsl_ = sl_prev; \
    VRD(0); VRD(4); SBAR(); \
    C0 = MF8(kf0, negm); pw0[0] = PKW(P0, 0); pw0[1] = PKW(P0, 2); pw0[2] = PKW(P0, 4); pw0[3] = PKW(P0, 6); PIN(pw0); SBAR(); \
    VRD(1); VRD(5); SBAR(); \
    C1 = MF8(kf1, negm); pw1[0] = PKW(P0, 8); pw1[1] = PKW(P0, 10); pw1[2] = PKW(P0, 12); pw1[3] = PKW(P0, 14); PIN(pw1); SBAR(); \
    VRD(2); VRD(6); SBAR(); \
    OSUM(0); pw2[0] = PKW(P1, 0); pw2[1] = PKW(P1, 2); pw2[2] = PKW(P1, 4); pw2[3] = PKW(P1, 6); PIN(pw2); SBAR(); \
    VRD(3); VRD(7); SBAR(); \
    OSUM(1); pw3[0] = PKW(P1, 8); pw3[1] = PKW(P1, 10); pw3[2] = PKW(P1, 12); pw3[3] = PKW(P1, 14); PIN(pw3); SBAR(); \
    OSUM(2); \
    if (GK) { DMA_K((t) + 3, sl_cur >> 1); } if (GV) { DMA_V((t) + 1, sl_next); } \
    OSUM(3); \
    CMASK(C0, C1, t); \
    SBAR(); \
    GAPB(o[0] = __builtin_amdgcn_mfma_f32_32x32x16_bf16(PAF(0), VFR(0), o[0], 0, 0, 0), C0, 0); \
    GAPB(o[1] = __builtin_amdgcn_mfma_f32_32x32x16_bf16(PAF(0), VFR(4), o[1], 0, 0, 0), C0, 4); \
    if (GL) { KLOAD(kf0, 0, sl_next >> 1); SBAR(); } \
    GAPB(o[0] = __builtin_amdgcn_mfma_f32_32x32x16_bf16(PAF(1), VFR(1), o[0], 0, 0, 0), C0, 8); \
    GAPB(o[1] = __builtin_amdgcn_mfma_f32_32x32x16_bf16(PAF(1), VFR(5), o[1], 0, 0, 0), C0, 12); \
    if (GL) { KLOAD(kf1, 1, sl_next >> 1); SBAR(); } \
    GAPB(o[0] = __builtin_amdgcn_mfma_f32_32x32x16_bf16(PAF(2), VFR(2), o[0], 0, 0, 0), C1, 0); \
    GAPB(o[1] = __builtin_amdgcn_mfma_f32_32x32x16_bf16(PAF(2), VFR(6), o[1], 0, 0, 0), C1, 4); \
    GAPB(o[0] = __builtin_amdgcn_mfma_f32_32x32x16_bf16(PAF(3), VFR(3), o[0], 0, 0, 0), C1, 8); \
    GAPB(o[1] = __builtin_amdgcn_mfma_f32_32x32x16_bf16(PAF(3), VFR(7), o[1], 0, 0, 0), C1, 12); \
    } while (0)
  int t = 1;
  for (; t + 5 < NT; t += 2) {
    STEP(pB0, pB1, pA0, pA1, t, true, true, true);     WAIT_BAR(2); ROT();
    STEP(pA0, pA1, pB0, pB1, t + 1, true, true, true);   WAIT_BAR(2); ROT();
  }
  #define ENDW(tt) do { if ((tt) + 3 < NT) { WAIT_BAR(2); } else if ((tt) + 2 < NT) { WAIT_BAR(1); } else { WAIT_BAR(0); } } while (0)
  for (; t + 1 < NT; t += 2) {
    STEP(pB0, pB1, pA0, pA1, t, (t + 3 < NT), (t + 1 < NT), (t + 1 < NT));       ENDW(t);   ROT();
    STEP(pA0, pA1, pB0, pB1, t + 1, (t + 4 < NT), (t + 2 < NT), (t + 2 < NT));     ENDW(t + 1); ROT();
  }
  STEP(pB0, pB1, pA0, pA1, NT - 1, false, false, false);
  { pw0 = (u32x4){PKW(pB0, 0), PKW(pB0, 2), PKW(pB0, 4), PKW(pB0, 6)}; pw1 = (u32x4){PKW(pB0, 8), PKW(pB0, 10), PKW(pB0, 12), PKW(pB0, 14)}; pw2 = (u32x4){PKW(pB1, 0), PKW(pB1, 2), PKW(pB1, 4), PKW(pB1, 6)}; pw3 = (u32x4){PKW(pB1, 8), PKW(pB1, 10), PKW(pB1, 12), PKW(pB1, 14)};
    SBAR(); OSUM(0); OSUM(1); OSUM(2); OSUM(3); pv2(o, vq, sl_cur, PAF(0), PAF(1), PAF(2), PAF(3)); }
  #undef PKW
  #undef PAF
  #undef VFR
  #undef PIN
  #undef OSUM
  #undef GAPB
  #undef EX
  #undef VRD
  #undef STEP
  #undef ENDW
  #undef MF8
  #undef KLOAD
  const float sterm = __builtin_amdgcn_exp2f(sink2 - ref);
  float rli[16];
  #pragma unroll
  for (int r = 0; r < 16; ++r) rli[r] = __builtin_amdgcn_rcpf(osum[r] + sterm);
  bf16* Ow = O + (qrow + wid * QBLK) * QP + qcol;
  { bf16* stg = (bf16*)(shm + LOST) + wid * 2048;
    #pragma unroll
    for (int r = 0; r < 16; ++r) { const int orow = crow(r, hi);
      #pragma unroll
      for (int d0 = 0; d0 < 2; ++d0) stg[orow * 64 + d0 * 32 + r32] = __float2bfloat16(o[d0][r] * rli[r]); }
    asm volatile("s_waitcnt lgkmcnt(0)" ::: "memory");
    #pragma unroll
    for (int i = 0; i < 4; ++i) { const int row = i * 8 + (lane >> 3), ch = lane & 7; const u32x4 v = *(const u32x4*)(stg + row * 64 + ch * 8); ATTN_STORE16(Ow + (long)row * QP + ch * 8, v); } }
  asm volatile("s_waitcnt lgkmcnt(0)\n\ts_barrier" ::: "memory");
  #undef DMA_K
  #undef DMA_V
  #undef ROWOFF
  #undef CMASK
  #undef ROT
}
template <int MODE> __device__ __forceinline__ void attn_unit_f8b(long qrow, long kvrow, int q0, int qcol, int kst, int vst, int NT, float sink2, float cref, const unsigned char* Qf8, const unsigned char* KVT, bf16* O, char* shm) {
  int tid_ = threadIdx.x; asm volatile("" : "+v"(tid_));
  const int tid = tid_, lane = tid & 63, r32 = lane & 31, hi = lane >> 5; const int wid = __builtin_amdgcn_readfirstlane(tid >> 6);
  constexpr int SL = 4096, LK = 0, LV = 3 * SL, LOST = LV + 3 * SL, TILEB = 32768;
  const unsigned lds0 = (unsigned)(uintptr_t)shm;
  const unsigned char* tile0 = KVT + (size_t)(kvrow >> 6) * TILEB + wid * 512 + (lane & 31) * 16;
  const unsigned char* ksrc = tile0 + kst * SL; const unsigned char* vsrc = tile0 + 4 * SL + vst * SL;
  const unsigned kdst = lds0 + LK + wid * 512, vdst = lds0 + LV + wid * 512;
  #define ROWOFF(t) ((long)(MODE == 1 ? ((t) + ((t) >= 4 ? ((q0 - 128) >> 6) : 0)) : (t)) * TILEB)
  #define DMA_K(t, slot) do { if (lane < 32) glds16(ksrc + ROWOFF(t), (unsigned)__builtin_amdgcn_readfirstlane(kdst + (slot))); } while (0)
  #define DMA_V(t, slot) do { if (lane < 32) glds16(vsrc + ROWOFF(t), (unsigned)__builtin_amdgcn_readfirstlane(vdst + (slot))); } while (0)
  const lds_cptr shm3 = (lds_cptr)shm;
  const int ksw = (r32 >> 2) & 3;
  const lds_cptr fq0 = shm3 + r32 * 64 + (((2 * hi) ^ ksw) * 16), fq1 = shm3 + r32 * 64 + (((2 * hi + 1) ^ ksw) * 16);
  DMA_K(0, 0); DMA_V(0, 0); DMA_K(1, SL);
  v8i_t qf;
  { const v4i_t* qp = (const v4i_t*)(Qf8 + (size_t)(qrow + wid * QBLK + r32) * 1024 + qcol + hi * 32); const v4i_t a = qp[0], b = qp[1]; qf = (v8i_t){a[0], a[1], a[2], a[3], b[0], b[1], b[2], b[3]}; }
  f32x16 o[2]; o[0] = f32x16{}; o[1] = f32x16{}; f32x16 osum = f32x16{};
  f32x16 negm;
  #pragma unroll
  for (int r = 0; r < 16; ++r) negm[r] = -cref;
  asm volatile("" : "+v"(negm));
  v8i_t ones8;
  #pragma unroll
  for (int i = 0; i < 8; ++i) ones8[i] = 0x38383838;
  asm volatile("" : "+v"(ones8));
  const int qrel = wid * QBLK + r32;
  int mlo = -128, mhi = 128;
  if (MODE == 1) { const int qi = q0 + qrel; mlo = (-qi > -128) ? -qi : -128; mhi = (SEQ - 1 - qi < 128) ? (SEQ - 1 - qi) : 128; }
  const unsigned mspan = (unsigned)(mhi - mlo);
  #define CMASK(P0, P1, t) do { if (MODE == 1) { if ((t) >= 4) bandmask(P0, P1, (t), mlo, mspan, qrel, hi); } } while (0)
  #define MFQK(kfr) __builtin_amdgcn_mfma_scale_f32_32x32x64_f8f6f4(kfr, qf, negm, 0, 0, 0, 0x7F7F7F7F, 0, 0x7F7F7F7F)
  #define MFPV(bfr, cin) __builtin_amdgcn_mfma_scale_f32_32x32x64_f8f6f4(pf, bfr, cin, 1, 0, 0, 0x7F7F7F7F, 0, 0x7F7F7F7F)
  #define FLOAD(dst, base, b, slot) do { const v4i_t a_ = *(const LAS v4i_t*)(fq0 + (base) + (slot) + (b) * 2048), b_ = *(const LAS v4i_t*)(fq1 + (base) + (slot) + (b) * 2048); dst = (v8i_t){a_[0], a_[1], a_[2], a_[3], b_[0], b_[1], b_[2], b_[3]}; } while (0)
  #define PK8(x0, x1, x2, x3) __builtin_amdgcn_cvt_pk_bf8_f32(x2, x3, __builtin_amdgcn_cvt_pk_bf8_f32(x0, x1, 0, false), true)
  f32x16 pA0, pA1, pB0, pB1;
  int sl_prev = 0, sl_cur = 0, sl_next = SL;
  #define ROT() do { sl_prev = sl_cur; sl_cur = sl_next; sl_next = (sl_next == 2 * SL) ? 0 : sl_next + SL; } while (0)
  DMA_K(2, 2 * SL);
  WAIT_BAR(3);
  v8i_t kf0, kf1, vf0, vf1, pf;
  FLOAD(kf0, LK, 0, 0); FLOAD(kf1, LK, 1, 0);
  pA0 = MFQK(kf0); pA1 = MFQK(kf1);
  asm volatile("s_nop 15\n\ts_nop 7" : "+v"(pA0), "+v"(pA1)); CMASK(pA0, pA1, 0);
  _Pragma("unroll") for (int r = 0; r < 16; ++r) { pA0[r] = __builtin_amdgcn_exp2f(pA0[r]); pA1[r] = __builtin_amdgcn_exp2f(pA1[r]); }
  WAIT_BAR(0);
  DMA_K(3, 0); DMA_V(1, SL);
  ROT();
  FLOAD(kf0, LK, 0, sl_cur); FLOAD(kf1, LK, 1, sl_cur);
  WAIT_BAR(2);
  #define PIN(x) asm volatile("" : "+v"(x))
  #define EX(v) __builtin_amdgcn_exp2f(v)
  #define EX8(X, B) do { _Pragma("unroll") for (int e_ = 0; e_ < 8; ++e_) X[(B) + e_] = EX(X[(B) + e_]); PIN(X); } while (0)
  #define PACKP(P0, P1) do { pf[0] = PK8(P0[0], P0[1], P0[2], P0[3]); pf[1] = PK8(P0[4], P0[5], P0[6], P0[7]); pf[2] = PK8(P0[8], P0[9], P0[10], P0[11]); pf[3] = PK8(P0[12], P0[13], P0[14], P0[15]); \
                             pf[4] = PK8(P1[0], P1[1], P1[2], P1[3]); pf[5] = PK8(P1[4], P1[5], P1[6], P1[7]); pf[6] = PK8(P1[8], P1[9], P1[10], P1[11]); pf[7] = PK8(P1[12], P1[13], P1[14], P1[15]); PIN(pf); } while (0)
  #define STEP(C0, C1, P0, P1, t, GK, GV, GL) do { SBAR(); \
    FLOAD(vf0, LV, 0, sl_prev); FLOAD(vf1, LV, 1, sl_prev); SBAR(); \
    C0 = MFQK(kf0); SBAR(); \
    PACKP(P0, P1); SBAR(); \
    C1 = MFQK(kf1); SBAR(); \
    if (GK) { DMA_K((t) + 3, sl_cur); } if (GV) { DMA_V((t) + 1, sl_next); } \
    osum = MFPV(ones8, osum); SBAR(); \
    CMASK(C0, C1, t); SBAR(); \
    o[0] = MFPV(vf0, o[0]); EX8(C0, 0); SBAR(); \
    if (GL) { FLOAD(kf0, LK, 0, sl_next); SBAR(); } \
    EX8(C0, 8); SBAR(); \
    o[1] = MFPV(vf1, o[1]); EX8(C1, 0); SBAR(); \
    if (GL) { FLOAD(kf1, LK, 1, sl_next); SBAR(); } \
    EX8(C1, 8); SBAR(); \
    } while (0)
  int t = 1;
  for (; t + 5 < NT; t += 2) {
    STEP(pB0, pB1, pA0, pA1, t, true, true, true);     WAIT_BAR(2); ROT();
    STEP(pA0, pA1, pB0, pB1, t + 1, true, true, true);   WAIT_BAR(2); ROT();
  }
  #define ENDW(tt) do { if ((tt) + 3 < NT) { WAIT_BAR(2); } else if ((tt) + 2 < NT) { WAIT_BAR(1); } else { WAIT_BAR(0); } } while (0)
  for (; t + 1 < NT; t += 2) {
    STEP(pB0, pB1, pA0, pA1, t, (t + 3 < NT), (t + 1 < NT), (t + 1 < NT));       ENDW(t);   ROT();
    STEP(pA0, pA1, pB0, pB1, t + 1, (t + 4 < NT), (t + 2 < NT), (t + 2 < NT));     ENDW(t + 1); ROT();
  }
  STEP(pB0, pB1, pA0, pA1, NT - 1, false, false, false);
  { PACKP(pB0, pB1); SBAR(); FLOAD(vf0, LV, 0, sl_cur); FLOAD(vf1, LV, 1, sl_cur); osum = MFPV(ones8, osum); o[0] = MFPV(vf0, o[0]); o[1] = MFPV(vf1, o[1]); }
  #undef PIN
  #undef EX
  #undef EX8
  #undef PACKP
  #undef STEP
  #undef ENDW
  #undef MFQK
  #undef MFPV
  #undef FLOAD
  #undef PK8
  const float sterm = __builtin_amdgcn_exp2f(sink2 - cref);
  float rli[16];
  #pragma unroll
  for (int r = 0; r < 16; ++r) rli[r] = __builtin_amdgcn_rcpf(osum[r] + sterm);
  bf16* Ow = O + (qrow + wid * QBLK) * QP + qcol;
  { bf16* stg = (bf16*)(shm + LOST) + wid * 2048;
    #pragma unroll
    for (int r = 0; r < 16; ++r) { const int orow = crow(r, hi);
      #pragma unroll
      for (int d0 = 0; d0 < 2; ++d0) stg[orow * 64 + d0 * 32 + r32] = __float2bfloat16(o[d0][r] * rli[r]); }
    asm volatile("s_waitcnt lgkmcnt(0)" ::: "memory");
    #pragma unroll
    for (int i = 0; i < 4; ++i) { const int row = i * 8 + (lane >> 3), ch = lane & 7; const u32x4 v = *(const u32x4*)(stg + row * 64 + ch * 8); ATTN_STORE16(Ow + (long)row * QP + ch * 8, v); } }
  asm volatile("s_waitcnt lgkmcnt(0)\n\ts_barrier" ::: "memory");
  #undef DMA_K
  #undef DMA_V
  #undef ROWOFF
  #undef CMASK
  #undef ROT
}
constexpr int ATTN_LDS_BYTES = LDS_BYTES;
#undef SBAR
#undef WAIT_BAR
}

struct Args { const float* in[20]; float* out; unsigned char* ws; int ph_lo, ph_hi; };
typedef const Args __attribute__((address_space(4)))* kargp_t;
__device__ __forceinline__ kargp_t kargs() { auto p = __builtin_amdgcn_kernarg_segment_ptr(); asm volatile("" : "+s"(p)); return (kargp_t)p; }
enum { I_X = 0, I_C, I_CTX, I_CCTX, I_ADAW, I_ADAB, I_GATTN, I_GFFN, I_WIN, I_QNG, I_KNG, I_QNL, I_KNL, I_SINK, I_WOUT, I_RW, I_RB, I_WGATE, I_WUP, I_WDOWN };
struct Frame {
    LAS unsigned char* lds; volatile LAS unsigned* MISC;
    int tid, lane, wave, vcu, G;
};
#define WSP(T, off) ((T*)(kargs()->ws + (off)))
__device__ const float ROPE_INV[16] = {1.000000000e+00f, 5.623413324e-01f, 3.162277639e-01f, 1.778279394e-01f, 1.000000015e-01f, 5.623413250e-02f, 3.162277490e-02f, 1.778279431e-02f,
                                       9.999999776e-03f, 5.623413250e-03f, 3.162277630e-03f, 1.778279431e-03f, 1.000000047e-03f, 5.623413017e-04f, 3.162277571e-04f, 1.778279402e-04f};

template <int KIND> __device__ __forceinline__ int dst_row(int n) {
    if (KIND == 0) return n;
    if (KIND == 2) return ((n >> 7) << 8) + (n & 127);
    if (KIND == 3) return ((n >> 7) << 8) + 128 + (n & 127);
    int tile, wc;
    if (n < 512) { const int h = n >> 6; tile = h >> 2; wc = h & 3; }
    else if (n < 640) { tile = 4; wc = (n - 512) >> 6; }
    else if (n < 768) { tile = 4; wc = 2 + ((n - 640) >> 6); }
    else if (n < 1280) { const int h = (n - 768) >> 6; tile = 2 + (h >> 2); wc = h & 3; }
    else if (n < 1408) { tile = 5; wc = (n - 1280) >> 6; }
    else { tile = 5; wc = 2 + ((n - 1408) >> 6); }
    const int d = n & 63, bj = d >> 5, dd = d & 31, np = dd >> 4, f = dd & 15, fq = f >> 2, j = f & 3;
    return 256 * tile + 128 * bj + 32 * wc + 8 * fq + 4 * np + j;
}
template <int KIND> __device__ __forceinline__ void p0_transpose_item(const float* W, int N, bf16_t* WT, int Kd, LAS float* scr, int kb, int nb, int lane) {
    const int k0 = 64 * kb, n0 = 32 * nb;
#pragma unroll 8
    for (int i = 0; i < 32; ++i) { const int kk = 2 * i + (lane >> 5); scr[kk * 33 + (lane & 31)] = W[(size_t)(k0 + kk) * N + n0 + (lane & 31)]; }
    LDS_WAIT(); asm volatile("" ::: "memory");
    const int c = lane & 7;
#pragma unroll
    for (int j = 0; j < 4; ++j) { const int n = (lane >> 3) + 8 * j; const LAS float* s = scr + (8 * c) * 33 + n;
        u32x4 o; o.x = pk2(s[0 * 33], s[1 * 33]); o.y = pk2(s[2 * 33], s[3 * 33]); o.z = pk2(s[4 * 33], s[5 * 33]); o.w = pk2(s[6 * 33], s[7 * 33]);
        *(GAS u32x4*)(WT + (size_t)dst_row<KIND>(n0 + n) * Kd + k0 + 8 * c) = o; }
    LDS_WAIT(); asm volatile("" ::: "memory");
}
__device__ __forceinline__ void sincos_d(float ang, float& cs, float& sn) {
    const double x = (double)ang; const double kq = __builtin_rint(x * 0.63661977236758134308);
    const double r = (x - kq * 1.5707963267948966192) - kq * 6.123233995736766036e-17, r2 = r * r;
    const double s = r * (1.0 + r2 * (-1.0 / 6 + r2 * (1.0 / 120 + r2 * (-1.0 / 5040 + r2 * (1.0 / 362880 + r2 * (-1.0 / 39916800 + r2 * (1.0 / 6227020800.0)))))));
    const double c = 1.0 + r2 * (-0.5 + r2 * (1.0 / 24 + r2 * (-1.0 / 720 + r2 * (1.0 / 40320 + r2 * (-1.0 / 3628800 + r2 * (1.0 / 479001600.0 + r2 * (-1.0 / 87178291200.0)))))));
    const int q = ((int)kq) & 3;
    const double cc = (q == 0) ? c : (q == 1) ? -s : (q == 2) ? -c : s;
    const double ss = (q == 0) ? s : (q == 1) ? c : (q == 2) ? -s : -c;
    cs = (float)cc; sn = (float)ss;
}
__device__ __forceinline__ void p0_prologue(Frame& F) {
    const int gw = F.vcu * NWAVES + F.wave, NGW = F.G * NWAVES;
    {
        const float* c = kargs()->in[I_C]; const float* cctx = kargs()->in[I_CCTX]; const float* ada_w = kargs()->in[I_ADAW]; const float* ada_b = kargs()->in[I_ADAB];
        float* modv = WSP(float, WS_MODV);
        LAS float* sv = (LAS float*)(F.lds);
        LAS float* part = (LAS float*)(F.lds + 16384);
        for (int i = F.tid; i < 3072; i += NWAVES * 64) { const int v = i >> 10, k = i & 1023; const float cv = v < 2 ? c[v * 1024 + k] : cctx[k]; sv[i] = cv / (1.0f + expf(-cv)); }
        __syncthreads();
        for (int tile = F.vcu; tile < NLAYER * 96; tile += F.G) {
            const int l = tile / 96, c0 = (tile % 96) * 64;
            const float* W = ada_w + (size_t)l * 1024 * 6144 + c0 + F.lane;
            float a0 = 0.f, a1 = 0.f, a2 = 0.f; const int kb = F.wave * 128;
#pragma unroll 8
            for (int k = 0; k < 128; ++k) { const float w = W[(size_t)(kb + k) * 6144]; a0 += sv[kb + k] * w; a1 += sv[1024 + kb + k] * w; a2 += sv[2048 + kb + k] * w; }
            part[(F.wave * 3 + 0) * 64 + F.lane] = a0; part[(F.wave * 3 + 1) * 64 + F.lane] = a1; part[(F.wave * 3 + 2) * 64 + F.lane] = a2;
            __syncthreads();
            if (F.tid < 192) { const int v = F.tid >> 6, col = F.tid & 63; float s = ada_b[l * 6144 + c0 + col];
#pragma unroll
                for (int w = 0; w < 8; ++w) s += part[(w * 3 + v) * 64 + col];
                modv[(size_t)(l * 3 + v) * 6144 + c0 + col] = s; }
            __syncthreads();
        }
    }
    { float* rope = WSP(float, WS_ROPE); const int gt = F.vcu * NWAVES * 64 + F.tid; if (gt < 4096) { const int pos = gt >> 4, f = gt & 15; const float ang = (float)pos * ROPE_INV[f]; float cs, sn; sincos_d(ang, cs, sn); rope[gt * 2] = cs; rope[gt * 2 + 1] = sn; } }
    { const int gt = F.vcu * NWAVES * 64 + F.tid; if (gt < NLAYER * 256) { const int l = gt >> 8, kq = (gt >> 6) & 3, d = gt & 63; const float* src = kargs()->in[kq == 0 ? I_QNG : (kq == 1 ? I_QNL : (kq == 2 ? I_KNG : I_KNL))]; WSP(float, WS_GN)[gt] = src[l * 64 + d]; } }
    if (gw < NLAYER * 2) { const int l = gw >> 1, loc = gw & 1; float mq = fabsf(kargs()->in[loc ? I_QNL : I_QNG][l * 64 + F.lane]), mk = fabsf(kargs()->in[loc ? I_KNL : I_KNG][l * 64 + F.lane]);
#pragma unroll
        for (int o = 1; o < 64; o <<= 1) { mq = fmaxf(mq, __shfl_xor(mq, o)); mk = fmaxf(mk, __shfl_xor(mk, o)); }
        if (F.lane == 0) WSP(float, WS_BND)[gw] = 64.0f * C2 * mq * mk * 1.02f + 0.05f; }
    { u32x4* p = (u32x4*)(WSP(unsigned char, WS_KV) + (size_t)(NROW / 64) * KV_TILEB); for (int i = F.vcu * NWAVES * 64 + F.tid; i < 4 * KV_TILEB / 16; i += F.G * NWAVES * 64) p[i] = (u32x4){0u, 0u, 0u, 0u}; }
    {
        const float* x = kargs()->in[I_X]; const float* ctx = kargs()->in[I_CTX]; bf16_t* XS = WSP(bf16_t, WS_XS);
        for (int R = gw; R < NROW; R += NGW) {
            const int b = R >= RB ? 1 : 0, rr = R - b * RB;
            const float* src = rr < NCTX ? ctx + (size_t)(b * NCTX + rr) * 1024 : x + (size_t)(b * SEQ + rr - NCTX) * 1024;
            const f32x4* s4 = (const f32x4*)src + F.lane; u32x2* d2 = (u32x2*)(XS + (size_t)R * 1024) + F.lane;
            f32x4 v[4];
#pragma unroll
            for (int j = 0; j < 4; ++j) v[j] = s4[64 * j];
#pragma unroll
            for (int j = 0; j < 4; ++j) { u32x2 w; w.x = pk2(v[j][0], v[j][1]); w.y = pk2(v[j][2], v[j][3]); d2[64 * j] = w; }
        }
    }
    {
        LAS float* scr = (LAS float*)(F.lds + RING_OFF + F.wave * 16384);
        constexpr int I_IN = 4 * 768, I_OUT = 4 * 512, I_G = 64 * 256, I_U = 64 * 256, I_D = 64 * 256;
        for (int it0 = gw; it0 < I_IN + I_OUT + I_G + I_U + I_D; it0 += NGW) {
            int it = it0;
            if (it < I_IN) { const int l = it / 768, r = it % 768; p0_transpose_item<1>(kargs()->in[I_WIN] + (size_t)l * 1024 * 1536, 1536, WSP(bf16_t, WS_WIN) + (size_t)l * 1536 * 1024, 1024, scr, r / 48, r % 48, F.lane); continue; } it -= I_IN;
            if (it < I_OUT) { const int l = it / 512, r = it % 512; p0_transpose_item<0>(kargs()->in[I_WOUT] + (size_t)l * 1024 * 1024, 1024, WSP(bf16_t, WS_WOUT) + (size_t)l * 1024 * 1024, 1024, scr, r / 32, r % 32, F.lane); continue; } it -= I_OUT;
            if (it < I_G) { const int m = it / 256, r = it % 256; p0_transpose_item<2>(kargs()->in[I_WGATE] + (size_t)m * 1024 * 512, 512, WSP(bf16_t, WS_WGU) + (size_t)m * 1024 * 1024, 1024, scr, r / 16, r % 16, F.lane); continue; } it -= I_G;
            if (it < I_U) { const int m = it / 256, r = it % 256; p0_transpose_item<3>(kargs()->in[I_WUP] + (size_t)m * 1024 * 512, 512, WSP(bf16_t, WS_WGU) + (size_t)m * 1024 * 1024, 1024, scr, r / 16, r % 16, F.lane); continue; } it -= I_U;
            { const int m = it / 256, r = it % 256; p0_transpose_item<0>(kargs()->in[I_WDOWN] + (size_t)m * 512 * 1024, 1024, WSP(bf16_t, WS_WD) + (size_t)m * 1024 * 512, 512, scr, r / 32, r % 32, F.lane); }
        }
    }
}

__device__ __forceinline__ void load_row(const bf16_t* xrow, int lane, f32x4 (&h)[4]) {
    const u32x2* xr = (const u32x2*)xrow + lane;
#pragma unroll
    for (int j = 0; j < 4; ++j) { const u32x2 w = xr[64 * j]; h[j] = (f32x4){__builtin_bit_cast(float, w.x << 16), __builtin_bit_cast(float, w.x & 0xffff0000u), __builtin_bit_cast(float, w.y << 16), __builtin_bit_cast(float, w.y & 0xffff0000u)}; }
}
__device__ __forceinline__ void rms_mod(const float* g, const float* sh, const float* sc, int lane, f32x4 (&h)[4]) {
    float ss = 0.f;
#pragma unroll
    for (int j = 0; j < 4; ++j) ss += (h[j][0] * h[j][0] + h[j][1] * h[j][1]) + (h[j][2] * h[j][2] + h[j][3] * h[j][3]);
    const float rs = 1.0f / sqrtf(wave_sum(ss) * (1.0f / 1024.0f) + NORM_EPS);
#pragma unroll
    for (int j = 0; j < 4; ++j) { const f32x4 gg = ((const f32x4*)g)[lane + 64 * j], s1 = ((const f32x4*)sh)[lane + 64 * j], s2 = ((const f32x4*)sc)[lane + 64 * j];
        h[j] = (h[j] * rs * gg) * (1.0f + s2) + s1; }
}
__device__ __forceinline__ void store_row_bf16(bf16_t* orow, int lane, const f32x4 (&h)[4]) {
    u32x2* o8 = (u32x2*)orow + lane;
#pragma unroll
    for (int j = 0; j < 4; ++j) { u32x2 w; w.x = pk2(h[j][0], h[j][1]); w.y = pk2(h[j][2], h[j][3]); o8[64 * j] = w; }
}
__device__ __forceinline__ int row_mv(int R) { const int b = R >= RB ? 1 : 0; return (R - b * RB) < NCTX ? 2 : b; }

__device__ __forceinline__ void phase_norm1(Frame& F0, int l) {
    Frame F = F0; asm volatile("" : "+v"(F.tid), "+v"(F.lane), "+s"(F.wave), "+s"(F.vcu));
    const int gw = F.vcu * NWAVES + F.wave, NGW = F.G * NWAVES;
    const float* g = kargs()->in[I_GATTN] + l * 1024; const float* modv = WSP(float, WS_MODV); const bf16_t* XS = WSP(bf16_t, WS_XS); bf16_t* HN = WSP(bf16_t, WS_HN);
    f32x4 xn[4]; if (gw < NROW) load_row(XS + (size_t)gw * 1024, F.lane, xn);
    for (int R = gw; R < NROW; R += NGW) {
        const float* mv = modv + (size_t)(l * 3 + row_mv(R)) * 6144;
        f32x4 h[4];
#pragma unroll
        for (int j = 0; j < 4; ++j) h[j] = xn[j];
        if (R + NGW < NROW) load_row(XS + (size_t)(R + NGW) * 1024, F.lane, xn);
        rms_mod(g, mv + 0, mv + 1024, F.lane, h);
        store_row_bf16(HN + (size_t)R * 1024, F.lane, h);
    }
}
__device__ __forceinline__ void phase_norm2_router(Frame& F0, int l, bool lastl, bool dry = false) {
    Frame F = F0; asm volatile("" : "+v"(F.tid), "+v"(F.lane), "+s"(F.wave), "+s"(F.vcu));
    const int gw = F.vcu * NWAVES + F.wave, NGW = F.G * NWAVES;
    LAS f32x4* RW = (LAS f32x4*)(F.lds + RING_OFF);
    { const float* router_w = kargs()->in[I_RW];
      for (int idx = F.tid; idx < 4096; idx += NWAVES * 64) { const int j = idx >> 10, e = (idx >> 6) & 15, ln = idx & 63, c = 4 * ln + 256 * j;
        RW[idx] = (f32x4){router_w[(c + 0) * 16 + e], router_w[(c + 1) * 16 + e], router_w[(c + 2) * 16 + e], router_w[(c + 3) * 16 + e]}; } }
    __syncthreads();
    const float* g = kargs()->in[I_GFFN] + l * 1024; const float* router_b = kargs()->in[I_RB];
    LAS float* PS = (LAS float*)(F.lds + RING_OFF + 65536) + F.wave * (16 * 65);
    const float* modv = WSP(float, WS_MODV); const bf16_t* XS = WSP(bf16_t, WS_XS); bf16_t* HN = WSP(bf16_t, WS_HN);
    int my_cls = -1, my_tok = 0; float my_wlo = 0.f, my_whi = 0.f;
    int k = 0;
    f32x4 xn[4]; if (gw < NROW) load_row(XS + (size_t)gw * 1024, F.lane, xn);
    for (int R = gw; R < NROW; R += NGW, ++k) {
        const int mvi = row_mv(R);
        f32x4 h[4];
#pragma unroll
        for (int j = 0; j < 4; ++j) h[j] = xn[j];
        if (R + NGW < NROW) load_row(XS + (size_t)(R + NGW) * 1024, F.lane, xn);
        if (lastl && mvi == 2) continue;
        const float* mv = modv + (size_t)(l * 3 + mvi) * 6144;
        rms_mod(g, mv + 3072, mv + 4096, F.lane, h);
        store_row_bf16(HN + (size_t)R * 1024, F.lane, h);
        {
            float s[16];
#pragma unroll
            for (int e = 0; e < 16; ++e) s[e] = 0.f;
#pragma unroll
            for (int j = 0; j < 4; ++j)
#pragma unroll
                for (int e = 0; e < 16; ++e) { const f32x4 w4 = RW[(j * 16 + e) * 64 + F.lane]; s[e] += (h[j][0] * w4[0] + h[j][1] * w4[1]) + (h[j][2] * w4[2] + h[j][3] * w4[3]); }
#pragma unroll
            for (int e = 0; e < 16; ++e) PS[e * 65 + F.lane] = s[e];
        }
        float tl = 0.f;
        { const LAS float* pr = PS + (F.lane & 15) * 65 + (F.lane >> 4) * 16;
#pragma unroll
          for (int i = 0; i < 16; ++i) tl += pr[i]; }
        tl += __shfl_xor(tl, 16); tl += __shfl_xor(tl, 32);
        const float my_sc = 1.0f / (1.0f + expf(-tl)), my_sel = my_sc + router_b[F.lane & 15];
        float sc[16], sel[16];
#pragma unroll
        for (int e = 0; e < 16; ++e) { sc[e] = __builtin_bit_cast(float, __builtin_amdgcn_readlane(__builtin_bit_cast(int, my_sc), e)); sel[e] = __builtin_bit_cast(float, __builtin_amdgcn_readlane(__builtin_bit_cast(int, my_sel), e)); }
        float gs[4];
#pragma unroll
        for (int gq = 0; gq < 4; ++gq) { const float a = sel[4 * gq], b = sel[4 * gq + 1], c = sel[4 * gq + 2], d = sel[4 * gq + 3];
            const float h1 = fmaxf(a, b), l1 = fminf(a, b), h2 = fmaxf(c, d), l2 = fminf(c, d);
            gs[gq] = fmaxf(h1, h2) + fmaxf(fminf(h1, h2), fmaxf(l1, l2)); }
        int gi = 0; float bg = gs[0];
#pragma unroll
        for (int gq = 1; gq < 4; ++gq) if (gs[gq] > bg) { bg = gs[gq]; gi = gq; }
        float s4[4], c4[4];
#pragma unroll
        for (int q = 0; q < 4; ++q) { s4[q] = sel[q]; c4[q] = sc[q]; }
#pragma unroll
        for (int gq = 1; gq < 4; ++gq)
#pragma unroll
            for (int q = 0; q < 4; ++q) { s4[q] = (gi == gq) ? sel[4 * gq + q] : s4[q]; c4[q] = (gi == gq) ? sc[4 * gq + q] : c4[q]; }
        int i1 = 0; float b1 = s4[0], w1 = c4[0];
#pragma unroll
        for (int q = 1; q < 4; ++q) if (s4[q] > b1) { b1 = s4[q]; i1 = q; w1 = c4[q]; }
        int i2 = -1; float b2 = -INFINITY, w2 = 0.f;
#pragma unroll
        for (int q = 0; q < 4; ++q) if (q != i1 && (i2 < 0 || s4[q] > b2)) { b2 = s4[q]; i2 = q; w2 = c4[q]; }
        const float wsum = w1 + w2; w1 = w1 / wsum; w2 = w2 / wsum;
        const int ia = i1 < i2 ? i1 : i2, ib = i1 < i2 ? i2 : i1;
        const float wlo = i1 < i2 ? w1 : w2, whi = i1 < i2 ? w2 : w1;
        const int pidx = ia == 0 ? ib - 1 : (ia == 1 ? ib + 1 : 5);
        if (F.lane == k) { my_cls = gi * 6 + pidx; my_tok = R; my_wlo = wlo; my_whi = whi; }
    }
    if (my_cls >= 0 && !dry) {
        const unsigned pos = __hip_atomic_fetch_add(WSP(unsigned, WS_CTL) + CW_CNT + (l * NCLS + my_cls) * 64, 1u, RLX_AGENT);
        WSP(int, WS_TOK)[(size_t)my_cls * CAP + pos] = my_tok; WSP(f32x2, WS_WTS)[(size_t)my_cls * CAP + pos] = (f32x2){my_wlo, my_whi};
    }
    __syncthreads();
}
__device__ __forceinline__ int moe_tables(Frame& F0, int l) {
    Frame F = F0; asm volatile("" : "+v"(F.tid));
    LAS int* s_n = (LAS int*)(F.lds + MOE_OFF); LAS int* s_ts = s_n + 32;
    __syncthreads();
    if (F.tid < NCLS) s_n[F.tid] = (int)__hip_atomic_load(WSP(unsigned, WS_CTL) + CW_CNT + (l * NCLS + F.tid) * 64, RLX_AGENT);
    __syncthreads();
    if (F.tid == 0) { int acc = 0; for (int c = 0; c < NCLS; ++c) { s_ts[c] = acc; acc += (s_n[c] + 255) >> 8; } s_ts[NCLS] = acc; }
    __syncthreads();
    return s_ts[NCLS];
}

constexpr int NPHASE = 1 + 7 * NLAYER;
__global__ void __launch_bounds__(NWAVES * 64, 2) fwd_kernel(Args args) {
    extern __shared__ __attribute__((aligned(16))) unsigned char lds[];
    Frame F;
    F.lds = (LAS unsigned char*)lds; F.MISC = (volatile LAS unsigned*)(F.lds + MISC_OFF);
    F.tid = threadIdx.x; F.lane = F.tid & 63; F.wave = __builtin_amdgcn_readfirstlane(F.tid >> 6);
    F.G = gridDim.x; { const int bx = blockIdx.x; F.vcu = (F.G % 8 == 0) ? (bx % 8) * (F.G / 8) + bx / 8 : bx; }
    for (int u = F.tid; u < (LDS_BYTES - LDSCTL_OFF) / 4; u += NWAVES * 64) ((LAS unsigned*)(F.lds + LDSCTL_OFF))[u] = 0u;
    __syncthreads();
    const int lo = args.ph_lo, hi = args.ph_hi;
    XcdBarrier bar; bar.bar = WSP(unsigned, WS_CTL) + CW_BAR; bar.x = 0; bar.st = nullptr;
    if (hi - lo > 1) bar = xcd_barrier_post(WSP(unsigned, WS_CTL) + CW_BAR, F.MISC + 8);
#ifndef MK_EN
#define MK_EN 0xff
#endif
#define EN(k) (((MK_EN) >> (k)) & 1)
#ifndef REP_P0
#define REP_P0 1
#endif
#ifndef REP_A
#define REP_A 1
#endif
#ifndef REP_B
#define REP_B 1
#endif
#ifndef REP_C
#define REP_C 1
#endif
#ifndef REP_F
#define REP_F 1
#endif
#ifndef REP_D
#define REP_D 1
#endif
#ifndef REP_E
#define REP_E 1
#endif
#ifndef REP_G
#define REP_G 1
#endif
#define RUN(p) (lo <= (p) && (p) < hi)
#ifndef REP_BAR
#define REP_BAR 1
#endif
#define SEAM(p) do { if (RUN(p) && RUN((p) + 1)) { xcd_barrier(bar); if (REP_BAR > 1) xcd_barrier(bar); if (REP_BAR > 2) xcd_barrier(bar); } } while (0)

    if (EN(7) && RUN(0)) { for (int rep = 0; rep < REP_P0; ++rep) { p0_prologue(F); if (rep + 1 < REP_P0) xcd_barrier(bar); } SEAM(0); }

    for (int l = 0; l < NLAYER; ++l) {
        const int pb = 1 + 7 * l; const bool lastl = (l == NLAYER - 1);
        if (EN(0) && RUN(pb + 0)) { for (int rep = 0; rep < REP_A; ++rep) { phase_norm1(F, l); if (rep + 1 < REP_A) xcd_barrier(bar); } SEAM(pb + 0); }
        if (EN(1) && RUN(pb + 1)) {
            pg8::ProbDense P; P.A = WSP(const char, WS_HN); P.B = (const char*)(WSP(bf16_t, WS_WIN) + (size_t)l * 1536 * 1024); P.lda = 1024; P.ldb = 1024; P.nt = 16; P.skip_ctx = false; P.S.init(NROW, 1536, F.G, (int)blockIdx.x);
            pg8::EpiQKV E{kargs()->ws, WSP(float, WS_GN) + l * 256, WSP(float, WS_ROPE)};
            for (int rep = 0; rep < REP_B; ++rep) { pg8::gemm_phase<pg8::EpiQKV, pg8::ProbDense, true>(F.lds + RING_OFF, F.lds + OFFS_OFF, P, E); if (rep + 1 < REP_B) xcd_barrier(bar); }
            SEAM(pb + 1);
        }
        if (EN(2) && RUN(pb + 2)) {
            const unsigned char* Qf8 = WSP(const unsigned char, WS_QO); const unsigned char* KVT = WSP(const unsigned char, WS_KV); attn_body::bf16* O = WSP(attn_body::bf16, WS_HN);
            const float* sink = kargs()->in[I_SINK] + l * 8;
            const int n0 = 1024 + (lastl ? 0 : 32);
            const float bnd_g = WSP(const float, WS_BND)[l * 2], bnd_l = WSP(const float, WS_BND)[l * 2 + 1];
#if VFP8
            const float ref_g = bnd_g - 15.5f, ref_l = bnd_l - 15.5f;
#define ATTN_BODY attn_unit_f8b
#else
            const float ref_g = fmaxf(bnd_g - 96.0f, 0.0f), ref_l = fmaxf(bnd_l - 96.0f, 0.0f);
#define ATTN_BODY attn_unit_f8
#endif
            for (int rep = 0; rep < REP_C; ++rep) {
            for (int L = F.vcu; L < n0; L += F.G) {
                long qrow, kvrow; int qcol, st, NT; float sink2 = -INFINITY, ref = ref_g;
                if (L < 1024) { const int bh = L >> 6, b = bh >> 3, h = bh & 7, qb = L & 63; qrow = (long)b * RB + NCTX + qb * 256; kvrow = (long)b * RB; NT = RB / 64; qcol = h * 64; st = h >> 2; }
                else { const int Lc = L - 1024, b = Lc >> 4, h = Lc & 15; qrow = (long)b * RB; kvrow = qrow; NT = NCTX / 64; qcol = h * 64;
                    if (h < 8) { st = h >> 2; } else { const int hl = h - 8; st = 2 + (hl >> 2); sink2 = sink[hl] * LOG2E; ref = ref_l; } }
                attn_body::ATTN_BODY<0>(qrow, kvrow, 0, qcol, st, st, NT, sink2, ref, Qf8, KVT, O, (char*)lds + RING_OFF);
            }
            for (int L = F.vcu; L < 1024; L += F.G) {
                const int bh = L >> 6, b = bh >> 3, hl = bh & 7, qb = L & 63, q0 = qb * 256;
                attn_body::ATTN_BODY<1>((long)b * RB + NCTX + q0, (long)b * RB, q0, (8 + hl) * 64, 2 + (hl >> 2), 2 + (hl >> 2), 12, sink[hl] * LOG2E, ref_l, Qf8, KVT, O, (char*)lds + RING_OFF);
            }
            if (rep + 1 < REP_C) xcd_barrier(bar); }
            SEAM(pb + 2);
        }
        if (EN(3) && RUN(pb + 3)) {
            pg8::ProbDense P; P.A = WSP(const char, WS_HN); P.B = (const char*)(WSP(bf16_t, WS_WOUT) + (size_t)l * 1024 * 1024); P.lda = 1024; P.ldb = 1024; P.nt = 16; P.skip_ctx = lastl; P.S.init(lastl ? NB * SEQ : NROW, 1024, F.G, (int)blockIdx.x);
            for (int rep = 0; rep < REP_D; ++rep) {
            pg8::EpiResid E{WSP(bf16_t, WS_XS), WSP(float, WS_MODV) + (size_t)l * 3 * 6144, 2048, (rep & 1) ? -1.0f : 1.0f};
            pg8::gemm_phase<pg8::EpiResid, pg8::ProbDense, true>(F.lds + RING_OFF, F.lds + OFFS_OFF, P, E); if (rep + 1 < REP_D) xcd_barrier(bar); }
            SEAM(pb + 3);
        }
        if (EN(4) && RUN(pb + 4)) {
#if REP_E == 2
            phase_norm2_router(F, l, lastl, true); xcd_barrier(bar);
#endif
            phase_norm2_router(F, l, lastl, false); SEAM(pb + 4); }
        if (EN(5) && RUN(pb + 5)) {
            const int ntile = moe_tables(F, l);
            pg8::ProbGU P; P.A = WSP(const char, WS_HN); P.B = (const char*)(WSP(bf16_t, WS_WGU) + (size_t)l * 16 * 1024 * 1024); P.tok = WSP(int, WS_TOK); P.s_n = (const LAS int*)(F.lds + MOE_OFF); P.s_ts = P.s_n + 32;
            P.total = ntile * 8; P.G = F.G; P.c = F.vcu; P.nt = 16;
            pg8::EpiGU E{WSP(bf16_t, WS_ACT), WSP(f32x2, WS_WTS)};
            for (int rep = 0; rep < REP_F; ++rep) { pg8::gemm_phase<pg8::EpiGU, pg8::ProbGU, true>(F.lds + RING_OFF, F.lds + OFFS_OFF, P, E); if (rep + 1 < REP_F) xcd_barrier(bar); }
            SEAM(pb + 5);
        }
        if (EN(6) && RUN(pb + 6)) {
            const int ntile = moe_tables(F, l);
            pg8::ProbDown P; P.A = WSP(const char, WS_ACT); P.B = (const char*)(WSP(bf16_t, WS_WD) + (size_t)l * 16 * 1024 * 512); P.s_n = (const LAS int*)(F.lds + MOE_OFF); P.s_ts = P.s_n + 32;
            P.total = ntile * 4; P.G = F.G; P.c = F.vcu; P.nt = 16;
            for (int rep = 0; rep < REP_G; ++rep) {
            pg8::EpiDown E{WSP(bf16_t, WS_XS), lastl ? kargs()->out : nullptr, WSP(int, WS_TOK), WSP(float, WS_MODV) + (size_t)l * 3 * 6144, (rep & 1) ? -1.0f : 1.0f};
            pg8::gemm_phase<pg8::EpiDown, pg8::ProbDown, true>(F.lds + RING_OFF, F.lds + OFFS_OFF, P, E); if (rep + 1 < REP_G) xcd_barrier(bar); }
            SEAM(pb + 6);
        }
    }
#undef RUN
#undef SEAM
}

#ifndef MK_SPLIT
#define MK_SPLIT 0
#endif
extern "C" void kernel_launch(void* const* d_in, const int* in_sizes, int n_in, void* d_out, int out_size, void* d_ws, size_t ws_size, hipStream_t stream) {
    static int grid = 0;
    if (grid == 0) {
        if (n_in != 20 || in_sizes[0] != NB * SEQ * DM || out_size != NB * SEQ * DM || ws_size < WS_END) {
            fprintf(stderr, "kernel_launch: unexpected shapes (n_in %d, in0 %d, out %d, ws %zu); nothing launched\n", n_in, n_in > 0 ? in_sizes[0] : -1, out_size, ws_size); grid = -1; return; }
        int dev = 0, cus = 0, per_cu = 0;
        if (hipGetDevice(&dev) != hipSuccess || hipDeviceGetAttribute(&cus, hipDeviceAttributeMultiprocessorCount, dev) != hipSuccess) { grid = -1; return; }
        if (hipFuncSetAttribute((const void*)fwd_kernel, hipFuncAttributeMaxDynamicSharedMemorySize, LDS_BYTES) != hipSuccess) { fprintf(stderr, "kernel_launch: hipFuncSetAttribute failed\n"); grid = -1; return; }
        if (hipOccupancyMaxActiveBlocksPerMultiprocessor(&per_cu, (const void*)fwd_kernel, NWAVES * 64, LDS_BYTES) != hipSuccess || per_cu < 1)
            fprintf(stderr, "kernel_launch: note: occupancy query reports %d workgroups per CU\n", per_cu);
        (void)hipGetLastError();
        grid = cus;
    }
    if (grid < 0) return;
    if (hipMemsetAsync((char*)d_ws + WS_CTL, 0, CTL_ZERO_BYTES, stream) != hipSuccess) return;
    Args a{};
    for (int i = 0; i < 20; ++i) a.in[i] = (const float*)d_in[i];
    a.out = (float*)d_out; a.ws = (unsigned char*)d_ws;
#if MK_SPLIT
    for (int p = 0; p < NPHASE; ++p) { a.ph_lo = p; a.ph_hi = p + 1; hipLaunchKernelGGL(fwd_kernel, dim3(grid), dim3(NWAVES * 64), LDS_BYTES, stream, a); }
#else
    a.ph_lo = 0; a.ph_hi = NPHASE;
    hipLaunchKernelGGL(fwd_kernel, dim3(grid), dim3(NWAVES * 64), LDS_BYTES, stream, a);
#endif
    const hipError_t le = hipPeekAtLastError();
    if (le != hipSuccess) fprintf(stderr, "kernel_launch: launch failed: %s\n", hipGetErrorName(le));
}
```

```cpp
#include <hip/hip_runtime.h>
#include <hip/hip_bf16.h>
#include <cstdio>
#include <cstdint>
#include <cmath>

#define LAS __attribute__((address_space(3)))
#define GAS __attribute__((address_space(1)))
typedef unsigned short bf16_t;
typedef short bf16x8 __attribute__((ext_vector_type(8)));
typedef float f32x4 __attribute__((ext_vector_type(4)));
typedef float f32x2 __attribute__((ext_vector_type(2)));
typedef unsigned u32x4 __attribute__((ext_vector_type(4)));
typedef unsigned u32x2 __attribute__((ext_vector_type(2)));
typedef GAS unsigned gu32;

constexpr int NB = 2, SEQ = 16384, DM = 1024, NCTX = 256, NLAYER = 4, NEXP = 16, DEXP = 512;
constexpr int RB = SEQ + NCTX;
constexpr int NROW = NB * RB;
constexpr int NCLS = 24, CAP = NROW;
constexpr int MAXSLOT = 39424;
constexpr float NORM_EPS = 1e-6f;
constexpr float C2 = 0.125f * 1.4426950408889634f;
constexpr float LOG2E = 1.4426950408889634f;
#ifndef VFP8
#define VFP8 1
#endif
#ifndef EXPFREE
#define EXPFREE 1
#endif
constexpr int KV_VSL = VFP8 ? 4096 : 8192, KV_TILEB = 16384 + 4 * KV_VSL;
constexpr float SQC2 = 0.42466090014400953f;

constexpr size_t MiB = 1u << 20;
constexpr size_t WS_CTL = 0, CTL_ZERO_BYTES = 1 * MiB;
constexpr size_t WS_MODV = 1 * MiB;
constexpr size_t WS_ROPE = 2 * MiB;
constexpr size_t WS_GN = 3 * MiB;
constexpr size_t WS_BND = 3 * MiB + 8192;
constexpr size_t WS_TOK = 4 * MiB;
constexpr size_t WS_WTS = 8 * MiB;
constexpr size_t WS_WIN = 16 * MiB;
constexpr size_t WS_WOUT = 28 * MiB;
constexpr size_t WS_WGU = 36 * MiB;
constexpr size_t WS_WD = 164 * MiB;
constexpr size_t WS_XS = 228 * MiB;
constexpr size_t WS_HN = 358 * MiB;
constexpr size_t WS_QO = 423 * MiB;
constexpr size_t WS_KV = 488 * MiB;
constexpr size_t WS_ACT = 423 * MiB;
constexpr size_t WS_END = 522 * MiB;
static_assert(WS_TOK + (size_t)NCLS * CAP * 4 <= WS_WTS && WS_WTS + (size_t)NCLS * CAP * 8 <= WS_WIN, "lists");
static_assert(WS_KV + (size_t)(NROW + 256) * 512 * 2 <= WS_END && WS_ACT + (size_t)MAXSLOT * 1024 * 2 <= WS_END, "ws map");
constexpr int CW_TMO = 0, CW_CODE = 1, CW_BAR = 4096, CW_CNT = 8192;

constexpr int RING_OFF = 0, RING_BYTES = 131072;
constexpr int LDSCTL_OFF = RING_BYTES, MISC_OFF = LDSCTL_OFF + 320, MOE_OFF = LDSCTL_OFF + 1024, OFFS_OFF = LDSCTL_OFF + 2048  ;
constexpr int LDS_BYTES = 147456;
constexpr int NWAVES = 8;

#define LDS_WAIT() asm volatile("s_waitcnt lgkmcnt(0)" ::: "memory")
#define VM_WAIT() asm volatile("s_waitcnt vmcnt(0)" ::: "memory")
#define RLX_AGENT __ATOMIC_RELAXED, __HIP_MEMORY_SCOPE_AGENT

__device__ __forceinline__ unsigned f2bf(float f) { unsigned u = __builtin_bit_cast(unsigned, f); return (u + 0x7fffu + ((u >> 16) & 1u)) >> 16; }
__device__ __forceinline__ unsigned pk2(float lo, float hi) { return f2bf(lo) | (f2bf(hi) << 16); }
__device__ __forceinline__ unsigned cvt_pk_bf16(float lo, float hi) { unsigned r; asm volatile("v_cvt_pk_bf16_f32 %0, %1, %2" : "=v"(r) : "v"(lo), "v"(hi)); return r; }
__device__ __forceinline__ float wave_sum(float v) {
#pragma unroll
    for (int o = 1; o < 64; o <<= 1) v += __shfl_xor(v, o);
    return v;
}

#define XB_TMO      128
#define XB_XCNT(j)  (256  + 64 * (j))
#define XB_XSUB(j)  (1280 + 64 * (j))
#define XB_XGEN(j)  (2304 + 64 * (j))
#define XB_TOP      3328
#define XB_TOPGEN   3392
#define XCD_BAR_WORDS 3456
#define XB_SPIN_CAP (1u << 22)
__device__ __forceinline__ unsigned xb_ld(unsigned* p)              { return __hip_atomic_load(p, __ATOMIC_RELAXED, __HIP_MEMORY_SCOPE_AGENT); }
__device__ __forceinline__ unsigned xb_add(unsigned* p, unsigned v) { return __hip_atomic_fetch_add(p, v, __ATOMIC_RELAXED, __HIP_MEMORY_SCOPE_AGENT); }
__device__ __forceinline__ unsigned xb_xcc_id() { return (unsigned)__builtin_amdgcn_s_getreg((3 << 11) | 20) & 0xFu; }
#define XB_SPIN(cond, bar) do { unsigned _sp = 0; while (cond) { __builtin_amdgcn_s_sleep(1); \
    if ((++_sp & 255u) == 0u) { if (xb_ld(&(bar)[XB_TMO])) break; if (_sp > XB_SPIN_CAP) { atomicAdd(&(bar)[XB_TMO], 1u); break; } } } } while (0)
struct XcdBarrier { unsigned* bar; unsigned x; volatile LAS unsigned* st; };
__device__ __forceinline__ XcdBarrier xcd_barrier_post(unsigned* bar, volatile LAS unsigned* st) {
    XcdBarrier b; b.bar = bar; b.x = xb_xcc_id(); b.st = st;
    if (threadIdx.x == 0) (void)xb_add(&bar[XB_XCNT(b.x)], 1u);
    return b;
}
__device__ __forceinline__ void xcd_barrier_complete(unsigned* bar, unsigned x, unsigned& nloc, unsigned& nx) {
    const unsigned G = gridDim.x * gridDim.y * gridDim.z;
    unsigned sum, cnt, mine, sp = 0u;
    for (;;) {
        sum = 0u; cnt = 0u; mine = 0u;
#pragma unroll
        for (unsigned j = 0; j < 16; ++j) { const unsigned c = xb_ld(&bar[XB_XCNT(j)]); sum += c; cnt += (c > 0u) ? 1u : 0u; mine = (j == x) ? c : mine; }
        if (sum == G) break;
        __builtin_amdgcn_s_sleep(1);
        if ((++sp & 255u) == 0u) { if (xb_ld(&bar[XB_TMO])) break; if (sp > XB_SPIN_CAP) { atomicAdd(&bar[XB_TMO], 1u); break; } }
    }
    nloc = mine > 0u ? mine : 1u; nx = cnt > 0u ? cnt : 1u;
}
__device__ __forceinline__ void xcd_barrier(const XcdBarrier& b) {
    asm volatile("s_waitcnt vmcnt(0)" ::: "memory");
    __syncthreads();
    if (threadIdx.x == 0) {
        unsigned* bar = b.bar;
        __builtin_amdgcn_s_waitcnt(0);
        unsigned nloc = b.st[0], nx = b.st[1];
        if (nloc == 0u) { xcd_barrier_complete(bar, b.x, nloc, nx); b.st[0] = nloc; b.st[1] = nx; }
        const unsigned old = xb_add(&bar[XB_XSUB(b.x)], 1u);
        const unsigned gen = old / nloc;
        if (old + 1u == (gen + 1u) * nloc) {
            __builtin_amdgcn_fence(__ATOMIC_RELEASE, "agent");
            asm volatile("s_waitcnt vmcnt(0)" ::: "memory");
            const unsigned og = xb_add(&bar[XB_TOP], 1u);
            const unsigned tg = og / nx;
            if (og + 1u == (tg + 1u) * nx) xb_add(&bar[XB_TOPGEN], 1u);
            else XB_SPIN(xb_ld(&bar[XB_TOPGEN]) == tg, bar);
            __builtin_amdgcn_fence(__ATOMIC_ACQUIRE, "agent");
            xb_add(&bar[XB_XGEN(b.x)], 1u);
            asm volatile("s_waitcnt vmcnt(0)" ::: "memory");
        } else {
            XB_SPIN(xb_ld(&bar[XB_XGEN(b.x)]) == gen, bar);
            __builtin_amdgcn_fence(__ATOMIC_ACQUIRE, "agent");
            asm volatile("s_waitcnt vmcnt(0)" ::: "memory");
        }
    }
    __syncthreads();
}

namespace pg8 {
constexpr int BM = 256, BK = 64, HALF = 128, HTB = HALF * BK * 2, STAGE_BYTES = 8 * HTB, NXCD = 8, WGM = 8;
__host__ __device__ __forceinline__ int lds_byte(int r, int c) { const int st = (r >> 4) * 2 + (c >> 5), rr = r & 15, cc = c & 31, ob = rr * 64 + cc * 2; return st * 1024 + (ob ^ (((ob >> 9) & 1) << 5)); }
__host__ __device__ __forceinline__ void stage_rc(int b, int& R, int& C) { const int st = b / 1024, sb = b % 1024, swz = sb ^ (((sb >> 9) & 1) << 5); R = (st >> 1) * 16 + swz / 64; C = (st & 1) * 32 + (swz % 64) / 2; }
__host__ __device__ __forceinline__ int perm32(int rho) { const int n = rho >> 4, i = rho & 15; return 8 * (i >> 2) + 4 * n + (i & 3); }

struct Unit { int pm, pn, cls, row0, ncls, elo, ehi; };

struct StaticOrder {
    int nM, nN, nwg, G, c;
    __device__ void init(int M, int N, int G_, int c_) { nM = M / BM; nN = N / BM; nwg = nM * nN; G = G_; c = c_; }
    __device__ __forceinline__ bool next(int i, Unit& u) const {
        const long L = (long)i * G + c; if (L >= nwg) return false;
        int wgid = (int)L; { const int q = nwg / NXCD, r = nwg % NXCD, xcd = wgid % NXCD, off = wgid / NXCD; wgid = (xcd < r ? xcd * (q + 1) : r * (q + 1) + (xcd - r) * q) + off; }
        const int nig = WGM * nN, gid = wgid / nig, fm = gid * WGM, gsz = (nM - fm) < WGM ? (nM - fm) : WGM;
        u.pm = fm + ((wgid % nig) % gsz); u.pn = (wgid % nig) / gsz; u.cls = 0; u.row0 = 0; u.ncls = 0; u.elo = 0; u.ehi = 0; return true;
    }
};

struct ProbDense {
    const char* A; const char* B; int lda, ldb, nt; StaticOrder S; bool skip_ctx;
    __device__ __forceinline__ bool next(int i, Unit& u) const { if (!S.next(i, u)) return false; if (skip_ctx) u.pm += 1 + (u.pm >= 64 ? 1 : 0); return true; }
    __device__ __forceinline__ void a_offs(const Unit& u, int tid, unsigned (&off)[2][2]) const {
#pragma unroll
        for (int i = 0; i < 2; ++i) { int R, C; stage_rc(tid * 16 + i * 8192, R, C);
#pragma unroll
            for (int h = 0; h < 2; ++h) off[h][i] = (unsigned)((u.pm * BM + h * HALF + R) * lda + C) * 2u; }
    }
    __device__ __forceinline__ const char* b_ptr(const Unit& u, int t) const { return B + (size_t)u.pn * BM * ldb * 2 + (size_t)t * (BK * 2); }
};
__device__ __forceinline__ void moe_unit(const LAS int* s_n, const LAS int* s_ts, int rt, Unit& u) {
    int cc = 0; while (s_ts[cc + 1] <= rt) ++cc;
    u.pm = rt; u.cls = cc; u.row0 = (rt - s_ts[cc]) * BM; u.ncls = s_n[cc];
    const int g = cc / 6, idx = cc % 6; const int a = idx < 3 ? 0 : (idx < 5 ? 1 : 2), b = idx < 3 ? idx + 1 : (idx < 5 ? idx - 1 : 3);
    u.elo = 4 * g + a; u.ehi = 4 * g + b;
}
struct ProbGU {
    const char* A; const char* B; const int* tok; const LAS int* s_n; const LAS int* s_ts; int total, G, c; static constexpr int ldb = 1024; int nt;
    __device__ __forceinline__ bool next(int i, Unit& u) const { const long L = (long)i * G + c; if (L >= total) return false; u.pn = (int)(L & 7); moe_unit(s_n, s_ts, (int)(L >> 3), u); return true; }
    __device__ __forceinline__ void a_offs(const Unit& u, int tid, unsigned (&off)[2][2]) const {
#pragma unroll
        for (int i = 0; i < 2; ++i) { int R, C; stage_rc(tid * 16 + i * 8192, R, C);
#pragma unroll
            for (int h = 0; h < 2; ++h) { int r = u.row0 + h * HALF + R; r = r < u.ncls ? r : u.ncls - 1; const int t = tok[(size_t)u.cls * CAP + r]; off[h][i] = (unsigned)t * 2048u + (unsigned)C * 2u; } }
    }
    __device__ __forceinline__ const char* b_ptr(const Unit& u, int t) const { const int e = u.pn >= 4 ? u.ehi : u.elo; return B + (size_t)e * (1024 * 1024 * 2) + (size_t)(u.pn & 3) * (BM * 1024 * 2) + (size_t)t * (BK * 2); }
};
struct ProbDown {
    const char* A; const char* B; const LAS int* s_n; const LAS int* s_ts; int total, G, c; static constexpr int ldb = 512; int nt;
    __device__ __forceinline__ bool next(int i, Unit& u) const { const long L = (long)i * G + c; if (L >= total) return false; u.pn = (int)(L & 3); moe_unit(s_n, s_ts, (int)(L >> 2), u); return true; }
    __device__ __forceinline__ void a_offs(const Unit& u, int tid, unsigned (&off)[2][2]) const {
#pragma unroll
        for (int i = 0; i < 2; ++i) { int R, C; stage_rc(tid * 16 + i * 8192, R, C);
#pragma unroll
            for (int h = 0; h < 2; ++h) off[h][i] = (unsigned)(u.pm * BM + h * HALF + R) * 2048u + (unsigned)C * 2u; }
    }
    __device__ __forceinline__ const char* b_ptr(const Unit& u, int t) const { const int e = t < 8 ? u.elo : u.ehi; return B + (size_t)e * (1024 * 512 * 2) + (size_t)u.pn * (BM * 512 * 2) + (size_t)(t & 7) * (BK * 2); }
};

template <class Epi, class Prob, bool ALIGN_EPI>
__device__ __forceinline__ void gemm_phase(LAS unsigned char* lds, LAS unsigned char* offs_lds, const Prob& P, const Epi& E) {
    int tid_ = threadIdx.x; asm volatile("" : "+v"(tid_));
    const int tid = tid_, wid = __builtin_amdgcn_readfirstlane(tid >> 6), lane = tid & 63, wr = wid >> 2, wc = wid & 3, fr = lane & 15, fq = lane >> 4;
    const int nt = P.nt;
    unsigned voffB[2];
#pragma unroll
    for (int i = 0; i < 2; ++i) { int R, C; stage_rc(tid * 16 + i * 8192, R, C); const int Rb = Epi::PERM ? ((R & ~31) + perm32(R & 31)) : R; voffB[i] = (unsigned)(Rb * P.ldb + C) * 2u; }
    LAS u32x4* const myoffs = (LAS u32x4*)offs_lds + tid;
    const size_t hstepB = (size_t)HALF * P.ldb * 2;
    const unsigned ldsw = (unsigned)wid * 1024u;
    const int aoff = lds_byte(wr * 64 + fr, fq * 8), boff = lds_byte(wc * 32 + fr, fq * 8);
    const char* const Ab = P.A;
#define PG8_SA(b, h) (((b) * 2 + (h)) * HTB)
#define PG8_SB(b, h) ((4 + (b) * 2 + (h)) * HTB)
#define PG8_STAGE_A(bufoff, h, offs, kt) do { _Pragma("unroll") for (int _i = 0; _i < 2; ++_i) \
        __builtin_amdgcn_global_load_lds((const unsigned*)(Ab + (size_t)(offs)[h][_i] + (size_t)(kt) * (BK * 2)), (LAS unsigned*)(lds + (bufoff) + ldsw + _i * 8192), 16, 0, 0); } while (0)
#define PG8_STAGE_B(bufoff, bp) do { _Pragma("unroll") for (int _i = 0; _i < 2; ++_i) \
        __builtin_amdgcn_global_load_lds((const unsigned*)((bp) + voffB[_i]), (LAS unsigned*)(lds + (bufoff) + ldsw + _i * 8192), 16, 0, 0); } while (0)
#define PG8_LDA(dst, b, h) do { _Pragma("unroll") for (int m = 0; m < 4; ++m) _Pragma("unroll") for (int k = 0; k < 2; ++k) dst[m][k] = *(const LAS bf16x8*)(lds + PG8_SA(b, h) + aoff + m * 2048 + k * 1024); } while (0)
#define PG8_LDB(dst, b, h) do { _Pragma("unroll") for (int n = 0; n < 2; ++n) _Pragma("unroll") for (int k = 0; k < 2; ++k) dst[n][k] = *(const LAS bf16x8*)(lds + PG8_SB(b, h) + boff + n * 2048 + k * 1024); } while (0)
#define PG8_MMA(ai, bj, At, Bt) do { __builtin_amdgcn_s_setprio(1); _Pragma("unroll") for (int m = 0; m < 4; ++m) _Pragma("unroll") for (int n = 0; n < 2; ++n) _Pragma("unroll") for (int k = 0; k < 2; ++k) \
        acc[ai][bj][m][n] = __builtin_amdgcn_mfma_f32_16x16x32_bf16(Bt[n][k], At[m][k], acc[ai][bj][m][n], 0, 0, 0); __builtin_amdgcn_s_setprio(0); } while (0)
#define PG8_WAIT_V(n) asm volatile("s_waitcnt vmcnt(" #n ")" ::: "memory")
#define PG8_WAIT_L(n) asm volatile("s_waitcnt lgkmcnt(" #n ")" ::: "memory")
#define PG8_BAR __builtin_amdgcn_s_barrier()
#define PG8_SCHED __builtin_amdgcn_sched_barrier(0)
    Unit cur, nxt; int ui = 0;
    if (!P.next(0, cur)) return;
    f32x4 acc[2][2][4][2];
#pragma unroll
    for (int a = 0; a < 2; ++a)
#pragma unroll
        for (int b = 0; b < 2; ++b)
#pragma unroll
            for (int m = 0; m < 4; ++m)
#pragma unroll
                for (int n = 0; n < 2; ++n) acc[a][b][m][n] = (f32x4){0.f, 0.f, 0.f, 0.f};
    bf16x8 At[4][2], B0[2][2], B1[2][2];
    unsigned offC[2][2];
    P.a_offs(cur, tid, offC);
    {
        const char* b0 = P.b_ptr(cur, 0); const char* b1 = P.b_ptr(cur, 1);
        PG8_STAGE_B(PG8_SB(0, 0), b0); PG8_STAGE_B(PG8_SB(0, 1), b0 + hstepB); PG8_STAGE_A(PG8_SA(0, 0), 0, offC, 0); PG8_STAGE_A(PG8_SA(0, 1), 1, offC, 0);
        if (wr == 1) PG8_BAR;
        PG8_WAIT_V(2); PG8_BAR;
        PG8_STAGE_B(PG8_SB(1, 0), b1); PG8_STAGE_A(PG8_SA(1, 0), 0, offC, 1); PG8_STAGE_B(PG8_SB(1, 1), b1 + hstepB);
        PG8_WAIT_V(6); PG8_BAR;
    }
    for (;;) {
        const bool has_next = P.next(ui + 1, nxt);
        if (!has_next) nxt = cur;
        {
            unsigned offN[2][2];
            if (has_next) P.a_offs(nxt, tid, offN);
            else {
#pragma unroll
                for (int h = 0; h < 2; ++h)
#pragma unroll
                    for (int i = 0; i < 2; ++i) offN[h][i] = offC[h][i];
            }
            *myoffs = (u32x4){offN[0][0], offN[0][1], offN[1][0], offN[1][1]};
        }
        for (int t = 0; t < nt; t += 2) {
            const bool last = (t == nt - 2);
            const int k2 = last ? 0 : t + 2;
            const char* b2 = last ? P.b_ptr(nxt, 0) : P.b_ptr(cur, t + 2);
            const char* b3 = last ? P.b_ptr(nxt, 1) : P.b_ptr(cur, t + 3);
            PG8_LDB(B0, 0, 0); PG8_LDB(B1, 0, 1); PG8_SCHED; PG8_LDA(At, 0, 0); PG8_STAGE_A(PG8_SA(1, 1), 1, offC, t + 1);
            if (last) { const u32x4 v = *myoffs; offC[0][0] = v.x; offC[0][1] = v.y; offC[1][0] = v.z; offC[1][1] = v.w; }
            PG8_WAIT_V(8); PG8_WAIT_L(0); PG8_BAR; PG8_MMA(0, 0, At, B0); PG8_MMA(0, 1, At, B1); PG8_BAR; PG8_SCHED;
            PG8_LDA(At, 0, 1); PG8_STAGE_B(PG8_SB(0, 0), b2); PG8_STAGE_B(PG8_SB(0, 1), b2 + hstepB); PG8_STAGE_A(PG8_SA(0, 0), 0, offC, k2);
            PG8_WAIT_V(8); PG8_WAIT_L(0); PG8_BAR; PG8_MMA(1, 0, At, B0); PG8_MMA(1, 1, At, B1); PG8_BAR; PG8_SCHED;
            PG8_LDB(B0, 1, 0); PG8_LDB(B1, 1, 1); PG8_SCHED; PG8_LDA(At, 1, 0); PG8_STAGE_A(PG8_SA(0, 1), 1, offC, k2);
            PG8_WAIT_V(8); PG8_WAIT_L(0); PG8_BAR; PG8_MMA(0, 0, At, B0); PG8_MMA(0, 1, At, B1); PG8_BAR; PG8_SCHED;
            PG8_LDA(At, 1, 1); PG8_STAGE_B(PG8_SB(1, 0), b3); PG8_STAGE_B(PG8_SB(1, 1), b3 + hstepB); PG8_STAGE_A(PG8_SA(1, 0), 0, offC, k2 + 1);
            PG8_WAIT_V(8); PG8_WAIT_L(0); PG8_BAR; PG8_MMA(1, 0, At, B0); PG8_MMA(1, 1, At, B1); PG8_BAR; PG8_SCHED;
        }
        if constexpr (ALIGN_EPI) { if (wr == 0) PG8_BAR; }
        E(acc, cur, wr, wc, fr, fq);
        if (!has_next) break;
#pragma unroll
        for (int a = 0; a < 2; ++a)
#pragma unroll
            for (int b = 0; b < 2; ++b)
#pragma unroll
                for (int m = 0; m < 4; ++m)
#pragma unroll
                    for (int n = 0; n < 2; ++n) acc[a][b][m][n] = (f32x4){0.f, 0.f, 0.f, 0.f};
        cur = nxt; ++ui;
        if constexpr (ALIGN_EPI) { if (wr == 1) PG8_BAR; }
    }
    PG8_WAIT_V(0);
    if constexpr (!ALIGN_EPI) { if (wr == 0) PG8_BAR; }
    PG8_BAR;
#undef PG8_SA
#undef PG8_SB
#undef PG8_STAGE_A
#undef PG8_STAGE_B
#undef PG8_LDA
#undef PG8_LDB
#undef PG8_MMA
#undef PG8_WAIT_V
#undef PG8_WAIT_L
#undef PG8_BAR
#undef PG8_SCHED
}
}

namespace pg8 {
struct EpiQKV {
    static constexpr bool PERM = true;
    unsigned char* ws; const float* gn; const float* rope;
    __device__ __forceinline__ void operator()(const f32x4 (&acc)[2][2][4][2], const Unit& u, int wr, int wc, int fr, int fq) const {
        const int pn = u.pn, tb_ = u.pm % 65;
        const bool is_ctx = (tb_ == 0);
        const bool isV = (pn >= 4) && (wc >= 2);
        const float* gain = gn + (pn < 2 ? 0 : (pn < 4 ? 64 : (pn == 4 ? 128 : 192)));
        const int strm = 2 * (pn - 4) + (wc & 1);
#pragma unroll
        for (int ai = 0; ai < 2; ++ai)
#pragma unroll
            for (int m = 0; m < 4; ++m) {
                int mfr = m * 16 + fr; asm volatile("" : "+v"(mfr));
                const int row = u.pm * BM + ai * HALF + wr * 64 + mfr;
                f32x4 v[2][2];
#pragma unroll
                for (int bj = 0; bj < 2; ++bj)
#pragma unroll
                    for (int n = 0; n < 2; ++n) v[bj][n] = acc[ai][bj][m][n];
                if (!isV) {
                    float ss = 0.f;
#pragma unroll
                    for (int bj = 0; bj < 2; ++bj)
#pragma unroll
                        for (int n = 0; n < 2; ++n) { const f32x4 x = v[bj][n]; ss += (x[0] * x[0] + x[1] * x[1]) + (x[2] * x[2] + x[3] * x[3]); }
                    ss += __shfl_xor(ss, 16); ss += __shfl_xor(ss, 32);
                    const float rs = ((EXPFREE && pn < 4) ? 4.0f * SQC2 : SQC2) / sqrtf(ss * (1.0f / 64.0f) + NORM_EPS);
#pragma unroll
                    for (int bj = 0; bj < 2; ++bj)
#pragma unroll
                        for (int n = 0; n < 2; ++n) v[bj][n] = v[bj][n] * rs * *(const f32x4*)(gain + 32 * bj + 16 * n + 4 * fq);
                    if (!is_ctx) {
                        const int pr = (tb_ - 1) * 4 + 2 * ai + wr, pc = mfr;
#pragma unroll
                        for (int bj = 0; bj < 2; ++bj) {
                            const int pos = bj ? pc : pr;
                            const f32x4* rp = (const f32x4*)(rope + (size_t)(pos * 16 + 4 * fq) * 2);
                            const f32x4 r0 = rp[0], r1 = rp[1];
                            const f32x4 cs = (f32x4){r0[0], r0[2], r1[0], r1[2]}, sn = (f32x4){r0[1], r0[3], r1[1], r1[3]};
                            const f32x4 x1 = v[bj][0], x2 = v[bj][1];
                            v[bj][0] = x1 * cs - x2 * sn; v[bj][1] = x2 * cs + x1 * sn;
                        }
                    }
                }
                if (pn < 4) {
                    unsigned char* rowp = ws + WS_QO + (size_t)row * 1024 + 256 * pn + 64 * wc + 4 * fq;
#pragma unroll
                    for (int bj = 0; bj < 2; ++bj)
#pragma unroll
                        for (int n = 0; n < 2; ++n) { int w = __builtin_amdgcn_cvt_pk_fp8_f32(v[bj][n][0], v[bj][n][1], 0, false); w = __builtin_amdgcn_cvt_pk_fp8_f32(v[bj][n][2], v[bj][n][3], w, true);
                            *(int*)(rowp + 32 * bj + 16 * n) = w; }
                } else {
                    unsigned char* tb = ws + WS_KV + (size_t)(u.pm * 4 + ai * 2 + wr) * KV_TILEB + (isV ? 16384 + strm * KV_VSL : strm * 4096);
                    if (!isV) {
                        const int kk = mfr; const unsigned kof = (unsigned)(kk * 64 + 4 * fq), ksw = (unsigned)((kk >> 2) & 3);
#pragma unroll
                        for (int bj = 0; bj < 2; ++bj)
#pragma unroll
                            for (int n = 0; n < 2; ++n) { int w = __builtin_amdgcn_cvt_pk_fp8_f32(v[bj][n][0], v[bj][n][1], 0, false); w = __builtin_amdgcn_cvt_pk_fp8_f32(v[bj][n][2], v[bj][n][3], w, true);
                                *(int*)(tb + (kof + (((unsigned)(2 * bj + n) ^ ksw) * 16u))) = w; }
                    } else {
#if VFP8
                        const int kk = mfr, uu = kk >> 5, w5 = kk & 31, hh = (w5 >> 2) & 1, jb = (w5 & 3) + 4 * (w5 >> 3);
                        const unsigned vof = (unsigned)(4 * fq * 64 + (((2 * hh + uu) ^ fq) * 16) + jb);
#pragma unroll
                        for (int bj = 0; bj < 2; ++bj)
#pragma unroll
                            for (int n = 0; n < 2; ++n)
#pragma unroll
                                for (int jp = 0; jp < 2; ++jp) { const int w = __builtin_amdgcn_cvt_pk_fp8_f32(v[bj][n][2 * jp], v[bj][n][2 * jp + 1], 0, false);
                                    *(unsigned char*)(tb + (vof + (unsigned)((32 * bj + 16 * n + 2 * jp) * 64))) = (unsigned char)w; *(unsigned char*)(tb + (vof + (unsigned)((32 * bj + 16 * n + 2 * jp + 1) * 64))) = (unsigned char)(w >> 8); }
#else
                        const int fr_ = mfr & 15, m_ = mfr >> 4, sub = fr_ >> 2, hb = sub & 1;
                        const unsigned vbase = (unsigned)(4 * fq * 128 + (4 * (sub >> 1) + (fr_ & 3)) * 2);
#pragma unroll
                        for (int j = 0; j < 4; ++j) { const int swz = (2 * fq + (j >> 1)) & 7;
                            const unsigned vof = vbase + (unsigned)(j * 128) + (unsigned)((((2 * m_) ^ (swz & 6)) | ((hb ^ swz) & 1)) * 16);
#pragma unroll
                            for (int bj = 0; bj < 2; ++bj)
#pragma unroll
                                for (int n = 0; n < 2; ++n) *(bf16_t*)(tb + (vof + (unsigned)((32 * bj + 16 * n) * 128))) = (bf16_t)f2bf(v[bj][n][j]); }
#endif
                    }
                }
            }
    }
};
__device__ __forceinline__ float bf_lo(unsigned w) { return __builtin_bit_cast(float, w << 16); }
__device__ __forceinline__ float bf_hi(unsigned w) { return __builtin_bit_cast(float, w & 0xffff0000u); }
struct EpiResid {
    static constexpr bool PERM = true;
    bf16_t* XS; const float* modv_l; int goff; float sgn;
    __device__ __forceinline__ void operator()(const f32x4 (&acc)[2][2][4][2], const Unit& u, int wr, int wc, int fr, int fq) const {
        const int mv = (u.pm % 65 == 0) ? 2 : (u.pm / 65);
        const float* g = modv_l + mv * 6144 + goff;
        const int col0 = u.pn * BM + wc * 32 + 8 * fq;
        f32x4 gv[2][2];
#pragma unroll
        for (int bj = 0; bj < 2; ++bj)
#pragma unroll
            for (int n = 0; n < 2; ++n) gv[bj][n] = *(const f32x4*)(g + col0 + bj * HALF + n * 4) * sgn;
#pragma unroll
        for (int ai = 0; ai < 2; ++ai)
#pragma unroll
            for (int m = 0; m < 4; ++m) {
                bf16_t* rowp = XS + (size_t)(u.pm * BM + ai * HALF + wr * 64 + m * 16 + fr) * 1024 + col0;
#pragma unroll
                for (int bj = 0; bj < 2; ++bj) { u32x4* p = (u32x4*)(rowp + bj * HALF); const u32x4 w = *p; u32x4 o;
                    const f32x4 a0 = gv[bj][0] * acc[ai][bj][m][0], a1 = gv[bj][1] * acc[ai][bj][m][1];
                    o.x = cvt_pk_bf16(bf_lo(w.x) + a0[0], bf_hi(w.x) + a0[1]); o.y = cvt_pk_bf16(bf_lo(w.y) + a0[2], bf_hi(w.y) + a0[3]);
                    o.z = cvt_pk_bf16(bf_lo(w.z) + a1[0], bf_hi(w.z) + a1[1]); o.w = cvt_pk_bf16(bf_lo(w.w) + a1[2], bf_hi(w.w) + a1[3]);
                    *p = o; }
            }
    }
};
struct EpiGU {
    static constexpr bool PERM = true;
    bf16_t* ACT; const f32x2* wts;
    __device__ __forceinline__ void operator()(const f32x4 (&acc)[2][2][4][2], const Unit& u, int wr, int wc, int fr, int fq) const {
        const int k = u.pn >= 4 ? 1 : 0, jt = u.pn & 3;
        const int colbase = 512 * k + 128 * jt + 32 * wc + 8 * fq;
#pragma unroll
        for (int ai = 0; ai < 2; ++ai)
#pragma unroll
            for (int m = 0; m < 4; ++m) {
                const int r = ai * HALF + wr * 64 + m * 16 + fr;
                int idx = u.row0 + r; idx = idx < u.ncls ? idx : u.ncls - 1;
                const f32x2 w2 = wts[(size_t)u.cls * CAP + idx];
                const float w = k ? w2[1] : w2[0];
                u32x4 o;
#pragma unroll
                for (int n = 0; n < 2; ++n) {
                    const f32x4 g = acc[ai][0][m][n], up = acc[ai][1][m][n]; float a[4];
#pragma unroll
                    for (int j = 0; j < 4; ++j) { const float sg = g[j] * __builtin_amdgcn_rcpf(1.0f + __builtin_amdgcn_exp2f(-g[j] * LOG2E)); a[j] = w * sg * up[j]; }
                    const unsigned lo = cvt_pk_bf16(a[0], a[1]), hi = cvt_pk_bf16(a[2], a[3]);
                    if (n == 0) { o.x = lo; o.y = hi; } else { o.z = lo; o.w = hi; }
                }
                *(u32x4*)(ACT + (size_t)(u.pm * BM + r) * 1024 + colbase) = o;
            }
    }
};
struct EpiDown {
    static constexpr bool PERM = true;
    bf16_t* XS; float* out; const int* tok; const float* modv_l; float sgn;
    __device__ __forceinline__ void operator()(const f32x4 (&acc)[2][2][4][2], const Unit& u, int wr, int wc, int fr, int fq) const {
        const int col0 = u.pn * BM + wc * 32 + 8 * fq;
#pragma unroll
        for (int ai = 0; ai < 2; ++ai)
#pragma unroll
            for (int m = 0; m < 4; ++m) {
                const int idx = u.row0 + ai * HALF + wr * 64 + m * 16 + fr;
                if (idx < u.ncls) {
                    const int t = tok[(size_t)u.cls * CAP + idx];
                    const int b = t >= RB ? 1 : 0, rr = t - b * RB;
                    const int mv = rr < NCTX ? 2 : b;
                    const float* g = modv_l + mv * 6144 + 5120 + col0;
                    bf16_t* xp = XS + (size_t)t * 1024 + col0;
                    float* op = out + (size_t)(b * SEQ + rr - NCTX) * 1024 + col0;
#pragma unroll
                    for (int bj = 0; bj < 2; ++bj) { const u32x4 w = *(const u32x4*)(xp + bj * HALF);
                        const f32x4 a0 = (*(const f32x4*)(g + bj * HALF) * sgn) * acc[ai][bj][m][0], a1 = (*(const f32x4*)(g + bj * HALF + 4) * sgn) * acc[ai][bj][m][1];
                        const f32x4 x0 = (f32x4){bf_lo(w.x) + a0[0], bf_hi(w.x) + a0[1], bf_lo(w.y) + a0[2], bf_hi(w.y) + a0[3]}, x1 = (f32x4){bf_lo(w.z) + a1[0], bf_hi(w.z) + a1[1], bf_lo(w.w) + a1[2], bf_hi(w.w) + a1[3]};
                        if (out) { *(f32x4*)(op + bj * HALF) = x0; *(f32x4*)(op + bj * HALF + 4) = x1; }
                        else { u32x4 o; o.x = cvt_pk_bf16(x0[0], x0[1]); o.y = cvt_pk_bf16(x0[2], x0[3]); o.z = cvt_pk_bf16(x1[0], x1[1]); o.w = cvt_pk_bf16(x1[2], x1[3]); *(u32x4*)(xp + bj * HALF) = o; }
                    }
                }
            }
    }
};
}

namespace attn_body {
using bf16 = __hip_bfloat16;
using s16x4 = __attribute__((ext_vector_type(4))) short;
using f32x16 = __attribute__((ext_vector_type(16))) float;
constexpr int D = 64, QP = 1024, KP = 512;
constexpr int NW = 8, QBLK = 32, QB = QBLK * NW, KVBLK = 64;
__device__ __forceinline__ int crow(int r, int hi) { return (r & 3) + 8 * (r >> 2) + 4 * hi; }
#define SBAR() __builtin_amdgcn_sched_barrier(0)
constexpr int NSLOT = 3, SLOTB = 8192;
constexpr int LDS_K = 0, LDS_V = NSLOT * SLOTB, LDS_WS = 2 * NSLOT * SLOTB, LDS_OST = LDS_WS + NW * 64 * 4, LDS_BYTES = LDS_OST + NW * 4096;
__device__ __forceinline__ void glds16(const void* gsrc, unsigned lds_dst) { unsigned keep;
  asm volatile("s_mov_b32 %0, m0\n\ts_mov_b32 m0, %2\n\ts_nop 0\n\tglobal_load_lds_dwordx4 %1, off\n\ts_mov_b32 m0, %0" : "=&s"(keep) : "v"(gsrc), "s"(lds_dst) : "memory"); }
__device__ __forceinline__ float max3f(float a, float b, float c) { float r; asm("v_max3_f32 %0, %1, %2, %3" : "=v"(r) : "v"(a), "v"(b), "v"(c)); return r; }
__device__ __forceinline__ float max2f(float a, float b) { float r; asm("v_max_f32_e32 %0, %1, %2" : "=v"(r) : "v"(a), "v"(b)); return r; }
__device__ __forceinline__ float fadd_s(float a, float b) { float r; asm("v_add_f32_e32 %0, %1, %2" : "=v"(r) : "v"(a), "v"(b)); return r; }
__device__ __forceinline__ float fsub_s(float a, float b) { float r; asm("v_sub_f32_e32 %0, %1, %2" : "=v"(r) : "v"(a), "v"(b)); return r; }
typedef float f32x2_t __attribute__((ext_vector_type(2))); typedef __bf16 bf16x2_t __attribute__((ext_vector_type(2)));
__device__ __forceinline__ unsigned cvtpk_s(float lo, float hi) { f32x2_t v = {lo, hi}; bf16x2_t b = __builtin_convertvector(v, bf16x2_t); return __builtin_bit_cast(unsigned, b); }
#define WAIT_BAR(N) asm volatile("s_waitcnt vmcnt(" #N ") lgkmcnt(0)\n\ts_barrier" ::: "memory")

__device__ __forceinline__ void qkt(f32x16& p0, f32x16& p1, const char* Kslot, const bf16x8* qr, const f32x16& negm, int r32, int hi) {
  const char* kb = Kslot + hi * 1024 + r32 * 16;
  #pragma unroll
  for (int d0 = 0; d0 < 4; ++d0) {
    const bf16x8 b0 = *reinterpret_cast<const bf16x8*>(kb + d0 * 2048);
    const bf16x8 b1 = *reinterpret_cast<const bf16x8*>(kb + d0 * 2048 + 512);
    if (d0 == 0) { p0 = __builtin_amdgcn_mfma_f32_32x32x16_bf16(b0, qr[0], negm, 0, 0, 0); p1 = __builtin_amdgcn_mfma_f32_32x32x16_bf16(b1, qr[0], negm, 0, 0, 0); }
    else { p0 = __builtin_amdgcn_mfma_f32_32x32x16_bf16(b0, qr[d0], p0, 0, 0, 0); p1 = __builtin_amdgcn_mfma_f32_32x32x16_bf16(b1, qr[d0], p1, 0, 0, 0); } }
}
typedef __attribute__((address_space(3))) const char* lds_cptr;
typedef short v4i16_t __attribute__((ext_vector_type(4)));
__device__ __forceinline__ void kload8(bf16x8* kf, lds_cptr kp) {
  kf[0] = *(const LAS bf16x8*)(kp);        kf[1] = *(const LAS bf16x8*)(kp + 512);
  kf[2] = *(const LAS bf16x8*)(kp + 2048); kf[3] = *(const LAS bf16x8*)(kp + 2560);
  kf[4] = *(const LAS bf16x8*)(kp + 4096); kf[5] = *(const LAS bf16x8*)(kp + 4608);
  kf[6] = *(const LAS bf16x8*)(kp + 6144); kf[7] = *(const LAS bf16x8*)(kp + 6656);
}
__device__ __forceinline__ void kload2(bf16x8* kf, lds_cptr kp, int j) { kf[2 * j] = *(const LAS bf16x8*)(kp + j * 2048); kf[2 * j + 1] = *(const LAS bf16x8*)(kp + j * 2048 + 512); }
__device__ __forceinline__ s16x4 vtr(lds_cptr p) { return __builtin_bit_cast(s16x4, __builtin_amdgcn_ds_read_tr16_b64_v4i16((LAS v4i16_t*)p)); }
__device__ __forceinline__ float rowmax(const f32x16& p0, const f32x16& p1) {
  float a = max3f(p0[0], p0[1], p1[0]), b = max3f(p0[2], p0[3], p1[1]); a = max3f(a, p1[2], p1[3]);
  #pragma unroll
  for (int r = 4; r < 16; r += 4) { a = max3f(a, p0[r], p0[r + 1]); b = max3f(b, p0[r + 2], p0[r + 3]); a = max3f(a, p1[r], p1[r + 1]); b = max3f(b, p1[r + 2], p1[r + 3]); }
  const float m = max2f(a, b);
  auto rr = __builtin_amdgcn_permlane32_swap(__float_as_uint(m), __float_as_uint(m), false, false);
  return max2f(__uint_as_float(rr[0]), __uint_as_float(rr[1]));
}
__device__ __forceinline__ void pv(f32x16* o, int vb, bf16x8 pa0, bf16x8 pa1, bf16x8 pa2, bf16x8 pa3) {
  #pragma unroll
  for (int d0 = 0; d0 < 2; ++d0) { s16x4 lo[4], hi[4];
    #pragma unroll
    for (int ks = 0; ks < 4; ++ks) {
      asm volatile("ds_read_b64_tr_b16 %0,%1 offset:%c2" : "=&v"(lo[ks]) : "v"(vb), "i"(d0 * 4096 + ks * 1024) : "memory");
      asm volatile("ds_read_b64_tr_b16 %0,%1 offset:%c2" : "=&v"(hi[ks]) : "v"(vb), "i"(d0 * 4096 + ks * 1024 + 512) : "memory"); }
    asm volatile("s_waitcnt lgkmcnt(0)" ::: "memory"); SBAR();
    #define PK(k) (bf16x8){lo[k][0], lo[k][1], lo[k][2], lo[k][3], hi[k][0], hi[k][1], hi[k][2], hi[k][3]}
    o[d0] = __builtin_amdgcn_mfma_f32_32x32x16_bf16(pa0, PK(0), o[d0], 0, 0, 0);
    o[d0] = __builtin_amdgcn_mfma_f32_32x32x16_bf16(pa1, PK(1), o[d0], 0, 0, 0);
    o[d0] = __builtin_amdgcn_mfma_f32_32x32x16_bf16(pa2, PK(2), o[d0], 0, 0, 0);
    o[d0] = __builtin_amdgcn_mfma_f32_32x32x16_bf16(pa3, PK(3), o[d0], 0, 0, 0);
    #undef PK
  }
}
__device__ __forceinline__ void pv2(f32x16* o, const lds_cptr* vq, int slot, bf16x8 pa0, bf16x8 pa1, bf16x8 pa2, bf16x8 pa3) {
  #pragma unroll
  for (int d0 = 0; d0 < 2; ++d0) {
    const bf16x8 v0 = *(const LAS bf16x8*)(vq[0] + slot + d0 * 4096), v1 = *(const LAS bf16x8*)(vq[1] + slot + d0 * 4096), v2 = *(const LAS bf16x8*)(vq[2] + slot + d0 * 4096), v3 = *(const LAS bf16x8*)(vq[3] + slot + d0 * 4096);
    o[d0] = __builtin_amdgcn_mfma_f32_32x32x16_bf16(pa0, v0, o[d0], 0, 0, 0);
    o[d0] = __builtin_amdgcn_mfma_f32_32x32x16_bf16(pa1, v1, o[d0], 0, 0, 0);
    o[d0] = __builtin_amdgcn_mfma_f32_32x32x16_bf16(pa2, v2, o[d0], 0, 0, 0);
    o[d0] = __builtin_amdgcn_mfma_f32_32x32x16_bf16(pa3, v3, o[d0], 0, 0, 0);
  }
}
__device__ __forceinline__ void bandmask(f32x16& p0, f32x16& p1, int t, int mlo, unsigned mspan, int qrel, int hi) {
  const float NEG = -INFINITY; const int kb = 64 * (t - 4) - 128 + 4 * hi - qrel - mlo;
  #pragma unroll
  for (int r = 0; r < 16; ++r) { const int d0 = kb + (r & 3) + 8 * (r >> 2); if ((unsigned)d0 > mspan) p0[r] = NEG; if ((unsigned)(d0 + 32) > mspan) p1[r] = NEG; }
}
#ifndef FASTEXP
#define FASTEXP 0
#endif
__device__ __forceinline__ float exp2_fast(float x) { const float t = __builtin_fmaf(x, 8388608.0f, 1064986823.0f); unsigned u; asm("v_cvt_u32_f32 %0, %1" : "=v"(u) : "v"(t)); return __builtin_bit_cast(float, u); }
#define ATTN_STORE16(p, v) (*(u32x4*)(p) = (v))

template <int MODE, int THRL> __device__ __forceinline__ void attn_unit(long qrow, long kvrow, int q0, int qcol, int kcol, int vcol, int NT, float sink2, const bf16* Q, const bf16* __restrict__ KVb, bf16* O, char* shm) {
  int tid_ = threadIdx.x; asm volatile("" : "+v"(tid_));
  const int tid = tid_, lane = tid & 63, r32 = lane & 31, hi = lane >> 5; const int wid = __builtin_amdgcn_readfirstlane(tid >> 6);
  const bf16* Qw = Q + (qrow + wid * QBLK) * QP + qcol;
  const char* kvt = (const char*)KVb + (size_t)(kvrow >> 6) * 65536 + wid * 1024 + lane * 16;
  const unsigned lds0 = (unsigned)(uintptr_t)shm;
  float* wsf = (float*)(shm + LDS_WS) + wid * 64;
  const char* ksrc = kvt + kcol * 8192; const char* vsrc = kvt + vcol * 8192;
  const unsigned kdst = lds0 + LDS_K + wid * 1024, vdst = lds0 + LDS_V + wid * 1024;
  #define ROWOFF(t) ((long)(MODE == 1 ? ((t) + ((t) >= 4 ? ((q0 - 128) >> 6) : 0)) : (t)) * 65536)
  #define DMA_K(t, slot) glds16(ksrc + ROWOFF(t), (unsigned)__builtin_amdgcn_readfirstlane(kdst + (slot)))
  #define DMA_V(t, slot) glds16(vsrc + ROWOFF(t), (unsigned)__builtin_amdgcn_readfirstlane(vdst + (slot)))
  const char* Kbase = shm + LDS_K; bf16x8 kf[8];
  const lds_cptr shm3 = (lds_cptr)shm; const lds_cptr kp0 = shm3 + LDS_K + hi * 1024 + r32 * 16; lds_cptr vq[4];
  { const int swz = (r32 >> 1) & 7; _Pragma("unroll") for (int ks_ = 0; ks_ < 4; ++ks_) vq[ks_] = shm3 + LDS_V + r32 * 128 + (((2 * ks_ + hi) ^ swz) * 16); }
  DMA_K(0, 0); DMA_V(0, 0); DMA_K(1, SLOTB);
  bf16x8 qr[4];
  #pragma unroll
  for (int d0 = 0; d0 < 4; ++d0) qr[d0] = *reinterpret_cast<const bf16x8*>(&Qw[(long)r32 * QP + d0 * 16 + hi * 8]);
  float mhat = 0.f, l_reg = 0.f; f32x16 o[2]; o[0] = f32x16{}; o[1] = f32x16{}; f32x16 negm = f32x16{}; asm volatile("" : "+v"(negm));
  const int qrel = wid * QBLK + r32;
  int mlo = -128, mhi = 128;
  if (MODE == 1) { const int qi = q0 + qrel; mlo = (-qi > -128) ? -qi : -128; mhi = (SEQ - 1 - qi < 128) ? (SEQ - 1 - qi) : 128; }
  const unsigned mspan = (unsigned)(mhi - mlo);
  #define CMASK(P0, P1, t) do { if (MODE == 1) { if ((t) >= 4) bandmask(P0, P1, (t), mlo, mspan, qrel, hi); } } while (0)
  bool resc = false;
  #define START(P0, P1) do { const float rm = rowmax(P0, P1); resc = false; \
    { const float dl = rm; mhat = fadd_s(mhat, dl); \
      _Pragma("unroll") for (int r = 0; r < 16; ++r) { P0[r] = fsub_s(P0[r], dl); P1[r] = fsub_s(P1[r], dl); } \
      _Pragma("unroll") for (int r = 0; r < 16; ++r) negm[r] = -mhat; asm volatile("" : "+v"(negm)); } \
    _Pragma("unroll") for (int r = 0; r < 16; ++r) P0[r] = __builtin_amdgcn_exp2f(P0[r]); } while (0)
  #define RESC() do { if (resc) { asm volatile("s_waitcnt lgkmcnt(0)" ::: "memory"); \
      _Pragma("unroll") for (int d_ = 0; d_ < 2; ++d_) _Pragma("unroll") for (int r = 0; r < 16; ++r) o[d_][r] *= wsf[crow(r, hi)]; } } while (0)
  f32x16 pA0, pA1, pB0, pB1;
  int sl_prev = 0, sl_cur = 0, sl_next = SLOTB;
  #define ROT() do { sl_prev = sl_cur; sl_cur = sl_next; sl_next = (sl_next == (NSLOT - 1) * SLOTB) ? 0 : sl_next + SLOTB; } while (0)
  DMA_K(2, 2 * SLOTB);
  WAIT_BAR(3);
  qkt(pA0, pA1, Kbase, qr, negm, r32, hi); asm volatile("s_nop 15\n\ts_nop 7" : "+v"(pA0), "+v"(pA1)); CMASK(pA0, pA1, 0);
  START(pA0, pA1);
  _Pragma("unroll") for (int r = 0; r < 16; ++r) pA1[r] = __builtin_amdgcn_exp2f(pA1[r]);
  WAIT_BAR(0);
  DMA_K(3, 0); DMA_V(1, SLOTB);
  ROT();
  kload8(kf, kp0 + sl_cur);
  WAIT_BAR(2);
  bf16x8 vfr[8]; u32x4 pw0, pw1, pw2, pw3;
  #define PKW(P, B) cvtpk_s(P[B], P[B + 1])
  #define PAF(k) __builtin_bit_cast(bf16x8, pw##k)
  #define VFR(i) vfr[i]
  #define PIN(x) asm volatile("" : "+v"(x))
  #define MX3(a, b, c) __builtin_fmaxf(__builtin_fmaxf((a), (b)), (c))
  #define GAPA(MF, A0, A1, A2, A3, W0, W1, PW) do { MF; sacc += A0; sacc += A1; sacc += A2; sacc += A3; PIN(sacc); W0; W1; PIN(PW); SBAR(); } while (0)
  #define EX(v) __builtin_amdgcn_exp2f(v)
  #define GAPB(MF, X, B) do { MF; X[B] = EX(X[B]); X[B + 1] = EX(X[B + 1]); X[B + 2] = EX(X[B + 2]); X[B + 3] = EX(X[B + 3]); PIN(X); SBAR(); } while (0)
  #define VRD(i) do { vfr[i] = *(const LAS bf16x8*)(vq[(i) & 3] + vsl_ + ((i) >> 2) * 4096); } while (0)
  #define KRD(G, j) do { if (G) { kload2(kf, kp0 + sl_next, j); SBAR(); } } while (0)
  #define STEP(C0, C1, P0, P1, t, GK, GV, GL) do { SBAR(); \
    const int vsl_ = sl_prev; \
    VRD(0); SBAR(); float sacc = (P0[0] + P0[1]); \
    GAPA(C0 = __builtin_amdgcn_mfma_f32_32x32x16_bf16(kf[0], qr[0], negm, 0, 0, 0), P0[2], P0[3], P0[4], P0[5],     pw0[0] = PKW(P0, 0), pw0[1] = PKW(P0, 2), pw0); \
    VRD(4); SBAR(); GAPA(C1 = __builtin_amdgcn_mfma_f32_32x32x16_bf16(kf[1], qr[0], negm, 0, 0, 0), P0[6], P0[7], P0[8], P0[9],     pw0[2] = PKW(P0, 4), pw0[3] = PKW(P0, 6), pw0); \
    VRD(1); SBAR(); GAPA(C0 = __builtin_amdgcn_mfma_f32_32x32x16_bf16(kf[2], qr[1], C0, 0, 0, 0),   P0[10], P0[11], P0[12], P0[13], pw1[0] = PKW(P0, 8), pw1[1] = PKW(P0, 10), pw1); \
    VRD(5); SBAR(); GAPA(C1 = __builtin_amdgcn_mfma_f32_32x32x16_bf16(kf[3], qr[1], C1, 0, 0, 0),   P0[14], P0[15], P1[0], P1[1],   pw1[2] = PKW(P0, 12), pw1[3] = PKW(P0, 14), pw1); \
    VRD(2); SBAR(); GAPA(C0 = __builtin_amdgcn_mfma_f32_32x32x16_bf16(kf[4], qr[2], C0, 0, 0, 0),   P1[2], P1[3], P1[4], P1[5],     pw2[0] = PKW(P1, 0), pw2[1] = PKW(P1, 2), pw2); \
    VRD(6); SBAR(); GAPA(C1 = __builtin_amdgcn_mfma_f32_32x32x16_bf16(kf[5], qr[2], C1, 0, 0, 0),   P1[6], P1[7], P1[8], P1[9],     pw2[2] = PKW(P1, 4), pw2[3] = PKW(P1, 6), pw2); \
    VRD(3); SBAR(); GAPA(C0 = __builtin_amdgcn_mfma_f32_32x32x16_bf16(kf[6], qr[3], C0, 0, 0, 0),   P1[10], P1[11], P1[12], P1[13], pw3[0] = PKW(P1, 8), pw3[1] = PKW(P1, 10), pw3); \
    VRD(7); SBAR(); GAPA(C1 = __builtin_amdgcn_mfma_f32_32x32x16_bf16(kf[7], qr[3], C1, 0, 0, 0),   P1[14], P1[15], 0.f, 0.f,       pw3[2] = PKW(P1, 12), pw3[3] = PKW(P1, 14), pw3); \
    l_reg += sacc; \
    if (GK) { DMA_K((t) + 3, sl_cur); } if (GV) { DMA_V((t) + 1, sl_next); } \
    CMASK(C0, C1, t); \
    { float a = MX3(C0[0], C0[1], C1[0]), b = MX3(C0[2], C0[3], C1[1]); a = MX3(a, C1[2], C1[3]); \
      _Pragma("unroll") for (int r = 4; r < 16; r += 4) { a = MX3(a, C0[r], C0[r + 1]); b = MX3(b, C0[r + 2], C0[r + 3]); a = MX3(a, C1[r], C1[r + 1]); b = MX3(b, C1[r + 2], C1[r + 3]); } \
      float rm = __builtin_fmaxf(a, b); { auto rr = __builtin_amdgcn_permlane32_swap(__float_as_uint(rm), __float_as_uint(rm), false, false); rm = __builtin_fmaxf(__uint_as_float(rr[0]), __uint_as_float(rr[1])); } \
      resc = false; \
      if (__builtin_expect(__any(rm > (float)THRL), 0)) { const float dl = __builtin_fmaxf(rm, 0.f); mhat += dl; \
        _Pragma("unroll") for (int r = 0; r < 16; ++r) { C0[r] -= dl; C1[r] -= dl; } \
        _Pragma("unroll") for (int r = 0; r < 16; ++r) negm[r] = -mhat; asm volatile("" : "+v"(negm)); \
        const float f = __builtin_amdgcn_exp2f(-dl); l_reg *= f; if (hi == 0) wsf[r32] = f; resc = true; } } \
    SBAR(); \
    GAPB(o[0] = __builtin_amdgcn_mfma_f32_32x32x16_bf16(PAF(0), VFR(0), o[0], 0, 0, 0), C0, 0); \
    GAPB(o[1] = __builtin_amdgcn_mfma_f32_32x32x16_bf16(PAF(0), VFR(4), o[1], 0, 0, 0), C0, 4); \
    KRD(GL, 0); GAPB(o[0] = __builtin_amdgcn_mfma_f32_32x32x16_bf16(PAF(1), VFR(1), o[0], 0, 0, 0), C0, 8); \
    KRD(GL, 1); GAPB(o[1] = __builtin_amdgcn_mfma_f32_32x32x16_bf16(PAF(1), VFR(5), o[1], 0, 0, 0), C0, 12); \
    KRD(GL, 2); GAPB(o[0] = __builtin_amdgcn_mfma_f32_32x32x16_bf16(PAF(2), VFR(2), o[0], 0, 0, 0), C1, 0); \
    KRD(GL, 3); GAPB(o[1] = __builtin_amdgcn_mfma_f32_32x32x16_bf16(PAF(2), VFR(6), o[1], 0, 0, 0), C1, 4); \
    GAPB(o[0] = __builtin_amdgcn_mfma_f32_32x32x16_bf16(PAF(3), VFR(3), o[0], 0, 0, 0), C1, 8); \
    GAPB(o[1] = __builtin_amdgcn_mfma_f32_32x32x16_bf16(PAF(3), VFR(7), o[1], 0, 0, 0), C1, 12); \
    } while (0)
  int t = 1;
  for (; t + 5 < NT; t += 2) {
    STEP(pB0, pB1, pA0, pA1, t, true, true, true);     WAIT_BAR(2); RESC(); ROT();
    STEP(pA0, pA1, pB0, pB1, t + 1, true, true, true);   WAIT_BAR(2); RESC(); ROT();
  }
  #define ENDW(tt) do { if ((tt) + 3 < NT) { WAIT_BAR(2); } else if ((tt) + 2 < NT) { WAIT_BAR(1); } else { WAIT_BAR(0); } } while (0)
  for (; t + 1 < NT; t += 2) {
    STEP(pB0, pB1, pA0, pA1, t, (t + 3 < NT), (t + 1 < NT), (t + 1 < NT));       ENDW(t);   RESC(); ROT();
    STEP(pA0, pA1, pB0, pB1, t + 1, (t + 4 < NT), (t + 2 < NT), (t + 2 < NT));     ENDW(t + 1); RESC(); ROT();
  }
  STEP(pB0, pB1, pA0, pA1, NT - 1, false, false, false); RESC();
  { float sacc = pB0[0] + pB0[1]; _Pragma("unroll") for (int r = 2; r < 16; ++r) sacc += pB0[r]; _Pragma("unroll") for (int r = 0; r < 16; ++r) sacc += pB1[r]; l_reg += sacc;
    pw0 = (u32x4){PKW(pB0, 0), PKW(pB0, 2), PKW(pB0, 4), PKW(pB0, 6)}; pw1 = (u32x4){PKW(pB0, 8), PKW(pB0, 10), PKW(pB0, 12), PKW(pB0, 14)}; pw2 = (u32x4){PKW(pB1, 0), PKW(pB1, 2), PKW(pB1, 4), PKW(pB1, 6)}; pw3 = (u32x4){PKW(pB1, 8), PKW(pB1, 10), PKW(pB1, 12), PKW(pB1, 14)};
    SBAR(); pv2(o, vq, sl_cur, PAF(0), PAF(1), PAF(2), PAF(3)); }
  #undef PKW
  #undef PAF
  #undef VFR
  #undef PIN
  #undef MX3
  #undef GAPA
  #undef GAPB
  #undef EX
  #undef VRD
  #undef KRD
  #undef STEP
  #undef ENDW
  { auto rr = __builtin_amdgcn_permlane32_swap(__float_as_uint(l_reg), __float_as_uint(l_reg), false, false); l_reg = __uint_as_float(rr[0]) + __uint_as_float(rr[1]); }
  l_reg += __builtin_amdgcn_exp2f(sink2 - mhat);
  if (hi == 0) wsf[32 + r32] = l_reg; asm volatile("s_waitcnt lgkmcnt(0)" ::: "memory");
  float rli[16];
  #pragma unroll
  for (int r = 0; r < 16; ++r) rli[r] = __builtin_amdgcn_rcpf(wsf[32 + crow(r, hi)]);
  bf16* Ow = O + (qrow + wid * QBLK) * QP + qcol;
  { bf16* stg = (bf16*)(shm + LDS_OST) + wid * 2048;
    #pragma unroll
    for (int r = 0; r < 16; ++r) { const int orow = crow(r, hi);
      #pragma unroll
      for (int d0 = 0; d0 < 2; ++d0) stg[orow * 64 + d0 * 32 + r32] = __float2bfloat16(o[d0][r] * rli[r]); }
    asm volatile("s_waitcnt lgkmcnt(0)" ::: "memory");
    #pragma unroll
    for (int i = 0; i < 4; ++i) { const int row = i * 8 + (lane >> 3), ch = lane & 7; const u32x4 v = *(const u32x4*)(stg + row * 64 + ch * 8); ATTN_STORE16(Ow + (long)row * QP + ch * 8, v); } }
  asm volatile("s_waitcnt lgkmcnt(0)\n\ts_barrier" ::: "memory");
  #undef DMA_K
  #undef DMA_V
  #undef ROWOFF
  #undef CMASK
  #undef START
  #undef RESC
  #undef ROT
}
template <int MODE, int XV = 0> __device__ __forceinline__ void attn_unit_sb(long qrow, long kvrow, int q0, int qcol, int kcol, int vcol, int NT, float sink2, float bound, const bf16* Q, const bf16* __restrict__ KVb, bf16* O, char* shm) {
  int tid_ = threadIdx.x; asm volatile("" : "+v"(tid_));
  const int tid = tid_, lane = tid & 63, r32 = lane & 31, hi = lane >> 5; const int wid = __builtin_amdgcn_readfirstlane(tid >> 6);
  const bf16* Qw = Q + (qrow + wid * QBLK) * QP + qcol;
  const char* kvt = (const char*)KVb + (size_t)(kvrow >> 6) * 65536 + wid * 1024 + lane * 16;
  const unsigned lds0 = (unsigned)(uintptr_t)shm;
  const char* ksrc = kvt + kcol * 8192; const char* vsrc = kvt + vcol * 8192;
  const unsigned kdst = lds0 + LDS_K + wid * 1024, vdst = lds0 + LDS_V + wid * 1024;
  #define ROWOFF(t) ((long)(MODE == 1 ? ((t) + ((t) >= 4 ? ((q0 - 128) >> 6) : 0)) : (t)) * 65536)
  #define DMA_K(t, slot) glds16(ksrc + ROWOFF(t), (unsigned)__builtin_amdgcn_readfirstlane(kdst + (slot)))
  #define DMA_V(t, slot) glds16(vsrc + ROWOFF(t), (unsigned)__builtin_amdgcn_readfirstlane(vdst + (slot)))
  const char* Kbase = shm + LDS_K; bf16x8 kf[8];
  const lds_cptr shm3 = (lds_cptr)shm; const lds_cptr kp0 = shm3 + LDS_K + hi * 1024 + r32 * 16; lds_cptr vq[4];
  { const int swz = (r32 >> 1) & 7; _Pragma("unroll") for (int ks_ = 0; ks_ < 4; ++ks_) vq[ks_] = shm3 + LDS_V + r32 * 128 + (((2 * ks_ + hi) ^ swz) * 16); }
  DMA_K(0, 0); DMA_V(0, 0); DMA_K(1, SLOTB);
  bf16x8 qr[4];
  #pragma unroll
  for (int d0 = 0; d0 < 4; ++d0) qr[d0] = *reinterpret_cast<const bf16x8*>(&Qw[(long)r32 * QP + d0 * 16 + hi * 8]);
  f32x16 o[2]; o[0] = f32x16{}; o[1] = f32x16{}; f32x16 osum = f32x16{};
  const f32x16 negm = f32x16{};
  bf16x8 ones;
  #pragma unroll
  for (int i = 0; i < 8; ++i) ones[i] = (short)0x3F80;
  asm volatile("" : "+v"(ones));
  const int qrel = wid * QBLK + r32;
  int mlo = -128, mhi = 128;
  if (MODE == 1) { const int qi = q0 + qrel; mlo = (-qi > -128) ? -qi : -128; mhi = (SEQ - 1 - qi < 128) ? (SEQ - 1 - qi) : 128; }
  const unsigned mspan = (unsigned)(mhi - mlo);
  #define CMASK(P0, P1, t) do { if (MODE == 1) { if ((t) >= 4) bandmask(P0, P1, (t), mlo, mspan, qrel, hi); } } while (0)
  f32x16 pA0, pA1, pB0, pB1;
  int sl_prev = 0, sl_cur = 0, sl_next = SLOTB;
  #define ROT() do { sl_prev = sl_cur; sl_cur = sl_next; sl_next = (sl_next == (NSLOT - 1) * SLOTB) ? 0 : sl_next + SLOTB; } while (0)
  DMA_K(2, 2 * SLOTB);
  WAIT_BAR(3);
  qkt(pA0, pA1, Kbase, qr, negm, r32, hi); asm volatile("s_nop 15\n\ts_nop 7" : "+v"(pA0), "+v"(pA1)); CMASK(pA0, pA1, 0);
  _Pragma("unroll") for (int r = 0; r < 16; ++r) { pA0[r] = __builtin_amdgcn_exp2f(pA0[r]); pA1[r] = __builtin_amdgcn_exp2f(pA1[r]); }
  WAIT_BAR(0);
  DMA_K(3, 0); DMA_V(1, SLOTB);
  ROT();
  kload8(kf, kp0 + sl_cur);
  WAIT_BAR(2);
  bf16x8 vfr[8]; u32x4 pw0, pw1, pw2, pw3;
  #define PKW(P, B) cvtpk_s(P[B], P[B + 1])
  #define PAF(k) __builtin_bit_cast(bf16x8, pw##k)
  #define VFR(i) vfr[i]
  #define PIN(x) asm volatile("" : "+v"(x))
  #define GAPA(MF, W0, W1, PW) do { MF; W0; W1; PIN(PW); SBAR(); } while (0)
  #define OSUM(k) do { if (XV != 5) osum = __builtin_amdgcn_mfma_f32_32x32x16_bf16(PAF(k), ones, osum, 0, 0, 0); SBAR(); } while (0)
  #define EX(v) (XV == 2 ? (v) : (FASTEXP ? exp2_fast(v) : __builtin_amdgcn_exp2f(v)))
  #define GAPB(MF, X, B) do { MF; X[B] = EX(X[B]); X[B + 1] = EX(X[B + 1]); X[B + 2] = EX(X[B + 2]); X[B + 3] = EX(X[B + 3]); PIN(X); SBAR(); } while (0)
  #define VRD(i) do { if (XV == 3) break; vfr[i] = *(const LAS bf16x8*)(vq[(i) & 3] + vsl_ + ((i) >> 2) * 4096); } while (0)
  #define KRD(G, j) do { if ((G) && XV != 3) { kload2(kf, kp0 + sl_next, j); SBAR(); } } while (0)
  #define STEP(C0, C1, P0, P1, t, GK, GV, GL) do { SBAR(); \
    const int vsl_ = sl_prev; \
    VRD(0); SBAR(); GAPA(C0 = __builtin_amdgcn_mfma_f32_32x32x16_bf16(kf[0], qr[0], negm, 0, 0, 0), pw0[0] = PKW(P0, 0), pw0[1] = PKW(P0, 2), pw0); \
    VRD(4); SBAR(); GAPA(C1 = __builtin_amdgcn_mfma_f32_32x32x16_bf16(kf[1], qr[0], negm, 0, 0, 0), pw0[2] = PKW(P0, 4), pw0[3] = PKW(P0, 6), pw0); \
    VRD(1); SBAR(); GAPA(C0 = __builtin_amdgcn_mfma_f32_32x32x16_bf16(kf[2], qr[1], C0, 0, 0, 0),   pw1[0] = PKW(P0, 8), pw1[1] = PKW(P0, 10), pw1); \
    OSUM(0); \
    VRD(5); SBAR(); GAPA(C1 = __builtin_amdgcn_mfma_f32_32x32x16_bf16(kf[3], qr[1], C1, 0, 0, 0),   pw1[2] = PKW(P0, 12), pw1[3] = PKW(P0, 14), pw1); \
    VRD(2); SBAR(); GAPA(C0 = __builtin_amdgcn_mfma_f32_32x32x16_bf16(kf[4], qr[2], C0, 0, 0, 0),   pw2[0] = PKW(P1, 0), pw2[1] = PKW(P1, 2), pw2); \
    OSUM(1); \
    VRD(6); SBAR(); GAPA(C1 = __builtin_amdgcn_mfma_f32_32x32x16_bf16(kf[5], qr[2], C1, 0, 0, 0),   pw2[2] = PKW(P1, 4), pw2[3] = PKW(P1, 6), pw2); \
    VRD(3); SBAR(); GAPA(C0 = __builtin_amdgcn_mfma_f32_32x32x16_bf16(kf[6], qr[3], C0, 0, 0, 0),   pw3[0] = PKW(P1, 8), pw3[1] = PKW(P1, 10), pw3); \
    OSUM(2); \
    VRD(7); SBAR(); GAPA(C1 = __builtin_amdgcn_mfma_f32_32x32x16_bf16(kf[7], qr[3], C1, 0, 0, 0),   pw3[2] = PKW(P1, 12), pw3[3] = PKW(P1, 14), pw3); \
    if (XV != 1) { if (GK) { DMA_K((t) + 3, sl_cur); } if (GV) { DMA_V((t) + 1, sl_next); } } \
    OSUM(3); \
    CMASK(C0, C1, t); \
    SBAR(); \
    GAPB(o[0] = __builtin_amdgcn_mfma_f32_32x32x16_bf16(PAF(0), VFR(0), o[0], 0, 0, 0), C0, 0); \
    GAPB(o[1] = __builtin_amdgcn_mfma_f32_32x32x16_bf16(PAF(0), VFR(4), o[1], 0, 0, 0), C0, 4); \
    KRD(GL, 0); GAPB(o[0] = __builtin_amdgcn_mfma_f32_32x32x16_bf16(PAF(1), VFR(1), o[0], 0, 0, 0), C0, 8); \
    KRD(GL, 1); GAPB(o[1] = __builtin_amdgcn_mfma_f32_32x32x16_bf16(PAF(1), VFR(5), o[1], 0, 0, 0), C0, 12); \
    KRD(GL, 2); GAPB(o[0] = __builtin_amdgcn_mfma_f32_32x32x16_bf16(PAF(2), VFR(2), o[0], 0, 0, 0), C1, 0); \
    KRD(GL, 3); GAPB(o[1] = __builtin_amdgcn_mfma_f32_32x32x16_bf16(PAF(2), VFR(6), o[1], 0, 0, 0), C1, 4); \
    GAPB(o[0] = __builtin_amdgcn_mfma_f32_32x32x16_bf16(PAF(3), VFR(3), o[0], 0, 0, 0), C1, 8); \
    GAPB(o[1] = __builtin_amdgcn_mfma_f32_32x32x16_bf16(PAF(3), VFR(7), o[1], 0, 0, 0), C1, 12); \
    } while (0)
  int t = 1;
  for (; t + 5 < NT; t += 2) {
    STEP(pB0, pB1, pA0, pA1, t, true, true, true);     WAIT_BAR(2); ROT();
    STEP(pA0, pA1, pB0, pB1, t + 1, true, true, true);   WAIT_BAR(2); ROT();
  }
  #define ENDW(tt) do { if ((tt) + 3 < NT) { WAIT_BAR(2); } else if ((tt) + 2 < NT) { WAIT_BAR(1); } else { WAIT_BAR(0); } } while (0)
  for (; t + 1 < NT; t += 2) {
    STEP(pB0, pB1, pA0, pA1, t, (t + 3 < NT), (t + 1 < NT), (t + 1 < NT));       ENDW(t);   ROT();
    STEP(pA0, pA1, pB0, pB1, t + 1, (t + 4 < NT), (t + 2 < NT), (t + 2 < NT));     ENDW(t + 1); ROT();
  }
  STEP(pB0, pB1, pA0, pA1, NT - 1, false, false, false);
  { pw0 = (u32x4){PKW(pB0, 0), PKW(pB0, 2), PKW(pB0, 4), PKW(pB0, 6)}; pw1 = (u32x4){PKW(pB0, 8), PKW(pB0, 10), PKW(pB0, 12), PKW(pB0, 14)}; pw2 = (u32x4){PKW(pB1, 0), PKW(pB1, 2), PKW(pB1, 4), PKW(pB1, 6)}; pw3 = (u32x4){PKW(pB1, 8), PKW(pB1, 10), PKW(pB1, 12), PKW(pB1, 14)};
    SBAR(); OSUM(0); OSUM(1); OSUM(2); OSUM(3); pv2(o, vq, sl_cur, PAF(0), PAF(1), PAF(2), PAF(3)); }
  #undef PKW
  #undef PAF
  #undef VFR
  #undef PIN
  #undef GAPA
  #undef OSUM
  #undef GAPB
  #undef EX
  #undef VRD
  #undef KRD
  #undef STEP
  #undef ENDW
  const float sterm = __builtin_amdgcn_exp2f(sink2);
  float rli[16];
  #pragma unroll
  for (int r = 0; r < 16; ++r) rli[r] = __builtin_amdgcn_rcpf(osum[r] + sterm);
  bf16* Ow = O + (qrow + wid * QBLK) * QP + qcol;
  { bf16* stg = (bf16*)(shm + LDS_OST) + wid * 2048;
    #pragma unroll
    for (int r = 0; r < 16; ++r) { const int orow = crow(r, hi);
      #pragma unroll
      for (int d0 = 0; d0 < 2; ++d0) stg[orow * 64 + d0 * 32 + r32] = __float2bfloat16(o[d0][r] * rli[r]); }
    asm volatile("s_waitcnt lgkmcnt(0)" ::: "memory");
    #pragma unroll
    for (int i = 0; i < 4; ++i) { const int row = i * 8 + (lane >> 3), ch = lane & 7; const u32x4 v = *(const u32x4*)(stg + row * 64 + ch * 8); ATTN_STORE16(Ow + (long)row * QP + ch * 8, v); } }
  asm volatile("s_waitcnt lgkmcnt(0)\n\ts_barrier" ::: "memory");
  #undef DMA_K
  #undef DMA_V
  #undef ROWOFF
  #undef CMASK
  #undef ROT
}
template <int MODE> __device__ __forceinline__ void attn_unit_sk(long qrow, long kvrow, int q0, int qcol, int kcol, int vcol, int NT, float sink2, float bound, const bf16* Q, const bf16* __restrict__ KVb, bf16* O, char* shm) {
  int tid_ = threadIdx.x; asm volatile("" : "+v"(tid_));
  const int tid = tid_, lane = tid & 63, r32 = lane & 31, hi = lane >> 5; const int wid = __builtin_amdgcn_readfirstlane(tid >> 6);
  const bf16* Qw = Q + (qrow + wid * QBLK) * QP + qcol;
  const char* kvt = (const char*)KVb + (size_t)(kvrow >> 6) * 65536 + wid * 1024 + lane * 16;
  constexpr int NSL = 4, LK = 0, LV = NSL * SLOTB, LOST = 2 * NSL * SLOTB + NW * 64 * 4;
  const unsigned lds0 = (unsigned)(uintptr_t)shm;
  const char* ksrc = kvt + kcol * 8192; const char* vsrc = kvt + vcol * 8192;
  const unsigned kdst = lds0 + LK + wid * 1024, vdst = lds0 + LV + wid * 1024;
  #define ROWOFF(t) ((long)(MODE == 1 ? ((t) + ((t) >= 4 ? ((q0 - 128) >> 6) : 0)) : (t)) * 65536)
  #define DMA_K(t, slot) glds16(ksrc + ROWOFF(t), (unsigned)__builtin_amdgcn_readfirstlane(kdst + (slot)))
  #define DMA_V(t, slot) glds16(vsrc + ROWOFF(t), (unsigned)__builtin_amdgcn_readfirstlane(vdst + (slot)))
  const char* Kbase = shm + LK; bf16x8 kf[8];
  const lds_cptr shm3 = (lds_cptr)shm; const lds_cptr kp0 = shm3 + LK + hi * 1024 + r32 * 16; lds_cptr vq[4];
  { const int swz = (r32 >> 1) & 7; _Pragma("unroll") for (int ks_ = 0; ks_ < 4; ++ks_) vq[ks_] = shm3 + LV + r32 * 128 + (((2 * ks_ + hi) ^ swz) * 16); }
  DMA_K(0, 0); DMA_V(0, 0); DMA_K(1, SLOTB);
  bf16x8 qr[4];
  #pragma unroll
  for (int d0 = 0; d0 < 4; ++d0) qr[d0] = *reinterpret_cast<const bf16x8*>(&Qw[(long)r32 * QP + d0 * 16 + hi * 8]);
  f32x16 o[2]; o[0] = f32x16{}; o[1] = f32x16{}; f32x16 osum = f32x16{};
  const f32x16 negm = f32x16{};
  bf16x8 ones;
  #pragma unroll
  for (int i = 0; i < 8; ++i) ones[i] = (short)0x3F80;
  asm volatile("" : "+v"(ones));
  const int qrel = wid * QBLK + r32;
  int mlo = -128, mhi = 128;
  if (MODE == 1) { const int qi = q0 + qrel; mlo = (-qi > -128) ? -qi : -128; mhi = (SEQ - 1 - qi < 128) ? (SEQ - 1 - qi) : 128; }
  const unsigned mspan = (unsigned)(mhi - mlo);
  #define CMASK(P0, P1, t) do { if (MODE == 1) { if ((t) >= 4) bandmask(P0, P1, (t), mlo, mspan, qrel, hi); } } while (0)
  f32x16 pA0, pA1, pB0, pB1;
  int sl_prev = 0, sl_cur = 0, sl_next = SLOTB;
  #define ROT() do { sl_prev = sl_cur; sl_cur = sl_next; sl_next = (sl_next == (NSL - 1) * SLOTB) ? 0 : sl_next + SLOTB; } while (0)
  DMA_K(2, 2 * SLOTB);
  WAIT_BAR(3);
  qkt(pA0, pA1, Kbase, qr, negm, r32, hi); asm volatile("s_nop 15\n\ts_nop 7" : "+v"(pA0), "+v"(pA1)); CMASK(pA0, pA1, 0);
  _Pragma("unroll") for (int r = 0; r < 16; ++r) { pA0[r] = __builtin_amdgcn_exp2f(pA0[r]); pA1[r] = __builtin_amdgcn_exp2f(pA1[r]); }
  WAIT_BAR(0);
  DMA_V(1, SLOTB); DMA_K(3, 3 * SLOTB); DMA_V(2, 2 * SLOTB); if (4 < NT) { DMA_K(4, 0); }
  ROT();
  kload8(kf, kp0 + sl_cur);
  WAIT_BAR(4);
  if (wid >= 4) asm volatile("s_barrier" ::: "memory");
  bf16x8 vfr[8]; u32x4 pw0, pw1, pw2, pw3;
  #define PKW(P, B) cvtpk_s(P[B], P[B + 1])
  #define PAF(k) __builtin_bit_cast(bf16x8, pw##k)
  #define VFR(i) vfr[i]
  #define PIN(x) asm volatile("" : "+v"(x))
  #define GAPA(MF, W0, W1, PW) do { MF; W0; W1; PIN(PW); SBAR(); } while (0)
  #define OSUM(k) do { osum = __builtin_amdgcn_mfma_f32_32x32x16_bf16(PAF(k), ones, osum, 0, 0, 0); SBAR(); } while (0)
  #define EX(v) (FASTEXP ? exp2_fast(v) : __builtin_amdgcn_exp2f(v))
  #define GAPB(MF, X, B) do { MF; X[B] = EX(X[B]); X[B + 1] = EX(X[B + 1]); X[B + 2] = EX(X[B + 2]); X[B + 3] = EX(X[B + 3]); PIN(X); SBAR(); } while (0)
  #define VRD(i) do { vfr[i] = *(const LAS bf16x8*)(vq[(i) & 3] + vsl_ + ((i) >> 2) * 4096); } while (0)
  #define KRD(G, j) do { if (G) { kload2(kf, kp0 + sl_next, j); SBAR(); } } while (0)
  #define STEP(C0, C1, P0, P1, t, GK, GV, GL, WMID) do { SBAR(); \
    const int vsl_ = sl_prev; \
    VRD(0); SBAR(); GAPA(C0 = __builtin_amdgcn_mfma_f32_32x32x16_bf16(kf[0], qr[0], negm, 0, 0, 0), pw0[0] = PKW(P0, 0), pw0[1] = PKW(P0, 2), pw0); \
    VRD(4); SBAR(); GAPA(C1 = __builtin_amdgcn_mfma_f32_32x32x16_bf16(kf[1], qr[0], negm, 0, 0, 0), pw0[2] = PKW(P0, 4), pw0[3] = PKW(P0, 6), pw0); \
    VRD(1); SBAR(); GAPA(C0 = __builtin_amdgcn_mfma_f32_32x32x16_bf16(kf[2], qr[1], C0, 0, 0, 0),   pw1[0] = PKW(P0, 8), pw1[1] = PKW(P0, 10), pw1); \
    OSUM(0); \
    VRD(5); SBAR(); GAPA(C1 = __builtin_amdgcn_mfma_f32_32x32x16_bf16(kf[3], qr[1], C1, 0, 0, 0),   pw1[2] = PKW(P0, 12), pw1[3] = PKW(P0, 14), pw1); \
    VRD(2); SBAR(); GAPA(C0 = __builtin_amdgcn_mfma_f32_32x32x16_bf16(kf[4], qr[2], C0, 0, 0, 0),   pw2[0] = PKW(P1, 0), pw2[1] = PKW(P1, 2), pw2); \
    OSUM(1); \
    VRD(6); SBAR(); GAPA(C1 = __builtin_amdgcn_mfma_f32_32x32x16_bf16(kf[5], qr[2], C1, 0, 0, 0),   pw2[2] = PKW(P1, 4), pw2[3] = PKW(P1, 6), pw2); \
    VRD(3); SBAR(); GAPA(C0 = __builtin_amdgcn_mfma_f32_32x32x16_bf16(kf[6], qr[3], C0, 0, 0, 0),   pw3[0] = PKW(P1, 8), pw3[1] = PKW(P1, 10), pw3); \
    OSUM(2); \
    VRD(7); SBAR(); GAPA(C1 = __builtin_amdgcn_mfma_f32_32x32x16_bf16(kf[7], qr[3], C1, 0, 0, 0),   pw3[2] = PKW(P1, 12), pw3[3] = PKW(P1, 14), pw3); \
    OSUM(3); \
    CMASK(C0, C1, t); \
    SBAR(); \
    WMID; \
    if (GV) { DMA_V((t) + 2, (sl_next == (NSL - 1) * SLOTB) ? 0 : sl_next + SLOTB); } if (GK) { DMA_K((t) + 4, sl_cur); } \
    SBAR(); \
    GAPB(o[0] = __builtin_amdgcn_mfma_f32_32x32x16_bf16(PAF(0), VFR(0), o[0], 0, 0, 0), C0, 0); \
    GAPB(o[1] = __builtin_amdgcn_mfma_f32_32x32x16_bf16(PAF(0), VFR(4), o[1], 0, 0, 0), C0, 4); \
    KRD(GL, 0); GAPB(o[0] = __builtin_amdgcn_mfma_f32_32x32x16_bf16(PAF(1), VFR(1), o[0], 0, 0, 0), C0, 8); \
    KRD(GL, 1); GAPB(o[1] = __builtin_amdgcn_mfma_f32_32x32x16_bf16(PAF(1), VFR(5), o[1], 0, 0, 0), C0, 12); \
    KRD(GL, 2); GAPB(o[0] = __builtin_amdgcn_mfma_f32_32x32x16_bf16(PAF(2), VFR(2), o[0], 0, 0, 0), C1, 0); \
    KRD(GL, 3); GAPB(o[1] = __builtin_amdgcn_mfma_f32_32x32x16_bf16(PAF(2), VFR(6), o[1], 0, 0, 0), C1, 4); \
    GAPB(o[0] = __builtin_amdgcn_mfma_f32_32x32x16_bf16(PAF(3), VFR(3), o[0], 0, 0, 0), C1, 8); \
    GAPB(o[1] = __builtin_amdgcn_mfma_f32_32x32x16_bf16(PAF(3), VFR(7), o[1], 0, 0, 0), C1, 12); \
    } while (0)
  int t = 1;
  for (; t + 5 < NT; t += 2) {
    STEP(pB0, pB1, pA0, pA1, t, true, true, true, WAIT_BAR(3));     WAIT_BAR(4); ROT();
    STEP(pA0, pA1, pB0, pB1, t + 1, true, true, true, WAIT_BAR(3));   WAIT_BAR(4); ROT();
  }
  for (; t + 1 < NT; t += 2) {
    STEP(pB0, pB1, pA0, pA1, t, (t + 4 < NT), (t + 2 < NT), (t + 1 < NT), WAIT_BAR(0));       WAIT_BAR(0); ROT();
    STEP(pA0, pA1, pB0, pB1, t + 1, (t + 5 < NT), (t + 3 < NT), (t + 2 < NT), WAIT_BAR(0));     WAIT_BAR(0); ROT();
  }
  STEP(pB0, pB1, pA0, pA1, NT - 1, false, false, false, WAIT_BAR(0));
  if (wid < 4) { WAIT_BAR(0); }
  { pw0 = (u32x4){PKW(pB0, 0), PKW(pB0, 2), PKW(pB0, 4), PKW(pB0, 6)}; pw1 = (u32x4){PKW(pB0, 8), PKW(pB0, 10), PKW(pB0, 12), PKW(pB0, 14)}; pw2 = (u32x4){PKW(pB1, 0), PKW(pB1, 2), PKW(pB1, 4), PKW(pB1, 6)}; pw3 = (u32x4){PKW(pB1, 8), PKW(pB1, 10), PKW(pB1, 12), PKW(pB1, 14)};
    SBAR(); OSUM(0); OSUM(1); OSUM(2); OSUM(3); pv2(o, vq, sl_cur, PAF(0), PAF(1), PAF(2), PAF(3)); }
  #undef PKW
  #undef PAF
  #undef VFR
  #undef PIN
  #undef GAPA
  #undef OSUM
  #undef GAPB
  #undef EX
  #undef VRD
  #undef KRD
  #undef STEP
  const float sterm = __builtin_amdgcn_exp2f(sink2);
  float rli[16];
  #pragma unroll
  for (int r = 0; r < 16; ++r) rli[r] = __builtin_amdgcn_rcpf(osum[r] + sterm);
  bf16* Ow = O + (qrow + wid * QBLK) * QP + qcol;
  { bf16* stg = (bf16*)(shm + LOST) + wid * 2048;
    #pragma unroll
    for (int r = 0; r < 16; ++r) { const int orow = crow(r, hi);
      #pragma unroll
      for (int d0 = 0; d0 < 2; ++d0) stg[orow * 64 + d0 * 32 + r32] = __float2bfloat16(o[d0][r] * rli[r]); }
    asm volatile("s_waitcnt lgkmcnt(0)" ::: "memory");
    #pragma unroll
    for (int i = 0; i < 4; ++i) { const int row = i * 8 + (lane >> 3), ch = lane & 7; const u32x4 v = *(const u32x4*)(stg + row * 64 + ch * 8); ATTN_STORE16(Ow + (long)row * QP + ch * 8, v); } }
  asm volatile("s_waitcnt lgkmcnt(0)\n\ts_barrier" ::: "memory");
  #undef DMA_K
  #undef DMA_V
  #undef ROWOFF
  #undef CMASK
  #undef ROT
}
typedef int v8i_t __attribute__((ext_vector_type(8)));
typedef int v4i_t __attribute__((ext_vector_type(4)));
template <int MODE, int XV = 0> __device__ __forceinline__ void attn_unit_f8(long qrow, long kvrow, int q0, int qcol, int kst, int vst, int NT, float sink2, float ref, const unsigned char* Qf8, const unsigned char* KVT, bf16* O, char* shm) {
  int tid_ = threadIdx.x; asm volatile("" : "+v"(tid_));
  const int tid = tid_, lane = tid & 63, r32 = lane & 31, hi = lane >> 5; const int wid = __builtin_amdgcn_readfirstlane(tid >> 6);
  constexpr int KSL = 4096, VSL = 8192, LK = 0, LV = 3 * KSL, LOST = LV + 3 * VSL, TILEB = 49152;
  const unsigned lds0 = (unsigned)(uintptr_t)shm;
  const unsigned char* tile0 = KVT + (size_t)(kvrow >> 6) * TILEB;
  const unsigned char* ksrc = tile0 + kst * KSL + wid * 512 + (lane & 31) * 16;
  const unsigned char* vsrc = tile0 + 4 * KSL + vst * VSL + wid * 1024 + lane * 16;
  const unsigned kdst = lds0 + LK + wid * 512, vdst = lds0 + LV + wid * 1024;
  #define ROWOFF(t) ((long)(MODE == 1 ? ((t) + ((t) >= 4 ? ((q0 - 128) >> 6) : 0)) : (t)) * TILEB)
  #define DMA_K(t, kslot) do { if (lane < 32) glds16(ksrc + ROWOFF(t), (unsigned)__builtin_amdgcn_readfirstlane(kdst + (kslot))); } while (0)
  #define DMA_V(t, vslot) glds16(vsrc + ROWOFF(t), (unsigned)__builtin_amdgcn_readfirstlane(vdst + (vslot)))
  const lds_cptr shm3 = (lds_cptr)shm;
  const int ksw = (r32 >> 2) & 3;
  const lds_cptr kq0 = shm3 + LK + r32 * 64 + (((2 * hi) ^ ksw) * 16), kq1 = shm3 + LK + r32 * 64 + (((2 * hi + 1) ^ ksw) * 16);
  lds_cptr vq[4];
  { const int swz = (r32 >> 1) & 7; _Pragma("unroll") for (int ks_ = 0; ks_ < 4; ++ks_) vq[ks_] = shm3 + LV + r32 * 128 + (((2 * ks_ + hi) ^ swz) * 16); }
  DMA_K(0, 0); DMA_V(0, 0); DMA_K(1, KSL);
  v8i_t qf;
  { const v4i_t* qp = (const v4i_t*)(Qf8 + (size_t)(qrow + wid * QBLK + r32) * 1024 + qcol + hi * 32); const v4i_t a = qp[0], b = qp[1]; qf = (v8i_t){a[0], a[1], a[2], a[3], b[0], b[1], b[2], b[3]}; }
  f32x16 o[2]; o[0] = f32x16{}; o[1] = f32x16{}; f32x16 osum = f32x16{};
  f32x16 negm;
  #pragma unroll
  for (int r = 0; r < 16; ++r) negm[r] = -ref;
  asm volatile("" : "+v"(negm));
  bf16x8 ones;
  #pragma unroll
  for (int i = 0; i < 8; ++i) ones[i] = (short)0x3F80;
  asm volatile("" : "+v"(ones));
  const int qrel = wid * QBLK + r32;
  int mlo = -128, mhi = 128;
  if (MODE == 1) { const int qi = q0 + qrel; mlo = (-qi > -128) ? -qi : -128; mhi = (SEQ - 1 - qi < 128) ? (SEQ - 1 - qi) : 128; }
  const unsigned mspan = (unsigned)(mhi - mlo);
  #define CMASK(P0, P1, t) do { if (MODE == 1) { if ((t) >= 4) bandmask(P0, P1, (t), mlo, mspan, qrel, hi); } } while (0)
  #define MF8(kfr, cin) __builtin_amdgcn_mfma_scale_f32_32x32x64_f8f6f4(kfr, qf, cin, 0, 0, 0, 0x7F7F7F7F, 0, 0x7F7F7F7F)
  #define KLOAD(dst, b, kslot) do { const v4i_t a_ = *(const LAS v4i_t*)(kq0 + (kslot) + (b) * 2048), b_ = *(const LAS v4i_t*)(kq1 + (kslot) + (b) * 2048); dst = (v8i_t){a_[0], a_[1], a_[2], a_[3], b_[0], b_[1], b_[2], b_[3]}; } while (0)
  f32x16 pA0, pA1, pB0, pB1;
  int sl_prev = 0, sl_cur = 0, sl_next = VSL;
  #define ROT() do { sl_prev = sl_cur; sl_cur = sl_next; sl_next = (sl_next == 2 * VSL) ? 0 : sl_next + VSL; } while (0)
  DMA_K(2, 2 * KSL);
  WAIT_BAR(3);
  v8i_t kf0, kf1;
  KLOAD(kf0, 0, 0); KLOAD(kf1, 1, 0);
  pA0 = MF8(kf0, negm); pA1 = MF8(kf1, negm);
  asm volatile("s_nop 15\n\ts_nop 7" : "+v"(pA0), "+v"(pA1)); CMASK(pA0, pA1, 0);
  _Pragma("unroll") for (int r = 0; r < 16; ++r) { pA0[r] = __builtin_amdgcn_exp2f(pA0[r]); pA1[r] = __builtin_amdgcn_exp2f(pA1[r]); }
  WAIT_BAR(0);
  DMA_K(3, 0); DMA_V(1, VSL);
  ROT();
  KLOAD(kf0, 0, sl_cur >> 1); KLOAD(kf1, 1, sl_cur >> 1);
  WAIT_BAR(2);
  bf16x8 vfr[8]; u32x4 pw0, pw1, pw2, pw3;
  #define PKW(P, B) cvtpk_s(P[B], P[B + 1])
  #define PAF(k) __builtin_bit_cast(bf16x8, pw##k)
  #define VFR(i) vfr[i]
  #define PIN(x) asm volatile("" : "+v"(x))
  #define OSUM(k) do { if (XV != 5) osum = __builtin_amdgcn_mfma_f32_32x32x16_bf16(PAF(k), ones, osum, 0, 0, 0); SBAR(); } while (0)
  #define EX(v) __builtin_amdgcn_exp2f(v)
  #define GAPB(MF, X, B) do { MF; X[B] = EX(X[B]); X[B + 1] = EX(X[B + 1]); X[B + 2] = EX(X[B + 2]); X[B + 3] = EX(X[B + 3]); PIN(X); SBAR(); } while (0)
  #define VRD(i) do { vfr[i] = *(const LAS bf16x8*)(vq[(i) & 3] + vsl_ + ((i) >> 2) * 4096); } while (0)
  #define STEP(C0, C1, P0, P1, t, GK, GV, GL) do { SBAR(); \
    const int vsl_ = sl_prev; \
    VRD(0); VRD(4); SBAR(); \
    C0 = MF8(kf0, negm); pw0[0] = PKW(P0, 0); pw0[1] = PKW(P0, 2); pw0[2] = PKW(P0, 4); pw0[3] = PKW(P0, 6); PIN(pw0); SBAR(); \
    VRD(1); VRD(5); SBAR(); \
    C1 = MF8(kf1, negm); pw1[0] = PKW(P0, 8); pw1[1] = PKW(P0, 10); pw1[2] = PKW(P0, 12); pw1[3] = PKW(P0, 14); PIN(pw1); SBAR(); \
    VRD(2); VRD(6); SBAR(); \
    OSUM(0); pw2[0] = PKW(P1, 0); pw2[1] = PKW(P1, 2); pw2[2] = PKW(P1, 4); pw2[3] = PKW(P1, 6); PIN(pw2); SBAR(); \
    VRD(3); VRD(7); SBAR(); \
    OSUM(1); pw3[0] = PKW(P1, 8); pw3[1] = PKW(P1, 10); pw3[2] = PKW(P1, 12); pw3[3] = PKW(P1, 14); PIN(pw3); SBAR(); \
    OSUM(2); \
    if (GK) { DMA_K((t) + 3, sl_cur >> 1); } if (GV) { DMA_V((t) + 1, sl_next); } \
    OSUM(3); \
    CMASK(C0, C1, t); \
    SBAR(); \
    GAPB(o[0] = __builtin_amdgcn_mfma_f32_32x32x16_bf16(PAF(0), VFR(0), o[0], 0, 0, 0), C0, 0); \
    GAPB(o[1] = __builtin_amdgcn_mfma_f32_32x32x16_bf16(PAF(0), VFR(4), o[1], 0, 0, 0), C0, 4); \
    if (GL) { KLOAD(kf0, 0, sl_next >> 1); SBAR(); } \
    GAPB(o[0] = __builtin_amdgcn_mfma_f32_32x32x16_bf16(PAF(1), VFR(1), o[0], 0, 0, 0), C0, 8); \
    GAPB(o[1] = __builtin_amdgcn_mfma_f32_32x32x16_bf16(PAF(1), VFR(5), o[1], 0, 0, 0), C0, 12); \
    if (GL) { KLOAD(kf1, 1, sl_next >> 1); SBAR(); } \
    GAPB(o[0] = __builtin_amdgcn_mfma_f32_32x32x16_bf16(PAF(2), VFR(2), o[0], 0, 0, 0), C1, 0); \
    GAPB(o[1] = __builtin_amdgcn_mfma_f32_32x32x16_bf16(PAF(2), VFR(6), o[1], 0, 0, 0), C1, 4); \
    GAPB(o[0] = __builtin_amdgcn_mfma_f32_32x32x16_bf16(PAF(3), VFR(3), o[0], 0, 0, 0), C1, 8); \
    GAPB(o[1] = __builtin_amdgcn_mfma_f32_32x32x16_bf16(PAF(3), VFR(7), o[1], 0, 0, 0), C1, 12); \
    } while (0)
  int t = 1;
  for (; t + 5 < NT; t += 2) {
    STEP(pB0, pB1, pA0, pA1, t, true, true, true);     WAIT_BAR(2); ROT();
    STEP(pA0, pA1, pB0, pB1, t + 1, true, true, true);   WAIT_BAR(2); ROT();
  }
  #define ENDW(tt) do { if ((tt) + 3 < NT) { WAIT_BAR(2); } else if ((tt) + 2 < NT) { WAIT_BAR(1); } else { WAIT_BAR(0); } } while (0)
  for (; t + 1 < NT; t += 2) {
    STEP(pB0, pB1, pA0, pA1, t, (t + 3 < NT), (t + 1 < NT), (t + 1 < NT));       ENDW(t);   ROT();
    STEP(pA0, pA1, pB0, pB1, t + 1, (t + 4 < NT), (t + 2 < NT), (t + 2 < NT));     ENDW(t + 1); ROT();
  }
  STEP(pB0, pB1, pA0, pA1, NT - 1, false, false, false);
  { pw0 = (u32x4){PKW(pB0, 0), PKW(pB0, 2), PKW(pB0, 4), PKW(pB0, 6)}; pw1 = (u32x4){PKW(pB0, 8), PKW(pB0, 10), PKW(pB0, 12), PKW(pB0, 14)}; pw2 = (u32x4){PKW(pB1, 0), PKW(pB1, 2), PKW(pB1, 4), PKW(pB1, 6)}; pw3 = (u32x4){PKW(pB1, 8), PKW(pB1, 10), PKW(pB1, 12), PKW(pB1, 14)};
    SBAR(); OSUM(0); OSUM(1); OSUM(2); OSUM(3); pv2(o, vq, sl_cur, PAF(0), PAF(1), PAF(2), PAF(3)); }
  #undef PKW
  #undef PAF
  #undef VFR
  #undef PIN
  #undef OSUM
  #undef GAPB
  #undef EX
  #undef VRD
  #undef STEP
  #undef ENDW
  #undef MF8
  #undef KLOAD
  const float sterm = __builtin_amdgcn_exp2f(sink2 - ref);
  float rli[16];
  #pragma unroll
  for (int r = 0; r < 16; ++r) rli[r] = __builtin_amdgcn_rcpf(osum[r] + sterm);
  bf16* Ow = O + (qrow + wid * QBLK) * QP + qcol;
  { bf16* stg = (bf16*)(shm + LOST) + wid * 2048;
    #pragma unroll
    for (int r = 0; r < 16; ++r) { const int orow = crow(r, hi);
      #pragma unroll
      for (int d0 = 0; d0 < 2; ++d0) stg[orow * 64 + d0 * 32 + r32] = __float2bfloat16(o[d0][r] * rli[r]); }
    asm volatile("s_waitcnt lgkmcnt(0)" ::: "memory");
    #pragma unroll
    for (int i = 0; i < 4; ++i) { const int row = i * 8 + (lane >> 3), ch = lane & 7; const u32x4 v = *(const u32x4*)(stg + row * 64 + ch * 8); ATTN_STORE16(Ow + (long)row * QP + ch * 8, v); } }
  asm volatile("s_waitcnt lgkmcnt(0)\n\ts_barrier" ::: "memory");
  #undef DMA_K
  #undef DMA_V
  #undef ROWOFF
  #undef CMASK
  #undef ROT
}
template <int MODE> __device__ __forceinline__ void attn_unit_f8b(long qrow, long kvrow, int q0, int qcol, int kst, int vst, int NT, float sink2, float cref, const unsigned char* Qf8, const unsigned char* KVT, bf16* O, char* shm) {
  int tid_ = threadIdx.x; asm volatile("" : "+v"(tid_));
  const int tid = tid_, lane = tid & 63, r32 = lane & 31, hi = lane >> 5; const int wid = __builtin_amdgcn_readfirstlane(tid >> 6);
  constexpr int SL = 4096, LK = 0, LV = 3 * SL, LOST = LV + 3 * SL, TILEB = 32768;
  const unsigned lds0 = (unsigned)(uintptr_t)shm;
  const unsigned char* tile0 = KVT + (size_t)(kvrow >> 6) * TILEB + wid * 512 + (lane & 31) * 16;
  const unsigned char* ksrc = tile0 + kst * SL; const unsigned char* vsrc = tile0 + 4 * SL + vst * SL;
  const unsigned kdst = lds0 + LK + wid * 512, vdst = lds0 + LV + wid * 512;
  #define ROWOFF(t) ((long)(MODE == 1 ? ((t) + ((t) >= 4 ? ((q0 - 128) >> 6) : 0)) : (t)) * TILEB)
  #define DMA_K(t, slot) do { if (lane < 32) glds16(ksrc + ROWOFF(t), (unsigned)__builtin_amdgcn_readfirstlane(kdst + (slot))); } while (0)
  #define DMA_V(t, slot) do { if (lane < 32) glds16(vsrc + ROWOFF(t), (unsigned)__builtin_amdgcn_readfirstlane(vdst + (slot))); } while (0)
  const lds_cptr shm3 = (lds_cptr)shm;
  const int ksw = (r32 >> 2) & 3;
  const lds_cptr fq0 = shm3 + r32 * 64 + (((2 * hi) ^ ksw) * 16), fq1 = shm3 + r32 * 64 + (((2 * hi + 1) ^ ksw) * 16);
  DMA_K(0, 0); DMA_V(0, 0); DMA_K(1, SL);
  v8i_t qf;
  { const v4i_t* qp = (const v4i_t*)(Qf8 + (size_t)(qrow + wid * QBLK + r32) * 1024 + qcol + hi * 32); const v4i_t a = qp[0], b = qp[1]; qf = (v8i_t){a[0], a[1], a[2], a[3], b[0], b[1], b[2], b[3]}; }
  f32x16 o[2]; o[0] = f32x16{}; o[1] = f32x16{}; f32x16 osum = f32x16{};
  f32x16 negm;
  #pragma unroll
  for (int r = 0; r < 16; ++r) negm[r] = -cref;
  asm volatile("" : "+v"(negm));
  v8i_t ones8;
  #pragma unroll
  for (int i = 0; i < 8; ++i) ones8[i] = 0x38383838;
  asm volatile("" : "+v"(ones8));
  const int qrel = wid * QBLK + r32;
  int mlo = -128, mhi = 128;
  if (MODE == 1) { const int qi = q0 + qrel; mlo = (-qi > -128) ? -qi : -128; mhi = (SEQ - 1 - qi < 128) ? (SEQ - 1 - qi) : 128; }
  const unsigned mspan = (unsigned)(mhi - mlo);
  #define CMASK(P0, P1, t) do { if (MODE == 1) { if ((t) >= 4) bandmask(P0, P1, (t), mlo, mspan, qrel, hi); } } while (0)
  #define MFQK(kfr) __builtin_amdgcn_mfma_scale_f32_32x32x64_f8f6f4(kfr, qf, negm, 0, 0, 0, 0x7F7F7F7F, 0, 0x7F7F7F7F)
  #define MFPV(bfr, cin) __builtin_amdgcn_mfma_scale_f32_32x32x64_f8f6f4(pf, bfr, cin, 1, 0, 0, 0x7F7F7F7F, 0, 0x7F7F7F7F)
  #define FLOAD(dst, base, b, slot) do { const v4i_t a_ = *(const LAS v4i_t*)(fq0 + (base) + (slot) + (b) * 2048), b_ = *(const LAS v4i_t*)(fq1 + (base) + (slot) + (b) * 2048); dst = (v8i_t){a_[0], a_[1], a_[2], a_[3], b_[0], b_[1], b_[2], b_[3]}; } while (0)
  #define PK8(x0, x1, x2, x3) __builtin_amdgcn_cvt_pk_bf8_f32(x2, x3, __builtin_amdgcn_cvt_pk_bf8_f32(x0, x1, 0, false), true)
  f32x16 pA0, pA1, pB0, pB1;
  int sl_prev = 0, sl_cur = 0, sl_next = SL;
  #define ROT() do { sl_prev = sl_cur; sl_cur = sl_next; sl_next = (sl_next == 2 * SL) ? 0 : sl_next + SL; } while (0)
  DMA_K(2, 2 * SL);
  WAIT_BAR(3);
  v8i_t kf0, kf1, vf0, vf1, pf;
  FLOAD(kf0, LK, 0, 0); FLOAD(kf1, LK, 1, 0);
  pA0 = MFQK(kf0); pA1 = MFQK(kf1);
  asm volatile("s_nop 15\n\ts_nop 7" : "+v"(pA0), "+v"(pA1)); CMASK(pA0, pA1, 0);
  _Pragma("unroll") for (int r = 0; r < 16; ++r) { pA0[r] = __builtin_amdgcn_exp2f(pA0[r]); pA1[r] = __builtin_amdgcn_exp2f(pA1[r]); }
  WAIT_BAR(0);
  DMA_K(3, 0); DMA_V(1, SL);
  ROT();
  FLOAD(kf0, LK, 0, sl_cur); FLOAD(kf1, LK, 1, sl_cur);
  WAIT_BAR(2);
  #define PIN(x) asm volatile("" : "+v"(x))
  #define EX(v) __builtin_amdgcn_exp2f(v)
  #define EX8(X, B) do { _Pragma("unroll") for (int e_ = 0; e_ < 8; ++e_) X[(B) + e_] = EX(X[(B) + e_]); PIN(X); } while (0)
  #define PACKP(P0, P1) do { pf[0] = PK8(P0[0], P0[1], P0[2], P0[3]); pf[1] = PK8(P0[4], P0[5], P0[6], P0[7]); pf[2] = PK8(P0[8], P0[9], P0[10], P0[11]); pf[3] = PK8(P0[12], P0[13], P0[14], P0[15]); \
                             pf[4] = PK8(P1[0], P1[1], P1[2], P1[3]); pf[5] = PK8(P1[4], P1[5], P1[6], P1[7]); pf[6] = PK8(P1[8], P1[9], P1[10], P1[11]); pf[7] = PK8(P1[12], P1[13], P1[14], P1[15]); PIN(pf); } while (0)
  #define STEP(C0, C1, P0, P1, t, GK, GV, GL) do { SBAR(); \
    FLOAD(vf0, LV, 0, sl_prev); FLOAD(vf1, LV, 1, sl_prev); SBAR(); \
    C0 = MFQK(kf0); SBAR(); \
    PACKP(P0, P1); SBAR(); \
    C1 = MFQK(kf1); SBAR(); \
    if (GK) { DMA_K((t) + 3, sl_cur); } if (GV) { DMA_V((t) + 1, sl_next); } \
    osum = MFPV(ones8, osum); SBAR(); \
    CMASK(C0, C1, t); SBAR(); \
    o[0] = MFPV(vf0, o[0]); EX8(C0, 0); SBAR(); \
    if (GL) { FLOAD(kf0, LK, 0, sl_next); SBAR(); } \
    EX8(C0, 8); SBAR(); \
    o[1] = MFPV(vf1, o[1]); EX8(C1, 0); SBAR(); \
    if (GL) { FLOAD(kf1, LK, 1, sl_next); SBAR(); } \
    EX8(C1, 8); SBAR(); \
    } while (0)
  int t = 1;
  for (; t + 5 < NT; t += 2) {
    STEP(pB0, pB1, pA0, pA1, t, true, true, true);     WAIT_BAR(2); ROT();
    STEP(pA0, pA1, pB0, pB1, t + 1, true, true, true);   WAIT_BAR(2); ROT();
  }
  #define ENDW(tt) do { if ((tt) + 3 < NT) { WAIT_BAR(2); } else if ((tt) + 2 < NT) { WAIT_BAR(1); } else { WAIT_BAR(0); } } while (0)
  for (; t + 1 < NT; t += 2) {
    STEP(pB0, pB1, pA0, pA1, t, (t + 3 < NT), (t + 1 < NT), (t + 1 < NT));       ENDW(t);   ROT();
    STEP(pA0, pA1, pB0, pB1, t + 1, (t + 4 < NT), (t + 2 < NT), (t + 2 < NT));     ENDW(t + 1); ROT();
  }
  STEP(pB0, pB1, pA0, pA1, NT - 1, false, false, false);
  { PACKP(pB0, pB1); SBAR(); FLOAD(vf0, LV, 0, sl_cur); FLOAD(vf1, LV, 1, sl_cur); osum = MFPV(ones8, osum); o[0] = MFPV(vf0, o[0]); o[1] = MFPV(vf1, o[1]); }
  #undef PIN
  #undef EX
  #undef EX8
  #undef PACKP
  #undef STEP
  #undef ENDW
  #undef MFQK
  #undef MFPV
  #undef FLOAD
  #undef PK8
  const float sterm = __builtin_amdgcn_exp2f(sink2 - cref);
  float rli[16];
  #pragma unroll
  for (int r = 0; r < 16; ++r) rli[r] = __builtin_amdgcn_rcpf(osum[r] + sterm);
  bf16* Ow = O + (qrow + wid * QBLK) * QP + qcol;
  { bf16* stg = (bf16*)(shm + LOST) + wid * 2048;
    #pragma unroll
    for (int r = 0; r < 16; ++r) { const int orow = crow(r, hi);
      #pragma unroll
      for (int d0 = 0; d0 < 2; ++d0) stg[orow * 64 + d0 * 32 + r32] = __float2bfloat16(o[d0][r] * rli[r]); }
    asm volatile("s_waitcnt lgkmcnt(0)" ::: "memory");
    #pragma unroll
    for (int i = 0; i < 4; ++i) { const int row = i * 8 + (lane >> 3), ch = lane & 7; const u32x4 v = *(const u32x4*)(stg + row * 64 + ch * 8); ATTN_STORE16(Ow + (long)row * QP + ch * 8, v); } }
  asm volatile("s_waitcnt lgkmcnt(0)\n\ts_barrier" ::: "memory");
  #undef DMA_K
  #undef DMA_V
  #undef ROWOFF
  #undef CMASK
  #undef ROT
}
template <int MODE> __device__ __forceinline__ void attn_unit_f8c(long qrow, long kvrow, int q0, int qcol, int kst, int vst, int NT, float sink2, float cref, const unsigned char* Qf8, const unsigned char* KVT, bf16* O, char* shm) {
  int tid_ = threadIdx.x; asm volatile("" : "+v"(tid_));
  const int tid = tid_, lane = tid & 63, r32 = lane & 31, hi = lane >> 5; const int wid = __builtin_amdgcn_readfirstlane(tid >> 6);
  constexpr int SL = 4096, LK = 0, LV = 3 * SL, LOST = LV + 3 * SL, TILEB = 32768;
  const unsigned lds0 = (unsigned)(uintptr_t)shm;
  const unsigned char* tile0 = KVT + (size_t)(kvrow >> 6) * TILEB + wid * 512 + (lane & 31) * 16;
  const unsigned char* ksrc = tile0 + kst * SL; const unsigned char* vsrc = tile0 + 4 * SL + vst * SL;
  const unsigned kdst = lds0 + LK + wid * 512, vdst = lds0 + LV + wid * 512;
  #define ROWOFF(t) ((long)(MODE == 1 ? ((t) + ((t) >= 4 ? ((q0 - 128) >> 6) : 0)) : (t)) * TILEB)
  #define DMA_K(t, slot) do { if (lane < 32) glds16(ksrc + ROWOFF(t), (unsigned)__builtin_amdgcn_readfirstlane(kdst + (slot))); } while (0)
  #define DMA_V(t, slot) do { if (lane < 32) glds16(vsrc + ROWOFF(t), (unsigned)__builtin_amdgcn_readfirstlane(vdst + (slot))); } while (0)
  const lds_cptr shm3 = (lds_cptr)shm;
  const int ksw = (r32 >> 2) & 3;
  const lds_cptr fq0 = shm3 + r32 * 64 + (((2 * hi) ^ ksw) * 16), fq1 = shm3 + r32 * 64 + (((2 * hi + 1) ^ ksw) * 16);
  DMA_K(0, 0); DMA_V(0, 0); DMA_K(1, SL);
  v8i_t qf;
  { const v4i_t* qp = (const v4i_t*)(Qf8 + (size_t)(qrow + wid * QBLK + r32) * 1024 + qcol + hi * 32); const v4i_t a = qp[0], b = qp[1]; qf = (v8i_t){a[0], a[1], a[2], a[3], b[0], b[1], b[2], b[3]}; }
  f32x16 o[2]; o[0] = f32x16{}; o[1] = f32x16{}; f32x16 osum = f32x16{};
  f32x16 cinit;
  #pragma unroll
  for (int r = 0; r < 16; ++r) cinit[r] = 60.5f - 4.0f * cref;
  asm volatile("" : "+v"(cinit));
  v8i_t ones8;
  #pragma unroll
  for (int i = 0; i < 8; ++i) ones8[i] = 0x38383838;
  asm volatile("" : "+v"(ones8));
  const int qrel = wid * QBLK + r32;
  int mlo = -128, mhi = 128;
  if (MODE == 1) { const int qi = q0 + qrel; mlo = (-qi > -128) ? -qi : -128; mhi = (SEQ - 1 - qi < 128) ? (SEQ - 1 - qi) : 128; }
  const unsigned mspan = (unsigned)(mhi - mlo);
  #define CMASK(P0, P1, t) do { if (MODE == 1) { if ((t) >= 4) bandmask(P0, P1, (t), mlo, mspan, qrel, hi); } } while (0)
  #define MFQK(kfr) __builtin_amdgcn_mfma_scale_f32_32x32x64_f8f6f4(kfr, qf, cinit, 0, 0, 0, 0x7F7F7F7F, 0, 0x7F7F7F7F)
  #define MFPV(pfr, bfr, cin) __builtin_amdgcn_mfma_scale_f32_32x32x64_f8f6f4(pfr, bfr, cin, 1, 0, 0, 0x7F7F7F7F, 0, 0x7F7F7F7F)
  #define FLOAD(dst, base, b, slot) do { const v4i_t a_ = *(const LAS v4i_t*)(fq0 + (base) + (slot) + (b) * 2048), b_ = *(const LAS v4i_t*)(fq1 + (base) + (slot) + (b) * 2048); dst = (v8i_t){a_[0], a_[1], a_[2], a_[3], b_[0], b_[1], b_[2], b_[3]}; } while (0)
  #define PK4(x0, x1, x2, x3) (int)__builtin_amdgcn_cvt_pk_u8_f32(x3, 3, __builtin_amdgcn_cvt_pk_u8_f32(x2, 2, __builtin_amdgcn_cvt_pk_u8_f32(x1, 1, __builtin_amdgcn_cvt_pk_u8_f32(x0, 0, 0u))))
  #define PACKP(PF, X0, X1) do { PF[0] = PK4(X0[0], X0[1], X0[2], X0[3]); PF[1] = PK4(X0[4], X0[5], X0[6], X0[7]); PF[2] = PK4(X0[8], X0[9], X0[10], X0[11]); PF[3] = PK4(X0[12], X0[13], X0[14], X0[15]); \
                                 PF[4] = PK4(X1[0], X1[1], X1[2], X1[3]); PF[5] = PK4(X1[4], X1[5], X1[6], X1[7]); PF[6] = PK4(X1[8], X1[9], X1[10], X1[11]); PF[7] = PK4(X1[12], X1[13], X1[14], X1[15]); asm volatile("" : "+v"(PF)); } while (0)
  int sl_prev = 0, sl_cur = 0, sl_next = SL;
  #define ROT() do { sl_prev = sl_cur; sl_cur = sl_next; sl_next = (sl_next == 2 * SL) ? 0 : sl_next + SL; } while (0)
  DMA_K(2, 2 * SL);
  WAIT_BAR(3);
  v8i_t kf0, kf1, vf0, vf1, pfA, pfB;
  f32x16 x0, x1;
  FLOAD(kf0, LK, 0, 0); FLOAD(kf1, LK, 1, 0);
  x0 = MFQK(kf0); x1 = MFQK(kf1);
  CMASK(x0, x1, 0);
  PACKP(pfA, x0, x1);
  WAIT_BAR(0);
  DMA_K(3, 0); DMA_V(1, SL);
  ROT();
  FLOAD(kf0, LK, 0, sl_cur); FLOAD(kf1, LK, 1, sl_cur);
  WAIT_BAR(2);
  #define STEP(PFP, PFN, t, GK, GV, GL) do { SBAR(); \
    FLOAD(vf0, LV, 0, sl_prev); FLOAD(vf1, LV, 1, sl_prev); SBAR(); \
    x0 = MFQK(kf0); x1 = MFQK(kf1); SBAR(); \
    osum = MFPV(PFP, ones8, osum); o[0] = MFPV(PFP, vf0, o[0]); o[1] = MFPV(PFP, vf1, o[1]); SBAR(); \
    if (GK) { DMA_K((t) + 3, sl_cur); } if (GV) { DMA_V((t) + 1, sl_next); } \
    if (GL) { FLOAD(kf0, LK, 0, sl_next); FLOAD(kf1, LK, 1, sl_next); SBAR(); } \
    CMASK(x0, x1, t); \
    PACKP(PFN, x0, x1); SBAR(); \
    } while (0)
  int t = 1;
  for (; t + 5 < NT; t += 2) {
    STEP(pfA, pfB, t, true, true, true);     WAIT_BAR(2); ROT();
    STEP(pfB, pfA, t + 1, true, true, true);   WAIT_BAR(2); ROT();
  }
  #define ENDW(tt) do { if ((tt) + 3 < NT) { WAIT_BAR(2); } else if ((tt) + 2 < NT) { WAIT_BAR(1); } else { WAIT_BAR(0); } } while (0)
  for (; t + 1 < NT; t += 2) {
    STEP(pfA, pfB, t, (t + 3 < NT), (t + 1 < NT), (t + 1 < NT));       ENDW(t);   ROT();
    STEP(pfB, pfA, t + 1, (t + 4 < NT), (t + 2 < NT), (t + 2 < NT));     ENDW(t + 1); ROT();
  }
  STEP(pfA, pfB, NT - 1, false, false, false);
  { FLOAD(vf0, LV, 0, sl_cur); FLOAD(vf1, LV, 1, sl_cur); osum = MFPV(pfB, ones8, osum); o[0] = MFPV(pfB, vf0, o[0]); o[1] = MFPV(pfB, vf1, o[1]); }
  #undef PACKP
  #undef PK4
  #undef STEP
  #undef ENDW
  #undef MFQK
  #undef MFPV
  #undef FLOAD
  const float sterm = __builtin_amdgcn_exp2f(sink2 - cref);
  float rli[16];
  #pragma unroll
  for (int r = 0; r < 16; ++r) rli[r] = __builtin_amdgcn_rcpf(osum[r] + sterm);
  bf16* Ow = O + (qrow + wid * QBLK) * QP + qcol;
  { bf16* stg = (bf16*)(shm + LOST) + wid * 2048;
    #pragma unroll
    for (int r = 0; r < 16; ++r) { const int orow = crow(r, hi);
      #pragma unroll
      for (int d0 = 0; d0 < 2; ++d0) stg[orow * 64 + d0 * 32 + r32] = __float2bfloat16(o[d0][r] * rli[r]); }
    asm volatile("s_waitcnt lgkmcnt(0)" ::: "memory");
    #pragma unroll
    for (int i = 0; i < 4; ++i) { const int row = i * 8 + (lane >> 3), ch = lane & 7; const u32x4 v = *(const u32x4*)(stg + row * 64 + ch * 8); ATTN_STORE16(Ow + (long)row * QP + ch * 8, v); } }
  asm volatile("s_waitcnt lgkmcnt(0)\n\ts_barrier" ::: "memory");
  #undef DMA_K
  #undef DMA_V
  #undef ROWOFF
  #undef CMASK
  #undef ROT
}
constexpr int ATTN_LDS_BYTES = LDS_BYTES;
#undef SBAR
#undef WAIT_BAR
}

struct Args { const float* in[20]; float* out; unsigned char* ws; int ph_lo, ph_hi; };
typedef const Args __attribute__((address_space(4)))* kargp_t;
__device__ __forceinline__ kargp_t kargs() { auto p = __builtin_amdgcn_kernarg_segment_ptr(); asm volatile("" : "+s"(p)); return (kargp_t)p; }
enum { I_X = 0, I_C, I_CTX, I_CCTX, I_ADAW, I_ADAB, I_GATTN, I_GFFN, I_WIN, I_QNG, I_KNG, I_QNL, I_KNL, I_SINK, I_WOUT, I_RW, I_RB, I_WGATE, I_WUP, I_WDOWN };
struct Frame {
    LAS unsigned char* lds; volatile LAS unsigned* MISC;
    int tid, lane, wave, vcu, G;
};
#define WSP(T, off) ((T*)(kargs()->ws + (off)))
__device__ const float ROPE_INV[16] = {1.000000000e+00f, 5.623413324e-01f, 3.162277639e-01f, 1.778279394e-01f, 1.000000015e-01f, 5.623413250e-02f, 3.162277490e-02f, 1.778279431e-02f,
                                       9.999999776e-03f, 5.623413250e-03f, 3.162277630e-03f, 1.778279431e-03f, 1.000000047e-03f, 5.623413017e-04f, 3.162277571e-04f, 1.778279402e-04f};

template <int KIND> __device__ __forceinline__ int dst_row(int n) {
    if (KIND == 0) return n;
    if (KIND == 2) return ((n >> 7) << 8) + (n & 127);
    if (KIND == 3) return ((n >> 7) << 8) + 128 + (n & 127);
    int tile, wc;
    if (n < 512) { const int h = n >> 6; tile = h >> 2; wc = h & 3; }
    else if (n < 640) { tile = 4; wc = (n - 512) >> 6; }
    else if (n < 768) { tile = 4; wc = 2 + ((n - 640) >> 6); }
    else if (n < 1280) { const int h = (n - 768) >> 6; tile = 2 + (h >> 2); wc = h & 3; }
    else if (n < 1408) { tile = 5; wc = (n - 1280) >> 6; }
    else { tile = 5; wc = 2 + ((n - 1408) >> 6); }
    const int d = n & 63, bj = d >> 5, dd = d & 31, np = dd >> 4, f = dd & 15, fq = f >> 2, j = f & 3;
    return 256 * tile + 128 * bj + 32 * wc + 8 * fq + 4 * np + j;
}
template <int KIND> __device__ __forceinline__ void p0_transpose_item(const float* W, int N, bf16_t* WT, int Kd, LAS float* scr, int kb, int nb, int lane) {
    const int k0 = 64 * kb, n0 = 32 * nb;
#pragma unroll 8
    for (int i = 0; i < 32; ++i) { const int kk = 2 * i + (lane >> 5); scr[kk * 33 + (lane & 31)] = W[(size_t)(k0 + kk) * N + n0 + (lane & 31)]; }
    LDS_WAIT(); asm volatile("" ::: "memory");
    const int c = lane & 7;
#pragma unroll
    for (int j = 0; j < 4; ++j) { const int n = (lane >> 3) + 8 * j; const LAS float* s = scr + (8 * c) * 33 + n;
        u32x4 o; o.x = pk2(s[0 * 33], s[1 * 33]); o.y = pk2(s[2 * 33], s[3 * 33]); o.z = pk2(s[4 * 33], s[5 * 33]); o.w = pk2(s[6 * 33], s[7 * 33]);
        *(GAS u32x4*)(WT + (size_t)dst_row<KIND>(n0 + n) * Kd + k0 + 8 * c) = o; }
    LDS_WAIT(); asm volatile("" ::: "memory");
}
__device__ __forceinline__ void sincos_d(float ang, float& cs, float& sn) {
    const double x = (double)ang; const double kq = __builtin_rint(x * 0.63661977236758134308);
    const double r = (x - kq * 1.5707963267948966192) - kq * 6.123233995736766036e-17, r2 = r * r;
    const double s = r * (1.0 + r2 * (-1.0 / 6 + r2 * (1.0 / 120 + r2 * (-1.0 / 5040 + r2 * (1.0 / 362880 + r2 * (-1.0 / 39916800 + r2 * (1.0 / 6227020800.0)))))));
    const double c = 1.0 + r2 * (-0.5 + r2 * (1.0 / 24 + r2 * (-1.0 / 720 + r2 * (1.0 / 40320 + r2 * (-1.0 / 3628800 + r2 * (1.0 / 479001600.0 + r2 * (-1.0 / 87178291200.0)))))));
    const int q = ((int)kq) & 3;
    const double cc = (q == 0) ? c : (q == 1) ? -s : (q == 2) ? -c : s;
    const double ss = (q == 0) ? s : (q == 1) ? c : (q == 2) ? -s : -c;
    cs = (float)cc; sn = (float)ss;
}
__device__ __forceinline__ void p0_prologue(Frame& F) {
    const int gw = F.vcu * NWAVES + F.wave, NGW = F.G * NWAVES;
    {
        const float* c = kargs()->in[I_C]; const float* cctx = kargs()->in[I_CCTX]; const float* ada_w = kargs()->in[I_ADAW]; const float* ada_b = kargs()->in[I_ADAB];
        float* modv = WSP(float, WS_MODV);
        LAS float* sv = (LAS float*)(F.lds);
        LAS float* part = (LAS float*)(F.lds + 16384);
        for (int i = F.tid; i < 3072; i += NWAVES * 64) { const int v = i >> 10, k = i & 1023; const float cv = v < 2 ? c[v * 1024 + k] : cctx[k]; sv[i] = cv / (1.0f + expf(-cv)); }
        __syncthreads();
        for (int tile = F.vcu; tile < NLAYER * 96; tile += F.G) {
            const int l = tile / 96, c0 = (tile % 96) * 64;
            const float* W = ada_w + (size_t)l * 1024 * 6144 + c0 + F.lane;
            float a0 = 0.f, a1 = 0.f, a2 = 0.f; const int kb = F.wave * 128;
#pragma unroll 8
            for (int k = 0; k < 128; ++k) { const float w = W[(size_t)(kb + k) * 6144]; a0 += sv[kb + k] * w; a1 += sv[1024 + kb + k] * w; a2 += sv[2048 + kb + k] * w; }
            part[(F.wave * 3 + 0) * 64 + F.lane] = a0; part[(F.wave * 3 + 1) * 64 + F.lane] = a1; part[(F.wave * 3 + 2) * 64 + F.lane] = a2;
            __syncthreads();
            if (F.tid < 192) { const int v = F.tid >> 6, col = F.tid & 63; float s = ada_b[l * 6144 + c0 + col];
#pragma unroll
                for (int w = 0; w < 8; ++w) s += part[(w * 3 + v) * 64 + col];
                modv[(size_t)(l * 3 + v) * 6144 + c0 + col] = s; }
            __syncthreads();
        }
    }
    { float* rope = WSP(float, WS_ROPE); const int gt = F.vcu * NWAVES * 64 + F.tid; if (gt < 4096) { const int pos = gt >> 4, f = gt & 15; const float ang = (float)pos * ROPE_INV[f]; float cs, sn; sincos_d(ang, cs, sn); rope[gt * 2] = cs; rope[gt * 2 + 1] = sn; } }
    { const int gt = F.vcu * NWAVES * 64 + F.tid; if (gt < NLAYER * 256) { const int l = gt >> 8, kq = (gt >> 6) & 3, d = gt & 63; const float* src = kargs()->in[kq == 0 ? I_QNG : (kq == 1 ? I_QNL : (kq == 2 ? I_KNG : I_KNL))]; WSP(float, WS_GN)[gt] = src[l * 64 + d]; } }
    if (gw < NLAYER * 2) { const int l = gw >> 1, loc = gw & 1; float mq = fabsf(kargs()->in[loc ? I_QNL : I_QNG][l * 64 + F.lane]), mk = fabsf(kargs()->in[loc ? I_KNL : I_KNG][l * 64 + F.lane]);
#pragma unroll
        for (int o = 1; o < 64; o <<= 1) { mq = fmaxf(mq, __shfl_xor(mq, o)); mk = fmaxf(mk, __shfl_xor(mk, o)); }
        if (F.lane == 0) WSP(float, WS_BND)[gw] = 64.0f * C2 * mq * mk * 1.02f + 0.05f; }
    { u32x4* p = (u32x4*)(WSP(unsigned char, WS_KV) + (size_t)(NROW / 64) * KV_TILEB); for (int i = F.vcu * NWAVES * 64 + F.tid; i < 4 * KV_TILEB / 16; i += F.G * NWAVES * 64) p[i] = (u32x4){0u, 0u, 0u, 0u}; }
    {
        const float* x = kargs()->in[I_X]; const float* ctx = kargs()->in[I_CTX]; bf16_t* XS = WSP(bf16_t, WS_XS);
        for (int R = gw; R < NROW; R += NGW) {
            const int b = R >= RB ? 1 : 0, rr = R - b * RB;
            const float* src = rr < NCTX ? ctx + (size_t)(b * NCTX + rr) * 1024 : x + (size_t)(b * SEQ + rr - NCTX) * 1024;
            const f32x4* s4 = (const f32x4*)src + F.lane; u32x2* d2 = (u32x2*)(XS + (size_t)R * 1024) + F.lane;
            f32x4 v[4];
#pragma unroll
            for (int j = 0; j < 4; ++j) v[j] = s4[64 * j];
#pragma unroll
            for (int j = 0; j < 4; ++j) { u32x2 w; w.x = pk2(v[j][0], v[j][1]); w.y = pk2(v[j][2], v[j][3]); d2[64 * j] = w; }
        }
    }
    {
        LAS float* scr = (LAS float*)(F.lds + RING_OFF + F.wave * 16384);
        constexpr int I_IN = 4 * 768, I_OUT = 4 * 512, I_G = 64 * 256, I_U = 64 * 256, I_D = 64 * 256;
        for (int it0 = gw; it0 < I_IN + I_OUT + I_G + I_U + I_D; it0 += NGW) {
            int it = it0;
            if (it < I_IN) { const int l = it / 768, r = it % 768; p0_transpose_item<1>(kargs()->in[I_WIN] + (size_t)l * 1024 * 1536, 1536, WSP(bf16_t, WS_WIN) + (size_t)l * 1536 * 1024, 1024, scr, r / 48, r % 48, F.lane); continue; } it -= I_IN;
            if (it < I_OUT) { const int l = it / 512, r = it % 512; p0_transpose_item<0>(kargs()->in[I_WOUT] + (size_t)l * 1024 * 1024, 1024, WSP(bf16_t, WS_WOUT) + (size_t)l * 1024 * 1024, 1024, scr, r / 32, r % 32, F.lane); continue; } it -= I_OUT;
            if (it < I_G) { const int m = it / 256, r = it % 256; p0_transpose_item<2>(kargs()->in[I_WGATE] + (size_t)m * 1024 * 512, 512, WSP(bf16_t, WS_WGU) + (size_t)m * 1024 * 1024, 1024, scr, r / 16, r % 16, F.lane); continue; } it -= I_G;
            if (it < I_U) { const int m = it / 256, r = it % 256; p0_transpose_item<3>(kargs()->in[I_WUP] + (size_t)m * 1024 * 512, 512, WSP(bf16_t, WS_WGU) + (size_t)m * 1024 * 1024, 1024, scr, r / 16, r % 16, F.lane); continue; } it -= I_U;
            { const int m = it / 256, r = it % 256; p0_transpose_item<0>(kargs()->in[I_WDOWN] + (size_t)m * 512 * 1024, 1024, WSP(bf16_t, WS_WD) + (size_t)m * 1024 * 512, 512, scr, r / 32, r % 32, F.lane); }
        }
    }
}

__device__ __forceinline__ void load_row(const bf16_t* xrow, int lane, f32x4 (&h)[4]) {
    const u32x2* xr = (const u32x2*)xrow + lane;
#pragma unroll
    for (int j = 0; j < 4; ++j) { const u32x2 w = xr[64 * j]; h[j] = (f32x4){__builtin_bit_cast(float, w.x << 16), __builtin_bit_cast(float, w.x & 0xffff0000u), __builtin_bit_cast(float, w.y << 16), __builtin_bit_cast(float, w.y & 0xffff0000u)}; }
}
__device__ __forceinline__ void rms_mod(const float* g, const float* sh, const float* sc, int lane, f32x4 (&h)[4]) {
    float ss = 0.f;
#pragma unroll
    for (int j = 0; j < 4; ++j) ss += (h[j][0] * h[j][0] + h[j][1] * h[j][1]) + (h[j][2] * h[j][2] + h[j][3] * h[j][3]);
    const float rs = 1.0f / sqrtf(wave_sum(ss) * (1.0f / 1024.0f) + NORM_EPS);
#pragma unroll
    for (int j = 0; j < 4; ++j) { const f32x4 gg = ((const f32x4*)g)[lane + 64 * j], s1 = ((const f32x4*)sh)[lane + 64 * j], s2 = ((const f32x4*)sc)[lane + 64 * j];
        h[j] = (h[j] * rs * gg) * (1.0f + s2) + s1; }
}
__device__ __forceinline__ void store_row_bf16(bf16_t* orow, int lane, const f32x4 (&h)[4]) {
    u32x2* o8 = (u32x2*)orow + lane;
#pragma unroll
    for (int j = 0; j < 4; ++j) { u32x2 w; w.x = pk2(h[j][0], h[j][1]); w.y = pk2(h[j][2], h[j][3]); o8[64 * j] = w; }
}
__device__ __forceinline__ int row_mv(int R) { const int b = R >= RB ? 1 : 0; return (R - b * RB) < NCTX ? 2 : b; }

__device__ __forceinline__ void phase_norm1(Frame& F0, int l) {
    Frame F = F0; asm volatile("" : "+v"(F.tid), "+v"(F.lane), "+s"(F.wave), "+s"(F.vcu));
    const int gw = F.vcu * NWAVES + F.wave, NGW = F.G * NWAVES;
    const float* g = kargs()->in[I_GATTN] + l * 1024; const float* modv = WSP(float, WS_MODV); const bf16_t* XS = WSP(bf16_t, WS_XS); bf16_t* HN = WSP(bf16_t, WS_HN);
    f32x4 xn[4]; if (gw < NROW) load_row(XS + (size_t)gw * 1024, F.lane, xn);
    for (int R = gw; R < NROW; R += NGW) {
        const float* mv = modv + (size_t)(l * 3 + row_mv(R)) * 6144;
        f32x4 h[4];
#pragma unroll
        for (int j = 0; j < 4; ++j) h[j] = xn[j];
        if (R + NGW < NROW) load_row(XS + (size_t)(R + NGW) * 1024, F.lane, xn);
        rms_mod(g, mv + 0, mv + 1024, F.lane, h);
        store_row_bf16(HN + (size_t)R * 1024, F.lane, h);
    }
}
__device__ __forceinline__ void phase_norm2_router(Frame& F0, int l, bool lastl, bool dry = false) {
    Frame F = F0; asm volatile("" : "+v"(F.tid), "+v"(F.lane), "+s"(F.wave), "+s"(F.vcu));
    const int gw = F.vcu * NWAVES + F.wave, NGW = F.G * NWAVES;
    LAS f32x4* RW = (LAS f32x4*)(F.lds + RING_OFF);
    { const float* router_w = kargs()->in[I_RW];
      for (int idx = F.tid; idx < 4096; idx += NWAVES * 64) { const int j = idx >> 10, e = (idx >> 6) & 15, ln = idx & 63, c = 4 * ln + 256 * j;
        RW[idx] = (f32x4){router_w[(c + 0) * 16 + e], router_w[(c + 1) * 16 + e], router_w[(c + 2) * 16 + e], router_w[(c + 3) * 16 + e]}; } }
    __syncthreads();
    const float* g = kargs()->in[I_GFFN] + l * 1024; const float* router_b = kargs()->in[I_RB];
    LAS float* PS = (LAS float*)(F.lds + RING_OFF + 65536) + F.wave * (16 * 65);
    const float* modv = WSP(float, WS_MODV); const bf16_t* XS = WSP(bf16_t, WS_XS); bf16_t* HN = WSP(bf16_t, WS_HN);
    int my_cls = -1, my_tok = 0; float my_wlo = 0.f, my_whi = 0.f;
    int k = 0;
    f32x4 xn[4]; if (gw < NROW) load_row(XS + (size_t)gw * 1024, F.lane, xn);
    for (int R = gw; R < NROW; R += NGW, ++k) {
        const int mvi = row_mv(R);
        f32x4 h[4];
#pragma unroll
        for (int j = 0; j < 4; ++j) h[j] = xn[j];
        if (R + NGW < NROW) load_row(XS + (size_t)(R + NGW) * 1024, F.lane, xn);
        if (lastl && mvi == 2) continue;
        const float* mv = modv + (size_t)(l * 3 + mvi) * 6144;
        rms_mod(g, mv + 3072, mv + 4096, F.lane, h);
        store_row_bf16(HN + (size_t)R * 1024, F.lane, h);
        {
            float s[16];
#pragma unroll
            for (int e = 0; e < 16; ++e) s[e] = 0.f;
#pragma unroll
            for (int j = 0; j < 4; ++j)
#pragma unroll
                for (int e = 0; e < 16; ++e) { const f32x4 w4 = RW[(j * 16 + e) * 64 + F.lane]; s[e] += (h[j][0] * w4[0] + h[j][1] * w4[1]) + (h[j][2] * w4[2] + h[j][3] * w4[3]); }
#pragma unroll
            for (int e = 0; e < 16; ++e) PS[e * 65 + F.lane] = s[e];
        }
        float tl = 0.f;
        { const LAS float* pr = PS + (F.lane & 15) * 65 + (F.lane >> 4) * 16;
#pragma unroll
          for (int i = 0; i < 16; ++i) tl += pr[i]; }
        tl += __shfl_xor(tl, 16); tl += __shfl_xor(tl, 32);
        const float my_sc = 1.0f / (1.0f + expf(-tl)), my_sel = my_sc + router_b[F.lane & 15];
        float sc[16], sel[16];
#pragma unroll
        for (int e = 0; e < 16; ++e) { sc[e] = __builtin_bit_cast(float, __builtin_amdgcn_readlane(__builtin_bit_cast(int, my_sc), e)); sel[e] = __builtin_bit_cast(float, __builtin_amdgcn_readlane(__builtin_bit_cast(int, my_sel), e)); }
        float gs[4];
#pragma unroll
        for (int gq = 0; gq < 4; ++gq) { const float a = sel[4 * gq], b = sel[4 * gq + 1], c = sel[4 * gq + 2], d = sel[4 * gq + 3];
            const float h1 = fmaxf(a, b), l1 = fminf(a, b), h2 = fmaxf(c, d), l2 = fminf(c, d);
            gs[gq] = fmaxf(h1, h2) + fmaxf(fminf(h1, h2), fmaxf(l1, l2)); }
        int gi = 0; float bg = gs[0];
#pragma unroll
        for (int gq = 1; gq < 4; ++gq) if (gs[gq] > bg) { bg = gs[gq]; gi = gq; }
        float s4[4], c4[4];
#pragma unroll
        for (int q = 0; q < 4; ++q) { s4[q] = sel[q]; c4[q] = sc[q]; }
#pragma unroll
        for (int gq = 1; gq < 4; ++gq)
#pragma unroll
            for (int q = 0; q < 4; ++q) { s4[q] = (gi == gq) ? sel[4 * gq + q] : s4[q]; c4[q] = (gi == gq) ? sc[4 * gq + q] : c4[q]; }
        int i1 = 0; float b1 = s4[0], w1 = c4[0];
#pragma unroll
        for (int q = 1; q < 4; ++q) if (s4[q] > b1) { b1 = s4[q]; i1 = q; w1 = c4[q]; }
        int i2 = -1; float b2 = -INFINITY, w2 = 0.f;
#pragma unroll
        for (int q = 0; q < 4; ++q) if (q != i1 && (i2 < 0 || s4[q] > b2)) { b2 = s4[q]; i2 = q; w2 = c4[q]; }
        const float wsum = w1 + w2; w1 = w1 / wsum; w2 = w2 / wsum;
        const int ia = i1 < i2 ? i1 : i2, ib = i1 < i2 ? i2 : i1;
        const float wlo = i1 < i2 ? w1 : w2, whi = i1 < i2 ? w2 : w1;
        const int pidx = ia == 0 ? ib - 1 : (ia == 1 ? ib + 1 : 5);
        if (F.lane == k) { my_cls = gi * 6 + pidx; my_tok = R; my_wlo = wlo; my_whi = whi; }
    }
    if (my_cls >= 0 && !dry) {
        const unsigned pos = __hip_atomic_fetch_add(WSP(unsigned, WS_CTL) + CW_CNT + (l * NCLS + my_cls) * 64, 1u, RLX_AGENT);
        WSP(int, WS_TOK)[(size_t)my_cls * CAP + pos] = my_tok; WSP(f32x2, WS_WTS)[(size_t)my_cls * CAP + pos] = (f32x2){my_wlo, my_whi};
    }
    __syncthreads();
}
__device__ __forceinline__ int moe_tables(Frame& F0, int l) {
    Frame F = F0; asm volatile("" : "+v"(F.tid));
    LAS int* s_n = (LAS int*)(F.lds + MOE_OFF); LAS int* s_ts = s_n + 32;
    __syncthreads();
    if (F.tid < NCLS) s_n[F.tid] = (int)__hip_atomic_load(WSP(unsigned, WS_CTL) + CW_CNT + (l * NCLS + F.tid) * 64, RLX_AGENT);
    __syncthreads();
    if (F.tid == 0) { int acc = 0; for (int c = 0; c < NCLS; ++c) { s_ts[c] = acc; acc += (s_n[c] + 255) >> 8; } s_ts[NCLS] = acc; }
    __syncthreads();
    return s_ts[NCLS];
}

constexpr int NPHASE = 1 + 7 * NLAYER;
__global__ void __launch_bounds__(NWAVES * 64, 2) fwd_kernel(Args args) {
    extern __shared__ __attribute__((aligned(16))) unsigned char lds[];
    Frame F;
    F.lds = (LAS unsigned char*)lds; F.MISC = (volatile LAS unsigned*)(F.lds + MISC_OFF);
    F.tid = threadIdx.x; F.lane = F.tid & 63; F.wave = __builtin_amdgcn_readfirstlane(F.tid >> 6);
    F.G = gridDim.x; { const int bx = blockIdx.x; F.vcu = (F.G % 8 == 0) ? (bx % 8) * (F.G / 8) + bx / 8 : bx; }
    for (int u = F.tid; u < (LDS_BYTES - LDSCTL_OFF) / 4; u += NWAVES * 64) ((LAS unsigned*)(F.lds + LDSCTL_OFF))[u] = 0u;
    __syncthreads();
    const int lo = args.ph_lo, hi = args.ph_hi;
    XcdBarrier bar; bar.bar = WSP(unsigned, WS_CTL) + CW_BAR; bar.x = 0; bar.st = nullptr;
    if (hi - lo > 1) bar = xcd_barrier_post(WSP(unsigned, WS_CTL) + CW_BAR, F.MISC + 8);
#ifndef MK_EN
#define MK_EN 0xff
#endif
#define EN(k) (((MK_EN) >> (k)) & 1)
#ifndef REP_P0
#define REP_P0 1
#endif
#ifndef REP_A
#define REP_A 1
#endif
#ifndef REP_B
#define REP_B 1
#endif
#ifndef REP_C
#define REP_C 1
#endif
#ifndef REP_F
#define REP_F 1
#endif
#ifndef REP_D
#define REP_D 1
#endif
#ifndef REP_E
#define REP_E 1
#endif
#ifndef REP_G
#define REP_G 1
#endif
#define RUN(p) (lo <= (p) && (p) < hi)
#ifndef REP_BAR
#define REP_BAR 1
#endif
#define SEAM(p) do { if (RUN(p) && RUN((p) + 1)) { xcd_barrier(bar); if (REP_BAR > 1) xcd_barrier(bar); if (REP_BAR > 2) xcd_barrier(bar); } } while (0)

    if (EN(7) && RUN(0)) { for (int rep = 0; rep < REP_P0; ++rep) { p0_prologue(F); if (rep + 1 < REP_P0) xcd_barrier(bar); } SEAM(0); }

    for (int l = 0; l < NLAYER; ++l) {
        const int pb = 1 + 7 * l; const bool lastl = (l == NLAYER - 1);
        if (EN(0) && RUN(pb + 0)) { for (int rep = 0; rep < REP_A; ++rep) { phase_norm1(F, l); if (rep + 1 < REP_A) xcd_barrier(bar); } SEAM(pb + 0); }
        if (EN(1) && RUN(pb + 1)) {
            pg8::ProbDense P; P.A = WSP(const char, WS_HN); P.B = (const char*)(WSP(bf16_t, WS_WIN) + (size_t)l * 1536 * 1024); P.lda = 1024; P.ldb = 1024; P.nt = 16; P.skip_ctx = false; P.S.init(NROW, 1536, F.G, (int)blockIdx.x);
            pg8::EpiQKV E{kargs()->ws, WSP(float, WS_GN) + l * 256, WSP(float, WS_ROPE)};
            for (int rep = 0; rep < REP_B; ++rep) { pg8::gemm_phase<pg8::EpiQKV, pg8::ProbDense, true>(F.lds + RING_OFF, F.lds + OFFS_OFF, P, E); if (rep + 1 < REP_B) xcd_barrier(bar); }
            SEAM(pb + 1);
        }
        if (EN(2) && RUN(pb + 2)) {
            const unsigned char* Qf8 = WSP(const unsigned char, WS_QO); const unsigned char* KVT = WSP(const unsigned char, WS_KV); attn_body::bf16* O = WSP(attn_body::bf16, WS_HN);
            const float* sink = kargs()->in[I_SINK] + l * 8;
            const int n0 = 1024 + (lastl ? 0 : 32);
            const float bnd_g = WSP(const float, WS_BND)[l * 2], bnd_l = WSP(const float, WS_BND)[l * 2 + 1];
#if VFP8
            const float ref_g = bnd_g - 15.5f, ref_l = bnd_l - 15.5f;
#if EXPFREE
#define ATTN_BODY attn_unit_f8c
#else
#define ATTN_BODY attn_unit_f8b
#endif
#else
            const float ref_g = fmaxf(bnd_g - 96.0f, 0.0f), ref_l = fmaxf(bnd_l - 96.0f, 0.0f);
#define ATTN_BODY attn_unit_f8
#endif
            for (int rep = 0; rep < REP_C; ++rep) {
            for (int L = F.vcu; L < n0; L += F.G) {
                long qrow, kvrow; int qcol, st, NT; float sink2 = -INFINITY, ref = ref_g;
                if (L < 1024) { const int bh = L >> 6, b = bh >> 3, h = bh & 7, qb = L & 63; qrow = (long)b * RB + NCTX + qb * 256; kvrow = (long)b * RB; NT = RB / 64; qcol = h * 64; st = h >> 2; }
                else { const int Lc = L - 1024, b = Lc >> 4, h = Lc & 15; qrow = (long)b * RB; kvrow = qrow; NT = NCTX / 64; qcol = h * 64;
                    if (h < 8) { st = h >> 2; } else { const int hl = h - 8; st = 2 + (hl >> 2); sink2 = sink[hl] * LOG2E; ref = ref_l; } }
                attn_body::ATTN_BODY<0>(qrow, kvrow, 0, qcol, st, st, NT, sink2, ref, Qf8, KVT, O, (char*)lds + RING_OFF);
            }
            for (int L = F.vcu; L < 1024; L += F.G) {
                const int bh = L >> 6, b = bh >> 3, hl = bh & 7, qb = L & 63, q0 = qb * 256;
                attn_body::ATTN_BODY<1>((long)b * RB + NCTX + q0, (long)b * RB, q0, (8 + hl) * 64, 2 + (hl >> 2), 2 + (hl >> 2), 12, sink[hl] * LOG2E, ref_l, Qf8, KVT, O, (char*)lds + RING_OFF);
            }
            if (rep + 1 < REP_C) xcd_barrier(bar); }
            SEAM(pb + 2);
        }
        if (EN(3) && RUN(pb + 3)) {
            pg8::ProbDense P; P.A = WSP(const char, WS_HN); P.B = (const char*)(WSP(bf16_t, WS_WOUT) + (size_t)l * 1024 * 1024); P.lda = 1024; P.ldb = 1024; P.nt = 16; P.skip_ctx = lastl; P.S.init(lastl ? NB * SEQ : NROW, 1024, F.G, (int)blockIdx.x);
            for (int rep = 0; rep < REP_D; ++rep) {
            pg8::EpiResid E{WSP(bf16_t, WS_XS), WSP(float, WS_MODV) + (size_t)l * 3 * 6144, 2048, (rep & 1) ? -1.0f : 1.0f};
            pg8::gemm_phase<pg8::EpiResid, pg8::ProbDense, true>(F.lds + RING_OFF, F.lds + OFFS_OFF, P, E); if (rep + 1 < REP_D) xcd_barrier(bar); }
            SEAM(pb + 3);
        }
        if (EN(4) && RUN(pb + 4)) {
#if REP_E == 2
            phase_norm2_router(F, l, lastl, true); xcd_barrier(bar);
#endif
            phase_norm2_router(F, l, lastl, false); SEAM(pb + 4); }
        if (EN(5) && RUN(pb + 5)) {
            const int ntile = moe_tables(F, l);
            pg8::ProbGU P; P.A = WSP(const char, WS_HN); P.B = (const char*)(WSP(bf16_t, WS_WGU) + (size_t)l * 16 * 1024 * 1024); P.tok = WSP(int, WS_TOK); P.s_n = (const LAS int*)(F.lds + MOE_OFF); P.s_ts = P.s_n + 32;
            P.total = ntile * 8; P.G = F.G; P.c = F.vcu; P.nt = 16;
            pg8::EpiGU E{WSP(bf16_t, WS_ACT), WSP(f32x2, WS_WTS)};
            for (int rep = 0; rep < REP_F; ++rep) { pg8::gemm_phase<pg8::EpiGU, pg8::ProbGU, true>(F.lds + RING_OFF, F.lds + OFFS_OFF, P, E); if (rep + 1 < REP_F) xcd_barrier(bar); }
            SEAM(pb + 5);
        }
        if (EN(6) && RUN(pb + 6)) {
            const int ntile = moe_tables(F, l);
            pg8::ProbDown P; P.A = WSP(const char, WS_ACT); P.B = (const char*)(WSP(bf16_t, WS_WD) + (size_t)l * 16 * 1024 * 512); P.s_n = (const LAS int*)(F.lds + MOE_OFF); P.s_ts = P.s_n + 32;
            P.total = ntile * 4; P.G = F.G; P.c = F.vcu; P.nt = 16;
            for (int rep = 0; rep < REP_G; ++rep) {
            pg8::EpiDown E{WSP(bf16_t, WS_XS), lastl ? kargs()->out : nullptr, WSP(int, WS_TOK), WSP(float, WS_MODV) + (size_t)l * 3 * 6144, (rep & 1) ? -1.0f : 1.0f};
            pg8::gemm_phase<pg8::EpiDown, pg8::ProbDown, true>(F.lds + RING_OFF, F.lds + OFFS_OFF, P, E); if (rep + 1 < REP_G) xcd_barrier(bar); }
            SEAM(pb + 6);
        }
    }
#undef RUN
#undef SEAM
}

#ifndef MK_SPLIT
#define MK_SPLIT 0
#endif
extern "C" void kernel_launch(void* const* d_in, const int* in_sizes, int n_in, void* d_out, int out_size, void* d_ws, size_t ws_size, hipStream_t stream) {
    static int grid = 0;
    if (grid == 0) {
        if (n_in != 20 || in_sizes[0] != NB * SEQ * DM || out_size != NB * SEQ * DM || ws_size < WS_END) {
            fprintf(stderr, "kernel_launch: unexpected shapes (n_in %d, in0 %d, out %d, ws %zu); nothing launched\n", n_in, n_in > 0 ? in_sizes[0] : -1, out_size, ws_size); grid = -1; return; }
        int dev = 0, cus = 0, per_cu = 0;
        if (hipGetDevice(&dev) != hipSuccess || hipDeviceGetAttribute(&cus, hipDeviceAttributeMultiprocessorCount, dev) != hipSuccess) { grid = -1; return; }
        if (hipFuncSetAttribute((const void*)fwd_kernel, hipFuncAttributeMaxDynamicSharedMemorySize, LDS_BYTES) != hipSuccess) { fprintf(stderr, "kernel_launch: hipFuncSetAttribute failed\n"); grid = -1; return; }
        if (hipOccupancyMaxActiveBlocksPerMultiprocessor(&per_cu, (const void*)fwd_kernel, NWAVES * 64, LDS_BYTES) != hipSuccess || per_cu < 1)
            fprintf(stderr, "kernel_launch: note: occupancy query reports %d workgroups per CU\n", per_cu);
        (void)hipGetLastError();
        grid = cus;
    }
    if (grid < 0) return;
    if (hipMemsetAsync((char*)d_ws + WS_CTL, 0, CTL_ZERO_BYTES, stream) != hipSuccess) return;
    Args a{};
    for (int i = 0; i < 20; ++i) a.in[i] = (const float*)d_in[i];
    a.out = (float*)d_out; a.ws = (unsigned char*)d_ws;
#if MK_SPLIT
    for (int p = 0; p < NPHASE; ++p) { a.ph_lo = p; a.ph_hi = p + 1; hipLaunchKernelGGL(fwd_kernel, dim3(grid), dim3(NWAVES * 64), LDS_BYTES, stream, a); }
#else
    a.ph_lo = 0; a.ph_hi = NPHASE;
    hipLaunchKernelGGL(fwd_kernel, dim3(grid), dim3(NWAVES * 64), LDS_BYTES, stream, a);
#endif
    const hipError_t le = hipPeekAtLastError();
    if (le != hipSuccess) fprintf(stderr, "kernel_launch: launch failed: %s\n", hipGetErrorName(le));
}
```

```cpp
#include <hip/hip_runtime.h>
#include <hip/hip_bf16.h>
#include <cstdio>
#include <cstdint>
#include <cmath>

#define LAS __attribute__((address_space(3)))
#define GAS __attribute__((address_space(1)))
typedef unsigned short bf16_t;
typedef short bf16x8 __attribute__((ext_vector_type(8)));
typedef float f32x4 __attribute__((ext_vector_type(4)));
typedef float f32x2 __attribute__((ext_vector_type(2)));
typedef unsigned u32x4 __attribute__((ext_vector_type(4)));
typedef unsigned u32x2 __attribute__((ext_vector_type(2)));
typedef GAS unsigned gu32;

constexpr int NB = 2, SEQ = 16384, DM = 1024, NCTX = 256, NLAYER = 4, NEXP = 16, DEXP = 512;
constexpr int RB = SEQ + NCTX;
constexpr int NROW = NB * RB;
constexpr int NCLS = 24, CAP = NROW;
constexpr int MAXSLOT = 39424;
constexpr float NORM_EPS = 1e-6f;
constexpr float C2 = 0.125f * 1.4426950408889634f;
constexpr float LOG2E = 1.4426950408889634f;
#ifndef VFP8
#define VFP8 1
#endif
#ifndef EXPFREE
#define EXPFREE 1
#endif
constexpr int KV_VSL = VFP8 ? 4096 : 8192, KV_TILEB = 16384 + 4 * KV_VSL;
constexpr float SQC2 = 0.42466090014400953f;

constexpr size_t MiB = 1u << 20;
constexpr size_t WS_CTL = 0, CTL_ZERO_BYTES = 1 * MiB;
constexpr size_t WS_MODV = 1 * MiB;
constexpr size_t WS_ROPE = 2 * MiB;
constexpr size_t WS_GN = 3 * MiB;
constexpr size_t WS_BND = 3 * MiB + 8192;
constexpr size_t WS_TOK = 4 * MiB;
constexpr size_t WS_WTS = 8 * MiB;
constexpr size_t WS_WIN = 16 * MiB;
constexpr size_t WS_WOUT = 28 * MiB;
constexpr size_t WS_WGU = 36 * MiB;
constexpr size_t WS_WD = 164 * MiB;
constexpr size_t WS_XS = 228 * MiB;
constexpr size_t WS_HN = 358 * MiB;
constexpr size_t WS_QO = 423 * MiB;
constexpr size_t WS_KV = 488 * MiB;
constexpr size_t WS_ACT = 423 * MiB;
constexpr size_t WS_END = 522 * MiB;
static_assert(WS_TOK + (size_t)NCLS * CAP * 4 <= WS_WTS && WS_WTS + (size_t)NCLS * CAP * 8 <= WS_WIN, "lists");
static_assert(WS_KV + (size_t)(NROW + 256) * 512 * 2 <= WS_END && WS_ACT + (size_t)MAXSLOT * 1024 * 2 <= WS_END, "ws map");
constexpr int CW_TMO = 0, CW_CODE = 1, CW_BAR = 4096, CW_CNT = 8192;

constexpr int RING_OFF = 0, RING_BYTES = 131072;
constexpr int LDSCTL_OFF = RING_BYTES, MISC_OFF = LDSCTL_OFF + 320, MOE_OFF = LDSCTL_OFF + 1024, OFFS_OFF = LDSCTL_OFF + 2048  ;
constexpr int LDS_BYTES = 147456;
constexpr int NWAVES = 8;

#define LDS_WAIT() asm volatile("s_waitcnt lgkmcnt(0)" ::: "memory")
#define VM_WAIT() asm volatile("s_waitcnt vmcnt(0)" ::: "memory")
#define RLX_AGENT __ATOMIC_RELAXED, __HIP_MEMORY_SCOPE_AGENT

__device__ __forceinline__ unsigned f2bf(float f) { unsigned u = __builtin_bit_cast(unsigned, f); return (u + 0x7fffu + ((u >> 16) & 1u)) >> 16; }
__device__ __forceinline__ unsigned pk2(float lo, float hi) { return f2bf(lo) | (f2bf(hi) << 16); }
__device__ __forceinline__ unsigned cvt_pk_bf16(float lo, float hi) { unsigned r; asm volatile("v_cvt_pk_bf16_f32 %0, %1, %2" : "=v"(r) : "v"(lo), "v"(hi)); return r; }
__device__ __forceinline__ float wave_sum(float v) {
#pragma unroll
    for (int o = 1; o < 64; o <<= 1) v += __shfl_xor(v, o);
    return v;
}

#define XB_TMO      128
#define XB_XCNT(j)  (256  + 64 * (j))
#define XB_XSUB(j)  (1280 + 64 * (j))
#define XB_XGEN(j)  (2304 + 64 * (j))
#define XB_TOP      3328
#define XB_TOPGEN   3392
#define XCD_BAR_WORDS 3456
#define XB_SPIN_CAP (1u << 22)
__device__ __forceinline__ unsigned xb_ld(unsigned* p)              { return __hip_atomic_load(p, __ATOMIC_RELAXED, __HIP_MEMORY_SCOPE_AGENT); }
__device__ __forceinline__ unsigned xb_add(unsigned* p, unsigned v) { return __hip_atomic_fetch_add(p, v, __ATOMIC_RELAXED, __HIP_MEMORY_SCOPE_AGENT); }
__device__ __forceinline__ unsigned xb_xcc_id() { return (unsigned)__builtin_amdgcn_s_getreg((3 << 11) | 20) & 0xFu; }
#define XB_SPIN(cond, bar) do { unsigned _sp = 0; while (cond) { __builtin_amdgcn_s_sleep(1); \
    if ((++_sp & 255u) == 0u) { if (xb_ld(&(bar)[XB_TMO])) break; if (_sp > XB_SPIN_CAP) { atomicAdd(&(bar)[XB_TMO], 1u); break; } } } } while (0)
struct XcdBarrier { unsigned* bar; unsigned x; volatile LAS unsigned* st; };
__device__ __forceinline__ XcdBarrier xcd_barrier_post(unsigned* bar, volatile LAS unsigned* st) {
    XcdBarrier b; b.bar = bar; b.x = xb_xcc_id(); b.st = st;
    if (threadIdx.x == 0) (void)xb_add(&bar[XB_XCNT(b.x)], 1u);
    return b;
}
__device__ __forceinline__ void xcd_barrier_complete(unsigned* bar, unsigned x, unsigned& nloc, unsigned& nx) {
    const unsigned G = gridDim.x * gridDim.y * gridDim.z;
    unsigned sum, cnt, mine, sp = 0u;
    for (;;) {
        sum = 0u; cnt = 0u; mine = 0u;
#pragma unroll
        for (unsigned j = 0; j < 16; ++j) { const unsigned c = xb_ld(&bar[XB_XCNT(j)]); sum += c; cnt += (c > 0u) ? 1u : 0u; mine = (j == x) ? c : mine; }
        if (sum == G) break;
        __builtin_amdgcn_s_sleep(1);
        if ((++sp & 255u) == 0u) { if (xb_ld(&bar[XB_TMO])) break; if (sp > XB_SPIN_CAP) { atomicAdd(&bar[XB_TMO], 1u); break; } }
    }
    nloc = mine > 0u ? mine : 1u; nx = cnt > 0u ? cnt : 1u;
}
__device__ __forceinline__ void xcd_barrier(const XcdBarrier& b) {
    asm volatile("s_waitcnt vmcnt(0)" ::: "memory");
    __syncthreads();
    if (threadIdx.x == 0) {
        unsigned* bar = b.bar;
        __builtin_amdgcn_s_waitcnt(0);
        unsigned nloc = b.st[0], nx = b.st[1];
        if (nloc == 0u) { xcd_barrier_complete(bar, b.x, nloc, nx); b.st[0] = nloc; b.st[1] = nx; }
        const unsigned old = xb_add(&bar[XB_XSUB(b.x)], 1u);
        const unsigned gen = old / nloc;
        if (old + 1u == (gen + 1u) * nloc) {
            __builtin_amdgcn_fence(__ATOMIC_RELEASE, "agent");
            asm volatile("s_waitcnt vmcnt(0)" ::: "memory");
            const unsigned og = xb_add(&bar[XB_TOP], 1u);
            const unsigned tg = og / nx;
            if (og + 1u == (tg + 1u) * nx) xb_add(&bar[XB_TOPGEN], 1u);
            else XB_SPIN(xb_ld(&bar[XB_TOPGEN]) == tg, bar);
            __builtin_amdgcn_fence(__ATOMIC_ACQUIRE, "agent");
            xb_add(&bar[XB_XGEN(b.x)], 1u);
            asm volatile("s_waitcnt vmcnt(0)" ::: "memory");
        } else {
            XB_SPIN(xb_ld(&bar[XB_XGEN(b.x)]) == gen, bar);
            __builtin_amdgcn_fence(__ATOMIC_ACQUIRE, "agent");
            asm volatile("s_waitcnt vmcnt(0)" ::: "memory");
        }
    }
    __syncthreads();
}

namespace pg8 {
constexpr int BM = 256, BK = 64, HALF = 128, HTB = HALF * BK * 2, STAGE_BYTES = 8 * HTB, NXCD = 8, WGM = 8;
__host__ __device__ __forceinline__ int lds_byte(int r, int c) { const int st = (r >> 4) * 2 + (c >> 5), rr = r & 15, cc = c & 31, ob = rr * 64 + cc * 2; return st * 1024 + (ob ^ (((ob >> 9) & 1) << 5)); }
__host__ __device__ __forceinline__ void stage_rc(int b, int& R, int& C) { const int st = b / 1024, sb = b % 1024, swz = sb ^ (((sb >> 9) & 1) << 5); R = (st >> 1) * 16 + swz / 64; C = (st & 1) * 32 + (swz % 64) / 2; }
__host__ __device__ __forceinline__ int perm32(int rho) { const int n = rho >> 4, i = rho & 15; return 8 * (i >> 2) + 4 * n + (i & 3); }

struct Unit { int pm, pn, cls, row0, ncls, elo, ehi; };

struct StaticOrder {
    int nM, nN, nwg, G, c;
    __device__ void init(int M, int N, int G_, int c_) { nM = M / BM; nN = N / BM; nwg = nM * nN; G = G_; c = c_; }
    __device__ __forceinline__ bool next(int i, Unit& u) const {
        const long L = (long)i * G + c; if (L >= nwg) return false;
        int wgid = (int)L; { const int q = nwg / NXCD, r = nwg % NXCD, xcd = wgid % NXCD, off = wgid / NXCD; wgid = (xcd < r ? xcd * (q + 1) : r * (q + 1) + (xcd - r) * q) + off; }
        const int nig = WGM * nN, gid = wgid / nig, fm = gid * WGM, gsz = (nM - fm) < WGM ? (nM - fm) : WGM;
        u.pm = fm + ((wgid % nig) % gsz); u.pn = (wgid % nig) / gsz; u.cls = 0; u.row0 = 0; u.ncls = 0; u.elo = 0; u.ehi = 0; return true;
    }
};

struct ProbDense {
    const char* A; const char* B; int lda, ldb, nt; StaticOrder S; bool skip_ctx;
    __device__ __forceinline__ bool next(int i, Unit& u) const { if (!S.next(i, u)) return false; if (skip_ctx) u.pm += 1 + (u.pm >= 64 ? 1 : 0); return true; }
    __device__ __forceinline__ void a_offs(const Unit& u, int tid, unsigned (&off)[2][2]) const {
#pragma unroll
        for (int i = 0; i < 2; ++i) { int R, C; stage_rc(tid * 16 + i * 8192, R, C);
#pragma unroll
            for (int h = 0; h < 2; ++h) off[h][i] = (unsigned)((u.pm * BM + h * HALF + R) * lda + C) * 2u; }
    }
    __device__ __forceinline__ const char* b_ptr(const Unit& u, int t) const { return B + (size_t)u.pn * BM * ldb * 2 + (size_t)t * (BK * 2); }
};
__device__ __forceinline__ void moe_unit(const LAS int* s_n, const LAS int* s_ts, int rt, Unit& u) {
    int cc = 0; while (s_ts[cc + 1] <= rt) ++cc;
    u.pm = rt; u.cls = cc; u.row0 = (rt - s_ts[cc]) * BM; u.ncls = s_n[cc];
    const int g = cc / 6, idx = cc % 6; const int a = idx < 3 ? 0 : (idx < 5 ? 1 : 2), b = idx < 3 ? idx + 1 : (idx < 5 ? idx - 1 : 3);
    u.elo = 4 * g + a; u.ehi = 4 * g + b;
}
struct ProbGU {
    const char* A; const char* B; const int* tok; const LAS int* s_n; const LAS int* s_ts; int total, G, c; static constexpr int ldb = 1024; int nt;
    __device__ __forceinline__ bool next(int i, Unit& u) const { const long L = (long)i * G + c; if (L >= total) return false; u.pn = (int)(L & 7); moe_unit(s_n, s_ts, (int)(L >> 3), u); return true; }
    __device__ __forceinline__ void a_offs(const Unit& u, int tid, unsigned (&off)[2][2]) const {
#pragma unroll
        for (int i = 0; i < 2; ++i) { int R, C; stage_rc(tid * 16 + i * 8192, R, C);
#pragma unroll
            for (int h = 0; h < 2; ++h) { int r = u.row0 + h * HALF + R; r = r < u.ncls ? r : u.ncls - 1; const int t = tok[(size_t)u.cls * CAP + r]; off[h][i] = (unsigned)t * 2048u + (unsigned)C * 2u; } }
    }
    __device__ __forceinline__ const char* b_ptr(const Unit& u, int t) const { const int e = u.pn >= 4 ? u.ehi : u.elo; return B + (size_t)e * (1024 * 1024 * 2) + (size_t)(u.pn & 3) * (BM * 1024 * 2) + (size_t)t * (BK * 2); }
};
struct ProbDown {
    const char* A; const char* B; const LAS int* s_n; const LAS int* s_ts; int total, G, c; static constexpr int ldb = 512; int nt;
    __device__ __forceinline__ bool next(int i, Unit& u) const { const long L = (long)i * G + c; if (L >= total) return false; u.pn = (int)(L & 3); moe_unit(s_n, s_ts, (int)(L >> 2), u); return true; }
    __device__ __forceinline__ void a_offs(const Unit& u, int tid, unsigned (&off)[2][2]) const {
#pragma unroll
        for (int i = 0; i < 2; ++i) { int R, C; stage_rc(tid * 16 + i * 8192, R, C);
#pragma unroll
            for (int h = 0; h < 2; ++h) off[h][i] = (unsigned)(u.pm * BM + h * HALF + R) * 2048u + (unsigned)C * 2u; }
    }
    __device__ __forceinline__ const char* b_ptr(const Unit& u, int t) const { const int e = t < 8 ? u.elo : u.ehi; return B + (size_t)e * (1024 * 512 * 2) + (size_t)u.pn * (BM * 512 * 2) + (size_t)(t & 7) * (BK * 2); }
};

template <class Epi, class Prob, bool ALIGN_EPI>
__device__ __forceinline__ void gemm_phase(LAS unsigned char* lds, LAS unsigned char* offs_lds, const Prob& P, const Epi& E) {
    int tid_ = threadIdx.x; asm volatile("" : "+v"(tid_));
    const int tid = tid_, wid = __builtin_amdgcn_readfirstlane(tid >> 6), lane = tid & 63, wr = wid >> 2, wc = wid & 3, fr = lane & 15, fq = lane >> 4;
    const int nt = P.nt;
    unsigned voffB[2];
#pragma unroll
    for (int i = 0; i < 2; ++i) { int R, C; stage_rc(tid * 16 + i * 8192, R, C); const int Rb = Epi::PERM ? ((R & ~31) + perm32(R & 31)) : R; voffB[i] = (unsigned)(Rb * P.ldb + C) * 2u; }
    LAS u32x4* const myoffs = (LAS u32x4*)offs_lds + tid;
    const size_t hstepB = (size_t)HALF * P.ldb * 2;
    const unsigned ldsw = (unsigned)wid * 1024u;
    const int aoff = lds_byte(wr * 64 + fr, fq * 8), boff = lds_byte(wc * 32 + fr, fq * 8);
    const char* const Ab = P.A;
#define PG8_SA(b, h) (((b) * 2 + (h)) * HTB)
#define PG8_SB(b, h) ((4 + (b) * 2 + (h)) * HTB)
#define PG8_STAGE_A(bufoff, h, offs, kt) do { _Pragma("unroll") for (int _i = 0; _i < 2; ++_i) \
        __builtin_amdgcn_global_load_lds((const unsigned*)(Ab + (size_t)(offs)[h][_i] + (size_t)(kt) * (BK * 2)), (LAS unsigned*)(lds + (bufoff) + ldsw + _i * 8192), 16, 0, 0); } while (0)
#define PG8_STAGE_B(bufoff, bp) do { _Pragma("unroll") for (int _i = 0; _i < 2; ++_i) \
        __builtin_amdgcn_global_load_lds((const unsigned*)((bp) + voffB[_i]), (LAS unsigned*)(lds + (bufoff) + ldsw + _i * 8192), 16, 0, 0); } while (0)
#define PG8_LDA(dst, b, h) do { _Pragma("unroll") for (int m = 0; m < 4; ++m) _Pragma("unroll") for (int k = 0; k < 2; ++k) dst[m][k] = *(const LAS bf16x8*)(lds + PG8_SA(b, h) + aoff + m * 2048 + k * 1024); } while (0)
#define PG8_LDB(dst, b, h) do { _Pragma("unroll") for (int n = 0; n < 2; ++n) _Pragma("unroll") for (int k = 0; k < 2; ++k) dst[n][k] = *(const LAS bf16x8*)(lds + PG8_SB(b, h) + boff + n * 2048 + k * 1024); } while (0)
#define PG8_MMA(ai, bj, At, Bt) do { __builtin_amdgcn_s_setprio(1); _Pragma("unroll") for (int m = 0; m < 4; ++m) _Pragma("unroll") for (int n = 0; n < 2; ++n) _Pragma("unroll") for (int k = 0; k < 2; ++k) \
        acc[ai][bj][m][n] = __builtin_amdgcn_mfma_f32_16x16x32_bf16(Bt[n][k], At[m][k], acc[ai][bj][m][n], 0, 0, 0); __builtin_amdgcn_s_setprio(0); } while (0)
#define PG8_WAIT_V(n) asm volatile("s_waitcnt vmcnt(" #n ")" ::: "memory")
#define PG8_WAIT_L(n) asm volatile("s_waitcnt lgkmcnt(" #n ")" ::: "memory")
#define PG8_BAR __builtin_amdgcn_s_barrier()
#define PG8_SCHED __builtin_amdgcn_sched_barrier(0)
    Unit cur, nxt; int ui = 0;
    if (!P.next(0, cur)) return;
    f32x4 acc[2][2][4][2];
#pragma unroll
    for (int a = 0; a < 2; ++a)
#pragma unroll
        for (int b = 0; b < 2; ++b)
#pragma unroll
            for (int m = 0; m < 4; ++m)
#pragma unroll
                for (int n = 0; n < 2; ++n) acc[a][b][m][n] = (f32x4){0.f, 0.f, 0.f, 0.f};
    bf16x8 At[4][2], B0[2][2], B1[2][2];
    unsigned offC[2][2];
    P.a_offs(cur, tid, offC);
    {
        const char* b0 = P.b_ptr(cur, 0); const char* b1 = P.b_ptr(cur, 1);
        PG8_STAGE_B(PG8_SB(0, 0), b0); PG8_STAGE_B(PG8_SB(0, 1), b0 + hstepB); PG8_STAGE_A(PG8_SA(0, 0), 0, offC, 0); PG8_STAGE_A(PG8_SA(0, 1), 1, offC, 0);
        if (wr == 1) PG8_BAR;
        PG8_WAIT_V(2); PG8_BAR;
        PG8_STAGE_B(PG8_SB(1, 0), b1); PG8_STAGE_A(PG8_SA(1, 0), 0, offC, 1); PG8_STAGE_B(PG8_SB(1, 1), b1 + hstepB);
        PG8_WAIT_V(6); PG8_BAR;
    }
    for (;;) {
        const bool has_next = P.next(ui + 1, nxt);
        if (!has_next) nxt = cur;
        {
            unsigned offN[2][2];
            if (has_next) P.a_offs(nxt, tid, offN);
            else {
#pragma unroll
                for (int h = 0; h < 2; ++h)
#pragma unroll
                    for (int i = 0; i < 2; ++i) offN[h][i] = offC[h][i];
            }
            *myoffs = (u32x4){offN[0][0], offN[0][1], offN[1][0], offN[1][1]};
        }
        for (int t = 0; t < nt; t += 2) {
            const bool last = (t == nt - 2);
            const int k2 = last ? 0 : t + 2;
            const char* b2 = last ? P.b_ptr(nxt, 0) : P.b_ptr(cur, t + 2);
            const char* b3 = last ? P.b_ptr(nxt, 1) : P.b_ptr(cur, t + 3);
            PG8_LDB(B0, 0, 0); PG8_LDB(B1, 0, 1); PG8_SCHED; PG8_LDA(At, 0, 0); PG8_STAGE_A(PG8_SA(1, 1), 1, offC, t + 1);
            if (last) { const u32x4 v = *myoffs; offC[0][0] = v.x; offC[0][1] = v.y; offC[1][0] = v.z; offC[1][1] = v.w; }
            PG8_WAIT_V(8); PG8_WAIT_L(0); PG8_BAR; PG8_MMA(0, 0, At, B0); PG8_MMA(0, 1, At, B1); PG8_BAR; PG8_SCHED;
            PG8_LDA(At, 0, 1); PG8_STAGE_B(PG8_SB(0, 0), b2); PG8_STAGE_B(PG8_SB(0, 1), b2 + hstepB); PG8_STAGE_A(PG8_SA(0, 0), 0, offC, k2);
            PG8_WAIT_V(8); PG8_WAIT_L(0); PG8_BAR; PG8_MMA(1, 0, At, B0); PG8_MMA(1, 1, At, B1); PG8_BAR; PG8_SCHED;
            PG8_LDB(B0, 1, 0); PG8_LDB(B1, 1, 1); PG8_SCHED; PG8_LDA(At, 1, 0); PG8_STAGE_A(PG8_SA(0, 1), 1, offC, k2);
            PG8_WAIT_V(8); PG8_WAIT_L(0); PG8_BAR; PG8_MMA(0, 0, At, B0); PG8_MMA(0, 1, At, B1); PG8_BAR; PG8_SCHED;
            PG8_LDA(At, 1, 1); PG8_STAGE_B(PG8_SB(1, 0), b3); PG8_STAGE_B(PG8_SB(1, 1), b3 + hstepB); PG8_STAGE_A(PG8_SA(1, 0), 0, offC, k2 + 1);
            PG8_WAIT_V(8); PG8_WAIT_L(0); PG8_BAR; PG8_MMA(1, 0, At, B0); PG8_MMA(1, 1, At, B1); PG8_BAR; PG8_SCHED;
        }
        if constexpr (ALIGN_EPI) { if (wr == 0) PG8_BAR; }
        E(acc, cur, wr, wc, fr, fq);
        if (!has_next) break;
#pragma unroll
        for (int a = 0; a < 2; ++a)
#pragma unroll
            for (int b = 0; b < 2; ++b)
#pragma unroll
                for (int m = 0; m < 4; ++m)
#pragma unroll
                    for (int n = 0; n < 2; ++n) acc[a][b][m][n] = (f32x4){0.f, 0.f, 0.f, 0.f};
        cur = nxt; ++ui;
        if constexpr (ALIGN_EPI) { if (wr == 1) PG8_BAR; }
    }
    PG8_WAIT_V(0);
    if constexpr (!ALIGN_EPI) { if (wr == 0) PG8_BAR; }
    PG8_BAR;
#undef PG8_SA
#undef PG8_SB
#undef PG8_STAGE_A
#undef PG8_STAGE_B
#undef PG8_LDA
#undef PG8_LDB
#undef PG8_MMA
#undef PG8_WAIT_V
#undef PG8_WAIT_L
#undef PG8_BAR
#undef PG8_SCHED
}
}

namespace pg8 {
struct EpiQKV {
    static constexpr bool PERM = true;
    unsigned char* ws; const float* gn; const float* rope;
    __device__ __forceinline__ void operator()(const f32x4 (&acc)[2][2][4][2], const Unit& u, int wr, int wc, int fr, int fq) const {
        const int pn = u.pn, tb_ = u.pm % 65;
        const bool is_ctx = (tb_ == 0);
        const bool isV = (pn >= 4) && (wc >= 2);
        const float* gain = gn + (pn < 2 ? 0 : (pn < 4 ? 64 : (pn == 4 ? 128 : 192)));
        const int strm = 2 * (pn - 4) + (wc & 1);
#pragma unroll
        for (int ai = 0; ai < 2; ++ai)
#pragma unroll
            for (int m = 0; m < 4; ++m) {
                int mfr = m * 16 + fr; asm volatile("" : "+v"(mfr));
                const int row = u.pm * BM + ai * HALF + wr * 64 + mfr;
                f32x4 v[2][2];
#pragma unroll
                for (int bj = 0; bj < 2; ++bj)
#pragma unroll
                    for (int n = 0; n < 2; ++n) v[bj][n] = acc[ai][bj][m][n];
                if (!isV) {
                    float ss = 0.f;
#pragma unroll
                    for (int bj = 0; bj < 2; ++bj)
#pragma unroll
                        for (int n = 0; n < 2; ++n) { const f32x4 x = v[bj][n]; ss += (x[0] * x[0] + x[1] * x[1]) + (x[2] * x[2] + x[3] * x[3]); }
                    ss += __shfl_xor(ss, 16); ss += __shfl_xor(ss, 32);
                    const float rs = ((EXPFREE && pn < 4) ? 4.0f * SQC2 : SQC2) / sqrtf(ss * (1.0f / 64.0f) + NORM_EPS);
#pragma unroll
                    for (int bj = 0; bj < 2; ++bj)
#pragma unroll
                        for (int n = 0; n < 2; ++n) v[bj][n] = v[bj][n] * rs * *(const f32x4*)(gain + 32 * bj + 16 * n + 4 * fq);
                    if (!is_ctx) {
                        const int pr = (tb_ - 1) * 4 + 2 * ai + wr, pc = mfr;
#pragma unroll
                        for (int bj = 0; bj < 2; ++bj) {
                            const int pos = bj ? pc : pr;
                            const f32x4* rp = (const f32x4*)(rope + (size_t)(pos * 16 + 4 * fq) * 2);
                            const f32x4 r0 = rp[0], r1 = rp[1];
                            const f32x4 cs = (f32x4){r0[0], r0[2], r1[0], r1[2]}, sn = (f32x4){r0[1], r0[3], r1[1], r1[3]};
                            const f32x4 x1 = v[bj][0], x2 = v[bj][1];
                            v[bj][0] = x1 * cs - x2 * sn; v[bj][1] = x2 * cs + x1 * sn;
                        }
                    }
                }
                if (pn < 4) {
                    unsigned char* rowp = ws + WS_QO + (size_t)row * 1024 + 256 * pn + 64 * wc + 4 * fq;
#pragma unroll
                    for (int bj = 0; bj < 2; ++bj)
#pragma unroll
                        for (int n = 0; n < 2; ++n) { int w = __builtin_amdgcn_cvt_pk_fp8_f32(v[bj][n][0], v[bj][n][1], 0, false); w = __builtin_amdgcn_cvt_pk_fp8_f32(v[bj][n][2], v[bj][n][3], w, true);
                            *(int*)(rowp + 32 * bj + 16 * n) = w; }
                } else {
                    unsigned char* tb = ws + WS_KV + (size_t)(u.pm * 4 + ai * 2 + wr) * KV_TILEB + (isV ? 16384 + strm * KV_VSL : strm * 4096);
                    if (!isV) {
                        const int kk = mfr; const unsigned kof = (unsigned)(kk * 64 + 4 * fq), ksw = (unsigned)((kk >> 2) & 3);
#pragma unroll
                        for (int bj = 0; bj < 2; ++bj)
#pragma unroll
                            for (int n = 0; n < 2; ++n) { int w = __builtin_amdgcn_cvt_pk_fp8_f32(v[bj][n][0], v[bj][n][1], 0, false); w = __builtin_amdgcn_cvt_pk_fp8_f32(v[bj][n][2], v[bj][n][3], w, true);
                                *(int*)(tb + (kof + (((unsigned)(2 * bj + n) ^ ksw) * 16u))) = w; }
                    } else {
#if VFP8
                        const int kk = mfr, uu = kk >> 5, w5 = kk & 31, hh = (w5 >> 2) & 1, jb = (w5 & 3) + 4 * (w5 >> 3);
                        const unsigned vof = (unsigned)(4 * fq * 64 + (((2 * hh + uu) ^ fq) * 16) + jb);
#pragma unroll
                        for (int bj = 0; bj < 2; ++bj)
#pragma unroll
                            for (int n = 0; n < 2; ++n)
#pragma unroll
                                for (int jp = 0; jp < 2; ++jp) { const int w = __builtin_amdgcn_cvt_pk_fp8_f32(v[bj][n][2 * jp], v[bj][n][2 * jp + 1], 0, false);
                                    *(unsigned char*)(tb + (vof + (unsigned)((32 * bj + 16 * n + 2 * jp) * 64))) = (unsigned char)w; *(unsigned char*)(tb + (vof + (unsigned)((32 * bj + 16 * n + 2 * jp + 1) * 64))) = (unsigned char)(w >> 8); }
#else
                        const int fr_ = mfr & 15, m_ = mfr >> 4, sub = fr_ >> 2, hb = sub & 1;
                        const unsigned vbase = (unsigned)(4 * fq * 128 + (4 * (sub >> 1) + (fr_ & 3)) * 2);
#pragma unroll
                        for (int j = 0; j < 4; ++j) { const int swz = (2 * fq + (j >> 1)) & 7;
                            const unsigned vof = vbase + (unsigned)(j * 128) + (unsigned)((((2 * m_) ^ (swz & 6)) | ((hb ^ swz) & 1)) * 16);
#pragma unroll
                            for (int bj = 0; bj < 2; ++bj)
#pragma unroll
                                for (int n = 0; n < 2; ++n) *(bf16_t*)(tb + (vof + (unsigned)((32 * bj + 16 * n) * 128))) = (bf16_t)f2bf(v[bj][n][j]); }
#endif
                    }
                }
            }
    }
};
__device__ __forceinline__ float bf_lo(unsigned w) { return __builtin_bit_cast(float, w << 16); }
__device__ __forceinline__ float bf_hi(unsigned w) { return __builtin_bit_cast(float, w & 0xffff0000u); }
struct EpiResid {
    static constexpr bool PERM = true;
    bf16_t* XS; const float* modv_l; int goff; float sgn;
    __device__ __forceinline__ void operator()(const f32x4 (&acc)[2][2][4][2], const Unit& u, int wr, int wc, int fr, int fq) const {
        const int mv = (u.pm % 65 == 0) ? 2 : (u.pm / 65);
        const float* g = modv_l + mv * 6144 + goff;
        const int col0 = u.pn * BM + wc * 32 + 8 * fq;
        f32x4 gv[2][2];
#pragma unroll
        for (int bj = 0; bj < 2; ++bj)
#pragma unroll
            for (int n = 0; n < 2; ++n) gv[bj][n] = *(const f32x4*)(g + col0 + bj * HALF + n * 4) * sgn;
#pragma unroll
        for (int ai = 0; ai < 2; ++ai)
#pragma unroll
            for (int m = 0; m < 4; ++m) {
                bf16_t* rowp = XS + (size_t)(u.pm * BM + ai * HALF + wr * 64 + m * 16 + fr) * 1024 + col0;
#pragma unroll
                for (int bj = 0; bj < 2; ++bj) { u32x4* p = (u32x4*)(rowp + bj * HALF); const u32x4 w = *p; u32x4 o;
                    const f32x4 a0 = gv[bj][0] * acc[ai][bj][m][0], a1 = gv[bj][1] * acc[ai][bj][m][1];
                    o.x = cvt_pk_bf16(bf_lo(w.x) + a0[0], bf_hi(w.x) + a0[1]); o.y = cvt_pk_bf16(bf_lo(w.y) + a0[2], bf_hi(w.y) + a0[3]);
                    o.z = cvt_pk_bf16(bf_lo(w.z) + a1[0], bf_hi(w.z) + a1[1]); o.w = cvt_pk_bf16(bf_lo(w.w) + a1[2], bf_hi(w.w) + a1[3]);
                    *p = o; }
            }
    }
};
struct EpiGU {
    static constexpr bool PERM = true;
    bf16_t* ACT; const f32x2* wts;
    __device__ __forceinline__ void operator()(const f32x4 (&acc)[2][2][4][2], const Unit& u, int wr, int wc, int fr, int fq) const {
        const int k = u.pn >= 4 ? 1 : 0, jt = u.pn & 3;
        const int colbase = 512 * k + 128 * jt + 32 * wc + 8 * fq;
#pragma unroll
        for (int ai = 0; ai < 2; ++ai)
#pragma unroll
            for (int m = 0; m < 4; ++m) {
                const int r = ai * HALF + wr * 64 + m * 16 + fr;
                int idx = u.row0 + r; idx = idx < u.ncls ? idx : u.ncls - 1;
                const f32x2 w2 = wts[(size_t)u.cls * CAP + idx];
                const float w = k ? w2[1] : w2[0];
                u32x4 o;
#pragma unroll
                for (int n = 0; n < 2; ++n) {
                    const f32x4 g = acc[ai][0][m][n], up = acc[ai][1][m][n]; float a[4];
#pragma unroll
                    for (int j = 0; j < 4; ++j) { const float sg = g[j] * __builtin_amdgcn_rcpf(1.0f + __builtin_amdgcn_exp2f(-g[j] * LOG2E)); a[j] = w * sg * up[j]; }
                    const unsigned lo = cvt_pk_bf16(a[0], a[1]), hi = cvt_pk_bf16(a[2], a[3]);
                    if (n == 0) { o.x = lo; o.y = hi; } else { o.z = lo; o.w = hi; }
                }
                *(u32x4*)(ACT + (size_t)(u.pm * BM + r) * 1024 + colbase) = o;
            }
    }
};
struct EpiDown {
    static constexpr bool PERM = true;
    bf16_t* XS; float* out; const int* tok; const float* modv_l; float sgn;
    __device__ __forceinline__ void operator()(const f32x4 (&acc)[2][2][4][2], const Unit& u, int wr, int wc, int fr, int fq) const {
        const int col0 = u.pn * BM + wc * 32 + 8 * fq;
#pragma unroll
        for (int ai = 0; ai < 2; ++ai)
#pragma unroll
            for (int m = 0; m < 4; ++m) {
                const int idx = u.row0 + ai * HALF + wr * 64 + m * 16 + fr;
                if (idx < u.ncls) {
                    const int t = tok[(size_t)u.cls * CAP + idx];
                    const int b = t >= RB ? 1 : 0, rr = t - b * RB;
                    const int mv = rr < NCTX ? 2 : b;
                    const float* g = modv_l + mv * 6144 + 5120 + col0;
                    bf16_t* xp = XS + (size_t)t * 1024 + col0;
                    float* op = out + (size_t)(b * SEQ + rr - NCTX) * 1024 + col0;
#pragma unroll
                    for (int bj = 0; bj < 2; ++bj) { const u32x4 w = *(const u32x4*)(xp + bj * HALF);
                        const f32x4 a0 = (*(const f32x4*)(g + bj * HALF) * sgn) * acc[ai][bj][m][0], a1 = (*(const f32x4*)(g + bj * HALF + 4) * sgn) * acc[ai][bj][m][1];
                        const f32x4 x0 = (f32x4){bf_lo(w.x) + a0[0], bf_hi(w.x) + a0[1], bf_lo(w.y) + a0[2], bf_hi(w.y) + a0[3]}, x1 = (f32x4){bf_lo(w.z) + a1[0], bf_hi(w.z) + a1[1], bf_lo(w.w) + a1[2], bf_hi(w.w) + a1[3]};
                        if (out) { *(f32x4*)(op + bj * HALF) = x0; *(f32x4*)(op + bj * HALF + 4) = x1; }
                        else { u32x4 o; o.x = cvt_pk_bf16(x0[0], x0[1]); o.y = cvt_pk_bf16(x0[2], x0[3]); o.z = cvt_pk_bf16(x1[0], x1[1]); o.w = cvt_pk_bf16(x1[2], x1[3]); *(u32x4*)(xp + bj * HALF) = o; }
                    }
                }
            }
    }
};
}

namespace attn_body {
using bf16 = __hip_bfloat16;
using s16x4 = __attribute__((ext_vector_type(4))) short;
using f32x16 = __attribute__((ext_vector_type(16))) float;
constexpr int D = 64, QP = 1024, KP = 512;
constexpr int NW = 8, QBLK = 32, QB = QBLK * NW, KVBLK = 64;
__device__ __forceinline__ int crow(int r, int hi) { return (r & 3) + 8 * (r >> 2) + 4 * hi; }
#define SBAR() __builtin_amdgcn_sched_barrier(0)
constexpr int NSLOT = 3, SLOTB = 8192;
constexpr int LDS_K = 0, LDS_V = NSLOT * SLOTB, LDS_WS = 2 * NSLOT * SLOTB, LDS_OST = LDS_WS + NW * 64 * 4, LDS_BYTES = LDS_OST + NW * 4096;
__device__ __forceinline__ void glds16(const void* gsrc, unsigned lds_dst) { unsigned keep;
  asm volatile("s_mov_b32 %0, m0\n\ts_mov_b32 m0, %2\n\ts_nop 0\n\tglobal_load_lds_dwordx4 %1, off\n\ts_mov_b32 m0, %0" : "=&s"(keep) : "v"(gsrc), "s"(lds_dst) : "memory"); }
__device__ __forceinline__ void glds16h(const void* gsrc, unsigned lds_dst) { unsigned keep;
  asm volatile("s_mov_b32 %0, m0\n\ts_mov_b32 m0, %2\n\ts_mov_b32 exec_hi, 0\n\tglobal_load_lds_dwordx4 %1, off\n\ts_mov_b32 exec_hi, -1\n\ts_mov_b32 m0, %0" : "=&s"(keep) : "v"(gsrc), "s"(lds_dst) : "memory"); }
__device__ __forceinline__ float max3f(float a, float b, float c) { float r; asm("v_max3_f32 %0, %1, %2, %3" : "=v"(r) : "v"(a), "v"(b), "v"(c)); return r; }
__device__ __forceinline__ float max2f(float a, float b) { float r; asm("v_max_f32_e32 %0, %1, %2" : "=v"(r) : "v"(a), "v"(b)); return r; }
__device__ __forceinline__ float fadd_s(float a, float b) { float r; asm("v_add_f32_e32 %0, %1, %2" : "=v"(r) : "v"(a), "v"(b)); return r; }
__device__ __forceinline__ float fsub_s(float a, float b) { float r; asm("v_sub_f32_e32 %0, %1, %2" : "=v"(r) : "v"(a), "v"(b)); return r; }
typedef float f32x2_t __attribute__((ext_vector_type(2))); typedef __bf16 bf16x2_t __attribute__((ext_vector_type(2)));
__device__ __forceinline__ unsigned cvtpk_s(float lo, float hi) { f32x2_t v = {lo, hi}; bf16x2_t b = __builtin_convertvector(v, bf16x2_t); return __builtin_bit_cast(unsigned, b); }
#define WAIT_BAR(N) asm volatile("s_waitcnt vmcnt(" #N ") lgkmcnt(0)\n\ts_barrier" ::: "memory")

__device__ __forceinline__ void qkt(f32x16& p0, f32x16& p1, const char* Kslot, const bf16x8* qr, const f32x16& negm, int r32, int hi) {
  const char* kb = Kslot + hi * 1024 + r32 * 16;
  #pragma unroll
  for (int d0 = 0; d0 < 4; ++d0) {
    const bf16x8 b0 = *reinterpret_cast<const bf16x8*>(kb + d0 * 2048);
    const bf16x8 b1 = *reinterpret_cast<const bf16x8*>(kb + d0 * 2048 + 512);
    if (d0 == 0) { p0 = __builtin_amdgcn_mfma_f32_32x32x16_bf16(b0, qr[0], negm, 0, 0, 0); p1 = __builtin_amdgcn_mfma_f32_32x32x16_bf16(b1, qr[0], negm, 0, 0, 0); }
    else { p0 = __builtin_amdgcn_mfma_f32_32x32x16_bf16(b0, qr[d0], p0, 0, 0, 0); p1 = __builtin_amdgcn_mfma_f32_32x32x16_bf16(b1, qr[d0], p1, 0, 0, 0); } }
}
typedef __attribute__((address_space(3))) const char* lds_cptr;
typedef short v4i16_t __attribute__((ext_vector_type(4)));
__device__ __forceinline__ void kload8(bf16x8* kf, lds_cptr kp) {
  kf[0] = *(const LAS bf16x8*)(kp);        kf[1] = *(const LAS bf16x8*)(kp + 512);
  kf[2] = *(const LAS bf16x8*)(kp + 2048); kf[3] = *(const LAS bf16x8*)(kp + 2560);
  kf[4] = *(const LAS bf16x8*)(kp + 4096); kf[5] = *(const LAS bf16x8*)(kp + 4608);
  kf[6] = *(const LAS bf16x8*)(kp + 6144); kf[7] = *(const LAS bf16x8*)(kp + 6656);
}
__device__ __forceinline__ void kload2(bf16x8* kf, lds_cptr kp, int j) { kf[2 * j] = *(const LAS bf16x8*)(kp + j * 2048); kf[2 * j + 1] = *(const LAS bf16x8*)(kp + j * 2048 + 512); }
__device__ __forceinline__ s16x4 vtr(lds_cptr p) { return __builtin_bit_cast(s16x4, __builtin_amdgcn_ds_read_tr16_b64_v4i16((LAS v4i16_t*)p)); }
__device__ __forceinline__ float rowmax(const f32x16& p0, const f32x16& p1) {
  float a = max3f(p0[0], p0[1], p1[0]), b = max3f(p0[2], p0[3], p1[1]); a = max3f(a, p1[2], p1[3]);
  #pragma unroll
  for (int r = 4; r < 16; r += 4) { a = max3f(a, p0[r], p0[r + 1]); b = max3f(b, p0[r + 2], p0[r + 3]); a = max3f(a, p1[r], p1[r + 1]); b = max3f(b, p1[r + 2], p1[r + 3]); }
  const float m = max2f(a, b);
  auto rr = __builtin_amdgcn_permlane32_swap(__float_as_uint(m), __float_as_uint(m), false, false);
  return max2f(__uint_as_float(rr[0]), __uint_as_float(rr[1]));
}
__device__ __forceinline__ void pv(f32x16* o, int vb, bf16x8 pa0, bf16x8 pa1, bf16x8 pa2, bf16x8 pa3) {
  #pragma unroll
  for (int d0 = 0; d0 < 2; ++d0) { s16x4 lo[4], hi[4];
    #pragma unroll
    for (int ks = 0; ks < 4; ++ks) {
      asm volatile("ds_read_b64_tr_b16 %0,%1 offset:%c2" : "=&v"(lo[ks]) : "v"(vb), "i"(d0 * 4096 + ks * 1024) : "memory");
      asm volatile("ds_read_b64_tr_b16 %0,%1 offset:%c2" : "=&v"(hi[ks]) : "v"(vb), "i"(d0 * 4096 + ks * 1024 + 512) : "memory"); }
    asm volatile("s_waitcnt lgkmcnt(0)" ::: "memory"); SBAR();
    #define PK(k) (bf16x8){lo[k][0], lo[k][1], lo[k][2], lo[k][3], hi[k][0], hi[k][1], hi[k][2], hi[k][3]}
    o[d0] = __builtin_amdgcn_mfma_f32_32x32x16_bf16(pa0, PK(0), o[d0], 0, 0, 0);
    o[d0] = __builtin_amdgcn_mfma_f32_32x32x16_bf16(pa1, PK(1), o[d0], 0, 0, 0);
    o[d0] = __builtin_amdgcn_mfma_f32_32x32x16_bf16(pa2, PK(2), o[d0], 0, 0, 0);
    o[d0] = __builtin_amdgcn_mfma_f32_32x32x16_bf16(pa3, PK(3), o[d0], 0, 0, 0);
    #undef PK
  }
}
__device__ __forceinline__ void pv2(f32x16* o, const lds_cptr* vq, int slot, bf16x8 pa0, bf16x8 pa1, bf16x8 pa2, bf16x8 pa3) {
  #pragma unroll
  for (int d0 = 0; d0 < 2; ++d0) {
    const bf16x8 v0 = *(const LAS bf16x8*)(vq[0] + slot + d0 * 4096), v1 = *(const LAS bf16x8*)(vq[1] + slot + d0 * 4096), v2 = *(const LAS bf16x8*)(vq[2] + slot + d0 * 4096), v3 = *(const LAS bf16x8*)(vq[3] + slot + d0 * 4096);
    o[d0] = __builtin_amdgcn_mfma_f32_32x32x16_bf16(pa0, v0, o[d0], 0, 0, 0);
    o[d0] = __builtin_amdgcn_mfma_f32_32x32x16_bf16(pa1, v1, o[d0], 0, 0, 0);
    o[d0] = __builtin_amdgcn_mfma_f32_32x32x16_bf16(pa2, v2, o[d0], 0, 0, 0);
    o[d0] = __builtin_amdgcn_mfma_f32_32x32x16_bf16(pa3, v3, o[d0], 0, 0, 0);
  }
}
__device__ __forceinline__ void bandmask(f32x16& p0, f32x16& p1, int t, int mlo, unsigned mspan, int qrel, int hi) {
  const float NEG = -INFINITY; const int kb = 64 * (t - 4) - 128 + 4 * hi - qrel - mlo;
  #pragma unroll
  for (int r = 0; r < 16; ++r) { const int d0 = kb + (r & 3) + 8 * (r >> 2); if ((unsigned)d0 > mspan) p0[r] = NEG; if ((unsigned)(d0 + 32) > mspan) p1[r] = NEG; }
}
#ifndef FASTEXP
#define FASTEXP 0
#endif
__device__ __forceinline__ float exp2_fast(float x) { const float t = __builtin_fmaf(x, 8388608.0f, 1064986823.0f); unsigned u; asm("v_cvt_u32_f32 %0, %1" : "=v"(u) : "v"(t)); return __builtin_bit_cast(float, u); }
#define ATTN_STORE16(p, v) (*(u32x4*)(p) = (v))

template <int MODE, int THRL> __device__ __forceinline__ void attn_unit(long qrow, long kvrow, int q0, int qcol, int kcol, int vcol, int NT, float sink2, const bf16* Q, const bf16* __restrict__ KVb, bf16* O, char* shm) {
  int tid_ = threadIdx.x; asm volatile("" : "+v"(tid_));
  const int tid = tid_, lane = tid & 63, r32 = lane & 31, hi = lane >> 5; const int wid = __builtin_amdgcn_readfirstlane(tid >> 6);
  const bf16* Qw = Q + (qrow + wid * QBLK) * QP + qcol;
  const char* kvt = (const char*)KVb + (size_t)(kvrow >> 6) * 65536 + wid * 1024 + lane * 16;
  const unsigned lds0 = (unsigned)(uintptr_t)shm;
  float* wsf = (float*)(shm + LDS_WS) + wid * 64;
  const char* ksrc = kvt + kcol * 8192; const char* vsrc = kvt + vcol * 8192;
  const unsigned kdst = lds0 + LDS_K + wid * 1024, vdst = lds0 + LDS_V + wid * 1024;
  #define ROWOFF(t) ((long)(MODE == 1 ? ((t) + ((t) >= 4 ? ((q0 - 128) >> 6) : 0)) : (t)) * 65536)
  #define DMA_K(t, slot) glds16(ksrc + ROWOFF(t), (unsigned)__builtin_amdgcn_readfirstlane(kdst + (slot)))
  #define DMA_V(t, slot) glds16(vsrc + ROWOFF(t), (unsigned)__builtin_amdgcn_readfirstlane(vdst + (slot)))
  const char* Kbase = shm + LDS_K; bf16x8 kf[8];
  const lds_cptr shm3 = (lds_cptr)shm; const lds_cptr kp0 = shm3 + LDS_K + hi * 1024 + r32 * 16; lds_cptr vq[4];
  { const int swz = (r32 >> 1) & 7; _Pragma("unroll") for (int ks_ = 0; ks_ < 4; ++ks_) vq[ks_] = shm3 + LDS_V + r32 * 128 + (((2 * ks_ + hi) ^ swz) * 16); }
  DMA_K(0, 0); DMA_V(0, 0); DMA_K(1, SLOTB);
  bf16x8 qr[4];
  #pragma unroll
  for (int d0 = 0; d0 < 4; ++d0) qr[d0] = *reinterpret_cast<const bf16x8*>(&Qw[(long)r32 * QP + d0 * 16 + hi * 8]);
  float mhat = 0.f, l_reg = 0.f; f32x16 o[2]; o[0] = f32x16{}; o[1] = f32x16{}; f32x16 negm = f32x16{}; asm volatile("" : "+v"(negm));
  const int qrel = wid * QBLK + r32;
  int mlo = -128, mhi = 128;
  if (MODE == 1) { const int qi = q0 + qrel; mlo = (-qi > -128) ? -qi : -128; mhi = (SEQ - 1 - qi < 128) ? (SEQ - 1 - qi) : 128; }
  const unsigned mspan = (unsigned)(mhi - mlo);
  #define CMASK(P0, P1, t) do { if (MODE == 1) { if ((t) >= 4) bandmask(P0, P1, (t), mlo, mspan, qrel, hi); } } while (0)
  bool resc = false;
  #define START(P0, P1) do { const float rm = rowmax(P0, P1); resc = false; \
    { const float dl = rm; mhat = fadd_s(mhat, dl); \
      _Pragma("unroll") for (int r = 0; r < 16; ++r) { P0[r] = fsub_s(P0[r], dl); P1[r] = fsub_s(P1[r], dl); } \
      _Pragma("unroll") for (int r = 0; r < 16; ++r) negm[r] = -mhat; asm volatile("" : "+v"(negm)); } \
    _Pragma("unroll") for (int r = 0; r < 16; ++r) P0[r] = __builtin_amdgcn_exp2f(P0[r]); } while (0)
  #define RESC() do { if (resc) { asm volatile("s_waitcnt lgkmcnt(0)" ::: "memory"); \
      _Pragma("unroll") for (int d_ = 0; d_ < 2; ++d_) _Pragma("unroll") for (int r = 0; r < 16; ++r) o[d_][r] *= wsf[crow(r, hi)]; } } while (0)
  f32x16 pA0, pA1, pB0, pB1;
  int sl_prev = 0, sl_cur = 0, sl_next = SLOTB;
  #define ROT() do { sl_prev = sl_cur; sl_cur = sl_next; sl_next = (sl_next == (NSLOT - 1) * SLOTB) ? 0 : sl_next + SLOTB; } while (0)
  DMA_K(2, 2 * SLOTB);
  WAIT_BAR(3);
  qkt(pA0, pA1, Kbase, qr, negm, r32, hi); asm volatile("s_nop 15\n\ts_nop 7" : "+v"(pA0), "+v"(pA1)); CMASK(pA0, pA1, 0);
  START(pA0, pA1);
  _Pragma("unroll") for (int r = 0; r < 16; ++r) pA1[r] = __builtin_amdgcn_exp2f(pA1[r]);
  WAIT_BAR(0);
  DMA_K(3, 0); DMA_V(1, SLOTB);
  ROT();
  kload8(kf, kp0 + sl_cur);
  WAIT_BAR(2);
  bf16x8 vfr[8]; u32x4 pw0, pw1, pw2, pw3;
  #define PKW(P, B) cvtpk_s(P[B], P[B + 1])
  #define PAF(k) __builtin_bit_cast(bf16x8, pw##k)
  #define VFR(i) vfr[i]
  #define PIN(x) asm volatile("" : "+v"(x))
  #define MX3(a, b, c) __builtin_fmaxf(__builtin_fmaxf((a), (b)), (c))
  #define GAPA(MF, A0, A1, A2, A3, W0, W1, PW) do { MF; sacc += A0; sacc += A1; sacc += A2; sacc += A3; PIN(sacc); W0; W1; PIN(PW); SBAR(); } while (0)
  #define EX(v) __builtin_amdgcn_exp2f(v)
  #define GAPB(MF, X, B) do { MF; X[B] = EX(X[B]); X[B + 1] = EX(X[B + 1]); X[B + 2] = EX(X[B + 2]); X[B + 3] = EX(X[B + 3]); PIN(X); SBAR(); } while (0)
  #define VRD(i) do { vfr[i] = *(const LAS bf16x8*)(vq[(i) & 3] + vsl_ + ((i) >> 2) * 4096); } while (0)
  #define KRD(G, j) do { if (G) { kload2(kf, kp0 + sl_next, j); SBAR(); } } while (0)
  #define STEP(C0, C1, P0, P1, t, GK, GV, GL) do { SBAR(); \
    const int vsl_ = sl_prev; \
    VRD(0); SBAR(); float sacc = (P0[0] + P0[1]); \
    GAPA(C0 = __builtin_amdgcn_mfma_f32_32x32x16_bf16(kf[0], qr[0], negm, 0, 0, 0), P0[2], P0[3], P0[4], P0[5],     pw0[0] = PKW(P0, 0), pw0[1] = PKW(P0, 2), pw0); \
    VRD(4); SBAR(); GAPA(C1 = __builtin_amdgcn_mfma_f32_32x32x16_bf16(kf[1], qr[0], negm, 0, 0, 0), P0[6], P0[7], P0[8], P0[9],     pw0[2] = PKW(P0, 4), pw0[3] = PKW(P0, 6), pw0); \
    VRD(1); SBAR(); GAPA(C0 = __builtin_amdgcn_mfma_f32_32x32x16_bf16(kf[2], qr[1], C0, 0, 0, 0),   P0[10], P0[11], P0[12], P0[13], pw1[0] = PKW(P0, 8), pw1[1] = PKW(P0, 10), pw1); \
    VRD(5); SBAR(); GAPA(C1 = __builtin_amdgcn_mfma_f32_32x32x16_bf16(kf[3], qr[1], C1, 0, 0, 0),   P0[14], P0[15], P1[0], P1[1],   pw1[2] = PKW(P0, 12), pw1[3] = PKW(P0, 14), pw1); \
    VRD(2); SBAR(); GAPA(C0 = __builtin_amdgcn_mfma_f32_32x32x16_bf16(kf[4], qr[2], C0, 0, 0, 0),   P1[2], P1[3], P1[4], P1[5],     pw2[0] = PKW(P1, 0), pw2[1] = PKW(P1, 2), pw2); \
    VRD(6); SBAR(); GAPA(C1 = __builtin_amdgcn_mfma_f32_32x32x16_bf16(kf[5], qr[2], C1, 0, 0, 0),   P1[6], P1[7], P1[8], P1[9],     pw2[2] = PKW(P1, 4), pw2[3] = PKW(P1, 6), pw2); \
    VRD(3); SBAR(); GAPA(C0 = __builtin_amdgcn_mfma_f32_32x32x16_bf16(kf[6], qr[3], C0, 0, 0, 0),   P1[10], P1[11], P1[12], P1[13], pw3[0] = PKW(P1, 8), pw3[1] = PKW(P1, 10), pw3); \
    VRD(7); SBAR(); GAPA(C1 = __builtin_amdgcn_mfma_f32_32x32x16_bf16(kf[7], qr[3], C1, 0, 0, 0),   P1[14], P1[15], 0.f, 0.f,       pw3[2] = PKW(P1, 12), pw3[3] = PKW(P1, 14), pw3); \
    l_reg += sacc; \
    if (GK) { DMA_K((t) + 3, sl_cur); } if (GV) { DMA_V((t) + 1, sl_next); } \
    CMASK(C0, C1, t); \
    { float a = MX3(C0[0], C0[1], C1[0]), b = MX3(C0[2], C0[3], C1[1]); a = MX3(a, C1[2], C1[3]); \
      _Pragma("unroll") for (int r = 4; r < 16; r += 4) { a = MX3(a, C0[r], C0[r + 1]); b = MX3(b, C0[r + 2], C0[r + 3]); a = MX3(a, C1[r], C1[r + 1]); b = MX3(b, C1[r + 2], C1[r + 3]); } \
      float rm = __builtin_fmaxf(a, b); { auto rr = __builtin_amdgcn_permlane32_swap(__float_as_uint(rm), __float_as_uint(rm), false, false); rm = __builtin_fmaxf(__uint_as_float(rr[0]), __uint_as_float(rr[1])); } \
      resc = false; \
      if (__builtin_expect(__any(rm > (float)THRL), 0)) { const float dl = __builtin_fmaxf(rm, 0.f); mhat += dl; \
        _Pragma("unroll") for (int r = 0; r < 16; ++r) { C0[r] -= dl; C1[r] -= dl; } \
        _Pragma("unroll") for (int r = 0; r < 16; ++r) negm[r] = -mhat; asm volatile("" : "+v"(negm)); \
        const float f = __builtin_amdgcn_exp2f(-dl); l_reg *= f; if (hi == 0) wsf[r32] = f; resc = true; } } \
    SBAR(); \
    GAPB(o[0] = __builtin_amdgcn_mfma_f32_32x32x16_bf16(PAF(0), VFR(0), o[0], 0, 0, 0), C0, 0); \
    GAPB(o[1] = __builtin_amdgcn_mfma_f32_32x32x16_bf16(PAF(0), VFR(4), o[1], 0, 0, 0), C0, 4); \
    KRD(GL, 0); GAPB(o[0] = __builtin_amdgcn_mfma_f32_32x32x16_bf16(PAF(1), VFR(1), o[0], 0, 0, 0), C0, 8); \
    KRD(GL, 1); GAPB(o[1] = __builtin_amdgcn_mfma_f32_32x32x16_bf16(PAF(1), VFR(5), o[1], 0, 0, 0), C0, 12); \
    KRD(GL, 2); GAPB(o[0] = __builtin_amdgcn_mfma_f32_32x32x16_bf16(PAF(2), VFR(2), o[0], 0, 0, 0), C1, 0); \
    KRD(GL, 3); GAPB(o[1] = __builtin_amdgcn_mfma_f32_32x32x16_bf16(PAF(2), VFR(6), o[1], 0, 0, 0), C1, 4); \
    GAPB(o[0] = __builtin_amdgcn_mfma_f32_32x32x16_bf16(PAF(3), VFR(3), o[0], 0, 0, 0), C1, 8); \
    GAPB(o[1] = __builtin_amdgcn_mfma_f32_32x32x16_bf16(PAF(3), VFR(7), o[1], 0, 0, 0), C1, 12); \
    } while (0)
  int t = 1;
  for (; t + 5 < NT; t += 2) {
    STEP(pB0, pB1, pA0, pA1, t, true, true, true);     WAIT_BAR(2); RESC(); ROT();
    STEP(pA0, pA1, pB0, pB1, t + 1, true, true, true);   WAIT_BAR(2); RESC(); ROT();
  }
  #define ENDW(tt) do { if ((tt) + 3 < NT) { WAIT_BAR(2); } else if ((tt) + 2 < NT) { WAIT_BAR(1); } else { WAIT_BAR(0); } } while (0)
  for (; t + 1 < NT; t += 2) {
    STEP(pB0, pB1, pA0, pA1, t, (t + 3 < NT), (t + 1 < NT), (t + 1 < NT));       ENDW(t);   RESC(); ROT();
    STEP(pA0, pA1, pB0, pB1, t + 1, (t + 4 < NT), (t + 2 < NT), (t + 2 < NT));     ENDW(t + 1); RESC(); ROT();
  }
  STEP(pB0, pB1, pA0, pA1, NT - 1, false, false, false); RESC();
  { float sacc = pB0[0] + pB0[1]; _Pragma("unroll") for (int r = 2; r < 16; ++r) sacc += pB0[r]; _Pragma("unroll") for (int r = 0; r < 16; ++r) sacc += pB1[r]; l_reg += sacc;
    pw0 = (u32x4){PKW(pB0, 0), PKW(pB0, 2), PKW(pB0, 4), PKW(pB0, 6)}; pw1 = (u32x4){PKW(pB0, 8), PKW(pB0, 10), PKW(pB0, 12), PKW(pB0, 14)}; pw2 = (u32x4){PKW(pB1, 0), PKW(pB1, 2), PKW(pB1, 4), PKW(pB1, 6)}; pw3 = (u32x4){PKW(pB1, 8), PKW(pB1, 10), PKW(pB1, 12), PKW(pB1, 14)};
    SBAR(); pv2(o, vq, sl_cur, PAF(0), PAF(1), PAF(2), PAF(3)); }
  #undef PKW
  #undef PAF
  #undef VFR
  #undef PIN
  #undef MX3
  #undef GAPA
  #undef GAPB
  #undef EX
  #undef VRD
  #undef KRD
  #undef STEP
  #undef ENDW
  { auto rr = __builtin_amdgcn_permlane32_swap(__float_as_uint(l_reg), __float_as_uint(l_reg), false, false); l_reg = __uint_as_float(rr[0]) + __uint_as_float(rr[1]); }
  l_reg += __builtin_amdgcn_exp2f(sink2 - mhat);
  if (hi == 0) wsf[32 + r32] = l_reg; asm volatile("s_waitcnt lgkmcnt(0)" ::: "memory");
  float rli[16];
  #pragma unroll
  for (int r = 0; r < 16; ++r) rli[r] = __builtin_amdgcn_rcpf(wsf[32 + crow(r, hi)]);
  bf16* Ow = O + (qrow + wid * QBLK) * QP + qcol;
  { bf16* stg = (bf16*)(shm + LDS_OST) + wid * 2048;
    #pragma unroll
    for (int r = 0; r < 16; ++r) { const int orow = crow(r, hi);
      #pragma unroll
      for (int d0 = 0; d0 < 2; ++d0) stg[orow * 64 + d0 * 32 + r32] = __float2bfloat16(o[d0][r] * rli[r]); }
    asm volatile("s_waitcnt lgkmcnt(0)" ::: "memory");
    #pragma unroll
    for (int i = 0; i < 4; ++i) { const int row = i * 8 + (lane >> 3), ch = lane & 7; const u32x4 v = *(const u32x4*)(stg + row * 64 + ch * 8); ATTN_STORE16(Ow + (long)row * QP + ch * 8, v); } }
  asm volatile("s_waitcnt lgkmcnt(0)\n\ts_barrier" ::: "memory");
  #undef DMA_K
  #undef DMA_V
  #undef ROWOFF
  #undef CMASK
  #undef START
  #undef RESC
  #undef ROT
}
template <int MODE, int XV = 0> __device__ __forceinline__ void attn_unit_sb(long qrow, long kvrow, int q0, int qcol, int kcol, int vcol, int NT, float sink2, float bound, const bf16* Q, const bf16* __restrict__ KVb, bf16* O, char* shm) {
  int tid_ = threadIdx.x; asm volatile("" : "+v"(tid_));
  const int tid = tid_, lane = tid & 63, r32 = lane & 31, hi = lane >> 5; const int wid = __builtin_amdgcn_readfirstlane(tid >> 6);
  const bf16* Qw = Q + (qrow + wid * QBLK) * QP + qcol;
  const char* kvt = (const char*)KVb + (size_t)(kvrow >> 6) * 65536 + wid * 1024 + lane * 16;
  const unsigned lds0 = (unsigned)(uintptr_t)shm;
  const char* ksrc = kvt + kcol * 8192; const char* vsrc = kvt + vcol * 8192;
  const unsigned kdst = lds0 + LDS_K + wid * 1024, vdst = lds0 + LDS_V + wid * 1024;
  #define ROWOFF(t) ((long)(MODE == 1 ? ((t) + ((t) >= 4 ? ((q0 - 128) >> 6) : 0)) : (t)) * 65536)
  #define DMA_K(t, slot) glds16(ksrc + ROWOFF(t), (unsigned)__builtin_amdgcn_readfirstlane(kdst + (slot)))
  #define DMA_V(t, slot) glds16(vsrc + ROWOFF(t), (unsigned)__builtin_amdgcn_readfirstlane(vdst + (slot)))
  const char* Kbase = shm + LDS_K; bf16x8 kf[8];
  const lds_cptr shm3 = (lds_cptr)shm; const lds_cptr kp0 = shm3 + LDS_K + hi * 1024 + r32 * 16; lds_cptr vq[4];
  { const int swz = (r32 >> 1) & 7; _Pragma("unroll") for (int ks_ = 0; ks_ < 4; ++ks_) vq[ks_] = shm3 + LDS_V + r32 * 128 + (((2 * ks_ + hi) ^ swz) * 16); }
  DMA_K(0, 0); DMA_V(0, 0); DMA_K(1, SLOTB);
  bf16x8 qr[4];
  #pragma unroll
  for (int d0 = 0; d0 < 4; ++d0) qr[d0] = *reinterpret_cast<const bf16x8*>(&Qw[(long)r32 * QP + d0 * 16 + hi * 8]);
  f32x16 o[2]; o[0] = f32x16{}; o[1] = f32x16{}; f32x16 osum = f32x16{};
  const f32x16 negm = f32x16{};
  bf16x8 ones;
  #pragma unroll
  for (int i = 0; i < 8; ++i) ones[i] = (short)0x3F80;
  asm volatile("" : "+v"(ones));
  const int qrel = wid * QBLK + r32;
  int mlo = -128, mhi = 128;
  if (MODE == 1) { const int qi = q0 + qrel; mlo = (-qi > -128) ? -qi : -128; mhi = (SEQ - 1 - qi < 128) ? (SEQ - 1 - qi) : 128; }
  const unsigned mspan = (unsigned)(mhi - mlo);
  #define CMASK(P0, P1, t) do { if (MODE == 1) { if ((t) >= 4) bandmask(P0, P1, (t), mlo, mspan, qrel, hi); } } while (0)
  f32x16 pA0, pA1, pB0, pB1;
  int sl_prev = 0, sl_cur = 0, sl_next = SLOTB;
  #define ROT() do { sl_prev = sl_cur; sl_cur = sl_next; sl_next = (sl_next == (NSLOT - 1) * SLOTB) ? 0 : sl_next + SLOTB; } while (0)
  DMA_K(2, 2 * SLOTB);
  WAIT_BAR(3);
  qkt(pA0, pA1, Kbase, qr, negm, r32, hi); asm volatile("s_nop 15\n\ts_nop 7" : "+v"(pA0), "+v"(pA1)); CMASK(pA0, pA1, 0);
  _Pragma("unroll") for (int r = 0; r < 16; ++r) { pA0[r] = __builtin_amdgcn_exp2f(pA0[r]); pA1[r] = __builtin_amdgcn_exp2f(pA1[r]); }
  WAIT_BAR(0);
  DMA_K(3, 0); DMA_V(1, SLOTB);
  ROT();
  kload8(kf, kp0 + sl_cur);
  WAIT_BAR(2);
  bf16x8 vfr[8]; u32x4 pw0, pw1, pw2, pw3;
  #define PKW(P, B) cvtpk_s(P[B], P[B + 1])
  #define PAF(k) __builtin_bit_cast(bf16x8, pw##k)
  #define VFR(i) vfr[i]
  #define PIN(x) asm volatile("" : "+v"(x))
  #define GAPA(MF, W0, W1, PW) do { MF; W0; W1; PIN(PW); SBAR(); } while (0)
  #define OSUM(k) do { if (XV != 5) osum = __builtin_amdgcn_mfma_f32_32x32x16_bf16(PAF(k), ones, osum, 0, 0, 0); SBAR(); } while (0)
  #define EX(v) (XV == 2 ? (v) : (FASTEXP ? exp2_fast(v) : __builtin_amdgcn_exp2f(v)))
  #define GAPB(MF, X, B) do { MF; X[B] = EX(X[B]); X[B + 1] = EX(X[B + 1]); X[B + 2] = EX(X[B + 2]); X[B + 3] = EX(X[B + 3]); PIN(X); SBAR(); } while (0)
  #define VRD(i) do { if (XV == 3) break; vfr[i] = *(const LAS bf16x8*)(vq[(i) & 3] + vsl_ + ((i) >> 2) * 4096); } while (0)
  #define KRD(G, j) do { if ((G) && XV != 3) { kload2(kf, kp0 + sl_next, j); SBAR(); } } while (0)
  #define STEP(C0, C1, P0, P1, t, GK, GV, GL) do { SBAR(); \
    const int vsl_ = sl_prev; \
    VRD(0); SBAR(); GAPA(C0 = __builtin_amdgcn_mfma_f32_32x32x16_bf16(kf[0], qr[0], negm, 0, 0, 0), pw0[0] = PKW(P0, 0), pw0[1] = PKW(P0, 2), pw0); \
    VRD(4); SBAR(); GAPA(C1 = __builtin_amdgcn_mfma_f32_32x32x16_bf16(kf[1], qr[0], negm, 0, 0, 0), pw0[2] = PKW(P0, 4), pw0[3] = PKW(P0, 6), pw0); \
    VRD(1); SBAR(); GAPA(C0 = __builtin_amdgcn_mfma_f32_32x32x16_bf16(kf[2], qr[1], C0, 0, 0, 0),   pw1[0] = PKW(P0, 8), pw1[1] = PKW(P0, 10), pw1); \
    OSUM(0); \
    VRD(5); SBAR(); GAPA(C1 = __builtin_amdgcn_mfma_f32_32x32x16_bf16(kf[3], qr[1], C1, 0, 0, 0),   pw1[2] = PKW(P0, 12), pw1[3] = PKW(P0, 14), pw1); \
    VRD(2); SBAR(); GAPA(C0 = __builtin_amdgcn_mfma_f32_32x32x16_bf16(kf[4], qr[2], C0, 0, 0, 0),   pw2[0] = PKW(P1, 0), pw2[1] = PKW(P1, 2), pw2); \
    OSUM(1); \
    VRD(6); SBAR(); GAPA(C1 = __builtin_amdgcn_mfma_f32_32x32x16_bf16(kf[5], qr[2], C1, 0, 0, 0),   pw2[2] = PKW(P1, 4), pw2[3] = PKW(P1, 6), pw2); \
    VRD(3); SBAR(); GAPA(C0 = __builtin_amdgcn_mfma_f32_32x32x16_bf16(kf[6], qr[3], C0, 0, 0, 0),   pw3[0] = PKW(P1, 8), pw3[1] = PKW(P1, 10), pw3); \
    OSUM(2); \
    VRD(7); SBAR(); GAPA(C1 = __builtin_amdgcn_mfma_f32_32x32x16_bf16(kf[7], qr[3], C1, 0, 0, 0),   pw3[2] = PKW(P1, 12), pw3[3] = PKW(P1, 14), pw3); \
    if (XV != 1) { if (GK) { DMA_K((t) + 3, sl_cur); } if (GV) { DMA_V((t) + 1, sl_next); } } \
    OSUM(3); \
    CMASK(C0, C1, t); \
    SBAR(); \
    GAPB(o[0] = __builtin_amdgcn_mfma_f32_32x32x16_bf16(PAF(0), VFR(0), o[0], 0, 0, 0), C0, 0); \
    GAPB(o[1] = __builtin_amdgcn_mfma_f32_32x32x16_bf16(PAF(0), VFR(4), o[1], 0, 0, 0), C0, 4); \
    KRD(GL, 0); GAPB(o[0] = __builtin_amdgcn_mfma_f32_32x32x16_bf16(PAF(1), VFR(1), o[0], 0, 0, 0), C0, 8); \
    KRD(GL, 1); GAPB(o[1] = __builtin_amdgcn_mfma_f32_32x32x16_bf16(PAF(1), VFR(5), o[1], 0, 0, 0), C0, 12); \
    KRD(GL, 2); GAPB(o[0] = __builtin_amdgcn_mfma_f32_32x32x16_bf16(PAF(2), VFR(2), o[0], 0, 0, 0), C1, 0); \
    KRD(GL, 3); GAPB(o[1] = __builtin_amdgcn_mfma_f32_32x32x16_bf16(PAF(2), VFR(6), o[1], 0, 0, 0), C1, 4); \
    GAPB(o[0] = __builtin_amdgcn_mfma_f32_32x32x16_bf16(PAF(3), VFR(3), o[0], 0, 0, 0), C1, 8); \
    GAPB(o[1] = __builtin_amdgcn_mfma_f32_32x32x16_bf16(PAF(3), VFR(7), o[1], 0, 0, 0), C1, 12); \
    } while (0)
  int t = 1;
  for (; t + 5 < NT; t += 2) {
    STEP(pB0, pB1, pA0, pA1, t, true, true, true);     WAIT_BAR(2); ROT();
    STEP(pA0, pA1, pB0, pB1, t + 1, true, true, true);   WAIT_BAR(2); ROT();
  }
  #define ENDW(tt) do { if ((tt) + 3 < NT) { WAIT_BAR(2); } else if ((tt) + 2 < NT) { WAIT_BAR(1); } else { WAIT_BAR(0); } } while (0)
  for (; t + 1 < NT; t += 2) {
    STEP(pB0, pB1, pA0, pA1, t, (t + 3 < NT), (t + 1 < NT), (t + 1 < NT));       ENDW(t);   ROT();
    STEP(pA0, pA1, pB0, pB1, t + 1, (t + 4 < NT), (t + 2 < NT), (t + 2 < NT));     ENDW(t + 1); ROT();
  }
  STEP(pB0, pB1, pA0, pA1, NT - 1, false, false, false);
  { pw0 = (u32x4){PKW(pB0, 0), PKW(pB0, 2), PKW(pB0, 4), PKW(pB0, 6)}; pw1 = (u32x4){PKW(pB0, 8), PKW(pB0, 10), PKW(pB0, 12), PKW(pB0, 14)}; pw2 = (u32x4){PKW(pB1, 0), PKW(pB1, 2), PKW(pB1, 4), PKW(pB1, 6)}; pw3 = (u32x4){PKW(pB1, 8), PKW(pB1, 10), PKW(pB1, 12), PKW(pB1, 14)};
    SBAR(); OSUM(0); OSUM(1); OSUM(2); OSUM(3); pv2(o, vq, sl_cur, PAF(0), PAF(1), PAF(2), PAF(3)); }
  #undef PKW
  #undef PAF
  #undef VFR
  #undef PIN
  #undef GAPA
  #undef OSUM
  #undef GAPB
  #undef EX
  #undef VRD
  #undef KRD
  #undef STEP
  #undef ENDW
  const float sterm = __builtin_amdgcn_exp2f(sink2);
  float rli[16];
  #pragma unroll
  for (int r = 0; r < 16; ++r) rli[r] = __builtin_amdgcn_rcpf(osum[r] + sterm);
  bf16* Ow = O + (qrow + wid * QBLK) * QP + qcol;
  { bf16* stg = (bf16*)(shm + LDS_OST) + wid * 2048;
    #pragma unroll
    for (int r = 0; r < 16; ++r) { const int orow = crow(r, hi);
      #pragma unroll
      for (int d0 = 0; d0 < 2; ++d0) stg[orow * 64 + d0 * 32 + r32] = __float2bfloat16(o[d0][r] * rli[r]); }
    asm volatile("s_waitcnt lgkmcnt(0)" ::: "memory");
    #pragma unroll
    for (int i = 0; i < 4; ++i) { const int row = i * 8 + (lane >> 3), ch = lane & 7; const u32x4 v = *(const u32x4*)(stg + row * 64 + ch * 8); ATTN_STORE16(Ow + (long)row * QP + ch * 8, v); } }
  asm volatile("s_waitcnt lgkmcnt(0)\n\ts_barrier" ::: "memory");
  #undef DMA_K
  #undef DMA_V
  #undef ROWOFF
  #undef CMASK
  #undef ROT
}
template <int MODE> __device__ __forceinline__ void attn_unit_sk(long qrow, long kvrow, int q0, int qcol, int kcol, int vcol, int NT, float sink2, float bound, const bf16* Q, const bf16* __restrict__ KVb, bf16* O, char* shm) {
  int tid_ = threadIdx.x; asm volatile("" : "+v"(tid_));
  const int tid = tid_, lane = tid & 63, r32 = lane & 31, hi = lane >> 5; const int wid = __builtin_amdgcn_readfirstlane(tid >> 6);
  const bf16* Qw = Q + (qrow + wid * QBLK) * QP + qcol;
  const char* kvt = (const char*)KVb + (size_t)(kvrow >> 6) * 65536 + wid * 1024 + lane * 16;
  constexpr int NSL = 4, LK = 0, LV = NSL * SLOTB, LOST = 2 * NSL * SLOTB + NW * 64 * 4;
  const unsigned lds0 = (unsigned)(uintptr_t)shm;
  const char* ksrc = kvt + kcol * 8192; const char* vsrc = kvt + vcol * 8192;
  const unsigned kdst = lds0 + LK + wid * 1024, vdst = lds0 + LV + wid * 1024;
  #define ROWOFF(t) ((long)(MODE == 1 ? ((t) + ((t) >= 4 ? ((q0 - 128) >> 6) : 0)) : (t)) * 65536)
  #define DMA_K(t, slot) glds16(ksrc + ROWOFF(t), (unsigned)__builtin_amdgcn_readfirstlane(kdst + (slot)))
  #define DMA_V(t, slot) glds16(vsrc + ROWOFF(t), (unsigned)__builtin_amdgcn_readfirstlane(vdst + (slot)))
  const char* Kbase = shm + LK; bf16x8 kf[8];
  const lds_cptr shm3 = (lds_cptr)shm; const lds_cptr kp0 = shm3 + LK + hi * 1024 + r32 * 16; lds_cptr vq[4];
  { const int swz = (r32 >> 1) & 7; _Pragma("unroll") for (int ks_ = 0; ks_ < 4; ++ks_) vq[ks_] = shm3 + LV + r32 * 128 + (((2 * ks_ + hi) ^ swz) * 16); }
  DMA_K(0, 0); DMA_V(0, 0); DMA_K(1, SLOTB);
  bf16x8 qr[4];
  #pragma unroll
  for (int d0 = 0; d0 < 4; ++d0) qr[d0] = *reinterpret_cast<const bf16x8*>(&Qw[(long)r32 * QP + d0 * 16 + hi * 8]);
  f32x16 o[2]; o[0] = f32x16{}; o[1] = f32x16{}; f32x16 osum = f32x16{};
  const f32x16 negm = f32x16{};
  bf16x8 ones;
  #pragma unroll
  for (int i = 0; i < 8; ++i) ones[i] = (short)0x3F80;
  asm volatile("" : "+v"(ones));
  const int qrel = wid * QBLK + r32;
  int mlo = -128, mhi = 128;
  if (MODE == 1) { const int qi = q0 + qrel; mlo = (-qi > -128) ? -qi : -128; mhi = (SEQ - 1 - qi < 128) ? (SEQ - 1 - qi) : 128; }
  const unsigned mspan = (unsigned)(mhi - mlo);
  #define CMASK(P0, P1, t) do { if (MODE == 1) { if ((t) >= 4) bandmask(P0, P1, (t), mlo, mspan, qrel, hi); } } while (0)
  f32x16 pA0, pA1, pB0, pB1;
  int sl_prev = 0, sl_cur = 0, sl_next = SLOTB;
  #define ROT() do { sl_prev = sl_cur; sl_cur = sl_next; sl_next = (sl_next == (NSL - 1) * SLOTB) ? 0 : sl_next + SLOTB; } while (0)
  DMA_K(2, 2 * SLOTB);
  WAIT_BAR(3);
  qkt(pA0, pA1, Kbase, qr, negm, r32, hi); asm volatile("s_nop 15\n\ts_nop 7" : "+v"(pA0), "+v"(pA1)); CMASK(pA0, pA1, 0);
  _Pragma("unroll") for (int r = 0; r < 16; ++r) { pA0[r] = __builtin_amdgcn_exp2f(pA0[r]); pA1[r] = __builtin_amdgcn_exp2f(pA1[r]); }
  WAIT_BAR(0);
  DMA_V(1, SLOTB); DMA_K(3, 3 * SLOTB); DMA_V(2, 2 * SLOTB); if (4 < NT) { DMA_K(4, 0); }
  ROT();
  kload8(kf, kp0 + sl_cur);
  WAIT_BAR(4);
  if (wid >= 4) asm volatile("s_barrier" ::: "memory");
  bf16x8 vfr[8]; u32x4 pw0, pw1, pw2, pw3;
  #define PKW(P, B) cvtpk_s(P[B], P[B + 1])
  #define PAF(k) __builtin_bit_cast(bf16x8, pw##k)
  #define VFR(i) vfr[i]
  #define PIN(x) asm volatile("" : "+v"(x))
  #define GAPA(MF, W0, W1, PW) do { MF; W0; W1; PIN(PW); SBAR(); } while (0)
  #define OSUM(k) do { osum = __builtin_amdgcn_mfma_f32_32x32x16_bf16(PAF(k), ones, osum, 0, 0, 0); SBAR(); } while (0)
  #define EX(v) (FASTEXP ? exp2_fast(v) : __builtin_amdgcn_exp2f(v))
  #define GAPB(MF, X, B) do { MF; X[B] = EX(X[B]); X[B + 1] = EX(X[B + 1]); X[B + 2] = EX(X[B + 2]); X[B + 3] = EX(X[B + 3]); PIN(X); SBAR(); } while (0)
  #define VRD(i) do { vfr[i] = *(const LAS bf16x8*)(vq[(i) & 3] + vsl_ + ((i) >> 2) * 4096); } while (0)
  #define KRD(G, j) do { if (G) { kload2(kf, kp0 + sl_next, j); SBAR(); } } while (0)
  #define STEP(C0, C1, P0, P1, t, GK, GV, GL, WMID) do { SBAR(); \
    const int vsl_ = sl_prev; \
    VRD(0); SBAR(); GAPA(C0 = __builtin_amdgcn_mfma_f32_32x32x16_bf16(kf[0], qr[0], negm, 0, 0, 0), pw0[0] = PKW(P0, 0), pw0[1] = PKW(P0, 2), pw0); \
    VRD(4); SBAR(); GAPA(C1 = __builtin_amdgcn_mfma_f32_32x32x16_bf16(kf[1], qr[0], negm, 0, 0, 0), pw0[2] = PKW(P0, 4), pw0[3] = PKW(P0, 6), pw0); \
    VRD(1); SBAR(); GAPA(C0 = __builtin_amdgcn_mfma_f32_32x32x16_bf16(kf[2], qr[1], C0, 0, 0, 0),   pw1[0] = PKW(P0, 8), pw1[1] = PKW(P0, 10), pw1); \
    OSUM(0); \
    VRD(5); SBAR(); GAPA(C1 = __builtin_amdgcn_mfma_f32_32x32x16_bf16(kf[3], qr[1], C1, 0, 0, 0),   pw1[2] = PKW(P0, 12), pw1[3] = PKW(P0, 14), pw1); \
    VRD(2); SBAR(); GAPA(C0 = __builtin_amdgcn_mfma_f32_32x32x16_bf16(kf[4], qr[2], C0, 0, 0, 0),   pw2[0] = PKW(P1, 0), pw2[1] = PKW(P1, 2), pw2); \
    OSUM(1); \
    VRD(6); SBAR(); GAPA(C1 = __builtin_amdgcn_mfma_f32_32x32x16_bf16(kf[5], qr[2], C1, 0, 0, 0),   pw2[2] = PKW(P1, 4), pw2[3] = PKW(P1, 6), pw2); \
    VRD(3); SBAR(); GAPA(C0 = __builtin_amdgcn_mfma_f32_32x32x16_bf16(kf[6], qr[3], C0, 0, 0, 0),   pw3[0] = PKW(P1, 8), pw3[1] = PKW(P1, 10), pw3); \
    OSUM(2); \
    VRD(7); SBAR(); GAPA(C1 = __builtin_amdgcn_mfma_f32_32x32x16_bf16(kf[7], qr[3], C1, 0, 0, 0),   pw3[2] = PKW(P1, 12), pw3[3] = PKW(P1, 14), pw3); \
    OSUM(3); \
    CMASK(C0, C1, t); \
    SBAR(); \
    WMID; \
    if (GV) { DMA_V((t) + 2, (sl_next == (NSL - 1) * SLOTB) ? 0 : sl_next + SLOTB); } if (GK) { DMA_K((t) + 4, sl_cur); } \
    SBAR(); \
    GAPB(o[0] = __builtin_amdgcn_mfma_f32_32x32x16_bf16(PAF(0), VFR(0), o[0], 0, 0, 0), C0, 0); \
    GAPB(o[1] = __builtin_amdgcn_mfma_f32_32x32x16_bf16(PAF(0), VFR(4), o[1], 0, 0, 0), C0, 4); \
    KRD(GL, 0); GAPB(o[0] = __builtin_amdgcn_mfma_f32_32x32x16_bf16(PAF(1), VFR(1), o[0], 0, 0, 0), C0, 8); \
    KRD(GL, 1); GAPB(o[1] = __builtin_amdgcn_mfma_f32_32x32x16_bf16(PAF(1), VFR(5), o[1], 0, 0, 0), C0, 12); \
    KRD(GL, 2); GAPB(o[0] = __builtin_amdgcn_mfma_f32_32x32x16_bf16(PAF(2), VFR(2), o[0], 0, 0, 0), C1, 0); \
    KRD(GL, 3); GAPB(o[1] = __builtin_amdgcn_mfma_f32_32x32x16_bf16(PAF(2), VFR(6), o[1], 0, 0, 0), C1, 4); \
    GAPB(o[0] = __builtin_amdgcn_mfma_f32_32x32x16_bf16(PAF(3), VFR(3), o[0], 0, 0, 0), C1, 8); \
    GAPB(o[1] = __builtin_amdgcn_mfma_f32_32x32x16_bf16(PAF(3), VFR(7), o[1], 0, 0, 0), C1, 12); \
    } while (0)
  int t = 1;
  for (; t + 5 < NT; t += 2) {
    STEP(pB0, pB1, pA0, pA1, t, true, true, true, WAIT_BAR(3));     WAIT_BAR(4); ROT();
    STEP(pA0, pA1, pB0, pB1, t + 1, true, true, true, WAIT_BAR(3));   WAIT_BAR(4); ROT();
  }
  for (; t + 1 < NT; t += 2) {
    STEP(pB0, pB1, pA0, pA1, t, (t + 4 < NT), (t + 2 < NT), (t + 1 < NT), WAIT_BAR(0));       WAIT_BAR(0); ROT();
    STEP(pA0, pA1, pB0, pB1, t + 1, (t + 5 < NT), (t + 3 < NT), (t + 2 < NT), WAIT_BAR(0));     WAIT_BAR(0); ROT();
  }
  STEP(pB0, pB1, pA0, pA1, NT - 1, false, false, false, WAIT_BAR(0));
  if (wid < 4) { WAIT_BAR(0); }
  { pw0 = (u32x4){PKW(pB0, 0), PKW(pB0, 2), PKW(pB0, 4), PKW(pB0, 6)}; pw1 = (u32x4){PKW(pB0, 8), PKW(pB0, 10), PKW(pB0, 12), PKW(pB0, 14)}; pw2 = (u32x4){PKW(pB1, 0), PKW(pB1, 2), PKW(pB1, 4), PKW(pB1, 6)}; pw3 = (u32x4){PKW(pB1, 8), PKW(pB1, 10), PKW(pB1, 12), PKW(pB1, 14)};
    SBAR(); OSUM(0); OSUM(1); OSUM(2); OSUM(3); pv2(o, vq, sl_cur, PAF(0), PAF(1), PAF(2), PAF(3)); }
  #undef PKW
  #undef PAF
  #undef VFR
  #undef PIN
  #undef GAPA
  #undef OSUM
  #undef GAPB
  #undef EX
  #undef VRD
  #undef KRD
  #undef STEP
  const float sterm = __builtin_amdgcn_exp2f(sink2);
  float rli[16];
  #pragma unroll
  for (int r = 0; r < 16; ++r) rli[r] = __builtin_amdgcn_rcpf(osum[r] + sterm);
  bf16* Ow = O + (qrow + wid * QBLK) * QP + qcol;
  { bf16* stg = (bf16*)(shm + LOST) + wid * 2048;
    #pragma unroll
    for (int r = 0; r < 16; ++r) { const int orow = crow(r, hi);
      #pragma unroll
      for (int d0 = 0; d0 < 2; ++d0) stg[orow * 64 + d0 * 32 + r32] = __float2bfloat16(o[d0][r] * rli[r]); }
    asm volatile("s_waitcnt lgkmcnt(0)" ::: "memory");
    #pragma unroll
    for (int i = 0; i < 4; ++i) { const int row = i * 8 + (lane >> 3), ch = lane & 7; const u32x4 v = *(const u32x4*)(stg + row * 64 + ch * 8); ATTN_STORE16(Ow + (long)row * QP + ch * 8, v); } }
  asm volatile("s_waitcnt lgkmcnt(0)\n\ts_barrier" ::: "memory");
  #undef DMA_K
  #undef DMA_V
  #undef ROWOFF
  #undef CMASK
  #undef ROT
}
typedef int v8i_t __attribute__((ext_vector_type(8)));
typedef int v4i_t __attribute__((ext_vector_type(4)));
template <int MODE, int XV = 0> __device__ __forceinline__ void attn_unit_f8(long qrow, long kvrow, int q0, int qcol, int kst, int vst, int NT, float sink2, float ref, const unsigned char* Qf8, const unsigned char* KVT, bf16* O, char* shm) {
  int tid_ = threadIdx.x; asm volatile("" : "+v"(tid_));
  const int tid = tid_, lane = tid & 63, r32 = lane & 31, hi = lane >> 5; const int wid = __builtin_amdgcn_readfirstlane(tid >> 6);
  constexpr int KSL = 4096, VSL = 8192, LK = 0, LV = 3 * KSL, LOST = LV + 3 * VSL, TILEB = 49152;
  const unsigned lds0 = (unsigned)(uintptr_t)shm;
  const unsigned char* tile0 = KVT + (size_t)(kvrow >> 6) * TILEB;
  const unsigned char* ksrc = tile0 + kst * KSL + wid * 512 + (lane & 31) * 16;
  const unsigned char* vsrc = tile0 + 4 * KSL + vst * VSL + wid * 1024 + lane * 16;
  const unsigned kdst = lds0 + LK + wid * 512, vdst = lds0 + LV + wid * 1024;
  #define ROWOFF(t) ((long)(MODE == 1 ? ((t) + ((t) >= 4 ? ((q0 - 128) >> 6) : 0)) : (t)) * TILEB)
  #define DMA_K(t, kslot) do { if (lane < 32) glds16(ksrc + ROWOFF(t), (unsigned)__builtin_amdgcn_readfirstlane(kdst + (kslot))); } while (0)
  #define DMA_V(t, vslot) glds16(vsrc + ROWOFF(t), (unsigned)__builtin_amdgcn_readfirstlane(vdst + (vslot)))
  const lds_cptr shm3 = (lds_cptr)shm;
  const int ksw = (r32 >> 2) & 3;
  const lds_cptr kq0 = shm3 + LK + r32 * 64 + (((2 * hi) ^ ksw) * 16), kq1 = shm3 + LK + r32 * 64 + (((2 * hi + 1) ^ ksw) * 16);
  lds_cptr vq[4];
  { const int swz = (r32 >> 1) & 7; _Pragma("unroll") for (int ks_ = 0; ks_ < 4; ++ks_) vq[ks_] = shm3 + LV + r32 * 128 + (((2 * ks_ + hi) ^ swz) * 16); }
  DMA_K(0, 0); DMA_V(0, 0); DMA_K(1, KSL);
  v8i_t qf;
  { const v4i_t* qp = (const v4i_t*)(Qf8 + (size_t)(qrow + wid * QBLK + r32) * 1024 + qcol + hi * 32); const v4i_t a = qp[0], b = qp[1]; qf = (v8i_t){a[0], a[1], a[2], a[3], b[0], b[1], b[2], b[3]}; }
  f32x16 o[2]; o[0] = f32x16{}; o[1] = f32x16{}; f32x16 osum = f32x16{};
  f32x16 negm;
  #pragma unroll
  for (int r = 0; r < 16; ++r) negm[r] = -ref;
  asm volatile("" : "+v"(negm));
  bf16x8 ones;
  #pragma unroll
  for (int i = 0; i < 8; ++i) ones[i] = (short)0x3F80;
  asm volatile("" : "+v"(ones));
  const int qrel = wid * QBLK + r32;
  int mlo = -128, mhi = 128;
  if (MODE == 1) { const int qi = q0 + qrel; mlo = (-qi > -128) ? -qi : -128; mhi = (SEQ - 1 - qi < 128) ? (SEQ - 1 - qi) : 128; }
  const unsigned mspan = (unsigned)(mhi - mlo);
  #define CMASK(P0, P1, t) do { if (MODE == 1) { if ((t) >= 4) bandmask(P0, P1, (t), mlo, mspan, qrel, hi); } } while (0)
  #define MF8(kfr, cin) __builtin_amdgcn_mfma_scale_f32_32x32x64_f8f6f4(kfr, qf, cin, 0, 0, 0, 0x7F7F7F7F, 0, 0x7F7F7F7F)
  #define KLOAD(dst, b, kslot) do { const v4i_t a_ = *(const LAS v4i_t*)(kq0 + (kslot) + (b) * 2048), b_ = *(const LAS v4i_t*)(kq1 + (kslot) + (b) * 2048); dst = (v8i_t){a_[0], a_[1], a_[2], a_[3], b_[0], b_[1], b_[2], b_[3]}; } while (0)
  f32x16 pA0, pA1, pB0, pB1;
  int sl_prev = 0, sl_cur = 0, sl_next = VSL;
  #define ROT() do { sl_prev = sl_cur; sl_cur = sl_next; sl_next = (sl_next == 2 * VSL) ? 0 : sl_next + VSL; } while (0)
  DMA_K(2, 2 * KSL);
  WAIT_BAR(3);
  v8i_t kf0, kf1;
  KLOAD(kf0, 0, 0); KLOAD(kf1, 1, 0);
  pA0 = MF8(kf0, negm); pA1 = MF8(kf1, negm);
  asm volatile("s_nop 15\n\ts_nop 7" : "+v"(pA0), "+v"(pA1)); CMASK(pA0, pA1, 0);
  _Pragma("unroll") for (int r = 0; r < 16; ++r) { pA0[r] = __builtin_amdgcn_exp2f(pA0[r]); pA1[r] = __builtin_amdgcn_exp2f(pA1[r]); }
  WAIT_BAR(0);
  DMA_K(3, 0); DMA_V(1, VSL);
  ROT();
  KLOAD(kf0, 0, sl_cur >> 1); KLOAD(kf1, 1, sl_cur >> 1);
  WAIT_BAR(2);
  bf16x8 vfr[8]; u32x4 pw0, pw1, pw2, pw3;
  #define PKW(P, B) cvtpk_s(P[B], P[B + 1])
  #define PAF(k) __builtin_bit_cast(bf16x8, pw##k)
  #define VFR(i) vfr[i]
  #define PIN(x) asm volatile("" : "+v"(x))
  #define OSUM(k) do { if (XV != 5) osum = __builtin_amdgcn_mfma_f32_32x32x16_bf16(PAF(k), ones, osum, 0, 0, 0); SBAR(); } while (0)
  #define EX(v) __builtin_amdgcn_exp2f(v)
  #define GAPB(MF, X, B) do { MF; X[B] = EX(X[B]); X[B + 1] = EX(X[B + 1]); X[B + 2] = EX(X[B + 2]); X[B + 3] = EX(X[B + 3]); PIN(X); SBAR(); } while (0)
  #define VRD(i) do { vfr[i] = *(const LAS bf16x8*)(vq[(i) & 3] + vsl_ + ((i) >> 2) * 4096); } while (0)
  #define STEP(C0, C1, P0, P1, t, GK, GV, GL) do { SBAR(); \
    const int vsl_ = sl_prev; \
    VRD(0); VRD(4); SBAR(); \
    C0 = MF8(kf0, negm); pw0[0] = PKW(P0, 0); pw0[1] = PKW(P0, 2); pw0[2] = PKW(P0, 4); pw0[3] = PKW(P0, 6); PIN(pw0); SBAR(); \
    VRD(1); VRD(5); SBAR(); \
    C1 = MF8(kf1, negm); pw1[0] = PKW(P0, 8); pw1[1] = PKW(P0, 10); pw1[2] = PKW(P0, 12); pw1[3] = PKW(P0, 14); PIN(pw1); SBAR(); \
    VRD(2); VRD(6); SBAR(); \
    OSUM(0); pw2[0] = PKW(P1, 0); pw2[1] = PKW(P1, 2); pw2[2] = PKW(P1, 4); pw2[3] = PKW(P1, 6); PIN(pw2); SBAR(); \
    VRD(3); VRD(7); SBAR(); \
    OSUM(1); pw3[0] = PKW(P1, 8); pw3[1] = PKW(P1, 10); pw3[2] = PKW(P1, 12); pw3[3] = PKW(P1, 14); PIN(pw3); SBAR(); \
    OSUM(2); \
    if (GK) { DMA_K((t) + 3, sl_cur >> 1); } if (GV) { DMA_V((t) + 1, sl_next); } \
    OSUM(3); \
    CMASK(C0, C1, t); \
    SBAR(); \
    GAPB(o[0] = __builtin_amdgcn_mfma_f32_32x32x16_bf16(PAF(0), VFR(0), o[0], 0, 0, 0), C0, 0); \
    GAPB(o[1] = __builtin_amdgcn_mfma_f32_32x32x16_bf16(PAF(0), VFR(4), o[1], 0, 0, 0), C0, 4); \
    if (GL) { KLOAD(kf0, 0, sl_next >> 1); SBAR(); } \
    GAPB(o[0] = __builtin_amdgcn_mfma_f32_32x32x16_bf16(PAF(1), VFR(1), o[0], 0, 0, 0), C0, 8); \
    GAPB(o[1] = __builtin_amdgcn_mfma_f32_32x32x16_bf16(PAF(1), VFR(5), o[1], 0, 0, 0), C0, 12); \
    if (GL) { KLOAD(kf1, 1, sl_next >> 1); SBAR(); } \
    GAPB(o[0] = __builtin_amdgcn_mfma_f32_32x32x16_bf16(PAF(2), VFR(2), o[0], 0, 0, 0), C1, 0); \
    GAPB(o[1] = __builtin_amdgcn_mfma_f32_32x32x16_bf16(PAF(2), VFR(6), o[1], 0, 0, 0), C1, 4); \
    GAPB(o[0] = __builtin_amdgcn_mfma_f32_32x32x16_bf16(PAF(3), VFR(3), o[0], 0, 0, 0), C1, 8); \
    GAPB(o[1] = __builtin_amdgcn_mfma_f32_32x32x16_bf16(PAF(3), VFR(7), o[1], 0, 0, 0), C1, 12); \
    } while (0)
  int t = 1;
  for (; t + 5 < NT; t += 2) {
    STEP(pB0, pB1, pA0, pA1, t, true, true, true);     WAIT_BAR(2); ROT();
    STEP(pA0, pA1, pB0, pB1, t + 1, true, true, true);   WAIT_BAR(2); ROT();
  }
  #define ENDW(tt) do { if ((tt) + 3 < NT) { WAIT_BAR(2); } else if ((tt) + 2 < NT) { WAIT_BAR(1); } else { WAIT_BAR(0); } } while (0)
  for (; t + 1 < NT; t += 2) {
    STEP(pB0, pB1, pA0, pA1, t, (t + 3 < NT), (t + 1 < NT), (t + 1 < NT));       ENDW(t);   ROT();
    STEP(pA0, pA1, pB0, pB1, t + 1, (t + 4 < NT), (t + 2 < NT), (t + 2 < NT));     ENDW(t + 1); ROT();
  }
  STEP(pB0, pB1, pA0, pA1, NT - 1, false, false, false);
  { pw0 = (u32x4){PKW(pB0, 0), PKW(pB0, 2), PKW(pB0, 4), PKW(pB0, 6)}; pw1 = (u32x4){PKW(pB0, 8), PKW(pB0, 10), PKW(pB0, 12), PKW(pB0, 14)}; pw2 = (u32x4){PKW(pB1, 0), PKW(pB1, 2), PKW(pB1, 4), PKW(pB1, 6)}; pw3 = (u32x4){PKW(pB1, 8), PKW(pB1, 10), PKW(pB1, 12), PKW(pB1, 14)};
    SBAR(); OSUM(0); OSUM(1); OSUM(2); OSUM(3); pv2(o, vq, sl_cur, PAF(0), PAF(1), PAF(2), PAF(3)); }
  #undef PKW
  #undef PAF
  #undef VFR
  #undef PIN
  #undef OSUM
  #undef GAPB
  #undef EX
  #undef VRD
  #undef STEP
  #undef ENDW
  #undef MF8
  #undef KLOAD
  const float sterm = __builtin_amdgcn_exp2f(sink2 - ref);
  float rli[16];
  #pragma unroll
  for (int r = 0; r < 16; ++r) rli[r] = __builtin_amdgcn_rcpf(osum[r] + sterm);
  bf16* Ow = O + (qrow + wid * QBLK) * QP + qcol;
  { bf16* stg = (bf16*)(shm + LOST) + wid * 2048;
    #pragma unroll
    for (int r = 0; r < 16; ++r) { const int orow = crow(r, hi);
      #pragma unroll
      for (int d0 = 0; d0 < 2; ++d0) stg[orow * 64 + d0 * 32 + r32] = __float2bfloat16(o[d0][r] * rli[r]); }
    asm volatile("s_waitcnt lgkmcnt(0)" ::: "memory");
    #pragma unroll
    for (int i = 0; i < 4; ++i) { const int row = i * 8 + (lane >> 3), ch = lane & 7; const u32x4 v = *(const u32x4*)(stg + row * 64 + ch * 8); ATTN_STORE16(Ow + (long)row * QP + ch * 8, v); } }
  asm volatile("s_waitcnt lgkmcnt(0)\n\ts_barrier" ::: "memory");
  #undef DMA_K
  #undef DMA_V
  #undef ROWOFF
  #undef CMASK
  #undef ROT
}
template <int MODE> __device__ __forceinline__ void attn_unit_f8b(long qrow, long kvrow, int q0, int qcol, int kst, int vst, int NT, float sink2, float cref, const unsigned char* Qf8, const unsigned char* KVT, bf16* O, char* shm) {
  int tid_ = threadIdx.x; asm volatile("" : "+v"(tid_));
  const int tid = tid_, lane = tid & 63, r32 = lane & 31, hi = lane >> 5; const int wid = __builtin_amdgcn_readfirstlane(tid >> 6);
  constexpr int SL = 4096, LK = 0, LV = 3 * SL, LOST = LV + 3 * SL, TILEB = 32768;
  const unsigned lds0 = (unsigned)(uintptr_t)shm;
  const unsigned char* tile0 = KVT + (size_t)(kvrow >> 6) * TILEB + wid * 512 + (lane & 31) * 16;
  const unsigned char* ksrc = tile0 + kst * SL; const unsigned char* vsrc = tile0 + 4 * SL + vst * SL;
  const unsigned kdst = lds0 + LK + wid * 512, vdst = lds0 + LV + wid * 512;
  #define ROWOFF(t) ((long)(MODE == 1 ? ((t) + ((t) >= 4 ? ((q0 - 128) >> 6) : 0)) : (t)) * TILEB)
  #define DMA_K(t, slot) do { if (lane < 32) glds16(ksrc + ROWOFF(t), (unsigned)__builtin_amdgcn_readfirstlane(kdst + (slot))); } while (0)
  #define DMA_V(t, slot) do { if (lane < 32) glds16(vsrc + ROWOFF(t), (unsigned)__builtin_amdgcn_readfirstlane(vdst + (slot))); } while (0)
  const lds_cptr shm3 = (lds_cptr)shm;
  const int ksw = (r32 >> 2) & 3;
  const lds_cptr fq0 = shm3 + r32 * 64 + (((2 * hi) ^ ksw) * 16), fq1 = shm3 + r32 * 64 + (((2 * hi + 1) ^ ksw) * 16);
  DMA_K(0, 0); DMA_V(0, 0); DMA_K(1, SL);
  v8i_t qf;
  { const v4i_t* qp = (const v4i_t*)(Qf8 + (size_t)(qrow + wid * QBLK + r32) * 1024 + qcol + hi * 32); const v4i_t a = qp[0], b = qp[1]; qf = (v8i_t){a[0], a[1], a[2], a[3], b[0], b[1], b[2], b[3]}; }
  f32x16 o[2]; o[0] = f32x16{}; o[1] = f32x16{}; f32x16 osum = f32x16{};
  f32x16 negm;
  #pragma unroll
  for (int r = 0; r < 16; ++r) negm[r] = -cref;
  asm volatile("" : "+v"(negm));
  v8i_t ones8;
  #pragma unroll
  for (int i = 0; i < 8; ++i) ones8[i] = 0x38383838;
  asm volatile("" : "+v"(ones8));
  const int qrel = wid * QBLK + r32;
  int mlo = -128, mhi = 128;
  if (MODE == 1) { const int qi = q0 + qrel; mlo = (-qi > -128) ? -qi : -128; mhi = (SEQ - 1 - qi < 128) ? (SEQ - 1 - qi) : 128; }
  const unsigned mspan = (unsigned)(mhi - mlo);
  #define CMASK(P0, P1, t) do { if (MODE == 1) { if ((t) >= 4) bandmask(P0, P1, (t), mlo, mspan, qrel, hi); } } while (0)
  #define MFQK(kfr) __builtin_amdgcn_mfma_scale_f32_32x32x64_f8f6f4(kfr, qf, negm, 0, 0, 0, 0x7F7F7F7F, 0, 0x7F7F7F7F)
  #define MFPV(bfr, cin) __builtin_amdgcn_mfma_scale_f32_32x32x64_f8f6f4(pf, bfr, cin, 1, 0, 0, 0x7F7F7F7F, 0, 0x7F7F7F7F)
  #define FLOAD(dst, base, b, slot) do { const v4i_t a_ = *(const LAS v4i_t*)(fq0 + (base) + (slot) + (b) * 2048), b_ = *(const LAS v4i_t*)(fq1 + (base) + (slot) + (b) * 2048); dst = (v8i_t){a_[0], a_[1], a_[2], a_[3], b_[0], b_[1], b_[2], b_[3]}; } while (0)
  #define PK8(x0, x1, x2, x3) __builtin_amdgcn_cvt_pk_bf8_f32(x2, x3, __builtin_amdgcn_cvt_pk_bf8_f32(x0, x1, 0, false), true)
  f32x16 pA0, pA1, pB0, pB1;
  int sl_prev = 0, sl_cur = 0, sl_next = SL;
  #define ROT() do { sl_prev = sl_cur; sl_cur = sl_next; sl_next = (sl_next == 2 * SL) ? 0 : sl_next + SL; } while (0)
  DMA_K(2, 2 * SL);
  WAIT_BAR(3);
  v8i_t kf0, kf1, vf0, vf1, pf;
  FLOAD(kf0, LK, 0, 0); FLOAD(kf1, LK, 1, 0);
  pA0 = MFQK(kf0); pA1 = MFQK(kf1);
  asm volatile("s_nop 15\n\ts_nop 7" : "+v"(pA0), "+v"(pA1)); CMASK(pA0, pA1, 0);
  _Pragma("unroll") for (int r = 0; r < 16; ++r) { pA0[r] = __builtin_amdgcn_exp2f(pA0[r]); pA1[r] = __builtin_amdgcn_exp2f(pA1[r]); }
  WAIT_BAR(0);
  DMA_K(3, 0); DMA_V(1, SL);
  ROT();
  FLOAD(kf0, LK, 0, sl_cur); FLOAD(kf1, LK, 1, sl_cur);
  WAIT_BAR(2);
  #define PIN(x) asm volatile("" : "+v"(x))
  #define EX(v) __builtin_amdgcn_exp2f(v)
  #define EX8(X, B) do { _Pragma("unroll") for (int e_ = 0; e_ < 8; ++e_) X[(B) + e_] = EX(X[(B) + e_]); PIN(X); } while (0)
  #define PACKP(P0, P1) do { pf[0] = PK8(P0[0], P0[1], P0[2], P0[3]); pf[1] = PK8(P0[4], P0[5], P0[6], P0[7]); pf[2] = PK8(P0[8], P0[9], P0[10], P0[11]); pf[3] = PK8(P0[12], P0[13], P0[14], P0[15]); \
                             pf[4] = PK8(P1[0], P1[1], P1[2], P1[3]); pf[5] = PK8(P1[4], P1[5], P1[6], P1[7]); pf[6] = PK8(P1[8], P1[9], P1[10], P1[11]); pf[7] = PK8(P1[12], P1[13], P1[14], P1[15]); PIN(pf); } while (0)
  #define STEP(C0, C1, P0, P1, t, GK, GV, GL) do { SBAR(); \
    FLOAD(vf0, LV, 0, sl_prev); FLOAD(vf1, LV, 1, sl_prev); SBAR(); \
    C0 = MFQK(kf0); SBAR(); \
    PACKP(P0, P1); SBAR(); \
    C1 = MFQK(kf1); SBAR(); \
    if (GK) { DMA_K((t) + 3, sl_cur); } if (GV) { DMA_V((t) + 1, sl_next); } \
    osum = MFPV(ones8, osum); SBAR(); \
    CMASK(C0, C1, t); SBAR(); \
    o[0] = MFPV(vf0, o[0]); EX8(C0, 0); SBAR(); \
    if (GL) { FLOAD(kf0, LK, 0, sl_next); SBAR(); } \
    EX8(C0, 8); SBAR(); \
    o[1] = MFPV(vf1, o[1]); EX8(C1, 0); SBAR(); \
    if (GL) { FLOAD(kf1, LK, 1, sl_next); SBAR(); } \
    EX8(C1, 8); SBAR(); \
    } while (0)
  int t = 1;
  for (; t + 5 < NT; t += 2) {
    STEP(pB0, pB1, pA0, pA1, t, true, true, true);     WAIT_BAR(2); ROT();
    STEP(pA0, pA1, pB0, pB1, t + 1, true, true, true);   WAIT_BAR(2); ROT();
  }
  #define ENDW(tt) do { if ((tt) + 3 < NT) { WAIT_BAR(2); } else if ((tt) + 2 < NT) { WAIT_BAR(1); } else { WAIT_BAR(0); } } while (0)
  for (; t + 1 < NT; t += 2) {
    STEP(pB0, pB1, pA0, pA1, t, (t + 3 < NT), (t + 1 < NT), (t + 1 < NT));       ENDW(t);   ROT();
    STEP(pA0, pA1, pB0, pB1, t + 1, (t + 4 < NT), (t + 2 < NT), (t + 2 < NT));     ENDW(t + 1); ROT();
  }
  STEP(pB0, pB1, pA0, pA1, NT - 1, false, false, false);
  { PACKP(pB0, pB1); SBAR(); FLOAD(vf0, LV, 0, sl_cur); FLOAD(vf1, LV, 1, sl_cur); osum = MFPV(ones8, osum); o[0] = MFPV(vf0, o[0]); o[1] = MFPV(vf1, o[1]); }
  #undef PIN
  #undef EX
  #undef EX8
  #undef PACKP
  #undef STEP
  #undef ENDW
  #undef MFQK
  #undef MFPV
  #undef FLOAD
  #undef PK8
  const float sterm = __builtin_amdgcn_exp2f(sink2 - cref);
  float rli[16];
  #pragma unroll
  for (int r = 0; r < 16; ++r) rli[r] = __builtin_amdgcn_rcpf(osum[r] + sterm);
  bf16* Ow = O + (qrow + wid * QBLK) * QP + qcol;
  { bf16* stg = (bf16*)(shm + LOST) + wid * 2048;
    #pragma unroll
    for (int r = 0; r < 16; ++r) { const int orow = crow(r, hi);
      #pragma unroll
      for (int d0 = 0; d0 < 2; ++d0) stg[orow * 64 + d0 * 32 + r32] = __float2bfloat16(o[d0][r] * rli[r]); }
    asm volatile("s_waitcnt lgkmcnt(0)" ::: "memory");
    #pragma unroll
    for (int i = 0; i < 4; ++i) { const int row = i * 8 + (lane >> 3), ch = lane & 7; const u32x4 v = *(const u32x4*)(stg + row * 64 + ch * 8); ATTN_STORE16(Ow + (long)row * QP + ch * 8, v); } }
  asm volatile("s_waitcnt lgkmcnt(0)\n\ts_barrier" ::: "memory");
  #undef DMA_K
  #undef DMA_V
  #undef ROWOFF
  #undef CMASK
  #undef ROT
}
template <int MODE> __device__ __forceinline__ void attn_unit_f8c(long qrow, long kvrow, int q0, int qcol, int kst, int vst, int NT, float sink2, float cref, const unsigned char* Qf8, const unsigned char* KVT, bf16* O, char* shm) {
  int tid_ = threadIdx.x; asm volatile("" : "+v"(tid_));
  const int tid = tid_, lane = tid & 63, r32 = lane & 31, hi = lane >> 5; const int wid = __builtin_amdgcn_readfirstlane(tid >> 6);
  constexpr int SL = 4096, LK = 0, LV = 3 * SL, LOST = LV + 3 * SL, TILEB = 32768;
  const unsigned lds0 = (unsigned)(uintptr_t)shm;
  const unsigned char* tile0 = KVT + (size_t)(kvrow >> 6) * TILEB + wid * 512 + (lane & 31) * 16;
  const unsigned char* ksrc = tile0 + kst * SL; const unsigned char* vsrc = tile0 + 4 * SL + vst * SL;
  const unsigned kdst = lds0 + LK + wid * 512, vdst = lds0 + LV + wid * 512;
  #define ROWOFF(t) ((long)(MODE == 1 ? ((t) + ((t) >= 4 ? ((q0 - 128) >> 6) : 0)) : (t)) * TILEB)
  #define DMA_K(t, slot) do { if (lane < 32) glds16(ksrc + ROWOFF(t), (unsigned)__builtin_amdgcn_readfirstlane(kdst + (slot))); } while (0)
  #define DMA_V(t, slot) do { if (lane < 32) glds16(vsrc + ROWOFF(t), (unsigned)__builtin_amdgcn_readfirstlane(vdst + (slot))); } while (0)
  const lds_cptr shm3 = (lds_cptr)shm;
  const int ksw = (r32 >> 2) & 3;
  const lds_cptr fq0 = shm3 + r32 * 64 + (((2 * hi) ^ ksw) * 16), fq1 = shm3 + r32 * 64 + (((2 * hi + 1) ^ ksw) * 16);
  DMA_K(0, 0); DMA_V(0, 0); DMA_K(1, SL);
  v8i_t qf;
  { const v4i_t* qp = (const v4i_t*)(Qf8 + (size_t)(qrow + wid * QBLK + r32) * 1024 + qcol + hi * 32); const v4i_t a = qp[0], b = qp[1]; qf = (v8i_t){a[0], a[1], a[2], a[3], b[0], b[1], b[2], b[3]}; }
  f32x16 o[2]; o[0] = f32x16{}; o[1] = f32x16{}; f32x16 osum = f32x16{};
  f32x16 cinit;
  #pragma unroll
  for (int r = 0; r < 16; ++r) cinit[r] = 60.5f - 4.0f * cref;
  asm volatile("" : "+v"(cinit));
  v8i_t ones8;
  #pragma unroll
  for (int i = 0; i < 8; ++i) ones8[i] = 0x38383838;
  asm volatile("" : "+v"(ones8));
  const int qrel = wid * QBLK + r32;
  int mlo = -128, mhi = 128;
  if (MODE == 1) { const int qi = q0 + qrel; mlo = (-qi > -128) ? -qi : -128; mhi = (SEQ - 1 - qi < 128) ? (SEQ - 1 - qi) : 128; }
  const unsigned mspan = (unsigned)(mhi - mlo);
  #define CMASK(P0, P1, t) do { if (MODE == 1) { if ((t) >= 4) bandmask(P0, P1, (t), mlo, mspan, qrel, hi); } } while (0)
  #define MFQK(kfr) __builtin_amdgcn_mfma_scale_f32_32x32x64_f8f6f4(kfr, qf, cinit, 0, 0, 0, 0x7F7F7F7F, 0, 0x7F7F7F7F)
  #define MFPV(pfr, bfr, cin) __builtin_amdgcn_mfma_scale_f32_32x32x64_f8f6f4(pfr, bfr, cin, 1, 0, 0, 0x7F7F7F7F, 0, 0x7F7F7F7F)
  #define FLOAD(dst, base, b, slot) do { const v4i_t a_ = *(const LAS v4i_t*)(fq0 + (base) + (slot) + (b) * 2048), b_ = *(const LAS v4i_t*)(fq1 + (base) + (slot) + (b) * 2048); dst = (v8i_t){a_[0], a_[1], a_[2], a_[3], b_[0], b_[1], b_[2], b_[3]}; } while (0)
  #define PK4(x0, x1, x2, x3) (int)__builtin_amdgcn_cvt_pk_u8_f32(x3, 3, __builtin_amdgcn_cvt_pk_u8_f32(x2, 2, __builtin_amdgcn_cvt_pk_u8_f32(x1, 1, __builtin_amdgcn_cvt_pk_u8_f32(x0, 0, 0u))))
  #define PACKP(PF, X0, X1) do { PF[0] = PK4(X0[0], X0[1], X0[2], X0[3]); PF[1] = PK4(X0[4], X0[5], X0[6], X0[7]); PF[2] = PK4(X0[8], X0[9], X0[10], X0[11]); PF[3] = PK4(X0[12], X0[13], X0[14], X0[15]); \
                                 PF[4] = PK4(X1[0], X1[1], X1[2], X1[3]); PF[5] = PK4(X1[4], X1[5], X1[6], X1[7]); PF[6] = PK4(X1[8], X1[9], X1[10], X1[11]); PF[7] = PK4(X1[12], X1[13], X1[14], X1[15]); asm volatile("" : "+v"(PF)); } while (0)
  int sl_prev = 0, sl_cur = 0, sl_next = SL;
  #define ROT() do { sl_prev = sl_cur; sl_cur = sl_next; sl_next = (sl_next == 2 * SL) ? 0 : sl_next + SL; } while (0)
  DMA_K(2, 2 * SL);
  WAIT_BAR(3);
  v8i_t kf0, kf1, vf0, vf1, pfA, pfB;
  f32x16 x0, x1;
  FLOAD(kf0, LK, 0, 0); FLOAD(kf1, LK, 1, 0);
  x0 = MFQK(kf0); x1 = MFQK(kf1);
  CMASK(x0, x1, 0);
  PACKP(pfA, x0, x1);
  WAIT_BAR(0);
  DMA_K(3, 0); DMA_V(1, SL);
  ROT();
  FLOAD(kf0, LK, 0, sl_cur); FLOAD(kf1, LK, 1, sl_cur);
  WAIT_BAR(2);
  #define STEP(PFP, PFN, t, GK, GV, GL) do { SBAR(); \
    FLOAD(vf0, LV, 0, sl_prev); FLOAD(vf1, LV, 1, sl_prev); SBAR(); \
    x0 = MFQK(kf0); x1 = MFQK(kf1); SBAR(); \
    osum = MFPV(PFP, ones8, osum); o[0] = MFPV(PFP, vf0, o[0]); o[1] = MFPV(PFP, vf1, o[1]); SBAR(); \
    if (GK) { DMA_K((t) + 3, sl_cur); } if (GV) { DMA_V((t) + 1, sl_next); } \
    if (GL) { FLOAD(kf0, LK, 0, sl_next); FLOAD(kf1, LK, 1, sl_next); SBAR(); } \
    CMASK(x0, x1, t); \
    PACKP(PFN, x0, x1); SBAR(); \
    } while (0)
  int t = 1;
  for (; t + 5 < NT; t += 2) {
    STEP(pfA, pfB, t, true, true, true);     WAIT_BAR(2); ROT();
    STEP(pfB, pfA, t + 1, true, true, true);   WAIT_BAR(2); ROT();
  }
  #define ENDW(tt) do { if ((tt) + 3 < NT) { WAIT_BAR(2); } else if ((tt) + 2 < NT) { WAIT_BAR(1); } else { WAIT_BAR(0); } } while (0)
  for (; t + 1 < NT; t += 2) {
    STEP(pfA, pfB, t, (t + 3 < NT), (t + 1 < NT), (t + 1 < NT));       ENDW(t);   ROT();
    STEP(pfB, pfA, t + 1, (t + 4 < NT), (t + 2 < NT), (t + 2 < NT));     ENDW(t + 1); ROT();
  }
  STEP(pfA, pfB, NT - 1, false, false, false);
  { FLOAD(vf0, LV, 0, sl_cur); FLOAD(vf1, LV, 1, sl_cur); osum = MFPV(pfB, ones8, osum); o[0] = MFPV(pfB, vf0, o[0]); o[1] = MFPV(pfB, vf1, o[1]); }
  #undef PACKP
  #undef PK4
  #undef STEP
  #undef ENDW
  #undef MFQK
  #undef MFPV
  #undef FLOAD
  const float sterm = __builtin_amdgcn_exp2f(sink2 - cref);
  float rli[16];
  #pragma unroll
  for (int r = 0; r < 16; ++r) rli[r] = __builtin_amdgcn_rcpf(osum[r] + sterm);
  bf16* Ow = O + (qrow + wid * QBLK) * QP + qcol;
  { bf16* stg = (bf16*)(shm + LOST) + wid * 2048;
    #pragma unroll
    for (int r = 0; r < 16; ++r) { const int orow = crow(r, hi);
      #pragma unroll
      for (int d0 = 0; d0 < 2; ++d0) stg[orow * 64 + d0 * 32 + r32] = __float2bfloat16(o[d0][r] * rli[r]); }
    asm volatile("s_waitcnt lgkmcnt(0)" ::: "memory");
    #pragma unroll
    for (int i = 0; i < 4; ++i) { const int row = i * 8 + (lane >> 3), ch = lane & 7; const u32x4 v = *(const u32x4*)(stg + row * 64 + ch * 8); ATTN_STORE16(Ow + (long)row * QP + ch * 8, v); } }
  asm volatile("s_waitcnt lgkmcnt(0)\n\ts_barrier" ::: "memory");
  #undef DMA_K
  #undef DMA_V
  #undef ROWOFF
  #undef CMASK
  #undef ROT
}
template <int MODE, int XV = 0> __device__ __forceinline__ void attn_unit_f8d(long qrow, long kvrow, int q0, int qcol, int kst, int vst, int NT, float sink2, float cref, const unsigned char* Qf8, const unsigned char* KVT, bf16* O, char* shm) {
  int tid_ = threadIdx.x; asm volatile("" : "+v"(tid_));
  const int tid = tid_, lane = tid & 63, r32 = lane & 31, hi = lane >> 5; const int wid = __builtin_amdgcn_readfirstlane(tid >> 6);
  constexpr int SL = 4096, NS = 5, LK = 0, LV = NS * SL, LOST = LV + NS * SL, TILEB = 32768;
  const unsigned lds0 = (unsigned)(uintptr_t)shm;
  const unsigned char* tile0 = KVT + (size_t)(kvrow >> 6) * TILEB + wid * 512 + (lane & 31) * 16;
  const unsigned char* ksrc = tile0 + kst * SL; const unsigned char* vsrc = tile0 + 4 * SL + vst * SL;
  const unsigned kdst = lds0 + LK + wid * 512, vdst = lds0 + LV + wid * 512;
  #define ROWOFF(t) ((long)(MODE == 1 ? ((t) + ((t) >= 4 ? ((q0 - 128) >> 6) : 0)) : (t)) * TILEB)
  #define DMA_K(t, slot) glds16h(ksrc + ROWOFF(t), (unsigned)__builtin_amdgcn_readfirstlane(kdst + (slot)))
  #define DMA_V(t, slot) glds16h(vsrc + ROWOFF(t), (unsigned)__builtin_amdgcn_readfirstlane(vdst + (slot)))
  const lds_cptr shm3 = (lds_cptr)shm;
  const int ksw = (r32 >> 2) & 3;
  const lds_cptr fq0 = shm3 + r32 * 64 + (((2 * hi) ^ ksw) * 16), fq1 = shm3 + r32 * 64 + (((2 * hi + 1) ^ ksw) * 16);
  DMA_K(0, 0); DMA_K(1, SL); DMA_K(2, 2 * SL); DMA_V(0, 0); DMA_K(3, 3 * SL); DMA_V(1, SL); if (4 < NT) { DMA_K(4, 4 * SL); } DMA_V(2, 2 * SL);
  v8i_t qf;
  { const v4i_t* qp = (const v4i_t*)(Qf8 + (size_t)(qrow + wid * QBLK + r32) * 1024 + qcol + hi * 32); const v4i_t a = qp[0], b = qp[1]; qf = (v8i_t){a[0], a[1], a[2], a[3], b[0], b[1], b[2], b[3]}; }
  f32x16 o[2]; o[0] = f32x16{}; o[1] = f32x16{}; f32x16 osum = f32x16{};
  f32x16 cinit;
  #pragma unroll
  for (int r = 0; r < 16; ++r) cinit[r] = 60.5f - 4.0f * cref;
  asm volatile("" : "+v"(cinit));
  v8i_t ones8;
  #pragma unroll
  for (int i = 0; i < 8; ++i) ones8[i] = 0x38383838;
  asm volatile("" : "+v"(ones8));
  const int qrel = wid * QBLK + r32;
  int mlo = -128, mhi = 128;
  if (MODE == 1) { const int qi = q0 + qrel; mlo = (-qi > -128) ? -qi : -128; mhi = (SEQ - 1 - qi < 128) ? (SEQ - 1 - qi) : 128; }
  const unsigned mspan = (unsigned)(mhi - mlo);
  #define CMASK(P0, P1, t) do { if (MODE == 1) { if ((t) >= 4) bandmask(P0, P1, (t), mlo, mspan, qrel, hi); } } while (0)
  #define MFQK(kfr) __builtin_amdgcn_mfma_scale_f32_32x32x64_f8f6f4(kfr, qf, cinit, 0, 0, 0, 0x7F7F7F7F, 0, 0x7F7F7F7F)
  #define MFPV(pfr, bfr, cin) __builtin_amdgcn_mfma_scale_f32_32x32x64_f8f6f4(pfr, bfr, cin, 1, 0, 0, 0x7F7F7F7F, 0, 0x7F7F7F7F)
  #define FLOAD(dst, base, b, slot) do { const v4i_t a_ = *(const LAS v4i_t*)(fq0 + (base) + (slot) + (b) * 2048), b_ = *(const LAS v4i_t*)(fq1 + (base) + (slot) + (b) * 2048); dst = (v8i_t){a_[0], a_[1], a_[2], a_[3], b_[0], b_[1], b_[2], b_[3]}; } while (0)
  #define PK4(x0, x1, x2, x3) (int)__builtin_amdgcn_cvt_pk_u8_f32(x3, 3, __builtin_amdgcn_cvt_pk_u8_f32(x2, 2, __builtin_amdgcn_cvt_pk_u8_f32(x1, 1, __builtin_amdgcn_cvt_pk_u8_f32(x0, 0, 0u))))
  #define PACKP(PF, X0, X1) do { PF[0] = PK4(X0[0], X0[1], X0[2], X0[3]); PF[1] = PK4(X0[4], X0[5], X0[6], X0[7]); PF[2] = PK4(X0[8], X0[9], X0[10], X0[11]); PF[3] = PK4(X0[12], X0[13], X0[14], X0[15]); \
                                 PF[4] = PK4(X1[0], X1[1], X1[2], X1[3]); PF[5] = PK4(X1[4], X1[5], X1[6], X1[7]); PF[6] = PK4(X1[8], X1[9], X1[10], X1[11]); PF[7] = PK4(X1[12], X1[13], X1[14], X1[15]); asm volatile("" : "+v"(PF)); } while (0)
  int sl_prev = 0, sl_cur = 0, sl_next = SL;
  #define SLADD(s, k) (((s) + (k) * SL >= NS * SL) ? (s) + (k) * SL - NS * SL : (s) + (k) * SL)
  #define ROT() do { sl_prev = sl_cur; sl_cur = sl_next; sl_next = SLADD(sl_next, 1); } while (0)
  if (NT >= 5) { WAIT_BAR(7); } else { WAIT_BAR(0); }
  v8i_t kf0, kf1, vf0, vf1, pfA, pfB;
  f32x16 x0, x1;
  FLOAD(kf0, LK, 0, 0); FLOAD(kf1, LK, 1, 0);
  x0 = MFQK(kf0); x1 = MFQK(kf1);
  CMASK(x0, x1, 0);
  PACKP(pfA, x0, x1);
  if (NT >= 5) { WAIT_BAR(4); } else { WAIT_BAR(0); }
  if (5 < NT) { DMA_K(5, 0); } if (3 < NT) { DMA_V(3, 3 * SL); }
  ROT();
  FLOAD(kf0, LK, 0, sl_cur); FLOAD(kf1, LK, 1, sl_cur);
  asm volatile("s_waitcnt lgkmcnt(0)\n\ts_barrier" ::: "memory");
  #define PKQ(PF, i, X, B) do { if (XV == 1) PF[i] = (int)__builtin_amdgcn_cvt_pk_u8_f32(X[B], 0, 0u); else PF[i] = PK4(X[B], X[(B) + 1], X[(B) + 2], X[(B) + 3]); } while (0)
  #define STEP(PFP, PFN, t, GK, GV, GL) do { SBAR(); \
    x0 = MFQK(kf0); SBAR(); \
    if (XV != 2) { FLOAD(vf0, LV, 0, sl_prev); } SBAR(); \
    x1 = MFQK(kf1); SBAR(); \
    if (XV != 2) { FLOAD(vf1, LV, 1, sl_prev); } SBAR(); \
    osum = MFPV(PFP, ones8, osum); asm volatile("" : "+v"(osum)); SBAR(); \
    if ((GL) && XV != 2) { FLOAD(kf0, LK, 0, sl_next); SBAR(); } \
    CMASK(x0, x1, t); \
    PKQ(PFN, 0, x0, 0); PKQ(PFN, 1, x0, 4); PKQ(PFN, 2, x0, 8); PKQ(PFN, 3, x0, 12); asm volatile("" : "+v"(PFN)); SBAR(); \
    o[0] = MFPV(PFP, vf0, o[0]); asm volatile("" : "+v"(o[0])); SBAR(); \
    if ((GL) && XV != 2) { FLOAD(kf1, LK, 1, sl_next); SBAR(); } \
    PKQ(PFN, 4, x1, 0); PKQ(PFN, 5, x1, 4); asm volatile("" : "+v"(PFN)); SBAR(); \
    o[1] = MFPV(PFP, vf1, o[1]); asm volatile("" : "+v"(o[1])); SBAR(); \
    PKQ(PFN, 6, x1, 8); PKQ(PFN, 7, x1, 12); asm volatile("" : "+v"(PFN)); SBAR(); \
    if (XV != 3) { if (GK) { DMA_K((t) + 5, sl_cur); } if (GV) { DMA_V((t) + 3, SLADD(sl_cur, 3)); } } \
    } while (0)
  int t = 1;
  for (; t + 6 < NT; t += 2) {
    STEP(pfA, pfB, t, true, true, true);     WAIT_BAR(6); ROT();
    STEP(pfB, pfA, t + 1, true, true, true);   WAIT_BAR(6); ROT();
  }
  for (; t + 1 < NT; t += 2) {
    STEP(pfA, pfB, t, (t + 5 < NT), (t + 3 < NT), (t + 1 < NT));       WAIT_BAR(0); ROT();
    STEP(pfB, pfA, t + 1, (t + 6 < NT), (t + 4 < NT), (t + 2 < NT));     WAIT_BAR(0); ROT();
  }
  STEP(pfA, pfB, NT - 1, false, false, false);
  { FLOAD(vf0, LV, 0, sl_cur); FLOAD(vf1, LV, 1, sl_cur); osum = MFPV(pfB, ones8, osum); o[0] = MFPV(pfB, vf0, o[0]); o[1] = MFPV(pfB, vf1, o[1]); }
  #undef PACKP
  #undef PKQ
  #undef PK4
  #undef STEP
  #undef MFQK
  #undef MFPV
  #undef FLOAD
  const float sterm = __builtin_amdgcn_exp2f(sink2 - cref);
  float rli[16];
  #pragma unroll
  for (int r = 0; r < 16; ++r) rli[r] = __builtin_amdgcn_rcpf(osum[r] + sterm);
  bf16* Ow = O + (qrow + wid * QBLK) * QP + qcol;
  { bf16* stg = (bf16*)(shm + LOST) + wid * 2048;
    #pragma unroll
    for (int r = 0; r < 16; ++r) { const int orow = crow(r, hi);
      #pragma unroll
      for (int d0 = 0; d0 < 2; ++d0) stg[orow * 64 + d0 * 32 + r32] = __float2bfloat16(o[d0][r] * rli[r]); }
    asm volatile("s_waitcnt lgkmcnt(0)" ::: "memory");
    #pragma unroll
    for (int i = 0; i < 4; ++i) { const int row = i * 8 + (lane >> 3), ch = lane & 7; const u32x4 v = *(const u32x4*)(stg + row * 64 + ch * 8); ATTN_STORE16(Ow + (long)row * QP + ch * 8, v); } }
  asm volatile("s_waitcnt lgkmcnt(0)\n\ts_barrier" ::: "memory");
  #undef DMA_K
  #undef DMA_V
  #undef ROWOFF
  #undef CMASK
  #undef ROT
  #undef SLADD
}
constexpr int ATTN_LDS_BYTES = LDS_BYTES;
#undef SBAR
#undef WAIT_BAR
}

struct Args { const float* in[20]; float* out; unsigned char* ws; int ph_lo, ph_hi; };
typedef const Args __attribute__((address_space(4)))* kargp_t;
__device__ __forceinline__ kargp_t kargs() { auto p = __builtin_amdgcn_kernarg_segment_ptr(); asm volatile("" : "+s"(p)); return (kargp_t)p; }
enum { I_X = 0, I_C, I_CTX, I_CCTX, I_ADAW, I_ADAB, I_GATTN, I_GFFN, I_WIN, I_QNG, I_KNG, I_QNL, I_KNL, I_SINK, I_WOUT, I_RW, I_RB, I_WGATE, I_WUP, I_WDOWN };
struct Frame {
    LAS unsigned char* lds; volatile LAS unsigned* MISC;
    int tid, lane, wave, vcu, G;
};
#define WSP(T, off) ((T*)(kargs()->ws + (off)))
__device__ const float ROPE_INV[16] = {1.000000000e+00f, 5.623413324e-01f, 3.162277639e-01f, 1.778279394e-01f, 1.000000015e-01f, 5.623413250e-02f, 3.162277490e-02f, 1.778279431e-02f,
                                       9.999999776e-03f, 5.623413250e-03f, 3.162277630e-03f, 1.778279431e-03f, 1.000000047e-03f, 5.623413017e-04f, 3.162277571e-04f, 1.778279402e-04f};

template <int KIND> __device__ __forceinline__ int dst_row(int n) {
    if (KIND == 0) return n;
    if (KIND == 2) return ((n >> 7) << 8) + (n & 127);
    if (KIND == 3) return ((n >> 7) << 8) + 128 + (n & 127);
    int tile, wc;
    if (n < 512) { const int h = n >> 6; tile = h >> 2; wc = h & 3; }
    else if (n < 640) { tile = 4; wc = (n - 512) >> 6; }
    else if (n < 768) { tile = 4; wc = 2 + ((n - 640) >> 6); }
    else if (n < 1280) { const int h = (n - 768) >> 6; tile = 2 + (h >> 2); wc = h & 3; }
    else if (n < 1408) { tile = 5; wc = (n - 1280) >> 6; }
    else { tile = 5; wc = 2 + ((n - 1408) >> 6); }
    const int d = n & 63, bj = d >> 5, dd = d & 31, np = dd >> 4, f = dd & 15, fq = f >> 2, j = f & 3;
    return 256 * tile + 128 * bj + 32 * wc + 8 * fq + 4 * np + j;
}
template <int KIND> __device__ __forceinline__ void p0_transpose_item(const float* W, int N, bf16_t* WT, int Kd, LAS float* scr, int kb, int nb, int lane) {
    const int k0 = 64 * kb, n0 = 32 * nb;
#pragma unroll 8
    for (int i = 0; i < 32; ++i) { const int kk = 2 * i + (lane >> 5); scr[kk * 33 + (lane & 31)] = W[(size_t)(k0 + kk) * N + n0 + (lane & 31)]; }
    LDS_WAIT(); asm volatile("" ::: "memory");
    const int c = lane & 7;
#pragma unroll
    for (int j = 0; j < 4; ++j) { const int n = (lane >> 3) + 8 * j; const LAS float* s = scr + (8 * c) * 33 + n;
        u32x4 o; o.x = pk2(s[0 * 33], s[1 * 33]); o.y = pk2(s[2 * 33], s[3 * 33]); o.z = pk2(s[4 * 33], s[5 * 33]); o.w = pk2(s[6 * 33], s[7 * 33]);
        *(GAS u32x4*)(WT + (size_t)dst_row<KIND>(n0 + n) * Kd + k0 + 8 * c) = o; }
    LDS_WAIT(); asm volatile("" ::: "memory");
}
__device__ __forceinline__ void sincos_d(float ang, float& cs, float& sn) {
    const double x = (double)ang; const double kq = __builtin_rint(x * 0.63661977236758134308);
    const double r = (x - kq * 1.5707963267948966192) - kq * 6.123233995736766036e-17, r2 = r * r;
    const double s = r * (1.0 + r2 * (-1.0 / 6 + r2 * (1.0 / 120 + r2 * (-1.0 / 5040 + r2 * (1.0 / 362880 + r2 * (-1.0 / 39916800 + r2 * (1.0 / 6227020800.0)))))));
    const double c = 1.0 + r2 * (-0.5 + r2 * (1.0 / 24 + r2 * (-1.0 / 720 + r2 * (1.0 / 40320 + r2 * (-1.0 / 3628800 + r2 * (1.0 / 479001600.0 + r2 * (-1.0 / 87178291200.0)))))));
    const int q = ((int)kq) & 3;
    const double cc = (q == 0) ? c : (q == 1) ? -s : (q == 2) ? -c : s;
    const double ss = (q == 0) ? s : (q == 1) ? c : (q == 2) ? -s : -c;
    cs = (float)cc; sn = (float)ss;
}
__device__ __forceinline__ void p0_prologue(Frame& F) {
    const int gw = F.vcu * NWAVES + F.wave, NGW = F.G * NWAVES;
    {
        const float* c = kargs()->in[I_C]; const float* cctx = kargs()->in[I_CCTX]; const float* ada_w = kargs()->in[I_ADAW]; const float* ada_b = kargs()->in[I_ADAB];
        float* modv = WSP(float, WS_MODV);
        LAS float* sv = (LAS float*)(F.lds);
        LAS float* part = (LAS float*)(F.lds + 16384);
        for (int i = F.tid; i < 3072; i += NWAVES * 64) { const int v = i >> 10, k = i & 1023; const float cv = v < 2 ? c[v * 1024 + k] : cctx[k]; sv[i] = cv / (1.0f + expf(-cv)); }
        __syncthreads();
        for (int tile = F.vcu; tile < NLAYER * 96; tile += F.G) {
            const int l = tile / 96, c0 = (tile % 96) * 64;
            const float* W = ada_w + (size_t)l * 1024 * 6144 + c0 + F.lane;
            float a0 = 0.f, a1 = 0.f, a2 = 0.f; const int kb = F.wave * 128;
#pragma unroll 8
            for (int k = 0; k < 128; ++k) { const float w = W[(size_t)(kb + k) * 6144]; a0 += sv[kb + k] * w; a1 += sv[1024 + kb + k] * w; a2 += sv[2048 + kb + k] * w; }
            part[(F.wave * 3 + 0) * 64 + F.lane] = a0; part[(F.wave * 3 + 1) * 64 + F.lane] = a1; part[(F.wave * 3 + 2) * 64 + F.lane] = a2;
            __syncthreads();
            if (F.tid < 192) { const int v = F.tid >> 6, col = F.tid & 63; float s = ada_b[l * 6144 + c0 + col];
#pragma unroll
                for (int w = 0; w < 8; ++w) s += part[(w * 3 + v) * 64 + col];
                modv[(size_t)(l * 3 + v) * 6144 + c0 + col] = s; }
            __syncthreads();
        }
    }
    { float* rope = WSP(float, WS_ROPE); const int gt = F.vcu * NWAVES * 64 + F.tid; if (gt < 4096) { const int pos = gt >> 4, f = gt & 15; const float ang = (float)pos * ROPE_INV[f]; float cs, sn; sincos_d(ang, cs, sn); rope[gt * 2] = cs; rope[gt * 2 + 1] = sn; } }
    { const int gt = F.vcu * NWAVES * 64 + F.tid; if (gt < NLAYER * 256) { const int l = gt >> 8, kq = (gt >> 6) & 3, d = gt & 63; const float* src = kargs()->in[kq == 0 ? I_QNG : (kq == 1 ? I_QNL : (kq == 2 ? I_KNG : I_KNL))]; WSP(float, WS_GN)[gt] = src[l * 64 + d]; } }
    if (gw < NLAYER * 2) { const int l = gw >> 1, loc = gw & 1; float mq = fabsf(kargs()->in[loc ? I_QNL : I_QNG][l * 64 + F.lane]), mk = fabsf(kargs()->in[loc ? I_KNL : I_KNG][l * 64 + F.lane]);
#pragma unroll
        for (int o = 1; o < 64; o <<= 1) { mq = fmaxf(mq, __shfl_xor(mq, o)); mk = fmaxf(mk, __shfl_xor(mk, o)); }
        if (F.lane == 0) WSP(float, WS_BND)[gw] = 64.0f * C2 * mq * mk * 1.02f + 0.05f; }
    { u32x4* p = (u32x4*)(WSP(unsigned char, WS_KV) + (size_t)(NROW / 64) * KV_TILEB); for (int i = F.vcu * NWAVES * 64 + F.tid; i < 4 * KV_TILEB / 16; i += F.G * NWAVES * 64) p[i] = (u32x4){0u, 0u, 0u, 0u}; }
    {
        const float* x = kargs()->in[I_X]; const float* ctx = kargs()->in[I_CTX]; bf16_t* XS = WSP(bf16_t, WS_XS);
        for (int R = gw; R < NROW; R += NGW) {
            const int b = R >= RB ? 1 : 0, rr = R - b * RB;
            const float* src = rr < NCTX ? ctx + (size_t)(b * NCTX + rr) * 1024 : x + (size_t)(b * SEQ + rr - NCTX) * 1024;
            const f32x4* s4 = (const f32x4*)src + F.lane; u32x2* d2 = (u32x2*)(XS + (size_t)R * 1024) + F.lane;
            f32x4 v[4];
#pragma unroll
            for (int j = 0; j < 4; ++j) v[j] = s4[64 * j];
#pragma unroll
            for (int j = 0; j < 4; ++j) { u32x2 w; w.x = pk2(v[j][0], v[j][1]); w.y = pk2(v[j][2], v[j][3]); d2[64 * j] = w; }
        }
    }
    {
        LAS float* scr = (LAS float*)(F.lds + RING_OFF + F.wave * 16384);
        constexpr int I_IN = 4 * 768, I_OUT = 4 * 512, I_G = 64 * 256, I_U = 64 * 256, I_D = 64 * 256;
        for (int it0 = gw; it0 < I_IN + I_OUT + I_G + I_U + I_D; it0 += NGW) {
            int it = it0;
            if (it < I_IN) { const int l = it / 768, r = it % 768; p0_transpose_item<1>(kargs()->in[I_WIN] + (size_t)l * 1024 * 1536, 1536, WSP(bf16_t, WS_WIN) + (size_t)l * 1536 * 1024, 1024, scr, r / 48, r % 48, F.lane); continue; } it -= I_IN;
            if (it < I_OUT) { const int l = it / 512, r = it % 512; p0_transpose_item<0>(kargs()->in[I_WOUT] + (size_t)l * 1024 * 1024, 1024, WSP(bf16_t, WS_WOUT) + (size_t)l * 1024 * 1024, 1024, scr, r / 32, r % 32, F.lane); continue; } it -= I_OUT;
            if (it < I_G) { const int m = it / 256, r = it % 256; p0_transpose_item<2>(kargs()->in[I_WGATE] + (size_t)m * 1024 * 512, 512, WSP(bf16_t, WS_WGU) + (size_t)m * 1024 * 1024, 1024, scr, r / 16, r % 16, F.lane); continue; } it -= I_G;
            if (it < I_U) { const int m = it / 256, r = it % 256; p0_transpose_item<3>(kargs()->in[I_WUP] + (size_t)m * 1024 * 512, 512, WSP(bf16_t, WS_WGU) + (size_t)m * 1024 * 1024, 1024, scr, r / 16, r % 16, F.lane); continue; } it -= I_U;
            { const int m = it / 256, r = it % 256; p0_transpose_item<0>(kargs()->in[I_WDOWN] + (size_t)m * 512 * 1024, 1024, WSP(bf16_t, WS_WD) + (size_t)m * 1024 * 512, 512, scr, r / 32, r % 32, F.lane); }
        }
    }
}

__device__ __forceinline__ void load_row(const bf16_t* xrow, int lane, f32x4 (&h)[4]) {
    const u32x2* xr = (const u32x2*)xrow + lane;
#pragma unroll
    for (int j = 0; j < 4; ++j) { const u32x2 w = xr[64 * j]; h[j] = (f32x4){__builtin_bit_cast(float, w.x << 16), __builtin_bit_cast(float, w.x & 0xffff0000u), __builtin_bit_cast(float, w.y << 16), __builtin_bit_cast(float, w.y & 0xffff0000u)}; }
}
__device__ __forceinline__ void rms_mod(const float* g, const float* sh, const float* sc, int lane, f32x4 (&h)[4]) {
    float ss = 0.f;
#pragma unroll
    for (int j = 0; j < 4; ++j) ss += (h[j][0] * h[j][0] + h[j][1] * h[j][1]) + (h[j][2] * h[j][2] + h[j][3] * h[j][3]);
    const float rs = 1.0f / sqrtf(wave_sum(ss) * (1.0f / 1024.0f) + NORM_EPS);
#pragma unroll
    for (int j = 0; j < 4; ++j) { const f32x4 gg = ((const f32x4*)g)[lane + 64 * j], s1 = ((const f32x4*)sh)[lane + 64 * j], s2 = ((const f32x4*)sc)[lane + 64 * j];
        h[j] = (h[j] * rs * gg) * (1.0f + s2) + s1; }
}
__device__ __forceinline__ void store_row_bf16(bf16_t* orow, int lane, const f32x4 (&h)[4]) {
    u32x2* o8 = (u32x2*)orow + lane;
#pragma unroll
    for (int j = 0; j < 4; ++j) { u32x2 w; w.x = pk2(h[j][0], h[j][1]); w.y = pk2(h[j][2], h[j][3]); o8[64 * j] = w; }
}
__device__ __forceinline__ int row_mv(int R) { const int b = R >= RB ? 1 : 0; return (R - b * RB) < NCTX ? 2 : b; }

__device__ __forceinline__ void phase_norm1(Frame& F0, int l) {
    Frame F = F0; asm volatile("" : "+v"(F.tid), "+v"(F.lane), "+s"(F.wave), "+s"(F.vcu));
    const int gw = F.vcu * NWAVES + F.wave, NGW = F.G * NWAVES;
    const float* g = kargs()->in[I_GATTN] + l * 1024; const float* modv = WSP(float, WS_MODV); const bf16_t* XS = WSP(bf16_t, WS_XS); bf16_t* HN = WSP(bf16_t, WS_HN);
    f32x4 xn[4]; if (gw < NROW) load_row(XS + (size_t)gw * 1024, F.lane, xn);
    for (int R = gw; R < NROW; R += NGW) {
        const float* mv = modv + (size_t)(l * 3 + row_mv(R)) * 6144;
        f32x4 h[4];
#pragma unroll
        for (int j = 0; j < 4; ++j) h[j] = xn[j];
        if (R + NGW < NROW) load_row(XS + (size_t)(R + NGW) * 1024, F.lane, xn);
        rms_mod(g, mv + 0, mv + 1024, F.lane, h);
        store_row_bf16(HN + (size_t)R * 1024, F.lane, h);
    }
}
__device__ __forceinline__ void phase_norm2_router(Frame& F0, int l, bool lastl, bool dry = false) {
    Frame F = F0; asm volatile("" : "+v"(F.tid), "+v"(F.lane), "+s"(F.wave), "+s"(F.vcu));
    const int gw = F.vcu * NWAVES + F.wave, NGW = F.G * NWAVES;
    LAS f32x4* RW = (LAS f32x4*)(F.lds + RING_OFF);
    { const float* router_w = kargs()->in[I_RW];
      for (int idx = F.tid; idx < 4096; idx += NWAVES * 64) { const int j = idx >> 10, e = (idx >> 6) & 15, ln = idx & 63, c = 4 * ln + 256 * j;
        RW[idx] = (f32x4){router_w[(c + 0) * 16 + e], router_w[(c + 1) * 16 + e], router_w[(c + 2) * 16 + e], router_w[(c + 3) * 16 + e]}; } }
    __syncthreads();
    const float* g = kargs()->in[I_GFFN] + l * 1024; const float* router_b = kargs()->in[I_RB];
    LAS float* PS = (LAS float*)(F.lds + RING_OFF + 65536) + F.wave * (16 * 65);
    const float* modv = WSP(float, WS_MODV); const bf16_t* XS = WSP(bf16_t, WS_XS); bf16_t* HN = WSP(bf16_t, WS_HN);
    int my_cls = -1, my_tok = 0; float my_wlo = 0.f, my_whi = 0.f;
    int k = 0;
    f32x4 xn[4]; if (gw < NROW) load_row(XS + (size_t)gw * 1024, F.lane, xn);
    for (int R = gw; R < NROW; R += NGW, ++k) {
        const int mvi = row_mv(R);
        f32x4 h[4];
#pragma unroll
        for (int j = 0; j < 4; ++j) h[j] = xn[j];
        if (R + NGW < NROW) load_row(XS + (size_t)(R + NGW) * 1024, F.lane, xn);
        if (lastl && mvi == 2) continue;
        const float* mv = modv + (size_t)(l * 3 + mvi) * 6144;
        rms_mod(g, mv + 3072, mv + 4096, F.lane, h);
        store_row_bf16(HN + (size_t)R * 1024, F.lane, h);
        {
            float s[16];
#pragma unroll
            for (int e = 0; e < 16; ++e) s[e] = 0.f;
#pragma unroll
            for (int j = 0; j < 4; ++j)
#pragma unroll
                for (int e = 0; e < 16; ++e) { const f32x4 w4 = RW[(j * 16 + e) * 64 + F.lane]; s[e] += (h[j][0] * w4[0] + h[j][1] * w4[1]) + (h[j][2] * w4[2] + h[j][3] * w4[3]); }
#pragma unroll
            for (int e = 0; e < 16; ++e) PS[e * 65 + F.lane] = s[e];
        }
        float tl = 0.f;
        { const LAS float* pr = PS + (F.lane & 15) * 65 + (F.lane >> 4) * 16;
#pragma unroll
          for (int i = 0; i < 16; ++i) tl += pr[i]; }
        tl += __shfl_xor(tl, 16); tl += __shfl_xor(tl, 32);
        const float my_sc = 1.0f / (1.0f + expf(-tl)), my_sel = my_sc + router_b[F.lane & 15];
        float sc[16], sel[16];
#pragma unroll
        for (int e = 0; e < 16; ++e) { sc[e] = __builtin_bit_cast(float, __builtin_amdgcn_readlane(__builtin_bit_cast(int, my_sc), e)); sel[e] = __builtin_bit_cast(float, __builtin_amdgcn_readlane(__builtin_bit_cast(int, my_sel), e)); }
        float gs[4];
#pragma unroll
        for (int gq = 0; gq < 4; ++gq) { const float a = sel[4 * gq], b = sel[4 * gq + 1], c = sel[4 * gq + 2], d = sel[4 * gq + 3];
            const float h1 = fmaxf(a, b), l1 = fminf(a, b), h2 = fmaxf(c, d), l2 = fminf(c, d);
            gs[gq] = fmaxf(h1, h2) + fmaxf(fminf(h1, h2), fmaxf(l1, l2)); }
        int gi = 0; float bg = gs[0];
#pragma unroll
        for (int gq = 1; gq < 4; ++gq) if (gs[gq] > bg) { bg = gs[gq]; gi = gq; }
        float s4[4], c4[4];
#pragma unroll
        for (int q = 0; q < 4; ++q) { s4[q] = sel[q]; c4[q] = sc[q]; }
#pragma unroll
        for (int gq = 1; gq < 4; ++gq)
#pragma unroll
            for (int q = 0; q < 4; ++q) { s4[q] = (gi == gq) ? sel[4 * gq + q] : s4[q]; c4[q] = (gi == gq) ? sc[4 * gq + q] : c4[q]; }
        int i1 = 0; float b1 = s4[0], w1 = c4[0];
#pragma unroll
        for (int q = 1; q < 4; ++q) if (s4[q] > b1) { b1 = s4[q]; i1 = q; w1 = c4[q]; }
        int i2 = -1; float b2 = -INFINITY, w2 = 0.f;
#pragma unroll
        for (int q = 0; q < 4; ++q) if (q != i1 && (i2 < 0 || s4[q] > b2)) { b2 = s4[q]; i2 = q; w2 = c4[q]; }
        const float wsum = w1 + w2; w1 = w1 / wsum; w2 = w2 / wsum;
        const int ia = i1 < i2 ? i1 : i2, ib = i1 < i2 ? i2 : i1;
        const float wlo = i1 < i2 ? w1 : w2, whi = i1 < i2 ? w2 : w1;
        const int pidx = ia == 0 ? ib - 1 : (ia == 1 ? ib + 1 : 5);
        if (F.lane == k) { my_cls = gi * 6 + pidx; my_tok = R; my_wlo = wlo; my_whi = whi; }
    }
    if (my_cls >= 0 && !dry) {
        const unsigned pos = __hip_atomic_fetch_add(WSP(unsigned, WS_CTL) + CW_CNT + (l * NCLS + my_cls) * 64, 1u, RLX_AGENT);
        WSP(int, WS_TOK)[(size_t)my_cls * CAP + pos] = my_tok; WSP(f32x2, WS_WTS)[(size_t)my_cls * CAP + pos] = (f32x2){my_wlo, my_whi};
    }
    __syncthreads();
}
__device__ __forceinline__ int moe_tables(Frame& F0, int l) {
    Frame F = F0; asm volatile("" : "+v"(F.tid));
    LAS int* s_n = (LAS int*)(F.lds + MOE_OFF); LAS int* s_ts = s_n + 32;
    __syncthreads();
    if (F.tid < NCLS) s_n[F.tid] = (int)__hip_atomic_load(WSP(unsigned, WS_CTL) + CW_CNT + (l * NCLS + F.tid) * 64, RLX_AGENT);
    __syncthreads();
    if (F.tid == 0) { int acc = 0; for (int c = 0; c < NCLS; ++c) { s_ts[c] = acc; acc += (s_n[c] + 255) >> 8; } s_ts[NCLS] = acc; }
    __syncthreads();
    return s_ts[NCLS];
}

constexpr int NPHASE = 1 + 7 * NLAYER;
__global__ void __launch_bounds__(NWAVES * 64, 2) fwd_kernel(Args args) {
    extern __shared__ __attribute__((aligned(16))) unsigned char lds[];
    Frame F;
    F.lds = (LAS unsigned char*)lds; F.MISC = (volatile LAS unsigned*)(F.lds + MISC_OFF);
    F.tid = threadIdx.x; F.lane = F.tid & 63; F.wave = __builtin_amdgcn_readfirstlane(F.tid >> 6);
    F.G = gridDim.x; { const int bx = blockIdx.x; F.vcu = (F.G % 8 == 0) ? (bx % 8) * (F.G / 8) + bx / 8 : bx; }
    for (int u = F.tid; u < (LDS_BYTES - LDSCTL_OFF) / 4; u += NWAVES * 64) ((LAS unsigned*)(F.lds + LDSCTL_OFF))[u] = 0u;
    __syncthreads();
    const int lo = args.ph_lo, hi = args.ph_hi;
    XcdBarrier bar; bar.bar = WSP(unsigned, WS_CTL) + CW_BAR; bar.x = 0; bar.st = nullptr;
    if (hi - lo > 1) bar = xcd_barrier_post(WSP(unsigned, WS_CTL) + CW_BAR, F.MISC + 8);
#ifndef MK_EN
#define MK_EN 0xff
#endif
#define EN(k) (((MK_EN) >> (k)) & 1)
#ifndef REP_P0
#define REP_P0 1
#endif
#ifndef REP_A
#define REP_A 1
#endif
#ifndef REP_B
#define REP_B 1
#endif
#ifndef REP_C
#define REP_C 1
#endif
#ifndef REP_F
#define REP_F 1
#endif
#ifndef REP_D
#define REP_D 1
#endif
#ifndef REP_E
#define REP_E 1
#endif
#ifndef REP_G
#define REP_G 1
#endif
#define RUN(p) (lo <= (p) && (p) < hi)
#ifndef REP_BAR
#define REP_BAR 1
#endif
#define SEAM(p) do { if (RUN(p) && RUN((p) + 1)) { xcd_barrier(bar); if (REP_BAR > 1) xcd_barrier(bar); if (REP_BAR > 2) xcd_barrier(bar); } } while (0)

    if (EN(7) && RUN(0)) { for (int rep = 0; rep < REP_P0; ++rep) { p0_prologue(F); if (rep + 1 < REP_P0) xcd_barrier(bar); } SEAM(0); }

    for (int l = 0; l < NLAYER; ++l) {
        const int pb = 1 + 7 * l; const bool lastl = (l == NLAYER - 1);
        if (EN(0) && RUN(pb + 0)) { for (int rep = 0; rep < REP_A; ++rep) { phase_norm1(F, l); if (rep + 1 < REP_A) xcd_barrier(bar); } SEAM(pb + 0); }
        if (EN(1) && RUN(pb + 1)) {
            pg8::ProbDense P; P.A = WSP(const char, WS_HN); P.B = (const char*)(WSP(bf16_t, WS_WIN) + (size_t)l * 1536 * 1024); P.lda = 1024; P.ldb = 1024; P.nt = 16; P.skip_ctx = false; P.S.init(NROW, 1536, F.G, (int)blockIdx.x);
            pg8::EpiQKV E{kargs()->ws, WSP(float, WS_GN) + l * 256, WSP(float, WS_ROPE)};
            for (int rep = 0; rep < REP_B; ++rep) { pg8::gemm_phase<pg8::EpiQKV, pg8::ProbDense, true>(F.lds + RING_OFF, F.lds + OFFS_OFF, P, E); if (rep + 1 < REP_B) xcd_barrier(bar); }
            SEAM(pb + 1);
        }
        if (EN(2) && RUN(pb + 2)) {
            const unsigned char* Qf8 = WSP(const unsigned char, WS_QO); const unsigned char* KVT = WSP(const unsigned char, WS_KV); attn_body::bf16* O = WSP(attn_body::bf16, WS_HN);
            const float* sink = kargs()->in[I_SINK] + l * 8;
            const int n0 = 1024 + (lastl ? 0 : 32);
            const float bnd_g = WSP(const float, WS_BND)[l * 2], bnd_l = WSP(const float, WS_BND)[l * 2 + 1];
#if VFP8
            const float ref_g = bnd_g - 15.5f, ref_l = bnd_l - 15.5f;
#if EXPFREE
#ifndef ATTN_BODY
#define ATTN_BODY attn_unit_f8d
#endif
#else
#define ATTN_BODY attn_unit_f8b
#endif
#else
            const float ref_g = fmaxf(bnd_g - 96.0f, 0.0f), ref_l = fmaxf(bnd_l - 96.0f, 0.0f);
#define ATTN_BODY attn_unit_f8
#endif
#ifndef PROBE_XV
#define PROBE_XV 0
#endif
            for (int rep = 0; rep < REP_C; ++rep) {
            if (PROBE_XV != 0 && rep + 1 < REP_C) {
                attn_body::bf16* OD = (attn_body::bf16*)(kargs()->ws + (size_t)524 * MiB);
                for (int L = F.vcu; L < 1024; L += F.G) { const int bh = L >> 6, b = bh >> 3, h = bh & 7, qb = L & 63;
                    attn_body::attn_unit_f8d<0, (PROBE_XV == 9 ? 0 : PROBE_XV)>((long)b * RB + NCTX + qb * 256, (long)b * RB, 0, h * 64, h >> 2, h >> 2, RB / 64, -INFINITY, ref_g, Qf8, KVT, OD, (char*)lds + RING_OFF); }
                xcd_barrier(bar); continue; }
            for (int L = F.vcu; L < n0; L += F.G) {
                long qrow, kvrow; int qcol, st, NT; float sink2 = -INFINITY, ref = ref_g;
                if (L < 1024) { const int bh = L >> 6, b = bh >> 3, h = bh & 7, qb = L & 63; qrow = (long)b * RB + NCTX + qb * 256; kvrow = (long)b * RB; NT = RB / 64; qcol = h * 64; st = h >> 2; }
                else { const int Lc = L - 1024, b = Lc >> 4, h = Lc & 15; qrow = (long)b * RB; kvrow = qrow; NT = NCTX / 64; qcol = h * 64;
                    if (h < 8) { st = h >> 2; } else { const int hl = h - 8; st = 2 + (hl >> 2); sink2 = sink[hl] * LOG2E; ref = ref_l; } }
                attn_body::ATTN_BODY<0>(qrow, kvrow, 0, qcol, st, st, NT, sink2, ref, Qf8, KVT, O, (char*)lds + RING_OFF);
            }
            for (int L = F.vcu; L < 1024; L += F.G) {
                const int bh = L >> 6, b = bh >> 3, hl = bh & 7, qb = L & 63, q0 = qb * 256;
                attn_body::ATTN_BODY<1>((long)b * RB + NCTX + q0, (long)b * RB, q0, (8 + hl) * 64, 2 + (hl >> 2), 2 + (hl >> 2), 12, sink[hl] * LOG2E, ref_l, Qf8, KVT, O, (char*)lds + RING_OFF);
            }
            if (rep + 1 < REP_C) xcd_barrier(bar); }
            SEAM(pb + 2);
        }
        if (EN(3) && RUN(pb + 3)) {
            pg8::ProbDense P; P.A = WSP(const char, WS_HN); P.B = (const char*)(WSP(bf16_t, WS_WOUT) + (size_t)l * 1024 * 1024); P.lda = 1024; P.ldb = 1024; P.nt = 16; P.skip_ctx = lastl; P.S.init(lastl ? NB * SEQ : NROW, 1024, F.G, (int)blockIdx.x);
            for (int rep = 0; rep < REP_D; ++rep) {
            pg8::EpiResid E{WSP(bf16_t, WS_XS), WSP(float, WS_MODV) + (size_t)l * 3 * 6144, 2048, (rep & 1) ? -1.0f : 1.0f};
            pg8::gemm_phase<pg8::EpiResid, pg8::ProbDense, true>(F.lds + RING_OFF, F.lds + OFFS_OFF, P, E); if (rep + 1 < REP_D) xcd_barrier(bar); }
            SEAM(pb + 3);
        }
        if (EN(4) && RUN(pb + 4)) {
#if REP_E == 2
            phase_norm2_router(F, l, lastl, true); xcd_barrier(bar);
#endif
            phase_norm2_router(F, l, lastl, false); SEAM(pb + 4); }
        if (EN(5) && RUN(pb + 5)) {
            const int ntile = moe_tables(F, l);
            pg8::ProbGU P; P.A = WSP(const char, WS_HN); P.B = (const char*)(WSP(bf16_t, WS_WGU) + (size_t)l * 16 * 1024 * 1024); P.tok = WSP(int, WS_TOK); P.s_n = (const LAS int*)(F.lds + MOE_OFF); P.s_ts = P.s_n + 32;
            P.total = ntile * 8; P.G = F.G; P.c = F.vcu; P.nt = 16;
            pg8::EpiGU E{WSP(bf16_t, WS_ACT), WSP(f32x2, WS_WTS)};
            for (int rep = 0; rep < REP_F; ++rep) { pg8::gemm_phase<pg8::EpiGU, pg8::ProbGU, true>(F.lds + RING_OFF, F.lds + OFFS_OFF, P, E); if (rep + 1 < REP_F) xcd_barrier(bar); }
            SEAM(pb + 5);
        }
        if (EN(6) && RUN(pb + 6)) {
            const int ntile = moe_tables(F, l);
            pg8::ProbDown P; P.A = WSP(const char, WS_ACT); P.B = (const char*)(WSP(bf16_t, WS_WD) + (size_t)l * 16 * 1024 * 512); P.s_n = (const LAS int*)(F.lds + MOE_OFF); P.s_ts = P.s_n + 32;
            P.total = ntile * 4; P.G = F.G; P.c = F.vcu; P.nt = 16;
            for (int rep = 0; rep < REP_G; ++rep) {
            pg8::EpiDown E{WSP(bf16_t, WS_XS), lastl ? kargs()->out : nullptr, WSP(int, WS_TOK), WSP(float, WS_MODV) + (size_t)l * 3 * 6144, (rep & 1) ? -1.0f : 1.0f};
            pg8::gemm_phase<pg8::EpiDown, pg8::ProbDown, true>(F.lds + RING_OFF, F.lds + OFFS_OFF, P, E); if (rep + 1 < REP_G) xcd_barrier(bar); }
            SEAM(pb + 6);
        }
    }
#undef RUN
#undef SEAM
}

#ifndef MK_SPLIT
#define MK_SPLIT 0
#endif
extern "C" void kernel_launch(void* const* d_in, const int* in_sizes, int n_in, void* d_out, int out_size, void* d_ws, size_t ws_size, hipStream_t stream) {
    static int grid = 0;
    if (grid == 0) {
        if (n_in != 20 || in_sizes[0] != NB * SEQ * DM || out_size != NB * SEQ * DM || ws_size < WS_END) {
            fprintf(stderr, "kernel_launch: unexpected shapes (n_in %d, in0 %d, out %d, ws %zu); nothing launched\n", n_in, n_in > 0 ? in_sizes[0] : -1, out_size, ws_size); grid = -1; return; }
        int dev = 0, cus = 0, per_cu = 0;
        if (hipGetDevice(&dev) != hipSuccess || hipDeviceGetAttribute(&cus, hipDeviceAttributeMultiprocessorCount, dev) != hipSuccess) { grid = -1; return; }
        if (hipFuncSetAttribute((const void*)fwd_kernel, hipFuncAttributeMaxDynamicSharedMemorySize, LDS_BYTES) != hipSuccess) { fprintf(stderr, "kernel_launch: hipFuncSetAttribute failed\n"); grid = -1; return; }
        if (hipOccupancyMaxActiveBlocksPerMultiprocessor(&per_cu, (const void*)fwd_kernel, NWAVES * 64, LDS_BYTES) != hipSuccess || per_cu < 1)
            fprintf(stderr, "kernel_launch: note: occupancy query reports %d workgroups per CU\n", per_cu);
        (void)hipGetLastError();
        grid = cus;
    }
    if (grid < 0) return;
    if (hipMemsetAsync((char*)d_ws + WS_CTL, 0, CTL_ZERO_BYTES, stream) != hipSuccess) return;
    Args a{};
    for (int i = 0; i < 20; ++i) a.in[i] = (const float*)d_in[i];
    a.out = (float*)d_out; a.ws = (unsigned char*)d_ws;
#if MK_SPLIT
    for (int p = 0; p < NPHASE; ++p) { a.ph_lo = p; a.ph_hi = p + 1; hipLaunchKernelGGL(fwd_kernel, dim3(grid), dim3(NWAVES * 64), LDS_BYTES, stream, a); }
#else
    a.ph_lo = 0; a.ph_hi = NPHASE;
    hipLaunchKernelGGL(fwd_kernel, dim3(grid), dim3(NWAVES * 64), LDS_BYTES, stream, a);
#endif
    const hipError_t le = hipPeekAtLastError();
    if (le != hipSuccess) fprintf(stderr, "kernel_launch: launch failed: %s\n", hipGetErrorName(le));
}
```

```cpp
#include <hip/hip_runtime.h>
#include <hip/hip_bf16.h>
#include <cstdio>
#include <cstdint>
#include <cmath>

#define LAS __attribute__((address_space(3)))
#define GAS __attribute__((address_space(1)))
typedef unsigned short bf16_t;
typedef short bf16x8 __attribute__((ext_vector_type(8)));
typedef float f32x4 __attribute__((ext_vector_type(4)));
typedef float f32x2 __attribute__((ext_vector_type(2)));
typedef unsigned u32x4 __attribute__((ext_vector_type(4)));
typedef unsigned u32x2 __attribute__((ext_vector_type(2)));
typedef GAS unsigned gu32;

constexpr int NB = 2, SEQ = 16384, DM = 1024, NCTX = 256, NLAYER = 4, NEXP = 16, DEXP = 512;
constexpr int RB = SEQ + NCTX;
constexpr int NROW = NB * RB;
constexpr int NCLS = 24, CAP = NROW;
constexpr int MAXSLOT = 39424;
constexpr float NORM_EPS = 1e-6f;
constexpr float C2 = 0.125f * 1.4426950408889634f;
constexpr float LOG2E = 1.4426950408889634f;
#ifndef VFP8
#define VFP8 1
#endif
#ifndef INPROJ_F8
#define INPROJ_F8 1
#endif
constexpr float WSCALE_INV = INPROJ_F8 ? (1.0f / 32.0f) : 1.0f;
#ifndef OPROJ_F8
#define OPROJ_F8 1
#endif
#ifndef EXPFREE
#define EXPFREE 1
#endif
constexpr int KV_VSL = VFP8 ? 4096 : 8192, KV_TILEB = 16384 + 4 * KV_VSL;
constexpr float SQC2 = 0.42466090014400953f;

constexpr size_t MiB = 1u << 20;
constexpr size_t WS_CTL = 0, CTL_ZERO_BYTES = 1 * MiB;
constexpr size_t WS_MODV = 1 * MiB;
constexpr size_t WS_ROPE = 2 * MiB;
constexpr size_t WS_GN = 3 * MiB;
constexpr size_t WS_BND = 3 * MiB + 8192;
constexpr size_t WS_TOK = 4 * MiB;
constexpr size_t WS_WTS = 8 * MiB;
constexpr size_t WS_WIN = 16 * MiB;
constexpr size_t WS_WOUT = 28 * MiB;
constexpr size_t WS_WGU = 36 * MiB;
constexpr size_t WS_WD = 164 * MiB;
constexpr size_t WS_XS = 228 * MiB;
constexpr size_t WS_HN = 358 * MiB;
constexpr size_t WS_QO = 423 * MiB;
constexpr size_t WS_KV = 488 * MiB;
constexpr size_t WS_ACT = 423 * MiB;
constexpr size_t WS_HN8 = 524 * MiB;
constexpr size_t WS_END = 558 * MiB;
static_assert(WS_TOK + (size_t)NCLS * CAP * 4 <= WS_WTS && WS_WTS + (size_t)NCLS * CAP * 8 <= WS_WIN, "lists");
static_assert(WS_KV + (size_t)(NROW + 256) * 512 * 2 <= WS_END && WS_ACT + (size_t)MAXSLOT * 1024 * 2 <= WS_END, "ws map");
constexpr int CW_TMO = 0, CW_CODE = 1, CW_BAR = 4096, CW_CNT = 8192;

constexpr int RING_OFF = 0, RING_BYTES = 131072;
constexpr int LDSCTL_OFF = RING_BYTES, MISC_OFF = LDSCTL_OFF + 320, MOE_OFF = LDSCTL_OFF + 1024, OFFS_OFF = LDSCTL_OFF + 2048  ;
constexpr int LDS_BYTES = 147456;
constexpr int NWAVES = 8;

#define LDS_WAIT() asm volatile("s_waitcnt lgkmcnt(0)" ::: "memory")
#define VM_WAIT() asm volatile("s_waitcnt vmcnt(0)" ::: "memory")
#define RLX_AGENT __ATOMIC_RELAXED, __HIP_MEMORY_SCOPE_AGENT

__device__ __forceinline__ unsigned f2bf(float f) { unsigned u = __builtin_bit_cast(unsigned, f); return (u + 0x7fffu + ((u >> 16) & 1u)) >> 16; }
__device__ __forceinline__ unsigned pk2(float lo, float hi) { return f2bf(lo) | (f2bf(hi) << 16); }
__device__ __forceinline__ unsigned cvt_pk_bf16(float lo, float hi) { unsigned r; asm volatile("v_cvt_pk_bf16_f32 %0, %1, %2" : "=v"(r) : "v"(lo), "v"(hi)); return r; }
__device__ __forceinline__ float wave_sum(float v) {
#pragma unroll
    for (int o = 1; o < 64; o <<= 1) v += __shfl_xor(v, o);
    return v;
}

#define XB_TMO      128
#define XB_XCNT(j)  (256  + 64 * (j))
#define XB_XSUB(j)  (1280 + 64 * (j))
#define XB_XGEN(j)  (2304 + 64 * (j))
#define XB_TOP      3328
#define XB_TOPGEN   3392
#define XCD_BAR_WORDS 3456
#define XB_SPIN_CAP (1u << 22)
__device__ __forceinline__ unsigned xb_ld(unsigned* p)              { return __hip_atomic_load(p, __ATOMIC_RELAXED, __HIP_MEMORY_SCOPE_AGENT); }
__device__ __forceinline__ unsigned xb_add(unsigned* p, unsigned v) { return __hip_atomic_fetch_add(p, v, __ATOMIC_RELAXED, __HIP_MEMORY_SCOPE_AGENT); }
__device__ __forceinline__ unsigned xb_xcc_id() { return (unsigned)__builtin_amdgcn_s_getreg((3 << 11) | 20) & 0xFu; }
#define XB_SPIN(cond, bar) do { unsigned _sp = 0; while (cond) { __builtin_amdgcn_s_sleep(1); \
    if ((++_sp & 255u) == 0u) { if (xb_ld(&(bar)[XB_TMO])) break; if (_sp > XB_SPIN_CAP) { atomicAdd(&(bar)[XB_TMO], 1u); break; } } } } while (0)
struct XcdBarrier { unsigned* bar; unsigned x; volatile LAS unsigned* st; };
__device__ __forceinline__ XcdBarrier xcd_barrier_post(unsigned* bar, volatile LAS unsigned* st) {
    XcdBarrier b; b.bar = bar; b.x = xb_xcc_id(); b.st = st;
    if (threadIdx.x == 0) (void)xb_add(&bar[XB_XCNT(b.x)], 1u);
    return b;
}
__device__ __forceinline__ void xcd_barrier_complete(unsigned* bar, unsigned x, unsigned& nloc, unsigned& nx) {
    const unsigned G = gridDim.x * gridDim.y * gridDim.z;
    unsigned sum, cnt, mine, sp = 0u;
    for (;;) {
        sum = 0u; cnt = 0u; mine = 0u;
#pragma unroll
        for (unsigned j = 0; j < 16; ++j) { const unsigned c = xb_ld(&bar[XB_XCNT(j)]); sum += c; cnt += (c > 0u) ? 1u : 0u; mine = (j == x) ? c : mine; }
        if (sum == G) break;
        __builtin_amdgcn_s_sleep(1);
        if ((++sp & 255u) == 0u) { if (xb_ld(&bar[XB_TMO])) break; if (sp > XB_SPIN_CAP) { atomicAdd(&bar[XB_TMO], 1u); break; } }
    }
    nloc = mine > 0u ? mine : 1u; nx = cnt > 0u ? cnt : 1u;
}
__device__ __forceinline__ void xcd_barrier(const XcdBarrier& b) {
    asm volatile("s_waitcnt vmcnt(0)" ::: "memory");
    __syncthreads();
    if (threadIdx.x == 0) {
        unsigned* bar = b.bar;
        __builtin_amdgcn_s_waitcnt(0);
        unsigned nloc = b.st[0], nx = b.st[1];
        if (nloc == 0u) { xcd_barrier_complete(bar, b.x, nloc, nx); b.st[0] = nloc; b.st[1] = nx; }
        const unsigned old = xb_add(&bar[XB_XSUB(b.x)], 1u);
        const unsigned gen = old / nloc;
        if (old + 1u == (gen + 1u) * nloc) {
            __builtin_amdgcn_fence(__ATOMIC_RELEASE, "agent");
            asm volatile("s_waitcnt vmcnt(0)" ::: "memory");
            const unsigned og = xb_add(&bar[XB_TOP], 1u);
            const unsigned tg = og / nx;
            if (og + 1u == (tg + 1u) * nx) xb_add(&bar[XB_TOPGEN], 1u);
            else XB_SPIN(xb_ld(&bar[XB_TOPGEN]) == tg, bar);
            __builtin_amdgcn_fence(__ATOMIC_ACQUIRE, "agent");
            xb_add(&bar[XB_XGEN(b.x)], 1u);
            asm volatile("s_waitcnt vmcnt(0)" ::: "memory");
        } else {
            XB_SPIN(xb_ld(&bar[XB_XGEN(b.x)]) == gen, bar);
            __builtin_amdgcn_fence(__ATOMIC_ACQUIRE, "agent");
            asm volatile("s_waitcnt vmcnt(0)" ::: "memory");
        }
    }
    __syncthreads();
}

namespace pg8 {
constexpr int BM = 256, BK = 64, HALF = 128, HTB = HALF * BK * 2, STAGE_BYTES = 8 * HTB, NXCD = 8, WGM = 8;
__host__ __device__ __forceinline__ int lds_byte(int r, int c) { const int st = (r >> 4) * 2 + (c >> 5), rr = r & 15, cc = c & 31, ob = rr * 64 + cc * 2; return st * 1024 + (ob ^ (((ob >> 9) & 1) << 5)); }
__host__ __device__ __forceinline__ void stage_rc(int b, int& R, int& C) { const int st = b / 1024, sb = b % 1024, swz = sb ^ (((sb >> 9) & 1) << 5); R = (st >> 1) * 16 + swz / 64; C = (st & 1) * 32 + (swz % 64) / 2; }
__host__ __device__ __forceinline__ int perm32(int rho) { const int n = rho >> 4, i = rho & 15; return 8 * (i >> 2) + 4 * n + (i & 3); }

typedef int v4i_g __attribute__((ext_vector_type(4)));
struct Unit { int pm, pn, cls, row0, ncls, elo, ehi; };

struct StaticOrder {
    int nM, nN, nwg, G, c;
    __device__ void init(int M, int N, int G_, int c_) { nM = M / BM; nN = N / BM; nwg = nM * nN; G = G_; c = c_; }
    __device__ __forceinline__ bool next(int i, Unit& u) const {
        const long L = (long)i * G + c; if (L >= nwg) return false;
        int wgid = (int)L; { const int q = nwg / NXCD, r = nwg % NXCD, xcd = wgid % NXCD, off = wgid / NXCD; wgid = (xcd < r ? xcd * (q + 1) : r * (q + 1) + (xcd - r) * q) + off; }
        const int nig = WGM * nN, gid = wgid / nig, fm = gid * WGM, gsz = (nM - fm) < WGM ? (nM - fm) : WGM;
        u.pm = fm + ((wgid % nig) % gsz); u.pn = (wgid % nig) / gsz; u.cls = 0; u.row0 = 0; u.ncls = 0; u.elo = 0; u.ehi = 0; return true;
    }
};

struct ProbDense {
    const char* A; const char* B; int lda, ldb, nt; StaticOrder S; bool skip_ctx;
    __device__ __forceinline__ bool next(int i, Unit& u) const { if (!S.next(i, u)) return false; if (skip_ctx) u.pm += 1 + (u.pm >= 64 ? 1 : 0); return true; }
    __device__ __forceinline__ void a_offs(const Unit& u, int tid, unsigned (&off)[2][2]) const {
#pragma unroll
        for (int i = 0; i < 2; ++i) { int R, C; stage_rc(tid * 16 + i * 8192, R, C);
#pragma unroll
            for (int h = 0; h < 2; ++h) off[h][i] = (unsigned)((u.pm * BM + h * HALF + R) * lda + C) * 2u; }
    }
    __device__ __forceinline__ const char* b_ptr(const Unit& u, int t) const { return B + (size_t)u.pn * BM * ldb * 2 + (size_t)t * (BK * 2); }
};
__device__ __forceinline__ void moe_unit(const LAS int* s_n, const LAS int* s_ts, int rt, Unit& u) {
    int cc = 0; while (s_ts[cc + 1] <= rt) ++cc;
    u.pm = rt; u.cls = cc; u.row0 = (rt - s_ts[cc]) * BM; u.ncls = s_n[cc];
    const int g = cc / 6, idx = cc % 6; const int a = idx < 3 ? 0 : (idx < 5 ? 1 : 2), b = idx < 3 ? idx + 1 : (idx < 5 ? idx - 1 : 3);
    u.elo = 4 * g + a; u.ehi = 4 * g + b;
}
struct ProbGU {
    const char* A; const char* B; const int* tok; const LAS int* s_n; const LAS int* s_ts; int total, G, c; static constexpr int ldb = 1024; int nt;
    __device__ __forceinline__ bool next(int i, Unit& u) const { const long L = (long)i * G + c; if (L >= total) return false; u.pn = (int)(L & 7); moe_unit(s_n, s_ts, (int)(L >> 3), u); return true; }
    __device__ __forceinline__ void a_offs(const Unit& u, int tid, unsigned (&off)[2][2]) const {
#pragma unroll
        for (int i = 0; i < 2; ++i) { int R, C; stage_rc(tid * 16 + i * 8192, R, C);
#pragma unroll
            for (int h = 0; h < 2; ++h) { int r = u.row0 + h * HALF + R; r = r < u.ncls ? r : u.ncls - 1; const int t = tok[(size_t)u.cls * CAP + r]; off[h][i] = (unsigned)t * 2048u + (unsigned)C * 2u; } }
    }
    __device__ __forceinline__ const char* b_ptr(const Unit& u, int t) const { const int e = u.pn >= 4 ? u.ehi : u.elo; return B + (size_t)e * (1024 * 1024 * 2) + (size_t)(u.pn & 3) * (BM * 1024 * 2) + (size_t)t * (BK * 2); }
};
struct ProbDown {
    const char* A; const char* B; const LAS int* s_n; const LAS int* s_ts; int total, G, c; static constexpr int ldb = 512; int nt;
    __device__ __forceinline__ bool next(int i, Unit& u) const { const long L = (long)i * G + c; if (L >= total) return false; u.pn = (int)(L & 3); moe_unit(s_n, s_ts, (int)(L >> 2), u); return true; }
    __device__ __forceinline__ void a_offs(const Unit& u, int tid, unsigned (&off)[2][2]) const {
#pragma unroll
        for (int i = 0; i < 2; ++i) { int R, C; stage_rc(tid * 16 + i * 8192, R, C);
#pragma unroll
            for (int h = 0; h < 2; ++h) off[h][i] = (unsigned)(u.pm * BM + h * HALF + R) * 2048u + (unsigned)C * 2u; }
    }
    __device__ __forceinline__ const char* b_ptr(const Unit& u, int t) const { const int e = t < 8 ? u.elo : u.ehi; return B + (size_t)e * (1024 * 512 * 2) + (size_t)u.pn * (BM * 512 * 2) + (size_t)(t & 7) * (BK * 2); }
};

template <class Epi, class Prob, bool ALIGN_EPI, bool F8 = false>
__device__ __forceinline__ void gemm_phase(LAS unsigned char* lds, LAS unsigned char* offs_lds, const Prob& P, const Epi& E) {
    int tid_ = threadIdx.x; asm volatile("" : "+v"(tid_));
    const int tid = tid_, wid = __builtin_amdgcn_readfirstlane(tid >> 6), lane = tid & 63, wr = wid >> 2, wc = wid & 3, fr = lane & 15, fq = lane >> 4;
    const int nt = P.nt;
    unsigned voffB[2];
#pragma unroll
    for (int i = 0; i < 2; ++i) { int R, C; stage_rc(tid * 16 + i * 8192, R, C); const int Rb = Epi::PERM ? ((R & ~31) + perm32(R & 31)) : R; voffB[i] = (unsigned)(Rb * P.ldb + C) * 2u; }
    LAS u32x4* const myoffs = (LAS u32x4*)offs_lds + tid;
    const size_t hstepB = (size_t)HALF * P.ldb * 2;
    const unsigned ldsw = (unsigned)wid * 1024u;
    const int fcol = F8 ? (32 * (fq >> 1) + 16 * (fq & 1)) : fq * 8;
    const int aoff = lds_byte(wr * 64 + fr, fcol), boff = lds_byte(wc * 32 + fr, fcol);
    constexpr int KOFF = F8 ? 16 : 1024;
    const char* const Ab = P.A;
#define PG8_SA(b, h) (((b) * 2 + (h)) * HTB)
#define PG8_SB(b, h) ((4 + (b) * 2 + (h)) * HTB)
#define PG8_STAGE_A(bufoff, h, offs, kt) do { _Pragma("unroll") for (int _i = 0; _i < 2; ++_i) \
        __builtin_amdgcn_global_load_lds((const unsigned*)(Ab + (size_t)(offs)[h][_i] + (size_t)(kt) * (BK * 2)), (LAS unsigned*)(lds + (bufoff) + ldsw + _i * 8192), 16, 0, 0); } while (0)
#define PG8_STAGE_B(bufoff, bp) do { _Pragma("unroll") for (int _i = 0; _i < 2; ++_i) \
        __builtin_amdgcn_global_load_lds((const unsigned*)((bp) + voffB[_i]), (LAS unsigned*)(lds + (bufoff) + ldsw + _i * 8192), 16, 0, 0); } while (0)
#define PG8_LDA(dst, b, h) do { _Pragma("unroll") for (int m = 0; m < 4; ++m) _Pragma("unroll") for (int k = 0; k < 2; ++k) dst[m][k] = *(const LAS bf16x8*)(lds + PG8_SA(b, h) + aoff + m * 2048 + k * KOFF); } while (0)
#define PG8_LDB(dst, b, h) do { _Pragma("unroll") for (int n = 0; n < 2; ++n) _Pragma("unroll") for (int k = 0; k < 2; ++k) dst[n][k] = *(const LAS bf16x8*)(lds + PG8_SB(b, h) + boff + n * 2048 + k * KOFF); } while (0)
#define PG8_CAT(x) __builtin_shufflevector(__builtin_bit_cast(v4i_g, (x)[0]), __builtin_bit_cast(v4i_g, (x)[1]), 0, 1, 2, 3, 4, 5, 6, 7)
#define PG8_MMA(ai, bj, At, Bt) do { __builtin_amdgcn_s_setprio(1); _Pragma("unroll") for (int m = 0; m < 4; ++m) _Pragma("unroll") for (int n = 0; n < 2; ++n) { \
        if constexpr (F8) acc[ai][bj][m][n] = __builtin_amdgcn_mfma_scale_f32_16x16x128_f8f6f4(PG8_CAT(Bt[n]), PG8_CAT(At[m]), acc[ai][bj][m][n], 0, 0, 0, 0x7F7F7F7F, 0, 0x7F7F7F7F); \
        else { _Pragma("unroll") for (int k = 0; k < 2; ++k) acc[ai][bj][m][n] = __builtin_amdgcn_mfma_f32_16x16x32_bf16(Bt[n][k], At[m][k], acc[ai][bj][m][n], 0, 0, 0); } } __builtin_amdgcn_s_setprio(0); } while (0)
#define PG8_WAIT_V(n) asm volatile("s_waitcnt vmcnt(" #n ")" ::: "memory")
#define PG8_WAIT_L(n) asm volatile("s_waitcnt lgkmcnt(" #n ")" ::: "memory")
#define PG8_BAR __builtin_amdgcn_s_barrier()
#define PG8_SCHED __builtin_amdgcn_sched_barrier(0)
    Unit cur, nxt; int ui = 0;
    if (!P.next(0, cur)) return;
    f32x4 acc[2][2][4][2];
#pragma unroll
    for (int a = 0; a < 2; ++a)
#pragma unroll
        for (int b = 0; b < 2; ++b)
#pragma unroll
            for (int m = 0; m < 4; ++m)
#pragma unroll
                for (int n = 0; n < 2; ++n) acc[a][b][m][n] = (f32x4){0.f, 0.f, 0.f, 0.f};
    bf16x8 At[4][2], B0[2][2], B1[2][2];
    unsigned offC[2][2];
    P.a_offs(cur, tid, offC);
    {
        const char* b0 = P.b_ptr(cur, 0); const char* b1 = P.b_ptr(cur, 1);
        PG8_STAGE_B(PG8_SB(0, 0), b0); PG8_STAGE_B(PG8_SB(0, 1), b0 + hstepB); PG8_STAGE_A(PG8_SA(0, 0), 0, offC, 0); PG8_STAGE_A(PG8_SA(0, 1), 1, offC, 0);
        if (wr == 1) PG8_BAR;
        PG8_WAIT_V(2); PG8_BAR;
        PG8_STAGE_B(PG8_SB(1, 0), b1); PG8_STAGE_A(PG8_SA(1, 0), 0, offC, 1); PG8_STAGE_B(PG8_SB(1, 1), b1 + hstepB);
        PG8_WAIT_V(6); PG8_BAR;
    }
    for (;;) {
        const bool has_next = P.next(ui + 1, nxt);
        if (!has_next) nxt = cur;
        {
            unsigned offN[2][2];
            if (has_next) P.a_offs(nxt, tid, offN);
            else {
#pragma unroll
                for (int h = 0; h < 2; ++h)
#pragma unroll
                    for (int i = 0; i < 2; ++i) offN[h][i] = offC[h][i];
            }
            *myoffs = (u32x4){offN[0][0], offN[0][1], offN[1][0], offN[1][1]};
        }
        for (int t = 0; t < nt; t += 2) {
            const bool last = (t == nt - 2);
            const int k2 = last ? 0 : t + 2;
            const char* b2 = last ? P.b_ptr(nxt, 0) : P.b_ptr(cur, t + 2);
            const char* b3 = last ? P.b_ptr(nxt, 1) : P.b_ptr(cur, t + 3);
            PG8_LDB(B0, 0, 0); PG8_LDB(B1, 0, 1); PG8_SCHED; PG8_LDA(At, 0, 0); PG8_STAGE_A(PG8_SA(1, 1), 1, offC, t + 1);
            if (last) { const u32x4 v = *myoffs; offC[0][0] = v.x; offC[0][1] = v.y; offC[1][0] = v.z; offC[1][1] = v.w; }
            PG8_WAIT_V(8); PG8_WAIT_L(0); PG8_BAR; PG8_MMA(0, 0, At, B0); PG8_MMA(0, 1, At, B1); PG8_BAR; PG8_SCHED;
            PG8_LDA(At, 0, 1); PG8_STAGE_B(PG8_SB(0, 0), b2); PG8_STAGE_B(PG8_SB(0, 1), b2 + hstepB); PG8_STAGE_A(PG8_SA(0, 0), 0, offC, k2);
            PG8_WAIT_V(8); PG8_WAIT_L(0); PG8_BAR; PG8_MMA(1, 0, At, B0); PG8_MMA(1, 1, At, B1); PG8_BAR; PG8_SCHED;
            PG8_LDB(B0, 1, 0); PG8_LDB(B1, 1, 1); PG8_SCHED; PG8_LDA(At, 1, 0); PG8_STAGE_A(PG8_SA(0, 1), 1, offC, k2);
            PG8_WAIT_V(8); PG8_WAIT_L(0); PG8_BAR; PG8_MMA(0, 0, At, B0); PG8_MMA(0, 1, At, B1); PG8_BAR; PG8_SCHED;
            PG8_LDA(At, 1, 1); PG8_STAGE_B(PG8_SB(1, 0), b3); PG8_STAGE_B(PG8_SB(1, 1), b3 + hstepB); PG8_STAGE_A(PG8_SA(1, 0), 0, offC, k2 + 1);
            PG8_WAIT_V(8); PG8_WAIT_L(0); PG8_BAR; PG8_MMA(1, 0, At, B0); PG8_MMA(1, 1, At, B1); PG8_BAR; PG8_SCHED;
        }
        if constexpr (ALIGN_EPI) { if (wr == 0) PG8_BAR; }
        E(acc, cur, wr, wc, fr, fq);
        if (!has_next) break;
#pragma unroll
        for (int a = 0; a < 2; ++a)
#pragma unroll
            for (int b = 0; b < 2; ++b)
#pragma unroll
                for (int m = 0; m < 4; ++m)
#pragma unroll
                    for (int n = 0; n < 2; ++n) acc[a][b][m][n] = (f32x4){0.f, 0.f, 0.f, 0.f};
        cur = nxt; ++ui;
        if constexpr (ALIGN_EPI) { if (wr == 1) PG8_BAR; }
    }
    PG8_WAIT_V(0);
    if constexpr (!ALIGN_EPI) { if (wr == 0) PG8_BAR; }
    PG8_BAR;
#undef PG8_SA
#undef PG8_SB
#undef PG8_STAGE_A
#undef PG8_STAGE_B
#undef PG8_LDA
#undef PG8_LDB
#undef PG8_MMA
#undef PG8_CAT
#undef PG8_WAIT_V
#undef PG8_WAIT_L
#undef PG8_BAR
#undef PG8_SCHED
}
}

namespace pg8 {
struct EpiQKV {
    static constexpr bool PERM = true;
    unsigned char* ws; const float* gn; const float* rope;
    __device__ __forceinline__ void operator()(const f32x4 (&acc)[2][2][4][2], const Unit& u, int wr, int wc, int fr, int fq) const {
        const int pn = u.pn, tb_ = u.pm % 65;
        const bool is_ctx = (tb_ == 0);
        const bool isV = (pn >= 4) && (wc >= 2);
        const float* gain = gn + (pn < 2 ? 0 : (pn < 4 ? 64 : (pn == 4 ? 128 : 192)));
        const int strm = 2 * (pn - 4) + (wc & 1);
#pragma unroll
        for (int ai = 0; ai < 2; ++ai)
#pragma unroll
            for (int m = 0; m < 4; ++m) {
                int mfr = m * 16 + fr; asm volatile("" : "+v"(mfr));
                const int row = u.pm * BM + ai * HALF + wr * 64 + mfr;
                f32x4 v[2][2];
#pragma unroll
                for (int bj = 0; bj < 2; ++bj)
#pragma unroll
                    for (int n = 0; n < 2; ++n) v[bj][n] = acc[ai][bj][m][n];
                if (isV) {
#pragma unroll
                    for (int bj = 0; bj < 2; ++bj)
#pragma unroll
                        for (int n = 0; n < 2; ++n) v[bj][n] = v[bj][n] * WSCALE_INV;
                }
                if (!isV) {
                    float ss = 0.f;
#pragma unroll
                    for (int bj = 0; bj < 2; ++bj)
#pragma unroll
                        for (int n = 0; n < 2; ++n) { const f32x4 x = v[bj][n]; ss += (x[0] * x[0] + x[1] * x[1]) + (x[2] * x[2] + x[3] * x[3]); }
                    ss += __shfl_xor(ss, 16); ss += __shfl_xor(ss, 32);
                    const float rs = ((EXPFREE && pn < 4) ? 4.0f * SQC2 : SQC2) * WSCALE_INV / sqrtf(ss * (1.0f / 64.0f) * (WSCALE_INV * WSCALE_INV) + NORM_EPS);
#pragma unroll
                    for (int bj = 0; bj < 2; ++bj)
#pragma unroll
                        for (int n = 0; n < 2; ++n) v[bj][n] = v[bj][n] * rs * *(const f32x4*)(gain + 32 * bj + 16 * n + 4 * fq);
                    if (!is_ctx) {
                        const int pr = (tb_ - 1) * 4 + 2 * ai + wr, pc = mfr;
#pragma unroll
                        for (int bj = 0; bj < 2; ++bj) {
                            const int pos = bj ? pc : pr;
                            const f32x4* rp = (const f32x4*)(rope + (size_t)(pos * 16 + 4 * fq) * 2);
                            const f32x4 r0 = rp[0], r1 = rp[1];
                            const f32x4 cs = (f32x4){r0[0], r0[2], r1[0], r1[2]}, sn = (f32x4){r0[1], r0[3], r1[1], r1[3]};
                            const f32x4 x1 = v[bj][0], x2 = v[bj][1];
                            v[bj][0] = x1 * cs - x2 * sn; v[bj][1] = x2 * cs + x1 * sn;
                        }
                    }
                }
                if (pn < 4) {
                    unsigned char* rowp = ws + WS_QO + (size_t)row * 1024 + 256 * pn + 64 * wc + 4 * fq;
#pragma unroll
                    for (int bj = 0; bj < 2; ++bj)
#pragma unroll
                        for (int n = 0; n < 2; ++n) { int w = __builtin_amdgcn_cvt_pk_fp8_f32(v[bj][n][0], v[bj][n][1], 0, false); w = __builtin_amdgcn_cvt_pk_fp8_f32(v[bj][n][2], v[bj][n][3], w, true);
                            *(int*)(rowp + 32 * bj + 16 * n) = w; }
                } else {
                    unsigned char* tb = ws + WS_KV + (size_t)(u.pm * 4 + ai * 2 + wr) * KV_TILEB + (isV ? 16384 + strm * KV_VSL : strm * 4096);
                    if (!isV) {
                        const int kk = mfr; const unsigned kof = (unsigned)(kk * 64 + 4 * fq), ksw = (unsigned)((kk >> 2) & 3);
#pragma unroll
                        for (int bj = 0; bj < 2; ++bj)
#pragma unroll
                            for (int n = 0; n < 2; ++n) { int w = __builtin_amdgcn_cvt_pk_fp8_f32(v[bj][n][0], v[bj][n][1], 0, false); w = __builtin_amdgcn_cvt_pk_fp8_f32(v[bj][n][2], v[bj][n][3], w, true);
                                *(int*)(tb + (kof + (((unsigned)(2 * bj + n) ^ ksw) * 16u))) = w; }
                    } else {
#if VFP8
                        const int kk = mfr, uu = kk >> 5, w5 = kk & 31, hh = (w5 >> 2) & 1, jb = (w5 & 3) + 4 * (w5 >> 3);
                        const unsigned vof = (unsigned)(4 * fq * 64 + (((2 * hh + uu) ^ fq) * 16) + jb);
#pragma unroll
                        for (int bj = 0; bj < 2; ++bj)
#pragma unroll
                            for (int n = 0; n < 2; ++n)
#pragma unroll
                                for (int jp = 0; jp < 2; ++jp) { const int w = __builtin_amdgcn_cvt_pk_fp8_f32(v[bj][n][2 * jp], v[bj][n][2 * jp + 1], 0, false);
                                    *(unsigned char*)(tb + (vof + (unsigned)((32 * bj + 16 * n + 2 * jp) * 64))) = (unsigned char)w; *(unsigned char*)(tb + (vof + (unsigned)((32 * bj + 16 * n + 2 * jp + 1) * 64))) = (unsigned char)(w >> 8); }
#else
                        const int fr_ = mfr & 15, m_ = mfr >> 4, sub = fr_ >> 2, hb = sub & 1;
                        const unsigned vbase = (unsigned)(4 * fq * 128 + (4 * (sub >> 1) + (fr_ & 3)) * 2);
#pragma unroll
                        for (int j = 0; j < 4; ++j) { const int swz = (2 * fq + (j >> 1)) & 7;
                            const unsigned vof = vbase + (unsigned)(j * 128) + (unsigned)((((2 * m_) ^ (swz & 6)) | ((hb ^ swz) & 1)) * 16);
#pragma unroll
                            for (int bj = 0; bj < 2; ++bj)
#pragma unroll
                                for (int n = 0; n < 2; ++n) *(bf16_t*)(tb + (vof + (unsigned)((32 * bj + 16 * n) * 128))) = (bf16_t)f2bf(v[bj][n][j]); }
#endif
                    }
                }
            }
    }
};
__device__ __forceinline__ float bf_lo(unsigned w) { return __builtin_bit_cast(float, w << 16); }
__device__ __forceinline__ float bf_hi(unsigned w) { return __builtin_bit_cast(float, w & 0xffff0000u); }
struct EpiResid {
    static constexpr bool PERM = true;
    bf16_t* XS; const float* modv_l; int goff; float sgn;
    __device__ __forceinline__ void operator()(const f32x4 (&acc)[2][2][4][2], const Unit& u, int wr, int wc, int fr, int fq) const {
        const int mv = (u.pm % 65 == 0) ? 2 : (u.pm / 65);
        const float* g = modv_l + mv * 6144 + goff;
        const int col0 = u.pn * BM + wc * 32 + 8 * fq;
        f32x4 gv[2][2];
#pragma unroll
        for (int bj = 0; bj < 2; ++bj)
#pragma unroll
            for (int n = 0; n < 2; ++n) gv[bj][n] = *(const f32x4*)(g + col0 + bj * HALF + n * 4) * sgn;
#pragma unroll
        for (int ai = 0; ai < 2; ++ai)
#pragma unroll
            for (int m = 0; m < 4; ++m) {
                bf16_t* rowp = XS + (size_t)(u.pm * BM + ai * HALF + wr * 64 + m * 16 + fr) * 1024 + col0;
#pragma unroll
                for (int bj = 0; bj < 2; ++bj) { u32x4* p = (u32x4*)(rowp + bj * HALF); const u32x4 w = *p; u32x4 o;
                    const f32x4 a0 = gv[bj][0] * acc[ai][bj][m][0], a1 = gv[bj][1] * acc[ai][bj][m][1];
                    o.x = cvt_pk_bf16(bf_lo(w.x) + a0[0], bf_hi(w.x) + a0[1]); o.y = cvt_pk_bf16(bf_lo(w.y) + a0[2], bf_hi(w.y) + a0[3]);
                    o.z = cvt_pk_bf16(bf_lo(w.z) + a1[0], bf_hi(w.z) + a1[1]); o.w = cvt_pk_bf16(bf_lo(w.w) + a1[2], bf_hi(w.w) + a1[3]);
                    *p = o; }
            }
    }
};
struct EpiGU {
    static constexpr bool PERM = true;
    bf16_t* ACT; const f32x2* wts;
    __device__ __forceinline__ void operator()(const f32x4 (&acc)[2][2][4][2], const Unit& u, int wr, int wc, int fr, int fq) const {
        const int k = u.pn >= 4 ? 1 : 0, jt = u.pn & 3;
        const int colbase = 512 * k + 128 * jt + 32 * wc + 8 * fq;
#pragma unroll
        for (int ai = 0; ai < 2; ++ai)
#pragma unroll
            for (int m = 0; m < 4; ++m) {
                const int r = ai * HALF + wr * 64 + m * 16 + fr;
                int idx = u.row0 + r; idx = idx < u.ncls ? idx : u.ncls - 1;
                const f32x2 w2 = wts[(size_t)u.cls * CAP + idx];
                const float w = k ? w2[1] : w2[0];
                u32x4 o;
#pragma unroll
                for (int n = 0; n < 2; ++n) {
                    const f32x4 g = acc[ai][0][m][n], up = acc[ai][1][m][n]; float a[4];
#pragma unroll
                    for (int j = 0; j < 4; ++j) { const float sg = g[j] * __builtin_amdgcn_rcpf(1.0f + __builtin_amdgcn_exp2f(-g[j] * LOG2E)); a[j] = w * sg * up[j]; }
                    const unsigned lo = cvt_pk_bf16(a[0], a[1]), hi = cvt_pk_bf16(a[2], a[3]);
                    if (n == 0) { o.x = lo; o.y = hi; } else { o.z = lo; o.w = hi; }
                }
                *(u32x4*)(ACT + (size_t)(u.pm * BM + r) * 1024 + colbase) = o;
            }
    }
};
struct EpiDown {
    static constexpr bool PERM = true;
    bf16_t* XS; float* out; const int* tok; const float* modv_l; float sgn;
    __device__ __forceinline__ void operator()(const f32x4 (&acc)[2][2][4][2], const Unit& u, int wr, int wc, int fr, int fq) const {
        const int col0 = u.pn * BM + wc * 32 + 8 * fq;
#pragma unroll
        for (int ai = 0; ai < 2; ++ai)
#pragma unroll
            for (int m = 0; m < 4; ++m) {
                const int idx = u.row0 + ai * HALF + wr * 64 + m * 16 + fr;
                if (idx < u.ncls) {
                    const int t = tok[(size_t)u.cls * CAP + idx];
                    const int b = t >= RB ? 1 : 0, rr = t - b * RB;
                    const int mv = rr < NCTX ? 2 : b;
                    const float* g = modv_l + mv * 6144 + 5120 + col0;
                    bf16_t* xp = XS + (size_t)t * 1024 + col0;
                    float* op = out + (size_t)(b * SEQ + rr - NCTX) * 1024 + col0;
#pragma unroll
                    for (int bj = 0; bj < 2; ++bj) { const u32x4 w = *(const u32x4*)(xp + bj * HALF);
                        const f32x4 a0 = (*(const f32x4*)(g + bj * HALF) * sgn) * acc[ai][bj][m][0], a1 = (*(const f32x4*)(g + bj * HALF + 4) * sgn) * acc[ai][bj][m][1];
                        const f32x4 x0 = (f32x4){bf_lo(w.x) + a0[0], bf_hi(w.x) + a0[1], bf_lo(w.y) + a0[2], bf_hi(w.y) + a0[3]}, x1 = (f32x4){bf_lo(w.z) + a1[0], bf_hi(w.z) + a1[1], bf_lo(w.w) + a1[2], bf_hi(w.w) + a1[3]};
                        if (out) { *(f32x4*)(op + bj * HALF) = x0; *(f32x4*)(op + bj * HALF + 4) = x1; }
                        else { u32x4 o; o.x = cvt_pk_bf16(x0[0], x0[1]); o.y = cvt_pk_bf16(x0[2], x0[3]); o.z = cvt_pk_bf16(x1[0], x1[1]); o.w = cvt_pk_bf16(x1[2], x1[3]); *(u32x4*)(xp + bj * HALF) = o; }
                    }
                }
            }
    }
};
}

namespace attn_body {
using bf16 = __hip_bfloat16;
using s16x4 = __attribute__((ext_vector_type(4))) short;
using f32x16 = __attribute__((ext_vector_type(16))) float;
constexpr int D = 64, QP = 1024, KP = 512;
constexpr int NW = 8, QBLK = 32, QB = QBLK * NW, KVBLK = 64;
__device__ __forceinline__ int crow(int r, int hi) { return (r & 3) + 8 * (r >> 2) + 4 * hi; }
#define SBAR() __builtin_amdgcn_sched_barrier(0)
constexpr int NSLOT = 3, SLOTB = 8192;
constexpr int LDS_K = 0, LDS_V = NSLOT * SLOTB, LDS_WS = 2 * NSLOT * SLOTB, LDS_OST = LDS_WS + NW * 64 * 4, LDS_BYTES = LDS_OST + NW * 4096;
__device__ __forceinline__ void glds16(const void* gsrc, unsigned lds_dst) { unsigned keep;
  asm volatile("s_mov_b32 %0, m0\n\ts_mov_b32 m0, %2\n\ts_nop 0\n\tglobal_load_lds_dwordx4 %1, off\n\ts_mov_b32 m0, %0" : "=&s"(keep) : "v"(gsrc), "s"(lds_dst) : "memory"); }
__device__ __forceinline__ void glds16h(const void* gsrc, unsigned lds_dst) { unsigned keep;
  asm volatile("s_mov_b32 %0, m0\n\ts_mov_b32 m0, %2\n\ts_mov_b32 exec_hi, 0\n\tglobal_load_lds_dwordx4 %1, off\n\ts_mov_b32 exec_hi, -1\n\ts_mov_b32 m0, %0" : "=&s"(keep) : "v"(gsrc), "s"(lds_dst) : "memory"); }
__device__ __forceinline__ float max3f(float a, float b, float c) { float r; asm("v_max3_f32 %0, %1, %2, %3" : "=v"(r) : "v"(a), "v"(b), "v"(c)); return r; }
__device__ __forceinline__ float max2f(float a, float b) { float r; asm("v_max_f32_e32 %0, %1, %2" : "=v"(r) : "v"(a), "v"(b)); return r; }
__device__ __forceinline__ float fadd_s(float a, float b) { float r; asm("v_add_f32_e32 %0, %1, %2" : "=v"(r) : "v"(a), "v"(b)); return r; }
__device__ __forceinline__ float fsub_s(float a, float b) { float r; asm("v_sub_f32_e32 %0, %1, %2" : "=v"(r) : "v"(a), "v"(b)); return r; }
typedef float f32x2_t __attribute__((ext_vector_type(2))); typedef __bf16 bf16x2_t __attribute__((ext_vector_type(2)));
__device__ __forceinline__ unsigned cvtpk_s(float lo, float hi) { f32x2_t v = {lo, hi}; bf16x2_t b = __builtin_convertvector(v, bf16x2_t); return __builtin_bit_cast(unsigned, b); }
#define WAIT_BAR(N) asm volatile("s_waitcnt vmcnt(" #N ") lgkmcnt(0)\n\ts_barrier" ::: "memory")

__device__ __forceinline__ void qkt(f32x16& p0, f32x16& p1, const char* Kslot, const bf16x8* qr, const f32x16& negm, int r32, int hi) {
  const char* kb = Kslot + hi * 1024 + r32 * 16;
  #pragma unroll
  for (int d0 = 0; d0 < 4; ++d0) {
    const bf16x8 b0 = *reinterpret_cast<const bf16x8*>(kb + d0 * 2048);
    const bf16x8 b1 = *reinterpret_cast<const bf16x8*>(kb + d0 * 2048 + 512);
    if (d0 == 0) { p0 = __builtin_amdgcn_mfma_f32_32x32x16_bf16(b0, qr[0], negm, 0, 0, 0); p1 = __builtin_amdgcn_mfma_f32_32x32x16_bf16(b1, qr[0], negm, 0, 0, 0); }
    else { p0 = __builtin_amdgcn_mfma_f32_32x32x16_bf16(b0, qr[d0], p0, 0, 0, 0); p1 = __builtin_amdgcn_mfma_f32_32x32x16_bf16(b1, qr[d0], p1, 0, 0, 0); } }
}
typedef __attribute__((address_space(3))) const char* lds_cptr;
typedef short v4i16_t __attribute__((ext_vector_type(4)));
__device__ __forceinline__ void kload8(bf16x8* kf, lds_cptr kp) {
  kf[0] = *(const LAS bf16x8*)(kp);        kf[1] = *(const LAS bf16x8*)(kp + 512);
  kf[2] = *(const LAS bf16x8*)(kp + 2048); kf[3] = *(const LAS bf16x8*)(kp + 2560);
  kf[4] = *(const LAS bf16x8*)(kp + 4096); kf[5] = *(const LAS bf16x8*)(kp + 4608);
  kf[6] = *(const LAS bf16x8*)(kp + 6144); kf[7] = *(const LAS bf16x8*)(kp + 6656);
}
__device__ __forceinline__ void kload2(bf16x8* kf, lds_cptr kp, int j) { kf[2 * j] = *(const LAS bf16x8*)(kp + j * 2048); kf[2 * j + 1] = *(const LAS bf16x8*)(kp + j * 2048 + 512); }
__device__ __forceinline__ s16x4 vtr(lds_cptr p) { return __builtin_bit_cast(s16x4, __builtin_amdgcn_ds_read_tr16_b64_v4i16((LAS v4i16_t*)p)); }
__device__ __forceinline__ float rowmax(const f32x16& p0, const f32x16& p1) {
  float a = max3f(p0[0], p0[1], p1[0]), b = max3f(p0[2], p0[3], p1[1]); a = max3f(a, p1[2], p1[3]);
  #pragma unroll
  for (int r = 4; r < 16; r += 4) { a = max3f(a, p0[r], p0[r + 1]); b = max3f(b, p0[r + 2], p0[r + 3]); a = max3f(a, p1[r], p1[r + 1]); b = max3f(b, p1[r + 2], p1[r + 3]); }
  const float m = max2f(a, b);
  auto rr = __builtin_amdgcn_permlane32_swap(__float_as_uint(m), __float_as_uint(m), false, false);
  return max2f(__uint_as_float(rr[0]), __uint_as_float(rr[1]));
}
__device__ __forceinline__ void pv(f32x16* o, int vb, bf16x8 pa0, bf16x8 pa1, bf16x8 pa2, bf16x8 pa3) {
  #pragma unroll
  for (int d0 = 0; d0 < 2; ++d0) { s16x4 lo[4], hi[4];
    #pragma unroll
    for (int ks = 0; ks < 4; ++ks) {
      asm volatile("ds_read_b64_tr_b16 %0,%1 offset:%c2" : "=&v"(lo[ks]) : "v"(vb), "i"(d0 * 4096 + ks * 1024) : "memory");
      asm volatile("ds_read_b64_tr_b16 %0,%1 offset:%c2" : "=&v"(hi[ks]) : "v"(vb), "i"(d0 * 4096 + ks * 1024 + 512) : "memory"); }
    asm volatile("s_waitcnt lgkmcnt(0)" ::: "memory"); SBAR();
    #define PK(k) (bf16x8){lo[k][0], lo[k][1], lo[k][2], lo[k][3], hi[k][0], hi[k][1], hi[k][2], hi[k][3]}
    o[d0] = __builtin_amdgcn_mfma_f32_32x32x16_bf16(pa0, PK(0), o[d0], 0, 0, 0);
    o[d0] = __builtin_amdgcn_mfma_f32_32x32x16_bf16(pa1, PK(1), o[d0], 0, 0, 0);
    o[d0] = __builtin_amdgcn_mfma_f32_32x32x16_bf16(pa2, PK(2), o[d0], 0, 0, 0);
    o[d0] = __builtin_amdgcn_mfma_f32_32x32x16_bf16(pa3, PK(3), o[d0], 0, 0, 0);
    #undef PK
  }
}
__device__ __forceinline__ void pv2(f32x16* o, const lds_cptr* vq, int slot, bf16x8 pa0, bf16x8 pa1, bf16x8 pa2, bf16x8 pa3) {
  #pragma unroll
  for (int d0 = 0; d0 < 2; ++d0) {
    const bf16x8 v0 = *(const LAS bf16x8*)(vq[0] + slot + d0 * 4096), v1 = *(const LAS bf16x8*)(vq[1] + slot + d0 * 4096), v2 = *(const LAS bf16x8*)(vq[2] + slot + d0 * 4096), v3 = *(const LAS bf16x8*)(vq[3] + slot + d0 * 4096);
    o[d0] = __builtin_amdgcn_mfma_f32_32x32x16_bf16(pa0, v0, o[d0], 0, 0, 0);
    o[d0] = __builtin_amdgcn_mfma_f32_32x32x16_bf16(pa1, v1, o[d0], 0, 0, 0);
    o[d0] = __builtin_amdgcn_mfma_f32_32x32x16_bf16(pa2, v2, o[d0], 0, 0, 0);
    o[d0] = __builtin_amdgcn_mfma_f32_32x32x16_bf16(pa3, v3, o[d0], 0, 0, 0);
  }
}
__device__ __forceinline__ void bandmask(f32x16& p0, f32x16& p1, int t, int mlo, unsigned mspan, int qrel, int hi) {
  const float NEG = -INFINITY; const int kb = 64 * (t - 4) - 128 + 4 * hi - qrel - mlo;
  #pragma unroll
  for (int r = 0; r < 16; ++r) { const int d0 = kb + (r & 3) + 8 * (r >> 2); if ((unsigned)d0 > mspan) p0[r] = NEG; if ((unsigned)(d0 + 32) > mspan) p1[r] = NEG; }
}
#ifndef FASTEXP
#define FASTEXP 0
#endif
__device__ __forceinline__ float exp2_fast(float x) { const float t = __builtin_fmaf(x, 8388608.0f, 1064986823.0f); unsigned u; asm("v_cvt_u32_f32 %0, %1" : "=v"(u) : "v"(t)); return __builtin_bit_cast(float, u); }
#define ATTN_STORE16(p, v) (*(u32x4*)(p) = (v))

template <int MODE, int THRL> __device__ __forceinline__ void attn_unit(long qrow, long kvrow, int q0, int qcol, int kcol, int vcol, int NT, float sink2, const bf16* Q, const bf16* __restrict__ KVb, bf16* O, char* shm) {
  int tid_ = threadIdx.x; asm volatile("" : "+v"(tid_));
  const int tid = tid_, lane = tid & 63, r32 = lane & 31, hi = lane >> 5; const int wid = __builtin_amdgcn_readfirstlane(tid >> 6);
  const bf16* Qw = Q + (qrow + wid * QBLK) * QP + qcol;
  const char* kvt = (const char*)KVb + (size_t)(kvrow >> 6) * 65536 + wid * 1024 + lane * 16;
  const unsigned lds0 = (unsigned)(uintptr_t)shm;
  float* wsf = (float*)(shm + LDS_WS) + wid * 64;
  const char* ksrc = kvt + kcol * 8192; const char* vsrc = kvt + vcol * 8192;
  const unsigned kdst = lds0 + LDS_K + wid * 1024, vdst = lds0 + LDS_V + wid * 1024;
  #define ROWOFF(t) ((long)(MODE == 1 ? ((t) + ((t) >= 4 ? ((q0 - 128) >> 6) : 0)) : (t)) * 65536)
  #define DMA_K(t, slot) glds16(ksrc + ROWOFF(t), (unsigned)__builtin_amdgcn_readfirstlane(kdst + (slot)))
  #define DMA_V(t, slot) glds16(vsrc + ROWOFF(t), (unsigned)__builtin_amdgcn_readfirstlane(vdst + (slot)))
  const char* Kbase = shm + LDS_K; bf16x8 kf[8];
  const lds_cptr shm3 = (lds_cptr)shm; const lds_cptr kp0 = shm3 + LDS_K + hi * 1024 + r32 * 16; lds_cptr vq[4];
  { const int swz = (r32 >> 1) & 7; _Pragma("unroll") for (int ks_ = 0; ks_ < 4; ++ks_) vq[ks_] = shm3 + LDS_V + r32 * 128 + (((2 * ks_ + hi) ^ swz) * 16); }
  DMA_K(0, 0); DMA_V(0, 0); DMA_K(1, SLOTB);
  bf16x8 qr[4];
  #pragma unroll
  for (int d0 = 0; d0 < 4; ++d0) qr[d0] = *reinterpret_cast<const bf16x8*>(&Qw[(long)r32 * QP + d0 * 16 + hi * 8]);
  float mhat = 0.f, l_reg = 0.f; f32x16 o[2]; o[0] = f32x16{}; o[1] = f32x16{}; f32x16 negm = f32x16{}; asm volatile("" : "+v"(negm));
  const int qrel = wid * QBLK + r32;
  int mlo = -128, mhi = 128;
  if (MODE == 1) { const int qi = q0 + qrel; mlo = (-qi > -128) ? -qi : -128; mhi = (SEQ - 1 - qi < 128) ? (SEQ - 1 - qi) : 128; }
  const unsigned mspan = (unsigned)(mhi - mlo);
  #define CMASK(P0, P1, t) do { if (MODE == 1) { if ((t) >= 4) bandmask(P0, P1, (t), mlo, mspan, qrel, hi); } } while (0)
  bool resc = false;
  #define START(P0, P1) do { const float rm = rowmax(P0, P1); resc = false; \
    { const float dl = rm; mhat = fadd_s(mhat, dl); \
      _Pragma("unroll") for (int r = 0; r < 16; ++r) { P0[r] = fsub_s(P0[r], dl); P1[r] = fsub_s(P1[r], dl); } \
      _Pragma("unroll") for (int r = 0; r < 16; ++r) negm[r] = -mhat; asm volatile("" : "+v"(negm)); } \
    _Pragma("unroll") for (int r = 0; r < 16; ++r) P0[r] = __builtin_amdgcn_exp2f(P0[r]); } while (0)
  #define RESC() do { if (resc) { asm volatile("s_waitcnt lgkmcnt(0)" ::: "memory"); \
      _Pragma("unroll") for (int d_ = 0; d_ < 2; ++d_) _Pragma("unroll") for (int r = 0; r < 16; ++r) o[d_][r] *= wsf[crow(r, hi)]; } } while (0)
  f32x16 pA0, pA1, pB0, pB1;
  int sl_prev = 0, sl_cur = 0, sl_next = SLOTB;
  #define ROT() do { sl_prev = sl_cur; sl_cur = sl_next; sl_next = (sl_next == (NSLOT - 1) * SLOTB) ? 0 : sl_next + SLOTB; } while (0)
  DMA_K(2, 2 * SLOTB);
  WAIT_BAR(3);
  qkt(pA0, pA1, Kbase, qr, negm, r32, hi); asm volatile("s_nop 15\n\ts_nop 7" : "+v"(pA0), "+v"(pA1)); CMASK(pA0, pA1, 0);
  START(pA0, pA1);
  _Pragma("unroll") for (int r = 0; r < 16; ++r) pA1[r] = __builtin_amdgcn_exp2f(pA1[r]);
  WAIT_BAR(0);
  DMA_K(3, 0); DMA_V(1, SLOTB);
  ROT();
  kload8(kf, kp0 + sl_cur);
  WAIT_BAR(2);
  bf16x8 vfr[8]; u32x4 pw0, pw1, pw2, pw3;
  #define PKW(P, B) cvtpk_s(P[B], P[B + 1])
  #define PAF(k) __builtin_bit_cast(bf16x8, pw##k)
  #define VFR(i) vfr[i]
  #define PIN(x) asm volatile("" : "+v"(x))
  #define MX3(a, b, c) __builtin_fmaxf(__builtin_fmaxf((a), (b)), (c))
  #define GAPA(MF, A0, A1, A2, A3, W0, W1, PW) do { MF; sacc += A0; sacc += A1; sacc += A2; sacc += A3; PIN(sacc); W0; W1; PIN(PW); SBAR(); } while (0)
  #define EX(v) __builtin_amdgcn_exp2f(v)
  #define GAPB(MF, X, B) do { MF; X[B] = EX(X[B]); X[B + 1] = EX(X[B + 1]); X[B + 2] = EX(X[B + 2]); X[B + 3] = EX(X[B + 3]); PIN(X); SBAR(); } while (0)
  #define VRD(i) do { vfr[i] = *(const LAS bf16x8*)(vq[(i) & 3] + vsl_ + ((i) >> 2) * 4096); } while (0)
  #define KRD(G, j) do { if (G) { kload2(kf, kp0 + sl_next, j); SBAR(); } } while (0)
  #define STEP(C0, C1, P0, P1, t, GK, GV, GL) do { SBAR(); \
    const int vsl_ = sl_prev; \
    VRD(0); SBAR(); float sacc = (P0[0] + P0[1]); \
    GAPA(C0 = __builtin_amdgcn_mfma_f32_32x32x16_bf16(kf[0], qr[0], negm, 0, 0, 0), P0[2], P0[3], P0[4], P0[5],     pw0[0] = PKW(P0, 0), pw0[1] = PKW(P0, 2), pw0); \
    VRD(4); SBAR(); GAPA(C1 = __builtin_amdgcn_mfma_f32_32x32x16_bf16(kf[1], qr[0], negm, 0, 0, 0), P0[6], P0[7], P0[8], P0[9],     pw0[2] = PKW(P0, 4), pw0[3] = PKW(P0, 6), pw0); \
    VRD(1); SBAR(); GAPA(C0 = __builtin_amdgcn_mfma_f32_32x32x16_bf16(kf[2], qr[1], C0, 0, 0, 0),   P0[10], P0[11], P0[12], P0[13], pw1[0] = PKW(P0, 8), pw1[1] = PKW(P0, 10), pw1); \
    VRD(5); SBAR(); GAPA(C1 = __builtin_amdgcn_mfma_f32_32x32x16_bf16(kf[3], qr[1], C1, 0, 0, 0),   P0[14], P0[15], P1[0], P1[1],   pw1[2] = PKW(P0, 12), pw1[3] = PKW(P0, 14), pw1); \
    VRD(2); SBAR(); GAPA(C0 = __builtin_amdgcn_mfma_f32_32x32x16_bf16(kf[4], qr[2], C0, 0, 0, 0),   P1[2], P1[3], P1[4], P1[5],     pw2[0] = PKW(P1, 0), pw2[1] = PKW(P1, 2), pw2); \
    VRD(6); SBAR(); GAPA(C1 = __builtin_amdgcn_mfma_f32_32x32x16_bf16(kf[5], qr[2], C1, 0, 0, 0),   P1[6], P1[7], P1[8], P1[9],     pw2[2] = PKW(P1, 4), pw2[3] = PKW(P1, 6), pw2); \
    VRD(3); SBAR(); GAPA(C0 = __builtin_amdgcn_mfma_f32_32x32x16_bf16(kf[6], qr[3], C0, 0, 0, 0),   P1[10], P1[11], P1[12], P1[13], pw3[0] = PKW(P1, 8), pw3[1] = PKW(P1, 10), pw3); \
    VRD(7); SBAR(); GAPA(C1 = __builtin_amdgcn_mfma_f32_32x32x16_bf16(kf[7], qr[3], C1, 0, 0, 0),   P1[14], P1[15], 0.f, 0.f,       pw3[2] = PKW(P1, 12), pw3[3] = PKW(P1, 14), pw3); \
    l_reg += sacc; \
    if (GK) { DMA_K((t) + 3, sl_cur); } if (GV) { DMA_V((t) + 1, sl_next); } \
    CMASK(C0, C1, t); \
    { float a = MX3(C0[0], C0[1], C1[0]), b = MX3(C0[2], C0[3], C1[1]); a = MX3(a, C1[2], C1[3]); \
      _Pragma("unroll") for (int r = 4; r < 16; r += 4) { a = MX3(a, C0[r], C0[r + 1]); b = MX3(b, C0[r + 2], C0[r + 3]); a = MX3(a, C1[r], C1[r + 1]); b = MX3(b, C1[r + 2], C1[r + 3]); } \
      float rm = __builtin_fmaxf(a, b); { auto rr = __builtin_amdgcn_permlane32_swap(__float_as_uint(rm), __float_as_uint(rm), false, false); rm = __builtin_fmaxf(__uint_as_float(rr[0]), __uint_as_float(rr[1])); } \
      resc = false; \
      if (__builtin_expect(__any(rm > (float)THRL), 0)) { const float dl = __builtin_fmaxf(rm, 0.f); mhat += dl; \
        _Pragma("unroll") for (int r = 0; r < 16; ++r) { C0[r] -= dl; C1[r] -= dl; } \
        _Pragma("unroll") for (int r = 0; r < 16; ++r) negm[r] = -mhat; asm volatile("" : "+v"(negm)); \
        const float f = __builtin_amdgcn_exp2f(-dl); l_reg *= f; if (hi == 0) wsf[r32] = f; resc = true; } } \
    SBAR(); \
    GAPB(o[0] = __builtin_amdgcn_mfma_f32_32x32x16_bf16(PAF(0), VFR(0), o[0], 0, 0, 0), C0, 0); \
    GAPB(o[1] = __builtin_amdgcn_mfma_f32_32x32x16_bf16(PAF(0), VFR(4), o[1], 0, 0, 0), C0, 4); \
    KRD(GL, 0); GAPB(o[0] = __builtin_amdgcn_mfma_f32_32x32x16_bf16(PAF(1), VFR(1), o[0], 0, 0, 0), C0, 8); \
    KRD(GL, 1); GAPB(o[1] = __builtin_amdgcn_mfma_f32_32x32x16_bf16(PAF(1), VFR(5), o[1], 0, 0, 0), C0, 12); \
    KRD(GL, 2); GAPB(o[0] = __builtin_amdgcn_mfma_f32_32x32x16_bf16(PAF(2), VFR(2), o[0], 0, 0, 0), C1, 0); \
    KRD(GL, 3); GAPB(o[1] = __builtin_amdgcn_mfma_f32_32x32x16_bf16(PAF(2), VFR(6), o[1], 0, 0, 0), C1, 4); \
    GAPB(o[0] = __builtin_amdgcn_mfma_f32_32x32x16_bf16(PAF(3), VFR(3), o[0], 0, 0, 0), C1, 8); \
    GAPB(o[1] = __builtin_amdgcn_mfma_f32_32x32x16_bf16(PAF(3), VFR(7), o[1], 0, 0, 0), C1, 12); \
    } while (0)
  int t = 1;
  for (; t + 5 < NT; t += 2) {
    STEP(pB0, pB1, pA0, pA1, t, true, true, true);     WAIT_BAR(2); RESC(); ROT();
    STEP(pA0, pA1, pB0, pB1, t + 1, true, true, true);   WAIT_BAR(2); RESC(); ROT();
  }
  #define ENDW(tt) do { if ((tt) + 3 < NT) { WAIT_BAR(2); } else if ((tt) + 2 < NT) { WAIT_BAR(1); } else { WAIT_BAR(0); } } while (0)
  for (; t + 1 < NT; t += 2) {
    STEP(pB0, pB1, pA0, pA1, t, (t + 3 < NT), (t + 1 < NT), (t + 1 < NT));       ENDW(t);   RESC(); ROT();
    STEP(pA0, pA1, pB0, pB1, t + 1, (t + 4 < NT), (t + 2 < NT), (t + 2 < NT));     ENDW(t + 1); RESC(); ROT();
  }
  STEP(pB0, pB1, pA0, pA1, NT - 1, false, false, false); RESC();
  { float sacc = pB0[0] + pB0[1]; _Pragma("unroll") for (int r = 2; r < 16; ++r) sacc += pB0[r]; _Pragma("unroll") for (int r = 0; r < 16; ++r) sacc += pB1[r]; l_reg += sacc;
    pw0 = (u32x4){PKW(pB0, 0), PKW(pB0, 2), PKW(pB0, 4), PKW(pB0, 6)}; pw1 = (u32x4){PKW(pB0, 8), PKW(pB0, 10), PKW(pB0, 12), PKW(pB0, 14)}; pw2 = (u32x4){PKW(pB1, 0), PKW(pB1, 2), PKW(pB1, 4), PKW(pB1, 6)}; pw3 = (u32x4){PKW(pB1, 8), PKW(pB1, 10), PKW(pB1, 12), PKW(pB1, 14)};
    SBAR(); pv2(o, vq, sl_cur, PAF(0), PAF(1), PAF(2), PAF(3)); }
  #undef PKW
  #undef PAF
  #undef VFR
  #undef PIN
  #undef MX3
  #undef GAPA
  #undef GAPB
  #undef EX
  #undef VRD
  #undef KRD
  #undef STEP
  #undef ENDW
  { auto rr = __builtin_amdgcn_permlane32_swap(__float_as_uint(l_reg), __float_as_uint(l_reg), false, false); l_reg = __uint_as_float(rr[0]) + __uint_as_float(rr[1]); }
  l_reg += __builtin_amdgcn_exp2f(sink2 - mhat);
  if (hi == 0) wsf[32 + r32] = l_reg; asm volatile("s_waitcnt lgkmcnt(0)" ::: "memory");
  float rli[16];
  #pragma unroll
  for (int r = 0; r < 16; ++r) rli[r] = __builtin_amdgcn_rcpf(wsf[32 + crow(r, hi)]);
  bf16* Ow = O + (qrow + wid * QBLK) * QP + qcol;
  { bf16* stg = (bf16*)(shm + LDS_OST) + wid * 2048;
    #pragma unroll
    for (int r = 0; r < 16; ++r) { const int orow = crow(r, hi);
      #pragma unroll
      for (int d0 = 0; d0 < 2; ++d0) stg[orow * 64 + d0 * 32 + r32] = __float2bfloat16(o[d0][r] * rli[r]); }
    asm volatile("s_waitcnt lgkmcnt(0)" ::: "memory");
    #pragma unroll
    for (int i = 0; i < 4; ++i) { const int row = i * 8 + (lane >> 3), ch = lane & 7; const u32x4 v = *(const u32x4*)(stg + row * 64 + ch * 8); ATTN_STORE16(Ow + (long)row * QP + ch * 8, v); } }
  asm volatile("s_waitcnt lgkmcnt(0)\n\ts_barrier" ::: "memory");
  #undef DMA_K
  #undef DMA_V
  #undef ROWOFF
  #undef CMASK
  #undef START
  #undef RESC
  #undef ROT
}
template <int MODE, int XV = 0> __device__ __forceinline__ void attn_unit_sb(long qrow, long kvrow, int q0, int qcol, int kcol, int vcol, int NT, float sink2, float bound, const bf16* Q, const bf16* __restrict__ KVb, bf16* O, char* shm) {
  int tid_ = threadIdx.x; asm volatile("" : "+v"(tid_));
  const int tid = tid_, lane = tid & 63, r32 = lane & 31, hi = lane >> 5; const int wid = __builtin_amdgcn_readfirstlane(tid >> 6);
  const bf16* Qw = Q + (qrow + wid * QBLK) * QP + qcol;
  const char* kvt = (const char*)KVb + (size_t)(kvrow >> 6) * 65536 + wid * 1024 + lane * 16;
  const unsigned lds0 = (unsigned)(uintptr_t)shm;
  const char* ksrc = kvt + kcol * 8192; const char* vsrc = kvt + vcol * 8192;
  const unsigned kdst = lds0 + LDS_K + wid * 1024, vdst = lds0 + LDS_V + wid * 1024;
  #define ROWOFF(t) ((long)(MODE == 1 ? ((t) + ((t) >= 4 ? ((q0 - 128) >> 6) : 0)) : (t)) * 65536)
  #define DMA_K(t, slot) glds16(ksrc + ROWOFF(t), (unsigned)__builtin_amdgcn_readfirstlane(kdst + (slot)))
  #define DMA_V(t, slot) glds16(vsrc + ROWOFF(t), (unsigned)__builtin_amdgcn_readfirstlane(vdst + (slot)))
  const char* Kbase = shm + LDS_K; bf16x8 kf[8];
  const lds_cptr shm3 = (lds_cptr)shm; const lds_cptr kp0 = shm3 + LDS_K + hi * 1024 + r32 * 16; lds_cptr vq[4];
  { const int swz = (r32 >> 1) & 7; _Pragma("unroll") for (int ks_ = 0; ks_ < 4; ++ks_) vq[ks_] = shm3 + LDS_V + r32 * 128 + (((2 * ks_ + hi) ^ swz) * 16); }
  DMA_K(0, 0); DMA_V(0, 0); DMA_K(1, SLOTB);
  bf16x8 qr[4];
  #pragma unroll
  for (int d0 = 0; d0 < 4; ++d0) qr[d0] = *reinterpret_cast<const bf16x8*>(&Qw[(long)r32 * QP + d0 * 16 + hi * 8]);
  f32x16 o[2]; o[0] = f32x16{}; o[1] = f32x16{}; f32x16 osum = f32x16{};
  const f32x16 negm = f32x16{};
  bf16x8 ones;
  #pragma unroll
  for (int i = 0; i < 8; ++i) ones[i] = (short)0x3F80;
  asm volatile("" : "+v"(ones));
  const int qrel = wid * QBLK + r32;
  int mlo = -128, mhi = 128;
  if (MODE == 1) { const int qi = q0 + qrel; mlo = (-qi > -128) ? -qi : -128; mhi = (SEQ - 1 - qi < 128) ? (SEQ - 1 - qi) : 128; }
  const unsigned mspan = (unsigned)(mhi - mlo);
  #define CMASK(P0, P1, t) do { if (MODE == 1) { if ((t) >= 4) bandmask(P0, P1, (t), mlo, mspan, qrel, hi); } } while (0)
  f32x16 pA0, pA1, pB0, pB1;
  int sl_prev = 0, sl_cur = 0, sl_next = SLOTB;
  #define ROT() do { sl_prev = sl_cur; sl_cur = sl_next; sl_next = (sl_next == (NSLOT - 1) * SLOTB) ? 0 : sl_next + SLOTB; } while (0)
  DMA_K(2, 2 * SLOTB);
  WAIT_BAR(3);
  qkt(pA0, pA1, Kbase, qr, negm, r32, hi); asm volatile("s_nop 15\n\ts_nop 7" : "+v"(pA0), "+v"(pA1)); CMASK(pA0, pA1, 0);
  _Pragma("unroll") for (int r = 0; r < 16; ++r) { pA0[r] = __builtin_amdgcn_exp2f(pA0[r]); pA1[r] = __builtin_amdgcn_exp2f(pA1[r]); }
  WAIT_BAR(0);
  DMA_K(3, 0); DMA_V(1, SLOTB);
  ROT();
  kload8(kf, kp0 + sl_cur);
  WAIT_BAR(2);
  bf16x8 vfr[8]; u32x4 pw0, pw1, pw2, pw3;
  #define PKW(P, B) cvtpk_s(P[B], P[B + 1])
  #define PAF(k) __builtin_bit_cast(bf16x8, pw##k)
  #define VFR(i) vfr[i]
  #define PIN(x) asm volatile("" : "+v"(x))
  #define GAPA(MF, W0, W1, PW) do { MF; W0; W1; PIN(PW); SBAR(); } while (0)
  #define OSUM(k) do { if (XV != 5) osum = __builtin_amdgcn_mfma_f32_32x32x16_bf16(PAF(k), ones, osum, 0, 0, 0); SBAR(); } while (0)
  #define EX(v) (XV == 2 ? (v) : (FASTEXP ? exp2_fast(v) : __builtin_amdgcn_exp2f(v)))
  #define GAPB(MF, X, B) do { MF; X[B] = EX(X[B]); X[B + 1] = EX(X[B + 1]); X[B + 2] = EX(X[B + 2]); X[B + 3] = EX(X[B + 3]); PIN(X); SBAR(); } while (0)
  #define VRD(i) do { if (XV == 3) break; vfr[i] = *(const LAS bf16x8*)(vq[(i) & 3] + vsl_ + ((i) >> 2) * 4096); } while (0)
  #define KRD(G, j) do { if ((G) && XV != 3) { kload2(kf, kp0 + sl_next, j); SBAR(); } } while (0)
  #define STEP(C0, C1, P0, P1, t, GK, GV, GL) do { SBAR(); \
    const int vsl_ = sl_prev; \
    VRD(0); SBAR(); GAPA(C0 = __builtin_amdgcn_mfma_f32_32x32x16_bf16(kf[0], qr[0], negm, 0, 0, 0), pw0[0] = PKW(P0, 0), pw0[1] = PKW(P0, 2), pw0); \
    VRD(4); SBAR(); GAPA(C1 = __builtin_amdgcn_mfma_f32_32x32x16_bf16(kf[1], qr[0], negm, 0, 0, 0), pw0[2] = PKW(P0, 4), pw0[3] = PKW(P0, 6), pw0); \
    VRD(1); SBAR(); GAPA(C0 = __builtin_amdgcn_mfma_f32_32x32x16_bf16(kf[2], qr[1], C0, 0, 0, 0),   pw1[0] = PKW(P0, 8), pw1[1] = PKW(P0, 10), pw1); \
    OSUM(0); \
    VRD(5); SBAR(); GAPA(C1 = __builtin_amdgcn_mfma_f32_32x32x16_bf16(kf[3], qr[1], C1, 0, 0, 0),   pw1[2] = PKW(P0, 12), pw1[3] = PKW(P0, 14), pw1); \
    VRD(2); SBAR(); GAPA(C0 = __builtin_amdgcn_mfma_f32_32x32x16_bf16(kf[4], qr[2], C0, 0, 0, 0),   pw2[0] = PKW(P1, 0), pw2[1] = PKW(P1, 2), pw2); \
    OSUM(1); \
    VRD(6); SBAR(); GAPA(C1 = __builtin_amdgcn_mfma_f32_32x32x16_bf16(kf[5], qr[2], C1, 0, 0, 0),   pw2[2] = PKW(P1, 4), pw2[3] = PKW(P1, 6), pw2); \
    VRD(3); SBAR(); GAPA(C0 = __builtin_amdgcn_mfma_f32_32x32x16_bf16(kf[6], qr[3], C0, 0, 0, 0),   pw3[0] = PKW(P1, 8), pw3[1] = PKW(P1, 10), pw3); \
    OSUM(2); \
    VRD(7); SBAR(); GAPA(C1 = __builtin_amdgcn_mfma_f32_32x32x16_bf16(kf[7], qr[3], C1, 0, 0, 0),   pw3[2] = PKW(P1, 12), pw3[3] = PKW(P1, 14), pw3); \
    if (XV != 1) { if (GK) { DMA_K((t) + 3, sl_cur); } if (GV) { DMA_V((t) + 1, sl_next); } } \
    OSUM(3); \
    CMASK(C0, C1, t); \
    SBAR(); \
    GAPB(o[0] = __builtin_amdgcn_mfma_f32_32x32x16_bf16(PAF(0), VFR(0), o[0], 0, 0, 0), C0, 0); \
    GAPB(o[1] = __builtin_amdgcn_mfma_f32_32x32x16_bf16(PAF(0), VFR(4), o[1], 0, 0, 0), C0, 4); \
    KRD(GL, 0); GAPB(o[0] = __builtin_amdgcn_mfma_f32_32x32x16_bf16(PAF(1), VFR(1), o[0], 0, 0, 0), C0, 8); \
    KRD(GL, 1); GAPB(o[1] = __builtin_amdgcn_mfma_f32_32x32x16_bf16(PAF(1), VFR(5), o[1], 0, 0, 0), C0, 12); \
    KRD(GL, 2); GAPB(o[0] = __builtin_amdgcn_mfma_f32_32x32x16_bf16(PAF(2), VFR(2), o[0], 0, 0, 0), C1, 0); \
    KRD(GL, 3); GAPB(o[1] = __builtin_amdgcn_mfma_f32_32x32x16_bf16(PAF(2), VFR(6), o[1], 0, 0, 0), C1, 4); \
    GAPB(o[0] = __builtin_amdgcn_mfma_f32_32x32x16_bf16(PAF(3), VFR(3), o[0], 0, 0, 0), C1, 8); \
    GAPB(o[1] = __builtin_amdgcn_mfma_f32_32x32x16_bf16(PAF(3), VFR(7), o[1], 0, 0, 0), C1, 12); \
    } while (0)
  int t = 1;
  for (; t + 5 < NT; t += 2) {
    STEP(pB0, pB1, pA0, pA1, t, true, true, true);     WAIT_BAR(2); ROT();
    STEP(pA0, pA1, pB0, pB1, t + 1, true, true, true);   WAIT_BAR(2); ROT();
  }
  #define ENDW(tt) do { if ((tt) + 3 < NT) { WAIT_BAR(2); } else if ((tt) + 2 < NT) { WAIT_BAR(1); } else { WAIT_BAR(0); } } while (0)
  for (; t + 1 < NT; t += 2) {
    STEP(pB0, pB1, pA0, pA1, t, (t + 3 < NT), (t + 1 < NT), (t + 1 < NT));       ENDW(t);   ROT();
    STEP(pA0, pA1, pB0, pB1, t + 1, (t + 4 < NT), (t + 2 < NT), (t + 2 < NT));     ENDW(t + 1); ROT();
  }
  STEP(pB0, pB1, pA0, pA1, NT - 1, false, false, false);
  { pw0 = (u32x4){PKW(pB0, 0), PKW(pB0, 2), PKW(pB0, 4), PKW(pB0, 6)}; pw1 = (u32x4){PKW(pB0, 8), PKW(pB0, 10), PKW(pB0, 12), PKW(pB0, 14)}; pw2 = (u32x4){PKW(pB1, 0), PKW(pB1, 2), PKW(pB1, 4), PKW(pB1, 6)}; pw3 = (u32x4){PKW(pB1, 8), PKW(pB1, 10), PKW(pB1, 12), PKW(pB1, 14)};
    SBAR(); OSUM(0); OSUM(1); OSUM(2); OSUM(3); pv2(o, vq, sl_cur, PAF(0), PAF(1), PAF(2), PAF(3)); }
  #undef PKW
  #undef PAF
  #undef VFR
  #undef PIN
  #undef GAPA
  #undef OSUM
  #undef GAPB
  #undef EX
  #undef VRD
  #undef KRD
  #undef STEP
  #undef ENDW
  const float sterm = __builtin_amdgcn_exp2f(sink2);
  float rli[16];
  #pragma unroll
  for (int r = 0; r < 16; ++r) rli[r] = __builtin_amdgcn_rcpf(osum[r] + sterm);
  bf16* Ow = O + (qrow + wid * QBLK) * QP + qcol;
  { bf16* stg = (bf16*)(shm + LDS_OST) + wid * 2048;
    #pragma unroll
    for (int r = 0; r < 16; ++r) { const int orow = crow(r, hi);
      #pragma unroll
      for (int d0 = 0; d0 < 2; ++d0) stg[orow * 64 + d0 * 32 + r32] = __float2bfloat16(o[d0][r] * rli[r]); }
    asm volatile("s_waitcnt lgkmcnt(0)" ::: "memory");
    #pragma unroll
    for (int i = 0; i < 4; ++i) { const int row = i * 8 + (lane >> 3), ch = lane & 7; const u32x4 v = *(const u32x4*)(stg + row * 64 + ch * 8); ATTN_STORE16(Ow + (long)row * QP + ch * 8, v); } }
  asm volatile("s_waitcnt lgkmcnt(0)\n\ts_barrier" ::: "memory");
  #undef DMA_K
  #undef DMA_V
  #undef ROWOFF
  #undef CMASK
  #undef ROT
}
template <int MODE> __device__ __forceinline__ void attn_unit_sk(long qrow, long kvrow, int q0, int qcol, int kcol, int vcol, int NT, float sink2, float bound, const bf16* Q, const bf16* __restrict__ KVb, bf16* O, char* shm) {
  int tid_ = threadIdx.x; asm volatile("" : "+v"(tid_));
  const int tid = tid_, lane = tid & 63, r32 = lane & 31, hi = lane >> 5; const int wid = __builtin_amdgcn_readfirstlane(tid >> 6);
  const bf16* Qw = Q + (qrow + wid * QBLK) * QP + qcol;
  const char* kvt = (const char*)KVb + (size_t)(kvrow >> 6) * 65536 + wid * 1024 + lane * 16;
  constexpr int NSL = 4, LK = 0, LV = NSL * SLOTB, LOST = 2 * NSL * SLOTB + NW * 64 * 4;
  const unsigned lds0 = (unsigned)(uintptr_t)shm;
  const char* ksrc = kvt + kcol * 8192; const char* vsrc = kvt + vcol * 8192;
  const unsigned kdst = lds0 + LK + wid * 1024, vdst = lds0 + LV + wid * 1024;
  #define ROWOFF(t) ((long)(MODE == 1 ? ((t) + ((t) >= 4 ? ((q0 - 128) >> 6) : 0)) : (t)) * 65536)
  #define DMA_K(t, slot) glds16(ksrc + ROWOFF(t), (unsigned)__builtin_amdgcn_readfirstlane(kdst + (slot)))
  #define DMA_V(t, slot) glds16(vsrc + ROWOFF(t), (unsigned)__builtin_amdgcn_readfirstlane(vdst + (slot)))
  const char* Kbase = shm + LK; bf16x8 kf[8];
  const lds_cptr shm3 = (lds_cptr)shm; const lds_cptr kp0 = shm3 + LK + hi * 1024 + r32 * 16; lds_cptr vq[4];
  { const int swz = (r32 >> 1) & 7; _Pragma("unroll") for (int ks_ = 0; ks_ < 4; ++ks_) vq[ks_] = shm3 + LV + r32 * 128 + (((2 * ks_ + hi) ^ swz) * 16); }
  DMA_K(0, 0); DMA_V(0, 0); DMA_K(1, SLOTB);
  bf16x8 qr[4];
  #pragma unroll
  for (int d0 = 0; d0 < 4; ++d0) qr[d0] = *reinterpret_cast<const bf16x8*>(&Qw[(long)r32 * QP + d0 * 16 + hi * 8]);
  f32x16 o[2]; o[0] = f32x16{}; o[1] = f32x16{}; f32x16 osum = f32x16{};
  const f32x16 negm = f32x16{};
  bf16x8 ones;
  #pragma unroll
  for (int i = 0; i < 8; ++i) ones[i] = (short)0x3F80;
  asm volatile("" : "+v"(ones));
  const int qrel = wid * QBLK + r32;
  int mlo = -128, mhi = 128;
  if (MODE == 1) { const int qi = q0 + qrel; mlo = (-qi > -128) ? -qi : -128; mhi = (SEQ - 1 - qi < 128) ? (SEQ - 1 - qi) : 128; }
  const unsigned mspan = (unsigned)(mhi - mlo);
  #define CMASK(P0, P1, t) do { if (MODE == 1) { if ((t) >= 4) bandmask(P0, P1, (t), mlo, mspan, qrel, hi); } } while (0)
  f32x16 pA0, pA1, pB0, pB1;
  int sl_prev = 0, sl_cur = 0, sl_next = SLOTB;
  #define ROT() do { sl_prev = sl_cur; sl_cur = sl_next; sl_next = (sl_next == (NSL - 1) * SLOTB) ? 0 : sl_next + SLOTB; } while (0)
  DMA_K(2, 2 * SLOTB);
  WAIT_BAR(3);
  qkt(pA0, pA1, Kbase, qr, negm, r32, hi); asm volatile("s_nop 15\n\ts_nop 7" : "+v"(pA0), "+v"(pA1)); CMASK(pA0, pA1, 0);
  _Pragma("unroll") for (int r = 0; r < 16; ++r) { pA0[r] = __builtin_amdgcn_exp2f(pA0[r]); pA1[r] = __builtin_amdgcn_exp2f(pA1[r]); }
  WAIT_BAR(0);
  DMA_V(1, SLOTB); DMA_K(3, 3 * SLOTB); DMA_V(2, 2 * SLOTB); if (4 < NT) { DMA_K(4, 0); }
  ROT();
  kload8(kf, kp0 + sl_cur);
  WAIT_BAR(4);
  if (wid >= 4) asm volatile("s_barrier" ::: "memory");
  bf16x8 vfr[8]; u32x4 pw0, pw1, pw2, pw3;
  #define PKW(P, B) cvtpk_s(P[B], P[B + 1])
  #define PAF(k) __builtin_bit_cast(bf16x8, pw##k)
  #define VFR(i) vfr[i]
  #define PIN(x) asm volatile("" : "+v"(x))
  #define GAPA(MF, W0, W1, PW) do { MF; W0; W1; PIN(PW); SBAR(); } while (0)
  #define OSUM(k) do { osum = __builtin_amdgcn_mfma_f32_32x32x16_bf16(PAF(k), ones, osum, 0, 0, 0); SBAR(); } while (0)
  #define EX(v) (FASTEXP ? exp2_fast(v) : __builtin_amdgcn_exp2f(v))
  #define GAPB(MF, X, B) do { MF; X[B] = EX(X[B]); X[B + 1] = EX(X[B + 1]); X[B + 2] = EX(X[B + 2]); X[B + 3] = EX(X[B + 3]); PIN(X); SBAR(); } while (0)
  #define VRD(i) do { vfr[i] = *(const LAS bf16x8*)(vq[(i) & 3] + vsl_ + ((i) >> 2) * 4096); } while (0)
  #define KRD(G, j) do { if (G) { kload2(kf, kp0 + sl_next, j); SBAR(); } } while (0)
  #define STEP(C0, C1, P0, P1, t, GK, GV, GL, WMID) do { SBAR(); \
    const int vsl_ = sl_prev; \
    VRD(0); SBAR(); GAPA(C0 = __builtin_amdgcn_mfma_f32_32x32x16_bf16(kf[0], qr[0], negm, 0, 0, 0), pw0[0] = PKW(P0, 0), pw0[1] = PKW(P0, 2), pw0); \
    VRD(4); SBAR(); GAPA(C1 = __builtin_amdgcn_mfma_f32_32x32x16_bf16(kf[1], qr[0], negm, 0, 0, 0), pw0[2] = PKW(P0, 4), pw0[3] = PKW(P0, 6), pw0); \
    VRD(1); SBAR(); GAPA(C0 = __builtin_amdgcn_mfma_f32_32x32x16_bf16(kf[2], qr[1], C0, 0, 0, 0),   pw1[0] = PKW(P0, 8), pw1[1] = PKW(P0, 10), pw1); \
    OSUM(0); \
    VRD(5); SBAR(); GAPA(C1 = __builtin_amdgcn_mfma_f32_32x32x16_bf16(kf[3], qr[1], C1, 0, 0, 0),   pw1[2] = PKW(P0, 12), pw1[3] = PKW(P0, 14), pw1); \
    VRD(2); SBAR(); GAPA(C0 = __builtin_amdgcn_mfma_f32_32x32x16_bf16(kf[4], qr[2], C0, 0, 0, 0),   pw2[0] = PKW(P1, 0), pw2[1] = PKW(P1, 2), pw2); \
    OSUM(1); \
    VRD(6); SBAR(); GAPA(C1 = __builtin_amdgcn_mfma_f32_32x32x16_bf16(kf[5], qr[2], C1, 0, 0, 0),   pw2[2] = PKW(P1, 4), pw2[3] = PKW(P1, 6), pw2); \
    VRD(3); SBAR(); GAPA(C0 = __builtin_amdgcn_mfma_f32_32x32x16_bf16(kf[6], qr[3], C0, 0, 0, 0),   pw3[0] = PKW(P1, 8), pw3[1] = PKW(P1, 10), pw3); \
    OSUM(2); \
    VRD(7); SBAR(); GAPA(C1 = __builtin_amdgcn_mfma_f32_32x32x16_bf16(kf[7], qr[3], C1, 0, 0, 0),   pw3[2] = PKW(P1, 12), pw3[3] = PKW(P1, 14), pw3); \
    OSUM(3); \
    CMASK(C0, C1, t); \
    SBAR(); \
    WMID; \
    if (GV) { DMA_V((t) + 2, (sl_next == (NSL - 1) * SLOTB) ? 0 : sl_next + SLOTB); } if (GK) { DMA_K((t) + 4, sl_cur); } \
    SBAR(); \
    GAPB(o[0] = __builtin_amdgcn_mfma_f32_32x32x16_bf16(PAF(0), VFR(0), o[0], 0, 0, 0), C0, 0); \
    GAPB(o[1] = __builtin_amdgcn_mfma_f32_32x32x16_bf16(PAF(0), VFR(4), o[1], 0, 0, 0), C0, 4); \
    KRD(GL, 0); GAPB(o[0] = __builtin_amdgcn_mfma_f32_32x32x16_bf16(PAF(1), VFR(1), o[0], 0, 0, 0), C0, 8); \
    KRD(GL, 1); GAPB(o[1] = __builtin_amdgcn_mfma_f32_32x32x16_bf16(PAF(1), VFR(5), o[1], 0, 0, 0), C0, 12); \
    KRD(GL, 2); GAPB(o[0] = __builtin_amdgcn_mfma_f32_32x32x16_bf16(PAF(2), VFR(2), o[0], 0, 0, 0), C1, 0); \
    KRD(GL, 3); GAPB(o[1] = __builtin_amdgcn_mfma_f32_32x32x16_bf16(PAF(2), VFR(6), o[1], 0, 0, 0), C1, 4); \
    GAPB(o[0] = __builtin_amdgcn_mfma_f32_32x32x16_bf16(PAF(3), VFR(3), o[0], 0, 0, 0), C1, 8); \
    GAPB(o[1] = __builtin_amdgcn_mfma_f32_32x32x16_bf16(PAF(3), VFR(7), o[1], 0, 0, 0), C1, 12); \
    } while (0)
  int t = 1;
  for (; t + 5 < NT; t += 2) {
    STEP(pB0, pB1, pA0, pA1, t, true, true, true, WAIT_BAR(3));     WAIT_BAR(4); ROT();
    STEP(pA0, pA1, pB0, pB1, t + 1, true, true, true, WAIT_BAR(3));   WAIT_BAR(4); ROT();
  }
  for (; t + 1 < NT; t += 2) {
    STEP(pB0, pB1, pA0, pA1, t, (t + 4 < NT), (t + 2 < NT), (t + 1 < NT), WAIT_BAR(0));       WAIT_BAR(0); ROT();
    STEP(pA0, pA1, pB0, pB1, t + 1, (t + 5 < NT), (t + 3 < NT), (t + 2 < NT), WAIT_BAR(0));     WAIT_BAR(0); ROT();
  }
  STEP(pB0, pB1, pA0, pA1, NT - 1, false, false, false, WAIT_BAR(0));
  if (wid < 4) { WAIT_BAR(0); }
  { pw0 = (u32x4){PKW(pB0, 0), PKW(pB0, 2), PKW(pB0, 4), PKW(pB0, 6)}; pw1 = (u32x4){PKW(pB0, 8), PKW(pB0, 10), PKW(pB0, 12), PKW(pB0, 14)}; pw2 = (u32x4){PKW(pB1, 0), PKW(pB1, 2), PKW(pB1, 4), PKW(pB1, 6)}; pw3 = (u32x4){PKW(pB1, 8), PKW(pB1, 10), PKW(pB1, 12), PKW(pB1, 14)};
    SBAR(); OSUM(0); OSUM(1); OSUM(2); OSUM(3); pv2(o, vq, sl_cur, PAF(0), PAF(1), PAF(2), PAF(3)); }
  #undef PKW
  #undef PAF
  #undef VFR
  #undef PIN
  #undef GAPA
  #undef OSUM
  #undef GAPB
  #undef EX
  #undef VRD
  #undef KRD
  #undef STEP
  const float sterm = __builtin_amdgcn_exp2f(sink2);
  float rli[16];
  #pragma unroll
  for (int r = 0; r < 16; ++r) rli[r] = __builtin_amdgcn_rcpf(osum[r] + sterm);
  bf16* Ow = O + (qrow + wid * QBLK) * QP + qcol;
  { bf16* stg = (bf16*)(shm + LOST) + wid * 2048;
    #pragma unroll
    for (int r = 0; r < 16; ++r) { const int orow = crow(r, hi);
      #pragma unroll
      for (int d0 = 0; d0 < 2; ++d0) stg[orow * 64 + d0 * 32 + r32] = __float2bfloat16(o[d0][r] * rli[r]); }
    asm volatile("s_waitcnt lgkmcnt(0)" ::: "memory");
    #pragma unroll
    for (int i = 0; i < 4; ++i) { const int row = i * 8 + (lane >> 3), ch = lane & 7; const u32x4 v = *(const u32x4*)(stg + row * 64 + ch * 8); ATTN_STORE16(Ow + (long)row * QP + ch * 8, v); } }
  asm volatile("s_waitcnt lgkmcnt(0)\n\ts_barrier" ::: "memory");
  #undef DMA_K
  #undef DMA_V
  #undef ROWOFF
  #undef CMASK
  #undef ROT
}
typedef int v8i_t __attribute__((ext_vector_type(8)));
typedef int v4i_t __attribute__((ext_vector_type(4)));
template <int MODE, int XV = 0> __device__ __forceinline__ void attn_unit_f8(long qrow, long kvrow, int q0, int qcol, int kst, int vst, int NT, float sink2, float ref, const unsigned char* Qf8, const unsigned char* KVT, bf16* O, char* shm) {
  int tid_ = threadIdx.x; asm volatile("" : "+v"(tid_));
  const int tid = tid_, lane = tid & 63, r32 = lane & 31, hi = lane >> 5; const int wid = __builtin_amdgcn_readfirstlane(tid >> 6);
  constexpr int KSL = 4096, VSL = 8192, LK = 0, LV = 3 * KSL, LOST = LV + 3 * VSL, TILEB = 49152;
  const unsigned lds0 = (unsigned)(uintptr_t)shm;
  const unsigned char* tile0 = KVT + (size_t)(kvrow >> 6) * TILEB;
  const unsigned char* ksrc = tile0 + kst * KSL + wid * 512 + (lane & 31) * 16;
  const unsigned char* vsrc = tile0 + 4 * KSL + vst * VSL + wid * 1024 + lane * 16;
  const unsigned kdst = lds0 + LK + wid * 512, vdst = lds0 + LV + wid * 1024;
  #define ROWOFF(t) ((long)(MODE == 1 ? ((t) + ((t) >= 4 ? ((q0 - 128) >> 6) : 0)) : (t)) * TILEB)
  #define DMA_K(t, kslot) do { if (lane < 32) glds16(ksrc + ROWOFF(t), (unsigned)__builtin_amdgcn_readfirstlane(kdst + (kslot))); } while (0)
  #define DMA_V(t, vslot) glds16(vsrc + ROWOFF(t), (unsigned)__builtin_amdgcn_readfirstlane(vdst + (vslot)))
  const lds_cptr shm3 = (lds_cptr)shm;
  const int ksw = (r32 >> 2) & 3;
  const lds_cptr kq0 = shm3 + LK + r32 * 64 + (((2 * hi) ^ ksw) * 16), kq1 = shm3 + LK + r32 * 64 + (((2 * hi + 1) ^ ksw) * 16);
  lds_cptr vq[4];
  { const int swz = (r32 >> 1) & 7; _Pragma("unroll") for (int ks_ = 0; ks_ < 4; ++ks_) vq[ks_] = shm3 + LV + r32 * 128 + (((2 * ks_ + hi) ^ swz) * 16); }
  DMA_K(0, 0); DMA_V(0, 0); DMA_K(1, KSL);
  v8i_t qf;
  { const v4i_t* qp = (const v4i_t*)(Qf8 + (size_t)(qrow + wid * QBLK + r32) * 1024 + qcol + hi * 32); const v4i_t a = qp[0], b = qp[1]; qf = (v8i_t){a[0], a[1], a[2], a[3], b[0], b[1], b[2], b[3]}; }
  f32x16 o[2]; o[0] = f32x16{}; o[1] = f32x16{}; f32x16 osum = f32x16{};
  f32x16 negm;
  #pragma unroll
  for (int r = 0; r < 16; ++r) negm[r] = -ref;
  asm volatile("" : "+v"(negm));
  bf16x8 ones;
  #pragma unroll
  for (int i = 0; i < 8; ++i) ones[i] = (short)0x3F80;
  asm volatile("" : "+v"(ones));
  const int qrel = wid * QBLK + r32;
  int mlo = -128, mhi = 128;
  if (MODE == 1) { const int qi = q0 + qrel; mlo = (-qi > -128) ? -qi : -128; mhi = (SEQ - 1 - qi < 128) ? (SEQ - 1 - qi) : 128; }
  const unsigned mspan = (unsigned)(mhi - mlo);
  #define CMASK(P0, P1, t) do { if (MODE == 1) { if ((t) >= 4) bandmask(P0, P1, (t), mlo, mspan, qrel, hi); } } while (0)
  #define MF8(kfr, cin) __builtin_amdgcn_mfma_scale_f32_32x32x64_f8f6f4(kfr, qf, cin, 0, 0, 0, 0x7F7F7F7F, 0, 0x7F7F7F7F)
  #define KLOAD(dst, b, kslot) do { const v4i_t a_ = *(const LAS v4i_t*)(kq0 + (kslot) + (b) * 2048), b_ = *(const LAS v4i_t*)(kq1 + (kslot) + (b) * 2048); dst = (v8i_t){a_[0], a_[1], a_[2], a_[3], b_[0], b_[1], b_[2], b_[3]}; } while (0)
  f32x16 pA0, pA1, pB0, pB1;
  int sl_prev = 0, sl_cur = 0, sl_next = VSL;
  #define ROT() do { sl_prev = sl_cur; sl_cur = sl_next; sl_next = (sl_next == 2 * VSL) ? 0 : sl_next + VSL; } while (0)
  DMA_K(2, 2 * KSL);
  WAIT_BAR(3);
  v8i_t kf0, kf1;
  KLOAD(kf0, 0, 0); KLOAD(kf1, 1, 0);
  pA0 = MF8(kf0, negm); pA1 = MF8(kf1, negm);
  asm volatile("s_nop 15\n\ts_nop 7" : "+v"(pA0), "+v"(pA1)); CMASK(pA0, pA1, 0);
  _Pragma("unroll") for (int r = 0; r < 16; ++r) { pA0[r] = __builtin_amdgcn_exp2f(pA0[r]); pA1[r] = __builtin_amdgcn_exp2f(pA1[r]); }
  WAIT_BAR(0);
  DMA_K(3, 0); DMA_V(1, VSL);
  ROT();
  KLOAD(kf0, 0, sl_cur >> 1); KLOAD(kf1, 1, sl_cur >> 1);
  WAIT_BAR(2);
  bf16x8 vfr[8]; u32x4 pw0, pw1, pw2, pw3;
  #define PKW(P, B) cvtpk_s(P[B], P[B + 1])
  #define PAF(k) __builtin_bit_cast(bf16x8, pw##k)
  #define VFR(i) vfr[i]
  #define PIN(x) asm volatile("" : "+v"(x))
  #define OSUM(k) do { if (XV != 5) osum = __builtin_amdgcn_mfma_f32_32x32x16_bf16(PAF(k), ones, osum, 0, 0, 0); SBAR(); } while (0)
  #define EX(v) __builtin_amdgcn_exp2f(v)
  #define GAPB(MF, X, B) do { MF; X[B] = EX(X[B]); X[B + 1] = EX(X[B + 1]); X[B + 2] = EX(X[B + 2]); X[B + 3] = EX(X[B + 3]); PIN(X); SBAR(); } while (0)
  #define VRD(i) do { vfr[i] = *(const LAS bf16x8*)(vq[(i) & 3] + vsl_ + ((i) >> 2) * 4096); } while (0)
  #define STEP(C0, C1, P0, P1, t, GK, GV, GL) do { SBAR(); \
    const int vsl_ = sl_prev; \
    VRD(0); VRD(4); SBAR(); \
    C0 = MF8(kf0, negm); pw0[0] = PKW(P0, 0); pw0[1] = PKW(P0, 2); pw0[2] = PKW(P0, 4); pw0[3] = PKW(P0, 6); PIN(pw0); SBAR(); \
    VRD(1); VRD(5); SBAR(); \
    C1 = MF8(kf1, negm); pw1[0] = PKW(P0, 8); pw1[1] = PKW(P0, 10); pw1[2] = PKW(P0, 12); pw1[3] = PKW(P0, 14); PIN(pw1); SBAR(); \
    VRD(2); VRD(6); SBAR(); \
    OSUM(0); pw2[0] = PKW(P1, 0); pw2[1] = PKW(P1, 2); pw2[2] = PKW(P1, 4); pw2[3] = PKW(P1, 6); PIN(pw2); SBAR(); \
    VRD(3); VRD(7); SBAR(); \
    OSUM(1); pw3[0] = PKW(P1, 8); pw3[1] = PKW(P1, 10); pw3[2] = PKW(P1, 12); pw3[3] = PKW(P1, 14); PIN(pw3); SBAR(); \
    OSUM(2); \
    if (GK) { DMA_K((t) + 3, sl_cur >> 1); } if (GV) { DMA_V((t) + 1, sl_next); } \
    OSUM(3); \
    CMASK(C0, C1, t); \
    SBAR(); \
    GAPB(o[0] = __builtin_amdgcn_mfma_f32_32x32x16_bf16(PAF(0), VFR(0), o[0], 0, 0, 0), C0, 0); \
    GAPB(o[1] = __builtin_amdgcn_mfma_f32_32x32x16_bf16(PAF(0), VFR(4), o[1], 0, 0, 0), C0, 4); \
    if (GL) { KLOAD(kf0, 0, sl_next >> 1); SBAR(); } \
    GAPB(o[0] = __builtin_amdgcn_mfma_f32_32x32x16_bf16(PAF(1), VFR(1), o[0], 0, 0, 0), C0, 8); \
    GAPB(o[1] = __builtin_amdgcn_mfma_f32_32x32x16_bf16(PAF(1), VFR(5), o[1], 0, 0, 0), C0, 12); \
    if (GL) { KLOAD(kf1, 1, sl_next >> 1); SBAR(); } \
    GAPB(o[0] = __builtin_amdgcn_mfma_f32_32x32x16_bf16(PAF(2), VFR(2), o[0], 0, 0, 0), C1, 0); \
    GAPB(o[1] = __builtin_amdgcn_mfma_f32_32x32x16_bf16(PAF(2), VFR(6), o[1], 0, 0, 0), C1, 4); \
    GAPB(o[0] = __builtin_amdgcn_mfma_f32_32x32x16_bf16(PAF(3), VFR(3), o[0], 0, 0, 0), C1, 8); \
    GAPB(o[1] = __builtin_amdgcn_mfma_f32_32x32x16_bf16(PAF(3), VFR(7), o[1], 0, 0, 0), C1, 12); \
    } while (0)
  int t = 1;
  for (; t + 5 < NT; t += 2) {
    STEP(pB0, pB1, pA0, pA1, t, true, true, true);     WAIT_BAR(2); ROT();
    STEP(pA0, pA1, pB0, pB1, t + 1, true, true, true);   WAIT_BAR(2); ROT();
  }
  #define ENDW(tt) do { if ((tt) + 3 < NT) { WAIT_BAR(2); } else if ((tt) + 2 < NT) { WAIT_BAR(1); } else { WAIT_BAR(0); } } while (0)
  for (; t + 1 < NT; t += 2) {
    STEP(pB0, pB1, pA0, pA1, t, (t + 3 < NT), (t + 1 < NT), (t + 1 < NT));       ENDW(t);   ROT();
    STEP(pA0, pA1, pB0, pB1, t + 1, (t + 4 < NT), (t + 2 < NT), (t + 2 < NT));     ENDW(t + 1); ROT();
  }
  STEP(pB0, pB1, pA0, pA1, NT - 1, false, false, false);
  { pw0 = (u32x4){PKW(pB0, 0), PKW(pB0, 2), PKW(pB0, 4), PKW(pB0, 6)}; pw1 = (u32x4){PKW(pB0, 8), PKW(pB0, 10), PKW(pB0, 12), PKW(pB0, 14)}; pw2 = (u32x4){PKW(pB1, 0), PKW(pB1, 2), PKW(pB1, 4), PKW(pB1, 6)}; pw3 = (u32x4){PKW(pB1, 8), PKW(pB1, 10), PKW(pB1, 12), PKW(pB1, 14)};
    SBAR(); OSUM(0); OSUM(1); OSUM(2); OSUM(3); pv2(o, vq, sl_cur, PAF(0), PAF(1), PAF(2), PAF(3)); }
  #undef PKW
  #undef PAF
  #undef VFR
  #undef PIN
  #undef OSUM
  #undef GAPB
  #undef EX
  #undef VRD
  #undef STEP
  #undef ENDW
  #undef MF8
  #undef KLOAD
  const float sterm = __builtin_amdgcn_exp2f(sink2 - ref);
  float rli[16];
  #pragma unroll
  for (int r = 0; r < 16; ++r) rli[r] = __builtin_amdgcn_rcpf(osum[r] + sterm);
  bf16* Ow = O + (qrow + wid * QBLK) * QP + qcol;
  { bf16* stg = (bf16*)(shm + LOST) + wid * 2048;
    #pragma unroll
    for (int r = 0; r < 16; ++r) { const int orow = crow(r, hi);
      #pragma unroll
      for (int d0 = 0; d0 < 2; ++d0) stg[orow * 64 + d0 * 32 + r32] = __float2bfloat16(o[d0][r] * rli[r]); }
    asm volatile("s_waitcnt lgkmcnt(0)" ::: "memory");
    #pragma unroll
    for (int i = 0; i < 4; ++i) { const int row = i * 8 + (lane >> 3), ch = lane & 7; const u32x4 v = *(const u32x4*)(stg + row * 64 + ch * 8); ATTN_STORE16(Ow + (long)row * QP + ch * 8, v); } }
  asm volatile("s_waitcnt lgkmcnt(0)\n\ts_barrier" ::: "memory");
  #undef DMA_K
  #undef DMA_V
  #undef ROWOFF
  #undef CMASK
  #undef ROT
}
template <int MODE> __device__ __forceinline__ void attn_unit_f8b(long qrow, long kvrow, int q0, int qcol, int kst, int vst, int NT, float sink2, float cref, const unsigned char* Qf8, const unsigned char* KVT, bf16* O, char* shm) {
  int tid_ = threadIdx.x; asm volatile("" : "+v"(tid_));
  const int tid = tid_, lane = tid & 63, r32 = lane & 31, hi = lane >> 5; const int wid = __builtin_amdgcn_readfirstlane(tid >> 6);
  constexpr int SL = 4096, LK = 0, LV = 3 * SL, LOST = LV + 3 * SL, TILEB = 32768;
  const unsigned lds0 = (unsigned)(uintptr_t)shm;
  const unsigned char* tile0 = KVT + (size_t)(kvrow >> 6) * TILEB + wid * 512 + (lane & 31) * 16;
  const unsigned char* ksrc = tile0 + kst * SL; const unsigned char* vsrc = tile0 + 4 * SL + vst * SL;
  const unsigned kdst = lds0 + LK + wid * 512, vdst = lds0 + LV + wid * 512;
  #define ROWOFF(t) ((long)(MODE == 1 ? ((t) + ((t) >= 4 ? ((q0 - 128) >> 6) : 0)) : (t)) * TILEB)
  #define DMA_K(t, slot) do { if (lane < 32) glds16(ksrc + ROWOFF(t), (unsigned)__builtin_amdgcn_readfirstlane(kdst + (slot))); } while (0)
  #define DMA_V(t, slot) do { if (lane < 32) glds16(vsrc + ROWOFF(t), (unsigned)__builtin_amdgcn_readfirstlane(vdst + (slot))); } while (0)
  const lds_cptr shm3 = (lds_cptr)shm;
  const int ksw = (r32 >> 2) & 3;
  const lds_cptr fq0 = shm3 + r32 * 64 + (((2 * hi) ^ ksw) * 16), fq1 = shm3 + r32 * 64 + (((2 * hi + 1) ^ ksw) * 16);
  DMA_K(0, 0); DMA_V(0, 0); DMA_K(1, SL);
  v8i_t qf;
  { const v4i_t* qp = (const v4i_t*)(Qf8 + (size_t)(qrow + wid * QBLK + r32) * 1024 + qcol + hi * 32); const v4i_t a = qp[0], b = qp[1]; qf = (v8i_t){a[0], a[1], a[2], a[3], b[0], b[1], b[2], b[3]}; }
  f32x16 o[2]; o[0] = f32x16{}; o[1] = f32x16{}; f32x16 osum = f32x16{};
  f32x16 negm;
  #pragma unroll
  for (int r = 0; r < 16; ++r) negm[r] = -cref;
  asm volatile("" : "+v"(negm));
  v8i_t ones8;
  #pragma unroll
  for (int i = 0; i < 8; ++i) ones8[i] = 0x38383838;
  asm volatile("" : "+v"(ones8));
  const int qrel = wid * QBLK + r32;
  int mlo = -128, mhi = 128;
  if (MODE == 1) { const int qi = q0 + qrel; mlo = (-qi > -128) ? -qi : -128; mhi = (SEQ - 1 - qi < 128) ? (SEQ - 1 - qi) : 128; }
  const unsigned mspan = (unsigned)(mhi - mlo);
  #define CMASK(P0, P1, t) do { if (MODE == 1) { if ((t) >= 4) bandmask(P0, P1, (t), mlo, mspan, qrel, hi); } } while (0)
  #define MFQK(kfr) __builtin_amdgcn_mfma_scale_f32_32x32x64_f8f6f4(kfr, qf, negm, 0, 0, 0, 0x7F7F7F7F, 0, 0x7F7F7F7F)
  #define MFPV(bfr, cin) __builtin_amdgcn_mfma_scale_f32_32x32x64_f8f6f4(pf, bfr, cin, 1, 0, 0, 0x7F7F7F7F, 0, 0x7F7F7F7F)
  #define FLOAD(dst, base, b, slot) do { const v4i_t a_ = *(const LAS v4i_t*)(fq0 + (base) + (slot) + (b) * 2048), b_ = *(const LAS v4i_t*)(fq1 + (base) + (slot) + (b) * 2048); dst = (v8i_t){a_[0], a_[1], a_[2], a_[3], b_[0], b_[1], b_[2], b_[3]}; } while (0)
  #define PK8(x0, x1, x2, x3) __builtin_amdgcn_cvt_pk_bf8_f32(x2, x3, __builtin_amdgcn_cvt_pk_bf8_f32(x0, x1, 0, false), true)
  f32x16 pA0, pA1, pB0, pB1;
  int sl_prev = 0, sl_cur = 0, sl_next = SL;
  #define ROT() do { sl_prev = sl_cur; sl_cur = sl_next; sl_next = (sl_next == 2 * SL) ? 0 : sl_next + SL; } while (0)
  DMA_K(2, 2 * SL);
  WAIT_BAR(3);
  v8i_t kf0, kf1, vf0, vf1, pf;
  FLOAD(kf0, LK, 0, 0); FLOAD(kf1, LK, 1, 0);
  pA0 = MFQK(kf0); pA1 = MFQK(kf1);
  asm volatile("s_nop 15\n\ts_nop 7" : "+v"(pA0), "+v"(pA1)); CMASK(pA0, pA1, 0);
  _Pragma("unroll") for (int r = 0; r < 16; ++r) { pA0[r] = __builtin_amdgcn_exp2f(pA0[r]); pA1[r] = __builtin_amdgcn_exp2f(pA1[r]); }
  WAIT_BAR(0);
  DMA_K(3, 0); DMA_V(1, SL);
  ROT();
  FLOAD(kf0, LK, 0, sl_cur); FLOAD(kf1, LK, 1, sl_cur);
  WAIT_BAR(2);
  #define PIN(x) asm volatile("" : "+v"(x))
  #define EX(v) __builtin_amdgcn_exp2f(v)
  #define EX8(X, B) do { _Pragma("unroll") for (int e_ = 0; e_ < 8; ++e_) X[(B) + e_] = EX(X[(B) + e_]); PIN(X); } while (0)
  #define PACKP(P0, P1) do { pf[0] = PK8(P0[0], P0[1], P0[2], P0[3]); pf[1] = PK8(P0[4], P0[5], P0[6], P0[7]); pf[2] = PK8(P0[8], P0[9], P0[10], P0[11]); pf[3] = PK8(P0[12], P0[13], P0[14], P0[15]); \
                             pf[4] = PK8(P1[0], P1[1], P1[2], P1[3]); pf[5] = PK8(P1[4], P1[5], P1[6], P1[7]); pf[6] = PK8(P1[8], P1[9], P1[10], P1[11]); pf[7] = PK8(P1[12], P1[13], P1[14], P1[15]); PIN(pf); } while (0)
  #define STEP(C0, C1, P0, P1, t, GK, GV, GL) do { SBAR(); \
    FLOAD(vf0, LV, 0, sl_prev); FLOAD(vf1, LV, 1, sl_prev); SBAR(); \
    C0 = MFQK(kf0); SBAR(); \
    PACKP(P0, P1); SBAR(); \
    C1 = MFQK(kf1); SBAR(); \
    if (GK) { DMA_K((t) + 3, sl_cur); } if (GV) { DMA_V((t) + 1, sl_next); } \
    osum = MFPV(ones8, osum); SBAR(); \
    CMASK(C0, C1, t); SBAR(); \
    o[0] = MFPV(vf0, o[0]); EX8(C0, 0); SBAR(); \
    if (GL) { FLOAD(kf0, LK, 0, sl_next); SBAR(); } \
    EX8(C0, 8); SBAR(); \
    o[1] = MFPV(vf1, o[1]); EX8(C1, 0); SBAR(); \
    if (GL) { FLOAD(kf1, LK, 1, sl_next); SBAR(); } \
    EX8(C1, 8); SBAR(); \
    } while (0)
  int t = 1;
  for (; t + 5 < NT; t += 2) {
    STEP(pB0, pB1, pA0, pA1, t, true, true, true);     WAIT_BAR(2); ROT();
    STEP(pA0, pA1, pB0, pB1, t + 1, true, true, true);   WAIT_BAR(2); ROT();
  }
  #define ENDW(tt) do { if ((tt) + 3 < NT) { WAIT_BAR(2); } else if ((tt) + 2 < NT) { WAIT_BAR(1); } else { WAIT_BAR(0); } } while (0)
  for (; t + 1 < NT; t += 2) {
    STEP(pB0, pB1, pA0, pA1, t, (t + 3 < NT), (t + 1 < NT), (t + 1 < NT));       ENDW(t);   ROT();
    STEP(pA0, pA1, pB0, pB1, t + 1, (t + 4 < NT), (t + 2 < NT), (t + 2 < NT));     ENDW(t + 1); ROT();
  }
  STEP(pB0, pB1, pA0, pA1, NT - 1, false, false, false);
  { PACKP(pB0, pB1); SBAR(); FLOAD(vf0, LV, 0, sl_cur); FLOAD(vf1, LV, 1, sl_cur); osum = MFPV(ones8, osum); o[0] = MFPV(vf0, o[0]); o[1] = MFPV(vf1, o[1]); }
  #undef PIN
  #undef EX
  #undef EX8
  #undef PACKP
  #undef STEP
  #undef ENDW
  #undef MFQK
  #undef MFPV
  #undef FLOAD
  #undef PK8
  const float sterm = __builtin_amdgcn_exp2f(sink2 - cref);
  float rli[16];
  #pragma unroll
  for (int r = 0; r < 16; ++r) rli[r] = __builtin_amdgcn_rcpf(osum[r] + sterm);
  bf16* Ow = O + (qrow + wid * QBLK) * QP + qcol;
  { bf16* stg = (bf16*)(shm + LOST) + wid * 2048;
    #pragma unroll
    for (int r = 0; r < 16; ++r) { const int orow = crow(r, hi);
      #pragma unroll
      for (int d0 = 0; d0 < 2; ++d0) stg[orow * 64 + d0 * 32 + r32] = __float2bfloat16(o[d0][r] * rli[r]); }
    asm volatile("s_waitcnt lgkmcnt(0)" ::: "memory");
    #pragma unroll
    for (int i = 0; i < 4; ++i) { const int row = i * 8 + (lane >> 3), ch = lane & 7; const u32x4 v = *(const u32x4*)(stg + row * 64 + ch * 8); ATTN_STORE16(Ow + (long)row * QP + ch * 8, v); } }
  asm volatile("s_waitcnt lgkmcnt(0)\n\ts_barrier" ::: "memory");
  #undef DMA_K
  #undef DMA_V
  #undef ROWOFF
  #undef CMASK
  #undef ROT
}
template <int MODE> __device__ __forceinline__ void attn_unit_f8c(long qrow, long kvrow, int q0, int qcol, int kst, int vst, int NT, float sink2, float cref, const unsigned char* Qf8, const unsigned char* KVT, bf16* O, char* shm) {
  int tid_ = threadIdx.x; asm volatile("" : "+v"(tid_));
  const int tid = tid_, lane = tid & 63, r32 = lane & 31, hi = lane >> 5; const int wid = __builtin_amdgcn_readfirstlane(tid >> 6);
  constexpr int SL = 4096, LK = 0, LV = 3 * SL, LOST = LV + 3 * SL, TILEB = 32768;
  const unsigned lds0 = (unsigned)(uintptr_t)shm;
  const unsigned char* tile0 = KVT + (size_t)(kvrow >> 6) * TILEB + wid * 512 + (lane & 31) * 16;
  const unsigned char* ksrc = tile0 + kst * SL; const unsigned char* vsrc = tile0 + 4 * SL + vst * SL;
  const unsigned kdst = lds0 + LK + wid * 512, vdst = lds0 + LV + wid * 512;
  #define ROWOFF(t) ((long)(MODE == 1 ? ((t) + ((t) >= 4 ? ((q0 - 128) >> 6) : 0)) : (t)) * TILEB)
  #define DMA_K(t, slot) do { if (lane < 32) glds16(ksrc + ROWOFF(t), (unsigned)__builtin_amdgcn_readfirstlane(kdst + (slot))); } while (0)
  #define DMA_V(t, slot) do { if (lane < 32) glds16(vsrc + ROWOFF(t), (unsigned)__builtin_amdgcn_readfirstlane(vdst + (slot))); } while (0)
  const lds_cptr shm3 = (lds_cptr)shm;
  const int ksw = (r32 >> 2) & 3;
  const lds_cptr fq0 = shm3 + r32 * 64 + (((2 * hi) ^ ksw) * 16), fq1 = shm3 + r32 * 64 + (((2 * hi + 1) ^ ksw) * 16);
  DMA_K(0, 0); DMA_V(0, 0); DMA_K(1, SL);
  v8i_t qf;
  { const v4i_t* qp = (const v4i_t*)(Qf8 + (size_t)(qrow + wid * QBLK + r32) * 1024 + qcol + hi * 32); const v4i_t a = qp[0], b = qp[1]; qf = (v8i_t){a[0], a[1], a[2], a[3], b[0], b[1], b[2], b[3]}; }
  f32x16 o[2]; o[0] = f32x16{}; o[1] = f32x16{}; f32x16 osum = f32x16{};
  f32x16 cinit;
  #pragma unroll
  for (int r = 0; r < 16; ++r) cinit[r] = 60.5f - 4.0f * cref;
  asm volatile("" : "+v"(cinit));
  v8i_t ones8;
  #pragma unroll
  for (int i = 0; i < 8; ++i) ones8[i] = 0x38383838;
  asm volatile("" : "+v"(ones8));
  const int qrel = wid * QBLK + r32;
  int mlo = -128, mhi = 128;
  if (MODE == 1) { const int qi = q0 + qrel; mlo = (-qi > -128) ? -qi : -128; mhi = (SEQ - 1 - qi < 128) ? (SEQ - 1 - qi) : 128; }
  const unsigned mspan = (unsigned)(mhi - mlo);
  #define CMASK(P0, P1, t) do { if (MODE == 1) { if ((t) >= 4) bandmask(P0, P1, (t), mlo, mspan, qrel, hi); } } while (0)
  #define MFQK(kfr) __builtin_amdgcn_mfma_scale_f32_32x32x64_f8f6f4(kfr, qf, cinit, 0, 0, 0, 0x7F7F7F7F, 0, 0x7F7F7F7F)
  #define MFPV(pfr, bfr, cin) __builtin_amdgcn_mfma_scale_f32_32x32x64_f8f6f4(pfr, bfr, cin, 1, 0, 0, 0x7F7F7F7F, 0, 0x7F7F7F7F)
  #define FLOAD(dst, base, b, slot) do { const v4i_t a_ = *(const LAS v4i_t*)(fq0 + (base) + (slot) + (b) * 2048), b_ = *(const LAS v4i_t*)(fq1 + (base) + (slot) + (b) * 2048); dst = (v8i_t){a_[0], a_[1], a_[2], a_[3], b_[0], b_[1], b_[2], b_[3]}; } while (0)
  #define PK4(x0, x1, x2, x3) (int)__builtin_amdgcn_cvt_pk_u8_f32(x3, 3, __builtin_amdgcn_cvt_pk_u8_f32(x2, 2, __builtin_amdgcn_cvt_pk_u8_f32(x1, 1, __builtin_amdgcn_cvt_pk_u8_f32(x0, 0, 0u))))
  #define PACKP(PF, X0, X1) do { PF[0] = PK4(X0[0], X0[1], X0[2], X0[3]); PF[1] = PK4(X0[4], X0[5], X0[6], X0[7]); PF[2] = PK4(X0[8], X0[9], X0[10], X0[11]); PF[3] = PK4(X0[12], X0[13], X0[14], X0[15]); \
                                 PF[4] = PK4(X1[0], X1[1], X1[2], X1[3]); PF[5] = PK4(X1[4], X1[5], X1[6], X1[7]); PF[6] = PK4(X1[8], X1[9], X1[10], X1[11]); PF[7] = PK4(X1[12], X1[13], X1[14], X1[15]); asm volatile("" : "+v"(PF)); } while (0)
  int sl_prev = 0, sl_cur = 0, sl_next = SL;
  #define ROT() do { sl_prev = sl_cur; sl_cur = sl_next; sl_next = (sl_next == 2 * SL) ? 0 : sl_next + SL; } while (0)
  DMA_K(2, 2 * SL);
  WAIT_BAR(3);
  v8i_t kf0, kf1, vf0, vf1, pfA, pfB;
  f32x16 x0, x1;
  FLOAD(kf0, LK, 0, 0); FLOAD(kf1, LK, 1, 0);
  x0 = MFQK(kf0); x1 = MFQK(kf1);
  CMASK(x0, x1, 0);
  PACKP(pfA, x0, x1);
  WAIT_BAR(0);
  DMA_K(3, 0); DMA_V(1, SL);
  ROT();
  FLOAD(kf0, LK, 0, sl_cur); FLOAD(kf1, LK, 1, sl_cur);
  WAIT_BAR(2);
  #define STEP(PFP, PFN, t, GK, GV, GL) do { SBAR(); \
    FLOAD(vf0, LV, 0, sl_prev); FLOAD(vf1, LV, 1, sl_prev); SBAR(); \
    x0 = MFQK(kf0); x1 = MFQK(kf1); SBAR(); \
    osum = MFPV(PFP, ones8, osum); o[0] = MFPV(PFP, vf0, o[0]); o[1] = MFPV(PFP, vf1, o[1]); SBAR(); \
    if (GK) { DMA_K((t) + 3, sl_cur); } if (GV) { DMA_V((t) + 1, sl_next); } \
    if (GL) { FLOAD(kf0, LK, 0, sl_next); FLOAD(kf1, LK, 1, sl_next); SBAR(); } \
    CMASK(x0, x1, t); \
    PACKP(PFN, x0, x1); SBAR(); \
    } while (0)
  int t = 1;
  for (; t + 5 < NT; t += 2) {
    STEP(pfA, pfB, t, true, true, true);     WAIT_BAR(2); ROT();
    STEP(pfB, pfA, t + 1, true, true, true);   WAIT_BAR(2); ROT();
  }
  #define ENDW(tt) do { if ((tt) + 3 < NT) { WAIT_BAR(2); } else if ((tt) + 2 < NT) { WAIT_BAR(1); } else { WAIT_BAR(0); } } while (0)
  for (; t + 1 < NT; t += 2) {
    STEP(pfA, pfB, t, (t + 3 < NT), (t + 1 < NT), (t + 1 < NT));       ENDW(t);   ROT();
    STEP(pfB, pfA, t + 1, (t + 4 < NT), (t + 2 < NT), (t + 2 < NT));     ENDW(t + 1); ROT();
  }
  STEP(pfA, pfB, NT - 1, false, false, false);
  { FLOAD(vf0, LV, 0, sl_cur); FLOAD(vf1, LV, 1, sl_cur); osum = MFPV(pfB, ones8, osum); o[0] = MFPV(pfB, vf0, o[0]); o[1] = MFPV(pfB, vf1, o[1]); }
  #undef PACKP
  #undef PK4
  #undef STEP
  #undef ENDW
  #undef MFQK
  #undef MFPV
  #undef FLOAD
  const float sterm = __builtin_amdgcn_exp2f(sink2 - cref);
  float rli[16];
  #pragma unroll
  for (int r = 0; r < 16; ++r) rli[r] = __builtin_amdgcn_rcpf(osum[r] + sterm);
  bf16* Ow = O + (qrow + wid * QBLK) * QP + qcol;
  { bf16* stg = (bf16*)(shm + LOST) + wid * 2048;
    #pragma unroll
    for (int r = 0; r < 16; ++r) { const int orow = crow(r, hi);
      #pragma unroll
      for (int d0 = 0; d0 < 2; ++d0) stg[orow * 64 + d0 * 32 + r32] = __float2bfloat16(o[d0][r] * rli[r]); }
    asm volatile("s_waitcnt lgkmcnt(0)" ::: "memory");
    #pragma unroll
    for (int i = 0; i < 4; ++i) { const int row = i * 8 + (lane >> 3), ch = lane & 7; const u32x4 v = *(const u32x4*)(stg + row * 64 + ch * 8); ATTN_STORE16(Ow + (long)row * QP + ch * 8, v); } }
  asm volatile("s_waitcnt lgkmcnt(0)\n\ts_barrier" ::: "memory");
  #undef DMA_K
  #undef DMA_V
  #undef ROWOFF
  #undef CMASK
  #undef ROT
}
template <int MODE, int XV = 0> __device__ __forceinline__ void attn_unit_f8d(long qrow, long kvrow, int q0, int qcol, int kst, int vst, int NT, float sink2, float cref, const unsigned char* Qf8, const unsigned char* KVT, bf16* O, char* shm) {
  int tid_ = threadIdx.x; asm volatile("" : "+v"(tid_));
  const int tid = tid_, lane = tid & 63, r32 = lane & 31, hi = lane >> 5; const int wid = __builtin_amdgcn_readfirstlane(tid >> 6);
  constexpr int SL = 4096, NS = 5, LK = 0, LV = NS * SL, LOST = LV + NS * SL, TILEB = 32768;
  const unsigned lds0 = (unsigned)(uintptr_t)shm;
  const unsigned char* tile0 = KVT + (size_t)(kvrow >> 6) * TILEB + wid * 512 + (lane & 31) * 16;
  const unsigned char* ksrc = tile0 + kst * SL; const unsigned char* vsrc = tile0 + 4 * SL + vst * SL;
  const unsigned kdst = lds0 + LK + wid * 512, vdst = lds0 + LV + wid * 512;
  #define ROWOFF(t) ((long)(MODE == 1 ? ((t) + ((t) >= 4 ? ((q0 - 128) >> 6) : 0)) : (t)) * TILEB)
  #define DMA_K(t, slot) glds16h(ksrc + ROWOFF(t), (unsigned)__builtin_amdgcn_readfirstlane(kdst + (slot)))
  #define DMA_V(t, slot) glds16h(vsrc + ROWOFF(t), (unsigned)__builtin_amdgcn_readfirstlane(vdst + (slot)))
  const lds_cptr shm3 = (lds_cptr)shm;
  const int ksw = (r32 >> 2) & 3;
  const lds_cptr fq0 = shm3 + r32 * 64 + (((2 * hi) ^ ksw) * 16), fq1 = shm3 + r32 * 64 + (((2 * hi + 1) ^ ksw) * 16);
  DMA_K(0, 0); DMA_K(1, SL); DMA_K(2, 2 * SL); DMA_V(0, 0); DMA_K(3, 3 * SL); DMA_V(1, SL); if (4 < NT) { DMA_K(4, 4 * SL); } DMA_V(2, 2 * SL);
  v8i_t qf;
  { const v4i_t* qp = (const v4i_t*)(Qf8 + (size_t)(qrow + wid * QBLK + r32) * 1024 + qcol + hi * 32); const v4i_t a = qp[0], b = qp[1]; qf = (v8i_t){a[0], a[1], a[2], a[3], b[0], b[1], b[2], b[3]}; }
  f32x16 o[2]; o[0] = f32x16{}; o[1] = f32x16{}; f32x16 osum = f32x16{};
  f32x16 cinit;
  #pragma unroll
  for (int r = 0; r < 16; ++r) cinit[r] = 60.5f - 4.0f * cref;
  asm volatile("" : "+v"(cinit));
  v8i_t ones8;
  #pragma unroll
  for (int i = 0; i < 8; ++i) ones8[i] = 0x38383838;
  asm volatile("" : "+v"(ones8));
  const int qrel = wid * QBLK + r32;
  int mlo = -128, mhi = 128;
  if (MODE == 1) { const int qi = q0 + qrel; mlo = (-qi > -128) ? -qi : -128; mhi = (SEQ - 1 - qi < 128) ? (SEQ - 1 - qi) : 128; }
  const unsigned mspan = (unsigned)(mhi - mlo);
  #define CMASK(P0, P1, t) do { if (MODE == 1) { if ((t) >= 4) bandmask(P0, P1, (t), mlo, mspan, qrel, hi); } } while (0)
  #define MFQK(kfr) __builtin_amdgcn_mfma_scale_f32_32x32x64_f8f6f4(kfr, qf, cinit, 0, 0, 0, 0x7F7F7F7F, 0, 0x7F7F7F7F)
  #define MFPV(pfr, bfr, cin) __builtin_amdgcn_mfma_scale_f32_32x32x64_f8f6f4(pfr, bfr, cin, 1, 0, 0, 0x7F7F7F7F, 0, 0x7F7F7F7F)
  #define FLOAD(dst, base, b, slot) do { const v4i_t a_ = *(const LAS v4i_t*)(fq0 + (base) + (slot) + (b) * 2048), b_ = *(const LAS v4i_t*)(fq1 + (base) + (slot) + (b) * 2048); dst = (v8i_t){a_[0], a_[1], a_[2], a_[3], b_[0], b_[1], b_[2], b_[3]}; } while (0)
  #define PK4(x0, x1, x2, x3) (int)__builtin_amdgcn_cvt_pk_u8_f32(x3, 3, __builtin_amdgcn_cvt_pk_u8_f32(x2, 2, __builtin_amdgcn_cvt_pk_u8_f32(x1, 1, __builtin_amdgcn_cvt_pk_u8_f32(x0, 0, 0u))))
  #define PACKP(PF, X0, X1) do { PF[0] = PK4(X0[0], X0[1], X0[2], X0[3]); PF[1] = PK4(X0[4], X0[5], X0[6], X0[7]); PF[2] = PK4(X0[8], X0[9], X0[10], X0[11]); PF[3] = PK4(X0[12], X0[13], X0[14], X0[15]); \
                                 PF[4] = PK4(X1[0], X1[1], X1[2], X1[3]); PF[5] = PK4(X1[4], X1[5], X1[6], X1[7]); PF[6] = PK4(X1[8], X1[9], X1[10], X1[11]); PF[7] = PK4(X1[12], X1[13], X1[14], X1[15]); asm volatile("" : "+v"(PF)); } while (0)
  int sl_prev = 0, sl_cur = 0, sl_next = SL;
  #define SLADD(s, k) (((s) + (k) * SL >= NS * SL) ? (s) + (k) * SL - NS * SL : (s) + (k) * SL)
  #define ROT() do { sl_prev = sl_cur; sl_cur = sl_next; sl_next = SLADD(sl_next, 1); } while (0)
  if (NT >= 5) { WAIT_BAR(7); } else { WAIT_BAR(0); }
  v8i_t kf0, kf1, vf0, vf1, pfA, pfB;
  f32x16 x0, x1;
  FLOAD(kf0, LK, 0, 0); FLOAD(kf1, LK, 1, 0);
  x0 = MFQK(kf0); x1 = MFQK(kf1);
  CMASK(x0, x1, 0);
  PACKP(pfA, x0, x1);
  if (NT >= 5) { WAIT_BAR(4); } else { WAIT_BAR(0); }
  if (5 < NT) { DMA_K(5, 0); } if (3 < NT) { DMA_V(3, 3 * SL); }
  ROT();
  FLOAD(kf0, LK, 0, sl_cur); FLOAD(kf1, LK, 1, sl_cur);
  asm volatile("s_waitcnt lgkmcnt(0)\n\ts_barrier" ::: "memory");
  #define PKQ(PF, i, X, B) do { if (XV == 1) PF[i] = (int)__builtin_amdgcn_cvt_pk_u8_f32(X[B], 0, 0u); else PF[i] = PK4(X[B], X[(B) + 1], X[(B) + 2], X[(B) + 3]); } while (0)
  #define STEP(PFP, PFN, t, GK, GV, GL) do { SBAR(); \
    x0 = MFQK(kf0); SBAR(); \
    if (XV != 2) { FLOAD(vf0, LV, 0, sl_prev); } SBAR(); \
    x1 = MFQK(kf1); SBAR(); \
    if (XV != 2) { FLOAD(vf1, LV, 1, sl_prev); } SBAR(); \
    osum = MFPV(PFP, ones8, osum); asm volatile("" : "+v"(osum)); SBAR(); \
    if ((GL) && XV != 2) { FLOAD(kf0, LK, 0, sl_next); SBAR(); } \
    CMASK(x0, x1, t); \
    PKQ(PFN, 0, x0, 0); PKQ(PFN, 1, x0, 4); PKQ(PFN, 2, x0, 8); PKQ(PFN, 3, x0, 12); asm volatile("" : "+v"(PFN)); SBAR(); \
    o[0] = MFPV(PFP, vf0, o[0]); asm volatile("" : "+v"(o[0])); SBAR(); \
    if ((GL) && XV != 2) { FLOAD(kf1, LK, 1, sl_next); SBAR(); } \
    PKQ(PFN, 4, x1, 0); PKQ(PFN, 5, x1, 4); asm volatile("" : "+v"(PFN)); SBAR(); \
    o[1] = MFPV(PFP, vf1, o[1]); asm volatile("" : "+v"(o[1])); SBAR(); \
    PKQ(PFN, 6, x1, 8); PKQ(PFN, 7, x1, 12); asm volatile("" : "+v"(PFN)); SBAR(); \
    if (XV != 3) { if (GK) { DMA_K((t) + 5, sl_cur); } if (GV) { DMA_V((t) + 3, SLADD(sl_cur, 3)); } } \
    } while (0)
  int t = 1;
  for (; t + 6 < NT; t += 2) {
    STEP(pfA, pfB, t, true, true, true);     if (XV == 4) { asm volatile("s_waitcnt vmcnt(6) lgkmcnt(0)" ::: "memory"); } else { WAIT_BAR(6); } ROT();
    STEP(pfB, pfA, t + 1, true, true, true);   if (XV == 4) { asm volatile("s_waitcnt vmcnt(6) lgkmcnt(0)" ::: "memory"); } else { WAIT_BAR(6); } ROT();
  }
  for (; t + 1 < NT; t += 2) {
    STEP(pfA, pfB, t, (t + 5 < NT), (t + 3 < NT), (t + 1 < NT));       WAIT_BAR(0); ROT();
    STEP(pfB, pfA, t + 1, (t + 6 < NT), (t + 4 < NT), (t + 2 < NT));     WAIT_BAR(0); ROT();
  }
  STEP(pfA, pfB, NT - 1, false, false, false);
  { FLOAD(vf0, LV, 0, sl_cur); FLOAD(vf1, LV, 1, sl_cur); osum = MFPV(pfB, ones8, osum); o[0] = MFPV(pfB, vf0, o[0]); o[1] = MFPV(pfB, vf1, o[1]); }
  #undef PACKP
  #undef PKQ
  #undef PK4
  #undef STEP
  #undef MFQK
  #undef MFPV
  #undef FLOAD
  const float sterm = __builtin_amdgcn_exp2f(sink2 - cref);
  float rli[16];
  #pragma unroll
  for (int r = 0; r < 16; ++r) rli[r] = __builtin_amdgcn_rcpf(osum[r] + sterm);
#if OPROJ_F8
  { unsigned char* Ow8 = (unsigned char*)O + (size_t)(qrow + wid * QBLK) * 1024 + qcol;
    LAS unsigned char* stg = (LAS unsigned char*)(shm3 + LOST) + wid * 2048;
    #pragma unroll
    for (int r = 0; r < 16; ++r) { const int orow = crow(r, hi); const float sc_ = rli[r] * 64.0f;
      const int w = __builtin_amdgcn_cvt_pk_fp8_f32(o[0][r] * sc_, o[1][r] * sc_, 0, false);
      stg[orow * 64 + r32] = (unsigned char)w; stg[orow * 64 + 32 + r32] = (unsigned char)(w >> 8); }
    asm volatile("s_waitcnt lgkmcnt(0)" ::: "memory");
    #pragma unroll
    for (int i = 0; i < 2; ++i) { const int row = i * 16 + (lane >> 2), ch = lane & 3; const u32x4 v = *(const LAS u32x4*)(stg + row * 64 + ch * 16); *(u32x4*)(Ow8 + (size_t)row * 1024 + ch * 16) = v; } }
#else
  bf16* Ow = O + (qrow + wid * QBLK) * QP + qcol;
  { bf16* stg = (bf16*)(shm + LOST) + wid * 2048;
    #pragma unroll
    for (int r = 0; r < 16; ++r) { const int orow = crow(r, hi);
      #pragma unroll
      for (int d0 = 0; d0 < 2; ++d0) stg[orow * 64 + d0 * 32 + r32] = __float2bfloat16(o[d0][r] * rli[r]); }
    asm volatile("s_waitcnt lgkmcnt(0)" ::: "memory");
    #pragma unroll
    for (int i = 0; i < 4; ++i) { const int row = i * 8 + (lane >> 3), ch = lane & 7; const u32x4 v = *(const u32x4*)(stg + row * 64 + ch * 8); ATTN_STORE16(Ow + (long)row * QP + ch * 8, v); } }
#endif
  asm volatile("s_waitcnt lgkmcnt(0)\n\ts_barrier" ::: "memory");
  #undef DMA_K
  #undef DMA_V
  #undef ROWOFF
  #undef CMASK
  #undef ROT
  #undef SLADD
}
constexpr int ATTN_LDS_BYTES = LDS_BYTES;
#undef SBAR
#undef WAIT_BAR
}

struct Args { const float* in[20]; float* out; unsigned char* ws; int ph_lo, ph_hi; };
typedef const Args __attribute__((address_space(4)))* kargp_t;
__device__ __forceinline__ kargp_t kargs() { auto p = __builtin_amdgcn_kernarg_segment_ptr(); asm volatile("" : "+s"(p)); return (kargp_t)p; }
enum { I_X = 0, I_C, I_CTX, I_CCTX, I_ADAW, I_ADAB, I_GATTN, I_GFFN, I_WIN, I_QNG, I_KNG, I_QNL, I_KNL, I_SINK, I_WOUT, I_RW, I_RB, I_WGATE, I_WUP, I_WDOWN };
struct Frame {
    LAS unsigned char* lds; volatile LAS unsigned* MISC;
    int tid, lane, wave, vcu, G;
};
#define WSP(T, off) ((T*)(kargs()->ws + (off)))
__device__ const float ROPE_INV[16] = {1.000000000e+00f, 5.623413324e-01f, 3.162277639e-01f, 1.778279394e-01f, 1.000000015e-01f, 5.623413250e-02f, 3.162277490e-02f, 1.778279431e-02f,
                                       9.999999776e-03f, 5.623413250e-03f, 3.162277630e-03f, 1.778279431e-03f, 1.000000047e-03f, 5.623413017e-04f, 3.162277571e-04f, 1.778279402e-04f};

template <int KIND> __device__ __forceinline__ int dst_row(int n) {
    if (KIND == 0) return n;
    if (KIND == 2) return ((n >> 7) << 8) + (n & 127);
    if (KIND == 3) return ((n >> 7) << 8) + 128 + (n & 127);
    int tile, wc;
    if (n < 512) { const int h = n >> 6; tile = h >> 2; wc = h & 3; }
    else if (n < 640) { tile = 4; wc = (n - 512) >> 6; }
    else if (n < 768) { tile = 4; wc = 2 + ((n - 640) >> 6); }
    else if (n < 1280) { const int h = (n - 768) >> 6; tile = 2 + (h >> 2); wc = h & 3; }
    else if (n < 1408) { tile = 5; wc = (n - 1280) >> 6; }
    else { tile = 5; wc = 2 + ((n - 1408) >> 6); }
    const int d = n & 63, bj = d >> 5, dd = d & 31, np = dd >> 4, f = dd & 15, fq = f >> 2, j = f & 3;
    return 256 * tile + 128 * bj + 32 * wc + 8 * fq + 4 * np + j;
}
template <int KIND> __device__ __forceinline__ void p0_transpose_item(const float* W, int N, bf16_t* WT, int Kd, LAS float* scr, int kb, int nb, int lane) {
    const int k0 = 64 * kb, n0 = 32 * nb;
#pragma unroll 8
    for (int i = 0; i < 32; ++i) { const int kk = 2 * i + (lane >> 5); scr[kk * 33 + (lane & 31)] = W[(size_t)(k0 + kk) * N + n0 + (lane & 31)]; }
    LDS_WAIT(); asm volatile("" ::: "memory");
    const int c = lane & 7;
#pragma unroll
    for (int j = 0; j < 4; ++j) { const int n = (lane >> 3) + 8 * j; const LAS float* s = scr + (8 * c) * 33 + n;
        u32x4 o; o.x = pk2(s[0 * 33], s[1 * 33]); o.y = pk2(s[2 * 33], s[3 * 33]); o.z = pk2(s[4 * 33], s[5 * 33]); o.w = pk2(s[6 * 33], s[7 * 33]);
        *(GAS u32x4*)(WT + (size_t)dst_row<KIND>(n0 + n) * Kd + k0 + 8 * c) = o; }
    LDS_WAIT(); asm volatile("" ::: "memory");
}
template <int KIND> __device__ __forceinline__ void p0_transpose_item8(const float* W, int N, unsigned char* WT, int Kd, float wscale, LAS float* scr, int kb, int nb, int lane) {
    const int k0 = 64 * kb, n0 = 32 * nb;
#pragma unroll 8
    for (int i = 0; i < 32; ++i) { const int kk = 2 * i + (lane >> 5); scr[kk * 33 + (lane & 31)] = W[(size_t)(k0 + kk) * N + n0 + (lane & 31)]; }
    LDS_WAIT(); asm volatile("" ::: "memory");
    const int c = lane & 7;
#pragma unroll
    for (int j = 0; j < 4; ++j) { const int n = (lane >> 3) + 8 * j; const LAS float* s = scr + (8 * c) * 33 + n;
        int w0 = __builtin_amdgcn_cvt_pk_fp8_f32(s[0 * 33] * wscale, s[1 * 33] * wscale, 0, false); w0 = __builtin_amdgcn_cvt_pk_fp8_f32(s[2 * 33] * wscale, s[3 * 33] * wscale, w0, true);
        int w1 = __builtin_amdgcn_cvt_pk_fp8_f32(s[4 * 33] * wscale, s[5 * 33] * wscale, 0, false); w1 = __builtin_amdgcn_cvt_pk_fp8_f32(s[6 * 33] * wscale, s[7 * 33] * wscale, w1, true);
        *(GAS u32x2*)(WT + (size_t)dst_row<KIND>(n0 + n) * Kd + k0 + 8 * c) = (u32x2){(unsigned)w0, (unsigned)w1}; }
    LDS_WAIT(); asm volatile("" ::: "memory");
}
__device__ __forceinline__ void sincos_d(float ang, float& cs, float& sn) {
    const double x = (double)ang; const double kq = __builtin_rint(x * 0.63661977236758134308);
    const double r = (x - kq * 1.5707963267948966192) - kq * 6.123233995736766036e-17, r2 = r * r;
    const double s = r * (1.0 + r2 * (-1.0 / 6 + r2 * (1.0 / 120 + r2 * (-1.0 / 5040 + r2 * (1.0 / 362880 + r2 * (-1.0 / 39916800 + r2 * (1.0 / 6227020800.0)))))));
    const double c = 1.0 + r2 * (-0.5 + r2 * (1.0 / 24 + r2 * (-1.0 / 720 + r2 * (1.0 / 40320 + r2 * (-1.0 / 3628800 + r2 * (1.0 / 479001600.0 + r2 * (-1.0 / 87178291200.0)))))));
    const int q = ((int)kq) & 3;
    const double cc = (q == 0) ? c : (q == 1) ? -s : (q == 2) ? -c : s;
    const double ss = (q == 0) ? s : (q == 1) ? c : (q == 2) ? -s : -c;
    cs = (float)cc; sn = (float)ss;
}
__device__ __forceinline__ void p0_prologue(Frame& F) {
    const int gw = F.vcu * NWAVES + F.wave, NGW = F.G * NWAVES;
    {
        const float* c = kargs()->in[I_C]; const float* cctx = kargs()->in[I_CCTX]; const float* ada_w = kargs()->in[I_ADAW]; const float* ada_b = kargs()->in[I_ADAB];
        float* modv = WSP(float, WS_MODV);
        LAS float* sv = (LAS float*)(F.lds);
        LAS float* part = (LAS float*)(F.lds + 16384);
        for (int i = F.tid; i < 3072; i += NWAVES * 64) { const int v = i >> 10, k = i & 1023; const float cv = v < 2 ? c[v * 1024 + k] : cctx[k]; sv[i] = cv / (1.0f + expf(-cv)); }
        __syncthreads();
        for (int tile = F.vcu; tile < NLAYER * 96; tile += F.G) {
            const int l = tile / 96, c0 = (tile % 96) * 64;
            const float* W = ada_w + (size_t)l * 1024 * 6144 + c0 + F.lane;
            float a0 = 0.f, a1 = 0.f, a2 = 0.f; const int kb = F.wave * 128;
#pragma unroll 8
            for (int k = 0; k < 128; ++k) { const float w = W[(size_t)(kb + k) * 6144]; a0 += sv[kb + k] * w; a1 += sv[1024 + kb + k] * w; a2 += sv[2048 + kb + k] * w; }
            part[(F.wave * 3 + 0) * 64 + F.lane] = a0; part[(F.wave * 3 + 1) * 64 + F.lane] = a1; part[(F.wave * 3 + 2) * 64 + F.lane] = a2;
            __syncthreads();
            if (F.tid < 192) { const int v = F.tid >> 6, col = F.tid & 63; float s = ada_b[l * 6144 + c0 + col];
#pragma unroll
                for (int w = 0; w < 8; ++w) s += part[(w * 3 + v) * 64 + col];
                modv[(size_t)(l * 3 + v) * 6144 + c0 + col] = s; }
            __syncthreads();
        }
    }
    { float* rope = WSP(float, WS_ROPE); const int gt = F.vcu * NWAVES * 64 + F.tid; if (gt < 4096) { const int pos = gt >> 4, f = gt & 15; const float ang = (float)pos * ROPE_INV[f]; float cs, sn; sincos_d(ang, cs, sn); rope[gt * 2] = cs; rope[gt * 2 + 1] = sn; } }
    { const int gt = F.vcu * NWAVES * 64 + F.tid; if (gt < NLAYER * 256) { const int l = gt >> 8, kq = (gt >> 6) & 3, d = gt & 63; const float* src = kargs()->in[kq == 0 ? I_QNG : (kq == 1 ? I_QNL : (kq == 2 ? I_KNG : I_KNL))]; WSP(float, WS_GN)[gt] = src[l * 64 + d]; } }
    if (gw < NLAYER * 2) { const int l = gw >> 1, loc = gw & 1; float mq = fabsf(kargs()->in[loc ? I_QNL : I_QNG][l * 64 + F.lane]), mk = fabsf(kargs()->in[loc ? I_KNL : I_KNG][l * 64 + F.lane]);
#pragma unroll
        for (int o = 1; o < 64; o <<= 1) { mq = fmaxf(mq, __shfl_xor(mq, o)); mk = fmaxf(mk, __shfl_xor(mk, o)); }
        if (F.lane == 0) WSP(float, WS_BND)[gw] = 64.0f * C2 * mq * mk * 1.02f + 0.05f; }
    { u32x4* p = (u32x4*)(WSP(unsigned char, WS_KV) + (size_t)(NROW / 64) * KV_TILEB); for (int i = F.vcu * NWAVES * 64 + F.tid; i < 4 * KV_TILEB / 16; i += F.G * NWAVES * 64) p[i] = (u32x4){0u, 0u, 0u, 0u}; }
    {
        const float* x = kargs()->in[I_X]; const float* ctx = kargs()->in[I_CTX]; bf16_t* XS = WSP(bf16_t, WS_XS);
        for (int R = gw; R < NROW; R += NGW) {
            const int b = R >= RB ? 1 : 0, rr = R - b * RB;
            const float* src = rr < NCTX ? ctx + (size_t)(b * NCTX + rr) * 1024 : x + (size_t)(b * SEQ + rr - NCTX) * 1024;
            const f32x4* s4 = (const f32x4*)src + F.lane; u32x2* d2 = (u32x2*)(XS + (size_t)R * 1024) + F.lane;
            f32x4 v[4];
#pragma unroll
            for (int j = 0; j < 4; ++j) v[j] = s4[64 * j];
#pragma unroll
            for (int j = 0; j < 4; ++j) { u32x2 w; w.x = pk2(v[j][0], v[j][1]); w.y = pk2(v[j][2], v[j][3]); d2[64 * j] = w; }
        }
    }
    {
        LAS float* scr = (LAS float*)(F.lds + RING_OFF + F.wave * 16384);
        constexpr int I_IN = 4 * 768, I_OUT = 4 * 512, I_G = 64 * 256, I_U = 64 * 256, I_D = 64 * 256;
        for (int it0 = gw; it0 < I_IN + I_OUT + I_G + I_U + I_D; it0 += NGW) {
            int it = it0;
            if (it < I_IN) { const int l = it / 768, r = it % 768;
#if INPROJ_F8
                p0_transpose_item8<1>(kargs()->in[I_WIN] + (size_t)l * 1024 * 1536, 1536, WSP(unsigned char, WS_WIN) + (size_t)l * 1536 * 1024, 1024, 32.0f, scr, r / 48, r % 48, F.lane);
#else
                p0_transpose_item<1>(kargs()->in[I_WIN] + (size_t)l * 1024 * 1536, 1536, WSP(bf16_t, WS_WIN) + (size_t)l * 1536 * 1024, 1024, scr, r / 48, r % 48, F.lane);
#endif
                continue; } it -= I_IN;
            if (it < I_OUT) { const int l = it / 512, r = it % 512;
#if OPROJ_F8
                p0_transpose_item8<0>(kargs()->in[I_WOUT] + (size_t)l * 1024 * 1024, 1024, WSP(unsigned char, WS_WOUT) + (size_t)l * 1024 * 1024, 1024, 32.0f, scr, r / 32, r % 32, F.lane);
#else
                p0_transpose_item<0>(kargs()->in[I_WOUT] + (size_t)l * 1024 * 1024, 1024, WSP(bf16_t, WS_WOUT) + (size_t)l * 1024 * 1024, 1024, scr, r / 32, r % 32, F.lane);
#endif
                continue; } it -= I_OUT;
            if (it < I_G) { const int m = it / 256, r = it % 256; p0_transpose_item<2>(kargs()->in[I_WGATE] + (size_t)m * 1024 * 512, 512, WSP(bf16_t, WS_WGU) + (size_t)m * 1024 * 1024, 1024, scr, r / 16, r % 16, F.lane); continue; } it -= I_G;
            if (it < I_U) { const int m = it / 256, r = it % 256; p0_transpose_item<3>(kargs()->in[I_WUP] + (size_t)m * 1024 * 512, 512, WSP(bf16_t, WS_WGU) + (size_t)m * 1024 * 1024, 1024, scr, r / 16, r % 16, F.lane); continue; } it -= I_U;
            { const int m = it / 256, r = it % 256; p0_transpose_item<0>(kargs()->in[I_WDOWN] + (size_t)m * 512 * 1024, 1024, WSP(bf16_t, WS_WD) + (size_t)m * 1024 * 512, 512, scr, r / 32, r % 32, F.lane); }
        }
    }
}

__device__ __forceinline__ void load_row(const bf16_t* xrow, int lane, f32x4 (&h)[4]) {
    const u32x2* xr = (const u32x2*)xrow + lane;
#pragma unroll
    for (int j = 0; j < 4; ++j) { const u32x2 w = xr[64 * j]; h[j] = (f32x4){__builtin_bit_cast(float, w.x << 16), __builtin_bit_cast(float, w.x & 0xffff0000u), __builtin_bit_cast(float, w.y << 16), __builtin_bit_cast(float, w.y & 0xffff0000u)}; }
}
__device__ __forceinline__ void rms_mod(const float* g, const float* sh, const float* sc, int lane, f32x4 (&h)[4]) {
    float ss = 0.f;
#pragma unroll
    for (int j = 0; j < 4; ++j) ss += (h[j][0] * h[j][0] + h[j][1] * h[j][1]) + (h[j][2] * h[j][2] + h[j][3] * h[j][3]);
    const float rs = 1.0f / sqrtf(wave_sum(ss) * (1.0f / 1024.0f) + NORM_EPS);
#pragma unroll
    for (int j = 0; j < 4; ++j) { const f32x4 gg = ((const f32x4*)g)[lane + 64 * j], s1 = ((const f32x4*)sh)[lane + 64 * j], s2 = ((const f32x4*)sc)[lane + 64 * j];
        h[j] = (h[j] * rs * gg) * (1.0f + s2) + s1; }
}
__device__ __forceinline__ void store_row_bf16(bf16_t* orow, int lane, const f32x4 (&h)[4]) {
    u32x2* o8 = (u32x2*)orow + lane;
#pragma unroll
    for (int j = 0; j < 4; ++j) { u32x2 w; w.x = pk2(h[j][0], h[j][1]); w.y = pk2(h[j][2], h[j][3]); o8[64 * j] = w; }
}
__device__ __forceinline__ int row_mv(int R) { const int b = R >= RB ? 1 : 0; return (R - b * RB) < NCTX ? 2 : b; }

__device__ __forceinline__ void phase_norm1(Frame& F0, int l) {
    Frame F = F0; asm volatile("" : "+v"(F.tid), "+v"(F.lane), "+s"(F.wave), "+s"(F.vcu));
    const int gw = F.vcu * NWAVES + F.wave, NGW = F.G * NWAVES;
    const float* g = kargs()->in[I_GATTN] + l * 1024; const float* modv = WSP(float, WS_MODV); const bf16_t* XS = WSP(bf16_t, WS_XS); bf16_t* HN = WSP(bf16_t, WS_HN);
    f32x4 xn[4]; if (gw < NROW) load_row(XS + (size_t)gw * 1024, F.lane, xn);
    for (int R = gw; R < NROW; R += NGW) {
        const float* mv = modv + (size_t)(l * 3 + row_mv(R)) * 6144;
        f32x4 h[4];
#pragma unroll
        for (int j = 0; j < 4; ++j) h[j] = xn[j];
        if (R + NGW < NROW) load_row(XS + (size_t)(R + NGW) * 1024, F.lane, xn);
        rms_mod(g, mv + 0, mv + 1024, F.lane, h);
#if INPROJ_F8
        { int* o4 = (int*)(WSP(unsigned char, WS_HN8) + (size_t)R * 1024) + F.lane;
#pragma unroll
          for (int j = 0; j < 4; ++j) { int w = __builtin_amdgcn_cvt_pk_fp8_f32(h[j][0], h[j][1], 0, false); w = __builtin_amdgcn_cvt_pk_fp8_f32(h[j][2], h[j][3], w, true); o4[64 * j] = w; } }
#else
        store_row_bf16(HN + (size_t)R * 1024, F.lane, h);
#endif
    }
}
__device__ __forceinline__ void phase_norm2_router(Frame& F0, int l, bool lastl, bool dry = false) {
    Frame F = F0; asm volatile("" : "+v"(F.tid), "+v"(F.lane), "+s"(F.wave), "+s"(F.vcu));
    const int gw = F.vcu * NWAVES + F.wave, NGW = F.G * NWAVES;
    LAS f32x4* RW = (LAS f32x4*)(F.lds + RING_OFF);
    { const float* router_w = kargs()->in[I_RW];
      for (int idx = F.tid; idx < 4096; idx += NWAVES * 64) { const int j = idx >> 10, e = (idx >> 6) & 15, ln = idx & 63, c = 4 * ln + 256 * j;
        RW[idx] = (f32x4){router_w[(c + 0) * 16 + e], router_w[(c + 1) * 16 + e], router_w[(c + 2) * 16 + e], router_w[(c + 3) * 16 + e]}; } }
    __syncthreads();
    const float* g = kargs()->in[I_GFFN] + l * 1024; const float* router_b = kargs()->in[I_RB];
    LAS float* PS = (LAS float*)(F.lds + RING_OFF + 65536) + F.wave * (16 * 65);
    const float* modv = WSP(float, WS_MODV); const bf16_t* XS = WSP(bf16_t, WS_XS); bf16_t* HN = WSP(bf16_t, WS_HN);
    int my_cls = -1, my_tok = 0; float my_wlo = 0.f, my_whi = 0.f;
    int k = 0;
    f32x4 xn[4]; if (gw < NROW) load_row(XS + (size_t)gw * 1024, F.lane, xn);
    for (int R = gw; R < NROW; R += NGW, ++k) {
        const int mvi = row_mv(R);
        f32x4 h[4];
#pragma unroll
        for (int j = 0; j < 4; ++j) h[j] = xn[j];
        if (R + NGW < NROW) load_row(XS + (size_t)(R + NGW) * 1024, F.lane, xn);
        if (lastl && mvi == 2) continue;
        const float* mv = modv + (size_t)(l * 3 + mvi) * 6144;
        rms_mod(g, mv + 3072, mv + 4096, F.lane, h);
        store_row_bf16(HN + (size_t)R * 1024, F.lane, h);
        {
            float s[16];
#pragma unroll
            for (int e = 0; e < 16; ++e) s[e] = 0.f;
#pragma unroll
            for (int j = 0; j < 4; ++j)
#pragma unroll
                for (int e = 0; e < 16; ++e) { const f32x4 w4 = RW[(j * 16 + e) * 64 + F.lane]; s[e] += (h[j][0] * w4[0] + h[j][1] * w4[1]) + (h[j][2] * w4[2] + h[j][3] * w4[3]); }
#pragma unroll
            for (int e = 0; e < 16; ++e) PS[e * 65 + F.lane] = s[e];
        }
        float tl = 0.f;
        { const LAS float* pr = PS + (F.lane & 15) * 65 + (F.lane >> 4) * 16;
#pragma unroll
          for (int i = 0; i < 16; ++i) tl += pr[i]; }
        tl += __shfl_xor(tl, 16); tl += __shfl_xor(tl, 32);
        const float my_sc = 1.0f / (1.0f + expf(-tl)), my_sel = my_sc + router_b[F.lane & 15];
        float sc[16], sel[16];
#pragma unroll
        for (int e = 0; e < 16; ++e) { sc[e] = __builtin_bit_cast(float, __builtin_amdgcn_readlane(__builtin_bit_cast(int, my_sc), e)); sel[e] = __builtin_bit_cast(float, __builtin_amdgcn_readlane(__builtin_bit_cast(int, my_sel), e)); }
        float gs[4];
#pragma unroll
        for (int gq = 0; gq < 4; ++gq) { const float a = sel[4 * gq], b = sel[4 * gq + 1], c = sel[4 * gq + 2], d = sel[4 * gq + 3];
            const float h1 = fmaxf(a, b), l1 = fminf(a, b), h2 = fmaxf(c, d), l2 = fminf(c, d);
            gs[gq] = fmaxf(h1, h2) + fmaxf(fminf(h1, h2), fmaxf(l1, l2)); }
        int gi = 0; float bg = gs[0];
#pragma unroll
        for (int gq = 1; gq < 4; ++gq) if (gs[gq] > bg) { bg = gs[gq]; gi = gq; }
        float s4[4], c4[4];
#pragma unroll
        for (int q = 0; q < 4; ++q) { s4[q] = sel[q]; c4[q] = sc[q]; }
#pragma unroll
        for (int gq = 1; gq < 4; ++gq)
#pragma unroll
            for (int q = 0; q < 4; ++q) { s4[q] = (gi == gq) ? sel[4 * gq + q] : s4[q]; c4[q] = (gi == gq) ? sc[4 * gq + q] : c4[q]; }
        int i1 = 0; float b1 = s4[0], w1 = c4[0];
#pragma unroll
        for (int q = 1; q < 4; ++q) if (s4[q] > b1) { b1 = s4[q]; i1 = q; w1 = c4[q]; }
        int i2 = -1; float b2 = -INFINITY, w2 = 0.f;
#pragma unroll
        for (int q = 0; q < 4; ++q) if (q != i1 && (i2 < 0 || s4[q] > b2)) { b2 = s4[q]; i2 = q; w2 = c4[q]; }
        const float wsum = w1 + w2; w1 = w1 / wsum; w2 = w2 / wsum;
        const int ia = i1 < i2 ? i1 : i2, ib = i1 < i2 ? i2 : i1;
        const float wlo = i1 < i2 ? w1 : w2, whi = i1 < i2 ? w2 : w1;
        const int pidx = ia == 0 ? ib - 1 : (ia == 1 ? ib + 1 : 5);
        if (F.lane == k) { my_cls = gi * 6 + pidx; my_tok = R; my_wlo = wlo; my_whi = whi; }
    }
    if (my_cls >= 0 && !dry) {
        const unsigned pos = __hip_atomic_fetch_add(WSP(unsigned, WS_CTL) + CW_CNT + (l * NCLS + my_cls) * 64, 1u, RLX_AGENT);
        WSP(int, WS_TOK)[(size_t)my_cls * CAP + pos] = my_tok; WSP(f32x2, WS_WTS)[(size_t)my_cls * CAP + pos] = (f32x2){my_wlo, my_whi};
    }
    __syncthreads();
}
__device__ __forceinline__ int moe_tables(Frame& F0, int l) {
    Frame F = F0; asm volatile("" : "+v"(F.tid));
    LAS int* s_n = (LAS int*)(F.lds + MOE_OFF); LAS int* s_ts = s_n + 32;
    __syncthreads();
    if (F.tid < NCLS) s_n[F.tid] = (int)__hip_atomic_load(WSP(unsigned, WS_CTL) + CW_CNT + (l * NCLS + F.tid) * 64, RLX_AGENT);
    __syncthreads();
    if (F.tid == 0) { int acc = 0; for (int c = 0; c < NCLS; ++c) { s_ts[c] = acc; acc += (s_n[c] + 255) >> 8; } s_ts[NCLS] = acc; }
    __syncthreads();
    return s_ts[NCLS];
}

constexpr int NPHASE = 1 + 7 * NLAYER;
__global__ void __launch_bounds__(NWAVES * 64, 2) fwd_kernel(Args args) {
    extern __shared__ __attribute__((aligned(16))) unsigned char lds[];
    Frame F;
    F.lds = (LAS unsigned char*)lds; F.MISC = (volatile LAS unsigned*)(F.lds + MISC_OFF);
    F.tid = threadIdx.x; F.lane = F.tid & 63; F.wave = __builtin_amdgcn_readfirstlane(F.tid >> 6);
    F.G = gridDim.x; { const int bx = blockIdx.x; F.vcu = (F.G % 8 == 0) ? (bx % 8) * (F.G / 8) + bx / 8 : bx; }
    for (int u = F.tid; u < (LDS_BYTES - LDSCTL_OFF) / 4; u += NWAVES * 64) ((LAS unsigned*)(F.lds + LDSCTL_OFF))[u] = 0u;
    __syncthreads();
    const int lo = args.ph_lo, hi = args.ph_hi;
    XcdBarrier bar; bar.bar = WSP(unsigned, WS_CTL) + CW_BAR; bar.x = 0; bar.st = nullptr;
    if (hi - lo > 1) bar = xcd_barrier_post(WSP(unsigned, WS_CTL) + CW_BAR, F.MISC + 8);
#ifndef MK_EN
#define MK_EN 0xff
#endif
#define EN(k) (((MK_EN) >> (k)) & 1)
#ifndef REP_P0
#define REP_P0 1
#endif
#ifndef REP_A
#define REP_A 1
#endif
#ifndef REP_B
#define REP_B 1
#endif
#ifndef REP_C
#define REP_C 1
#endif
#ifndef REP_F
#define REP_F 1
#endif
#ifndef REP_D
#define REP_D 1
#endif
#ifndef REP_E
#define REP_E 1
#endif
#ifndef REP_G
#define REP_G 1
#endif
#define RUN(p) (lo <= (p) && (p) < hi)
#ifndef REP_BAR
#define REP_BAR 1
#endif
#define SEAM(p) do { if (RUN(p) && RUN((p) + 1)) { xcd_barrier(bar); if (REP_BAR > 1) xcd_barrier(bar); if (REP_BAR > 2) xcd_barrier(bar); } } while (0)

    if (EN(7) && RUN(0)) { for (int rep = 0; rep < REP_P0; ++rep) { p0_prologue(F); if (rep + 1 < REP_P0) xcd_barrier(bar); } SEAM(0); }

    for (int l = 0; l < NLAYER; ++l) {
        const int pb = 1 + 7 * l; const bool lastl = (l == NLAYER - 1);
        if (EN(0) && RUN(pb + 0)) { for (int rep = 0; rep < REP_A; ++rep) { phase_norm1(F, l); if (rep + 1 < REP_A) xcd_barrier(bar); } SEAM(pb + 0); }
        if (EN(1) && RUN(pb + 1)) {
#if INPROJ_F8
            pg8::ProbDense P; P.A = WSP(const char, WS_HN8); P.B = WSP(const char, WS_WIN) + (size_t)l * 1536 * 1024; P.lda = 512; P.ldb = 512; P.nt = 8; P.skip_ctx = false; P.S.init(NROW, 1536, F.G, (int)blockIdx.x);
#else
            pg8::ProbDense P; P.A = WSP(const char, WS_HN); P.B = (const char*)(WSP(bf16_t, WS_WIN) + (size_t)l * 1536 * 1024); P.lda = 1024; P.ldb = 1024; P.nt = 16; P.skip_ctx = false; P.S.init(NROW, 1536, F.G, (int)blockIdx.x);
#endif
            pg8::EpiQKV E{kargs()->ws, WSP(float, WS_GN) + l * 256, WSP(float, WS_ROPE)};
            for (int rep = 0; rep < REP_B; ++rep) { pg8::gemm_phase<pg8::EpiQKV, pg8::ProbDense, true, INPROJ_F8 != 0>(F.lds + RING_OFF, F.lds + OFFS_OFF, P, E); if (rep + 1 < REP_B) xcd_barrier(bar); }
            SEAM(pb + 1);
        }
        if (EN(2) && RUN(pb + 2)) {
            const unsigned char* Qf8 = WSP(const unsigned char, WS_QO); const unsigned char* KVT = WSP(const unsigned char, WS_KV); attn_body::bf16* O = WSP(attn_body::bf16, OPROJ_F8 ? WS_HN8 : WS_HN);
            const float* sink = kargs()->in[I_SINK] + l * 8;
            const int n0 = 1024 + (lastl ? 0 : 32);
            const float bnd_g = WSP(const float, WS_BND)[l * 2], bnd_l = WSP(const float, WS_BND)[l * 2 + 1];
#if VFP8
            const float ref_g = bnd_g - 15.5f, ref_l = bnd_l - 15.5f;
#if EXPFREE
#ifndef ATTN_BODY
#define ATTN_BODY attn_unit_f8d
#endif
#else
#define ATTN_BODY attn_unit_f8b
#endif
#else
            const float ref_g = fmaxf(bnd_g - 96.0f, 0.0f), ref_l = fmaxf(bnd_l - 96.0f, 0.0f);
#define ATTN_BODY attn_unit_f8
#endif
#ifndef PROBE_XV
#define PROBE_XV 0
#endif
            for (int rep = 0; rep < REP_C; ++rep) {
            if (PROBE_XV != 0 && rep + 1 < REP_C) {
                attn_body::bf16* OD = (attn_body::bf16*)(kargs()->ws + (size_t)560 * MiB);
                for (int L = F.vcu; L < 1024; L += F.G) { const int bh = L >> 6, b = bh >> 3, h = bh & 7, qb = L & 63;
                    attn_body::attn_unit_f8d<0, (PROBE_XV == 9 ? 0 : PROBE_XV)>((long)b * RB + NCTX + qb * 256, (long)b * RB, 0, h * 64, h >> 2, h >> 2, RB / 64, -INFINITY, ref_g, Qf8, KVT, OD, (char*)lds + RING_OFF); }
                xcd_barrier(bar); continue; }
            for (int L = F.vcu; L < n0; L += F.G) {
                long qrow, kvrow; int qcol, st, NT; float sink2 = -INFINITY, ref = ref_g;
                if (L < 1024) { const int bh = L >> 6, b = bh >> 3, h = bh & 7, qb = L & 63; qrow = (long)b * RB + NCTX + qb * 256; kvrow = (long)b * RB; NT = RB / 64; qcol = h * 64; st = h >> 2; }
                else { const int Lc = L - 1024, b = Lc >> 4, h = Lc & 15; qrow = (long)b * RB; kvrow = qrow; NT = NCTX / 64; qcol = h * 64;
                    if (h < 8) { st = h >> 2; } else { const int hl = h - 8; st = 2 + (hl >> 2); sink2 = sink[hl] * LOG2E; ref = ref_l; } }
                attn_body::ATTN_BODY<0>(qrow, kvrow, 0, qcol, st, st, NT, sink2, ref, Qf8, KVT, O, (char*)lds + RING_OFF);
            }
            for (int L = F.vcu; L < 1024; L += F.G) {
                const int bh = L >> 6, b = bh >> 3, hl = bh & 7, qb = L & 63, q0 = qb * 256;
                attn_body::ATTN_BODY<1>((long)b * RB + NCTX + q0, (long)b * RB, q0, (8 + hl) * 64, 2 + (hl >> 2), 2 + (hl >> 2), 12, sink[hl] * LOG2E, ref_l, Qf8, KVT, O, (char*)lds + RING_OFF);
            }
            if (rep + 1 < REP_C) xcd_barrier(bar); }
            SEAM(pb + 2);
        }
        if (EN(3) && RUN(pb + 3)) {
#if OPROJ_F8
            pg8::ProbDense P; P.A = WSP(const char, WS_HN8); P.B = WSP(const char, WS_WOUT) + (size_t)l * 1024 * 1024; P.lda = 512; P.ldb = 512; P.nt = 8; P.skip_ctx = lastl;
#else
            pg8::ProbDense P; P.A = WSP(const char, WS_HN); P.B = (const char*)(WSP(bf16_t, WS_WOUT) + (size_t)l * 1024 * 1024); P.lda = 1024; P.ldb = 1024; P.nt = 16; P.skip_ctx = lastl;
#endif
            P.S.init(lastl ? NB * SEQ : NROW, 1024, F.G, (int)blockIdx.x);
            for (int rep = 0; rep < REP_D; ++rep) {
            pg8::EpiResid E{WSP(bf16_t, WS_XS), WSP(float, WS_MODV) + (size_t)l * 3 * 6144, 2048, ((rep & 1) ? -1.0f : 1.0f) * (OPROJ_F8 ? (1.0f / 2048.0f) : 1.0f)};
            pg8::gemm_phase<pg8::EpiResid, pg8::ProbDense, true, OPROJ_F8 != 0>(F.lds + RING_OFF, F.lds + OFFS_OFF, P, E); if (rep + 1 < REP_D) xcd_barrier(bar); }
            SEAM(pb + 3);
        }
        if (EN(4) && RUN(pb + 4)) {
#if REP_E == 2
            phase_norm2_router(F, l, lastl, true); xcd_barrier(bar);
#endif
            phase_norm2_router(F, l, lastl, false); SEAM(pb + 4); }
        if (EN(5) && RUN(pb + 5)) {
            const int ntile = moe_tables(F, l);
            pg8::ProbGU P; P.A = WSP(const char, WS_HN); P.B = (const char*)(WSP(bf16_t, WS_WGU) + (size_t)l * 16 * 1024 * 1024); P.tok = WSP(int, WS_TOK); P.s_n = (const LAS int*)(F.lds + MOE_OFF); P.s_ts = P.s_n + 32;
            P.total = ntile * 8; P.G = F.G; P.c = F.vcu; P.nt = 16;
            pg8::EpiGU E{WSP(bf16_t, WS_ACT), WSP(f32x2, WS_WTS)};
            for (int rep = 0; rep < REP_F; ++rep) { pg8::gemm_phase<pg8::EpiGU, pg8::ProbGU, true>(F.lds + RING_OFF, F.lds + OFFS_OFF, P, E); if (rep + 1 < REP_F) xcd_barrier(bar); }
            SEAM(pb + 5);
        }
        if (EN(6) && RUN(pb + 6)) {
            const int ntile = moe_tables(F, l);
            pg8::ProbDown P; P.A = WSP(const char, WS_ACT); P.B = (const char*)(WSP(bf16_t, WS_WD) + (size_t)l * 16 * 1024 * 512); P.s_n = (const LAS int*)(F.lds + MOE_OFF); P.s_ts = P.s_n + 32;
            P.total = ntile * 4; P.G = F.G; P.c = F.vcu; P.nt = 16;
            for (int rep = 0; rep < REP_G; ++rep) {
            pg8::EpiDown E{WSP(bf16_t, WS_XS), lastl ? kargs()->out : nullptr, WSP(int, WS_TOK), WSP(float, WS_MODV) + (size_t)l * 3 * 6144, (rep & 1) ? -1.0f : 1.0f};
            pg8::gemm_phase<pg8::EpiDown, pg8::ProbDown, true>(F.lds + RING_OFF, F.lds + OFFS_OFF, P, E); if (rep + 1 < REP_G) xcd_barrier(bar); }
            SEAM(pb + 6);
        }
    }
#undef RUN
#undef SEAM
}

#ifndef MK_SPLIT
#define MK_SPLIT 0
#endif
extern "C" void kernel_launch(void* const* d_in, const int* in_sizes, int n_in, void* d_out, int out_size, void* d_ws, size_t ws_size, hipStream_t stream) {
    static int grid = 0;
    if (grid == 0) {
        if (n_in != 20 || in_sizes[0] != NB * SEQ * DM || out_size != NB * SEQ * DM || ws_size < WS_END) {
            fprintf(stderr, "kernel_launch: unexpected shapes (n_in %d, in0 %d, out %d, ws %zu); nothing launched\n", n_in, n_in > 0 ? in_sizes[0] : -1, out_size, ws_size); grid = -1; return; }
        int dev = 0, cus = 0, per_cu = 0;
        if (hipGetDevice(&dev) != hipSuccess || hipDeviceGetAttribute(&cus, hipDeviceAttributeMultiprocessorCount, dev) != hipSuccess) { grid = -1; return; }
        if (hipFuncSetAttribute((const void*)fwd_kernel, hipFuncAttributeMaxDynamicSharedMemorySize, LDS_BYTES) != hipSuccess) { fprintf(stderr, "kernel_launch: hipFuncSetAttribute failed\n"); grid = -1; return; }
        if (hipOccupancyMaxActiveBlocksPerMultiprocessor(&per_cu, (const void*)fwd_kernel, NWAVES * 64, LDS_BYTES) != hipSuccess || per_cu < 1)
            fprintf(stderr, "kernel_launch: note: occupancy query reports %d workgroups per CU\n", per_cu);
        (void)hipGetLastError();
        grid = cus;
    }
    if (grid < 0) return;
    if (hipMemsetAsync((char*)d_ws + WS_CTL, 0, CTL_ZERO_BYTES, stream) != hipSuccess) return;
    Args a{};
    for (int i = 0; i < 20; ++i) a.in[i] = (const float*)d_in[i];
    a.out = (float*)d_out; a.ws = (unsigned char*)d_ws;
#if MK_SPLIT
    for (int p = 0; p < NPHASE; ++p) { a.ph_lo = p; a.ph_hi = p + 1; hipLaunchKernelGGL(fwd_kernel, dim3(grid), dim3(NWAVES * 64), LDS_BYTES, stream, a); }
#else
    a.ph_lo = 0; a.ph_hi = NPHASE;
    hipLaunchKernelGGL(fwd_kernel, dim3(grid), dim3(NWAVES * 64), LDS_BYTES, stream, a);
#endif
    const hipError_t le = hipPeekAtLastError();
    if (le != hipSuccess) fprintf(stderr, "kernel_launch: launch failed: %s\n", hipGetErrorName(le));
}
```
